# Optimizing an MI355X kernel written in HIP

```python
import jax
import jax.numpy as jnp
from jax import lax
import numpy as np

D_MODEL = 2048
BATCH = 2
SEQ = 4096
DEPTH = 2

GRID_W = 64

POOL_WINDOWS = (2, 4, 8, 16)
POOL_GROUPS = 4
POOL_GROUP_W = D_MODEL // 16
POOL_W = POOL_GROUPS * POOL_GROUP_W

ATT_HEAD_DIM = 128
ATT_HEADS = (D_MODEL - POOL_W) // ATT_HEAD_DIM
ATT_KV_HEADS = 4
ATT_GROUP = ATT_HEADS // ATT_KV_HEADS
Q_W = ATT_HEADS * ATT_HEAD_DIM
KV_W = ATT_KV_HEADS * ATT_HEAD_DIM
Q_BLOCK = 128
ROPE_THETA = 10000.0
AB_IN_W = POOL_W + Q_W + 2 * KV_W
AB_OUT_W = POOL_W + Q_W

MLSTM_HEADS = 8
MLSTM_HEAD_DIM = D_MODEL // MLSTM_HEADS
MLSTM_W = MLSTM_HEADS * MLSTM_HEAD_DIM
MLSTM_CHUNK = 64
C_IN_W = 4 * MLSTM_W + 4 * MLSTM_HEADS
FORGET_BIAS = 3.0

D_FF = 5632
CONV_WIDTH = 3

NORM_EPS = 1e-6

kernel_name = "hybrid_pool_gqa_mlstm_convffn_encoder"


def rms_norm(x, g):
    xf = x.astype(jnp.float32)
    y = xf * lax.rsqrt(jnp.mean(xf * xf, axis=-1, keepdims=True) + NORM_EPS)
    return (y * g.astype(jnp.float32)).astype(x.dtype)


def axial_rope(seq_len):
    rows = seq_len // GRID_W
    row = jnp.repeat(jnp.arange(rows), GRID_W).astype(jnp.float32)
    col = jnp.tile(jnp.arange(GRID_W), rows).astype(jnp.float32)
    half = ATT_HEAD_DIM // 2
    inv = 1.0 / (ROPE_THETA ** (jnp.arange(0, half, 2, dtype=jnp.float32) / half))
    a_r = row[:, None] * inv[None, :]
    a_c = col[:, None] * inv[None, :]
    ang = jnp.concatenate([a_r, a_r, a_c, a_c], axis=-1)
    return jnp.cos(ang)[:, None, :], jnp.sin(ang)[:, None, :]


def apply_rope(x, cos, sin):
    xf = x.astype(jnp.float32)
    half = ATT_HEAD_DIM // 2
    quarter = ATT_HEAD_DIM // 4

    def rot(z):
        return jnp.concatenate([-z[..., quarter:], z[..., :quarter]], axis=-1)

    rotated = jnp.concatenate([rot(xf[..., :half]), rot(xf[..., half:])], axis=-1)
    return (xf * cos + rotated * sin).astype(x.dtype)


def multiscale_pool(u, pool_w, pool_scale):
    b, s, _ = u.shape
    uf = u.astype(jnp.float32).reshape(b, s, POOL_GROUPS, POOL_GROUP_W)
    cs = jnp.concatenate(
        [jnp.zeros((b, 1, POOL_GROUPS, POOL_GROUP_W), jnp.float32), jnp.cumsum(uf, axis=1)], axis=1
    )
    t = jnp.arange(s)
    means = []
    for gi, w in enumerate(POOL_WINDOWS):
        lo = jnp.clip(t - w // 2, 0, s)
        hi = jnp.clip(t + w // 2, 0, s)
        csg = cs[:, :, gi]
        window_sum = jnp.take(csg, hi, axis=1) - jnp.take(csg, lo, axis=1)
        means.append(window_sum / (hi - lo).astype(jnp.float32)[None, :, None])
    pooled = jnp.stack(means, axis=2) - uf
    y = jnp.einsum("bsgc,gcd->bsgd", pooled, pool_w.astype(jnp.float32))
    y = y.reshape(b, s, POOL_W) * pool_scale.astype(jnp.float32)
    return y.astype(u.dtype)


def blocked_gqa(q, k, v):
    b, s, _, _ = q.shape
    nb = s // Q_BLOCK
    scale = ATT_HEAD_DIM ** -0.5
    qb = q.reshape(b, nb, Q_BLOCK, ATT_KV_HEADS, ATT_GROUP, ATT_HEAD_DIM).transpose(1, 0, 2, 3, 4, 5)

    def one_block(q_blk):
        scores = jnp.einsum("bqkgd,bskd->bkgqs", q_blk, k).astype(jnp.float32) * scale
        probs = jax.nn.softmax(scores, axis=-1).astype(v.dtype)
        return jnp.einsum("bkgqs,bskd->bqkgd", probs, v)

    out = lax.map(one_block, qb)
    return out.transpose(1, 0, 2, 3, 4, 5).reshape(b, s, Q_W)


def mlstm_one_direction(q, k, v, i_pre, f_pre):
    b, h, s, d = q.shape
    L = MLSTM_CHUNK
    nc = s // L

    def chunks(z):
        return jnp.moveaxis(z.reshape((b, h, nc, L) + z.shape[3:]), 2, 0)

    logf = jax.nn.log_sigmoid(f_pre)
    mask = jnp.tril(jnp.ones((L, L), dtype=bool))

    def step(carry, inp):
        c_st, n_st, m_st = carry
        qc, kc, vc, ic, lfc = inp
        bcum = jnp.cumsum(lfc, axis=-1)
        dmat = bcum[..., :, None] - bcum[..., None, :] + ic[..., None, :]
        dmat = jnp.where(mask, dmat, -jnp.inf)
        m_inter = bcum + m_st[..., None]
        m_t = jnp.maximum(m_inter, jnp.max(dmat, axis=-1))
        w = jnp.exp(dmat - m_t[..., None])
        a_inter = jnp.exp(m_inter - m_t)
        scores = jnp.einsum("bhtd,bhsd->bhts", qc, kc) * w
        num = jnp.einsum("bhts,bhse->bhte", scores, vc) + a_inter[..., None] * jnp.einsum(
            "bhtd,bhde->bhte", qc, c_st
        )
        den = jnp.sum(scores, axis=-1) + a_inter * jnp.einsum("bhtd,bhd->bht", qc, n_st)
        h_out = num / jnp.maximum(jnp.abs(den), jnp.exp(-m_t))[..., None]
        b_last = bcum[..., -1]
        g_s = b_last[..., None] - bcum + ic
        m_next = jnp.maximum(b_last + m_st, jnp.max(g_s, axis=-1))
        decay = jnp.exp(b_last + m_st - m_next)
        ws = jnp.exp(g_s - m_next[..., None])
        c_new = decay[..., None, None] * c_st + jnp.einsum("bhs,bhsd,bhse->bhde", ws, kc, vc)
        n_new = decay[..., None] * n_st + jnp.einsum("bhs,bhsd->bhd", ws, kc)
        return (c_new, n_new, m_next), h_out

    init = (
        jnp.zeros((b, h, d, d), jnp.float32),
        jnp.zeros((b, h, d), jnp.float32),
        jnp.zeros((b, h), jnp.float32),
    )
    _, hs = lax.scan(step, init, (chunks(q), chunks(k), chunks(v), chunks(i_pre), chunks(logf)))
    return jnp.moveaxis(hs, 0, 2).reshape(b, h, s, d)


def mlstm_mixer(h, w_in, b_gate, h_norm, w_out):
    b, s, _ = h.shape
    proj = h @ w_in

    def heads(z):
        return z.reshape(b, s, MLSTM_HEADS, MLSTM_HEAD_DIM).transpose(0, 2, 1, 3).astype(jnp.float32)

    q = heads(proj[..., :MLSTM_W]) * (MLSTM_HEAD_DIM ** -0.5)
    k = heads(proj[..., MLSTM_W:2 * MLSTM_W])
    v = heads(proj[..., 2 * MLSTM_W:3 * MLSTM_W])
    o_gate = jax.nn.sigmoid(proj[..., 3 * MLSTM_W:4 * MLSTM_W].astype(jnp.float32))
    gates = proj[..., 4 * MLSTM_W:].astype(jnp.float32) + b_gate.astype(jnp.float32)
    gates = gates.reshape(b, s, 4, MLSTM_HEADS).transpose(2, 0, 3, 1)
    h_fw = mlstm_one_direction(q, k, v, gates[0], gates[1])

    def flip(z):
        return jnp.flip(z, axis=2)

    h_bw = flip(mlstm_one_direction(flip(q), flip(k), flip(v), flip(gates[2]), flip(gates[3])))
    hsum = (h_fw + h_bw).transpose(0, 2, 1, 3)
    hn = hsum * lax.rsqrt(jnp.mean(hsum * hsum, axis=-1, keepdims=True) + NORM_EPS)
    hn = hn * h_norm.astype(jnp.float32).reshape(MLSTM_HEADS, MLSTM_HEAD_DIM)
    y = (hn.reshape(b, s, MLSTM_W) * o_gate).astype(h.dtype)
    return y @ w_out


def conv_ffn(x, w_up, conv_w, conv_b, w_down):
    u = x @ w_up
    up = jnp.pad(u, ((0, 0), (1, 1), (0, 0)))
    c = conv_w.astype(u.dtype)
    u = c[0] * up[:, :-2] + c[1] * up[:, 1:-1] + c[2] * up[:, 2:] + conv_b.astype(u.dtype)
    gate, val = jnp.split(u, 2, axis=-1)
    return (jax.nn.silu(gate) * val) @ w_down


def setup_inputs(seed: int = 0) -> dict:
    key = jax.random.key(seed)
    ks = jax.random.split(key, 20)
    n_even = (DEPTH + 1) // 2
    n_odd = DEPTH // 2
    f32 = jnp.float32

    def dense(k, shape, fan_in):
        return jax.random.normal(k, shape, f32) * (fan_in ** -0.5)

    def gain(k, shape):
        return 1.0 + 0.02 * jax.random.normal(k, shape, f32)

    x = jax.random.normal(ks[0], (BATCH, SEQ, D_MODEL), f32)
    norm_mix = gain(ks[1], (DEPTH, D_MODEL))
    norm_ffn = gain(ks[2], (DEPTH, D_MODEL))
    w_in_ab = dense(ks[3], (n_even, D_MODEL, AB_IN_W), D_MODEL)
    pool_w = dense(ks[4], (n_even, POOL_GROUPS, POOL_GROUP_W, POOL_GROUP_W), POOL_GROUP_W)
    pool_scale = gain(ks[5], (n_even, POOL_W))
    q_norm = gain(ks[6], (n_even, ATT_HEAD_DIM))
    k_norm = gain(ks[7], (n_even, ATT_HEAD_DIM))
    w_out_ab = dense(ks[8], (n_even, AB_OUT_W, D_MODEL), AB_OUT_W)
    w_in_c = dense(ks[9], (n_odd, D_MODEL, C_IN_W), D_MODEL)
    gate_base = jnp.array([0.0, FORGET_BIAS, 0.0, FORGET_BIAS], f32)[None, :, None]
    b_gate_c = (gate_base + 0.1 * jax.random.normal(ks[10], (n_odd, 4, MLSTM_HEADS), f32)).reshape(
        n_odd, 4 * MLSTM_HEADS
    )
    h_norm_c = gain(ks[11], (n_odd, MLSTM_W))
    w_out_c = dense(ks[12], (n_odd, MLSTM_W, D_MODEL), MLSTM_W)
    w_up = dense(ks[13], (DEPTH, D_MODEL, 2 * D_FF), D_MODEL)
    conv_w = dense(ks[14], (DEPTH, CONV_WIDTH, 2 * D_FF), CONV_WIDTH)
    conv_b = 0.02 * jax.random.normal(ks[15], (DEPTH, 2 * D_FF), f32)
    w_down = dense(ks[16], (DEPTH, D_FF, D_MODEL), D_FF)
    return {
        "x": x,
        "norm_mix": norm_mix,
        "norm_ffn": norm_ffn,
        "w_in_ab": w_in_ab,
        "pool_w": pool_w,
        "pool_scale": pool_scale,
        "q_norm": q_norm,
        "k_norm": k_norm,
        "w_out_ab": w_out_ab,
        "w_in_c": w_in_c,
        "b_gate_c": b_gate_c,
        "h_norm_c": h_norm_c,
        "w_out_c": w_out_c,
        "w_up": w_up,
        "conv_w": conv_w,
        "conv_b": conv_b,
        "w_down": w_down,
    }


def reference(x, norm_mix, norm_ffn, w_in_ab, pool_w, pool_scale, q_norm, k_norm, w_out_ab,
              w_in_c, b_gate_c, h_norm_c, w_out_c, w_up, conv_w, conv_b, w_down):
    b, s, _ = x.shape
    cos, sin = axial_rope(s)
    for layer in range(DEPTH):
        h = rms_norm(x, norm_mix[layer])
        if layer % 2 == 0:
            e = layer // 2
            proj = h @ w_in_ab[e]
            u = proj[..., :POOL_W]
            q = proj[..., POOL_W:POOL_W + Q_W].reshape(b, s, ATT_HEADS, ATT_HEAD_DIM)
            k = proj[..., POOL_W + Q_W:POOL_W + Q_W + KV_W].reshape(b, s, ATT_KV_HEADS, ATT_HEAD_DIM)
            v = proj[..., POOL_W + Q_W + KV_W:].reshape(b, s, ATT_KV_HEADS, ATT_HEAD_DIM)
            q = apply_rope(rms_norm(q, q_norm[e]), cos, sin)
            k = apply_rope(rms_norm(k, k_norm[e]), cos, sin)
            pool_out = multiscale_pool(u, pool_w[e], pool_scale[e])
            att_out = blocked_gqa(q, k, v)
            mixed = jnp.concatenate([pool_out, att_out], axis=-1) @ w_out_ab[e]
        else:
            o = layer // 2
            mixed = mlstm_mixer(h, w_in_c[o], b_gate_c[o], h_norm_c[o], w_out_c[o])
        x = x + mixed
        x = x + conv_ffn(rms_norm(x, norm_ffn[layer]), w_up[layer], conv_w[layer], conv_b[layer], w_down[layer])
    return x
```

```cpp
#include <hip/hip_runtime.h>
#include <hip/hip_cooperative_groups.h>
#include <hip/hip_bf16.h>
#include <cstdio>
#include <cstdint>
#include <cmath>
namespace cg = cooperative_groups;
__device__ __forceinline__ int mk_tid();
namespace pg8 {
#define PG8_LAS __attribute__((address_space(3)))
typedef unsigned short bf16_t;
typedef short bf16x8 __attribute__((ext_vector_type(8)));
typedef float f32x4 __attribute__((ext_vector_type(4)));
typedef unsigned u32x4 __attribute__((ext_vector_type(4)));
constexpr int BM = 256, BK = 64, HALF = 128, HTB = HALF * BK * 2  , STAGE_BYTES = 8 * HTB, NXCD = 8, WGM = 8;

__host__ __device__ __forceinline__ int lds_byte(int r, int c) { const int st = (r >> 4) * 2 + (c >> 5), rr = r & 15, cc = c & 31, ob = rr * 64 + cc * 2; return st * 1024 + (ob ^ (((ob >> 9) & 1) << 5)); }
__host__ __device__ __forceinline__ void stage_rc(int b, int& R, int& C) { const int st = b / 1024, sb = b % 1024, swz = sb ^ (((sb >> 9) & 1) << 5); R = (st >> 1) * 16 + swz / 64; C = (st & 1) * 32 + (swz % 64) / 2; }
__host__ __device__ __forceinline__ int perm32(int rho) { const int n = rho >> 4, i = rho & 15; return 8 * (i >> 2) + 4 * n + (i & 3); }

struct Unit { int pm, pn; };
struct Gemm { const bf16_t* A; const bf16_t* Bt; int M, N, K; };

struct StaticOrder {
    int nM, nN, nwg, G, c;
    __host__ __device__ void init(int M, int N, int G_, int c_) { nM = M / BM; nN = N / BM; nwg = nM * nN; G = G_; c = c_; }
    __host__ __device__ bool next(int i, Unit& u) const {
        const long L = (long)i * G + c; if (L >= nwg) return false;
        int wgid = (int)L; { const int q = nwg / NXCD, r = nwg % NXCD, xcd = wgid % NXCD, off = wgid / NXCD; wgid = (xcd < r ? xcd * (q + 1) : r * (q + 1) + (xcd - r) * q) + off; }
        const int nig = WGM * nN, gid = wgid / nig, fm = gid * WGM, gsz = (nM - fm) < WGM ? (nM - fm) : WGM;
        u.pm = fm + ((wgid % nig) % gsz); u.pn = (wgid % nig) / gsz; return true;
    }
    __device__ __forceinline__ void a_ready(const Unit&) const {}
    __device__ __forceinline__ void done(const Unit&) const {}
};

__device__ __forceinline__ unsigned cvt_pk_bf16(float lo, float hi) { unsigned r; asm volatile("v_cvt_pk_bf16_f32 %0, %1, %2" : "=v"(r) : "v"(lo), "v"(hi)); return r; }
typedef float f32x2 __attribute__((ext_vector_type(2)));
__device__ __forceinline__ f32x2 gelu_pk(f32x2 v) {
    const f32x2 av = __builtin_elementwise_abs(v), d = av * 0.2316418882f + 1.0f;
    f32x2 t; t.x = __builtin_amdgcn_rcpf(d.x); t.y = __builtin_amdgcn_rcpf(d.y);
    f32x2 q = t * 0.5307027145f + (-0.7265760135f); q = q * t + 0.7107068705f; q = q * t + (-0.142248368f); q = q * t + 0.127414796f; q = q * t;
    const f32x2 s = (v * v) * (-0.72134752044f);
    f32x2 e; e.x = __builtin_amdgcn_exp2f(s.x); e.y = __builtin_amdgcn_exp2f(s.y);
    const f32x2 m = v * (q * e), r = v - m;
    f32x2 o; o.x = v.x < 0.f ? m.x : r.x; o.y = v.y < 0.f ? m.y : r.y; return o;
}

template <int ACT  > struct EpiBf16 {
    static constexpr bool PERM = true, AFTER_DRAIN = false; static_assert(ACT == 0 || ACT == 1, "EpiBf16: ACT is 0 (none) or 1 (gelu_pk)");
    bf16_t* O; int ldc; const float* bias; int split_cols; size_t split_stride; float scale0;
    __device__ __forceinline__ void operator()(const f32x4 (&acc)[2][2][4][2], const Unit& u, int wr, int wc, int fr, int fq) const {
        const int row0 = u.pm * BM + wr * 64 + fr; int colt = u.pn * BM; bf16_t* base = O;
        float sc = 1.f; if (split_cols) { const int t = colt / split_cols; base += (size_t)t * split_stride; colt -= t * split_cols; if (t == 0) sc = scale0; }
        const int col0 = colt + wc * 32 + 8 * fq, bcol0 = u.pn * BM + wc * 32 + 8 * fq;
        f32x4 bv[2][2];
#pragma unroll
        for (int bj = 0; bj < 2; ++bj)
#pragma unroll
            for (int n = 0; n < 2; ++n) bv[bj][n] = bias ? *(const f32x4*)(bias + bcol0 + bj * HALF + 4 * n) : (f32x4){0.f, 0.f, 0.f, 0.f};
#pragma unroll
        for (int ai = 0; ai < 2; ++ai)
#pragma unroll
            for (int m = 0; m < 4; ++m) { bf16_t* rowp = base + (size_t)(row0 + ai * HALF + m * 16) * ldc + col0;
#pragma unroll
                for (int bj = 0; bj < 2; ++bj) { f32x4 v0 = acc[ai][bj][m][0] + bv[bj][0], v1 = acc[ai][bj][m][1] + bv[bj][1];
                    if (ACT == 1) { f32x2 a = gelu_pk((f32x2){v0[0], v0[1]}), b = gelu_pk((f32x2){v0[2], v0[3]}), c = gelu_pk((f32x2){v1[0], v1[1]}), d = gelu_pk((f32x2){v1[2], v1[3]});
                        v0 = (f32x4){a.x, a.y, b.x, b.y}; v1 = (f32x4){c.x, c.y, d.x, d.y}; }
                    v0 = v0 * sc; v1 = v1 * sc; u32x4 w; w.x = cvt_pk_bf16(v0[0], v0[1]); w.y = cvt_pk_bf16(v0[2], v0[3]); w.z = cvt_pk_bf16(v1[0], v1[1]); w.w = cvt_pk_bf16(v1[2], v1[3]);
                    *(u32x4*)(rowp + bj * HALF) = w; } }
    }
};

template <class Epi, class Sched, bool ALIGN_EPI = false, bool SP2 = false>
__device__ __forceinline__ void gemm_phase(PG8_LAS unsigned char* lds, const Gemm g, const Sched& S, const Epi& E) {
    const int tid = mk_tid(), wid = __builtin_amdgcn_readfirstlane(tid >> 6), lane = tid & 63, wr = wid >> 2, wc = wid & 3, fr = lane & 15, fq = lane >> 4;
    const int K = g.K, nt = K / BK;
    unsigned voffA[2], voffB[2];
#pragma unroll
    for (int i = 0; i < 2; ++i) { int R, C; stage_rc(tid * 16 + i * 8192, R, C); const int Rb = Epi::PERM ? ((R & ~31) + perm32(R & 31)) : R;
        voffA[i] = (unsigned)(R * K + C) * 2u; voffB[i] = (unsigned)(Rb * K + C) * 2u; }
    const size_t kstep = (size_t)(BK * 2);
    const size_t hstep = (size_t)HALF * K * 2;
    const size_t tstep = 2 * hstep;
    const unsigned ldsw = (unsigned)wid * 1024u;
    const int aoff = lds_byte(wr * 64 + fr, fq * 8), boff = lds_byte(wc * 32 + fr, fq * 8);
#define PG8_SA(b, h) (((b) * 2 + (h)) * HTB)
#define PG8_SB(b, h) ((4 + (b) * 2 + (h)) * HTB)
#define PG8_STAGE(bufoff, gbase, voff) do { _Pragma("unroll") for (int _i = 0; _i < 2; ++_i) \
        __builtin_amdgcn_global_load_lds((const unsigned*)((const char*)(gbase) + (voff)[_i]), (PG8_LAS unsigned*)(lds + (bufoff) + ldsw + _i * 8192), 16, 0, 0); } while (0)
#define PG8_LDA(dst, b, h) do { _Pragma("unroll") for (int m = 0; m < 4; ++m) _Pragma("unroll") for (int k = 0; k < 2; ++k) dst[m][k] = *(const PG8_LAS bf16x8*)(lds + PG8_SA(b, h) + aoff + m * 2048 + k * 1024); } while (0)
#define PG8_LDB(dst, b, h) do { _Pragma("unroll") for (int n = 0; n < 2; ++n) _Pragma("unroll") for (int k = 0; k < 2; ++k) dst[n][k] = *(const PG8_LAS bf16x8*)(lds + PG8_SB(b, h) + boff + n * 2048 + k * 1024); } while (0)
#define PG8_MMA(ai, bj, At, Bt) do { __builtin_amdgcn_s_setprio(1); _Pragma("unroll") for (int m = 0; m < 4; ++m) _Pragma("unroll") for (int n = 0; n < 2; ++n) _Pragma("unroll") for (int k = 0; k < 2; ++k) \
        acc[ai][bj][m][n] = __builtin_amdgcn_mfma_f32_16x16x32_bf16(Bt[n][k], At[m][k], acc[ai][bj][m][n], 0, 0, 0); __builtin_amdgcn_s_setprio(0); } while (0)
#define PG8_WAIT_V(n) asm volatile("s_waitcnt vmcnt(" #n ")" ::: "memory")
#define PG8_WAIT_L(n) asm volatile("s_waitcnt lgkmcnt(" #n ")" ::: "memory")
#define PG8_BAR __builtin_amdgcn_s_barrier()
#define PG8_SCHED __builtin_amdgcn_sched_barrier(0)
    Unit cur, nxt; int ui = 0;
    if (!S.next(0, cur)) return;
    f32x4 acc[2][2][4][2];
#pragma unroll
    for (int a = 0; a < 2; ++a)
#pragma unroll
        for (int b = 0; b < 2; ++b)
#pragma unroll
            for (int m = 0; m < 4; ++m)
#pragma unroll
                for (int n = 0; n < 2; ++n) acc[a][b][m][n] = (f32x4){0.f, 0.f, 0.f, 0.f};
    bf16x8 At[4][2], B0[2][2], B1[2][2];
    const char* cA = (const char*)g.A + (size_t)cur.pm * tstep; const char* cB = (const char*)g.Bt + (size_t)cur.pn * tstep;
    S.a_ready(cur);
    if constexpr (SP2) {
        PG8_STAGE(PG8_SB(0, 0), cB, voffB); PG8_STAGE(PG8_SB(0, 1), cB + hstep, voffB); PG8_STAGE(PG8_SA(0, 0), cA, voffA); PG8_STAGE(PG8_SA(0, 1), cA + hstep, voffA);
        if (wr == 1) PG8_BAR;
        PG8_WAIT_V(2); PG8_BAR;
        PG8_STAGE(PG8_SB(1, 0), cB + kstep, voffB); PG8_STAGE(PG8_SA(1, 0), cA + kstep, voffA); PG8_STAGE(PG8_SB(1, 1), cB + hstep + kstep, voffB);
        PG8_WAIT_V(6); PG8_BAR;
    } else {
        PG8_STAGE(PG8_SB(0, 0), cB, voffB); PG8_STAGE(PG8_SA(0, 0), cA, voffA); PG8_STAGE(PG8_SB(0, 1), cB + hstep, voffB); PG8_STAGE(PG8_SA(0, 1), cA + hstep, voffA);
        if (wr == 1) PG8_BAR;
        PG8_WAIT_V(4); PG8_BAR;
        PG8_STAGE(PG8_SB(1, 0), cB + kstep, voffB); PG8_STAGE(PG8_SA(1, 0), cA + kstep, voffA); PG8_STAGE(PG8_SB(1, 1), cB + hstep + kstep, voffB);
        PG8_WAIT_V(6); PG8_BAR;
    }
    for (;;) {
        const bool has_next = S.next(ui + 1, nxt);
        const char* nA = has_next ? (const char*)g.A + (size_t)nxt.pm * tstep : cA; const char* nB = has_next ? (const char*)g.Bt + (size_t)nxt.pn * tstep : cB;
        for (int t = 0; t < nt; t += 2) {
            const bool last = (t == nt - 2);
            const char* a1 = cA + (size_t)(t + 1) * kstep;
            const char* a2 = last ? nA : cA + (size_t)(t + 2) * kstep; const char* b2 = last ? nB : cB + (size_t)(t + 2) * kstep;
            const char* a3 = a2 + kstep; const char* b3 = b2 + kstep;
            if (last && has_next) S.a_ready(nxt);
            if constexpr (SP2) {
            PG8_LDB(B0, 0, 0); PG8_LDB(B1, 0, 1); PG8_SCHED; PG8_LDA(At, 0, 0); PG8_STAGE(PG8_SA(1, 1), a1 + hstep, voffA);
            PG8_WAIT_V(8); PG8_WAIT_L(0); PG8_BAR; PG8_MMA(0, 0, At, B0); PG8_MMA(0, 1, At, B1); PG8_BAR; PG8_SCHED;
            PG8_LDA(At, 0, 1); PG8_STAGE(PG8_SB(0, 0), b2, voffB); PG8_STAGE(PG8_SB(0, 1), b2 + hstep, voffB); PG8_STAGE(PG8_SA(0, 0), a2, voffA);
            PG8_WAIT_V(8); PG8_WAIT_L(0); PG8_BAR; PG8_MMA(1, 0, At, B0); PG8_MMA(1, 1, At, B1); PG8_BAR; PG8_SCHED;
            PG8_LDB(B0, 1, 0); PG8_LDB(B1, 1, 1); PG8_SCHED; PG8_LDA(At, 1, 0); PG8_STAGE(PG8_SA(0, 1), a2 + hstep, voffA);
            PG8_WAIT_V(8); PG8_WAIT_L(0); PG8_BAR; PG8_MMA(0, 0, At, B0); PG8_MMA(0, 1, At, B1); PG8_BAR; PG8_SCHED;
            PG8_LDA(At, 1, 1); PG8_STAGE(PG8_SB(1, 0), b3, voffB); PG8_STAGE(PG8_SB(1, 1), b3 + hstep, voffB); PG8_STAGE(PG8_SA(1, 0), a3, voffA);
            PG8_WAIT_V(8); PG8_WAIT_L(0); PG8_BAR; PG8_MMA(1, 0, At, B0); PG8_MMA(1, 1, At, B1); PG8_BAR; PG8_SCHED;
            } else {
            PG8_LDB(B0, 0, 0); PG8_SCHED; PG8_LDA(At, 0, 0); PG8_STAGE(PG8_SA(1, 1), a1 + hstep, voffA);
            PG8_WAIT_L(8); PG8_BAR; PG8_WAIT_L(0); PG8_MMA(0, 0, At, B0); PG8_BAR; PG8_SCHED;
            PG8_LDB(B1, 0, 1); PG8_STAGE(PG8_SB(0, 0), b2, voffB);
            PG8_BAR; PG8_WAIT_L(0); PG8_MMA(0, 1, At, B1); PG8_BAR;
            PG8_LDA(At, 0, 1); PG8_STAGE(PG8_SA(0, 0), a2, voffA);
            PG8_BAR; PG8_WAIT_L(0); PG8_MMA(1, 0, At, B0); PG8_BAR; PG8_SCHED;
            PG8_STAGE(PG8_SB(0, 1), b2 + hstep, voffB);
            PG8_WAIT_V(6); PG8_BAR; PG8_MMA(1, 1, At, B1); PG8_BAR;
            PG8_LDB(B0, 1, 0); PG8_SCHED; PG8_LDA(At, 1, 0); PG8_STAGE(PG8_SA(0, 1), a2 + hstep, voffA);
            PG8_WAIT_L(8); PG8_BAR; PG8_WAIT_L(0); PG8_MMA(0, 0, At, B0); PG8_BAR; PG8_SCHED;
            PG8_LDB(B1, 1, 1); PG8_STAGE(PG8_SB(1, 0), b3, voffB);
            PG8_BAR; PG8_WAIT_L(0); PG8_MMA(0, 1, At, B1); PG8_BAR;
            PG8_LDA(At, 1, 1); PG8_STAGE(PG8_SA(1, 0), a3, voffA);
            PG8_BAR; PG8_WAIT_L(0); PG8_MMA(1, 0, At, B0); PG8_BAR; PG8_SCHED;
            PG8_STAGE(PG8_SB(1, 1), b3 + hstep, voffB);
            PG8_WAIT_V(6); PG8_BAR; PG8_MMA(1, 1, At, B1); PG8_BAR;
            }
        }
        if constexpr (ALIGN_EPI) { if (wr == 0) PG8_BAR; }
        if constexpr (!Epi::AFTER_DRAIN) { E(acc, cur, wr, wc, fr, fq); S.done(cur); }
        if (!has_next) break;
#pragma unroll
        for (int a = 0; a < 2; ++a)
#pragma unroll
            for (int b = 0; b < 2; ++b)
#pragma unroll
                for (int m = 0; m < 4; ++m)
#pragma unroll
                    for (int n = 0; n < 2; ++n) acc[a][b][m][n] = (f32x4){0.f, 0.f, 0.f, 0.f};
        cur = nxt; cA = nA; cB = nB; ++ui;
        if constexpr (ALIGN_EPI) { if (wr == 1) PG8_BAR; }
    }
    PG8_WAIT_V(0);
    if constexpr (!ALIGN_EPI) { if (wr == 0) PG8_BAR; }
    PG8_BAR;
    if constexpr (Epi::AFTER_DRAIN) { E.fused(acc, cur, wr, wc, fr, fq, lds, wid, lane); S.done(cur); }
#undef PG8_SA
#undef PG8_SB
#undef PG8_STAGE
#undef PG8_LDA
#undef PG8_LDB
#undef PG8_MMA
#undef PG8_WAIT_V
#undef PG8_WAIT_L
#undef PG8_BAR
#undef PG8_SCHED
}
}

namespace att {
using bf16 = __hip_bfloat16;
constexpr int   D = 128, NW = 8, QBLK = 32, KVBLK = 64;
constexpr float SCALE = 0.088388347648318440f;
constexpr float THR = 8.f;
constexpr int SDEPTH = 2;
constexpr int LDQ = 3072, LDK = 3072, LDO = 2048;
constexpr size_t SHM_V = KVBLK * D * 2, SHM_K = KVBLK * D * 2, SHM_ATTN = 2 * SHM_V + 2 * SHM_K + NW * 64 * 4;
using bf16x8 = __attribute__((ext_vector_type(8))) short;
using s16x4  = __attribute__((ext_vector_type(4))) short;
using f32x16 = __attribute__((ext_vector_type(16))) float;
using f32x8  = __attribute__((ext_vector_type(8))) float;
using u32x4  = __attribute__((ext_vector_type(4))) unsigned;
#define KSWZ(row, colB) ((row) * 256 + ((colB) ^ (((row) & 7) << 4)))
#define SBAR() __builtin_amdgcn_sched_barrier(0)
__device__ __forceinline__ int crow(int r, int hi) { return (r & 3) + 8 * (r >> 2) + 4 * hi; }
__device__ __forceinline__ unsigned cvtpk(float lo, float hi) {
  unsigned r; asm volatile("v_cvt_pk_bf16_f32 %0, %1, %2" : "=v"(r) : "v"(lo), "v"(hi)); return r;
}
template <typename TIn> struct Stage;
template <> struct Stage<bf16>  { using T = bf16x8;
  __device__ static __forceinline__ T ld8(const bf16* p) { return *reinterpret_cast<const bf16x8*>(p); }
  __device__ static __forceinline__ bf16x8 tobf(T x) { return x; } };
template <> struct Stage<float> { using T = f32x8;
  __device__ static __forceinline__ T ld8(const float* p) { return *reinterpret_cast<const f32x8*>(p); }
  __device__ static __forceinline__ bf16x8 tobf(T x) {
    u32x4 w = {cvtpk(x[0], x[1]), cvtpk(x[2], x[3]), cvtpk(x[4], x[5]), cvtpk(x[6], x[7])}; return *reinterpret_cast<bf16x8*>(&w); } };

__device__ __forceinline__ void partialSM(f32x16& p0, f32x16& p1, float& m_reg, float& mn, float& alpha) {
  constexpr float C = SCALE * 1.4426950408889634f;
  float pmax = p0[0]; for (int r = 1; r < 16; ++r) pmax = fmaxf(pmax, p0[r]); for (int r = 0; r < 16; ++r) pmax = fmaxf(pmax, p1[r]);
  { auto rr = __builtin_amdgcn_permlane32_swap(__float_as_uint(pmax), __float_as_uint(pmax), false, false);
    pmax = fmaxf(__uint_as_float(rr[0]), __uint_as_float(rr[1])); }
  if (__builtin_expect(__all(pmax - m_reg <= THR / SCALE), 1)) { mn = m_reg; alpha = 1.f; }
  else { mn = fmaxf(m_reg, pmax); alpha = __builtin_amdgcn_exp2f((m_reg - mn) * C); m_reg = mn; }
  float mnC = -mn * C;
  for (int r = 0; r < 16; ++r) p0[r] = fmaf(p0[r], C, mnC); for (int r = 0; r < 16; ++r) p1[r] = fmaf(p1[r], C, mnC);
  for (int r = 0; r < 16; ++r) p0[r] = __builtin_amdgcn_exp2f(p0[r]);
}
__device__ __forceinline__ void finishSM(f32x16& p0, f32x16& p1, float alpha, float& l_reg, bf16x8& pa0, bf16x8& pa1, bf16x8& pa2, bf16x8& pa3) {
  for (int r = 0; r < 16; ++r) p1[r] = __builtin_amdgcn_exp2f(p1[r]);
  float ps = 0; for (int r = 0; r < 16; ++r) ps += p0[r]; for (int r = 0; r < 16; ++r) ps += p1[r];
  { auto rr = __builtin_amdgcn_permlane32_swap(__float_as_uint(ps), __float_as_uint(ps), false, false);
    ps = __uint_as_float(rr[0]) + __uint_as_float(rr[1]); }
  l_reg = l_reg * alpha + ps;
#define PK4(P, BASE, OUT) do { unsigned a0 = cvtpk(P[BASE + 0], P[BASE + 1]), a1 = cvtpk(P[BASE + 2], P[BASE + 3]);   \
    unsigned b0 = cvtpk(P[BASE + 4], P[BASE + 5]), b1 = cvtpk(P[BASE + 6], P[BASE + 7]);                              \
    auto r0 = __builtin_amdgcn_permlane32_swap(a0, b0, false, false); auto r1 = __builtin_amdgcn_permlane32_swap(a1, b1, false, false); \
    u32x4 w = {r0[0], r1[0], r0[1], r1[1]}; OUT = *reinterpret_cast<bf16x8*>(&w); } while (0)
  PK4(p0, 0, pa0); PK4(p0, 8, pa1); PK4(p1, 0, pa2); PK4(p1, 8, pa3);
#undef PK4
}
__device__ __forceinline__ void qkt(f32x16& p0, f32x16& p1, const bf16* Ks, const bf16x8* qr, int r32, int hi) {
  p0 = f32x16{}; p1 = f32x16{};
  for (int d0 = 0; d0 < 8; ++d0) { int cb = (d0 * 16 + hi * 8) * 2;
    bf16x8 b0 = *reinterpret_cast<const bf16x8*>((const char*)Ks + KSWZ(r32, cb));
    bf16x8 b1 = *reinterpret_cast<const bf16x8*>((const char*)Ks + KSWZ(32 + r32, cb));
    p0 = __builtin_amdgcn_mfma_f32_32x32x16_bf16(b0, qr[d0], p0, 0, 0, 0);
    p1 = __builtin_amdgcn_mfma_f32_32x32x16_bf16(b1, qr[d0], p1, 0, 0, 0); }
}
__device__ __forceinline__ int v_st(int k, int c) { const int kk = (k & ~0xC) | ((k & 4) << 1) | ((k & 8) >> 1); return ((kk >> 3) * 4 + (c >> 5)) * 512 + ((kk & 7) * 32 + (c & 31)) * 2; }
__device__ __forceinline__ int v_rd_base(int lane) { return ((lane & 3) << 3) | (((lane >> 2) & 3) << 6) | (((lane >> 4) & 1) << 5) | (((lane >> 5) & 1) << 8); }
constexpr int v_rd_off(int d0, int ks, int half) { return d0 * 512 + ks * 4096 + half * 2048; }
template <int OFF> __device__ __forceinline__ s16x4 tr_read(int vb) {
  s16x4 r; asm volatile("ds_read_b64_tr_b16 %0, %1 offset:%2" : "=&v"(r) : "v"(vb), "i"(OFF) : "memory"); return r;
}
template <int D0> __device__ __forceinline__ void pv_one(f32x16& od, int vb, bf16x8 pa0, bf16x8 pa1, bf16x8 pa2, bf16x8 pa3) {
  const s16x4 l0 = tr_read<v_rd_off(D0, 0, 0)>(vb), h0 = tr_read<v_rd_off(D0, 0, 1)>(vb), l1 = tr_read<v_rd_off(D0, 1, 0)>(vb), h1 = tr_read<v_rd_off(D0, 1, 1)>(vb);
  const s16x4 l2 = tr_read<v_rd_off(D0, 2, 0)>(vb), h2 = tr_read<v_rd_off(D0, 2, 1)>(vb), l3 = tr_read<v_rd_off(D0, 3, 0)>(vb), h3 = tr_read<v_rd_off(D0, 3, 1)>(vb);
  asm volatile("s_waitcnt lgkmcnt(0)" ::: "memory"); SBAR();
#define PK(L, H) (bf16x8){L[0], L[1], L[2], L[3], H[0], H[1], H[2], H[3]}
  od = __builtin_amdgcn_mfma_f32_32x32x16_bf16(pa0, PK(l0, h0), od, 0, 0, 0);
  od = __builtin_amdgcn_mfma_f32_32x32x16_bf16(pa1, PK(l1, h1), od, 0, 0, 0);
  od = __builtin_amdgcn_mfma_f32_32x32x16_bf16(pa2, PK(l2, h2), od, 0, 0, 0);
  od = __builtin_amdgcn_mfma_f32_32x32x16_bf16(pa3, PK(l3, h3), od, 0, 0, 0);
#undef PK
}
__device__ __forceinline__ void pv_d0(f32x16* o, int vb, bf16x8 pa0, bf16x8 pa1, bf16x8 pa2, bf16x8 pa3) {
  pv_one<0>(o[0], vb, pa0, pa1, pa2, pa3); pv_one<1>(o[1], vb, pa0, pa1, pa2, pa3); pv_one<2>(o[2], vb, pa0, pa1, pa2, pa3); pv_one<3>(o[3], vb, pa0, pa1, pa2, pa3);
}

template <typename TQ>
__device__ __forceinline__ void attn_dense_body(const TQ* __restrict__ Qb, const bf16* __restrict__ Kh, const bf16* __restrict__ Vh,
                                                unsigned short* __restrict__ Ob, int seq, char* lds) {
  using St = Stage<bf16>; using SQ = Stage<TQ>;
  const int tid = mk_tid(), wid = tid >> 6, lane = tid & 63, r32 = lane & 31, hi = lane >> 5;
  bf16* V_lds = (bf16*)lds; bf16* K_lds = (bf16*)(lds + 2 * SHM_V);
  float* ws = (float*)(lds + 2 * SHM_V + 2 * SHM_K) + wid * 64; float* li_l = ws; float* al_l = ws + 32;
  float m_reg = -1e30f, l_reg = 0; f32x16 o[4] = {}; bf16x8 qr[8];
  const TQ* Qw = Qb + (long)(wid * QBLK + r32) * LDQ + hi * 8;
#pragma unroll
  for (int d0 = 0; d0 < 8; ++d0) qr[d0] = SQ::tobf(SQ::ld8(Qw + d0 * 16));
  const int sr = tid >> 4, sc = (tid & 15) * 8, vst0 = v_st(sr, sc), vst1 = v_st(32 + sr, sc);
  const int vb0 = (int)(uintptr_t)V_lds + v_rd_base(lane);
  struct { typename St::T vs0, vs1, ks0, ks1; } sr_[SDEPTH];
#define SLOAD(i, k0) do { sr_[i].vs0 = St::ld8(&Vh[(long)((k0) + sr) * LDK + sc]); sr_[i].vs1 = St::ld8(&Vh[(long)((k0) + 32 + sr) * LDK + sc]); \
    sr_[i].ks0 = St::ld8(&Kh[(long)((k0) + sr) * LDK + sc]); sr_[i].ks1 = St::ld8(&Kh[(long)((k0) + 32 + sr) * LDK + sc]); } while (0)
#define SWRITE(b, i) do { *(bf16x8*)((char*)V_lds + (b) * SHM_V + vst0) = St::tobf(sr_[i].vs0);          \
    *(bf16x8*)((char*)V_lds + (b) * SHM_V + vst1) = St::tobf(sr_[i].vs1); int kc = sc * 2;               \
    *(bf16x8*)((char*)K_lds + (b) * SHM_K + KSWZ(sr, kc)) = St::tobf(sr_[i].ks0);                       \
    *(bf16x8*)((char*)K_lds + (b) * SHM_K + KSWZ(32 + sr, kc)) = St::tobf(sr_[i].ks1); } while (0)
#define SWAIT() do { if constexpr (SDEPTH == 2) asm volatile("s_waitcnt vmcnt(4)" ::: "memory"); else asm volatile("s_waitcnt vmcnt(0)" ::: "memory"); } while (0)
#define RESC(a) do { if (__any((a) < 1.f)) { if (hi == 0) al_l[r32] = (a); asm volatile("s_waitcnt lgkmcnt(0)" ::: "memory"); \
    for (int d = 0; d < 4; ++d) for (int r = 0; r < 16; ++r) o[d][r] *= al_l[crow(r, hi)]; } } while (0)
  f32x16 pA0, pA1, pB0, pB1; float mnA, mnB, alA, alB; bf16x8 pa0, pa1, pa2, pa3; const int NT = seq / KVBLK;
  constexpr int SE = 0, SO = SDEPTH - 1;
  SLOAD(SE, 0); asm volatile("s_waitcnt vmcnt(0)" ::: "memory"); SWRITE(0, SE); __syncthreads();
  qkt(pA0, pA1, K_lds, qr, r32, hi); partialSM(pA0, pA1, m_reg, mnA, alA);
  SLOAD(SO, KVBLK); if constexpr (SDEPTH == 2) { if (2 < NT) SLOAD(SE, 2 * KVBLK); }
  SWAIT(); SWRITE(1, SO); __syncthreads();
  for (int j = 1; j + 1 < NT; j += 2) {
    SBAR(); qkt(pB0, pB1, (bf16*)((char*)K_lds + SHM_K), qr, r32, hi);
    finishSM(pA0, pA1, alA, l_reg, pa0, pa1, pa2, pa3); SBAR();
    SLOAD(SO, (j + SDEPTH) * KVBLK); SBAR();
    pv_d0(o, vb0, pa0, pa1, pa2, pa3); partialSM(pB0, pB1, m_reg, mnB, alB);
    __syncthreads(); SWAIT(); SWRITE(0, SE);
    RESC(alB); __syncthreads();
    SBAR(); qkt(pA0, pA1, K_lds, qr, r32, hi);
    finishSM(pB0, pB1, alB, l_reg, pa0, pa1, pa2, pa3); SBAR();
    if (SDEPTH == 1 || j + 3 < NT) SLOAD(SE, (j + 1 + SDEPTH) * KVBLK); SBAR();
    pv_d0(o, vb0 + (int)SHM_V, pa0, pa1, pa2, pa3); partialSM(pA0, pA1, m_reg, mnA, alA);
    __syncthreads(); SWAIT(); SWRITE(1, SO);
    RESC(alA); __syncthreads();
  }
  SBAR(); qkt(pB0, pB1, (bf16*)((char*)K_lds + SHM_K), qr, r32, hi);
  finishSM(pA0, pA1, alA, l_reg, pa0, pa1, pa2, pa3); SBAR();
  pv_d0(o, vb0, pa0, pa1, pa2, pa3); partialSM(pB0, pB1, m_reg, mnB, alB);
  __syncthreads(); RESC(alB);
  finishSM(pB0, pB1, alB, l_reg, pa0, pa1, pa2, pa3); SBAR();
  pv_d0(o, vb0 + (int)SHM_V, pa0, pa1, pa2, pa3);
  if (hi == 0) li_l[r32] = l_reg; asm volatile("s_waitcnt lgkmcnt(0)" ::: "memory");
  float rli[16];
#pragma unroll
  for (int r = 0; r < 16; ++r) rli[r] = __builtin_amdgcn_rcpf(li_l[crow(r, hi)]);
  unsigned short* Ow = Ob + (long)(wid * QBLK) * LDO;
#pragma unroll
  for (int r = 0; r < 16; ++r) { int orow = crow(r, hi);
    for (int d0 = 0; d0 < 4; ++d0) Ow[(long)orow * LDO + d0 * 32 + r32] = (unsigned short)(cvtpk(o[d0][r] * rli[r], 0.f) & 0xffffu); }
#undef SLOAD
#undef SWRITE
#undef SWAIT
#undef RESC
}

}
__device__ __forceinline__ int mk_tid() { int t = threadIdx.x; asm volatile("" : "+v"(t)); return t; }
namespace mk {
#define LAS __attribute__((address_space(3)))
typedef unsigned short bf16;
typedef short bf16x8 __attribute__((ext_vector_type(8)));
typedef float f32x4 __attribute__((ext_vector_type(4)));
typedef unsigned u32x4 __attribute__((ext_vector_type(4)));
typedef unsigned u32x2 __attribute__((ext_vector_type(2)));

constexpr int D = 2048, M = 8192, SEQ = 4096, NW = 8;
constexpr int ABW = 3072, CW = 8224, FF2 = 11264, FF = 5632;
constexpr float EPS = 1e-6f;
constexpr size_t MiB = 1u << 20;
constexpr size_t WS_AB = 0, WS_BD = 12 * MiB, WS_OAB = 13 * MiB, WS_C = 21 * MiB  , WS_OC = 54 * MiB;
constexpr size_t WS_UP0 = 62 * MiB, WS_UP1 = 106 * MiB, WS_DN0 = 150 * MiB, WS_DN1 = 172 * MiB;
constexpr size_t WS_XN = 194 * MiB, WS_GATES = 226 * MiB, WS_S = 228 * MiB;
constexpr size_t WS_PROJ = WS_S, WS_POOLED = WS_S + 48 * MiB, WS_CAT = WS_S + 56 * MiB;
constexpr size_t WS_QK = WS_S, WS_OG = WS_S + 64 * MiB, WS_KVT = WS_S + 96 * MiB, WS_HF = WS_S + 160 * MiB, WS_Y = WS_S + 288 * MiB;
constexpr size_t WS_U = WS_S, WS_ACT = WS_S + 176 * MiB;
constexpr size_t WS_END = WS_S + 320 * MiB;
constexpr int LDS_BYTES = 154112;

#define LDSWAIT() asm volatile("s_waitcnt lgkmcnt(0)" ::: "memory")
__device__ __forceinline__ unsigned f2bf(float f) { unsigned u = __float_as_uint(f); return (u + 0x7fffu + ((u >> 16) & 1u)) >> 16; }
__device__ __forceinline__ unsigned pk2(float lo, float hi) { unsigned r; asm volatile("v_cvt_pk_bf16_f32 %0, %1, %2" : "=v"(r) : "v"(lo), "v"(hi)); return r; }
__device__ __forceinline__ float bflo(unsigned w) { return __uint_as_float(w << 16); }
__device__ __forceinline__ float bfhi(unsigned w) { return __uint_as_float(w & 0xffff0000u); }
__device__ __forceinline__ float wave_sum(float v) {
#pragma unroll
    for (int o = 1; o < 64; o <<= 1) v += __shfl_xor(v, o);
    return v;
}

__device__ __forceinline__ void transpose_item64(const float* __restrict__ W, int ldw, int K, int nblk, bf16* __restrict__ WT, LAS float* scr, int item, int lane) {
    const int kb = item / nblk, nb = item - kb * nblk, k0 = 64 * kb, n0 = 64 * nb;
    f32x4 v[16];
#pragma unroll
    for (int i = 0; i < 16; ++i) { const int kk = 4 * i + (lane >> 4); v[i] = *(const f32x4*)(W + (size_t)(k0 + kk) * ldw + n0 + 4 * (lane & 15)); }
#pragma unroll
    for (int i = 0; i < 16; ++i) { const int kk = 4 * i + (lane >> 4); LAS float* s = scr + kk * 65 + 4 * (lane & 15); s[0] = v[i].x; s[1] = v[i].y; s[2] = v[i].z; s[3] = v[i].w; }
    LDSWAIT();
    const int c = lane & 7, q = lane >> 3;
#pragma unroll
    for (int j = 0; j < 8; ++j) { const int n = q + 8 * j; const LAS float* s = scr + (8 * c) * 65 + n;
        u32x4 o; o.x = pk2(s[0], s[65]); o.y = pk2(s[130], s[195]); o.z = pk2(s[260], s[325]); o.w = pk2(s[390], s[455]);
        *(u32x4*)(WT + (size_t)(n0 + n) * K + k0 + 8 * c) = o; }
    LDSWAIT();
}

__device__ __forceinline__ void rmsnorm_rows(const float* __restrict__ src, const float* __restrict__ gain, bf16* __restrict__ dst, int gw, int ngw, int lane) {
    f32x4 g[8];
#pragma unroll
    for (int j = 0; j < 8; ++j) g[j] = *(const f32x4*)(gain + 4 * lane + 256 * j);
    for (int m = gw; m < M; m += ngw) {
        const f32x4* xr = (const f32x4*)(src + (size_t)m * D) + lane; f32x4 v[8]; float s = 0.f;
#pragma unroll
        for (int j = 0; j < 8; ++j) { v[j] = xr[64 * j]; s += (v[j].x * v[j].x + v[j].y * v[j].y) + (v[j].z * v[j].z + v[j].w * v[j].w); }
        const float rstd = 1.0f / sqrtf(wave_sum(s) * (1.0f / D) + EPS);
        u32x2* o = (u32x2*)(dst + (size_t)m * D) + lane;
#pragma unroll
        for (int j = 0; j < 8; ++j) { u32x2 w; w.x = pk2(v[j].x * rstd * g[j].x, v[j].y * rstd * g[j].y); w.y = pk2(v[j].z * rstd * g[j].z, v[j].w * rstd * g[j].w); o[64 * j] = w; }
    }
}

struct In { const float *x, *norm_mix, *norm_ffn, *w_in_ab, *pool_w, *pool_scale, *q_norm, *k_norm, *w_out_ab, *w_in_c, *b_gate, *h_norm, *w_out_c, *w_up, *conv_w, *conv_b, *w_down; };

__device__ __forceinline__ void prologue(const In& I, unsigned char* ws, LAS unsigned char* lds, int gw, int ngw, int wave, int lane) {
    LAS float* scr = (LAS float*)(lds + wave * 16640);
    for (int it = gw; it < 24576; it += ngw) {
        const float* W; int ldw, K, nblk; bf16* WT; int r = it;
        if (r < 1536) { W = I.w_in_ab; ldw = ABW; K = D; nblk = 48; WT = (bf16*)(ws + WS_AB); }
        else if (r < 2560) { r -= 1536; W = I.w_out_ab; ldw = D; K = D; nblk = 32; WT = (bf16*)(ws + WS_OAB); }
        else if (r < 6656) { r -= 2560; W = I.w_in_c; ldw = CW; K = D; nblk = 128; WT = (bf16*)(ws + WS_C); }
        else if (r < 7680) { r -= 6656; W = I.w_out_c; ldw = D; K = D; nblk = 32; WT = (bf16*)(ws + WS_OC); }
        else if (r < 13312) { r -= 7680; W = I.w_up; ldw = FF2; K = D; nblk = 176; WT = (bf16*)(ws + WS_UP0); }
        else if (r < 18944) { r -= 13312; W = I.w_up + (size_t)D * FF2; ldw = FF2; K = D; nblk = 176; WT = (bf16*)(ws + WS_UP1); }
        else if (r < 21760) { r -= 18944; W = I.w_down; ldw = D; K = FF; nblk = 32; WT = (bf16*)(ws + WS_DN0); }
        else { r -= 21760; W = I.w_down + (size_t)FF * D; ldw = D; K = FF; nblk = 32; WT = (bf16*)(ws + WS_DN1); }
        transpose_item64(W, ldw, K, nblk, WT, scr, r, lane);
    }
    const int gt = gw * 64 + lane, ngt = ngw * 64;
    { bf16* WG = (bf16*)(ws + WS_C) + (size_t)8192 * D;
      for (int idx = gt; idx < 32 * D; idx += ngt) { const int j = idx >> 11, k = idx & 2047; WG[idx] = (bf16)f2bf(I.w_in_c[(size_t)k * CW + 8192 + j]); } }
    { bf16* BD = (bf16*)(ws + WS_BD);
      for (int idx = gt; idx < 512 * 512; idx += ngt) { const int n = idx >> 9, k = idx & 511, gn = n >> 7, gk = k >> 7;
          const float v = (gn == gk) ? I.pool_w[(size_t)(gn * 128 + (k & 127)) * 128 + (n & 127)] * I.pool_scale[n] : 0.f; BD[idx] = (bf16)f2bf(v); } }
    rmsnorm_rows(I.x, I.norm_mix, (bf16*)(ws + WS_XN), gw, ngw, lane);
}

__device__ __forceinline__ void qk_rope_pool(bf16* __restrict__ PROJ, const float* __restrict__ qn, const float* __restrict__ kn, bf16* __restrict__ POOLED, int gw, int ngw, int lane) {
    const int l = lane & 31, hsel = lane >> 5, part = (l >> 4) & 1; const bool first = (l & 8) == 0;
    float inv[4];
#pragma unroll
    for (int e = 0; e < 4; ++e) inv[e] = exp2f(-(float)(4 * (l & 7) + e) * (13.287712379549449f / 32.0f));
    const f32x4 gq = *(const f32x4*)(qn + 4 * l), gk = *(const f32x4*)(kn + 4 * l);
    for (int it = gw; it < M * 8; it += ngw) {
        const int t = it >> 3, hh = (it & 7) * 2 + hsel;
        bf16* p = PROJ + (size_t)t * ABW + 512 + hh * 128 + 4 * l;
        const u32x2 w = *(const u32x2*)p;
        float x[4] = {bflo(w.x), bfhi(w.x), bflo(w.y), bfhi(w.y)};
        float ss = (x[0] * x[0] + x[1] * x[1]) + (x[2] * x[2] + x[3] * x[3]);
#pragma unroll
        for (int o = 1; o < 32; o <<= 1) ss += __shfl_xor(ss, o);
        const float rstd = 1.0f / sqrtf(ss * (1.0f / 128.0f) + EPS);
        const f32x4 g = (hh < 12) ? gq : gk;
        const int pos = t & (SEQ - 1); const float pp = part ? (float)(pos & 63) : (float)(pos >> 6);
        float y[4] = {x[0] * rstd * g.x, x[1] * rstd * g.y, x[2] * rstd * g.z, x[3] * rstd * g.w}, o4[4];
#pragma unroll
        for (int e = 0; e < 4; ++e) { const float yp = __shfl_xor(y[e], 8); const float ang = pp * inv[e]; const float sn = __sinf(ang), cs = __cosf(ang);
            o4[e] = y[e] * cs + (first ? -yp : yp) * sn; }
        u32x2 ow; ow.x = pk2(o4[0], o4[1]); ow.y = pk2(o4[2], o4[3]); *(u32x2*)p = ow;
    }
    const int gt = gw * 64 + lane, ngt = ngw * 64;
    for (int it = gt; it < M * 64; it += ngt) {
        const int t = it >> 6, c8 = (it & 63) * 8, g = c8 >> 7, w2 = 1 << g, pos = t & (SEQ - 1), base = t - pos;
        const int lo = max(pos - w2, 0), hi = min(pos + w2, SEQ);
        float acc[8] = {0.f, 0.f, 0.f, 0.f, 0.f, 0.f, 0.f, 0.f};
        for (int pz = lo; pz < hi; ++pz) { const u32x4 v = *(const u32x4*)(PROJ + (size_t)(base + pz) * ABW + c8);
            acc[0] += bflo(v.x); acc[1] += bfhi(v.x); acc[2] += bflo(v.y); acc[3] += bfhi(v.y); acc[4] += bflo(v.z); acc[5] += bfhi(v.z); acc[6] += bflo(v.w); acc[7] += bfhi(v.w); }
        const u32x4 sv = *(const u32x4*)(PROJ + (size_t)t * ABW + c8); const float iv = 1.0f / (float)(hi - lo);
        u32x4 o; o.x = pk2(acc[0] * iv - bflo(sv.x), acc[1] * iv - bfhi(sv.x)); o.y = pk2(acc[2] * iv - bflo(sv.y), acc[3] * iv - bfhi(sv.y));
        o.z = pk2(acc[4] * iv - bflo(sv.z), acc[5] * iv - bfhi(sv.z)); o.w = pk2(acc[6] * iv - bflo(sv.w), acc[7] * iv - bfhi(sv.w));
        *(u32x4*)(POOLED + (size_t)t * 512 + c8) = o;
    }
}

__device__ __forceinline__ void conv_act(const bf16* __restrict__ U, const float* __restrict__ cw, const float* __restrict__ cb, bf16* __restrict__ ACT, int gt, int ngt) {
    for (int it = gt; it < 1024 * 704; it += ngt) {
        const int jc = it % 704, tb = it / 704, j = jc * 8, t0 = tb * 8;
        float c0g[8], c1g[8], c2g[8], cbg[8], c0v[8], c1v[8], c2v[8], cbv[8];
#pragma unroll
        for (int e = 0; e < 8; e += 4) {
            const f32x4 a0 = *(const f32x4*)(cw + j + e), a1 = *(const f32x4*)(cw + FF2 + j + e), a2 = *(const f32x4*)(cw + 2 * FF2 + j + e), ab = *(const f32x4*)(cb + j + e);
            const f32x4 b0 = *(const f32x4*)(cw + FF + j + e), b1 = *(const f32x4*)(cw + FF2 + FF + j + e), b2 = *(const f32x4*)(cw + 2 * FF2 + FF + j + e), bb = *(const f32x4*)(cb + FF + j + e);
#pragma unroll
            for (int q = 0; q < 4; ++q) { c0g[e + q] = a0[q]; c1g[e + q] = a1[q]; c2g[e + q] = a2[q]; cbg[e + q] = ab[q]; c0v[e + q] = b0[q]; c1v[e + q] = b1[q]; c2v[e + q] = b2[q]; cbv[e + q] = bb[q]; }
        }
        for (int tt = 0; tt < 8; ++tt) {
            const int t = t0 + tt, pos = t & (SEQ - 1);
            const bf16* r1 = U + (size_t)t * FF2 + j;
            const u32x4 z = {0u, 0u, 0u, 0u};
            const u32x4 g1 = *(const u32x4*)r1, v1 = *(const u32x4*)(r1 + FF);
            const u32x4 g0 = pos > 0 ? *(const u32x4*)(r1 - FF2) : z, v0 = pos > 0 ? *(const u32x4*)(r1 - FF2 + FF) : z;
            const u32x4 g2 = pos < SEQ - 1 ? *(const u32x4*)(r1 + FF2) : z, v2 = pos < SEQ - 1 ? *(const u32x4*)(r1 + FF2 + FF) : z;
            float o[8];
#pragma unroll
            for (int q = 0; q < 4; ++q) {
                const float ga = c0g[2 * q] * bflo(g0[q]) + c1g[2 * q] * bflo(g1[q]) + c2g[2 * q] * bflo(g2[q]) + cbg[2 * q];
                const float gb = c0g[2 * q + 1] * bfhi(g0[q]) + c1g[2 * q + 1] * bfhi(g1[q]) + c2g[2 * q + 1] * bfhi(g2[q]) + cbg[2 * q + 1];
                const float va = c0v[2 * q] * bflo(v0[q]) + c1v[2 * q] * bflo(v1[q]) + c2v[2 * q] * bflo(v2[q]) + cbv[2 * q];
                const float vb = c0v[2 * q + 1] * bfhi(v0[q]) + c1v[2 * q + 1] * bfhi(v1[q]) + c2v[2 * q + 1] * bfhi(v2[q]) + cbv[2 * q + 1];
                o[2 * q] = ga / (1.0f + __expf(-ga)) * va; o[2 * q + 1] = gb / (1.0f + __expf(-gb)) * vb;
            }
            u32x4 ow; ow.x = pk2(o[0], o[1]); ow.y = pk2(o[2], o[3]); ow.z = pk2(o[4], o[5]); ow.w = pk2(o[6], o[7]);
            *(u32x4*)(ACT + (size_t)t * FF + j) = ow;
        }
    }
}

__device__ __forceinline__ void gates_phase(const bf16* __restrict__ XN, const bf16* __restrict__ WG, const float* __restrict__ bg, float* __restrict__ GATES, LAS float* red, int bid, int nblk) {
    const int tid = mk_tid(), wid = tid >> 6, lane = tid & 63, fr = lane & 15, fq = lane >> 4;
    const int tile = wid & 3, tt = tile & 1, jt = tile >> 1, kh = wid >> 2;
    for (int grp = bid; grp < 256; grp += nblk) {
        f32x4 acc = {0.f, 0.f, 0.f, 0.f};
        const bf16* ap = WG + (size_t)(jt * 16 + fr) * D + kh * 1024 + fq * 8;
        const bf16* bp = XN + (size_t)(grp * 32 + tt * 16 + fr) * D + kh * 1024 + fq * 8;
#pragma unroll 8
        for (int ks = 0; ks < 32; ++ks) { const bf16x8 a = *(const bf16x8*)(ap + ks * 32), b = *(const bf16x8*)(bp + ks * 32); acc = __builtin_amdgcn_mfma_f32_16x16x32_bf16(a, b, acc, 0, 0, 0); }
        if (kh == 1) { LAS float* r = red + (tile * 64 + lane) * 4; r[0] = acc[0]; r[1] = acc[1]; r[2] = acc[2]; r[3] = acc[3]; }
        __syncthreads();
        if (kh == 0) { const LAS float* r = red + (tile * 64 + lane) * 4; const int t = grp * 32 + tt * 16 + fr, j = jt * 16 + 4 * fq;
            const f32x4 b4 = *(const f32x4*)(bg + j); f32x4 o; o.x = acc[0] + r[0] + b4.x; o.y = acc[1] + r[1] + b4.y; o.z = acc[2] + r[2] + b4.z; o.w = acc[3] + r[3] + b4.w;
            *(f32x4*)(GATES + (size_t)t * 32 + j) = o; }
        __syncthreads();
    }
}

__device__ __forceinline__ void headnorm_phase(const float* __restrict__ HF, const bf16* __restrict__ OG, const float* __restrict__ hn, bf16* __restrict__ Y, int gw, int ngw, int lane) {
    for (int it = gw; it < M * 8; it += ngw) {
        const int t = it >> 3, h = it & 7; const size_t off = (size_t)t * D + h * 256 + 4 * lane;
        const f32x4 a = *(const f32x4*)(HF + off), b = *(const f32x4*)(HF + (size_t)M * D + off); const f32x4 s = a + b;
        const float ss = wave_sum((s.x * s.x + s.y * s.y) + (s.z * s.z + s.w * s.w));
        const float rstd = 1.0f / sqrtf(ss * (1.0f / 256.0f) + EPS);
        const f32x4 g = *(const f32x4*)(hn + h * 256 + 4 * lane); const u32x2 ow = *(const u32x2*)(OG + off);
        const float o0 = bflo(ow.x), o1 = bfhi(ow.x), o2 = bflo(ow.y), o3 = bfhi(ow.y);
        u32x2 w; w.x = pk2(s.x * rstd * g.x / (1.0f + __expf(-o0)), s.y * rstd * g.y / (1.0f + __expf(-o1)));
        w.y = pk2(s.z * rstd * g.z / (1.0f + __expf(-o2)), s.w * rstd * g.w / (1.0f + __expf(-o3)));
        *(u32x2*)(Y + off) = w;
    }
}

namespace ml {
constexpr int LQ = 264, LS = 72;
constexpr int OFF_Q = 0, OFF_K = 33792, OFF_KT = 67584, OFF_VT = 104448, OFF_VTW = 111360, OFF_P = 118272, OFF_CT = 127488, OFF_SC = 152832;
static_assert(OFF_SC + 1280 == LDS_BYTES, "mlstm lds map");
#define ML_MFMA(a, b, c) __builtin_amdgcn_mfma_f32_16x16x32_bf16(a, b, c, 0, 0, 0)

__device__ __forceinline__ void mlstm_phase(LAS unsigned char* lds, const bf16* __restrict__ QK, const bf16* __restrict__ KVT, const float* __restrict__ GATES, float* __restrict__ HF, int bid, int nblk) {
    const int tid = mk_tid(), wid = tid >> 6, lane = tid & 63, fr = lane & 15, fq = lane >> 4;
    LAS bf16* Qs = (LAS bf16*)(lds + OFF_Q); LAS bf16* Ks = (LAS bf16*)(lds + OFF_K); LAS bf16* KTs = (LAS bf16*)(lds + OFF_KT);
    LAS bf16* VTs = (LAS bf16*)(lds + OFF_VT); LAS bf16* VTw = (LAS bf16*)(lds + OFF_VTW); LAS bf16* Ps = (LAS bf16*)(lds + OFF_P); LAS bf16* CTs = (LAS bf16*)(lds + OFF_CT);
    LAS float* sA = (LAS float*)(lds + OFF_SC); LAS float* sM = sA + 64; LAS float* sAI = sM + 64; LAS float* sEM = sAI + 64;
    const int tt = wid & 3, sh = wid >> 2;
    for (int item = bid; item < 256; item += nblk) {
        const int es = item & 7, h = (item >> 3) & 7, b = (item >> 6) & 1, dir = item >> 7;
        for (int i = tid; i < 48 * LQ / 2; i += 512) ((LAS unsigned*)CTs)[i] = 0u;
        for (int i = tid; i < 16 * LS; i += 512) { VTs[32 * LS + i] = (i < LS) ? (bf16)0x3F80 : (bf16)0; VTw[32 * LS + i] = (bf16)0; }
        f32x4 ct[2][3];
#pragma unroll
        for (int a = 0; a < 2; ++a)
#pragma unroll
            for (int e = 0; e < 3; ++e) ct[a][e] = (f32x4){0.f, 0.f, 0.f, 0.f};
        float m_st = 0.f, decay = 1.f;
        bf16x8 rq[4], rk[4], rkt[4], rvt = {0, 0, 0, 0, 0, 0, 0, 0}; float gi = 0.f, gf = 0.f;
#define ML_LOAD(c) do { const int ncn_ = dir ? 63 - (c) : (c); const size_t trow_ = (size_t)b * SEQ + (size_t)ncn_ * 64; \
        _Pragma("unroll") for (int i_ = 0; i_ < 4; ++i_) { const int q_ = tid + 512 * i_, r_ = q_ >> 5, cc_ = (q_ & 31) * 8; \
            rq[i_] = *(const bf16x8*)(QK + (trow_ + r_) * 4096 + h * 256 + cc_); rk[i_] = *(const bf16x8*)(QK + (trow_ + r_) * 4096 + 2048 + h * 256 + cc_); } \
        _Pragma("unroll") for (int i_ = 0; i_ < 4; ++i_) { const int q_ = tid + 512 * i_, d_ = q_ >> 3, cc_ = (q_ & 7) * 8; \
            rkt[i_] = *(const bf16x8*)(KVT + (size_t)(h * 256 + d_) * M + trow_ + cc_); } \
        if (tid < 256) { const int e_ = tid >> 3, cc_ = (tid & 7) * 8; rvt = *(const bf16x8*)(KVT + (size_t)(2048 + h * 256 + es * 32 + e_) * M + trow_ + cc_); } \
        { const int r_ = dir ? 63 - lane : lane; const float* gp_ = GATES + (trow_ + r_) * 32 + dir * 16 + h; gi = gp_[0]; gf = gp_[8]; } } while (0)
#define ML_STORE() do { \
        const float lf_ = fminf(gf, 0.f) - log1pf(__expf(-fabsf(gf))); float bc_ = lf_; \
        _Pragma("unroll") for (int o_ = 1; o_ < 64; o_ <<= 1) { const float t_ = __shfl_up(bc_, o_); if (lane >= o_) bc_ += t_; } \
        const float a_ = gi - bc_; float cm_ = a_; \
        _Pragma("unroll") for (int o_ = 1; o_ < 64; o_ <<= 1) { const float t_ = __shfl_up(cm_, o_); if (lane >= o_) cm_ = fmaxf(cm_, t_); } \
        const float Mv_ = fmaxf(m_st, cm_), blast_ = __shfl(bc_, 63), cml_ = __shfl(cm_, 63), Mn_ = fmaxf(m_st, cml_); \
        const float ai_ = __expf(m_st - Mv_), em_ = __expf(-(bc_ + Mv_)), wsv_ = __expf(a_ - Mn_); decay = __expf(m_st - Mn_); m_st = blast_ + Mn_; \
        const int rr_ = dir ? 63 - lane : lane; \
        if (wid == 0) { sA[rr_] = a_; sM[rr_] = Mv_; sAI[rr_] = ai_; sEM[rr_] = em_; VTw[32 * LS + rr_] = (bf16)f2bf(wsv_); } \
        _Pragma("unroll") for (int i_ = 0; i_ < 4; ++i_) { const int q_ = tid + 512 * i_, r_ = q_ >> 5, cc_ = (q_ & 31) * 8; \
            *(LAS bf16x8*)(Qs + r_ * LQ + cc_) = rq[i_]; *(LAS bf16x8*)(Ks + r_ * LQ + cc_) = rk[i_]; } \
        _Pragma("unroll") for (int i_ = 0; i_ < 4; ++i_) { const int q_ = tid + 512 * i_, d_ = q_ >> 3, cc_ = (q_ & 7) * 8; *(LAS bf16x8*)(KTs + d_ * LS + cc_) = rkt[i_]; } \
        if (tid < 256) { const int e_ = tid >> 3, cc_ = (tid & 7) * 8; *(LAS bf16x8*)(VTs + e_ * LS + cc_) = rvt; \
            float wv_[8]; _Pragma("unroll") for (int i_ = 0; i_ < 8; ++i_) { const int s_ = cc_ + i_; wv_[i_] = __shfl(wsv_, dir ? 63 - s_ : s_); } \
            const u32x4 rv_ = __builtin_bit_cast(u32x4, rvt); u32x4 o_; \
            o_.x = pk2(bflo(rv_.x) * wv_[0], bfhi(rv_.x) * wv_[1]); o_.y = pk2(bflo(rv_.y) * wv_[2], bfhi(rv_.y) * wv_[3]); \
            o_.z = pk2(bflo(rv_.z) * wv_[4], bfhi(rv_.z) * wv_[5]); o_.w = pk2(bflo(rv_.w) * wv_[6], bfhi(rv_.w) * wv_[7]); \
            *(LAS u32x4*)(VTw + e_ * LS + cc_) = o_; } } while (0)
        ML_LOAD(0);
        __syncthreads();
        ML_STORE();
        __syncthreads();
        ML_LOAD(1);
        for (int c = 0; c < 64; ++c) {
            const int ncn = dir ? 63 - c : c; const size_t trow = (size_t)b * SEQ + (size_t)ncn * 64;
            const float dec_c = decay;
            f32x4 s0 = {0.f, 0.f, 0.f, 0.f}, s1 = s0, n3 = s0, d3 = s0;
#pragma unroll 2
            for (int ks = 0; ks < 8; ++ks) {
                const int ko = ks * 32 + fq * 8;
                const bf16x8 qf = *(const LAS bf16x8*)(Qs + (tt * 16 + fr) * LQ + ko);
                const bf16x8 k0 = *(const LAS bf16x8*)(Ks + ((2 * sh) * 16 + fr) * LQ + ko), k1 = *(const LAS bf16x8*)(Ks + ((2 * sh + 1) * 16 + fr) * LQ + ko);
                const bf16x8 c0 = *(const LAS bf16x8*)(CTs + (sh * 16 + fr) * LQ + ko), c2 = *(const LAS bf16x8*)(CTs + (32 + fr) * LQ + ko);
                s0 = ML_MFMA(k0, qf, s0); s1 = ML_MFMA(k1, qf, s1); n3 = ML_MFMA(c0, qf, n3); d3 = ML_MFMA(c2, qf, d3);
            }
            const int t = tt * 16 + fr; const float Mt = sM[t];
            {
                const int sb0 = (2 * sh) * 16 + 4 * fq, sb1 = sb0 + 16;
                const f32x4 a0 = *(const LAS f32x4*)(sA + sb0), a1 = *(const LAS f32x4*)(sA + sb1);
                float p0[4], p1[4];
#pragma unroll
                for (int r = 0; r < 4; ++r) {
                    const int sa = sb0 + r, sbb = sb1 + r;
                    const bool ok0 = dir ? (sa >= t) : (sa <= t), ok1 = dir ? (sbb >= t) : (sbb <= t);
                    p0[r] = ok0 ? s0[r] * __expf(a0[r] - Mt) : 0.f; p1[r] = ok1 ? s1[r] * __expf(a1[r] - Mt) : 0.f;
                }
                u32x2 w0, w1; w0.x = pk2(p0[0], p0[1]); w0.y = pk2(p0[2], p0[3]); w1.x = pk2(p1[0], p1[1]); w1.y = pk2(p1[2], p1[3]);
                *(LAS u32x2*)(Ps + t * LS + sb0) = w0; *(LAS u32x2*)(Ps + t * LS + sb1) = w1;
            }
            __syncthreads();
            f32x4 n2 = {0.f, 0.f, 0.f, 0.f}, d2 = n2;
#pragma unroll
            for (int ks = 0; ks < 2; ++ks) {
                const int ko = ks * 32 + fq * 8;
                const bf16x8 pf = *(const LAS bf16x8*)(Ps + (tt * 16 + fr) * LS + ko);
                const bf16x8 v0 = *(const LAS bf16x8*)(VTs + (sh * 16 + fr) * LS + ko), v2 = *(const LAS bf16x8*)(VTs + (32 + fr) * LS + ko);
                n2 = ML_MFMA(v0, pf, n2); d2 = ML_MFMA(v2, pf, d2);
            }
            {
                const float ai = sAI[t], em = sEM[t];
                const float den0 = d2[0] + ai * d3[0];
                const float den = __shfl(den0, fr);
                const float rinv = 1.0f / fmaxf(fabsf(den), em);
                f32x4 o; o.x = (n2[0] + ai * n3[0]) * rinv; o.y = (n2[1] + ai * n3[1]) * rinv; o.z = (n2[2] + ai * n3[2]) * rinv; o.w = (n2[3] + ai * n3[3]) * rinv;
                *(f32x4*)(HF + ((size_t)dir * M + trow + t) * D + h * 256 + es * 32 + sh * 16 + 4 * fq) = o;
            }
#pragma unroll
            for (int a = 0; a < 2; ++a)
#pragma unroll
                for (int e = 0; e < 3; ++e) ct[a][e] = ct[a][e] * dec_c;
#pragma unroll
            for (int ks = 0; ks < 2; ++ks) {
                const int ko = ks * 32 + fq * 8;
                bf16x8 kt[2], vw[3];
#pragma unroll
                for (int a = 0; a < 2; ++a) kt[a] = *(const LAS bf16x8*)(KTs + ((2 * wid + a) * 16 + fr) * LS + ko);
#pragma unroll
                for (int e = 0; e < 3; ++e) vw[e] = *(const LAS bf16x8*)(VTw + (e * 16 + fr) * LS + ko);
#pragma unroll
                for (int a = 0; a < 2; ++a)
#pragma unroll
                    for (int e = 0; e < 3; ++e) ct[a][e] = ML_MFMA(kt[a], vw[e], ct[a][e]);
            }
#pragma unroll
            for (int a = 0; a < 2; ++a)
#pragma unroll
                for (int e = 0; e < 3; ++e) { u32x2 w; w.x = pk2(ct[a][e][0], ct[a][e][1]); w.y = pk2(ct[a][e][2], ct[a][e][3]);
                    *(LAS u32x2*)(CTs + (e * 16 + fr) * LQ + (2 * wid + a) * 16 + 4 * fq) = w; }
            __syncthreads();
            if (c + 1 < 64) { ML_STORE(); }
            __syncthreads();
            if (c + 2 < 64) { ML_LOAD(c + 2); }
        }
#undef ML_LOAD
#undef ML_STORE
    }
}
}
}

struct EpiRes {
    static constexpr bool PERM = false, AFTER_DRAIN = false;
    const float* base; float* out; int ldc;
    __device__ __forceinline__ void operator()(const pg8::f32x4 (&acc)[2][2][4][2], const pg8::Unit& u, int wr, int wc, int fr, int fq) const {
#pragma unroll
        for (int ai = 0; ai < 2; ++ai)
#pragma unroll
            for (int m = 0; m < 4; ++m) { const size_t ro = (size_t)(u.pm * 256 + ai * 128 + wr * 64 + m * 16 + fr) * ldc + u.pn * 256 + wc * 32 + 4 * fq;
#pragma unroll
                for (int bj = 0; bj < 2; ++bj)
#pragma unroll
                    for (int n = 0; n < 2; ++n) { const size_t off = ro + bj * 128 + n * 16; const pg8::f32x4 bs = *(const pg8::f32x4*)(base + off); *(pg8::f32x4*)(out + off) = bs + acc[ai][bj][m][n]; } }
    }
};

struct GemmDesc { const unsigned short* A; const unsigned short* Bt; int Mg, Ng, Kg; int kind; unsigned short* O; int ldc; int split_cols; float scale0; const float* base; float* out; int G, c; };

struct Params { const float* in[17]; float* out; unsigned char* ws; int ph_lo, ph_hi; };
constexpr int N_PHASES = 18;

__global__ void __launch_bounds__(512, 2) fwd_mega(Params p) {
    extern __shared__ __attribute__((aligned(16))) unsigned char lds_raw[];
    using namespace mk;
    cg::grid_group grid = cg::this_grid();
    LAS unsigned char* lds = (LAS unsigned char*)lds_raw;
    const int bid = blockIdx.x, nblk = gridDim.x, ngw = nblk * NW, ngt = nblk * 512;
    const int ph_lo = p.ph_lo, ph_hi = p.ph_hi;
#pragma unroll 1
    for (int ph = ph_lo; ph < ph_hi; ++ph) {
        typedef const __attribute__((address_space(4))) Params* KP;
        KP kp = (KP)__builtin_amdgcn_kernarg_segment_ptr(); asm volatile("" : "+s"(kp));
        unsigned char* ws = kp->ws; float* OUT = kp->out; bf16* XN = (bf16*)(ws + WS_XN);
        In I; I.x = kp->in[0]; I.norm_mix = kp->in[1]; I.norm_ffn = kp->in[2]; I.w_in_ab = kp->in[3]; I.pool_w = kp->in[4]; I.pool_scale = kp->in[5]; I.q_norm = kp->in[6]; I.k_norm = kp->in[7];
        I.w_out_ab = kp->in[8]; I.w_in_c = kp->in[9]; I.b_gate = kp->in[10]; I.h_norm = kp->in[11]; I.w_out_c = kp->in[12]; I.w_up = kp->in[13]; I.conv_w = kp->in[14]; I.conv_b = kp->in[15]; I.w_down = kp->in[16];
        const int tid = mk_tid(), lane = tid & 63, wave = __builtin_amdgcn_readfirstlane(tid >> 6), gw = bid * NW + wave, gt = bid * 512 + tid;
#ifndef NO_THIN
        if (ph == 0) prologue(I, ws, lds, gw, ngw, wave, lane);
        if (ph == 5 || ph == 9 || ph == 14) rmsnorm_rows(OUT, ph == 5 ? I.norm_ffn : (ph == 9 ? I.norm_mix + D : I.norm_ffn + D), XN, gw, ngw, lane);
        if (ph == 2) qk_rope_pool((bf16*)(ws + WS_PROJ), I.q_norm, I.k_norm, (bf16*)(ws + WS_POOLED), gw, ngw, lane);
#endif
#ifndef NO_ATT
        if (ph == 3) {
            const bf16* PROJ = (const bf16*)(ws + WS_PROJ); bf16* CAT = (bf16*)(ws + WS_CAT);
            for (int u = bid; u < 384; u += nblk) {
                const int qb = u & 15, hq = (u >> 4) % 12, b = u / 192;
                const size_t r0 = (size_t)b * SEQ + (size_t)qb * 256;
                att::attn_dense_body<att::bf16>((const att::bf16*)(PROJ + r0 * ABW + 512 + hq * 128), (const att::bf16*)(PROJ + (size_t)b * SEQ * ABW + 2048 + (hq / 3) * 128),
                                                (const att::bf16*)(PROJ + (size_t)b * SEQ * ABW + 2560 + (hq / 3) * 128), CAT + r0 * D + 512 + hq * 128, SEQ, (char*)lds_raw);
                __syncthreads();
            }
        }
#endif
#ifndef NO_THIN
        if (ph == 7 || ph == 16) { const int l = ph == 7 ? 0 : 1; conv_act((const bf16*)(ws + WS_U), I.conv_w + (size_t)l * 3 * FF2, I.conv_b + (size_t)l * FF2, (bf16*)(ws + WS_ACT), gt, ngt); }
        if (ph == 10) gates_phase(XN, (const bf16*)(ws + WS_C) + (size_t)8192 * D, I.b_gate, (float*)(ws + WS_GATES), (LAS float*)lds, bid, nblk);
#endif
#ifndef NO_ML
        if (ph == 11) ml::mlstm_phase(lds, (const bf16*)(ws + WS_QK), (const bf16*)(ws + WS_KVT), (const float*)(ws + WS_GATES), (float*)(ws + WS_HF), bid, nblk);
#endif
#ifndef NO_THIN
        if (ph == 12) headnorm_phase((const float*)(ws + WS_HF), (const bf16*)(ws + WS_OG), I.h_norm, (bf16*)(ws + WS_Y), gw, ngw, lane);
#endif
#pragma unroll 1
        for (int gi = 0; gi < 3; ++gi) {
            GemmDesc d; d.kind = -1; d.G = nblk; d.c = bid; d.split_cols = 0; d.scale0 = 1.f; d.base = nullptr; d.out = nullptr; d.O = nullptr; d.ldc = 0; d.A = nullptr; d.Bt = nullptr; d.Mg = M; d.Ng = 0; d.Kg = D;
            if (gi == 0) {
                if (ph == 1) { d.kind = 0; d.A = XN; d.Bt = (bf16*)(ws + WS_AB); d.Ng = ABW; d.O = (bf16*)(ws + WS_PROJ); d.ldc = ABW; }
                else if (ph == 3) { d.kind = 0; d.A = (bf16*)(ws + WS_POOLED); d.Bt = (bf16*)(ws + WS_BD); d.Ng = 512; d.Kg = 512; d.O = (bf16*)(ws + WS_CAT); d.ldc = D;
                    if (nblk >= 192) { d.G = 64; d.c = bid - 128; if (bid < 128 || bid >= 192) d.kind = -1; } }
                else if (ph == 4) { d.kind = 1; d.A = (bf16*)(ws + WS_CAT); d.Bt = (bf16*)(ws + WS_OAB); d.Ng = D; d.base = I.x; d.out = OUT; }
                else if (ph == 6 || ph == 15) { d.kind = 0; d.A = XN; d.Bt = (bf16*)(ws + (ph == 6 ? WS_UP0 : WS_UP1)); d.Ng = FF2; d.O = (bf16*)(ws + WS_U); d.ldc = FF2; }
                else if (ph == 8 || ph == 17) { d.kind = 1; d.A = (bf16*)(ws + WS_ACT); d.Bt = (bf16*)(ws + (ph == 8 ? WS_DN0 : WS_DN1)); d.Ng = D; d.Kg = FF; d.base = OUT; d.out = OUT; }
                else if (ph == 10) { d.kind = 0; d.A = XN; d.Bt = (bf16*)(ws + WS_C); d.Ng = 4096; d.O = (bf16*)(ws + WS_QK); d.ldc = 4096; d.split_cols = 2048; d.scale0 = 0.0625f; }
                else if (ph == 13) { d.kind = 1; d.A = (bf16*)(ws + WS_Y); d.Bt = (bf16*)(ws + WS_OC); d.Ng = D; d.base = OUT; d.out = OUT; }
            } else if (ph == 10) {
                if (gi == 1) { d.kind = 0; d.A = XN; d.Bt = (bf16*)(ws + WS_C) + (size_t)6144 * D; d.Ng = D; d.O = (bf16*)(ws + WS_OG); d.ldc = D; }
                else { d.kind = 0; d.A = (bf16*)(ws + WS_C) + (size_t)2048 * D; d.Bt = XN; d.Mg = 4096; d.Ng = M; d.O = (bf16*)(ws + WS_KVT); d.ldc = M; }
            }
#ifndef NO_GEMM
            if (d.kind == 0) {
                pg8::Gemm g{d.A, d.Bt, d.Mg, d.Ng, d.Kg}; pg8::StaticOrder S; S.init(d.Mg, d.Ng, d.G, d.c);
                pg8::EpiBf16<0> E{d.O, d.ldc, nullptr, d.split_cols, (size_t)d.split_cols, d.scale0};
                pg8::gemm_phase<pg8::EpiBf16<0>, pg8::StaticOrder, true, true>(lds, g, S, E);
            } else if (d.kind == 1) {
                pg8::Gemm g{d.A, d.Bt, d.Mg, d.Ng, d.Kg}; pg8::StaticOrder S; S.init(d.Mg, d.Ng, d.G, d.c);
                EpiRes E{d.base, d.out, D};
                pg8::gemm_phase<EpiRes, pg8::StaticOrder, true, true>(lds, g, S, E);
            }
#endif
            __syncthreads();
        }
        if (ph + 1 < ph_hi) grid.sync();
    }
}

#ifndef MK_MULTI
#define MK_MULTI 0
#endif
extern "C" void kernel_launch(void* const* d_in, const int* in_sizes, int n_in, void* d_out, int out_size, void* d_ws, size_t ws_size, hipStream_t stream) {
    static int grid = 0;
    if (grid == 0) {
        if (n_in != 17 || out_size != mk::M * mk::D || ws_size < mk::WS_END) { fprintf(stderr, "kernel_launch: unexpected shapes n_in %d out %d ws %zu (need %zu)\n", n_in, out_size, ws_size, (size_t)mk::WS_END); grid = -1; return; }
        int dev = 0, cus = 0, per_cu = 0;
        (void)hipGetDevice(&dev); (void)hipDeviceGetAttribute(&cus, hipDeviceAttributeMultiprocessorCount, dev);
        if (hipFuncSetAttribute((const void*)fwd_mega, hipFuncAttributeMaxDynamicSharedMemorySize, mk::LDS_BYTES) != hipSuccess) { fprintf(stderr, "kernel_launch: hipFuncSetAttribute failed\n"); grid = -1; return; }
        if (hipOccupancyMaxActiveBlocksPerMultiprocessor(&per_cu, (const void*)fwd_mega, 512, mk::LDS_BYTES) != hipSuccess || per_cu < 1) { fprintf(stderr, "kernel_launch: occupancy query gave %d\n", per_cu); per_cu = 1; }
        (void)hipGetLastError();
        if (cus <= 0) cus = 256;
        grid = cus * per_cu; if (grid > 256) grid = 256;
        fprintf(stderr, "kernel_launch: cus %d per_cu %d grid %d\n", cus, per_cu, grid);
    }
    if (grid < 0) return;
    Params p{};
    for (int i = 0; i < 17; ++i) p.in[i] = (const float*)d_in[i];
    p.out = (float*)d_out; p.ws = (unsigned char*)d_ws;
#if MK_MULTI
    for (int ph = 0; ph < N_PHASES; ++ph) { p.ph_lo = ph; p.ph_hi = ph + 1; hipLaunchKernelGGL(fwd_mega, dim3(grid), dim3(512), mk::LDS_BYTES, stream, p); }
#else
    p.ph_lo = 0; p.ph_hi = N_PHASES;
    void* args[] = {&p};
    const hipError_t e = hipLaunchCooperativeKernel((const void*)fwd_mega, dim3(grid), dim3(512), args, mk::LDS_BYTES, stream);
    if (e != hipSuccess) fprintf(stderr, "kernel_launch: cooperative launch failed: %s (grid %d)\n", hipGetErrorString(e), grid);
#endif
}
```

```cpp
#include <hip/hip_runtime.h>
#include <hip/hip_cooperative_groups.h>
#include <hip/hip_bf16.h>
#include <cstdio>
#include <cstdint>
#include <cmath>
namespace cg = cooperative_groups;
__device__ __forceinline__ int mk_tid();
namespace pg8 {
#define PG8_LAS __attribute__((address_space(3)))
typedef unsigned short bf16_t;
typedef short bf16x8 __attribute__((ext_vector_type(8)));
typedef float f32x4 __attribute__((ext_vector_type(4)));
typedef unsigned u32x4 __attribute__((ext_vector_type(4)));
constexpr int BM = 256, BK = 64, HALF = 128, HTB = HALF * BK * 2  , STAGE_BYTES = 8 * HTB, NXCD = 8, WGM = 8;

__host__ __device__ __forceinline__ int lds_byte(int r, int c) { const int st = (r >> 4) * 2 + (c >> 5), rr = r & 15, cc = c & 31, ob = rr * 64 + cc * 2; return st * 1024 + (ob ^ (((ob >> 9) & 1) << 5)); }
__host__ __device__ __forceinline__ void stage_rc(int b, int& R, int& C) { const int st = b / 1024, sb = b % 1024, swz = sb ^ (((sb >> 9) & 1) << 5); R = (st >> 1) * 16 + swz / 64; C = (st & 1) * 32 + (swz % 64) / 2; }
__host__ __device__ __forceinline__ int perm32(int rho) { const int n = rho >> 4, i = rho & 15; return 8 * (i >> 2) + 4 * n + (i & 3); }

struct Unit { int pm, pn; };
struct Gemm { const bf16_t* A; const bf16_t* Bt; int M, N, K; };

struct StaticOrder {
    int nM, nN, nwg, G, c;
    __host__ __device__ void init(int M, int N, int G_, int c_) { nM = M / BM; nN = N / BM; nwg = nM * nN; G = G_; c = c_; }
    __host__ __device__ bool next(int i, Unit& u) const {
        const long L = (long)i * G + c; if (L >= nwg) return false;
        int wgid = (int)L; { const int q = nwg / NXCD, r = nwg % NXCD, xcd = wgid % NXCD, off = wgid / NXCD; wgid = (xcd < r ? xcd * (q + 1) : r * (q + 1) + (xcd - r) * q) + off; }
        const int nig = WGM * nN, gid = wgid / nig, fm = gid * WGM, gsz = (nM - fm) < WGM ? (nM - fm) : WGM;
        u.pm = fm + ((wgid % nig) % gsz); u.pn = (wgid % nig) / gsz; return true;
    }
    __device__ __forceinline__ void a_ready(const Unit&) const {}
    __device__ __forceinline__ void done(const Unit&) const {}
};

__device__ __forceinline__ unsigned cvt_pk_bf16(float lo, float hi) { unsigned r; asm volatile("v_cvt_pk_bf16_f32 %0, %1, %2" : "=v"(r) : "v"(lo), "v"(hi)); return r; }
typedef float f32x2 __attribute__((ext_vector_type(2)));
__device__ __forceinline__ f32x2 gelu_pk(f32x2 v) {
    const f32x2 av = __builtin_elementwise_abs(v), d = av * 0.2316418882f + 1.0f;
    f32x2 t; t.x = __builtin_amdgcn_rcpf(d.x); t.y = __builtin_amdgcn_rcpf(d.y);
    f32x2 q = t * 0.5307027145f + (-0.7265760135f); q = q * t + 0.7107068705f; q = q * t + (-0.142248368f); q = q * t + 0.127414796f; q = q * t;
    const f32x2 s = (v * v) * (-0.72134752044f);
    f32x2 e; e.x = __builtin_amdgcn_exp2f(s.x); e.y = __builtin_amdgcn_exp2f(s.y);
    const f32x2 m = v * (q * e), r = v - m;
    f32x2 o; o.x = v.x < 0.f ? m.x : r.x; o.y = v.y < 0.f ? m.y : r.y; return o;
}

template <int ACT  > struct EpiBf16 {
    static constexpr bool PERM = true, AFTER_DRAIN = false; static_assert(ACT == 0 || ACT == 1, "EpiBf16: ACT is 0 (none) or 1 (gelu_pk)");
    bf16_t* O; int ldc; const float* bias; int split_cols; size_t split_stride; float scale0;
    __device__ __forceinline__ void operator()(const f32x4 (&acc)[2][2][4][2], const Unit& u, int wr, int wc, int fr, int fq) const {
        const int row0 = u.pm * BM + wr * 64 + fr; int colt = u.pn * BM; bf16_t* base = O;
        float sc = 1.f; if (split_cols) { const int t = colt / split_cols; base += (size_t)t * split_stride; colt -= t * split_cols; if (t == 0) sc = scale0; }
        const int col0 = colt + wc * 32 + 8 * fq, bcol0 = u.pn * BM + wc * 32 + 8 * fq;
        f32x4 bv[2][2];
#pragma unroll
        for (int bj = 0; bj < 2; ++bj)
#pragma unroll
            for (int n = 0; n < 2; ++n) bv[bj][n] = bias ? *(const f32x4*)(bias + bcol0 + bj * HALF + 4 * n) : (f32x4){0.f, 0.f, 0.f, 0.f};
#pragma unroll
        for (int ai = 0; ai < 2; ++ai)
#pragma unroll
            for (int m = 0; m < 4; ++m) { bf16_t* rowp = base + (size_t)(row0 + ai * HALF + m * 16) * ldc + col0;
#pragma unroll
                for (int bj = 0; bj < 2; ++bj) { f32x4 v0 = acc[ai][bj][m][0] + bv[bj][0], v1 = acc[ai][bj][m][1] + bv[bj][1];
                    if (ACT == 1) { f32x2 a = gelu_pk((f32x2){v0[0], v0[1]}), b = gelu_pk((f32x2){v0[2], v0[3]}), c = gelu_pk((f32x2){v1[0], v1[1]}), d = gelu_pk((f32x2){v1[2], v1[3]});
                        v0 = (f32x4){a.x, a.y, b.x, b.y}; v1 = (f32x4){c.x, c.y, d.x, d.y}; }
                    v0 = v0 * sc; v1 = v1 * sc; u32x4 w; w.x = cvt_pk_bf16(v0[0], v0[1]); w.y = cvt_pk_bf16(v0[2], v0[3]); w.z = cvt_pk_bf16(v1[0], v1[1]); w.w = cvt_pk_bf16(v1[2], v1[3]);
                    *(u32x4*)(rowp + bj * HALF) = w; } }
    }
};

template <class Epi, class Sched, bool ALIGN_EPI = false, bool SP2 = false>
__device__ __forceinline__ void gemm_phase(PG8_LAS unsigned char* lds, const Gemm g, const Sched& S, const Epi& E) {
    const int tid = mk_tid(), wid = __builtin_amdgcn_readfirstlane(tid >> 6), lane = tid & 63, wr = wid >> 2, wc = wid & 3, fr = lane & 15, fq = lane >> 4;
    const int K = g.K, nt = K / BK;
    unsigned voffA[2], voffB[2];
#pragma unroll
    for (int i = 0; i < 2; ++i) { int R, C; stage_rc(tid * 16 + i * 8192, R, C); const int Rb = Epi::PERM ? ((R & ~31) + perm32(R & 31)) : R;
        voffA[i] = (unsigned)(R * K + C) * 2u; voffB[i] = (unsigned)(Rb * K + C) * 2u; }
    const size_t kstep = (size_t)(BK * 2);
    const size_t hstep = (size_t)HALF * K * 2;
    const size_t tstep = 2 * hstep;
    const unsigned ldsw = (unsigned)wid * 1024u;
    const int aoff = lds_byte(wr * 64 + fr, fq * 8), boff = lds_byte(wc * 32 + fr, fq * 8);
#define PG8_SA(b, h) (((b) * 2 + (h)) * HTB)
#define PG8_SB(b, h) ((4 + (b) * 2 + (h)) * HTB)
#define PG8_STAGE(bufoff, gbase, voff) do { _Pragma("unroll") for (int _i = 0; _i < 2; ++_i) \
        __builtin_amdgcn_global_load_lds((const unsigned*)((const char*)(gbase) + (voff)[_i]), (PG8_LAS unsigned*)(lds + (bufoff) + ldsw + _i * 8192), 16, 0, 0); } while (0)
#define PG8_LDA(dst, b, h) do { _Pragma("unroll") for (int m = 0; m < 4; ++m) _Pragma("unroll") for (int k = 0; k < 2; ++k) dst[m][k] = *(const PG8_LAS bf16x8*)(lds + PG8_SA(b, h) + aoff + m * 2048 + k * 1024); } while (0)
#define PG8_LDB(dst, b, h) do { _Pragma("unroll") for (int n = 0; n < 2; ++n) _Pragma("unroll") for (int k = 0; k < 2; ++k) dst[n][k] = *(const PG8_LAS bf16x8*)(lds + PG8_SB(b, h) + boff + n * 2048 + k * 1024); } while (0)
#define PG8_MMA(ai, bj, At, Bt) do { __builtin_amdgcn_s_setprio(1); _Pragma("unroll") for (int m = 0; m < 4; ++m) _Pragma("unroll") for (int n = 0; n < 2; ++n) _Pragma("unroll") for (int k = 0; k < 2; ++k) \
        acc[ai][bj][m][n] = __builtin_amdgcn_mfma_f32_16x16x32_bf16(Bt[n][k], At[m][k], acc[ai][bj][m][n], 0, 0, 0); __builtin_amdgcn_s_setprio(0); } while (0)
#define PG8_WAIT_V(n) asm volatile("s_waitcnt vmcnt(" #n ")" ::: "memory")
#define PG8_WAIT_L(n) asm volatile("s_waitcnt lgkmcnt(" #n ")" ::: "memory")
#define PG8_BAR __builtin_amdgcn_s_barrier()
#define PG8_SCHED __builtin_amdgcn_sched_barrier(0)
    Unit cur, nxt; int ui = 0;
    if (!S.next(0, cur)) return;
    f32x4 acc[2][2][4][2];
#pragma unroll
    for (int a = 0; a < 2; ++a)
#pragma unroll
        for (int b = 0; b < 2; ++b)
#pragma unroll
            for (int m = 0; m < 4; ++m)
#pragma unroll
                for (int n = 0; n < 2; ++n) acc[a][b][m][n] = (f32x4){0.f, 0.f, 0.f, 0.f};
    bf16x8 At[4][2], B0[2][2], B1[2][2];
    const char* cA = (const char*)g.A + (size_t)cur.pm * tstep; const char* cB = (const char*)g.Bt + (size_t)cur.pn * tstep;
    S.a_ready(cur);
    if constexpr (SP2) {
        PG8_STAGE(PG8_SB(0, 0), cB, voffB); PG8_STAGE(PG8_SB(0, 1), cB + hstep, voffB); PG8_STAGE(PG8_SA(0, 0), cA, voffA); PG8_STAGE(PG8_SA(0, 1), cA + hstep, voffA);
        if (wr == 1) PG8_BAR;
        PG8_WAIT_V(2); PG8_BAR;
        PG8_STAGE(PG8_SB(1, 0), cB + kstep, voffB); PG8_STAGE(PG8_SA(1, 0), cA + kstep, voffA); PG8_STAGE(PG8_SB(1, 1), cB + hstep + kstep, voffB);
        PG8_WAIT_V(6); PG8_BAR;
    } else {
        PG8_STAGE(PG8_SB(0, 0), cB, voffB); PG8_STAGE(PG8_SA(0, 0), cA, voffA); PG8_STAGE(PG8_SB(0, 1), cB + hstep, voffB); PG8_STAGE(PG8_SA(0, 1), cA + hstep, voffA);
        if (wr == 1) PG8_BAR;
        PG8_WAIT_V(4); PG8_BAR;
        PG8_STAGE(PG8_SB(1, 0), cB + kstep, voffB); PG8_STAGE(PG8_SA(1, 0), cA + kstep, voffA); PG8_STAGE(PG8_SB(1, 1), cB + hstep + kstep, voffB);
        PG8_WAIT_V(6); PG8_BAR;
    }
    for (;;) {
        const bool has_next = S.next(ui + 1, nxt);
        const char* nA = has_next ? (const char*)g.A + (size_t)nxt.pm * tstep : cA; const char* nB = has_next ? (const char*)g.Bt + (size_t)nxt.pn * tstep : cB;
        for (int t = 0; t < nt; t += 2) {
            const bool last = (t == nt - 2);
            const char* a1 = cA + (size_t)(t + 1) * kstep;
            const char* a2 = last ? nA : cA + (size_t)(t + 2) * kstep; const char* b2 = last ? nB : cB + (size_t)(t + 2) * kstep;
            const char* a3 = a2 + kstep; const char* b3 = b2 + kstep;
            if (last && has_next) S.a_ready(nxt);
            if constexpr (SP2) {
            PG8_LDB(B0, 0, 0); PG8_LDB(B1, 0, 1); PG8_SCHED; PG8_LDA(At, 0, 0); PG8_STAGE(PG8_SA(1, 1), a1 + hstep, voffA);
            PG8_WAIT_V(8); PG8_WAIT_L(0); PG8_BAR; PG8_MMA(0, 0, At, B0); PG8_MMA(0, 1, At, B1); PG8_BAR; PG8_SCHED;
            PG8_LDA(At, 0, 1); PG8_STAGE(PG8_SB(0, 0), b2, voffB); PG8_STAGE(PG8_SB(0, 1), b2 + hstep, voffB); PG8_STAGE(PG8_SA(0, 0), a2, voffA);
            PG8_WAIT_V(8); PG8_WAIT_L(0); PG8_BAR; PG8_MMA(1, 0, At, B0); PG8_MMA(1, 1, At, B1); PG8_BAR; PG8_SCHED;
            PG8_LDB(B0, 1, 0); PG8_LDB(B1, 1, 1); PG8_SCHED; PG8_LDA(At, 1, 0); PG8_STAGE(PG8_SA(0, 1), a2 + hstep, voffA);
            PG8_WAIT_V(8); PG8_WAIT_L(0); PG8_BAR; PG8_MMA(0, 0, At, B0); PG8_MMA(0, 1, At, B1); PG8_BAR; PG8_SCHED;
            PG8_LDA(At, 1, 1); PG8_STAGE(PG8_SB(1, 0), b3, voffB); PG8_STAGE(PG8_SB(1, 1), b3 + hstep, voffB); PG8_STAGE(PG8_SA(1, 0), a3, voffA);
            PG8_WAIT_V(8); PG8_WAIT_L(0); PG8_BAR; PG8_MMA(1, 0, At, B0); PG8_MMA(1, 1, At, B1); PG8_BAR; PG8_SCHED;
            } else {
            PG8_LDB(B0, 0, 0); PG8_SCHED; PG8_LDA(At, 0, 0); PG8_STAGE(PG8_SA(1, 1), a1 + hstep, voffA);
            PG8_WAIT_L(8); PG8_BAR; PG8_WAIT_L(0); PG8_MMA(0, 0, At, B0); PG8_BAR; PG8_SCHED;
            PG8_LDB(B1, 0, 1); PG8_STAGE(PG8_SB(0, 0), b2, voffB);
            PG8_BAR; PG8_WAIT_L(0); PG8_MMA(0, 1, At, B1); PG8_BAR;
            PG8_LDA(At, 0, 1); PG8_STAGE(PG8_SA(0, 0), a2, voffA);
            PG8_BAR; PG8_WAIT_L(0); PG8_MMA(1, 0, At, B0); PG8_BAR; PG8_SCHED;
            PG8_STAGE(PG8_SB(0, 1), b2 + hstep, voffB);
            PG8_WAIT_V(6); PG8_BAR; PG8_MMA(1, 1, At, B1); PG8_BAR;
            PG8_LDB(B0, 1, 0); PG8_SCHED; PG8_LDA(At, 1, 0); PG8_STAGE(PG8_SA(0, 1), a2 + hstep, voffA);
            PG8_WAIT_L(8); PG8_BAR; PG8_WAIT_L(0); PG8_MMA(0, 0, At, B0); PG8_BAR; PG8_SCHED;
            PG8_LDB(B1, 1, 1); PG8_STAGE(PG8_SB(1, 0), b3, voffB);
            PG8_BAR; PG8_WAIT_L(0); PG8_MMA(0, 1, At, B1); PG8_BAR;
            PG8_LDA(At, 1, 1); PG8_STAGE(PG8_SA(1, 0), a3, voffA);
            PG8_BAR; PG8_WAIT_L(0); PG8_MMA(1, 0, At, B0); PG8_BAR; PG8_SCHED;
            PG8_STAGE(PG8_SB(1, 1), b3 + hstep, voffB);
            PG8_WAIT_V(6); PG8_BAR; PG8_MMA(1, 1, At, B1); PG8_BAR;
            }
        }
        if constexpr (ALIGN_EPI) { if (wr == 0) PG8_BAR; }
        if constexpr (!Epi::AFTER_DRAIN) { E(acc, cur, wr, wc, fr, fq); S.done(cur); }
        if (!has_next) break;
#pragma unroll
        for (int a = 0; a < 2; ++a)
#pragma unroll
            for (int b = 0; b < 2; ++b)
#pragma unroll
                for (int m = 0; m < 4; ++m)
#pragma unroll
                    for (int n = 0; n < 2; ++n) acc[a][b][m][n] = (f32x4){0.f, 0.f, 0.f, 0.f};
        cur = nxt; cA = nA; cB = nB; ++ui;
        if constexpr (ALIGN_EPI) { if (wr == 1) PG8_BAR; }
    }
    PG8_WAIT_V(0);
    if constexpr (!ALIGN_EPI) { if (wr == 0) PG8_BAR; }
    PG8_BAR;
    if constexpr (Epi::AFTER_DRAIN) { E.fused(acc, cur, wr, wc, fr, fq, lds, wid, lane); S.done(cur); }
#undef PG8_SA
#undef PG8_SB
#undef PG8_STAGE
#undef PG8_LDA
#undef PG8_LDB
#undef PG8_MMA
#undef PG8_WAIT_V
#undef PG8_WAIT_L
#undef PG8_BAR
#undef PG8_SCHED
}
}

namespace att {
using bf16 = __hip_bfloat16;
constexpr int   D = 128, NW = 8, QBLK = 32, KVBLK = 64;
constexpr float SCALE = 0.088388347648318440f;
constexpr float THR = 8.f;
constexpr int SDEPTH = 2;
constexpr int LDQ = 3072, LDK = 3072, LDO = 2048;
constexpr size_t SHM_V = KVBLK * D * 2, SHM_K = KVBLK * D * 2, SHM_ATTN = 2 * SHM_V + 2 * SHM_K + NW * 64 * 4;
using bf16x8 = __attribute__((ext_vector_type(8))) short;
using s16x4  = __attribute__((ext_vector_type(4))) short;
using f32x16 = __attribute__((ext_vector_type(16))) float;
using f32x8  = __attribute__((ext_vector_type(8))) float;
using u32x4  = __attribute__((ext_vector_type(4))) unsigned;
#define KSWZ(row, colB) ((row) * 256 + ((colB) ^ (((row) & 7) << 4)))
#define SBAR() __builtin_amdgcn_sched_barrier(0)
__device__ __forceinline__ int crow(int r, int hi) { return (r & 3) + 8 * (r >> 2) + 4 * hi; }
__device__ __forceinline__ unsigned cvtpk(float lo, float hi) {
  unsigned r; asm volatile("v_cvt_pk_bf16_f32 %0, %1, %2" : "=v"(r) : "v"(lo), "v"(hi)); return r;
}
template <typename TIn> struct Stage;
template <> struct Stage<bf16>  { using T = bf16x8;
  __device__ static __forceinline__ T ld8(const bf16* p) { return *reinterpret_cast<const bf16x8*>(p); }
  __device__ static __forceinline__ bf16x8 tobf(T x) { return x; } };
template <> struct Stage<float> { using T = f32x8;
  __device__ static __forceinline__ T ld8(const float* p) { return *reinterpret_cast<const f32x8*>(p); }
  __device__ static __forceinline__ bf16x8 tobf(T x) {
    u32x4 w = {cvtpk(x[0], x[1]), cvtpk(x[2], x[3]), cvtpk(x[4], x[5]), cvtpk(x[6], x[7])}; return *reinterpret_cast<bf16x8*>(&w); } };

__device__ __forceinline__ void partialSM(f32x16& p0, f32x16& p1, float& m_reg, float& mn, float& alpha) {
  constexpr float C = SCALE * 1.4426950408889634f;
  float pmax = p0[0]; for (int r = 1; r < 16; ++r) pmax = fmaxf(pmax, p0[r]); for (int r = 0; r < 16; ++r) pmax = fmaxf(pmax, p1[r]);
  { auto rr = __builtin_amdgcn_permlane32_swap(__float_as_uint(pmax), __float_as_uint(pmax), false, false);
    pmax = fmaxf(__uint_as_float(rr[0]), __uint_as_float(rr[1])); }
  if (__builtin_expect(__all(pmax - m_reg <= THR / SCALE), 1)) { mn = m_reg; alpha = 1.f; }
  else { mn = fmaxf(m_reg, pmax); alpha = __builtin_amdgcn_exp2f((m_reg - mn) * C); m_reg = mn; }
  float mnC = -mn * C;
  for (int r = 0; r < 16; ++r) p0[r] = fmaf(p0[r], C, mnC); for (int r = 0; r < 16; ++r) p1[r] = fmaf(p1[r], C, mnC);
  for (int r = 0; r < 16; ++r) p0[r] = __builtin_amdgcn_exp2f(p0[r]);
}
__device__ __forceinline__ void finishSM(f32x16& p0, f32x16& p1, float alpha, float& l_reg, bf16x8& pa0, bf16x8& pa1, bf16x8& pa2, bf16x8& pa3) {
  for (int r = 0; r < 16; ++r) p1[r] = __builtin_amdgcn_exp2f(p1[r]);
  float ps = 0; for (int r = 0; r < 16; ++r) ps += p0[r]; for (int r = 0; r < 16; ++r) ps += p1[r];
  { auto rr = __builtin_amdgcn_permlane32_swap(__float_as_uint(ps), __float_as_uint(ps), false, false);
    ps = __uint_as_float(rr[0]) + __uint_as_float(rr[1]); }
  l_reg = l_reg * alpha + ps;
#define PK4(P, BASE, OUT) do { unsigned a0 = cvtpk(P[BASE + 0], P[BASE + 1]), a1 = cvtpk(P[BASE + 2], P[BASE + 3]);   \
    unsigned b0 = cvtpk(P[BASE + 4], P[BASE + 5]), b1 = cvtpk(P[BASE + 6], P[BASE + 7]);                              \
    auto r0 = __builtin_amdgcn_permlane32_swap(a0, b0, false, false); auto r1 = __builtin_amdgcn_permlane32_swap(a1, b1, false, false); \
    u32x4 w = {r0[0], r1[0], r0[1], r1[1]}; OUT = *reinterpret_cast<bf16x8*>(&w); } while (0)
  PK4(p0, 0, pa0); PK4(p0, 8, pa1); PK4(p1, 0, pa2); PK4(p1, 8, pa3);
#undef PK4
}
__device__ __forceinline__ void qkt(f32x16& p0, f32x16& p1, const bf16* Ks, const bf16x8* qr, int r32, int hi) {
  p0 = f32x16{}; p1 = f32x16{};
  for (int d0 = 0; d0 < 8; ++d0) { int cb = (d0 * 16 + hi * 8) * 2;
    bf16x8 b0 = *reinterpret_cast<const bf16x8*>((const char*)Ks + KSWZ(r32, cb));
    bf16x8 b1 = *reinterpret_cast<const bf16x8*>((const char*)Ks + KSWZ(32 + r32, cb));
    p0 = __builtin_amdgcn_mfma_f32_32x32x16_bf16(b0, qr[d0], p0, 0, 0, 0);
    p1 = __builtin_amdgcn_mfma_f32_32x32x16_bf16(b1, qr[d0], p1, 0, 0, 0); }
}
__device__ __forceinline__ int v_st(int k, int c) { const int kk = (k & ~0xC) | ((k & 4) << 1) | ((k & 8) >> 1); return ((kk >> 3) * 4 + (c >> 5)) * 512 + ((kk & 7) * 32 + (c & 31)) * 2; }
__device__ __forceinline__ int v_rd_base(int lane) { return ((lane & 3) << 3) | (((lane >> 2) & 3) << 6) | (((lane >> 4) & 1) << 5) | (((lane >> 5) & 1) << 8); }
constexpr int v_rd_off(int d0, int ks, int half) { return d0 * 512 + ks * 4096 + half * 2048; }
template <int OFF> __device__ __forceinline__ s16x4 tr_read(int vb) {
  s16x4 r; asm volatile("ds_read_b64_tr_b16 %0, %1 offset:%2" : "=&v"(r) : "v"(vb), "i"(OFF) : "memory"); return r;
}
template <int D0> __device__ __forceinline__ void pv_one(f32x16& od, int vb, bf16x8 pa0, bf16x8 pa1, bf16x8 pa2, bf16x8 pa3) {
  const s16x4 l0 = tr_read<v_rd_off(D0, 0, 0)>(vb), h0 = tr_read<v_rd_off(D0, 0, 1)>(vb), l1 = tr_read<v_rd_off(D0, 1, 0)>(vb), h1 = tr_read<v_rd_off(D0, 1, 1)>(vb);
  const s16x4 l2 = tr_read<v_rd_off(D0, 2, 0)>(vb), h2 = tr_read<v_rd_off(D0, 2, 1)>(vb), l3 = tr_read<v_rd_off(D0, 3, 0)>(vb), h3 = tr_read<v_rd_off(D0, 3, 1)>(vb);
  asm volatile("s_waitcnt lgkmcnt(0)" ::: "memory"); SBAR();
#define PK(L, H) (bf16x8){L[0], L[1], L[2], L[3], H[0], H[1], H[2], H[3]}
  od = __builtin_amdgcn_mfma_f32_32x32x16_bf16(pa0, PK(l0, h0), od, 0, 0, 0);
  od = __builtin_amdgcn_mfma_f32_32x32x16_bf16(pa1, PK(l1, h1), od, 0, 0, 0);
  od = __builtin_amdgcn_mfma_f32_32x32x16_bf16(pa2, PK(l2, h2), od, 0, 0, 0);
  od = __builtin_amdgcn_mfma_f32_32x32x16_bf16(pa3, PK(l3, h3), od, 0, 0, 0);
#undef PK
}
__device__ __forceinline__ void pv_d0(f32x16* o, int vb, bf16x8 pa0, bf16x8 pa1, bf16x8 pa2, bf16x8 pa3) {
  pv_one<0>(o[0], vb, pa0, pa1, pa2, pa3); pv_one<1>(o[1], vb, pa0, pa1, pa2, pa3); pv_one<2>(o[2], vb, pa0, pa1, pa2, pa3); pv_one<3>(o[3], vb, pa0, pa1, pa2, pa3);
}

template <typename TQ>
__device__ __forceinline__ void attn_dense_body(const TQ* __restrict__ Qb, const bf16* __restrict__ Kh, const bf16* __restrict__ Vh,
                                                unsigned short* __restrict__ Ob, int seq, char* lds) {
  using St = Stage<bf16>; using SQ = Stage<TQ>;
  const int tid = mk_tid(), wid = tid >> 6, lane = tid & 63, r32 = lane & 31, hi = lane >> 5;
  bf16* V_lds = (bf16*)lds; bf16* K_lds = (bf16*)(lds + 2 * SHM_V);
  float* ws = (float*)(lds + 2 * SHM_V + 2 * SHM_K) + wid * 64; float* li_l = ws; float* al_l = ws + 32;
  float m_reg = -1e30f, l_reg = 0; f32x16 o[4] = {}; bf16x8 qr[8];
  const TQ* Qw = Qb + (long)(wid * QBLK + r32) * LDQ + hi * 8;
#pragma unroll
  for (int d0 = 0; d0 < 8; ++d0) qr[d0] = SQ::tobf(SQ::ld8(Qw + d0 * 16));
  const int sr = tid >> 4, sc = (tid & 15) * 8, vst0 = v_st(sr, sc), vst1 = v_st(32 + sr, sc);
  const int vb0 = (int)(uintptr_t)V_lds + v_rd_base(lane);
  struct { typename St::T vs0, vs1, ks0, ks1; } sr_[SDEPTH];
#define SLOAD(i, k0) do { sr_[i].vs0 = St::ld8(&Vh[(long)((k0) + sr) * LDK + sc]); sr_[i].vs1 = St::ld8(&Vh[(long)((k0) + 32 + sr) * LDK + sc]); \
    sr_[i].ks0 = St::ld8(&Kh[(long)((k0) + sr) * LDK + sc]); sr_[i].ks1 = St::ld8(&Kh[(long)((k0) + 32 + sr) * LDK + sc]); } while (0)
#define SWRITE(b, i) do { *(bf16x8*)((char*)V_lds + (b) * SHM_V + vst0) = St::tobf(sr_[i].vs0);          \
    *(bf16x8*)((char*)V_lds + (b) * SHM_V + vst1) = St::tobf(sr_[i].vs1); int kc = sc * 2;               \
    *(bf16x8*)((char*)K_lds + (b) * SHM_K + KSWZ(sr, kc)) = St::tobf(sr_[i].ks0);                       \
    *(bf16x8*)((char*)K_lds + (b) * SHM_K + KSWZ(32 + sr, kc)) = St::tobf(sr_[i].ks1); } while (0)
#define SWAIT() do { if constexpr (SDEPTH == 2) asm volatile("s_waitcnt vmcnt(4)" ::: "memory"); else asm volatile("s_waitcnt vmcnt(0)" ::: "memory"); } while (0)
#define RESC(a) do { if (__any((a) < 1.f)) { if (hi == 0) al_l[r32] = (a); asm volatile("s_waitcnt lgkmcnt(0)" ::: "memory"); \
    for (int d = 0; d < 4; ++d) for (int r = 0; r < 16; ++r) o[d][r] *= al_l[crow(r, hi)]; } } while (0)
  f32x16 pA0, pA1, pB0, pB1; float mnA, mnB, alA, alB; bf16x8 pa0, pa1, pa2, pa3; const int NT = seq / KVBLK;
  constexpr int SE = 0, SO = SDEPTH - 1;
  SLOAD(SE, 0); asm volatile("s_waitcnt vmcnt(0)" ::: "memory"); SWRITE(0, SE); __syncthreads();
  qkt(pA0, pA1, K_lds, qr, r32, hi); partialSM(pA0, pA1, m_reg, mnA, alA);
  SLOAD(SO, KVBLK); if constexpr (SDEPTH == 2) { if (2 < NT) SLOAD(SE, 2 * KVBLK); }
  SWAIT(); SWRITE(1, SO); __syncthreads();
  for (int j = 1; j + 1 < NT; j += 2) {
    SBAR(); qkt(pB0, pB1, (bf16*)((char*)K_lds + SHM_K), qr, r32, hi);
    finishSM(pA0, pA1, alA, l_reg, pa0, pa1, pa2, pa3); SBAR();
    SLOAD(SO, (j + SDEPTH) * KVBLK); SBAR();
    pv_d0(o, vb0, pa0, pa1, pa2, pa3); partialSM(pB0, pB1, m_reg, mnB, alB);
    __syncthreads(); SWAIT(); SWRITE(0, SE);
    RESC(alB); __syncthreads();
    SBAR(); qkt(pA0, pA1, K_lds, qr, r32, hi);
    finishSM(pB0, pB1, alB, l_reg, pa0, pa1, pa2, pa3); SBAR();
    if (SDEPTH == 1 || j + 3 < NT) SLOAD(SE, (j + 1 + SDEPTH) * KVBLK); SBAR();
    pv_d0(o, vb0 + (int)SHM_V, pa0, pa1, pa2, pa3); partialSM(pA0, pA1, m_reg, mnA, alA);
    __syncthreads(); SWAIT(); SWRITE(1, SO);
    RESC(alA); __syncthreads();
  }
  SBAR(); qkt(pB0, pB1, (bf16*)((char*)K_lds + SHM_K), qr, r32, hi);
  finishSM(pA0, pA1, alA, l_reg, pa0, pa1, pa2, pa3); SBAR();
  pv_d0(o, vb0, pa0, pa1, pa2, pa3); partialSM(pB0, pB1, m_reg, mnB, alB);
  __syncthreads(); RESC(alB);
  finishSM(pB0, pB1, alB, l_reg, pa0, pa1, pa2, pa3); SBAR();
  pv_d0(o, vb0 + (int)SHM_V, pa0, pa1, pa2, pa3);
  if (hi == 0) li_l[r32] = l_reg; asm volatile("s_waitcnt lgkmcnt(0)" ::: "memory");
  float rli[16];
#pragma unroll
  for (int r = 0; r < 16; ++r) rli[r] = __builtin_amdgcn_rcpf(li_l[crow(r, hi)]);
  unsigned short* Ow = Ob + (long)(wid * QBLK) * LDO;
#pragma unroll
  for (int r = 0; r < 16; ++r) { int orow = crow(r, hi);
    for (int d0 = 0; d0 < 4; ++d0) Ow[(long)orow * LDO + d0 * 32 + r32] = (unsigned short)(cvtpk(o[d0][r] * rli[r], 0.f) & 0xffffu); }
#undef SLOAD
#undef SWRITE
#undef SWAIT
#undef RESC
}

}
__device__ __forceinline__ int mk_tid() { int t = threadIdx.x; asm volatile("" : "+v"(t)); return t; }
namespace mk {
#define LAS __attribute__((address_space(3)))
typedef unsigned short bf16;
typedef short bf16x8 __attribute__((ext_vector_type(8)));
typedef float f32x4 __attribute__((ext_vector_type(4)));
typedef unsigned u32x4 __attribute__((ext_vector_type(4)));
typedef unsigned u32x2 __attribute__((ext_vector_type(2)));

constexpr int D = 2048, M = 8192, SEQ = 4096, NW = 8;
constexpr int ABW = 3072, CW = 8224, FF2 = 11264, FF = 5632;
constexpr float EPS = 1e-6f;
constexpr size_t MiB = 1u << 20;
constexpr size_t WS_AB = 0, WS_BD = 12 * MiB, WS_OAB = 13 * MiB, WS_C = 21 * MiB  , WS_OC = 54 * MiB;
constexpr size_t WS_UP0 = 62 * MiB, WS_UP1 = 106 * MiB, WS_DN0 = 150 * MiB, WS_DN1 = 172 * MiB;
constexpr size_t WS_XN = 194 * MiB, WS_GATES = 226 * MiB, WS_S = 228 * MiB;
constexpr size_t WS_PROJ = WS_S, WS_POOLED = WS_S + 48 * MiB, WS_CAT = WS_S + 56 * MiB;
constexpr size_t WS_QK = WS_S, WS_OG = WS_S + 64 * MiB, WS_KVT = WS_S + 96 * MiB, WS_HF = WS_S + 160 * MiB, WS_Y = WS_S + 288 * MiB;
constexpr size_t WS_U = WS_S, WS_ACT = WS_S + 176 * MiB;
constexpr size_t WS_END = WS_S + 320 * MiB;
constexpr int LDS_BYTES = 154112;

#define LDSWAIT() asm volatile("s_waitcnt lgkmcnt(0)" ::: "memory")
__device__ __forceinline__ unsigned f2bf(float f) { unsigned u = __float_as_uint(f); return (u + 0x7fffu + ((u >> 16) & 1u)) >> 16; }
__device__ __forceinline__ unsigned pk2(float lo, float hi) { unsigned r; asm volatile("v_cvt_pk_bf16_f32 %0, %1, %2" : "=v"(r) : "v"(lo), "v"(hi)); return r; }
__device__ __forceinline__ float bflo(unsigned w) { return __uint_as_float(w << 16); }
__device__ __forceinline__ float bfhi(unsigned w) { return __uint_as_float(w & 0xffff0000u); }
__device__ __forceinline__ float wave_sum(float v) {
#pragma unroll
    for (int o = 1; o < 64; o <<= 1) v += __shfl_xor(v, o);
    return v;
}

__device__ __forceinline__ void transpose_item64(const float* __restrict__ W, int ldw, int K, int nblk, bf16* __restrict__ WT, LAS float* scr, int item, int lane) {
    const int kb = item / nblk, nb = item - kb * nblk, k0 = 64 * kb, n0 = 64 * nb;
    f32x4 v[16];
#pragma unroll
    for (int i = 0; i < 16; ++i) { const int kk = 4 * i + (lane >> 4); v[i] = *(const f32x4*)(W + (size_t)(k0 + kk) * ldw + n0 + 4 * (lane & 15)); }
#pragma unroll
    for (int i = 0; i < 16; ++i) { const int kk = 4 * i + (lane >> 4); LAS float* s = scr + kk * 65 + 4 * (lane & 15); s[0] = v[i].x; s[1] = v[i].y; s[2] = v[i].z; s[3] = v[i].w; }
    LDSWAIT();
    const int c = lane & 7, q = lane >> 3;
#pragma unroll
    for (int j = 0; j < 8; ++j) { const int n = q + 8 * j; const LAS float* s = scr + (8 * c) * 65 + n;
        u32x4 o; o.x = pk2(s[0], s[65]); o.y = pk2(s[130], s[195]); o.z = pk2(s[260], s[325]); o.w = pk2(s[390], s[455]);
        *(u32x4*)(WT + (size_t)(n0 + n) * K + k0 + 8 * c) = o; }
    LDSWAIT();
}

__device__ __forceinline__ void rmsnorm_rows(const float* __restrict__ src, const float* __restrict__ gain, bf16* __restrict__ dst, int gw, int ngw, int lane) {
    f32x4 g[8];
#pragma unroll
    for (int j = 0; j < 8; ++j) g[j] = *(const f32x4*)(gain + 4 * lane + 256 * j);
    for (int m = gw; m < M; m += ngw) {
        const f32x4* xr = (const f32x4*)(src + (size_t)m * D) + lane; f32x4 v[8]; float s = 0.f;
#pragma unroll
        for (int j = 0; j < 8; ++j) { v[j] = xr[64 * j]; s += (v[j].x * v[j].x + v[j].y * v[j].y) + (v[j].z * v[j].z + v[j].w * v[j].w); }
        const float rstd = 1.0f / sqrtf(wave_sum(s) * (1.0f / D) + EPS);
        u32x2* o = (u32x2*)(dst + (size_t)m * D) + lane;
#pragma unroll
        for (int j = 0; j < 8; ++j) { u32x2 w; w.x = pk2(v[j].x * rstd * g[j].x, v[j].y * rstd * g[j].y); w.y = pk2(v[j].z * rstd * g[j].z, v[j].w * rstd * g[j].w); o[64 * j] = w; }
    }
}

struct In { const float *x, *norm_mix, *norm_ffn, *w_in_ab, *pool_w, *pool_scale, *q_norm, *k_norm, *w_out_ab, *w_in_c, *b_gate, *h_norm, *w_out_c, *w_up, *conv_w, *conv_b, *w_down; };

__device__ __forceinline__ void prologue(const In& I, unsigned char* ws, LAS unsigned char* lds, int gw, int ngw, int wave, int lane) {
    LAS float* scr = (LAS float*)(lds + wave * 16640);
    for (int it = gw; it < 24576; it += ngw) {
        const float* W; int ldw, K, nblk; bf16* WT; int r = it;
        if (r < 1536) { W = I.w_in_ab; ldw = ABW; K = D; nblk = 48; WT = (bf16*)(ws + WS_AB); }
        else if (r < 2560) { r -= 1536; W = I.w_out_ab; ldw = D; K = D; nblk = 32; WT = (bf16*)(ws + WS_OAB); }
        else if (r < 6656) { r -= 2560; W = I.w_in_c; ldw = CW; K = D; nblk = 128; WT = (bf16*)(ws + WS_C); }
        else if (r < 7680) { r -= 6656; W = I.w_out_c; ldw = D; K = D; nblk = 32; WT = (bf16*)(ws + WS_OC); }
        else if (r < 13312) { r -= 7680; W = I.w_up; ldw = FF2; K = D; nblk = 176; WT = (bf16*)(ws + WS_UP0); }
        else if (r < 18944) { r -= 13312; W = I.w_up + (size_t)D * FF2; ldw = FF2; K = D; nblk = 176; WT = (bf16*)(ws + WS_UP1); }
        else if (r < 21760) { r -= 18944; W = I.w_down; ldw = D; K = FF; nblk = 32; WT = (bf16*)(ws + WS_DN0); }
        else { r -= 21760; W = I.w_down + (size_t)FF * D; ldw = D; K = FF; nblk = 32; WT = (bf16*)(ws + WS_DN1); }
        transpose_item64(W, ldw, K, nblk, WT, scr, r, lane);
    }
    const int gt = gw * 64 + lane, ngt = ngw * 64;
    { bf16* WG = (bf16*)(ws + WS_C) + (size_t)8192 * D;
      for (int idx = gt; idx < 32 * D; idx += ngt) { const int j = idx >> 11, k = idx & 2047; WG[idx] = (bf16)f2bf(I.w_in_c[(size_t)k * CW + 8192 + j]); } }
    { bf16* BD = (bf16*)(ws + WS_BD);
      for (int idx = gt; idx < 512 * 512; idx += ngt) { const int n = idx >> 9, k = idx & 511, gn = n >> 7, gk = k >> 7;
          const float v = (gn == gk) ? I.pool_w[(size_t)(gn * 128 + (k & 127)) * 128 + (n & 127)] * I.pool_scale[n] : 0.f; BD[idx] = (bf16)f2bf(v); } }
    rmsnorm_rows(I.x, I.norm_mix, (bf16*)(ws + WS_XN), gw, ngw, lane);
}

__device__ __forceinline__ void qk_rope_pool(bf16* __restrict__ PROJ, const float* __restrict__ qn, const float* __restrict__ kn, bf16* __restrict__ POOLED, int gw, int ngw, int lane) {
    const int l = lane & 31, hsel = lane >> 5, part = (l >> 4) & 1; const bool first = (l & 8) == 0;
    float inv[4];
#pragma unroll
    for (int e = 0; e < 4; ++e) inv[e] = exp2f(-(float)(4 * (l & 7) + e) * (13.287712379549449f / 32.0f));
    const f32x4 gq = *(const f32x4*)(qn + 4 * l), gk = *(const f32x4*)(kn + 4 * l);
    for (int it = gw; it < M * 8; it += ngw) {
        const int t = it >> 3, hh = (it & 7) * 2 + hsel;
        bf16* p = PROJ + (size_t)t * ABW + 512 + hh * 128 + 4 * l;
        const u32x2 w = *(const u32x2*)p;
        float x[4] = {bflo(w.x), bfhi(w.x), bflo(w.y), bfhi(w.y)};
        float ss = (x[0] * x[0] + x[1] * x[1]) + (x[2] * x[2] + x[3] * x[3]);
#pragma unroll
        for (int o = 1; o < 32; o <<= 1) ss += __shfl_xor(ss, o);
        const float rstd = 1.0f / sqrtf(ss * (1.0f / 128.0f) + EPS);
        const f32x4 g = (hh < 12) ? gq : gk;
        const int pos = t & (SEQ - 1); const float pp = part ? (float)(pos & 63) : (float)(pos >> 6);
        float y[4] = {x[0] * rstd * g.x, x[1] * rstd * g.y, x[2] * rstd * g.z, x[3] * rstd * g.w}, o4[4];
#pragma unroll
        for (int e = 0; e < 4; ++e) { const float yp = __shfl_xor(y[e], 8); const float ang = pp * inv[e]; const float sn = __sinf(ang), cs = __cosf(ang);
            o4[e] = y[e] * cs + (first ? -yp : yp) * sn; }
        u32x2 ow; ow.x = pk2(o4[0], o4[1]); ow.y = pk2(o4[2], o4[3]); *(u32x2*)p = ow;
    }
    const int gt = gw * 64 + lane, ngt = ngw * 64;
    for (int it = gt; it < M * 64; it += ngt) {
        const int t = it >> 6, c8 = (it & 63) * 8, g = c8 >> 7, w2 = 1 << g, pos = t & (SEQ - 1), base = t - pos;
        const int lo = max(pos - w2, 0), hi = min(pos + w2, SEQ);
        float acc[8] = {0.f, 0.f, 0.f, 0.f, 0.f, 0.f, 0.f, 0.f};
        for (int pz = lo; pz < hi; ++pz) { const u32x4 v = *(const u32x4*)(PROJ + (size_t)(base + pz) * ABW + c8);
            acc[0] += bflo(v.x); acc[1] += bfhi(v.x); acc[2] += bflo(v.y); acc[3] += bfhi(v.y); acc[4] += bflo(v.z); acc[5] += bfhi(v.z); acc[6] += bflo(v.w); acc[7] += bfhi(v.w); }
        const u32x4 sv = *(const u32x4*)(PROJ + (size_t)t * ABW + c8); const float iv = 1.0f / (float)(hi - lo);
        u32x4 o; o.x = pk2(acc[0] * iv - bflo(sv.x), acc[1] * iv - bfhi(sv.x)); o.y = pk2(acc[2] * iv - bflo(sv.y), acc[3] * iv - bfhi(sv.y));
        o.z = pk2(acc[4] * iv - bflo(sv.z), acc[5] * iv - bfhi(sv.z)); o.w = pk2(acc[6] * iv - bflo(sv.w), acc[7] * iv - bfhi(sv.w));
        *(u32x4*)(POOLED + (size_t)t * 512 + c8) = o;
    }
}

__device__ __forceinline__ void conv_act(const bf16* __restrict__ U, const float* __restrict__ cw, const float* __restrict__ cb, bf16* __restrict__ ACT, int gt, int ngt) {
    for (int it = gt; it < 1024 * 704; it += ngt) {
        const int jc = it % 704, tb = it / 704, j = jc * 8, t0 = tb * 8;
        float c0g[8], c1g[8], c2g[8], cbg[8], c0v[8], c1v[8], c2v[8], cbv[8];
#pragma unroll
        for (int e = 0; e < 8; e += 4) {
            const f32x4 a0 = *(const f32x4*)(cw + j + e), a1 = *(const f32x4*)(cw + FF2 + j + e), a2 = *(const f32x4*)(cw + 2 * FF2 + j + e), ab = *(const f32x4*)(cb + j + e);
            const f32x4 b0 = *(const f32x4*)(cw + FF + j + e), b1 = *(const f32x4*)(cw + FF2 + FF + j + e), b2 = *(const f32x4*)(cw + 2 * FF2 + FF + j + e), bb = *(const f32x4*)(cb + FF + j + e);
#pragma unroll
            for (int q = 0; q < 4; ++q) { c0g[e + q] = a0[q]; c1g[e + q] = a1[q]; c2g[e + q] = a2[q]; cbg[e + q] = ab[q]; c0v[e + q] = b0[q]; c1v[e + q] = b1[q]; c2v[e + q] = b2[q]; cbv[e + q] = bb[q]; }
        }
        for (int tt = 0; tt < 8; ++tt) {
            const int t = t0 + tt, pos = t & (SEQ - 1);
            const bf16* r1 = U + (size_t)t * FF2 + j;
            const u32x4 z = {0u, 0u, 0u, 0u};
            const u32x4 g1 = *(const u32x4*)r1, v1 = *(const u32x4*)(r1 + FF);
            const u32x4 g0 = pos > 0 ? *(const u32x4*)(r1 - FF2) : z, v0 = pos > 0 ? *(const u32x4*)(r1 - FF2 + FF) : z;
            const u32x4 g2 = pos < SEQ - 1 ? *(const u32x4*)(r1 + FF2) : z, v2 = pos < SEQ - 1 ? *(const u32x4*)(r1 + FF2 + FF) : z;
            float o[8];
#pragma unroll
            for (int q = 0; q < 4; ++q) {
                const float ga = c0g[2 * q] * bflo(g0[q]) + c1g[2 * q] * bflo(g1[q]) + c2g[2 * q] * bflo(g2[q]) + cbg[2 * q];
                const float gb = c0g[2 * q + 1] * bfhi(g0[q]) + c1g[2 * q + 1] * bfhi(g1[q]) + c2g[2 * q + 1] * bfhi(g2[q]) + cbg[2 * q + 1];
                const float va = c0v[2 * q] * bflo(v0[q]) + c1v[2 * q] * bflo(v1[q]) + c2v[2 * q] * bflo(v2[q]) + cbv[2 * q];
                const float vb = c0v[2 * q + 1] * bfhi(v0[q]) + c1v[2 * q + 1] * bfhi(v1[q]) + c2v[2 * q + 1] * bfhi(v2[q]) + cbv[2 * q + 1];
                o[2 * q] = ga / (1.0f + __expf(-ga)) * va; o[2 * q + 1] = gb / (1.0f + __expf(-gb)) * vb;
            }
            u32x4 ow; ow.x = pk2(o[0], o[1]); ow.y = pk2(o[2], o[3]); ow.z = pk2(o[4], o[5]); ow.w = pk2(o[6], o[7]);
            *(u32x4*)(ACT + (size_t)t * FF + j) = ow;
        }
    }
}

__device__ __forceinline__ void gates_phase(const bf16* __restrict__ XN, const bf16* __restrict__ WG, const float* __restrict__ bg, float* __restrict__ GATES, LAS float* red, int bid, int nblk) {
    const int tid = mk_tid(), wid = tid >> 6, lane = tid & 63, fr = lane & 15, fq = lane >> 4;
    const int tile = wid & 3, tt = tile & 1, jt = tile >> 1, kh = wid >> 2;
    for (int grp = bid; grp < 256; grp += nblk) {
        f32x4 acc = {0.f, 0.f, 0.f, 0.f};
        const bf16* ap = WG + (size_t)(jt * 16 + fr) * D + kh * 1024 + fq * 8;
        const bf16* bp = XN + (size_t)(grp * 32 + tt * 16 + fr) * D + kh * 1024 + fq * 8;
#pragma unroll 8
        for (int ks = 0; ks < 32; ++ks) { const bf16x8 a = *(const bf16x8*)(ap + ks * 32), b = *(const bf16x8*)(bp + ks * 32); acc = __builtin_amdgcn_mfma_f32_16x16x32_bf16(a, b, acc, 0, 0, 0); }
        if (kh == 1) { LAS float* r = red + (tile * 64 + lane) * 4; r[0] = acc[0]; r[1] = acc[1]; r[2] = acc[2]; r[3] = acc[3]; }
        __syncthreads();
        if (kh == 0) { const LAS float* r = red + (tile * 64 + lane) * 4; const int t = grp * 32 + tt * 16 + fr, j = jt * 16 + 4 * fq;
            const f32x4 b4 = *(const f32x4*)(bg + j); f32x4 o; o.x = acc[0] + r[0] + b4.x; o.y = acc[1] + r[1] + b4.y; o.z = acc[2] + r[2] + b4.z; o.w = acc[3] + r[3] + b4.w;
            *(f32x4*)(GATES + (size_t)t * 32 + j) = o; }
        __syncthreads();
    }
}

__device__ __forceinline__ void headnorm_phase(const float* __restrict__ HF, const bf16* __restrict__ OG, const float* __restrict__ hn, bf16* __restrict__ Y, int gw, int ngw, int lane) {
    for (int it = gw; it < M * 8; it += ngw) {
        const int t = it >> 3, h = it & 7; const size_t off = (size_t)t * D + h * 256 + 4 * lane;
        const f32x4 a = *(const f32x4*)(HF + off), b = *(const f32x4*)(HF + (size_t)M * D + off); const f32x4 s = a + b;
        const float ss = wave_sum((s.x * s.x + s.y * s.y) + (s.z * s.z + s.w * s.w));
        const float rstd = 1.0f / sqrtf(ss * (1.0f / 256.0f) + EPS);
        const f32x4 g = *(const f32x4*)(hn + h * 256 + 4 * lane); const u32x2 ow = *(const u32x2*)(OG + off);
        const float o0 = bflo(ow.x), o1 = bfhi(ow.x), o2 = bflo(ow.y), o3 = bfhi(ow.y);
        u32x2 w; w.x = pk2(s.x * rstd * g.x / (1.0f + __expf(-o0)), s.y * rstd * g.y / (1.0f + __expf(-o1)));
        w.y = pk2(s.z * rstd * g.z / (1.0f + __expf(-o2)), s.w * rstd * g.w / (1.0f + __expf(-o3)));
        *(u32x2*)(Y + off) = w;
    }
}

namespace ml {
constexpr int LQ = 264, LS = 72;
constexpr int OFF_Q = 0, OFF_K = 33792, OFF_KT = 67584, OFF_VT = 104448, OFF_VTW = 111360, OFF_P = 118272, OFF_CT = 127488, OFF_SC = 152832;
static_assert(OFF_SC + 1280 == LDS_BYTES, "mlstm lds map");
#define ML_BAR() do { asm volatile("s_waitcnt lgkmcnt(0)" ::: "memory"); __builtin_amdgcn_s_barrier(); asm volatile("" ::: "memory"); } while (0)
#define ML_MFMA(a, b, c) __builtin_amdgcn_mfma_f32_16x16x32_bf16(a, b, c, 0, 0, 0)

__device__ __forceinline__ void mlstm_phase(LAS unsigned char* lds, const bf16* __restrict__ QK, const bf16* __restrict__ KVT, const float* __restrict__ GATES, float* __restrict__ HF, int bid, int nblk) {
    const int tid = mk_tid(), wid = tid >> 6, lane = tid & 63, fr = lane & 15, fq = lane >> 4;
    LAS bf16* Qs = (LAS bf16*)(lds + OFF_Q); LAS bf16* Ks = (LAS bf16*)(lds + OFF_K); LAS bf16* KTs = (LAS bf16*)(lds + OFF_KT);
    LAS bf16* VTs = (LAS bf16*)(lds + OFF_VT); LAS bf16* VTw = (LAS bf16*)(lds + OFF_VTW); LAS bf16* Ps = (LAS bf16*)(lds + OFF_P); LAS bf16* CTs = (LAS bf16*)(lds + OFF_CT);
    LAS float* sA = (LAS float*)(lds + OFF_SC); LAS float* sM = sA + 64; LAS float* sAI = sM + 64; LAS float* sEM = sAI + 64;
    const int tt = wid & 3, sh = wid >> 2;
    for (int it0 = bid; it0 < 256; it0 += nblk) {
        const int item = (nblk == 256) ? (((it0 & 7) * 4 + (it0 >> 6)) * 8 + ((it0 >> 3) & 7)) : it0;
        const int es = item & 7, dir = (item >> 3) & 1, h = (item >> 4) & 7, b = (item >> 7) & 1;
        for (int i = tid; i < 48 * LQ / 2; i += 512) ((LAS unsigned*)CTs)[i] = 0u;
        for (int i = tid; i < 16 * LS; i += 512) { VTs[32 * LS + i] = (i < LS) ? (bf16)0x3F80 : (bf16)0; VTw[32 * LS + i] = (bf16)0; }
        f32x4 ct[2][3];
#pragma unroll
        for (int a = 0; a < 2; ++a)
#pragma unroll
            for (int e = 0; e < 3; ++e) ct[a][e] = (f32x4){0.f, 0.f, 0.f, 0.f};
        float m_st = 0.f, decay = 1.f;
        bf16x8 rq[4], rk[4], rkt[4], rvt = {0, 0, 0, 0, 0, 0, 0, 0}; float gi = 0.f, gf = 0.f;
        const unsigned voffQ = (unsigned)(((tid >> 5) * 4096 + (tid & 31) * 8) * 2), voffT = (unsigned)(((tid >> 3) * M + (tid & 7) * 8) * 2), voffG = (unsigned)((dir ? 63 - lane : lane) * 128);
#define ML_LOAD(c) do { const int ncn_ = dir ? 63 - (c) : (c); const size_t trow_ = (size_t)b * SEQ + (size_t)ncn_ * 64; \
        const char* qb_ = (const char*)(QK + trow_ * 4096 + h * 256); \
        _Pragma("unroll") for (int i_ = 0; i_ < 4; ++i_) { rq[i_] = *(const bf16x8*)(qb_ + (size_t)i_ * 131072 + voffQ); rk[i_] = *(const bf16x8*)(qb_ + 4096 + (size_t)i_ * 131072 + voffQ); } \
        const char* tb_ = (const char*)(KVT + (size_t)(h * 256) * M + trow_); \
        _Pragma("unroll") for (int i_ = 0; i_ < 4; ++i_) rkt[i_] = *(const bf16x8*)(tb_ + (size_t)i_ * (64 * M * 2) + voffT); \
        if (tid < 256) rvt = *(const bf16x8*)((const char*)(KVT + (size_t)(2048 + h * 256 + es * 32) * M + trow_) + voffT); \
        { const float* gp_ = GATES + trow_ * 32 + dir * 16 + h; gi = *(const float*)((const char*)gp_ + voffG); gf = *(const float*)((const char*)gp_ + 32 + voffG); } } while (0)
#define ML_STORE() do { \
        const float lf_ = fminf(gf, 0.f) - log1pf(__expf(-fabsf(gf))); float bc_ = lf_; \
        _Pragma("unroll") for (int o_ = 1; o_ < 64; o_ <<= 1) { const float t_ = __shfl_up(bc_, o_); if (lane >= o_) bc_ += t_; } \
        const float a_ = gi - bc_; float cm_ = a_; \
        _Pragma("unroll") for (int o_ = 1; o_ < 64; o_ <<= 1) { const float t_ = __shfl_up(cm_, o_); if (lane >= o_) cm_ = fmaxf(cm_, t_); } \
        const float Mv_ = fmaxf(m_st, cm_), blast_ = __shfl(bc_, 63), cml_ = __shfl(cm_, 63), Mn_ = fmaxf(m_st, cml_); \
        const float ai_ = __expf(m_st - Mv_), em_ = __expf(-(bc_ + Mv_)), wsv_ = __expf(a_ - Mn_); decay = __expf(m_st - Mn_); m_st = blast_ + Mn_; \
        const int rr_ = dir ? 63 - lane : lane; \
        if (wid == 0) { sA[rr_] = a_; sM[rr_] = Mv_; sAI[rr_] = ai_; sEM[rr_] = em_; VTw[32 * LS + rr_] = (bf16)f2bf(wsv_); } \
        _Pragma("unroll") for (int i_ = 0; i_ < 4; ++i_) { const int q_ = tid + 512 * i_, r_ = q_ >> 5, cc_ = (q_ & 31) * 8; \
            *(LAS bf16x8*)(Qs + r_ * LQ + cc_) = rq[i_]; *(LAS bf16x8*)(Ks + r_ * LQ + cc_) = rk[i_]; } \
        _Pragma("unroll") for (int i_ = 0; i_ < 4; ++i_) { const int q_ = tid + 512 * i_, d_ = q_ >> 3, cc_ = (q_ & 7) * 8; *(LAS bf16x8*)(KTs + d_ * LS + cc_) = rkt[i_]; } \
        if (tid < 256) { const int e_ = tid >> 3, cc_ = (tid & 7) * 8; *(LAS bf16x8*)(VTs + e_ * LS + cc_) = rvt; \
            float wv_[8]; _Pragma("unroll") for (int i_ = 0; i_ < 8; ++i_) { const int s_ = cc_ + i_; wv_[i_] = __shfl(wsv_, dir ? 63 - s_ : s_); } \
            const u32x4 rv_ = __builtin_bit_cast(u32x4, rvt); u32x4 o_; \
            o_.x = pk2(bflo(rv_.x) * wv_[0], bfhi(rv_.x) * wv_[1]); o_.y = pk2(bflo(rv_.y) * wv_[2], bfhi(rv_.y) * wv_[3]); \
            o_.z = pk2(bflo(rv_.z) * wv_[4], bfhi(rv_.z) * wv_[5]); o_.w = pk2(bflo(rv_.w) * wv_[6], bfhi(rv_.w) * wv_[7]); \
            *(LAS u32x4*)(VTw + e_ * LS + cc_) = o_; } } while (0)
        ML_LOAD(0);
        ML_BAR();
        ML_STORE();
        ML_BAR();
        ML_LOAD(1);
        for (int c = 0; c < 64; ++c) {
            const int ncn = dir ? 63 - c : c; const size_t trow = (size_t)b * SEQ + (size_t)ncn * 64;
            const float dec_c = decay;
            f32x4 s0 = {0.f, 0.f, 0.f, 0.f}, s1 = s0, n3 = s0, d3 = s0;
            {
                const LAS bf16* qp = Qs + (tt * 16 + fr) * LQ + fq * 8;
                const LAS bf16* kp0 = Ks + ((2 * sh) * 16 + fr) * LQ + fq * 8; const LAS bf16* kp1 = kp0 + 16 * LQ;
                const LAS bf16* cp0 = CTs + (sh * 16 + fr) * LQ + fq * 8; const LAS bf16* cp2 = CTs + (32 + fr) * LQ + fq * 8;
#pragma unroll
                for (int hf = 0; hf < 4; ++hf) {
                    bf16x8 qf[2], k0[2], k1[2], c0[2], c2[2];
#pragma unroll
                    for (int k4 = 0; k4 < 2; ++k4) { const int ko = (hf * 2 + k4) * 32;
                        qf[k4] = *(const LAS bf16x8*)(qp + ko); k0[k4] = *(const LAS bf16x8*)(kp0 + ko); k1[k4] = *(const LAS bf16x8*)(kp1 + ko);
                        c0[k4] = *(const LAS bf16x8*)(cp0 + ko); c2[k4] = *(const LAS bf16x8*)(cp2 + ko); }
                    __builtin_amdgcn_sched_barrier(0);
#pragma unroll
                    for (int k4 = 0; k4 < 2; ++k4) { s0 = ML_MFMA(k0[k4], qf[k4], s0); s1 = ML_MFMA(k1[k4], qf[k4], s1); n3 = ML_MFMA(c0[k4], qf[k4], n3); d3 = ML_MFMA(c2[k4], qf[k4], d3); }
                }
            }
            const int t = tt * 16 + fr; const float Mt = sM[t];
            {
                const int sb0 = (2 * sh) * 16 + 4 * fq, sb1 = sb0 + 16;
                const f32x4 a0 = *(const LAS f32x4*)(sA + sb0), a1 = *(const LAS f32x4*)(sA + sb1);
                float p0[4], p1[4];
#pragma unroll
                for (int r = 0; r < 4; ++r) {
                    const int sa = sb0 + r, sbb = sb1 + r;
                    const bool ok0 = dir ? (sa >= t) : (sa <= t), ok1 = dir ? (sbb >= t) : (sbb <= t);
                    p0[r] = ok0 ? s0[r] * __expf(a0[r] - Mt) : 0.f; p1[r] = ok1 ? s1[r] * __expf(a1[r] - Mt) : 0.f;
                }
                u32x2 w0, w1; w0.x = pk2(p0[0], p0[1]); w0.y = pk2(p0[2], p0[3]); w1.x = pk2(p1[0], p1[1]); w1.y = pk2(p1[2], p1[3]);
                *(LAS u32x2*)(Ps + t * LS + sb0) = w0; *(LAS u32x2*)(Ps + t * LS + sb1) = w1;
            }
            ML_BAR();
            f32x4 n2 = {0.f, 0.f, 0.f, 0.f}, d2 = n2, hout;
            bf16x8 kt[2][2], vw[2][3];
            {
                bf16x8 pf[2], v0[2], v2[2];
#pragma unroll
                for (int ks = 0; ks < 2; ++ks) { const int ko = ks * 32 + fq * 8;
                    pf[ks] = *(const LAS bf16x8*)(Ps + (tt * 16 + fr) * LS + ko); v0[ks] = *(const LAS bf16x8*)(VTs + (sh * 16 + fr) * LS + ko); v2[ks] = *(const LAS bf16x8*)(VTs + (32 + fr) * LS + ko); }
                __builtin_amdgcn_sched_barrier(0);
#pragma unroll
                for (int ks = 0; ks < 2; ++ks) { n2 = ML_MFMA(v0[ks], pf[ks], n2); d2 = ML_MFMA(v2[ks], pf[ks], d2); }
            }
#pragma unroll
            for (int ks = 0; ks < 2; ++ks) { const int ko = ks * 32 + fq * 8;
#pragma unroll
                for (int a = 0; a < 2; ++a) kt[ks][a] = *(const LAS bf16x8*)(KTs + ((2 * wid + a) * 16 + fr) * LS + ko);
#pragma unroll
                for (int e = 0; e < 3; ++e) vw[ks][e] = *(const LAS bf16x8*)(VTw + (e * 16 + fr) * LS + ko); }
            {
                const float ai = sAI[t], em = sEM[t];
                const float den0 = d2[0] + ai * d3[0];
                const float den = __shfl(den0, fr);
                const float rinv = 1.0f / fmaxf(fabsf(den), em);
                hout.x = (n2[0] + ai * n3[0]) * rinv; hout.y = (n2[1] + ai * n3[1]) * rinv; hout.z = (n2[2] + ai * n3[2]) * rinv; hout.w = (n2[3] + ai * n3[3]) * rinv;
            }
#pragma unroll
            for (int a = 0; a < 2; ++a)
#pragma unroll
                for (int e = 0; e < 3; ++e) ct[a][e] = ct[a][e] * dec_c;
#pragma unroll
            for (int ks = 0; ks < 2; ++ks)
#pragma unroll
                for (int a = 0; a < 2; ++a)
#pragma unroll
                    for (int e = 0; e < 3; ++e) ct[a][e] = ML_MFMA(kt[ks][a], vw[ks][e], ct[a][e]);
#pragma unroll
            for (int a = 0; a < 2; ++a)
#pragma unroll
                for (int e = 0; e < 3; ++e) { u32x2 w; w.x = f2bf(ct[a][e][0]) | (f2bf(ct[a][e][1]) << 16); w.y = f2bf(ct[a][e][2]) | (f2bf(ct[a][e][3]) << 16);
                    *(LAS u32x2*)(CTs + (e * 16 + fr) * LQ + (2 * wid + a) * 16 + 4 * fq) = w; }
            ML_BAR();
            if (c + 1 < 64) { ML_STORE(); }
            ML_BAR();
            *(f32x4*)(HF + ((size_t)dir * M + trow + t) * D + h * 256 + es * 32 + sh * 16 + 4 * fq) = hout;
            if (c + 2 < 64) { ML_LOAD(c + 2); }
        }
#undef ML_LOAD
#undef ML_STORE
    }
}
}
}

struct EpiRes {
    static constexpr bool PERM = false, AFTER_DRAIN = false;
    const float* base; float* out; int ldc;
    __device__ __forceinline__ void operator()(const pg8::f32x4 (&acc)[2][2][4][2], const pg8::Unit& u, int wr, int wc, int fr, int fq) const {
#pragma unroll
        for (int ai = 0; ai < 2; ++ai)
#pragma unroll
            for (int m = 0; m < 4; ++m) { const size_t ro = (size_t)(u.pm * 256 + ai * 128 + wr * 64 + m * 16 + fr) * ldc + u.pn * 256 + wc * 32 + 4 * fq;
#pragma unroll
                for (int bj = 0; bj < 2; ++bj)
#pragma unroll
                    for (int n = 0; n < 2; ++n) { const size_t off = ro + bj * 128 + n * 16; const pg8::f32x4 bs = *(const pg8::f32x4*)(base + off); *(pg8::f32x4*)(out + off) = bs + acc[ai][bj][m][n]; } }
    }
};

struct GemmDesc { const unsigned short* A; const unsigned short* Bt; int Mg, Ng, Kg; int kind; unsigned short* O; int ldc; int split_cols; float scale0; const float* base; float* out; int G, c; };

#ifndef REPEAT_PH
#define REPEAT_PH 1000
#define N_REPEAT 0
#else
#define N_REPEAT 1
#endif
struct Params { const float* in[17]; float* out; unsigned char* ws; int ph_lo, ph_hi; };
constexpr int N_PHASES = 18;

__global__ void __launch_bounds__(512, 2) fwd_mega(Params p) {
    extern __shared__ __attribute__((aligned(16))) unsigned char lds_raw[];
    using namespace mk;
    cg::grid_group grid = cg::this_grid();
    LAS unsigned char* lds = (LAS unsigned char*)lds_raw;
    const int bid = blockIdx.x, nblk = gridDim.x, ngw = nblk * NW, ngt = nblk * 512;
    const int ph_lo = p.ph_lo, ph_hi = p.ph_hi;
#ifdef PROBE_PH
    const unsigned long long t_start = __builtin_amdgcn_s_memrealtime();
#endif
#pragma unroll 1
    for (int ph_it = ph_lo; ph_it < ph_hi + N_REPEAT; ++ph_it) {
        const int ph = ph_it <= REPEAT_PH ? ph_it : ph_it - N_REPEAT;
        typedef const __attribute__((address_space(4))) Params* KP;
        KP kp = (KP)__builtin_amdgcn_kernarg_segment_ptr(); asm volatile("" : "+s"(kp));
        unsigned char* ws = kp->ws; float* OUT = kp->out; bf16* XN = (bf16*)(ws + WS_XN);
        In I; I.x = kp->in[0]; I.norm_mix = kp->in[1]; I.norm_ffn = kp->in[2]; I.w_in_ab = kp->in[3]; I.pool_w = kp->in[4]; I.pool_scale = kp->in[5]; I.q_norm = kp->in[6]; I.k_norm = kp->in[7];
        I.w_out_ab = kp->in[8]; I.w_in_c = kp->in[9]; I.b_gate = kp->in[10]; I.h_norm = kp->in[11]; I.w_out_c = kp->in[12]; I.w_up = kp->in[13]; I.conv_w = kp->in[14]; I.conv_b = kp->in[15]; I.w_down = kp->in[16];
        const int tid = mk_tid(), lane = tid & 63, wave = __builtin_amdgcn_readfirstlane(tid >> 6), gw = bid * NW + wave, gt = bid * 512 + tid;
#ifndef NO_THIN
        if (ph == 0) prologue(I, ws, lds, gw, ngw, wave, lane);
        if (ph == 5 || ph == 9 || ph == 14) rmsnorm_rows(OUT, ph == 5 ? I.norm_ffn : (ph == 9 ? I.norm_mix + D : I.norm_ffn + D), XN, gw, ngw, lane);
        if (ph == 2) qk_rope_pool((bf16*)(ws + WS_PROJ), I.q_norm, I.k_norm, (bf16*)(ws + WS_POOLED), gw, ngw, lane);
#endif
#ifndef NO_ATT
        if (ph == 3) {
            const bf16* PROJ = (const bf16*)(ws + WS_PROJ); bf16* CAT = (bf16*)(ws + WS_CAT);
            for (int u0 = bid; u0 < 384; u0 += nblk) {
                int u = u0;
                if (nblk == 256) { const int xcd = u0 & 7, j = (u0 >> 3) & 31, rnd = u0 >> 8; const int jj = j + 32 * rnd;
                    if (jj >= 48) continue; u = (xcd >> 2) * 192 + ((xcd & 3) * 3 + (jj >> 4)) * 16 + (jj & 15); }
                const int qb = u & 15, hq = (u >> 4) % 12, b = u / 192;
                const size_t r0 = (size_t)b * SEQ + (size_t)qb * 256;
                att::attn_dense_body<att::bf16>((const att::bf16*)(PROJ + r0 * ABW + 512 + hq * 128), (const att::bf16*)(PROJ + (size_t)b * SEQ * ABW + 2048 + (hq / 3) * 128),
                                                (const att::bf16*)(PROJ + (size_t)b * SEQ * ABW + 2560 + (hq / 3) * 128), CAT + r0 * D + 512 + hq * 128, SEQ, (char*)lds_raw);
                __syncthreads();
            }
        }
#endif
#ifndef NO_THIN
        if (ph == 7 || ph == 16) { const int l = ph == 7 ? 0 : 1; conv_act((const bf16*)(ws + WS_U), I.conv_w + (size_t)l * 3 * FF2, I.conv_b + (size_t)l * FF2, (bf16*)(ws + WS_ACT), gt, ngt); }
        if (ph == 10) gates_phase(XN, (const bf16*)(ws + WS_C) + (size_t)8192 * D, I.b_gate, (float*)(ws + WS_GATES), (LAS float*)lds, bid, nblk);
#endif
#ifndef NO_ML
        if (ph == 11) ml::mlstm_phase(lds, (const bf16*)(ws + WS_QK), (const bf16*)(ws + WS_KVT), (const float*)(ws + WS_GATES), (float*)(ws + WS_HF), bid, nblk);
#endif
#ifndef NO_THIN
        if (ph == 12) headnorm_phase((const float*)(ws + WS_HF), (const bf16*)(ws + WS_OG), I.h_norm, (bf16*)(ws + WS_Y), gw, ngw, lane);
#endif
#pragma unroll 1
        for (int gi = 0; gi < 3; ++gi) {
            GemmDesc d; d.kind = -1; d.G = nblk; d.c = bid; d.split_cols = 0; d.scale0 = 1.f; d.base = nullptr; d.out = nullptr; d.O = nullptr; d.ldc = 0; d.A = nullptr; d.Bt = nullptr; d.Mg = M; d.Ng = 0; d.Kg = D;
            if (gi == 0) {
                if (ph == 1) { d.kind = 0; d.A = XN; d.Bt = (bf16*)(ws + WS_AB); d.Ng = ABW; d.O = (bf16*)(ws + WS_PROJ); d.ldc = ABW; }
                else if (ph == 3) { d.kind = 0; d.A = (bf16*)(ws + WS_POOLED); d.Bt = (bf16*)(ws + WS_BD); d.Ng = 512; d.Kg = 512; d.O = (bf16*)(ws + WS_CAT); d.ldc = D;
                    if (nblk == 256) { const int slot = bid >> 3; d.G = 64; d.c = (slot - 16) * 8 + (bid & 7); if (slot < 16 || slot >= 24) d.kind = -1; } }
                else if (ph == 4) { d.kind = 1; d.A = (bf16*)(ws + WS_CAT); d.Bt = (bf16*)(ws + WS_OAB); d.Ng = D; d.base = I.x; d.out = OUT; }
                else if (ph == 6 || ph == 15) { d.kind = 0; d.A = XN; d.Bt = (bf16*)(ws + (ph == 6 ? WS_UP0 : WS_UP1)); d.Ng = FF2; d.O = (bf16*)(ws + WS_U); d.ldc = FF2; }
                else if (ph == 8 || ph == 17) { d.kind = 1; d.A = (bf16*)(ws + WS_ACT); d.Bt = (bf16*)(ws + (ph == 8 ? WS_DN0 : WS_DN1)); d.Ng = D; d.Kg = FF; d.base = OUT; d.out = OUT; }
                else if (ph == 10) { d.kind = 0; d.A = XN; d.Bt = (bf16*)(ws + WS_C); d.Ng = 4096; d.O = (bf16*)(ws + WS_QK); d.ldc = 4096; d.split_cols = 2048; d.scale0 = 0.0625f; }
                else if (ph == 13) { d.kind = 1; d.A = (bf16*)(ws + WS_Y); d.Bt = (bf16*)(ws + WS_OC); d.Ng = D; d.base = OUT; d.out = OUT; }
            } else if (ph == 10) {
                if (gi == 1) { d.kind = 0; d.A = XN; d.Bt = (bf16*)(ws + WS_C) + (size_t)6144 * D; d.Ng = D; d.O = (bf16*)(ws + WS_OG); d.ldc = D; }
                else { d.kind = 0; d.A = (bf16*)(ws + WS_C) + (size_t)2048 * D; d.Bt = XN; d.Mg = 4096; d.Ng = M; d.O = (bf16*)(ws + WS_KVT); d.ldc = M; }
            }
#ifndef NO_GEMM
            if (d.kind == 0) {
                pg8::Gemm g{d.A, d.Bt, d.Mg, d.Ng, d.Kg}; pg8::StaticOrder S; S.init(d.Mg, d.Ng, d.G, d.c);
                pg8::EpiBf16<0> E{d.O, d.ldc, nullptr, d.split_cols, (size_t)d.split_cols, d.scale0};
                pg8::gemm_phase<pg8::EpiBf16<0>, pg8::StaticOrder, true, true>(lds, g, S, E);
            } else if (d.kind == 1) {
                pg8::Gemm g{d.A, d.Bt, d.Mg, d.Ng, d.Kg}; pg8::StaticOrder S; S.init(d.Mg, d.Ng, d.G, d.c);
                EpiRes E{d.base, d.out, D};
                pg8::gemm_phase<EpiRes, pg8::StaticOrder, true, true>(lds, g, S, E);
            }
#endif
            __syncthreads();
        }
        if (ph_it + 1 < ph_hi + N_REPEAT) grid.sync();
#ifdef PROBE_PH
        if (bid == 0 && tid == 0) { unsigned long long* ts = (unsigned long long*)(ws + WS_BD + 768 * 1024); ts[ph + 1] = __builtin_amdgcn_s_memrealtime(); if (ph == 0) ts[0] = t_start;
            if (ph + 1 == ph_hi) { OUT[0] = (float)(ts[PROBE_PH + 1] - ts[PROBE_PH]) * 0.01f; } }
#endif
    }
}

#ifndef MK_MULTI
#define MK_MULTI 0
#endif
extern "C" void kernel_launch(void* const* d_in, const int* in_sizes, int n_in, void* d_out, int out_size, void* d_ws, size_t ws_size, hipStream_t stream) {
    static int grid = 0;
    if (grid == 0) {
        if (n_in != 17 || out_size != mk::M * mk::D || ws_size < mk::WS_END) { fprintf(stderr, "kernel_launch: unexpected shapes n_in %d out %d ws %zu (need %zu)\n", n_in, out_size, ws_size, (size_t)mk::WS_END); grid = -1; return; }
        int dev = 0, cus = 0, per_cu = 0;
        (void)hipGetDevice(&dev); (void)hipDeviceGetAttribute(&cus, hipDeviceAttributeMultiprocessorCount, dev);
        if (hipFuncSetAttribute((const void*)fwd_mega, hipFuncAttributeMaxDynamicSharedMemorySize, mk::LDS_BYTES) != hipSuccess) { fprintf(stderr, "kernel_launch: hipFuncSetAttribute failed\n"); grid = -1; return; }
        if (hipOccupancyMaxActiveBlocksPerMultiprocessor(&per_cu, (const void*)fwd_mega, 512, mk::LDS_BYTES) != hipSuccess || per_cu < 1) { fprintf(stderr, "kernel_launch: occupancy query gave %d\n", per_cu); per_cu = 1; }
        (void)hipGetLastError();
        if (cus <= 0) cus = 256;
        grid = cus * per_cu; if (grid > 256) grid = 256;
        fprintf(stderr, "kernel_launch: cus %d per_cu %d grid %d\n", cus, per_cu, grid);
    }
    if (grid < 0) return;
    Params p{};
    for (int i = 0; i < 17; ++i) p.in[i] = (const float*)d_in[i];
    p.out = (float*)d_out; p.ws = (unsigned char*)d_ws;
#if MK_MULTI
    for (int ph = 0; ph < N_PHASES; ++ph) { p.ph_lo = ph; p.ph_hi = ph + 1; hipLaunchKernelGGL(fwd_mega, dim3(grid), dim3(512), mk::LDS_BYTES, stream, p); }
#else
    p.ph_lo = 0; p.ph_hi = N_PHASES;
    void* args[] = {&p};
    const hipError_t e = hipLaunchCooperativeKernel((const void*)fwd_mega, dim3(grid), dim3(512), args, mk::LDS_BYTES, stream);
    if (e != hipSuccess) fprintf(stderr, "kernel_launch: cooperative launch failed: %s (grid %d)\n", hipGetErrorString(e), grid);
#endif
}
```

```cpp
#include <hip/hip_runtime.h>
#include <hip/hip_cooperative_groups.h>
#include <hip/hip_bf16.h>
#include <cstdio>
#include <cstdint>
#include <cmath>
namespace cg = cooperative_groups;
__device__ __forceinline__ int mk_tid();
namespace pg8 {
#define PG8_LAS __attribute__((address_space(3)))
typedef unsigned short bf16_t;
typedef short bf16x8 __attribute__((ext_vector_type(8)));
typedef float f32x4 __attribute__((ext_vector_type(4)));
typedef unsigned u32x4 __attribute__((ext_vector_type(4)));
constexpr int BM = 256, BK = 64, HALF = 128, HTB = HALF * BK * 2  , STAGE_BYTES = 8 * HTB, NXCD = 8, WGM = 8;

__host__ __device__ __forceinline__ int lds_byte(int r, int c) { const int st = (r >> 4) * 2 + (c >> 5), rr = r & 15, cc = c & 31, ob = rr * 64 + cc * 2; return st * 1024 + (ob ^ (((ob >> 9) & 1) << 5)); }
__host__ __device__ __forceinline__ void stage_rc(int b, int& R, int& C) { const int st = b / 1024, sb = b % 1024, swz = sb ^ (((sb >> 9) & 1) << 5); R = (st >> 1) * 16 + swz / 64; C = (st & 1) * 32 + (swz % 64) / 2; }
__host__ __device__ __forceinline__ int perm32(int rho) { const int n = rho >> 4, i = rho & 15; return 8 * (i >> 2) + 4 * n + (i & 3); }

struct Unit { int pm, pn; };
struct Gemm { const bf16_t* A; const bf16_t* Bt; int M, N, K; };

struct StaticOrder {
    int nM, nN, nwg, G, c;
    __host__ __device__ void init(int M, int N, int G_, int c_) { nM = M / BM; nN = N / BM; nwg = nM * nN; G = G_; c = c_; }
    __host__ __device__ bool next(int i, Unit& u) const {
        const long L = (long)i * G + c; if (L >= nwg) return false;
        int wgid = (int)L; { const int q = nwg / NXCD, r = nwg % NXCD, xcd = wgid % NXCD, off = wgid / NXCD; wgid = (xcd < r ? xcd * (q + 1) : r * (q + 1) + (xcd - r) * q) + off; }
        const int nig = WGM * nN, gid = wgid / nig, fm = gid * WGM, gsz = (nM - fm) < WGM ? (nM - fm) : WGM;
        u.pm = fm + ((wgid % nig) % gsz); u.pn = (wgid % nig) / gsz; return true;
    }
    __device__ __forceinline__ void a_ready(const Unit&) const {}
    __device__ __forceinline__ void done(const Unit&) const {}
};

__device__ __forceinline__ unsigned cvt_pk_bf16(float lo, float hi) { unsigned r; asm volatile("v_cvt_pk_bf16_f32 %0, %1, %2" : "=v"(r) : "v"(lo), "v"(hi)); return r; }
typedef float f32x2 __attribute__((ext_vector_type(2)));
__device__ __forceinline__ f32x2 gelu_pk(f32x2 v) {
    const f32x2 av = __builtin_elementwise_abs(v), d = av * 0.2316418882f + 1.0f;
    f32x2 t; t.x = __builtin_amdgcn_rcpf(d.x); t.y = __builtin_amdgcn_rcpf(d.y);
    f32x2 q = t * 0.5307027145f + (-0.7265760135f); q = q * t + 0.7107068705f; q = q * t + (-0.142248368f); q = q * t + 0.127414796f; q = q * t;
    const f32x2 s = (v * v) * (-0.72134752044f);
    f32x2 e; e.x = __builtin_amdgcn_exp2f(s.x); e.y = __builtin_amdgcn_exp2f(s.y);
    const f32x2 m = v * (q * e), r = v - m;
    f32x2 o; o.x = v.x < 0.f ? m.x : r.x; o.y = v.y < 0.f ? m.y : r.y; return o;
}

template <int ACT  > struct EpiBf16 {
    static constexpr bool PERM = true, AFTER_DRAIN = false; static_assert(ACT == 0 || ACT == 1, "EpiBf16: ACT is 0 (none) or 1 (gelu_pk)");
    bf16_t* O; int ldc; const float* bias; int split_cols; size_t split_stride; float scale0;
    __device__ __forceinline__ void operator()(const f32x4 (&acc)[2][2][4][2], const Unit& u, int wr, int wc, int fr, int fq) const {
        const int row0 = u.pm * BM + wr * 64 + fr; int colt = u.pn * BM; bf16_t* base = O;
        float sc = 1.f; if (split_cols) { const int t = colt / split_cols; base += (size_t)t * split_stride; colt -= t * split_cols; if (t == 0) sc = scale0; }
        const int col0 = colt + wc * 32 + 8 * fq, bcol0 = u.pn * BM + wc * 32 + 8 * fq;
        f32x4 bv[2][2];
#pragma unroll
        for (int bj = 0; bj < 2; ++bj)
#pragma unroll
            for (int n = 0; n < 2; ++n) bv[bj][n] = bias ? *(const f32x4*)(bias + bcol0 + bj * HALF + 4 * n) : (f32x4){0.f, 0.f, 0.f, 0.f};
#pragma unroll
        for (int ai = 0; ai < 2; ++ai)
#pragma unroll
            for (int m = 0; m < 4; ++m) { bf16_t* rowp = base + (size_t)(row0 + ai * HALF + m * 16) * ldc + col0;
#pragma unroll
                for (int bj = 0; bj < 2; ++bj) { f32x4 v0 = acc[ai][bj][m][0] + bv[bj][0], v1 = acc[ai][bj][m][1] + bv[bj][1];
                    if (ACT == 1) { f32x2 a = gelu_pk((f32x2){v0[0], v0[1]}), b = gelu_pk((f32x2){v0[2], v0[3]}), c = gelu_pk((f32x2){v1[0], v1[1]}), d = gelu_pk((f32x2){v1[2], v1[3]});
                        v0 = (f32x4){a.x, a.y, b.x, b.y}; v1 = (f32x4){c.x, c.y, d.x, d.y}; }
                    v0 = v0 * sc; v1 = v1 * sc; u32x4 w; w.x = cvt_pk_bf16(v0[0], v0[1]); w.y = cvt_pk_bf16(v0[2], v0[3]); w.z = cvt_pk_bf16(v1[0], v1[1]); w.w = cvt_pk_bf16(v1[2], v1[3]);
                    *(u32x4*)(rowp + bj * HALF) = w; } }
    }
};

template <class Epi, class Sched, bool ALIGN_EPI = false, bool SP2 = false>
__device__ __forceinline__ void gemm_phase(PG8_LAS unsigned char* lds, const Gemm g, const Sched& S, const Epi& E) {
    const int tid = mk_tid(), wid = __builtin_amdgcn_readfirstlane(tid >> 6), lane = tid & 63, wr = wid >> 2, wc = wid & 3, fr = lane & 15, fq = lane >> 4;
    const int K = g.K, nt = K / BK;
    unsigned voffA[2], voffB[2];
#pragma unroll
    for (int i = 0; i < 2; ++i) { int R, C; stage_rc(tid * 16 + i * 8192, R, C); const int Rb = Epi::PERM ? ((R & ~31) + perm32(R & 31)) : R;
        voffA[i] = (unsigned)(R * K + C) * 2u; voffB[i] = (unsigned)(Rb * K + C) * 2u; }
    const size_t kstep = (size_t)(BK * 2);
    const size_t hstep = (size_t)HALF * K * 2;
    const size_t tstep = 2 * hstep;
    const unsigned ldsw = (unsigned)wid * 1024u;
    const int aoff = lds_byte(wr * 64 + fr, fq * 8), boff = lds_byte(wc * 32 + fr, fq * 8);
#define PG8_SA(b, h) (((b) * 2 + (h)) * HTB)
#define PG8_SB(b, h) ((4 + (b) * 2 + (h)) * HTB)
#define PG8_STAGE(bufoff, gbase, voff) do { _Pragma("unroll") for (int _i = 0; _i < 2; ++_i) \
        __builtin_amdgcn_global_load_lds((const unsigned*)((const char*)(gbase) + (voff)[_i]), (PG8_LAS unsigned*)(lds + (bufoff) + ldsw + _i * 8192), 16, 0, 0); } while (0)
#define PG8_LDA(dst, b, h) do { _Pragma("unroll") for (int m = 0; m < 4; ++m) _Pragma("unroll") for (int k = 0; k < 2; ++k) dst[m][k] = *(const PG8_LAS bf16x8*)(lds + PG8_SA(b, h) + aoff + m * 2048 + k * 1024); } while (0)
#define PG8_LDB(dst, b, h) do { _Pragma("unroll") for (int n = 0; n < 2; ++n) _Pragma("unroll") for (int k = 0; k < 2; ++k) dst[n][k] = *(const PG8_LAS bf16x8*)(lds + PG8_SB(b, h) + boff + n * 2048 + k * 1024); } while (0)
#define PG8_MMA(ai, bj, At, Bt) do { __builtin_amdgcn_s_setprio(1); _Pragma("unroll") for (int m = 0; m < 4; ++m) _Pragma("unroll") for (int n = 0; n < 2; ++n) _Pragma("unroll") for (int k = 0; k < 2; ++k) \
        acc[ai][bj][m][n] = __builtin_amdgcn_mfma_f32_16x16x32_bf16(Bt[n][k], At[m][k], acc[ai][bj][m][n], 0, 0, 0); __builtin_amdgcn_s_setprio(0); } while (0)
#define PG8_WAIT_V(n) asm volatile("s_waitcnt vmcnt(" #n ")" ::: "memory")
#define PG8_WAIT_L(n) asm volatile("s_waitcnt lgkmcnt(" #n ")" ::: "memory")
#define PG8_BAR __builtin_amdgcn_s_barrier()
#define PG8_SCHED __builtin_amdgcn_sched_barrier(0)
    Unit cur, nxt; int ui = 0;
    if (!S.next(0, cur)) return;
    f32x4 acc[2][2][4][2];
#pragma unroll
    for (int a = 0; a < 2; ++a)
#pragma unroll
        for (int b = 0; b < 2; ++b)
#pragma unroll
            for (int m = 0; m < 4; ++m)
#pragma unroll
                for (int n = 0; n < 2; ++n) acc[a][b][m][n] = (f32x4){0.f, 0.f, 0.f, 0.f};
    bf16x8 At[4][2], B0[2][2], B1[2][2];
    const char* cA = (const char*)g.A + (size_t)cur.pm * tstep; const char* cB = (const char*)g.Bt + (size_t)cur.pn * tstep;
    S.a_ready(cur);
    if constexpr (SP2) {
        PG8_STAGE(PG8_SB(0, 0), cB, voffB); PG8_STAGE(PG8_SB(0, 1), cB + hstep, voffB); PG8_STAGE(PG8_SA(0, 0), cA, voffA); PG8_STAGE(PG8_SA(0, 1), cA + hstep, voffA);
        if (wr == 1) PG8_BAR;
        PG8_WAIT_V(2); PG8_BAR;
        PG8_STAGE(PG8_SB(1, 0), cB + kstep, voffB); PG8_STAGE(PG8_SA(1, 0), cA + kstep, voffA); PG8_STAGE(PG8_SB(1, 1), cB + hstep + kstep, voffB);
        PG8_WAIT_V(6); PG8_BAR;
    } else {
        PG8_STAGE(PG8_SB(0, 0), cB, voffB); PG8_STAGE(PG8_SA(0, 0), cA, voffA); PG8_STAGE(PG8_SB(0, 1), cB + hstep, voffB); PG8_STAGE(PG8_SA(0, 1), cA + hstep, voffA);
        if (wr == 1) PG8_BAR;
        PG8_WAIT_V(4); PG8_BAR;
        PG8_STAGE(PG8_SB(1, 0), cB + kstep, voffB); PG8_STAGE(PG8_SA(1, 0), cA + kstep, voffA); PG8_STAGE(PG8_SB(1, 1), cB + hstep + kstep, voffB);
        PG8_WAIT_V(6); PG8_BAR;
    }
    for (;;) {
        const bool has_next = S.next(ui + 1, nxt);
        const char* nA = has_next ? (const char*)g.A + (size_t)nxt.pm * tstep : cA; const char* nB = has_next ? (const char*)g.Bt + (size_t)nxt.pn * tstep : cB;
        for (int t = 0; t < nt; t += 2) {
            const bool last = (t == nt - 2);
            const char* a1 = cA + (size_t)(t + 1) * kstep;
            const char* a2 = last ? nA : cA + (size_t)(t + 2) * kstep; const char* b2 = last ? nB : cB + (size_t)(t + 2) * kstep;
            const char* a3 = a2 + kstep; const char* b3 = b2 + kstep;
            if (last && has_next) S.a_ready(nxt);
            if constexpr (SP2) {
            PG8_LDB(B0, 0, 0); PG8_LDB(B1, 0, 1); PG8_SCHED; PG8_LDA(At, 0, 0); PG8_STAGE(PG8_SA(1, 1), a1 + hstep, voffA);
            PG8_WAIT_V(8); PG8_WAIT_L(0); PG8_BAR; PG8_MMA(0, 0, At, B0); PG8_MMA(0, 1, At, B1); PG8_BAR; PG8_SCHED;
            PG8_LDA(At, 0, 1); PG8_STAGE(PG8_SB(0, 0), b2, voffB); PG8_STAGE(PG8_SB(0, 1), b2 + hstep, voffB); PG8_STAGE(PG8_SA(0, 0), a2, voffA);
            PG8_WAIT_V(8); PG8_WAIT_L(0); PG8_BAR; PG8_MMA(1, 0, At, B0); PG8_MMA(1, 1, At, B1); PG8_BAR; PG8_SCHED;
            PG8_LDB(B0, 1, 0); PG8_LDB(B1, 1, 1); PG8_SCHED; PG8_LDA(At, 1, 0); PG8_STAGE(PG8_SA(0, 1), a2 + hstep, voffA);
            PG8_WAIT_V(8); PG8_WAIT_L(0); PG8_BAR; PG8_MMA(0, 0, At, B0); PG8_MMA(0, 1, At, B1); PG8_BAR; PG8_SCHED;
            PG8_LDA(At, 1, 1); PG8_STAGE(PG8_SB(1, 0), b3, voffB); PG8_STAGE(PG8_SB(1, 1), b3 + hstep, voffB); PG8_STAGE(PG8_SA(1, 0), a3, voffA);
            PG8_WAIT_V(8); PG8_WAIT_L(0); PG8_BAR; PG8_MMA(1, 0, At, B0); PG8_MMA(1, 1, At, B1); PG8_BAR; PG8_SCHED;
            } else {
            PG8_LDB(B0, 0, 0); PG8_SCHED; PG8_LDA(At, 0, 0); PG8_STAGE(PG8_SA(1, 1), a1 + hstep, voffA);
            PG8_WAIT_L(8); PG8_BAR; PG8_WAIT_L(0); PG8_MMA(0, 0, At, B0); PG8_BAR; PG8_SCHED;
            PG8_LDB(B1, 0, 1); PG8_STAGE(PG8_SB(0, 0), b2, voffB);
            PG8_BAR; PG8_WAIT_L(0); PG8_MMA(0, 1, At, B1); PG8_BAR;
            PG8_LDA(At, 0, 1); PG8_STAGE(PG8_SA(0, 0), a2, voffA);
            PG8_BAR; PG8_WAIT_L(0); PG8_MMA(1, 0, At, B0); PG8_BAR; PG8_SCHED;
            PG8_STAGE(PG8_SB(0, 1), b2 + hstep, voffB);
            PG8_WAIT_V(6); PG8_BAR; PG8_MMA(1, 1, At, B1); PG8_BAR;
            PG8_LDB(B0, 1, 0); PG8_SCHED; PG8_LDA(At, 1, 0); PG8_STAGE(PG8_SA(0, 1), a2 + hstep, voffA);
            PG8_WAIT_L(8); PG8_BAR; PG8_WAIT_L(0); PG8_MMA(0, 0, At, B0); PG8_BAR; PG8_SCHED;
            PG8_LDB(B1, 1, 1); PG8_STAGE(PG8_SB(1, 0), b3, voffB);
            PG8_BAR; PG8_WAIT_L(0); PG8_MMA(0, 1, At, B1); PG8_BAR;
            PG8_LDA(At, 1, 1); PG8_STAGE(PG8_SA(1, 0), a3, voffA);
            PG8_BAR; PG8_WAIT_L(0); PG8_MMA(1, 0, At, B0); PG8_BAR; PG8_SCHED;
            PG8_STAGE(PG8_SB(1, 1), b3 + hstep, voffB);
            PG8_WAIT_V(6); PG8_BAR; PG8_MMA(1, 1, At, B1); PG8_BAR;
            }
        }
        if constexpr (ALIGN_EPI) { if (wr == 0) PG8_BAR; }
        if constexpr (!Epi::AFTER_DRAIN) { E(acc, cur, wr, wc, fr, fq); S.done(cur); }
        if (!has_next) break;
#pragma unroll
        for (int a = 0; a < 2; ++a)
#pragma unroll
            for (int b = 0; b < 2; ++b)
#pragma unroll
                for (int m = 0; m < 4; ++m)
#pragma unroll
                    for (int n = 0; n < 2; ++n) acc[a][b][m][n] = (f32x4){0.f, 0.f, 0.f, 0.f};
        cur = nxt; cA = nA; cB = nB; ++ui;
        if constexpr (ALIGN_EPI) { if (wr == 1) PG8_BAR; }
    }
    PG8_WAIT_V(0);
    if constexpr (!ALIGN_EPI) { if (wr == 0) PG8_BAR; }
    PG8_BAR;
    if constexpr (Epi::AFTER_DRAIN) { E.fused(acc, cur, wr, wc, fr, fq, lds, wid, lane); S.done(cur); }
#undef PG8_SA
#undef PG8_SB
#undef PG8_STAGE
#undef PG8_LDA
#undef PG8_LDB
#undef PG8_MMA
#undef PG8_WAIT_V
#undef PG8_WAIT_L
#undef PG8_BAR
#undef PG8_SCHED
}
}

namespace att {
using bf16 = __hip_bfloat16;
constexpr int   D = 128, NW = 8, QBLK = 32, KVBLK = 64;
constexpr float SCALE = 0.088388347648318440f;
constexpr float THR = 8.f;
constexpr int SDEPTH = 2;
constexpr int LDQ = 3072, LDK = 3072, LDO = 2048;
constexpr size_t SHM_V = KVBLK * D * 2, SHM_K = KVBLK * D * 2, SHM_ATTN = 2 * SHM_V + 2 * SHM_K + NW * 64 * 4;
using bf16x8 = __attribute__((ext_vector_type(8))) short;
using s16x4  = __attribute__((ext_vector_type(4))) short;
using f32x16 = __attribute__((ext_vector_type(16))) float;
using f32x8  = __attribute__((ext_vector_type(8))) float;
using u32x4  = __attribute__((ext_vector_type(4))) unsigned;
#define KSWZ(row, colB) ((row) * 256 + ((colB) ^ (((row) & 7) << 4)))
#define SBAR() __builtin_amdgcn_sched_barrier(0)
__device__ __forceinline__ int crow(int r, int hi) { return (r & 3) + 8 * (r >> 2) + 4 * hi; }
__device__ __forceinline__ unsigned cvtpk(float lo, float hi) {
  unsigned r; asm volatile("v_cvt_pk_bf16_f32 %0, %1, %2" : "=v"(r) : "v"(lo), "v"(hi)); return r;
}
template <typename TIn> struct Stage;
template <> struct Stage<bf16>  { using T = bf16x8;
  __device__ static __forceinline__ T ld8(const bf16* p) { return *reinterpret_cast<const bf16x8*>(p); }
  __device__ static __forceinline__ bf16x8 tobf(T x) { return x; } };
template <> struct Stage<float> { using T = f32x8;
  __device__ static __forceinline__ T ld8(const float* p) { return *reinterpret_cast<const f32x8*>(p); }
  __device__ static __forceinline__ bf16x8 tobf(T x) {
    u32x4 w = {cvtpk(x[0], x[1]), cvtpk(x[2], x[3]), cvtpk(x[4], x[5]), cvtpk(x[6], x[7])}; return *reinterpret_cast<bf16x8*>(&w); } };

__device__ __forceinline__ void partialSM(f32x16& p0, f32x16& p1, float& m_reg, float& mn, float& alpha) {
  constexpr float C = SCALE * 1.4426950408889634f;
  float pmax = p0[0]; for (int r = 1; r < 16; ++r) pmax = fmaxf(pmax, p0[r]); for (int r = 0; r < 16; ++r) pmax = fmaxf(pmax, p1[r]);
  { auto rr = __builtin_amdgcn_permlane32_swap(__float_as_uint(pmax), __float_as_uint(pmax), false, false);
    pmax = fmaxf(__uint_as_float(rr[0]), __uint_as_float(rr[1])); }
  if (__builtin_expect(__all(pmax - m_reg <= THR / SCALE), 1)) { mn = m_reg; alpha = 1.f; }
  else { mn = fmaxf(m_reg, pmax); alpha = __builtin_amdgcn_exp2f((m_reg - mn) * C); m_reg = mn; }
  float mnC = -mn * C;
  for (int r = 0; r < 16; ++r) p0[r] = fmaf(p0[r], C, mnC); for (int r = 0; r < 16; ++r) p1[r] = fmaf(p1[r], C, mnC);
  for (int r = 0; r < 16; ++r) p0[r] = __builtin_amdgcn_exp2f(p0[r]);
}
__device__ __forceinline__ void finishSM(f32x16& p0, f32x16& p1, float alpha, float& l_reg, bf16x8& pa0, bf16x8& pa1, bf16x8& pa2, bf16x8& pa3) {
  for (int r = 0; r < 16; ++r) p1[r] = __builtin_amdgcn_exp2f(p1[r]);
  float ps = 0; for (int r = 0; r < 16; ++r) ps += p0[r]; for (int r = 0; r < 16; ++r) ps += p1[r];
  { auto rr = __builtin_amdgcn_permlane32_swap(__float_as_uint(ps), __float_as_uint(ps), false, false);
    ps = __uint_as_float(rr[0]) + __uint_as_float(rr[1]); }
  l_reg = l_reg * alpha + ps;
#define PK4(P, BASE, OUT) do { unsigned a0 = cvtpk(P[BASE + 0], P[BASE + 1]), a1 = cvtpk(P[BASE + 2], P[BASE + 3]);   \
    unsigned b0 = cvtpk(P[BASE + 4], P[BASE + 5]), b1 = cvtpk(P[BASE + 6], P[BASE + 7]);                              \
    auto r0 = __builtin_amdgcn_permlane32_swap(a0, b0, false, false); auto r1 = __builtin_amdgcn_permlane32_swap(a1, b1, false, false); \
    u32x4 w = {r0[0], r1[0], r0[1], r1[1]}; OUT = *reinterpret_cast<bf16x8*>(&w); } while (0)
  PK4(p0, 0, pa0); PK4(p0, 8, pa1); PK4(p1, 0, pa2); PK4(p1, 8, pa3);
#undef PK4
}
__device__ __forceinline__ void qkt(f32x16& p0, f32x16& p1, const bf16* Ks, const bf16x8* qr, int r32, int hi) {
  p0 = f32x16{}; p1 = f32x16{};
  for (int d0 = 0; d0 < 8; ++d0) { int cb = (d0 * 16 + hi * 8) * 2;
    bf16x8 b0 = *reinterpret_cast<const bf16x8*>((const char*)Ks + KSWZ(r32, cb));
    bf16x8 b1 = *reinterpret_cast<const bf16x8*>((const char*)Ks + KSWZ(32 + r32, cb));
    p0 = __builtin_amdgcn_mfma_f32_32x32x16_bf16(b0, qr[d0], p0, 0, 0, 0);
    p1 = __builtin_amdgcn_mfma_f32_32x32x16_bf16(b1, qr[d0], p1, 0, 0, 0); }
}
__device__ __forceinline__ int v_st(int k, int c) { const int kk = (k & ~0xC) | ((k & 4) << 1) | ((k & 8) >> 1); return ((kk >> 3) * 4 + (c >> 5)) * 512 + ((kk & 7) * 32 + (c & 31)) * 2; }
__device__ __forceinline__ int v_rd_base(int lane) { return ((lane & 3) << 3) | (((lane >> 2) & 3) << 6) | (((lane >> 4) & 1) << 5) | (((lane >> 5) & 1) << 8); }
constexpr int v_rd_off(int d0, int ks, int half) { return d0 * 512 + ks * 4096 + half * 2048; }
template <int OFF> __device__ __forceinline__ s16x4 tr_read(int vb) {
  s16x4 r; asm volatile("ds_read_b64_tr_b16 %0, %1 offset:%2" : "=&v"(r) : "v"(vb), "i"(OFF) : "memory"); return r;
}
template <int D0> __device__ __forceinline__ void pv_one(f32x16& od, int vb, bf16x8 pa0, bf16x8 pa1, bf16x8 pa2, bf16x8 pa3) {
  const s16x4 l0 = tr_read<v_rd_off(D0, 0, 0)>(vb), h0 = tr_read<v_rd_off(D0, 0, 1)>(vb), l1 = tr_read<v_rd_off(D0, 1, 0)>(vb), h1 = tr_read<v_rd_off(D0, 1, 1)>(vb);
  const s16x4 l2 = tr_read<v_rd_off(D0, 2, 0)>(vb), h2 = tr_read<v_rd_off(D0, 2, 1)>(vb), l3 = tr_read<v_rd_off(D0, 3, 0)>(vb), h3 = tr_read<v_rd_off(D0, 3, 1)>(vb);
  asm volatile("s_waitcnt lgkmcnt(0)" ::: "memory"); SBAR();
#define PK(L, H) (bf16x8){L[0], L[1], L[2], L[3], H[0], H[1], H[2], H[3]}
  od = __builtin_amdgcn_mfma_f32_32x32x16_bf16(pa0, PK(l0, h0), od, 0, 0, 0);
  od = __builtin_amdgcn_mfma_f32_32x32x16_bf16(pa1, PK(l1, h1), od, 0, 0, 0);
  od = __builtin_amdgcn_mfma_f32_32x32x16_bf16(pa2, PK(l2, h2), od, 0, 0, 0);
  od = __builtin_amdgcn_mfma_f32_32x32x16_bf16(pa3, PK(l3, h3), od, 0, 0, 0);
#undef PK
}
__device__ __forceinline__ void pv_d0(f32x16* o, int vb, bf16x8 pa0, bf16x8 pa1, bf16x8 pa2, bf16x8 pa3) {
  pv_one<0>(o[0], vb, pa0, pa1, pa2, pa3); pv_one<1>(o[1], vb, pa0, pa1, pa2, pa3); pv_one<2>(o[2], vb, pa0, pa1, pa2, pa3); pv_one<3>(o[3], vb, pa0, pa1, pa2, pa3);
}

template <typename TQ>
__device__ __forceinline__ void attn_dense_body(const TQ* __restrict__ Qb, const bf16* __restrict__ Kh, const bf16* __restrict__ Vh,
                                                unsigned short* __restrict__ Ob, int seq, char* lds) {
  using St = Stage<bf16>; using SQ = Stage<TQ>;
  const int tid = mk_tid(), wid = tid >> 6, lane = tid & 63, r32 = lane & 31, hi = lane >> 5;
  bf16* V_lds = (bf16*)lds; bf16* K_lds = (bf16*)(lds + 2 * SHM_V);
  float* ws = (float*)(lds + 2 * SHM_V + 2 * SHM_K) + wid * 64; float* li_l = ws; float* al_l = ws + 32;
  float m_reg = -1e30f, l_reg = 0; f32x16 o[4] = {}; bf16x8 qr[8];
  const TQ* Qw = Qb + (long)(wid * QBLK + r32) * LDQ + hi * 8;
#pragma unroll
  for (int d0 = 0; d0 < 8; ++d0) qr[d0] = SQ::tobf(SQ::ld8(Qw + d0 * 16));
  const int sr = tid >> 4, sc = (tid & 15) * 8, vst0 = v_st(sr, sc), vst1 = v_st(32 + sr, sc);
  const int vb0 = (int)(uintptr_t)V_lds + v_rd_base(lane);
  struct { typename St::T vs0, vs1, ks0, ks1; } sr_[SDEPTH];
#define SLOAD(i, k0) do { sr_[i].vs0 = St::ld8(&Vh[(long)((k0) + sr) * LDK + sc]); sr_[i].vs1 = St::ld8(&Vh[(long)((k0) + 32 + sr) * LDK + sc]); \
    sr_[i].ks0 = St::ld8(&Kh[(long)((k0) + sr) * LDK + sc]); sr_[i].ks1 = St::ld8(&Kh[(long)((k0) + 32 + sr) * LDK + sc]); } while (0)
#define SWRITE(b, i) do { *(bf16x8*)((char*)V_lds + (b) * SHM_V + vst0) = St::tobf(sr_[i].vs0);          \
    *(bf16x8*)((char*)V_lds + (b) * SHM_V + vst1) = St::tobf(sr_[i].vs1); int kc = sc * 2;               \
    *(bf16x8*)((char*)K_lds + (b) * SHM_K + KSWZ(sr, kc)) = St::tobf(sr_[i].ks0);                       \
    *(bf16x8*)((char*)K_lds + (b) * SHM_K + KSWZ(32 + sr, kc)) = St::tobf(sr_[i].ks1); } while (0)
#define SWAIT() do { if constexpr (SDEPTH == 2) asm volatile("s_waitcnt vmcnt(4)" ::: "memory"); else asm volatile("s_waitcnt vmcnt(0)" ::: "memory"); } while (0)
#define RESC(a) do { if (__any((a) < 1.f)) { if (hi == 0) al_l[r32] = (a); asm volatile("s_waitcnt lgkmcnt(0)" ::: "memory"); \
    for (int d = 0; d < 4; ++d) for (int r = 0; r < 16; ++r) o[d][r] *= al_l[crow(r, hi)]; } } while (0)
  f32x16 pA0, pA1, pB0, pB1; float mnA, mnB, alA, alB; bf16x8 pa0, pa1, pa2, pa3; const int NT = seq / KVBLK;
  constexpr int SE = 0, SO = SDEPTH - 1;
  SLOAD(SE, 0); asm volatile("s_waitcnt vmcnt(0)" ::: "memory"); SWRITE(0, SE); __syncthreads();
  qkt(pA0, pA1, K_lds, qr, r32, hi); partialSM(pA0, pA1, m_reg, mnA, alA);
  SLOAD(SO, KVBLK); if constexpr (SDEPTH == 2) { if (2 < NT) SLOAD(SE, 2 * KVBLK); }
  SWAIT(); SWRITE(1, SO); __syncthreads();
  for (int j = 1; j + 1 < NT; j += 2) {
    SBAR(); qkt(pB0, pB1, (bf16*)((char*)K_lds + SHM_K), qr, r32, hi);
    finishSM(pA0, pA1, alA, l_reg, pa0, pa1, pa2, pa3); SBAR();
    SLOAD(SO, (j + SDEPTH) * KVBLK); SBAR();
    pv_d0(o, vb0, pa0, pa1, pa2, pa3); partialSM(pB0, pB1, m_reg, mnB, alB);
    __syncthreads(); SWAIT(); SWRITE(0, SE);
    RESC(alB); __syncthreads();
    SBAR(); qkt(pA0, pA1, K_lds, qr, r32, hi);
    finishSM(pB0, pB1, alB, l_reg, pa0, pa1, pa2, pa3); SBAR();
    if (SDEPTH == 1 || j + 3 < NT) SLOAD(SE, (j + 1 + SDEPTH) * KVBLK); SBAR();
    pv_d0(o, vb0 + (int)SHM_V, pa0, pa1, pa2, pa3); partialSM(pA0, pA1, m_reg, mnA, alA);
    __syncthreads(); SWAIT(); SWRITE(1, SO);
    RESC(alA); __syncthreads();
  }
  SBAR(); qkt(pB0, pB1, (bf16*)((char*)K_lds + SHM_K), qr, r32, hi);
  finishSM(pA0, pA1, alA, l_reg, pa0, pa1, pa2, pa3); SBAR();
  pv_d0(o, vb0, pa0, pa1, pa2, pa3); partialSM(pB0, pB1, m_reg, mnB, alB);
  __syncthreads(); RESC(alB);
  finishSM(pB0, pB1, alB, l_reg, pa0, pa1, pa2, pa3); SBAR();
  pv_d0(o, vb0 + (int)SHM_V, pa0, pa1, pa2, pa3);
  if (hi == 0) li_l[r32] = l_reg; asm volatile("s_waitcnt lgkmcnt(0)" ::: "memory");
  float rli[16];
#pragma unroll
  for (int r = 0; r < 16; ++r) rli[r] = __builtin_amdgcn_rcpf(li_l[crow(r, hi)]);
  unsigned short* Ow = Ob + (long)(wid * QBLK) * LDO;
#pragma unroll
  for (int r = 0; r < 16; ++r) { int orow = crow(r, hi);
    for (int d0 = 0; d0 < 4; ++d0) Ow[(long)orow * LDO + d0 * 32 + r32] = (unsigned short)(cvtpk(o[d0][r] * rli[r], 0.f) & 0xffffu); }
#undef SLOAD
#undef SWRITE
#undef SWAIT
#undef RESC
}

}
__device__ __forceinline__ int mk_tid() { int t = threadIdx.x; asm volatile("" : "+v"(t)); return t; }
namespace mk {
#define LAS __attribute__((address_space(3)))
typedef unsigned short bf16;
typedef short bf16x8 __attribute__((ext_vector_type(8)));
typedef float f32x4 __attribute__((ext_vector_type(4)));
typedef unsigned u32x4 __attribute__((ext_vector_type(4)));
typedef unsigned u32x2 __attribute__((ext_vector_type(2)));
#define XB_TMO      128
#define XB_XCNT(j)  (256  + 64 * (j))
#define XB_XSUB(j)  (1280 + 64 * (j))
#define XB_XGEN(j)  (2304 + 64 * (j))
#define XB_TOP      3328
#define XB_TOPGEN   3392
#define XCD_BAR_WORDS 3456
#define XB_SPIN_CAP (1u << 18)

__device__ __forceinline__ unsigned xb_ld(unsigned* p)              { return __hip_atomic_load(p, __ATOMIC_RELAXED, __HIP_MEMORY_SCOPE_AGENT); }
__device__ __forceinline__ unsigned xb_add(unsigned* p, unsigned v) { return __hip_atomic_fetch_add(p, v, __ATOMIC_RELAXED, __HIP_MEMORY_SCOPE_AGENT); }
__device__ __forceinline__ unsigned xb_xcc_id() { return (unsigned)__builtin_amdgcn_s_getreg((3 << 11) | 20) & 0xFu; }
#define XB_SPIN(cond, bar) do { unsigned _sp = 0; while (cond) { __builtin_amdgcn_s_sleep(1); \
    if ((++_sp & 255u) == 0u) { if (xb_ld(&(bar)[XB_TMO])) break; if (_sp > XB_SPIN_CAP) { atomicAdd(&(bar)[XB_TMO], 1u); break; } } } } while (0)

struct XcdBarrier {
    unsigned* bar; unsigned x;
    volatile LAS unsigned* st;
};

__device__ __forceinline__ XcdBarrier xcd_barrier_post(unsigned* bar, volatile LAS unsigned* st) {
    XcdBarrier b; b.bar = bar; b.x = xb_xcc_id(); b.st = st;
    if (mk_tid() == 0) (void)xb_add(&bar[XB_XCNT(b.x)], 1u);
    return b;
}
__device__ __forceinline__ void xcd_barrier_complete(unsigned* bar, unsigned x, unsigned& nloc, unsigned& nx) {
    const unsigned G = gridDim.x * gridDim.y * gridDim.z;
    unsigned sum, cnt, mine, sp = 0u;
    for (;;) {
        sum = 0u; cnt = 0u; mine = 0u;
#pragma unroll
        for (unsigned j = 0; j < 16; ++j) { const unsigned c = xb_ld(&bar[XB_XCNT(j)]); sum += c; cnt += (c > 0u) ? 1u : 0u; mine = (j == x) ? c : mine; }
        if (sum == G) break;
        __builtin_amdgcn_s_sleep(1);
        if ((++sp & 255u) == 0u) { if (xb_ld(&bar[XB_TMO])) break; if (sp > XB_SPIN_CAP) { atomicAdd(&bar[XB_TMO], 1u); break; } }
    }
    nloc = mine > 0u ? mine : 1u; nx = cnt > 0u ? cnt : 1u;
}

__device__ __forceinline__ void xcd_barrier(const XcdBarrier& b) {
    asm volatile("s_waitcnt vmcnt(0)" ::: "memory");
    __syncthreads();
    if (mk_tid() == 0) {
        unsigned* bar = b.bar;
        __builtin_amdgcn_s_waitcnt(0);
        unsigned nloc = b.st[0], nx = b.st[1];
        if (nloc == 0u) { xcd_barrier_complete(bar, b.x, nloc, nx); b.st[0] = nloc; b.st[1] = nx; }
        const unsigned old = xb_add(&bar[XB_XSUB(b.x)], 1u);
        const unsigned gen = old / nloc;
        if (old + 1u == (gen + 1u) * nloc) {
            __builtin_amdgcn_fence(__ATOMIC_RELEASE, "agent");
            asm volatile("s_waitcnt vmcnt(0)" ::: "memory");
            const unsigned og = xb_add(&bar[XB_TOP], 1u);
            const unsigned tg = og / nx;
            if (og + 1u == (tg + 1u) * nx) xb_add(&bar[XB_TOPGEN], 1u);
            else XB_SPIN(xb_ld(&bar[XB_TOPGEN]) == tg, bar);
            __builtin_amdgcn_fence(__ATOMIC_ACQUIRE, "agent");
            xb_add(&bar[XB_XGEN(b.x)], 1u);
            asm volatile("s_waitcnt vmcnt(0)" ::: "memory");
        } else {
            XB_SPIN(xb_ld(&bar[XB_XGEN(b.x)]) == gen, bar);
            __builtin_amdgcn_fence(__ATOMIC_ACQUIRE, "agent");
            asm volatile("s_waitcnt vmcnt(0)" ::: "memory");
        }
    }
    __syncthreads();
}


constexpr int D = 2048, M = 8192, SEQ = 4096, NW = 8;
constexpr int ABW = 3072, CW = 8224, FF2 = 11264, FF = 5632;
constexpr float EPS = 1e-6f;
constexpr size_t MiB = 1u << 20;
constexpr size_t WS_AB = 0, WS_BD = 12 * MiB, WS_OAB = 13 * MiB, WS_C = 21 * MiB  , WS_OC = 54 * MiB;
constexpr size_t WS_UP0 = 62 * MiB, WS_UP1 = 106 * MiB, WS_DN0 = 150 * MiB, WS_DN1 = 172 * MiB;
constexpr size_t WS_XN = 194 * MiB, WS_GATES = 226 * MiB, WS_S = 228 * MiB;
constexpr size_t WS_PROJ = WS_S, WS_POOLED = WS_S + 48 * MiB, WS_CAT = WS_S + 56 * MiB;
constexpr size_t WS_QK = WS_S, WS_OG = WS_S + 64 * MiB, WS_KVT = WS_S + 96 * MiB, WS_HF = WS_S + 160 * MiB, WS_Y = WS_S + 288 * MiB;
constexpr size_t WS_U = WS_S, WS_ACT = WS_S + 176 * MiB;
constexpr size_t WS_END = WS_S + 320 * MiB;
constexpr int LDS_ML = 154112 + 1024, LDS_MISC = LDS_ML, LDS_BYTES = LDS_ML + 64;
constexpr size_t WS_BAR = WS_BD + 768 * 1024, BAR_BYTES = 16384;

#define LDSWAIT() asm volatile("s_waitcnt lgkmcnt(0)" ::: "memory")
__device__ __forceinline__ unsigned f2bf(float f) { unsigned u = __float_as_uint(f); return (u + 0x7fffu + ((u >> 16) & 1u)) >> 16; }
__device__ __forceinline__ unsigned pk2(float lo, float hi) { unsigned r; asm volatile("v_cvt_pk_bf16_f32 %0, %1, %2" : "=v"(r) : "v"(lo), "v"(hi)); return r; }
__device__ __forceinline__ float bflo(unsigned w) { return __uint_as_float(w << 16); }
__device__ __forceinline__ float bfhi(unsigned w) { return __uint_as_float(w & 0xffff0000u); }
__device__ __forceinline__ float wave_sum(float v) {
#pragma unroll
    for (int o = 1; o < 64; o <<= 1) v += __shfl_xor(v, o);
    return v;
}

__device__ __forceinline__ void transpose_item64(const float* __restrict__ W, int ldw, int K, int nblk, bf16* __restrict__ WT, LAS float* scr, int item, int lane) {
    const int kb = item / nblk, nb = item - kb * nblk, k0 = 64 * kb, n0 = 64 * nb;
    f32x4 v[16];
#pragma unroll
    for (int i = 0; i < 16; ++i) { const int kk = 4 * i + (lane >> 4); v[i] = *(const f32x4*)(W + (size_t)(k0 + kk) * ldw + n0 + 4 * (lane & 15)); }
#pragma unroll
    for (int i = 0; i < 16; ++i) { const int kk = 4 * i + (lane >> 4); LAS float* s = scr + kk * 65 + 4 * (lane & 15); s[0] = v[i].x; s[1] = v[i].y; s[2] = v[i].z; s[3] = v[i].w; }
    LDSWAIT();
    const int c = lane & 7, q = lane >> 3;
#pragma unroll
    for (int j = 0; j < 8; ++j) { const int n = q + 8 * j; const LAS float* s = scr + (8 * c) * 65 + n;
        u32x4 o; o.x = pk2(s[0], s[65]); o.y = pk2(s[130], s[195]); o.z = pk2(s[260], s[325]); o.w = pk2(s[390], s[455]);
        *(u32x4*)(WT + (size_t)(n0 + n) * K + k0 + 8 * c) = o; }
    LDSWAIT();
}

__device__ __forceinline__ void rmsnorm_rows(const float* __restrict__ src, const float* __restrict__ gain, bf16* __restrict__ dst, int gw, int ngw, int lane) {
    f32x4 g[8];
#pragma unroll
    for (int j = 0; j < 8; ++j) g[j] = *(const f32x4*)(gain + 4 * lane + 256 * j);
    for (int m = gw; m < M; m += ngw) {
        const f32x4* xr = (const f32x4*)(src + (size_t)m * D) + lane; f32x4 v[8]; float s = 0.f;
#pragma unroll
        for (int j = 0; j < 8; ++j) { v[j] = xr[64 * j]; s += (v[j].x * v[j].x + v[j].y * v[j].y) + (v[j].z * v[j].z + v[j].w * v[j].w); }
        const float rstd = 1.0f / sqrtf(wave_sum(s) * (1.0f / D) + EPS);
        u32x2* o = (u32x2*)(dst + (size_t)m * D) + lane;
#pragma unroll
        for (int j = 0; j < 8; ++j) { u32x2 w; w.x = pk2(v[j].x * rstd * g[j].x, v[j].y * rstd * g[j].y); w.y = pk2(v[j].z * rstd * g[j].z, v[j].w * rstd * g[j].w); o[64 * j] = w; }
    }
}

struct In { const float *x, *norm_mix, *norm_ffn, *w_in_ab, *pool_w, *pool_scale, *q_norm, *k_norm, *w_out_ab, *w_in_c, *b_gate, *h_norm, *w_out_c, *w_up, *conv_w, *conv_b, *w_down; };

__device__ __forceinline__ void prologue(const In& I, unsigned char* ws, LAS unsigned char* lds, int gw, int ngw, int wave, int lane) {
    LAS float* scr = (LAS float*)(lds + wave * 16640);
    for (int it = gw; it < 24576; it += ngw) {
        const float* W; int ldw, K, nblk; bf16* WT; int r = it;
        if (r < 1536) { W = I.w_in_ab; ldw = ABW; K = D; nblk = 48; WT = (bf16*)(ws + WS_AB); }
        else if (r < 2560) { r -= 1536; W = I.w_out_ab; ldw = D; K = D; nblk = 32; WT = (bf16*)(ws + WS_OAB); }
        else if (r < 6656) { r -= 2560; W = I.w_in_c; ldw = CW; K = D; nblk = 128; WT = (bf16*)(ws + WS_C); }
        else if (r < 7680) { r -= 6656; W = I.w_out_c; ldw = D; K = D; nblk = 32; WT = (bf16*)(ws + WS_OC); }
        else if (r < 13312) { r -= 7680; W = I.w_up; ldw = FF2; K = D; nblk = 176; WT = (bf16*)(ws + WS_UP0); }
        else if (r < 18944) { r -= 13312; W = I.w_up + (size_t)D * FF2; ldw = FF2; K = D; nblk = 176; WT = (bf16*)(ws + WS_UP1); }
        else if (r < 21760) { r -= 18944; W = I.w_down; ldw = D; K = FF; nblk = 32; WT = (bf16*)(ws + WS_DN0); }
        else { r -= 21760; W = I.w_down + (size_t)FF * D; ldw = D; K = FF; nblk = 32; WT = (bf16*)(ws + WS_DN1); }
        transpose_item64(W, ldw, K, nblk, WT, scr, r, lane);
    }
    const int gt = gw * 64 + lane, ngt = ngw * 64;
    { bf16* WG = (bf16*)(ws + WS_C) + (size_t)8192 * D;
      for (int idx = gt; idx < 32 * D; idx += ngt) { const int j = idx >> 11, k = idx & 2047; WG[idx] = (bf16)f2bf(I.w_in_c[(size_t)k * CW + 8192 + j]); } }
    { bf16* BD = (bf16*)(ws + WS_BD);
      for (int idx = gt; idx < 512 * 512; idx += ngt) { const int n = idx >> 9, k = idx & 511, gn = n >> 7, gk = k >> 7;
          const float v = (gn == gk) ? I.pool_w[(size_t)(gn * 128 + (k & 127)) * 128 + (n & 127)] * I.pool_scale[n] : 0.f; BD[idx] = (bf16)f2bf(v); } }
    rmsnorm_rows(I.x, I.norm_mix, (bf16*)(ws + WS_XN), gw, ngw, lane);
}

__device__ __forceinline__ void qk_rope_pool(bf16* __restrict__ PROJ, const float* __restrict__ qn, const float* __restrict__ kn, bf16* __restrict__ POOLED, int gw, int ngw, int lane) {
    const int l = lane & 31, hsel = lane >> 5, part = (l >> 4) & 1; const bool first = (l & 8) == 0;
    float inv[4];
#pragma unroll
    for (int e = 0; e < 4; ++e) inv[e] = exp2f(-(float)(4 * (l & 7) + e) * (13.287712379549449f / 32.0f));
    const f32x4 gq = *(const f32x4*)(qn + 4 * l), gk = *(const f32x4*)(kn + 4 * l);
    for (int it = gw; it < M * 8; it += ngw) {
        const int t = it >> 3, hh = (it & 7) * 2 + hsel;
        bf16* p = PROJ + (size_t)t * ABW + 512 + hh * 128 + 4 * l;
        const u32x2 w = *(const u32x2*)p;
        float x[4] = {bflo(w.x), bfhi(w.x), bflo(w.y), bfhi(w.y)};
        float ss = (x[0] * x[0] + x[1] * x[1]) + (x[2] * x[2] + x[3] * x[3]);
#pragma unroll
        for (int o = 1; o < 32; o <<= 1) ss += __shfl_xor(ss, o);
        const float rstd = 1.0f / sqrtf(ss * (1.0f / 128.0f) + EPS);
        const f32x4 g = (hh < 12) ? gq : gk;
        const int pos = t & (SEQ - 1); const float pp = part ? (float)(pos & 63) : (float)(pos >> 6);
        float y[4] = {x[0] * rstd * g.x, x[1] * rstd * g.y, x[2] * rstd * g.z, x[3] * rstd * g.w}, o4[4];
#pragma unroll
        for (int e = 0; e < 4; ++e) { const float yp = __shfl_xor(y[e], 8); const float ang = pp * inv[e]; const float sn = __sinf(ang), cs = __cosf(ang);
            o4[e] = y[e] * cs + (first ? -yp : yp) * sn; }
        u32x2 ow; ow.x = pk2(o4[0], o4[1]); ow.y = pk2(o4[2], o4[3]); *(u32x2*)p = ow;
    }
    const int gt = gw * 64 + lane, ngt = ngw * 64;
    for (int it = gt; it < M * 64; it += ngt) {
        const int t = it >> 6, c8 = (it & 63) * 8, g = c8 >> 7, w2 = 1 << g, pos = t & (SEQ - 1), base = t - pos;
        const int lo = max(pos - w2, 0), hi = min(pos + w2, SEQ);
        float acc[8] = {0.f, 0.f, 0.f, 0.f, 0.f, 0.f, 0.f, 0.f};
        for (int pz = lo; pz < hi; ++pz) { const u32x4 v = *(const u32x4*)(PROJ + (size_t)(base + pz) * ABW + c8);
            acc[0] += bflo(v.x); acc[1] += bfhi(v.x); acc[2] += bflo(v.y); acc[3] += bfhi(v.y); acc[4] += bflo(v.z); acc[5] += bfhi(v.z); acc[6] += bflo(v.w); acc[7] += bfhi(v.w); }
        const u32x4 sv = *(const u32x4*)(PROJ + (size_t)t * ABW + c8); const float iv = 1.0f / (float)(hi - lo);
        u32x4 o; o.x = pk2(acc[0] * iv - bflo(sv.x), acc[1] * iv - bfhi(sv.x)); o.y = pk2(acc[2] * iv - bflo(sv.y), acc[3] * iv - bfhi(sv.y));
        o.z = pk2(acc[4] * iv - bflo(sv.z), acc[5] * iv - bfhi(sv.z)); o.w = pk2(acc[6] * iv - bflo(sv.w), acc[7] * iv - bfhi(sv.w));
        *(u32x4*)(POOLED + (size_t)t * 512 + c8) = o;
    }
}

__device__ __forceinline__ void conv_act(const bf16* __restrict__ U, const float* __restrict__ cw, const float* __restrict__ cb, bf16* __restrict__ ACT, int gt, int ngt) {
    for (int it = gt; it < 1024 * 704; it += ngt) {
        const int jc = it % 704, tb = it / 704, j = jc * 8, t0 = tb * 8;
        float c0g[8], c1g[8], c2g[8], cbg[8], c0v[8], c1v[8], c2v[8], cbv[8];
#pragma unroll
        for (int e = 0; e < 8; e += 4) {
            const f32x4 a0 = *(const f32x4*)(cw + j + e), a1 = *(const f32x4*)(cw + FF2 + j + e), a2 = *(const f32x4*)(cw + 2 * FF2 + j + e), ab = *(const f32x4*)(cb + j + e);
            const f32x4 b0 = *(const f32x4*)(cw + FF + j + e), b1 = *(const f32x4*)(cw + FF2 + FF + j + e), b2 = *(const f32x4*)(cw + 2 * FF2 + FF + j + e), bb = *(const f32x4*)(cb + FF + j + e);
#pragma unroll
            for (int q = 0; q < 4; ++q) { c0g[e + q] = a0[q]; c1g[e + q] = a1[q]; c2g[e + q] = a2[q]; cbg[e + q] = ab[q]; c0v[e + q] = b0[q]; c1v[e + q] = b1[q]; c2v[e + q] = b2[q]; cbv[e + q] = bb[q]; }
        }
        for (int tt = 0; tt < 8; ++tt) {
            const int t = t0 + tt, pos = t & (SEQ - 1);
            const bf16* r1 = U + (size_t)t * FF2 + j;
            const u32x4 z = {0u, 0u, 0u, 0u};
            const u32x4 g1 = *(const u32x4*)r1, v1 = *(const u32x4*)(r1 + FF);
            const u32x4 g0 = pos > 0 ? *(const u32x4*)(r1 - FF2) : z, v0 = pos > 0 ? *(const u32x4*)(r1 - FF2 + FF) : z;
            const u32x4 g2 = pos < SEQ - 1 ? *(const u32x4*)(r1 + FF2) : z, v2 = pos < SEQ - 1 ? *(const u32x4*)(r1 + FF2 + FF) : z;
            float o[8];
#pragma unroll
            for (int q = 0; q < 4; ++q) {
                const float ga = c0g[2 * q] * bflo(g0[q]) + c1g[2 * q] * bflo(g1[q]) + c2g[2 * q] * bflo(g2[q]) + cbg[2 * q];
                const float gb = c0g[2 * q + 1] * bfhi(g0[q]) + c1g[2 * q + 1] * bfhi(g1[q]) + c2g[2 * q + 1] * bfhi(g2[q]) + cbg[2 * q + 1];
                const float va = c0v[2 * q] * bflo(v0[q]) + c1v[2 * q] * bflo(v1[q]) + c2v[2 * q] * bflo(v2[q]) + cbv[2 * q];
                const float vb = c0v[2 * q + 1] * bfhi(v0[q]) + c1v[2 * q + 1] * bfhi(v1[q]) + c2v[2 * q + 1] * bfhi(v2[q]) + cbv[2 * q + 1];
                o[2 * q] = ga / (1.0f + __expf(-ga)) * va; o[2 * q + 1] = gb / (1.0f + __expf(-gb)) * vb;
            }
            u32x4 ow; ow.x = pk2(o[0], o[1]); ow.y = pk2(o[2], o[3]); ow.z = pk2(o[4], o[5]); ow.w = pk2(o[6], o[7]);
            *(u32x4*)(ACT + (size_t)t * FF + j) = ow;
        }
    }
}

__device__ __forceinline__ void gates_phase(const bf16* __restrict__ XN, const bf16* __restrict__ WG, const float* __restrict__ bg, float* __restrict__ GATES, LAS float* red, int bid, int nblk) {
    const int tid = mk_tid(), wid = tid >> 6, lane = tid & 63, fr = lane & 15, fq = lane >> 4;
    const int tile = wid & 3, tt = tile & 1, jt = tile >> 1, kh = wid >> 2;
    for (int grp = bid; grp < 256; grp += nblk) {
        f32x4 acc = {0.f, 0.f, 0.f, 0.f};
        const bf16* ap = WG + (size_t)(jt * 16 + fr) * D + kh * 1024 + fq * 8;
        const bf16* bp = XN + (size_t)(grp * 32 + tt * 16 + fr) * D + kh * 1024 + fq * 8;
#pragma unroll 8
        for (int ks = 0; ks < 32; ++ks) { const bf16x8 a = *(const bf16x8*)(ap + ks * 32), b = *(const bf16x8*)(bp + ks * 32); acc = __builtin_amdgcn_mfma_f32_16x16x32_bf16(a, b, acc, 0, 0, 0); }
        if (kh == 1) { LAS float* r = red + (tile * 64 + lane) * 4; r[0] = acc[0]; r[1] = acc[1]; r[2] = acc[2]; r[3] = acc[3]; }
        __syncthreads();
        if (kh == 0) { const LAS float* r = red + (tile * 64 + lane) * 4; const int t = grp * 32 + tt * 16 + fr, j = jt * 16 + 4 * fq;
            const f32x4 b4 = *(const f32x4*)(bg + j); f32x4 o; o.x = acc[0] + r[0] + b4.x; o.y = acc[1] + r[1] + b4.y; o.z = acc[2] + r[2] + b4.z; o.w = acc[3] + r[3] + b4.w;
            *(f32x4*)(GATES + (size_t)t * 32 + j) = o; }
        __syncthreads();
    }
}

__device__ __forceinline__ void headnorm_phase(const float* __restrict__ HF, const bf16* __restrict__ OG, const float* __restrict__ hn, bf16* __restrict__ Y, int gw, int ngw, int lane) {
    for (int it = gw; it < M * 8; it += ngw) {
        const int t = it >> 3, h = it & 7; const size_t off = (size_t)t * D + h * 256 + 4 * lane;
        const f32x4 a = *(const f32x4*)(HF + off), b = *(const f32x4*)(HF + (size_t)M * D + off); const f32x4 s = a + b;
        const float ss = wave_sum((s.x * s.x + s.y * s.y) + (s.z * s.z + s.w * s.w));
        const float rstd = 1.0f / sqrtf(ss * (1.0f / 256.0f) + EPS);
        const f32x4 g = *(const f32x4*)(hn + h * 256 + 4 * lane); const u32x2 ow = *(const u32x2*)(OG + off);
        const float o0 = bflo(ow.x), o1 = bfhi(ow.x), o2 = bflo(ow.y), o3 = bfhi(ow.y);
        u32x2 w; w.x = pk2(s.x * rstd * g.x / (1.0f + __expf(-o0)), s.y * rstd * g.y / (1.0f + __expf(-o1)));
        w.y = pk2(s.z * rstd * g.z / (1.0f + __expf(-o2)), s.w * rstd * g.w / (1.0f + __expf(-o3)));
        *(u32x2*)(Y + off) = w;
    }
}

namespace ml {
constexpr int LQ = 264, LS = 72;
constexpr int OFF_Q = 0, OFF_K = 33792, OFF_KT = 67584, OFF_VT = 104448, OFF_VTW = 111360, OFF_P = 118272, OFF_CT = 127488, OFF_SC = 152832;
static_assert(OFF_SC + 1280 + 1024 == LDS_ML, "mlstm lds map");
#define ML_BAR() do { asm volatile("s_waitcnt lgkmcnt(0)" ::: "memory"); __builtin_amdgcn_s_barrier(); asm volatile("" ::: "memory"); } while (0)
#define ML_MFMA(a, b, c) __builtin_amdgcn_mfma_f32_16x16x32_bf16(a, b, c, 0, 0, 0)

__device__ __forceinline__ void mlstm_phase(LAS unsigned char* lds, const bf16* __restrict__ QK, const bf16* __restrict__ KVT, const float* __restrict__ GATES, float* __restrict__ HF, int bid, int nblk) {
    const int tid = mk_tid(), wid = tid >> 6, lane = tid & 63, fr = lane & 15, fq = lane >> 4;
    LAS bf16* Qs = (LAS bf16*)(lds + OFF_Q); LAS bf16* Ks = (LAS bf16*)(lds + OFF_K); LAS bf16* KTs = (LAS bf16*)(lds + OFF_KT);
    LAS bf16* VTs = (LAS bf16*)(lds + OFF_VT); LAS bf16* VTw = (LAS bf16*)(lds + OFF_VTW); LAS bf16* Ps = (LAS bf16*)(lds + OFF_P); LAS bf16* CTs = (LAS bf16*)(lds + OFF_CT);
    LAS float* sA = (LAS float*)(lds + OFF_SC); LAS float* sM = sA + 64; LAS float* sAI = sM + 64; LAS float* sEM = sAI + 64; LAS float* sWS = (LAS float*)(lds + OFF_SC + 1280);
    const int tt = wid & 3, sh = wid >> 2;
    for (int it0 = bid; it0 < 256; it0 += nblk) {
        const int item = (nblk == 256) ? (((it0 & 7) * 4 + (it0 >> 6)) * 8 + ((it0 >> 3) & 7)) : it0;
        const int es = item & 7, dir = (item >> 3) & 1, h = (item >> 4) & 7, b = (item >> 7) & 1;
        for (int i = tid; i < 48 * LQ / 2; i += 512) ((LAS unsigned*)CTs)[i] = 0u;
        for (int i = tid; i < 16 * LS; i += 512) { VTs[32 * LS + i] = (i < LS) ? (bf16)0x3F80 : (bf16)0; VTw[32 * LS + i] = (bf16)0; }
        f32x4 ct[2][3];
#pragma unroll
        for (int a = 0; a < 2; ++a)
#pragma unroll
            for (int e = 0; e < 3; ++e) ct[a][e] = (f32x4){0.f, 0.f, 0.f, 0.f};
        float m_st = 0.f, decay = 1.f;
        bf16x8 rq[4], rk[4], rkt[4], rvt = {0, 0, 0, 0, 0, 0, 0, 0}; float gi = 0.f, gf = 0.f;
        const unsigned voffQ = (unsigned)(((tid >> 5) * 4096 + (tid & 31) * 8) * 2), voffT = (unsigned)(((tid >> 3) * M + (tid & 7) * 8) * 2), voffG = (unsigned)((dir ? 63 - lane : lane) * 128);
#define ML_LOAD(c) do { const int ncn_ = dir ? 63 - (c) : (c); const size_t trow_ = (size_t)b * SEQ + (size_t)ncn_ * 64; \
        const char* qb_ = (const char*)(QK + trow_ * 4096 + h * 256); \
        _Pragma("unroll") for (int i_ = 0; i_ < 4; ++i_) { rq[i_] = *(const bf16x8*)(qb_ + (size_t)i_ * 131072 + voffQ); rk[i_] = *(const bf16x8*)(qb_ + 4096 + (size_t)i_ * 131072 + voffQ); } \
        const char* tb_ = (const char*)(KVT + (size_t)(h * 256) * M + trow_); \
        _Pragma("unroll") for (int i_ = 0; i_ < 4; ++i_) rkt[i_] = *(const bf16x8*)(tb_ + (size_t)i_ * (64 * M * 2) + voffT); \
        if (tid < 256) rvt = *(const bf16x8*)((const char*)(KVT + (size_t)(2048 + h * 256 + es * 32) * M + trow_) + voffT); \
        { const float* gp_ = GATES + trow_ * 32 + dir * 16 + h; gi = *(const float*)((const char*)gp_ + voffG); gf = *(const float*)((const char*)gp_ + 32 + voffG); } } while (0)
#define ML_STORE() do { \
        const float lf_ = fminf(gf, 0.f) - log1pf(__expf(-fabsf(gf))); float bc_ = lf_; \
        _Pragma("unroll") for (int o_ = 1; o_ < 64; o_ <<= 1) { const float t_ = __shfl_up(bc_, o_); if (lane >= o_) bc_ += t_; } \
        const float a_ = gi - bc_; float cm_ = a_; \
        _Pragma("unroll") for (int o_ = 1; o_ < 64; o_ <<= 1) { const float t_ = __shfl_up(cm_, o_); if (lane >= o_) cm_ = fmaxf(cm_, t_); } \
        const float Mv_ = fmaxf(m_st, cm_), blast_ = __shfl(bc_, 63), cml_ = __shfl(cm_, 63), Mn_ = fmaxf(m_st, cml_); \
        const float ai_ = __expf(m_st - Mv_), em_ = __expf(-(bc_ + Mv_)), wsv_ = __expf(a_ - Mn_); decay = __expf(m_st - Mn_); m_st = blast_ + Mn_; \
        const int rr_ = dir ? 63 - lane : lane; \
        if (wid == 0) { sA[rr_] = a_; sM[rr_] = Mv_; sAI[rr_] = ai_; sEM[rr_] = em_; VTw[32 * LS + rr_] = (bf16)f2bf(wsv_); } \
        _Pragma("unroll") for (int i_ = 0; i_ < 4; ++i_) { const int q_ = tid + 512 * i_, r_ = q_ >> 5, cc_ = (q_ & 31) * 8; \
            *(LAS bf16x8*)(Qs + r_ * LQ + cc_) = rq[i_]; *(LAS bf16x8*)(Ks + r_ * LQ + cc_) = rk[i_]; } \
        _Pragma("unroll") for (int i_ = 0; i_ < 4; ++i_) { const int q_ = tid + 512 * i_, d_ = q_ >> 3, cc_ = (q_ & 7) * 8; *(LAS bf16x8*)(KTs + d_ * LS + cc_) = rkt[i_]; } \
        if (tid < 256) { const int e_ = tid >> 3, cc_ = (tid & 7) * 8; *(LAS bf16x8*)(VTs + e_ * LS + cc_) = rvt; \
            LAS float* wsp_ = sWS + wid * 64; wsp_[rr_] = wsv_; asm volatile("s_waitcnt lgkmcnt(0)" ::: "memory"); \
            const f32x4 wa_ = *(const LAS f32x4*)(wsp_ + cc_), wb_ = *(const LAS f32x4*)(wsp_ + cc_ + 4); const float wv_[8] = {wa_.x, wa_.y, wa_.z, wa_.w, wb_.x, wb_.y, wb_.z, wb_.w}; \
            const u32x4 rv_ = __builtin_bit_cast(u32x4, rvt); u32x4 o_; \
            o_.x = pk2(bflo(rv_.x) * wv_[0], bfhi(rv_.x) * wv_[1]); o_.y = pk2(bflo(rv_.y) * wv_[2], bfhi(rv_.y) * wv_[3]); \
            o_.z = pk2(bflo(rv_.z) * wv_[4], bfhi(rv_.z) * wv_[5]); o_.w = pk2(bflo(rv_.w) * wv_[6], bfhi(rv_.w) * wv_[7]); \
            *(LAS u32x4*)(VTw + e_ * LS + cc_) = o_; } } while (0)
        ML_LOAD(0);
        ML_BAR();
        ML_STORE();
        ML_BAR();
        ML_LOAD(1);
        for (int c = 0; c < 64; ++c) {
            const int ncn = dir ? 63 - c : c; const size_t trow = (size_t)b * SEQ + (size_t)ncn * 64;
            const float dec_c = decay;
            f32x4 s0 = {0.f, 0.f, 0.f, 0.f}, s1 = s0, n3 = s0, d3 = s0;
            {
                const LAS bf16* qp = Qs + (tt * 16 + fr) * LQ + fq * 8;
                const LAS bf16* kp0 = Ks + ((2 * sh) * 16 + fr) * LQ + fq * 8; const LAS bf16* kp1 = kp0 + 16 * LQ;
                const LAS bf16* cp0 = CTs + (sh * 16 + fr) * LQ + fq * 8; const LAS bf16* cp2 = CTs + (32 + fr) * LQ + fq * 8;
#pragma unroll
                for (int hf = 0; hf < 4; ++hf) {
                    bf16x8 qf[2], k0[2], k1[2], c0[2], c2[2];
#pragma unroll
                    for (int k4 = 0; k4 < 2; ++k4) { const int ko = (hf * 2 + k4) * 32;
                        qf[k4] = *(const LAS bf16x8*)(qp + ko); k0[k4] = *(const LAS bf16x8*)(kp0 + ko); k1[k4] = *(const LAS bf16x8*)(kp1 + ko);
                        c0[k4] = *(const LAS bf16x8*)(cp0 + ko); c2[k4] = *(const LAS bf16x8*)(cp2 + ko); }
                    __builtin_amdgcn_sched_barrier(0);
#pragma unroll
                    for (int k4 = 0; k4 < 2; ++k4) { s0 = ML_MFMA(k0[k4], qf[k4], s0); s1 = ML_MFMA(k1[k4], qf[k4], s1); n3 = ML_MFMA(c0[k4], qf[k4], n3); d3 = ML_MFMA(c2[k4], qf[k4], d3); }
                }
            }
            const int t = tt * 16 + fr; const float Mt = sM[t];
            {
                const int sb0 = (2 * sh) * 16 + 4 * fq, sb1 = sb0 + 16;
                const f32x4 a0 = *(const LAS f32x4*)(sA + sb0), a1 = *(const LAS f32x4*)(sA + sb1);
                float p0[4], p1[4];
#pragma unroll
                for (int r = 0; r < 4; ++r) {
                    const int sa = sb0 + r, sbb = sb1 + r;
                    const bool ok0 = dir ? (sa >= t) : (sa <= t), ok1 = dir ? (sbb >= t) : (sbb <= t);
                    p0[r] = ok0 ? s0[r] * __expf(a0[r] - Mt) : 0.f; p1[r] = ok1 ? s1[r] * __expf(a1[r] - Mt) : 0.f;
                }
                u32x2 w0, w1; w0.x = pk2(p0[0], p0[1]); w0.y = pk2(p0[2], p0[3]); w1.x = pk2(p1[0], p1[1]); w1.y = pk2(p1[2], p1[3]);
                *(LAS u32x2*)(Ps + t * LS + sb0) = w0; *(LAS u32x2*)(Ps + t * LS + sb1) = w1;
            }
            ML_BAR();
            f32x4 n2 = {0.f, 0.f, 0.f, 0.f}, d2 = n2;
            {
                bf16x8 pf[2], v0[2], v2[2];
#pragma unroll
                for (int ks = 0; ks < 2; ++ks) { const int ko = ks * 32 + fq * 8;
                    pf[ks] = *(const LAS bf16x8*)(Ps + (tt * 16 + fr) * LS + ko); v0[ks] = *(const LAS bf16x8*)(VTs + (sh * 16 + fr) * LS + ko); v2[ks] = *(const LAS bf16x8*)(VTs + (32 + fr) * LS + ko); }
                __builtin_amdgcn_sched_barrier(0);
#pragma unroll
                for (int ks = 0; ks < 2; ++ks) { n2 = ML_MFMA(v0[ks], pf[ks], n2); d2 = ML_MFMA(v2[ks], pf[ks], d2); }
            }
            {
                const float ai = sAI[t], em = sEM[t];
                const float den0 = d2[0] + ai * d3[0];
                const float den = __shfl(den0, fr);
                const float rinv = 1.0f / fmaxf(fabsf(den), em);
                f32x4 hout; hout.x = (n2[0] + ai * n3[0]) * rinv; hout.y = (n2[1] + ai * n3[1]) * rinv; hout.z = (n2[2] + ai * n3[2]) * rinv; hout.w = (n2[3] + ai * n3[3]) * rinv;
                *(f32x4*)(HF + ((size_t)dir * M + trow + t) * D + h * 256 + es * 32 + sh * 16 + 4 * fq) = hout;
            }
#pragma unroll
            for (int a = 0; a < 2; ++a)
#pragma unroll
                for (int e = 0; e < 3; ++e) ct[a][e] = ct[a][e] * dec_c;
#pragma unroll
            for (int ks = 0; ks < 2; ++ks) { const int ko = ks * 32 + fq * 8; bf16x8 kt[2], vw[3];
#pragma unroll
                for (int a = 0; a < 2; ++a) kt[a] = *(const LAS bf16x8*)(KTs + ((2 * wid + a) * 16 + fr) * LS + ko);
#pragma unroll
                for (int e = 0; e < 3; ++e) vw[e] = *(const LAS bf16x8*)(VTw + (e * 16 + fr) * LS + ko);
                __builtin_amdgcn_sched_barrier(0);
#pragma unroll
                for (int a = 0; a < 2; ++a)
#pragma unroll
                    for (int e = 0; e < 3; ++e) ct[a][e] = ML_MFMA(kt[a], vw[e], ct[a][e]);
            }
#pragma unroll
            for (int a = 0; a < 2; ++a)
#pragma unroll
                for (int e = 0; e < 3; ++e) { u32x2 w; w.x = f2bf(ct[a][e][0]) | (f2bf(ct[a][e][1]) << 16); w.y = f2bf(ct[a][e][2]) | (f2bf(ct[a][e][3]) << 16);
                    *(LAS u32x2*)(CTs + (e * 16 + fr) * LQ + (2 * wid + a) * 16 + 4 * fq) = w; }
            ML_BAR();
            if (c + 1 < 64) { ML_STORE(); }
            ML_BAR();
            if (c + 2 < 64) { ML_LOAD(c + 2); }
        }
#undef ML_LOAD
#undef ML_STORE
    }
}
}
}

struct EpiRes {
    static constexpr bool PERM = false, AFTER_DRAIN = false;
    const float* base; float* out; int ldc;
    __device__ __forceinline__ void operator()(const pg8::f32x4 (&acc)[2][2][4][2], const pg8::Unit& u, int wr, int wc, int fr, int fq) const {
#pragma unroll
        for (int ai = 0; ai < 2; ++ai)
#pragma unroll
            for (int m = 0; m < 4; ++m) { const size_t ro = (size_t)(u.pm * 256 + ai * 128 + wr * 64 + m * 16 + fr) * ldc + u.pn * 256 + wc * 32 + 4 * fq;
#pragma unroll
                for (int bj = 0; bj < 2; ++bj)
#pragma unroll
                    for (int n = 0; n < 2; ++n) { const size_t off = ro + bj * 128 + n * 16; const pg8::f32x4 bs = *(const pg8::f32x4*)(base + off); *(pg8::f32x4*)(out + off) = bs + acc[ai][bj][m][n]; } }
    }
};

struct GemmDesc { const unsigned short* A; const unsigned short* Bt; int Mg, Ng, Kg; int kind; unsigned short* O; int ldc; int split_cols; float scale0; const float* base; float* out; int G, c; };

#ifndef REPEAT_PH
#define REPEAT_PH 1000
#define N_REPEAT 0
#else
#define N_REPEAT 1
#endif
struct Params { const float* in[17]; float* out; unsigned char* ws; int ph_lo, ph_hi; };
constexpr int N_PHASES = 18;

__global__ void __launch_bounds__(512, 2) fwd_mega(Params p) {
    extern __shared__ __attribute__((aligned(16))) unsigned char lds_raw[];
    using namespace mk;
    cg::grid_group grid = cg::this_grid();
    LAS unsigned char* lds = (LAS unsigned char*)lds_raw;
    const int bid = blockIdx.x, nblk = gridDim.x;
    const int ph_lo = p.ph_lo, ph_hi = p.ph_hi;
    { volatile LAS unsigned* misc = (volatile LAS unsigned*)(lds + LDS_MISC); if (mk_tid() < 16) misc[mk_tid()] = 0u; }
    __syncthreads();
    (void)xcd_barrier_post((unsigned*)(p.ws + WS_BAR), (volatile LAS unsigned*)(lds + LDS_MISC) + 8);
    grid.sync();
#ifdef PROBE_PH
    const unsigned long long t_start = __builtin_amdgcn_s_memrealtime();
#endif
#pragma unroll 1
    for (int ph_it = ph_lo; ph_it < ph_hi + N_REPEAT; ++ph_it) {
        const int ph = ph_it <= REPEAT_PH ? ph_it : ph_it - N_REPEAT;
        typedef const __attribute__((address_space(4))) Params* KP;
        KP kp = (KP)__builtin_amdgcn_kernarg_segment_ptr(); asm volatile("" : "+s"(kp));
        unsigned char* ws = kp->ws; float* OUT = kp->out; bf16* XN = (bf16*)(ws + WS_XN);
        In I; I.x = kp->in[0]; I.norm_mix = kp->in[1]; I.norm_ffn = kp->in[2]; I.w_in_ab = kp->in[3]; I.pool_w = kp->in[4]; I.pool_scale = kp->in[5]; I.q_norm = kp->in[6]; I.k_norm = kp->in[7];
        I.w_out_ab = kp->in[8]; I.w_in_c = kp->in[9]; I.b_gate = kp->in[10]; I.h_norm = kp->in[11]; I.w_out_c = kp->in[12]; I.w_up = kp->in[13]; I.conv_w = kp->in[14]; I.conv_b = kp->in[15]; I.w_down = kp->in[16];
        int nb_ = nblk; asm volatile("" : "+s"(nb_)); const int ngw = nb_ * NW, ngt = nb_ * 512;
        const int tid = mk_tid(), lane = tid & 63, wave = __builtin_amdgcn_readfirstlane(tid >> 6), gw = bid * NW + wave, gt = bid * 512 + tid;
#ifndef NO_THIN
        if (ph == 0) prologue(I, ws, lds, gw, ngw, wave, lane);
        if (ph == 5 || ph == 9 || ph == 14) rmsnorm_rows(OUT, ph == 5 ? I.norm_ffn : (ph == 9 ? I.norm_mix + D : I.norm_ffn + D), XN, gw, ngw, lane);
        if (ph == 2) qk_rope_pool((bf16*)(ws + WS_PROJ), I.q_norm, I.k_norm, (bf16*)(ws + WS_POOLED), gw, ngw, lane);
#endif
#ifndef NO_ATT
        if (ph == 3) {
            const bf16* PROJ = (const bf16*)(ws + WS_PROJ); bf16* CAT = (bf16*)(ws + WS_CAT);
            for (int u0 = bid; u0 < 384; u0 += nblk) {
                int u = u0;
                if (nblk == 256) { const int xcd = u0 & 7, j = (u0 >> 3) & 31, rnd = u0 >> 8; const int jj = j + 32 * rnd;
                    if (jj >= 48) continue; u = (xcd >> 2) * 192 + ((xcd & 3) * 3 + (jj >> 4)) * 16 + (jj & 15); }
                const int qb = u & 15, hq = (u >> 4) % 12, b = u / 192;
                const size_t r0 = (size_t)b * SEQ + (size_t)qb * 256;
                att::attn_dense_body<att::bf16>((const att::bf16*)(PROJ + r0 * ABW + 512 + hq * 128), (const att::bf16*)(PROJ + (size_t)b * SEQ * ABW + 2048 + (hq / 3) * 128),
                                                (const att::bf16*)(PROJ + (size_t)b * SEQ * ABW + 2560 + (hq / 3) * 128), CAT + r0 * D + 512 + hq * 128, SEQ, (char*)lds_raw);
                __syncthreads();
            }
        }
#endif
#ifndef NO_THIN
        if (ph == 7 || ph == 16) { const int l = ph == 7 ? 0 : 1; conv_act((const bf16*)(ws + WS_U), I.conv_w + (size_t)l * 3 * FF2, I.conv_b + (size_t)l * FF2, (bf16*)(ws + WS_ACT), gt, ngt); }
        if (ph == 10) gates_phase(XN, (const bf16*)(ws + WS_C) + (size_t)8192 * D, I.b_gate, (float*)(ws + WS_GATES), (LAS float*)lds, bid, nblk);
#endif
#ifndef NO_ML
        if (ph == 11) ml::mlstm_phase(lds, (const bf16*)(ws + WS_QK), (const bf16*)(ws + WS_KVT), (const float*)(ws + WS_GATES), (float*)(ws + WS_HF), bid, nblk);
#endif
#ifndef NO_THIN
        if (ph == 12) headnorm_phase((const float*)(ws + WS_HF), (const bf16*)(ws + WS_OG), I.h_norm, (bf16*)(ws + WS_Y), gw, ngw, lane);
#endif
#pragma unroll 1
        for (int gi = 0; gi < 3; ++gi) {
            GemmDesc d; d.kind = -1; d.G = nblk; d.c = bid; d.split_cols = 0; d.scale0 = 1.f; d.base = nullptr; d.out = nullptr; d.O = nullptr; d.ldc = 0; d.A = nullptr; d.Bt = nullptr; d.Mg = M; d.Ng = 0; d.Kg = D;
            if (gi == 0) {
                if (ph == 1) { d.kind = 0; d.A = XN; d.Bt = (bf16*)(ws + WS_AB); d.Ng = ABW; d.O = (bf16*)(ws + WS_PROJ); d.ldc = ABW; }
                else if (ph == 3) { d.kind = 0; d.A = (bf16*)(ws + WS_POOLED); d.Bt = (bf16*)(ws + WS_BD); d.Ng = 512; d.Kg = 512; d.O = (bf16*)(ws + WS_CAT); d.ldc = D;
                    if (nblk == 256) { const int slot = bid >> 3; d.G = 64; d.c = (slot - 16) * 8 + (bid & 7); if (slot < 16 || slot >= 24) d.kind = -1; } }
                else if (ph == 4) { d.kind = 1; d.A = (bf16*)(ws + WS_CAT); d.Bt = (bf16*)(ws + WS_OAB); d.Ng = D; d.base = I.x; d.out = OUT; }
                else if (ph == 6 || ph == 15) { d.kind = 0; d.A = XN; d.Bt = (bf16*)(ws + (ph == 6 ? WS_UP0 : WS_UP1)); d.Ng = FF2; d.O = (bf16*)(ws + WS_U); d.ldc = FF2; }
                else if (ph == 8 || ph == 17) { d.kind = 1; d.A = (bf16*)(ws + WS_ACT); d.Bt = (bf16*)(ws + (ph == 8 ? WS_DN0 : WS_DN1)); d.Ng = D; d.Kg = FF; d.base = OUT; d.out = OUT; }
                else if (ph == 10) { d.kind = 0; d.A = XN; d.Bt = (bf16*)(ws + WS_C); d.Ng = 4096; d.O = (bf16*)(ws + WS_QK); d.ldc = 4096; d.split_cols = 2048; d.scale0 = 0.0625f; }
                else if (ph == 13) { d.kind = 1; d.A = (bf16*)(ws + WS_Y); d.Bt = (bf16*)(ws + WS_OC); d.Ng = D; d.base = OUT; d.out = OUT; }
            } else if (ph == 10) {
                if (gi == 1) { d.kind = 0; d.A = XN; d.Bt = (bf16*)(ws + WS_C) + (size_t)6144 * D; d.Ng = D; d.O = (bf16*)(ws + WS_OG); d.ldc = D; }
                else { d.kind = 0; d.A = (bf16*)(ws + WS_C) + (size_t)2048 * D; d.Bt = XN; d.Mg = 4096; d.Ng = M; d.O = (bf16*)(ws + WS_KVT); d.ldc = M; }
            }
#ifndef NO_GEMM
            if (d.kind == 0) {
                pg8::Gemm g{d.A, d.Bt, d.Mg, d.Ng, d.Kg}; pg8::StaticOrder S; S.init(d.Mg, d.Ng, d.G, d.c);
                pg8::EpiBf16<0> E{d.O, d.ldc, nullptr, d.split_cols, (size_t)d.split_cols, d.scale0};
                pg8::gemm_phase<pg8::EpiBf16<0>, pg8::StaticOrder, true, true>(lds, g, S, E);
            } else if (d.kind == 1) {
                pg8::Gemm g{d.A, d.Bt, d.Mg, d.Ng, d.Kg}; pg8::StaticOrder S; S.init(d.Mg, d.Ng, d.G, d.c);
                EpiRes E{d.base, d.out, D};
                pg8::gemm_phase<EpiRes, pg8::StaticOrder, true, true>(lds, g, S, E);
            }
#endif
            __syncthreads();
        }
        if (ph_it + 1 < ph_hi + N_REPEAT) { XcdBarrier xbar; xbar.bar = (unsigned*)(ws + WS_BAR); xbar.x = xb_xcc_id(); xbar.st = (volatile LAS unsigned*)(lds + LDS_MISC) + 8; xcd_barrier(xbar);
#ifdef SYNC2
            xcd_barrier(xbar);
#endif
        }
#ifdef PROBE_PH
        if (bid == 0 && tid == 0) { unsigned long long* ts = (unsigned long long*)(ws + WS_BD + 768 * 1024); ts[ph + 1] = __builtin_amdgcn_s_memrealtime(); if (ph == 0) ts[0] = t_start;
            if (ph + 1 == ph_hi) { OUT[0] = (float)(ts[PROBE_PH + 1] - ts[PROBE_PH]) * 0.01f; } }
#endif
    }
}

#ifndef MK_MULTI
#define MK_MULTI 0
#endif
extern "C" void kernel_launch(void* const* d_in, const int* in_sizes, int n_in, void* d_out, int out_size, void* d_ws, size_t ws_size, hipStream_t stream) {
    static int grid = 0;
    if (grid == 0) {
        if (n_in != 17 || out_size != mk::M * mk::D || ws_size < mk::WS_END) { fprintf(stderr, "kernel_launch: unexpected shapes n_in %d out %d ws %zu (need %zu)\n", n_in, out_size, ws_size, (size_t)mk::WS_END); grid = -1; return; }
        int dev = 0, cus = 0, per_cu = 0;
        (void)hipGetDevice(&dev); (void)hipDeviceGetAttribute(&cus, hipDeviceAttributeMultiprocessorCount, dev);
        if (hipFuncSetAttribute((const void*)fwd_mega, hipFuncAttributeMaxDynamicSharedMemorySize, mk::LDS_BYTES) != hipSuccess) { fprintf(stderr, "kernel_launch: hipFuncSetAttribute failed\n"); grid = -1; return; }
        if (hipOccupancyMaxActiveBlocksPerMultiprocessor(&per_cu, (const void*)fwd_mega, 512, mk::LDS_BYTES) != hipSuccess || per_cu < 1) { fprintf(stderr, "kernel_launch: occupancy query gave %d\n", per_cu); per_cu = 1; }
        (void)hipGetLastError();
        if (cus <= 0) cus = 256;
        grid = cus * per_cu; if (grid > 256) grid = 256;
        fprintf(stderr, "kernel_launch: cus %d per_cu %d grid %d\n", cus, per_cu, grid);
    }
    if (grid < 0) return;
    if (hipMemsetAsync((char*)d_ws + mk::WS_BAR, 0, mk::BAR_BYTES, stream) != hipSuccess) { fprintf(stderr, "kernel_launch: memset failed\n"); return; }
    Params p{};
    for (int i = 0; i < 17; ++i) p.in[i] = (const float*)d_in[i];
    p.out = (float*)d_out; p.ws = (unsigned char*)d_ws;
#if MK_MULTI
    for (int ph = 0; ph < N_PHASES; ++ph) { p.ph_lo = ph; p.ph_hi = ph + 1; hipLaunchKernelGGL(fwd_mega, dim3(grid), dim3(512), mk::LDS_BYTES, stream, p); }
#else
    p.ph_lo = 0; p.ph_hi = N_PHASES;
    void* args[] = {&p};
    const hipError_t e = hipLaunchCooperativeKernel((const void*)fwd_mega, dim3(grid), dim3(512), args, mk::LDS_BYTES, stream);
    if (e != hipSuccess) fprintf(stderr, "kernel_launch: cooperative launch failed: %s (grid %d)\n", hipGetErrorString(e), grid);
#endif
}
```

```cpp
#include <hip/hip_runtime.h>
#include <hip/hip_cooperative_groups.h>
#include <hip/hip_bf16.h>
#include <cstdio>
#include <cstdint>
#include <cmath>
namespace cg = cooperative_groups;
__device__ __forceinline__ int mk_tid();
namespace pg8 {
#define PG8_LAS __attribute__((address_space(3)))
typedef unsigned short bf16_t;
typedef short bf16x8 __attribute__((ext_vector_type(8)));
typedef float f32x4 __attribute__((ext_vector_type(4)));
typedef unsigned u32x4 __attribute__((ext_vector_type(4)));
constexpr int BM = 256, BK = 64, HALF = 128, HTB = HALF * BK * 2  , STAGE_BYTES = 8 * HTB, NXCD = 8, WGM = 8;

__host__ __device__ __forceinline__ int lds_byte(int r, int c) { const int st = (r >> 4) * 2 + (c >> 5), rr = r & 15, cc = c & 31, ob = rr * 64 + cc * 2; return st * 1024 + (ob ^ (((ob >> 9) & 1) << 5)); }
__host__ __device__ __forceinline__ void stage_rc(int b, int& R, int& C) { const int st = b / 1024, sb = b % 1024, swz = sb ^ (((sb >> 9) & 1) << 5); R = (st >> 1) * 16 + swz / 64; C = (st & 1) * 32 + (swz % 64) / 2; }
__host__ __device__ __forceinline__ int perm32(int rho) { const int n = rho >> 4, i = rho & 15; return 8 * (i >> 2) + 4 * n + (i & 3); }

struct Unit { int pm, pn; };
struct Gemm { const bf16_t* A; const bf16_t* Bt; int M, N, K; };

struct StaticOrder {
    int nM, nN, nwg, G, c;
    __host__ __device__ void init(int M, int N, int G_, int c_) { nM = M / BM; nN = N / BM; nwg = nM * nN; G = G_; c = c_; }
    __host__ __device__ bool next(int i, Unit& u) const {
        const long L = (long)i * G + c; if (L >= nwg) return false;
        int wgid = (int)L; { const int q = nwg / NXCD, r = nwg % NXCD, xcd = wgid % NXCD, off = wgid / NXCD; wgid = (xcd < r ? xcd * (q + 1) : r * (q + 1) + (xcd - r) * q) + off; }
        const int nig = WGM * nN, gid = wgid / nig, fm = gid * WGM, gsz = (nM - fm) < WGM ? (nM - fm) : WGM;
        u.pm = fm + ((wgid % nig) % gsz); u.pn = (wgid % nig) / gsz; return true;
    }
    __device__ __forceinline__ void a_ready(const Unit&) const {}
    __device__ __forceinline__ void done(const Unit&) const {}
};

__device__ __forceinline__ unsigned cvt_pk_bf16(float lo, float hi) { unsigned r; asm volatile("v_cvt_pk_bf16_f32 %0, %1, %2" : "=v"(r) : "v"(lo), "v"(hi)); return r; }
typedef float f32x2 __attribute__((ext_vector_type(2)));
__device__ __forceinline__ f32x2 gelu_pk(f32x2 v) {
    const f32x2 av = __builtin_elementwise_abs(v), d = av * 0.2316418882f + 1.0f;
    f32x2 t; t.x = __builtin_amdgcn_rcpf(d.x); t.y = __builtin_amdgcn_rcpf(d.y);
    f32x2 q = t * 0.5307027145f + (-0.7265760135f); q = q * t + 0.7107068705f; q = q * t + (-0.142248368f); q = q * t + 0.127414796f; q = q * t;
    const f32x2 s = (v * v) * (-0.72134752044f);
    f32x2 e; e.x = __builtin_amdgcn_exp2f(s.x); e.y = __builtin_amdgcn_exp2f(s.y);
    const f32x2 m = v * (q * e), r = v - m;
    f32x2 o; o.x = v.x < 0.f ? m.x : r.x; o.y = v.y < 0.f ? m.y : r.y; return o;
}

template <int ACT  > struct EpiBf16 {
    static constexpr bool PERM = true, AFTER_DRAIN = false; static_assert(ACT == 0 || ACT == 1, "EpiBf16: ACT is 0 (none) or 1 (gelu_pk)");
    bf16_t* O; int ldc; const float* bias; int split_cols; size_t split_stride; float scale0;
    __device__ __forceinline__ void operator()(const f32x4 (&acc)[2][2][4][2], const Unit& u, int wr, int wc, int fr, int fq) const {
        const int row0 = u.pm * BM + wr * 64 + fr; int colt = u.pn * BM; bf16_t* base = O;
        float sc = 1.f; if (split_cols) { const int t = colt / split_cols; base += (size_t)t * split_stride; colt -= t * split_cols; if (t == 0) sc = scale0; }
        const int col0 = colt + wc * 32 + 8 * fq, bcol0 = u.pn * BM + wc * 32 + 8 * fq;
        f32x4 bv[2][2];
#pragma unroll
        for (int bj = 0; bj < 2; ++bj)
#pragma unroll
            for (int n = 0; n < 2; ++n) bv[bj][n] = bias ? *(const f32x4*)(bias + bcol0 + bj * HALF + 4 * n) : (f32x4){0.f, 0.f, 0.f, 0.f};
#pragma unroll
        for (int ai = 0; ai < 2; ++ai)
#pragma unroll
            for (int m = 0; m < 4; ++m) { bf16_t* rowp = base + (size_t)(row0 + ai * HALF + m * 16) * ldc + col0;
#pragma unroll
                for (int bj = 0; bj < 2; ++bj) { f32x4 v0 = acc[ai][bj][m][0] + bv[bj][0], v1 = acc[ai][bj][m][1] + bv[bj][1];
                    if (ACT == 1) { f32x2 a = gelu_pk((f32x2){v0[0], v0[1]}), b = gelu_pk((f32x2){v0[2], v0[3]}), c = gelu_pk((f32x2){v1[0], v1[1]}), d = gelu_pk((f32x2){v1[2], v1[3]});
                        v0 = (f32x4){a.x, a.y, b.x, b.y}; v1 = (f32x4){c.x, c.y, d.x, d.y}; }
                    v0 = v0 * sc; v1 = v1 * sc; u32x4 w; w.x = cvt_pk_bf16(v0[0], v0[1]); w.y = cvt_pk_bf16(v0[2], v0[3]); w.z = cvt_pk_bf16(v1[0], v1[1]); w.w = cvt_pk_bf16(v1[2], v1[3]);
                    *(u32x4*)(rowp + bj * HALF) = w; } }
    }
};

template <class Epi, class Sched, bool ALIGN_EPI = false, bool SP2 = false>
__device__ __forceinline__ void gemm_phase(PG8_LAS unsigned char* lds, const Gemm g, const Sched& S, const Epi& E) {
    const int tid = mk_tid(), wid = __builtin_amdgcn_readfirstlane(tid >> 6), lane = tid & 63, wr = wid >> 2, wc = wid & 3, fr = lane & 15, fq = lane >> 4;
    const int K = g.K, nt = K / BK;
    unsigned voffA[2], voffB[2];
#pragma unroll
    for (int i = 0; i < 2; ++i) { int R, C; stage_rc(tid * 16 + i * 8192, R, C); const int Rb = Epi::PERM ? ((R & ~31) + perm32(R & 31)) : R;
        voffA[i] = (unsigned)(R * K + C) * 2u; voffB[i] = (unsigned)(Rb * K + C) * 2u; }
    const size_t kstep = (size_t)(BK * 2);
    const size_t hstep = (size_t)HALF * K * 2;
    const size_t tstep = 2 * hstep;
    const unsigned ldsw = (unsigned)wid * 1024u;
    const int aoff = lds_byte(wr * 64 + fr, fq * 8), boff = lds_byte(wc * 32 + fr, fq * 8);
#define PG8_SA(b, h) (((b) * 2 + (h)) * HTB)
#define PG8_SB(b, h) ((4 + (b) * 2 + (h)) * HTB)
#define PG8_STAGE(bufoff, gbase, voff) do { _Pragma("unroll") for (int _i = 0; _i < 2; ++_i) \
        __builtin_amdgcn_global_load_lds((const unsigned*)((const char*)(gbase) + (voff)[_i]), (PG8_LAS unsigned*)(lds + (bufoff) + ldsw + _i * 8192), 16, 0, 0); } while (0)
#define PG8_LDA(dst, b, h) do { _Pragma("unroll") for (int m = 0; m < 4; ++m) _Pragma("unroll") for (int k = 0; k < 2; ++k) dst[m][k] = *(const PG8_LAS bf16x8*)(lds + PG8_SA(b, h) + aoff + m * 2048 + k * 1024); } while (0)
#define PG8_LDB(dst, b, h) do { _Pragma("unroll") for (int n = 0; n < 2; ++n) _Pragma("unroll") for (int k = 0; k < 2; ++k) dst[n][k] = *(const PG8_LAS bf16x8*)(lds + PG8_SB(b, h) + boff + n * 2048 + k * 1024); } while (0)
#define PG8_MMA(ai, bj, At, Bt) do { __builtin_amdgcn_s_setprio(1); _Pragma("unroll") for (int m = 0; m < 4; ++m) _Pragma("unroll") for (int n = 0; n < 2; ++n) _Pragma("unroll") for (int k = 0; k < 2; ++k) \
        acc[ai][bj][m][n] = __builtin_amdgcn_mfma_f32_16x16x32_bf16(Bt[n][k], At[m][k], acc[ai][bj][m][n], 0, 0, 0); __builtin_amdgcn_s_setprio(0); } while (0)
#define PG8_WAIT_V(n) asm volatile("s_waitcnt vmcnt(" #n ")" ::: "memory")
#define PG8_WAIT_L(n) asm volatile("s_waitcnt lgkmcnt(" #n ")" ::: "memory")
#define PG8_BAR __builtin_amdgcn_s_barrier()
#define PG8_SCHED __builtin_amdgcn_sched_barrier(0)
    Unit cur, nxt; int ui = 0;
    if (!S.next(0, cur)) return;
    f32x4 acc[2][2][4][2];
#pragma unroll
    for (int a = 0; a < 2; ++a)
#pragma unroll
        for (int b = 0; b < 2; ++b)
#pragma unroll
            for (int m = 0; m < 4; ++m)
#pragma unroll
                for (int n = 0; n < 2; ++n) acc[a][b][m][n] = (f32x4){0.f, 0.f, 0.f, 0.f};
    bf16x8 At[4][2], B0[2][2], B1[2][2];
    const char* cA = (const char*)g.A + (size_t)cur.pm * tstep; const char* cB = (const char*)g.Bt + (size_t)cur.pn * tstep;
    S.a_ready(cur);
    if constexpr (SP2) {
        PG8_STAGE(PG8_SB(0, 0), cB, voffB); PG8_STAGE(PG8_SB(0, 1), cB + hstep, voffB); PG8_STAGE(PG8_SA(0, 0), cA, voffA); PG8_STAGE(PG8_SA(0, 1), cA + hstep, voffA);
        if (wr == 1) PG8_BAR;
        PG8_WAIT_V(2); PG8_BAR;
        PG8_STAGE(PG8_SB(1, 0), cB + kstep, voffB); PG8_STAGE(PG8_SA(1, 0), cA + kstep, voffA); PG8_STAGE(PG8_SB(1, 1), cB + hstep + kstep, voffB);
        PG8_WAIT_V(6); PG8_BAR;
    } else {
        PG8_STAGE(PG8_SB(0, 0), cB, voffB); PG8_STAGE(PG8_SA(0, 0), cA, voffA); PG8_STAGE(PG8_SB(0, 1), cB + hstep, voffB); PG8_STAGE(PG8_SA(0, 1), cA + hstep, voffA);
        if (wr == 1) PG8_BAR;
        PG8_WAIT_V(4); PG8_BAR;
        PG8_STAGE(PG8_SB(1, 0), cB + kstep, voffB); PG8_STAGE(PG8_SA(1, 0), cA + kstep, voffA); PG8_STAGE(PG8_SB(1, 1), cB + hstep + kstep, voffB);
        PG8_WAIT_V(6); PG8_BAR;
    }
    for (;;) {
        const bool has_next = S.next(ui + 1, nxt);
        const char* nA = has_next ? (const char*)g.A + (size_t)nxt.pm * tstep : cA; const char* nB = has_next ? (const char*)g.Bt + (size_t)nxt.pn * tstep : cB;
        for (int t = 0; t < nt; t += 2) {
            const bool last = (t == nt - 2);
            const char* a1 = cA + (size_t)(t + 1) * kstep;
            const char* a2 = last ? nA : cA + (size_t)(t + 2) * kstep; const char* b2 = last ? nB : cB + (size_t)(t + 2) * kstep;
            const char* a3 = a2 + kstep; const char* b3 = b2 + kstep;
            if (last && has_next) S.a_ready(nxt);
            if constexpr (SP2) {
            PG8_LDB(B0, 0, 0); PG8_LDB(B1, 0, 1); PG8_SCHED; PG8_LDA(At, 0, 0); PG8_STAGE(PG8_SA(1, 1), a1 + hstep, voffA);
            PG8_WAIT_V(8); PG8_WAIT_L(0); PG8_BAR; PG8_MMA(0, 0, At, B0); PG8_MMA(0, 1, At, B1); PG8_BAR; PG8_SCHED;
            PG8_LDA(At, 0, 1); PG8_STAGE(PG8_SB(0, 0), b2, voffB); PG8_STAGE(PG8_SB(0, 1), b2 + hstep, voffB); PG8_STAGE(PG8_SA(0, 0), a2, voffA);
            PG8_WAIT_V(8); PG8_WAIT_L(0); PG8_BAR; PG8_MMA(1, 0, At, B0); PG8_MMA(1, 1, At, B1); PG8_BAR; PG8_SCHED;
            PG8_LDB(B0, 1, 0); PG8_LDB(B1, 1, 1); PG8_SCHED; PG8_LDA(At, 1, 0); PG8_STAGE(PG8_SA(0, 1), a2 + hstep, voffA);
            PG8_WAIT_V(8); PG8_WAIT_L(0); PG8_BAR; PG8_MMA(0, 0, At, B0); PG8_MMA(0, 1, At, B1); PG8_BAR; PG8_SCHED;
            PG8_LDA(At, 1, 1); PG8_STAGE(PG8_SB(1, 0), b3, voffB); PG8_STAGE(PG8_SB(1, 1), b3 + hstep, voffB); PG8_STAGE(PG8_SA(1, 0), a3, voffA);
            PG8_WAIT_V(8); PG8_WAIT_L(0); PG8_BAR; PG8_MMA(1, 0, At, B0); PG8_MMA(1, 1, At, B1); PG8_BAR; PG8_SCHED;
            } else {
            PG8_LDB(B0, 0, 0); PG8_SCHED; PG8_LDA(At, 0, 0); PG8_STAGE(PG8_SA(1, 1), a1 + hstep, voffA);
            PG8_WAIT_L(8); PG8_BAR; PG8_WAIT_L(0); PG8_MMA(0, 0, At, B0); PG8_BAR; PG8_SCHED;
            PG8_LDB(B1, 0, 1); PG8_STAGE(PG8_SB(0, 0), b2, voffB);
            PG8_BAR; PG8_WAIT_L(0); PG8_MMA(0, 1, At, B1); PG8_BAR;
            PG8_LDA(At, 0, 1); PG8_STAGE(PG8_SA(0, 0), a2, voffA);
            PG8_BAR; PG8_WAIT_L(0); PG8_MMA(1, 0, At, B0); PG8_BAR; PG8_SCHED;
            PG8_STAGE(PG8_SB(0, 1), b2 + hstep, voffB);
            PG8_WAIT_V(6); PG8_BAR; PG8_MMA(1, 1, At, B1); PG8_BAR;
            PG8_LDB(B0, 1, 0); PG8_SCHED; PG8_LDA(At, 1, 0); PG8_STAGE(PG8_SA(0, 1), a2 + hstep, voffA);
            PG8_WAIT_L(8); PG8_BAR; PG8_WAIT_L(0); PG8_MMA(0, 0, At, B0); PG8_BAR; PG8_SCHED;
            PG8_LDB(B1, 1, 1); PG8_STAGE(PG8_SB(1, 0), b3, voffB);
            PG8_BAR; PG8_WAIT_L(0); PG8_MMA(0, 1, At, B1); PG8_BAR;
            PG8_LDA(At, 1, 1); PG8_STAGE(PG8_SA(1, 0), a3, voffA);
            PG8_BAR; PG8_WAIT_L(0); PG8_MMA(1, 0, At, B0); PG8_BAR; PG8_SCHED;
            PG8_STAGE(PG8_SB(1, 1), b3 + hstep, voffB);
            PG8_WAIT_V(6); PG8_BAR; PG8_MMA(1, 1, At, B1); PG8_BAR;
            }
        }
        if constexpr (ALIGN_EPI) { if (wr == 0) PG8_BAR; }
        if constexpr (!Epi::AFTER_DRAIN) { E(acc, cur, wr, wc, fr, fq); S.done(cur); }
        if (!has_next) break;
#pragma unroll
        for (int a = 0; a < 2; ++a)
#pragma unroll
            for (int b = 0; b < 2; ++b)
#pragma unroll
                for (int m = 0; m < 4; ++m)
#pragma unroll
                    for (int n = 0; n < 2; ++n) acc[a][b][m][n] = (f32x4){0.f, 0.f, 0.f, 0.f};
        cur = nxt; cA = nA; cB = nB; ++ui;
        if constexpr (ALIGN_EPI) { if (wr == 1) PG8_BAR; }
    }
    PG8_WAIT_V(0);
    if constexpr (!ALIGN_EPI) { if (wr == 0) PG8_BAR; }
    PG8_BAR;
    if constexpr (Epi::AFTER_DRAIN) { E.fused(acc, cur, wr, wc, fr, fq, lds, wid, lane); S.done(cur); }
#undef PG8_SA
#undef PG8_SB
#undef PG8_STAGE
#undef PG8_LDA
#undef PG8_LDB
#undef PG8_MMA
#undef PG8_WAIT_V
#undef PG8_WAIT_L
#undef PG8_BAR
#undef PG8_SCHED
}
}

namespace att {
using bf16 = __hip_bfloat16;
constexpr int   D = 128, NW = 8, QBLK = 32, KVBLK = 64;
constexpr float SCALE = 0.088388347648318440f;
constexpr float THR = 8.f;
constexpr int SDEPTH = 2;
constexpr int LDQ = 3072, LDK = 3072, LDO = 2048;
constexpr size_t SHM_V = KVBLK * D * 2, SHM_K = KVBLK * D * 2, SHM_ATTN = 2 * SHM_V + 2 * SHM_K + NW * 64 * 4;
using bf16x8 = __attribute__((ext_vector_type(8))) short;
using s16x4  = __attribute__((ext_vector_type(4))) short;
using f32x16 = __attribute__((ext_vector_type(16))) float;
using f32x8  = __attribute__((ext_vector_type(8))) float;
using u32x4  = __attribute__((ext_vector_type(4))) unsigned;
#define KSWZ(row, colB) ((row) * 256 + ((colB) ^ (((row) & 7) << 4)))
#define SBAR() __builtin_amdgcn_sched_barrier(0)
__device__ __forceinline__ int crow(int r, int hi) { return (r & 3) + 8 * (r >> 2) + 4 * hi; }
__device__ __forceinline__ unsigned cvtpk(float lo, float hi) {
  unsigned r; asm volatile("v_cvt_pk_bf16_f32 %0, %1, %2" : "=v"(r) : "v"(lo), "v"(hi)); return r;
}
template <typename TIn> struct Stage;
template <> struct Stage<bf16>  { using T = bf16x8;
  __device__ static __forceinline__ T ld8(const bf16* p) { return *reinterpret_cast<const bf16x8*>(p); }
  __device__ static __forceinline__ bf16x8 tobf(T x) { return x; } };
template <> struct Stage<float> { using T = f32x8;
  __device__ static __forceinline__ T ld8(const float* p) { return *reinterpret_cast<const f32x8*>(p); }
  __device__ static __forceinline__ bf16x8 tobf(T x) {
    u32x4 w = {cvtpk(x[0], x[1]), cvtpk(x[2], x[3]), cvtpk(x[4], x[5]), cvtpk(x[6], x[7])}; return *reinterpret_cast<bf16x8*>(&w); } };

__device__ __forceinline__ void partialSM(f32x16& p0, f32x16& p1, float& m_reg, float& mn, float& alpha) {
  constexpr float C = SCALE * 1.4426950408889634f;
  float pmax = p0[0]; for (int r = 1; r < 16; ++r) pmax = fmaxf(pmax, p0[r]); for (int r = 0; r < 16; ++r) pmax = fmaxf(pmax, p1[r]);
  { auto rr = __builtin_amdgcn_permlane32_swap(__float_as_uint(pmax), __float_as_uint(pmax), false, false);
    pmax = fmaxf(__uint_as_float(rr[0]), __uint_as_float(rr[1])); }
  if (__builtin_expect(__all(pmax - m_reg <= THR / SCALE), 1)) { mn = m_reg; alpha = 1.f; }
  else { mn = fmaxf(m_reg, pmax); alpha = __builtin_amdgcn_exp2f((m_reg - mn) * C); m_reg = mn; }
  float mnC = -mn * C;
  for (int r = 0; r < 16; ++r) p0[r] = fmaf(p0[r], C, mnC); for (int r = 0; r < 16; ++r) p1[r] = fmaf(p1[r], C, mnC);
  for (int r = 0; r < 16; ++r) p0[r] = __builtin_amdgcn_exp2f(p0[r]);
}
__device__ __forceinline__ void finishSM(f32x16& p0, f32x16& p1, float alpha, float& l_reg, bf16x8& pa0, bf16x8& pa1, bf16x8& pa2, bf16x8& pa3) {
  for (int r = 0; r < 16; ++r) p1[r] = __builtin_amdgcn_exp2f(p1[r]);
  float ps = 0; for (int r = 0; r < 16; ++r) ps += p0[r]; for (int r = 0; r < 16; ++r) ps += p1[r];
  { auto rr = __builtin_amdgcn_permlane32_swap(__float_as_uint(ps), __float_as_uint(ps), false, false);
    ps = __uint_as_float(rr[0]) + __uint_as_float(rr[1]); }
  l_reg = l_reg * alpha + ps;
#define PK4(P, BASE, OUT) do { unsigned a0 = cvtpk(P[BASE + 0], P[BASE + 1]), a1 = cvtpk(P[BASE + 2], P[BASE + 3]);   \
    unsigned b0 = cvtpk(P[BASE + 4], P[BASE + 5]), b1 = cvtpk(P[BASE + 6], P[BASE + 7]);                              \
    auto r0 = __builtin_amdgcn_permlane32_swap(a0, b0, false, false); auto r1 = __builtin_amdgcn_permlane32_swap(a1, b1, false, false); \
    u32x4 w = {r0[0], r1[0], r0[1], r1[1]}; OUT = *reinterpret_cast<bf16x8*>(&w); } while (0)
  PK4(p0, 0, pa0); PK4(p0, 8, pa1); PK4(p1, 0, pa2); PK4(p1, 8, pa3);
#undef PK4
}
__device__ __forceinline__ void qkt(f32x16& p0, f32x16& p1, const bf16* Ks, const bf16x8* qr, int r32, int hi) {
  p0 = f32x16{}; p1 = f32x16{};
  for (int d0 = 0; d0 < 8; ++d0) { int cb = (d0 * 16 + hi * 8) * 2;
    bf16x8 b0 = *reinterpret_cast<const bf16x8*>((const char*)Ks + KSWZ(r32, cb));
    bf16x8 b1 = *reinterpret_cast<const bf16x8*>((const char*)Ks + KSWZ(32 + r32, cb));
    p0 = __builtin_amdgcn_mfma_f32_32x32x16_bf16(b0, qr[d0], p0, 0, 0, 0);
    p1 = __builtin_amdgcn_mfma_f32_32x32x16_bf16(b1, qr[d0], p1, 0, 0, 0); }
}
__device__ __forceinline__ int v_st(int k, int c) { const int kk = (k & ~0xC) | ((k & 4) << 1) | ((k & 8) >> 1); return ((kk >> 3) * 4 + (c >> 5)) * 512 + ((kk & 7) * 32 + (c & 31)) * 2; }
__device__ __forceinline__ int v_rd_base(int lane) { return ((lane & 3) << 3) | (((lane >> 2) & 3) << 6) | (((lane >> 4) & 1) << 5) | (((lane >> 5) & 1) << 8); }
constexpr int v_rd_off(int d0, int ks, int half) { return d0 * 512 + ks * 4096 + half * 2048; }
template <int OFF> __device__ __forceinline__ s16x4 tr_read(int vb) {
  s16x4 r; asm volatile("ds_read_b64_tr_b16 %0, %1 offset:%2" : "=&v"(r) : "v"(vb), "i"(OFF) : "memory"); return r;
}
template <int D0> __device__ __forceinline__ void pv_one(f32x16& od, int vb, bf16x8 pa0, bf16x8 pa1, bf16x8 pa2, bf16x8 pa3) {
  const s16x4 l0 = tr_read<v_rd_off(D0, 0, 0)>(vb), h0 = tr_read<v_rd_off(D0, 0, 1)>(vb), l1 = tr_read<v_rd_off(D0, 1, 0)>(vb), h1 = tr_read<v_rd_off(D0, 1, 1)>(vb);
  const s16x4 l2 = tr_read<v_rd_off(D0, 2, 0)>(vb), h2 = tr_read<v_rd_off(D0, 2, 1)>(vb), l3 = tr_read<v_rd_off(D0, 3, 0)>(vb), h3 = tr_read<v_rd_off(D0, 3, 1)>(vb);
  asm volatile("s_waitcnt lgkmcnt(0)" ::: "memory"); SBAR();
#define PK(L, H) (bf16x8){L[0], L[1], L[2], L[3], H[0], H[1], H[2], H[3]}
  od = __builtin_amdgcn_mfma_f32_32x32x16_bf16(pa0, PK(l0, h0), od, 0, 0, 0);
  od = __builtin_amdgcn_mfma_f32_32x32x16_bf16(pa1, PK(l1, h1), od, 0, 0, 0);
  od = __builtin_amdgcn_mfma_f32_32x32x16_bf16(pa2, PK(l2, h2), od, 0, 0, 0);
  od = __builtin_amdgcn_mfma_f32_32x32x16_bf16(pa3, PK(l3, h3), od, 0, 0, 0);
#undef PK
}
__device__ __forceinline__ void pv_d0(f32x16* o, int vb, bf16x8 pa0, bf16x8 pa1, bf16x8 pa2, bf16x8 pa3) {
  pv_one<0>(o[0], vb, pa0, pa1, pa2, pa3); pv_one<1>(o[1], vb, pa0, pa1, pa2, pa3); pv_one<2>(o[2], vb, pa0, pa1, pa2, pa3); pv_one<3>(o[3], vb, pa0, pa1, pa2, pa3);
}

template <typename TQ>
__device__ __forceinline__ void attn_dense_body(const TQ* __restrict__ Qb, const bf16* __restrict__ Kh, const bf16* __restrict__ Vh,
                                                unsigned short* __restrict__ Ob, int seq, char* lds) {
  using St = Stage<bf16>; using SQ = Stage<TQ>;
  const int tid = mk_tid(), wid = tid >> 6, lane = tid & 63, r32 = lane & 31, hi = lane >> 5;
  bf16* V_lds = (bf16*)lds; bf16* K_lds = (bf16*)(lds + 2 * SHM_V);
  float* ws = (float*)(lds + 2 * SHM_V + 2 * SHM_K) + wid * 64; float* li_l = ws; float* al_l = ws + 32;
  float m_reg = -1e30f, l_reg = 0; f32x16 o[4] = {}; bf16x8 qr[8];
  const TQ* Qw = Qb + (long)(wid * QBLK + r32) * LDQ + hi * 8;
#pragma unroll
  for (int d0 = 0; d0 < 8; ++d0) qr[d0] = SQ::tobf(SQ::ld8(Qw + d0 * 16));
  const int sr = tid >> 4, sc = (tid & 15) * 8, vst0 = v_st(sr, sc), vst1 = v_st(32 + sr, sc);
  const int vb0 = (int)(uintptr_t)V_lds + v_rd_base(lane);
  struct { typename St::T vs0, vs1, ks0, ks1; } sr_[SDEPTH];
#define SLOAD(i, k0) do { sr_[i].vs0 = St::ld8(&Vh[(long)((k0) + sr) * LDK + sc]); sr_[i].vs1 = St::ld8(&Vh[(long)((k0) + 32 + sr) * LDK + sc]); \
    sr_[i].ks0 = St::ld8(&Kh[(long)((k0) + sr) * LDK + sc]); sr_[i].ks1 = St::ld8(&Kh[(long)((k0) + 32 + sr) * LDK + sc]); } while (0)
#define SWRITE(b, i) do { *(bf16x8*)((char*)V_lds + (b) * SHM_V + vst0) = St::tobf(sr_[i].vs0);          \
    *(bf16x8*)((char*)V_lds + (b) * SHM_V + vst1) = St::tobf(sr_[i].vs1); int kc = sc * 2;               \
    *(bf16x8*)((char*)K_lds + (b) * SHM_K + KSWZ(sr, kc)) = St::tobf(sr_[i].ks0);                       \
    *(bf16x8*)((char*)K_lds + (b) * SHM_K + KSWZ(32 + sr, kc)) = St::tobf(sr_[i].ks1); } while (0)
#define SWAIT() do { if constexpr (SDEPTH == 2) asm volatile("s_waitcnt vmcnt(4)" ::: "memory"); else asm volatile("s_waitcnt vmcnt(0)" ::: "memory"); } while (0)
#define RESC(a) do { if (__any((a) < 1.f)) { if (hi == 0) al_l[r32] = (a); asm volatile("s_waitcnt lgkmcnt(0)" ::: "memory"); \
    for (int d = 0; d < 4; ++d) for (int r = 0; r < 16; ++r) o[d][r] *= al_l[crow(r, hi)]; } } while (0)
  f32x16 pA0, pA1, pB0, pB1; float mnA, mnB, alA, alB; bf16x8 pa0, pa1, pa2, pa3; const int NT = seq / KVBLK;
  constexpr int SE = 0, SO = SDEPTH - 1;
  SLOAD(SE, 0); asm volatile("s_waitcnt vmcnt(0)" ::: "memory"); SWRITE(0, SE); __syncthreads();
  qkt(pA0, pA1, K_lds, qr, r32, hi); partialSM(pA0, pA1, m_reg, mnA, alA);
  SLOAD(SO, KVBLK); if constexpr (SDEPTH == 2) { if (2 < NT) SLOAD(SE, 2 * KVBLK); }
  SWAIT(); SWRITE(1, SO); __syncthreads();
  for (int j = 1; j + 1 < NT; j += 2) {
    SBAR(); qkt(pB0, pB1, (bf16*)((char*)K_lds + SHM_K), qr, r32, hi);
    finishSM(pA0, pA1, alA, l_reg, pa0, pa1, pa2, pa3); SBAR();
    SLOAD(SO, (j + SDEPTH) * KVBLK); SBAR();
    pv_d0(o, vb0, pa0, pa1, pa2, pa3); partialSM(pB0, pB1, m_reg, mnB, alB);
    __syncthreads(); SWAIT(); SWRITE(0, SE);
    RESC(alB); __syncthreads();
    SBAR(); qkt(pA0, pA1, K_lds, qr, r32, hi);
    finishSM(pB0, pB1, alB, l_reg, pa0, pa1, pa2, pa3); SBAR();
    if (SDEPTH == 1 || j + 3 < NT) SLOAD(SE, (j + 1 + SDEPTH) * KVBLK); SBAR();
    pv_d0(o, vb0 + (int)SHM_V, pa0, pa1, pa2, pa3); partialSM(pA0, pA1, m_reg, mnA, alA);
    __syncthreads(); SWAIT(); SWRITE(1, SO);
    RESC(alA); __syncthreads();
  }
  SBAR(); qkt(pB0, pB1, (bf16*)((char*)K_lds + SHM_K), qr, r32, hi);
  finishSM(pA0, pA1, alA, l_reg, pa0, pa1, pa2, pa3); SBAR();
  pv_d0(o, vb0, pa0, pa1, pa2, pa3); partialSM(pB0, pB1, m_reg, mnB, alB);
  __syncthreads(); RESC(alB);
  finishSM(pB0, pB1, alB, l_reg, pa0, pa1, pa2, pa3); SBAR();
  pv_d0(o, vb0 + (int)SHM_V, pa0, pa1, pa2, pa3);
  if (hi == 0) li_l[r32] = l_reg; asm volatile("s_waitcnt lgkmcnt(0)" ::: "memory");
  float rli[16];
#pragma unroll
  for (int r = 0; r < 16; ++r) rli[r] = __builtin_amdgcn_rcpf(li_l[crow(r, hi)]);
  unsigned short* Ow = Ob + (long)(wid * QBLK) * LDO;
#pragma unroll
  for (int r = 0; r < 16; ++r) { int orow = crow(r, hi);
    for (int d0 = 0; d0 < 4; ++d0) Ow[(long)orow * LDO + d0 * 32 + r32] = (unsigned short)(cvtpk(o[d0][r] * rli[r], 0.f) & 0xffffu); }
#undef SLOAD
#undef SWRITE
#undef SWAIT
#undef RESC
}

}
__device__ __forceinline__ int mk_tid() { int t = threadIdx.x; asm volatile("" : "+v"(t)); return t; }
namespace mk {
#define LAS __attribute__((address_space(3)))
typedef unsigned short bf16;
typedef short bf16x8 __attribute__((ext_vector_type(8)));
typedef float f32x4 __attribute__((ext_vector_type(4)));
typedef unsigned u32x4 __attribute__((ext_vector_type(4)));
typedef unsigned u32x2 __attribute__((ext_vector_type(2)));
#define XB_TMO      128
#define XB_XCNT(j)  (256  + 64 * (j))
#define XB_XSUB(j)  (1280 + 64 * (j))
#define XB_XGEN(j)  (2304 + 64 * (j))
#define XB_TOP      3328
#define XB_TOPGEN   3392
#define XCD_BAR_WORDS 3456
#define XB_SPIN_CAP (1u << 18)

__device__ __forceinline__ unsigned xb_ld(unsigned* p)              { return __hip_atomic_load(p, __ATOMIC_RELAXED, __HIP_MEMORY_SCOPE_AGENT); }
__device__ __forceinline__ unsigned xb_add(unsigned* p, unsigned v) { return __hip_atomic_fetch_add(p, v, __ATOMIC_RELAXED, __HIP_MEMORY_SCOPE_AGENT); }
__device__ __forceinline__ unsigned xb_xcc_id() { return (unsigned)__builtin_amdgcn_s_getreg((3 << 11) | 20) & 0xFu; }
#define XB_SPIN(cond, bar) do { unsigned _sp = 0; while (cond) { __builtin_amdgcn_s_sleep(1); \
    if ((++_sp & 255u) == 0u) { if (xb_ld(&(bar)[XB_TMO])) break; if (_sp > XB_SPIN_CAP) { atomicAdd(&(bar)[XB_TMO], 1u); break; } } } } while (0)

struct XcdBarrier {
    unsigned* bar; unsigned x;
    volatile LAS unsigned* st;
};

__device__ __forceinline__ XcdBarrier xcd_barrier_post(unsigned* bar, volatile LAS unsigned* st) {
    XcdBarrier b; b.bar = bar; b.x = xb_xcc_id(); b.st = st;
    if (mk_tid() == 0) (void)xb_add(&bar[XB_XCNT(b.x)], 1u);
    return b;
}
__device__ __forceinline__ void xcd_barrier_complete(unsigned* bar, unsigned x, unsigned& nloc, unsigned& nx) {
    const unsigned G = gridDim.x * gridDim.y * gridDim.z;
    unsigned sum, cnt, mine, sp = 0u;
    for (;;) {
        sum = 0u; cnt = 0u; mine = 0u;
#pragma unroll
        for (unsigned j = 0; j < 16; ++j) { const unsigned c = xb_ld(&bar[XB_XCNT(j)]); sum += c; cnt += (c > 0u) ? 1u : 0u; mine = (j == x) ? c : mine; }
        if (sum == G) break;
        __builtin_amdgcn_s_sleep(1);
        if ((++sp & 255u) == 0u) { if (xb_ld(&bar[XB_TMO])) break; if (sp > XB_SPIN_CAP) { atomicAdd(&bar[XB_TMO], 1u); break; } }
    }
    nloc = mine > 0u ? mine : 1u; nx = cnt > 0u ? cnt : 1u;
}

__device__ __forceinline__ void xcd_barrier(const XcdBarrier& b) {
    asm volatile("s_waitcnt vmcnt(0)" ::: "memory");
    __syncthreads();
    if (mk_tid() == 0) {
        unsigned* bar = b.bar;
        __builtin_amdgcn_s_waitcnt(0);
        unsigned nloc = b.st[0], nx = b.st[1];
        if (nloc == 0u) { xcd_barrier_complete(bar, b.x, nloc, nx); b.st[0] = nloc; b.st[1] = nx; }
        const unsigned old = xb_add(&bar[XB_XSUB(b.x)], 1u);
        const unsigned gen = old / nloc;
        if (old + 1u == (gen + 1u) * nloc) {
            __builtin_amdgcn_fence(__ATOMIC_RELEASE, "agent");
            asm volatile("s_waitcnt vmcnt(0)" ::: "memory");
            const unsigned og = xb_add(&bar[XB_TOP], 1u);
            const unsigned tg = og / nx;
            if (og + 1u == (tg + 1u) * nx) xb_add(&bar[XB_TOPGEN], 1u);
            else XB_SPIN(xb_ld(&bar[XB_TOPGEN]) == tg, bar);
            __builtin_amdgcn_fence(__ATOMIC_ACQUIRE, "agent");
            xb_add(&bar[XB_XGEN(b.x)], 1u);
            asm volatile("s_waitcnt vmcnt(0)" ::: "memory");
        } else {
            XB_SPIN(xb_ld(&bar[XB_XGEN(b.x)]) == gen, bar);
            __builtin_amdgcn_fence(__ATOMIC_ACQUIRE, "agent");
            asm volatile("s_waitcnt vmcnt(0)" ::: "memory");
        }
    }
    __syncthreads();
}


constexpr int D = 2048, M = 8192, SEQ = 4096, NW = 8;
constexpr int ABW = 3072, CW = 8224, FF2 = 11264, FF = 5632;
constexpr float EPS = 1e-6f;
constexpr size_t MiB = 1u << 20;
constexpr size_t WS_AB = 0, WS_BD = 12 * MiB, WS_OAB = 13 * MiB, WS_C = 21 * MiB  , WS_OC = 54 * MiB;
constexpr size_t WS_UP0 = 62 * MiB, WS_UP1 = 106 * MiB, WS_DN0 = 150 * MiB, WS_DN1 = 172 * MiB;
constexpr size_t WS_XN = 194 * MiB, WS_GATES = 226 * MiB, WS_S = 228 * MiB;
constexpr size_t WS_PROJ = WS_S, WS_POOLED = WS_S + 48 * MiB, WS_CAT = WS_S + 56 * MiB;
constexpr size_t WS_QK = WS_S, WS_OG = WS_S + 64 * MiB, WS_KVT = WS_S + 96 * MiB, WS_HF = WS_S + 160 * MiB, WS_Y = WS_S + 288 * MiB;
constexpr size_t WS_U = WS_S, WS_ACT = WS_S + 176 * MiB;
constexpr size_t WS_END = WS_S + 320 * MiB;
constexpr int LDS_ML = 154112 + 1024, LDS_MISC = LDS_ML, LDS_BYTES = LDS_ML + 64;
constexpr size_t WS_BAR = WS_BD + 768 * 1024, BAR_BYTES = 16384;

#define LDSWAIT() asm volatile("s_waitcnt lgkmcnt(0)" ::: "memory")
__device__ __forceinline__ unsigned f2bf(float f) { unsigned u = __float_as_uint(f); return (u + 0x7fffu + ((u >> 16) & 1u)) >> 16; }
__device__ __forceinline__ unsigned pk2(float lo, float hi) { unsigned r; asm volatile("v_cvt_pk_bf16_f32 %0, %1, %2" : "=v"(r) : "v"(lo), "v"(hi)); return r; }
__device__ __forceinline__ float bflo(unsigned w) { return __uint_as_float(w << 16); }
__device__ __forceinline__ float bfhi(unsigned w) { return __uint_as_float(w & 0xffff0000u); }
__device__ __forceinline__ float wave_sum(float v) {
#pragma unroll
    for (int o = 1; o < 64; o <<= 1) v += __shfl_xor(v, o);
    return v;
}

__device__ __forceinline__ void transpose_item64(const float* __restrict__ W, int ldw, int K, int nblk, bf16* __restrict__ WT, LAS float* scr, int item, int lane, bool upperm) {
    const int kb = item / nblk, nb = item - kb * nblk, k0 = 64 * kb, n0 = 64 * nb;
    const int d0 = !upperm ? n0 : (n0 < FF ? 256 * (n0 >> 7) + (n0 & 127) : 256 * ((n0 - FF) >> 7) + 128 + ((n0 - FF) & 127));
    f32x4 v[16];
#pragma unroll
    for (int i = 0; i < 16; ++i) { const int kk = 4 * i + (lane >> 4); v[i] = *(const f32x4*)(W + (size_t)(k0 + kk) * ldw + n0 + 4 * (lane & 15)); }
#pragma unroll
    for (int i = 0; i < 16; ++i) { const int kk = 4 * i + (lane >> 4); LAS float* s = scr + kk * 65 + 4 * (lane & 15); s[0] = v[i].x; s[1] = v[i].y; s[2] = v[i].z; s[3] = v[i].w; }
    LDSWAIT();
    const int c = lane & 7, q = lane >> 3;
#pragma unroll
    for (int j = 0; j < 8; ++j) { const int n = q + 8 * j; const LAS float* s = scr + (8 * c) * 65 + n;
        u32x4 o; o.x = pk2(s[0], s[65]); o.y = pk2(s[130], s[195]); o.z = pk2(s[260], s[325]); o.w = pk2(s[390], s[455]);
        *(u32x4*)(WT + (size_t)(d0 + n) * K + k0 + 8 * c) = o; }
    LDSWAIT();
}

__device__ __forceinline__ void rmsnorm_rows(const float* __restrict__ src, const float* __restrict__ gain, bf16* __restrict__ dst, int gw, int ngw, int lane) {
    f32x4 g[8];
#pragma unroll
    for (int j = 0; j < 8; ++j) g[j] = *(const f32x4*)(gain + 4 * lane + 256 * j);
    for (int m = gw; m < M; m += ngw) {
        const f32x4* xr = (const f32x4*)(src + (size_t)m * D) + lane; f32x4 v[8]; float s = 0.f;
#pragma unroll
        for (int j = 0; j < 8; ++j) { v[j] = xr[64 * j]; s += (v[j].x * v[j].x + v[j].y * v[j].y) + (v[j].z * v[j].z + v[j].w * v[j].w); }
        const float rstd = 1.0f / sqrtf(wave_sum(s) * (1.0f / D) + EPS);
        u32x2* o = (u32x2*)(dst + (size_t)m * D) + lane;
#pragma unroll
        for (int j = 0; j < 8; ++j) { u32x2 w; w.x = pk2(v[j].x * rstd * g[j].x, v[j].y * rstd * g[j].y); w.y = pk2(v[j].z * rstd * g[j].z, v[j].w * rstd * g[j].w); o[64 * j] = w; }
    }
}

struct In { const float *x, *norm_mix, *norm_ffn, *w_in_ab, *pool_w, *pool_scale, *q_norm, *k_norm, *w_out_ab, *w_in_c, *b_gate, *h_norm, *w_out_c, *w_up, *conv_w, *conv_b, *w_down; };

__device__ __forceinline__ void prologue(const In& I, unsigned char* ws, LAS unsigned char* lds, int gw, int ngw, int wave, int lane) {
    LAS float* scr = (LAS float*)(lds + wave * 16640);
    for (int it = gw; it < 24576; it += ngw) {
        const float* W; int ldw, K, nblk; bf16* WT; int r = it;
        if (r < 1536) { W = I.w_in_ab; ldw = ABW; K = D; nblk = 48; WT = (bf16*)(ws + WS_AB); }
        else if (r < 2560) { r -= 1536; W = I.w_out_ab; ldw = D; K = D; nblk = 32; WT = (bf16*)(ws + WS_OAB); }
        else if (r < 6656) { r -= 2560; W = I.w_in_c; ldw = CW; K = D; nblk = 128; WT = (bf16*)(ws + WS_C); }
        else if (r < 7680) { r -= 6656; W = I.w_out_c; ldw = D; K = D; nblk = 32; WT = (bf16*)(ws + WS_OC); }
        else if (r < 13312) { r -= 7680; W = I.w_up; ldw = FF2; K = D; nblk = 176; WT = (bf16*)(ws + WS_UP0); }
        else if (r < 18944) { r -= 13312; W = I.w_up + (size_t)D * FF2; ldw = FF2; K = D; nblk = 176; WT = (bf16*)(ws + WS_UP1); }
        else if (r < 21760) { r -= 18944; W = I.w_down; ldw = D; K = FF; nblk = 32; WT = (bf16*)(ws + WS_DN0); }
        else { r -= 21760; W = I.w_down + (size_t)FF * D; ldw = D; K = FF; nblk = 32; WT = (bf16*)(ws + WS_DN1); }
        transpose_item64(W, ldw, K, nblk, WT, scr, r, lane, (it >= 7680 && it < 18944));
    }
    const int gt = gw * 64 + lane, ngt = ngw * 64;
    { bf16* WG = (bf16*)(ws + WS_C) + (size_t)8192 * D;
      for (int idx = gt; idx < 32 * D; idx += ngt) { const int j = idx >> 11, k = idx & 2047; WG[idx] = (bf16)f2bf(I.w_in_c[(size_t)k * CW + 8192 + j]); } }
    { bf16* BD = (bf16*)(ws + WS_BD);
      for (int idx = gt; idx < 512 * 512; idx += ngt) { const int n = idx >> 9, k = idx & 511, gn = n >> 7, gk = k >> 7;
          const float v = (gn == gk) ? I.pool_w[(size_t)(gn * 128 + (k & 127)) * 128 + (n & 127)] * I.pool_scale[n] : 0.f; BD[idx] = (bf16)f2bf(v); } }
    rmsnorm_rows(I.x, I.norm_mix, (bf16*)(ws + WS_XN), gw, ngw, lane);
}

__device__ __forceinline__ void qk_rope_pool(bf16* __restrict__ PROJ, const float* __restrict__ qn, const float* __restrict__ kn, bf16* __restrict__ POOLED, int gw, int ngw, int lane) {
    const int l = lane & 31, hsel = lane >> 5, part = (l >> 4) & 1; const bool first = (l & 8) == 0;
    float inv[4];
#pragma unroll
    for (int e = 0; e < 4; ++e) inv[e] = exp2f(-(float)(4 * (l & 7) + e) * (13.287712379549449f / 32.0f));
    const f32x4 gq = *(const f32x4*)(qn + 4 * l), gk = *(const f32x4*)(kn + 4 * l);
    for (int it = gw; it < M * 8; it += ngw) {
        const int t = it >> 3, hh = (it & 7) * 2 + hsel;
        bf16* p = PROJ + (size_t)t * ABW + 512 + hh * 128 + 4 * l;
        const u32x2 w = *(const u32x2*)p;
        float x[4] = {bflo(w.x), bfhi(w.x), bflo(w.y), bfhi(w.y)};
        float ss = (x[0] * x[0] + x[1] * x[1]) + (x[2] * x[2] + x[3] * x[3]);
#pragma unroll
        for (int o = 1; o < 32; o <<= 1) ss += __shfl_xor(ss, o);
        const float rstd = 1.0f / sqrtf(ss * (1.0f / 128.0f) + EPS);
        const f32x4 g = (hh < 12) ? gq : gk;
        const int pos = t & (SEQ - 1); const float pp = part ? (float)(pos & 63) : (float)(pos >> 6);
        float y[4] = {x[0] * rstd * g.x, x[1] * rstd * g.y, x[2] * rstd * g.z, x[3] * rstd * g.w}, o4[4];
#pragma unroll
        for (int e = 0; e < 4; ++e) { const float yp = __shfl_xor(y[e], 8); const float ang = pp * inv[e]; const float sn = __sinf(ang), cs = __cosf(ang);
            o4[e] = y[e] * cs + (first ? -yp : yp) * sn; }
        u32x2 ow; ow.x = pk2(o4[0], o4[1]); ow.y = pk2(o4[2], o4[3]); *(u32x2*)p = ow;
    }
    const int gt = gw * 64 + lane, ngt = ngw * 64;
    for (int it = gt; it < M * 64; it += ngt) {
        const int t = it >> 6, c8 = (it & 63) * 8, g = c8 >> 7, w2 = 1 << g, pos = t & (SEQ - 1), base = t - pos;
        const int lo = max(pos - w2, 0), hi = min(pos + w2, SEQ);
        float acc[8] = {0.f, 0.f, 0.f, 0.f, 0.f, 0.f, 0.f, 0.f};
        for (int pz = lo; pz < hi; ++pz) { const u32x4 v = *(const u32x4*)(PROJ + (size_t)(base + pz) * ABW + c8);
            acc[0] += bflo(v.x); acc[1] += bfhi(v.x); acc[2] += bflo(v.y); acc[3] += bfhi(v.y); acc[4] += bflo(v.z); acc[5] += bfhi(v.z); acc[6] += bflo(v.w); acc[7] += bfhi(v.w); }
        const u32x4 sv = *(const u32x4*)(PROJ + (size_t)t * ABW + c8); const float iv = 1.0f / (float)(hi - lo);
        u32x4 o; o.x = pk2(acc[0] * iv - bflo(sv.x), acc[1] * iv - bfhi(sv.x)); o.y = pk2(acc[2] * iv - bflo(sv.y), acc[3] * iv - bfhi(sv.y));
        o.z = pk2(acc[4] * iv - bflo(sv.z), acc[5] * iv - bfhi(sv.z)); o.w = pk2(acc[6] * iv - bflo(sv.w), acc[7] * iv - bfhi(sv.w));
        *(u32x4*)(POOLED + (size_t)t * 512 + c8) = o;
    }
}

__device__ __forceinline__ void conv_fix(const bf16* __restrict__ HALO, const float* __restrict__ cw, const float* __restrict__ cb, bf16* __restrict__ ACT, int gt, int ngt) {
    for (int it = gt; it < 256 * 704; it += ngt) {
        const int jc = it % 704, re = it / 704, blk = re >> 1, last = re & 1, j = jc * 8;
        const int t = blk * 64 + (last ? 63 : 0), pos = t & (SEQ - 1);
        const bf16* rc = HALO + ((size_t)blk * 4 + (last ? 3 : 0)) * FF2 + j;
        const bf16* ru = last ? rc - FF2 : HALO + ((size_t)(blk - 1) * 4 + 3) * FF2 + j;
        const bf16* rd = last ? HALO + ((size_t)(blk + 1) * 4) * FF2 + j : rc + FF2;
        const u32x4 z = {0u, 0u, 0u, 0u};
        const u32x4 g1 = *(const u32x4*)rc, v1 = *(const u32x4*)(rc + FF);
        const u32x4 g0 = pos > 0 ? *(const u32x4*)ru : z, v0 = pos > 0 ? *(const u32x4*)(ru + FF) : z;
        const u32x4 g2 = pos < SEQ - 1 ? *(const u32x4*)rd : z, v2 = pos < SEQ - 1 ? *(const u32x4*)(rd + FF) : z;
        float o[8];
#pragma unroll
        for (int q = 0; q < 4; ++q) {
            const int ja = j + 2 * q, jb = ja + 1;
            const float ga = cw[ja] * bflo(g0[q]) + cw[FF2 + ja] * bflo(g1[q]) + cw[2 * FF2 + ja] * bflo(g2[q]) + cb[ja];
            const float gb = cw[jb] * bfhi(g0[q]) + cw[FF2 + jb] * bfhi(g1[q]) + cw[2 * FF2 + jb] * bfhi(g2[q]) + cb[jb];
            const float va = cw[FF + ja] * bflo(v0[q]) + cw[FF2 + FF + ja] * bflo(v1[q]) + cw[2 * FF2 + FF + ja] * bflo(v2[q]) + cb[FF + ja];
            const float vb = cw[FF + jb] * bfhi(v0[q]) + cw[FF2 + FF + jb] * bfhi(v1[q]) + cw[2 * FF2 + FF + jb] * bfhi(v2[q]) + cb[FF + jb];
            o[2 * q] = ga / (1.0f + __expf(-ga)) * va; o[2 * q + 1] = gb / (1.0f + __expf(-gb)) * vb;
        }
        u32x4 ow; ow.x = pk2(o[0], o[1]); ow.y = pk2(o[2], o[3]); ow.z = pk2(o[4], o[5]); ow.w = pk2(o[6], o[7]);
        *(u32x4*)(ACT + (size_t)t * FF + j) = ow;
    }
}

__device__ __forceinline__ void gates_phase(const bf16* __restrict__ XN, const bf16* __restrict__ WG, const float* __restrict__ bg, float* __restrict__ GATES, LAS float* red, int bid, int nblk) {
    const int tid = mk_tid(), wid = tid >> 6, lane = tid & 63, fr = lane & 15, fq = lane >> 4;
    const int tile = wid & 3, tt = tile & 1, jt = tile >> 1, kh = wid >> 2;
    for (int grp = bid; grp < 256; grp += nblk) {
        f32x4 acc = {0.f, 0.f, 0.f, 0.f};
        const bf16* ap = WG + (size_t)(jt * 16 + fr) * D + kh * 1024 + fq * 8;
        const bf16* bp = XN + (size_t)(grp * 32 + tt * 16 + fr) * D + kh * 1024 + fq * 8;
#pragma unroll 8
        for (int ks = 0; ks < 32; ++ks) { const bf16x8 a = *(const bf16x8*)(ap + ks * 32), b = *(const bf16x8*)(bp + ks * 32); acc = __builtin_amdgcn_mfma_f32_16x16x32_bf16(a, b, acc, 0, 0, 0); }
        if (kh == 1) { LAS float* r = red + (tile * 64 + lane) * 4; r[0] = acc[0]; r[1] = acc[1]; r[2] = acc[2]; r[3] = acc[3]; }
        __syncthreads();
        if (kh == 0) { const LAS float* r = red + (tile * 64 + lane) * 4; const int t = grp * 32 + tt * 16 + fr, j = jt * 16 + 4 * fq;
            const f32x4 b4 = *(const f32x4*)(bg + j); f32x4 o; o.x = acc[0] + r[0] + b4.x; o.y = acc[1] + r[1] + b4.y; o.z = acc[2] + r[2] + b4.z; o.w = acc[3] + r[3] + b4.w;
            *(f32x4*)(GATES + (size_t)t * 32 + j) = o; }
        __syncthreads();
    }
}

__device__ __forceinline__ void headnorm_phase(const float* __restrict__ HF, const bf16* __restrict__ OG, const float* __restrict__ hn, bf16* __restrict__ Y, int gw, int ngw, int lane) {
    for (int it = gw; it < M * 8; it += ngw) {
        const int t = it >> 3, h = it & 7; const size_t off = (size_t)t * D + h * 256 + 4 * lane;
        const f32x4 a = *(const f32x4*)(HF + off), b = *(const f32x4*)(HF + (size_t)M * D + off); const f32x4 s = a + b;
        const float ss = wave_sum((s.x * s.x + s.y * s.y) + (s.z * s.z + s.w * s.w));
        const float rstd = 1.0f / sqrtf(ss * (1.0f / 256.0f) + EPS);
        const f32x4 g = *(const f32x4*)(hn + h * 256 + 4 * lane); const u32x2 ow = *(const u32x2*)(OG + off);
        const float o0 = bflo(ow.x), o1 = bfhi(ow.x), o2 = bflo(ow.y), o3 = bfhi(ow.y);
        u32x2 w; w.x = pk2(s.x * rstd * g.x / (1.0f + __expf(-o0)), s.y * rstd * g.y / (1.0f + __expf(-o1)));
        w.y = pk2(s.z * rstd * g.z / (1.0f + __expf(-o2)), s.w * rstd * g.w / (1.0f + __expf(-o3)));
        *(u32x2*)(Y + off) = w;
    }
}

namespace ml {
constexpr int LQ = 264, LS = 72;
constexpr int OFF_Q = 0, OFF_K = 33792, OFF_KT = 67584, OFF_VT = 104448, OFF_VTW = 111360, OFF_P = 118272, OFF_CT = 127488, OFF_SC = 152832;
static_assert(OFF_SC + 1280 + 1024 == LDS_ML, "mlstm lds map");
#define ML_BAR() do { asm volatile("s_waitcnt lgkmcnt(0)" ::: "memory"); __builtin_amdgcn_s_barrier(); asm volatile("" ::: "memory"); } while (0)
#define ML_MFMA(a, b, c) __builtin_amdgcn_mfma_f32_16x16x32_bf16(a, b, c, 0, 0, 0)

__device__ __forceinline__ void mlstm_phase(LAS unsigned char* lds, const bf16* __restrict__ QK, const bf16* __restrict__ KVT, const float* __restrict__ GATES, float* __restrict__ HF, int bid, int nblk) {
    const int tid = mk_tid(), wid = tid >> 6, lane = tid & 63, fr = lane & 15, fq = lane >> 4;
    LAS bf16* Qs = (LAS bf16*)(lds + OFF_Q); LAS bf16* Ks = (LAS bf16*)(lds + OFF_K); LAS bf16* KTs = (LAS bf16*)(lds + OFF_KT);
    LAS bf16* VTs = (LAS bf16*)(lds + OFF_VT); LAS bf16* VTw = (LAS bf16*)(lds + OFF_VTW); LAS bf16* Ps = (LAS bf16*)(lds + OFF_P); LAS bf16* CTs = (LAS bf16*)(lds + OFF_CT);
    LAS float* sA = (LAS float*)(lds + OFF_SC); LAS float* sM = sA + 64; LAS float* sAI = sM + 64; LAS float* sEM = sAI + 64; LAS float* sWS = (LAS float*)(lds + OFF_SC + 1280);
    const int tt = wid & 3, sh = wid >> 2;
    for (int it0 = bid; it0 < 256; it0 += nblk) {
        const int item = (nblk == 256) ? (((it0 & 7) * 4 + (it0 >> 6)) * 8 + ((it0 >> 3) & 7)) : it0;
        const int es = item & 7, dir = (item >> 3) & 1, h = (item >> 4) & 7, b = (item >> 7) & 1;
        for (int i = tid; i < 48 * LQ / 2; i += 512) ((LAS unsigned*)CTs)[i] = 0u;
        for (int i = tid; i < 16 * LS; i += 512) { VTs[32 * LS + i] = (i < LS) ? (bf16)0x3F80 : (bf16)0; VTw[32 * LS + i] = (bf16)0; }
        f32x4 ct[2][3];
#pragma unroll
        for (int a = 0; a < 2; ++a)
#pragma unroll
            for (int e = 0; e < 3; ++e) ct[a][e] = (f32x4){0.f, 0.f, 0.f, 0.f};
        float m_st = 0.f, decay = 1.f;
        bf16x8 rq[4], rk[4], rkt[4], rvt = {0, 0, 0, 0, 0, 0, 0, 0}; float gi = 0.f, gf = 0.f;
        const unsigned voffQ = (unsigned)(((tid >> 5) * 4096 + (tid & 31) * 8) * 2), voffT = (unsigned)(((tid >> 3) * M + (tid & 7) * 8) * 2), voffG = (unsigned)((dir ? 63 - lane : lane) * 128);
#define ML_LOAD(c) do { const int ncn_ = dir ? 63 - (c) : (c); const size_t trow_ = (size_t)b * SEQ + (size_t)ncn_ * 64; \
        const char* qb_ = (const char*)(QK + trow_ * 4096 + h * 256); \
        _Pragma("unroll") for (int i_ = 0; i_ < 4; ++i_) { rq[i_] = *(const bf16x8*)(qb_ + (size_t)i_ * 131072 + voffQ); rk[i_] = *(const bf16x8*)(qb_ + 4096 + (size_t)i_ * 131072 + voffQ); } \
        const char* tb_ = (const char*)(KVT + (size_t)(h * 256) * M + trow_); \
        _Pragma("unroll") for (int i_ = 0; i_ < 4; ++i_) rkt[i_] = *(const bf16x8*)(tb_ + (size_t)i_ * (64 * M * 2) + voffT); \
        if (tid < 256) rvt = *(const bf16x8*)((const char*)(KVT + (size_t)(2048 + h * 256 + es * 32) * M + trow_) + voffT); \
        { const float* gp_ = GATES + trow_ * 32 + dir * 16 + h; gi = *(const float*)((const char*)gp_ + voffG); gf = *(const float*)((const char*)gp_ + 32 + voffG); } } while (0)
#define ML_STORE() do { \
        const float lf_ = fminf(gf, 0.f) - log1pf(__expf(-fabsf(gf))); float bc_ = lf_; \
        _Pragma("unroll") for (int o_ = 1; o_ < 64; o_ <<= 1) { const float t_ = __shfl_up(bc_, o_); if (lane >= o_) bc_ += t_; } \
        const float a_ = gi - bc_; float cm_ = a_; \
        _Pragma("unroll") for (int o_ = 1; o_ < 64; o_ <<= 1) { const float t_ = __shfl_up(cm_, o_); if (lane >= o_) cm_ = fmaxf(cm_, t_); } \
        const float Mv_ = fmaxf(m_st, cm_), blast_ = __shfl(bc_, 63), cml_ = __shfl(cm_, 63), Mn_ = fmaxf(m_st, cml_); \
        const float ai_ = __expf(m_st - Mv_), em_ = __expf(-(bc_ + Mv_)), wsv_ = __expf(a_ - Mn_); decay = __expf(m_st - Mn_); m_st = blast_ + Mn_; \
        const int rr_ = dir ? 63 - lane : lane; \
        if (wid == 0) { sA[rr_] = a_; sM[rr_] = Mv_; sAI[rr_] = ai_; sEM[rr_] = em_; VTw[32 * LS + rr_] = (bf16)f2bf(wsv_); } \
        _Pragma("unroll") for (int i_ = 0; i_ < 4; ++i_) { const int q_ = tid + 512 * i_, r_ = q_ >> 5, cc_ = (q_ & 31) * 8; \
            *(LAS bf16x8*)(Qs + r_ * LQ + cc_) = rq[i_]; *(LAS bf16x8*)(Ks + r_ * LQ + cc_) = rk[i_]; } \
        _Pragma("unroll") for (int i_ = 0; i_ < 4; ++i_) { const int q_ = tid + 512 * i_, d_ = q_ >> 3, cc_ = (q_ & 7) * 8; *(LAS bf16x8*)(KTs + d_ * LS + cc_) = rkt[i_]; } \
        if (tid < 256) { const int e_ = tid >> 3, cc_ = (tid & 7) * 8; *(LAS bf16x8*)(VTs + e_ * LS + cc_) = rvt; \
            LAS float* wsp_ = sWS + wid * 64; wsp_[rr_] = wsv_; asm volatile("s_waitcnt lgkmcnt(0)" ::: "memory"); \
            const f32x4 wa_ = *(const LAS f32x4*)(wsp_ + cc_), wb_ = *(const LAS f32x4*)(wsp_ + cc_ + 4); const float wv_[8] = {wa_.x, wa_.y, wa_.z, wa_.w, wb_.x, wb_.y, wb_.z, wb_.w}; \
            const u32x4 rv_ = __builtin_bit_cast(u32x4, rvt); u32x4 o_; \
            o_.x = pk2(bflo(rv_.x) * wv_[0], bfhi(rv_.x) * wv_[1]); o_.y = pk2(bflo(rv_.y) * wv_[2], bfhi(rv_.y) * wv_[3]); \
            o_.z = pk2(bflo(rv_.z) * wv_[4], bfhi(rv_.z) * wv_[5]); o_.w = pk2(bflo(rv_.w) * wv_[6], bfhi(rv_.w) * wv_[7]); \
            *(LAS u32x4*)(VTw + e_ * LS + cc_) = o_; } } while (0)
        ML_LOAD(0);
        ML_BAR();
        ML_STORE();
        ML_BAR();
        ML_LOAD(1);
        for (int c = 0; c < 64; ++c) {
            const int ncn = dir ? 63 - c : c; const size_t trow = (size_t)b * SEQ + (size_t)ncn * 64;
            const float dec_c = decay;
            f32x4 s0 = {0.f, 0.f, 0.f, 0.f}, s1 = s0, n3 = s0, d3 = s0;
            {
                const LAS bf16* qp = Qs + (tt * 16 + fr) * LQ + fq * 8;
                const LAS bf16* kp0 = Ks + ((2 * sh) * 16 + fr) * LQ + fq * 8; const LAS bf16* kp1 = kp0 + 16 * LQ;
                const LAS bf16* cp0 = CTs + (sh * 16 + fr) * LQ + fq * 8; const LAS bf16* cp2 = CTs + (32 + fr) * LQ + fq * 8;
#pragma unroll
                for (int hf = 0; hf < 4; ++hf) {
                    bf16x8 qf[2], k0[2], k1[2], c0[2], c2[2];
#pragma unroll
                    for (int k4 = 0; k4 < 2; ++k4) { const int ko = (hf * 2 + k4) * 32;
                        qf[k4] = *(const LAS bf16x8*)(qp + ko); k0[k4] = *(const LAS bf16x8*)(kp0 + ko); k1[k4] = *(const LAS bf16x8*)(kp1 + ko);
                        c0[k4] = *(const LAS bf16x8*)(cp0 + ko); c2[k4] = *(const LAS bf16x8*)(cp2 + ko); }
                    __builtin_amdgcn_sched_barrier(0);
#pragma unroll
                    for (int k4 = 0; k4 < 2; ++k4) { s0 = ML_MFMA(k0[k4], qf[k4], s0); s1 = ML_MFMA(k1[k4], qf[k4], s1); n3 = ML_MFMA(c0[k4], qf[k4], n3); d3 = ML_MFMA(c2[k4], qf[k4], d3); }
                }
            }
            const int t = tt * 16 + fr; const float Mt = sM[t];
            {
                const int sb0 = (2 * sh) * 16 + 4 * fq, sb1 = sb0 + 16;
                const f32x4 a0 = *(const LAS f32x4*)(sA + sb0), a1 = *(const LAS f32x4*)(sA + sb1);
                float p0[4], p1[4];
#pragma unroll
                for (int r = 0; r < 4; ++r) {
                    const int sa = sb0 + r, sbb = sb1 + r;
                    const bool ok0 = dir ? (sa >= t) : (sa <= t), ok1 = dir ? (sbb >= t) : (sbb <= t);
                    p0[r] = ok0 ? s0[r] * __expf(a0[r] - Mt) : 0.f; p1[r] = ok1 ? s1[r] * __expf(a1[r] - Mt) : 0.f;
                }
                u32x2 w0, w1; w0.x = pk2(p0[0], p0[1]); w0.y = pk2(p0[2], p0[3]); w1.x = pk2(p1[0], p1[1]); w1.y = pk2(p1[2], p1[3]);
                *(LAS u32x2*)(Ps + t * LS + sb0) = w0; *(LAS u32x2*)(Ps + t * LS + sb1) = w1;
            }
            ML_BAR();
            f32x4 n2 = {0.f, 0.f, 0.f, 0.f}, d2 = n2;
            {
                bf16x8 pf[2], v0[2], v2[2];
#pragma unroll
                for (int ks = 0; ks < 2; ++ks) { const int ko = ks * 32 + fq * 8;
                    pf[ks] = *(const LAS bf16x8*)(Ps + (tt * 16 + fr) * LS + ko); v0[ks] = *(const LAS bf16x8*)(VTs + (sh * 16 + fr) * LS + ko); v2[ks] = *(const LAS bf16x8*)(VTs + (32 + fr) * LS + ko); }
                __builtin_amdgcn_sched_barrier(0);
#pragma unroll
                for (int ks = 0; ks < 2; ++ks) { n2 = ML_MFMA(v0[ks], pf[ks], n2); d2 = ML_MFMA(v2[ks], pf[ks], d2); }
            }
            {
                const float ai = sAI[t], em = sEM[t];
                const float den0 = d2[0] + ai * d3[0];
                const float den = __shfl(den0, fr);
                const float rinv = 1.0f / fmaxf(fabsf(den), em);
                f32x4 hout; hout.x = (n2[0] + ai * n3[0]) * rinv; hout.y = (n2[1] + ai * n3[1]) * rinv; hout.z = (n2[2] + ai * n3[2]) * rinv; hout.w = (n2[3] + ai * n3[3]) * rinv;
                *(f32x4*)(HF + ((size_t)dir * M + trow + t) * D + h * 256 + es * 32 + sh * 16 + 4 * fq) = hout;
            }
#pragma unroll
            for (int a = 0; a < 2; ++a)
#pragma unroll
                for (int e = 0; e < 3; ++e) ct[a][e] = ct[a][e] * dec_c;
#pragma unroll
            for (int ks = 0; ks < 2; ++ks) { const int ko = ks * 32 + fq * 8; bf16x8 kt[2], vw[3];
#pragma unroll
                for (int a = 0; a < 2; ++a) kt[a] = *(const LAS bf16x8*)(KTs + ((2 * wid + a) * 16 + fr) * LS + ko);
#pragma unroll
                for (int e = 0; e < 3; ++e) vw[e] = *(const LAS bf16x8*)(VTw + (e * 16 + fr) * LS + ko);
                __builtin_amdgcn_sched_barrier(0);
#pragma unroll
                for (int a = 0; a < 2; ++a)
#pragma unroll
                    for (int e = 0; e < 3; ++e) ct[a][e] = ML_MFMA(kt[a], vw[e], ct[a][e]);
            }
#pragma unroll
            for (int a = 0; a < 2; ++a)
#pragma unroll
                for (int e = 0; e < 3; ++e) { u32x2 w; w.x = f2bf(ct[a][e][0]) | (f2bf(ct[a][e][1]) << 16); w.y = f2bf(ct[a][e][2]) | (f2bf(ct[a][e][3]) << 16);
                    *(LAS u32x2*)(CTs + (e * 16 + fr) * LQ + (2 * wid + a) * 16 + 4 * fq) = w; }
            ML_BAR();
            if (c + 1 < 64) { ML_STORE(); }
            ML_BAR();
            if (c + 2 < 64) { ML_LOAD(c + 2); }
        }
#undef ML_LOAD
#undef ML_STORE
    }
}
}
}

struct EpiRes {
    static constexpr bool PERM = false, AFTER_DRAIN = false;
    const float* base; float* out; int ldc;
    __device__ __forceinline__ void operator()(const pg8::f32x4 (&acc)[2][2][4][2], const pg8::Unit& u, int wr, int wc, int fr, int fq) const {
#pragma unroll
        for (int ai = 0; ai < 2; ++ai)
#pragma unroll
            for (int m = 0; m < 4; ++m) { const size_t ro = (size_t)(u.pm * 256 + ai * 128 + wr * 64 + m * 16 + fr) * ldc + u.pn * 256 + wc * 32 + 4 * fq;
#pragma unroll
                for (int bj = 0; bj < 2; ++bj)
#pragma unroll
                    for (int n = 0; n < 2; ++n) { const size_t off = ro + bj * 128 + n * 16; const pg8::f32x4 bs = *(const pg8::f32x4*)(base + off); *(pg8::f32x4*)(out + off) = bs + acc[ai][bj][m][n]; } }
    }
};

struct EpiConv {
    static constexpr bool PERM = true, AFTER_DRAIN = false;
    unsigned short* ACT; unsigned short* HALO; const float* cw; const float* cb;
    __device__ __forceinline__ void operator()(const pg8::f32x4 (&acc)[2][2][4][2], const pg8::Unit& u, int wr, int wc, int fr, int fq) const {
        using mk::FF; using mk::FF2;
        const int lane = fq * 16 + fr, lup = (lane & 48) | ((fr + 15) & 15), ldn = (lane & 48) | ((fr + 1) & 15);
        const int jb = u.pn * 128 + wc * 32 + 8 * fq;
#pragma unroll
        for (int n = 0; n < 2; ++n) {
            const int j = jb + 4 * n;
            const pg8::f32x4 c0g = *(const pg8::f32x4*)(cw + j), c1g = *(const pg8::f32x4*)(cw + FF2 + j), c2g = *(const pg8::f32x4*)(cw + 2 * FF2 + j), cbg = *(const pg8::f32x4*)(cb + j);
            const pg8::f32x4 c0v = *(const pg8::f32x4*)(cw + FF + j), c1v = *(const pg8::f32x4*)(cw + FF2 + FF + j), c2v = *(const pg8::f32x4*)(cw + 2 * FF2 + FF + j), cbv = *(const pg8::f32x4*)(cb + FF + j);
#pragma unroll
            for (int ai = 0; ai < 2; ++ai)
#pragma unroll
                for (int m = 0; m < 4; ++m) {
                    const int row = u.pm * 256 + ai * 128 + wr * 64 + m * 16 + fr;
                    float o[4];
#pragma unroll
                    for (int i = 0; i < 4; ++i) {
                        const float g = acc[ai][0][m][n][i], v = acc[ai][1][m][n][i];
                        float gu = __shfl(g, lup), gd = __shfl(g, ldn), vu = __shfl(v, lup), vd = __shfl(v, ldn);
                        if (m > 0) { const float ga = __shfl(acc[ai][0][m - 1][n][i], lup), va = __shfl(acc[ai][1][m - 1][n][i], lup); if (fr == 0) { gu = ga; vu = va; } }
                        if (m < 3) { const float ga = __shfl(acc[ai][0][m + 1][n][i], ldn), va = __shfl(acc[ai][1][m + 1][n][i], ldn); if (fr == 15) { gd = ga; vd = va; } }
                        const float G = c0g[i] * gu + c1g[i] * g + c2g[i] * gd + cbg[i];
                        const float V = c0v[i] * vu + c1v[i] * v + c2v[i] * vd + cbv[i];
                        o[i] = G / (1.0f + __expf(-G)) * V;
                    }
                    const bool edge = (m == 0 && fr == 0) || (m == 3 && fr == 15);
                    if (!edge) { mk::u32x2 w; w.x = mk::pk2(o[0], o[1]); w.y = mk::pk2(o[2], o[3]); *(mk::u32x2*)(ACT + (size_t)row * FF + j) = w; }
                    if ((m == 0 && fr < 2) || (m == 3 && fr > 13)) {
                        const int hr = (m == 0) ? fr : fr - 12;
                        unsigned short* hp = HALO + ((size_t)(row >> 6) * 4 + hr) * FF2 + j;
                        mk::u32x2 wg, wv; wg.x = mk::f2bf(acc[ai][0][m][n][0]) | (mk::f2bf(acc[ai][0][m][n][1]) << 16); wg.y = mk::f2bf(acc[ai][0][m][n][2]) | (mk::f2bf(acc[ai][0][m][n][3]) << 16);
                        wv.x = mk::f2bf(acc[ai][1][m][n][0]) | (mk::f2bf(acc[ai][1][m][n][1]) << 16); wv.y = mk::f2bf(acc[ai][1][m][n][2]) | (mk::f2bf(acc[ai][1][m][n][3]) << 16);
                        *(mk::u32x2*)hp = wg; *(mk::u32x2*)(hp + FF) = wv;
                    }
                }
        }
    }
};

struct GemmDesc { const unsigned short* A; const unsigned short* Bt; int Mg, Ng, Kg; int kind; unsigned short* O; int ldc; int split_cols; float scale0; const float* base; float* out; int G, c; };

#ifndef REPEAT_PH
#define REPEAT_PH 1000
#define N_REPEAT 0
#else
#define N_REPEAT 1
#endif
struct Params { const float* in[17]; float* out; unsigned char* ws; int ph_lo, ph_hi; };
constexpr int N_PHASES = 18;

__global__ void __launch_bounds__(512, 2) fwd_mega(Params p) {
    extern __shared__ __attribute__((aligned(16))) unsigned char lds_raw[];
    using namespace mk;
    cg::grid_group grid = cg::this_grid();
    LAS unsigned char* lds = (LAS unsigned char*)lds_raw;
    const int bid = blockIdx.x, nblk = gridDim.x;
    const int ph_lo = p.ph_lo, ph_hi = p.ph_hi;
    { volatile LAS unsigned* misc = (volatile LAS unsigned*)(lds + LDS_MISC); if (mk_tid() < 16) misc[mk_tid()] = 0u; }
    __syncthreads();
    (void)xcd_barrier_post((unsigned*)(p.ws + WS_BAR), (volatile LAS unsigned*)(lds + LDS_MISC) + 8);
    grid.sync();
#ifdef PROBE_PH
    const unsigned long long t_start = __builtin_amdgcn_s_memrealtime();
#endif
#pragma unroll 1
    for (int ph_it = ph_lo; ph_it < ph_hi + N_REPEAT; ++ph_it) {
        const int ph = ph_it <= REPEAT_PH ? ph_it : ph_it - N_REPEAT;
        typedef const __attribute__((address_space(4))) Params* KP;
        KP kp = (KP)__builtin_amdgcn_kernarg_segment_ptr(); asm volatile("" : "+s"(kp));
        unsigned char* ws = kp->ws; float* OUT = kp->out; bf16* XN = (bf16*)(ws + WS_XN);
        In I; I.x = kp->in[0]; I.norm_mix = kp->in[1]; I.norm_ffn = kp->in[2]; I.w_in_ab = kp->in[3]; I.pool_w = kp->in[4]; I.pool_scale = kp->in[5]; I.q_norm = kp->in[6]; I.k_norm = kp->in[7];
        I.w_out_ab = kp->in[8]; I.w_in_c = kp->in[9]; I.b_gate = kp->in[10]; I.h_norm = kp->in[11]; I.w_out_c = kp->in[12]; I.w_up = kp->in[13]; I.conv_w = kp->in[14]; I.conv_b = kp->in[15]; I.w_down = kp->in[16];
        int nb_ = nblk; asm volatile("" : "+s"(nb_)); const int ngw = nb_ * NW, ngt = nb_ * 512;
        const int tid = mk_tid(), lane = tid & 63, wave = __builtin_amdgcn_readfirstlane(tid >> 6), gw = bid * NW + wave, gt = bid * 512 + tid;
#ifndef NO_THIN
        if (ph == 0) prologue(I, ws, lds, gw, ngw, wave, lane);
        if (ph == 5 || ph == 9 || ph == 14) rmsnorm_rows(OUT, ph == 5 ? I.norm_ffn : (ph == 9 ? I.norm_mix + D : I.norm_ffn + D), XN, gw, ngw, lane);
        if (ph == 2) qk_rope_pool((bf16*)(ws + WS_PROJ), I.q_norm, I.k_norm, (bf16*)(ws + WS_POOLED), gw, ngw, lane);
#endif
#ifndef NO_ATT
        if (ph == 3) {
            const bf16* PROJ = (const bf16*)(ws + WS_PROJ); bf16* CAT = (bf16*)(ws + WS_CAT);
            for (int u0 = bid; u0 < 384; u0 += nblk) {
                int u = u0;
                if (nblk == 256) { const int xcd = u0 & 7, j = (u0 >> 3) & 31, rnd = u0 >> 8; const int jj = j + 32 * rnd;
                    if (jj >= 48) continue; u = (xcd >> 2) * 192 + ((xcd & 3) * 3 + (jj >> 4)) * 16 + (jj & 15); }
                const int qb = u & 15, hq = (u >> 4) % 12, b = u / 192;
                const size_t r0 = (size_t)b * SEQ + (size_t)qb * 256;
                att::attn_dense_body<att::bf16>((const att::bf16*)(PROJ + r0 * ABW + 512 + hq * 128), (const att::bf16*)(PROJ + (size_t)b * SEQ * ABW + 2048 + (hq / 3) * 128),
                                                (const att::bf16*)(PROJ + (size_t)b * SEQ * ABW + 2560 + (hq / 3) * 128), CAT + r0 * D + 512 + hq * 128, SEQ, (char*)lds_raw);
                __syncthreads();
            }
        }
#endif
#ifndef NO_THIN
        if (ph == 7 || ph == 16) { const int l = ph == 7 ? 0 : 1; conv_fix((const bf16*)(ws + WS_U), I.conv_w + (size_t)l * 3 * FF2, I.conv_b + (size_t)l * FF2, (bf16*)(ws + WS_ACT), gt, ngt); }
        if (ph == 10) gates_phase(XN, (const bf16*)(ws + WS_C) + (size_t)8192 * D, I.b_gate, (float*)(ws + WS_GATES), (LAS float*)lds, bid, nblk);
#endif
#ifndef NO_ML
        if (ph == 11) ml::mlstm_phase(lds, (const bf16*)(ws + WS_QK), (const bf16*)(ws + WS_KVT), (const float*)(ws + WS_GATES), (float*)(ws + WS_HF), bid, nblk);
#endif
#ifndef NO_THIN
        if (ph == 12) headnorm_phase((const float*)(ws + WS_HF), (const bf16*)(ws + WS_OG), I.h_norm, (bf16*)(ws + WS_Y), gw, ngw, lane);
#endif
#pragma unroll 1
        for (int gi = 0; gi < 3; ++gi) {
            GemmDesc d; d.kind = -1; d.G = nblk; d.c = bid; d.split_cols = 0; d.scale0 = 1.f; d.base = nullptr; d.out = nullptr; d.O = nullptr; d.ldc = 0; d.A = nullptr; d.Bt = nullptr; d.Mg = M; d.Ng = 0; d.Kg = D;
            if (gi == 0) {
                if (ph == 1) { d.kind = 0; d.A = XN; d.Bt = (bf16*)(ws + WS_AB); d.Ng = ABW; d.O = (bf16*)(ws + WS_PROJ); d.ldc = ABW; }
                else if (ph == 3) { d.kind = 0; d.A = (bf16*)(ws + WS_POOLED); d.Bt = (bf16*)(ws + WS_BD); d.Ng = 512; d.Kg = 512; d.O = (bf16*)(ws + WS_CAT); d.ldc = D;
                    if (nblk == 256) { const int slot = bid >> 3; d.G = 64; d.c = (slot - 16) * 8 + (bid & 7); if (slot < 16 || slot >= 24) d.kind = -1; } }
                else if (ph == 4) { d.kind = 1; d.A = (bf16*)(ws + WS_CAT); d.Bt = (bf16*)(ws + WS_OAB); d.Ng = D; d.base = I.x; d.out = OUT; }
                else if (ph == 6 || ph == 15) { d.kind = 2; d.A = XN; d.Bt = (bf16*)(ws + (ph == 6 ? WS_UP0 : WS_UP1)); d.Ng = FF2; d.O = (bf16*)(ws + WS_U); d.ldc = FF2; d.base = I.conv_w + (size_t)(ph == 6 ? 0 : 1) * 3 * FF2; d.out = (float*)(I.conv_b + (size_t)(ph == 6 ? 0 : 1) * FF2); }
                else if (ph == 8 || ph == 17) { d.kind = 1; d.A = (bf16*)(ws + WS_ACT); d.Bt = (bf16*)(ws + (ph == 8 ? WS_DN0 : WS_DN1)); d.Ng = D; d.Kg = FF; d.base = OUT; d.out = OUT; }
                else if (ph == 10) { d.kind = 0; d.A = XN; d.Bt = (bf16*)(ws + WS_C); d.Ng = 4096; d.O = (bf16*)(ws + WS_QK); d.ldc = 4096; d.split_cols = 2048; d.scale0 = 0.0625f; }
                else if (ph == 13) { d.kind = 1; d.A = (bf16*)(ws + WS_Y); d.Bt = (bf16*)(ws + WS_OC); d.Ng = D; d.base = OUT; d.out = OUT; }
            } else if (ph == 10) {
                if (gi == 1) { d.kind = 0; d.A = XN; d.Bt = (bf16*)(ws + WS_C) + (size_t)6144 * D; d.Ng = D; d.O = (bf16*)(ws + WS_OG); d.ldc = D; }
                else { d.kind = 0; d.A = (bf16*)(ws + WS_C) + (size_t)2048 * D; d.Bt = XN; d.Mg = 4096; d.Ng = M; d.O = (bf16*)(ws + WS_KVT); d.ldc = M; }
            }
#ifndef NO_GEMM
            if (d.kind == 0) {
                pg8::Gemm g{d.A, d.Bt, d.Mg, d.Ng, d.Kg}; pg8::StaticOrder S; S.init(d.Mg, d.Ng, d.G, d.c);
                pg8::EpiBf16<0> E{d.O, d.ldc, nullptr, d.split_cols, (size_t)d.split_cols, d.scale0};
                pg8::gemm_phase<pg8::EpiBf16<0>, pg8::StaticOrder, true, true>(lds, g, S, E);
            } else if (d.kind == 2) {
                pg8::Gemm g{d.A, d.Bt, d.Mg, d.Ng, d.Kg}; pg8::StaticOrder S; S.init(d.Mg, d.Ng, d.G, d.c);
                EpiConv E{(bf16*)(ws + WS_ACT), d.O, d.base, (const float*)d.out};
                pg8::gemm_phase<EpiConv, pg8::StaticOrder, true, true>(lds, g, S, E);
            } else if (d.kind == 1) {
                pg8::Gemm g{d.A, d.Bt, d.Mg, d.Ng, d.Kg}; pg8::StaticOrder S; S.init(d.Mg, d.Ng, d.G, d.c);
                EpiRes E{d.base, d.out, D};
                pg8::gemm_phase<EpiRes, pg8::StaticOrder, true, true>(lds, g, S, E);
            }
#endif
            __syncthreads();
        }
        if (ph_it + 1 < ph_hi + N_REPEAT) { XcdBarrier xbar; xbar.bar = (unsigned*)(ws + WS_BAR); xbar.x = xb_xcc_id(); xbar.st = (volatile LAS unsigned*)(lds + LDS_MISC) + 8; xcd_barrier(xbar);
#ifdef SYNC2
            xcd_barrier(xbar);
#endif
        }
#ifdef PROBE_PH
        if (bid == 0 && tid == 0) { unsigned long long* ts = (unsigned long long*)(ws + WS_BD + 768 * 1024); ts[ph + 1] = __builtin_amdgcn_s_memrealtime(); if (ph == 0) ts[0] = t_start;
            if (ph + 1 == ph_hi) { OUT[0] = (float)(ts[PROBE_PH + 1] - ts[PROBE_PH]) * 0.01f; } }
#endif
    }
}

#ifndef MK_MULTI
#define MK_MULTI 0
#endif
extern "C" void kernel_launch(void* const* d_in, const int* in_sizes, int n_in, void* d_out, int out_size, void* d_ws, size_t ws_size, hipStream_t stream) {
    static int grid = 0;
    if (grid == 0) {
        if (n_in != 17 || out_size != mk::M * mk::D || ws_size < mk::WS_END) { fprintf(stderr, "kernel_launch: unexpected shapes n_in %d out %d ws %zu (need %zu)\n", n_in, out_size, ws_size, (size_t)mk::WS_END); grid = -1; return; }
        int dev = 0, cus = 0, per_cu = 0;
        (void)hipGetDevice(&dev); (void)hipDeviceGetAttribute(&cus, hipDeviceAttributeMultiprocessorCount, dev);
        if (hipFuncSetAttribute((const void*)fwd_mega, hipFuncAttributeMaxDynamicSharedMemorySize, mk::LDS_BYTES) != hipSuccess) { fprintf(stderr, "kernel_launch: hipFuncSetAttribute failed\n"); grid = -1; return; }
        if (hipOccupancyMaxActiveBlocksPerMultiprocessor(&per_cu, (const void*)fwd_mega, 512, mk::LDS_BYTES) != hipSuccess || per_cu < 1) { fprintf(stderr, "kernel_launch: occupancy query gave %d\n", per_cu); per_cu = 1; }
        (void)hipGetLastError();
        if (cus <= 0) cus = 256;
        grid = cus * per_cu; if (grid > 256) grid = 256;
        fprintf(stderr, "kernel_launch: cus %d per_cu %d grid %d\n", cus, per_cu, grid);
    }
    if (grid < 0) return;
    if (hipMemsetAsync((char*)d_ws + mk::WS_BAR, 0, mk::BAR_BYTES, stream) != hipSuccess) { fprintf(stderr, "kernel_launch: memset failed\n"); return; }
    Params p{};
    for (int i = 0; i < 17; ++i) p.in[i] = (const float*)d_in[i];
    p.out = (float*)d_out; p.ws = (unsigned char*)d_ws;
#if MK_MULTI
    for (int ph = 0; ph < N_PHASES; ++ph) { p.ph_lo = ph; p.ph_hi = ph + 1; hipLaunchKernelGGL(fwd_mega, dim3(grid), dim3(512), mk::LDS_BYTES, stream, p); }
#else
    p.ph_lo = 0; p.ph_hi = N_PHASES;
    void* args[] = {&p};
    const hipError_t e = hipLaunchCooperativeKernel((const void*)fwd_mega, dim3(grid), dim3(512), args, mk::LDS_BYTES, stream);
    if (e != hipSuccess) fprintf(stderr, "kernel_launch: cooperative launch failed: %s (grid %d)\n", hipGetErrorString(e), grid);
#endif
}
```

```cpp
#include <hip/hip_runtime.h>
#include <hip/hip_cooperative_groups.h>
#include <hip/hip_bf16.h>
#include <cstdio>
#include <cstdint>
#include <cmath>
namespace cg = cooperative_groups;
__device__ __forceinline__ int mk_tid();
namespace pg8 {
#define PG8_LAS __attribute__((address_space(3)))
typedef unsigned short bf16_t;
typedef short bf16x8 __attribute__((ext_vector_type(8)));
typedef float f32x4 __attribute__((ext_vector_type(4)));
typedef unsigned u32x4 __attribute__((ext_vector_type(4)));
constexpr int BM = 256, BK = 64, HALF = 128, HTB = HALF * BK * 2  , STAGE_BYTES = 8 * HTB, NXCD = 8, WGM = 8;

__host__ __device__ __forceinline__ int lds_byte(int r, int c) { const int st = (r >> 4) * 2 + (c >> 5), rr = r & 15, cc = c & 31, ob = rr * 64 + cc * 2; return st * 1024 + (ob ^ (((ob >> 9) & 1) << 5)); }
__host__ __device__ __forceinline__ void stage_rc(int b, int& R, int& C) { const int st = b / 1024, sb = b % 1024, swz = sb ^ (((sb >> 9) & 1) << 5); R = (st >> 1) * 16 + swz / 64; C = (st & 1) * 32 + (swz % 64) / 2; }
__host__ __device__ __forceinline__ int perm32(int rho) { const int n = rho >> 4, i = rho & 15; return 8 * (i >> 2) + 4 * n + (i & 3); }

struct Unit { int pm, pn; };
struct Gemm { const bf16_t* A; const bf16_t* Bt; int M, N, K; };

struct StaticOrder {
    int nM, nN, nwg, G, c;
    __host__ __device__ void init(int M, int N, int G_, int c_) { nM = M / BM; nN = N / BM; nwg = nM * nN; G = G_; c = c_; }
    __host__ __device__ bool next(int i, Unit& u) const {
        const long L = (long)i * G + c; if (L >= nwg) return false;
        int wgid = (int)L; { const int q = nwg / NXCD, r = nwg % NXCD, xcd = wgid % NXCD, off = wgid / NXCD; wgid = (xcd < r ? xcd * (q + 1) : r * (q + 1) + (xcd - r) * q) + off; }
        const int nig = WGM * nN, gid = wgid / nig, fm = gid * WGM, gsz = (nM - fm) < WGM ? (nM - fm) : WGM;
        u.pm = fm + ((wgid % nig) % gsz); u.pn = (wgid % nig) / gsz; return true;
    }
    __device__ __forceinline__ void a_ready(const Unit&) const {}
    __device__ __forceinline__ void done(const Unit&) const {}
};

__device__ __forceinline__ unsigned cvt_pk_bf16(float lo, float hi) { unsigned r; asm volatile("v_cvt_pk_bf16_f32 %0, %1, %2" : "=v"(r) : "v"(lo), "v"(hi)); return r; }
typedef float f32x2 __attribute__((ext_vector_type(2)));
__device__ __forceinline__ f32x2 gelu_pk(f32x2 v) {
    const f32x2 av = __builtin_elementwise_abs(v), d = av * 0.2316418882f + 1.0f;
    f32x2 t; t.x = __builtin_amdgcn_rcpf(d.x); t.y = __builtin_amdgcn_rcpf(d.y);
    f32x2 q = t * 0.5307027145f + (-0.7265760135f); q = q * t + 0.7107068705f; q = q * t + (-0.142248368f); q = q * t + 0.127414796f; q = q * t;
    const f32x2 s = (v * v) * (-0.72134752044f);
    f32x2 e; e.x = __builtin_amdgcn_exp2f(s.x); e.y = __builtin_amdgcn_exp2f(s.y);
    const f32x2 m = v * (q * e), r = v - m;
    f32x2 o; o.x = v.x < 0.f ? m.x : r.x; o.y = v.y < 0.f ? m.y : r.y; return o;
}

template <int ACT  > struct EpiBf16 {
    static constexpr bool PERM = true, AFTER_DRAIN = false; static_assert(ACT == 0 || ACT == 1, "EpiBf16: ACT is 0 (none) or 1 (gelu_pk)");
    bf16_t* O; int ldc; const float* bias; int split_cols; size_t split_stride; float scale0;
    __device__ __forceinline__ void operator()(const f32x4 (&acc)[2][2][4][2], const Unit& u, int wr, int wc, int fr, int fq) const {
        const int row0 = u.pm * BM + wr * 64 + fr; int colt = u.pn * BM; bf16_t* base = O;
        float sc = 1.f; if (split_cols) { const int t = colt / split_cols; base += (size_t)t * split_stride; colt -= t * split_cols; if (t == 0) sc = scale0; }
        const int col0 = colt + wc * 32 + 8 * fq, bcol0 = u.pn * BM + wc * 32 + 8 * fq;
        f32x4 bv[2][2];
#pragma unroll
        for (int bj = 0; bj < 2; ++bj)
#pragma unroll
            for (int n = 0; n < 2; ++n) bv[bj][n] = bias ? *(const f32x4*)(bias + bcol0 + bj * HALF + 4 * n) : (f32x4){0.f, 0.f, 0.f, 0.f};
#pragma unroll
        for (int ai = 0; ai < 2; ++ai)
#pragma unroll
            for (int m = 0; m < 4; ++m) { bf16_t* rowp = base + (size_t)(row0 + ai * HALF + m * 16) * ldc + col0;
#pragma unroll
                for (int bj = 0; bj < 2; ++bj) { f32x4 v0 = acc[ai][bj][m][0] + bv[bj][0], v1 = acc[ai][bj][m][1] + bv[bj][1];
                    if (ACT == 1) { f32x2 a = gelu_pk((f32x2){v0[0], v0[1]}), b = gelu_pk((f32x2){v0[2], v0[3]}), c = gelu_pk((f32x2){v1[0], v1[1]}), d = gelu_pk((f32x2){v1[2], v1[3]});
                        v0 = (f32x4){a.x, a.y, b.x, b.y}; v1 = (f32x4){c.x, c.y, d.x, d.y}; }
                    v0 = v0 * sc; v1 = v1 * sc; u32x4 w; w.x = cvt_pk_bf16(v0[0], v0[1]); w.y = cvt_pk_bf16(v0[2], v0[3]); w.z = cvt_pk_bf16(v1[0], v1[1]); w.w = cvt_pk_bf16(v1[2], v1[3]);
                    *(u32x4*)(rowp + bj * HALF) = w; } }
    }
};

template <class Epi, class Sched, bool ALIGN_EPI = false, bool SP2 = false>
__device__ __forceinline__ void gemm_phase(PG8_LAS unsigned char* lds, const Gemm g, const Sched& S, const Epi& E) {
    const int tid = mk_tid(), wid = __builtin_amdgcn_readfirstlane(tid >> 6), lane = tid & 63, wr = wid >> 2, wc = wid & 3, fr = lane & 15, fq = lane >> 4;
    const int K = g.K, nt = K / BK;
    unsigned voffA[2], voffB[2];
#pragma unroll
    for (int i = 0; i < 2; ++i) { int R, C; stage_rc(tid * 16 + i * 8192, R, C); const int Rb = Epi::PERM ? ((R & ~31) + perm32(R & 31)) : R;
        voffA[i] = (unsigned)(R * K + C) * 2u; voffB[i] = (unsigned)(Rb * K + C) * 2u; }
    const size_t kstep = (size_t)(BK * 2);
    const size_t hstep = (size_t)HALF * K * 2;
    const size_t tstep = 2 * hstep;
    const unsigned ldsw = (unsigned)wid * 1024u;
    const int aoff = lds_byte(wr * 64 + fr, fq * 8), boff = lds_byte(wc * 32 + fr, fq * 8);
#define PG8_SA(b, h) (((b) * 2 + (h)) * HTB)
#define PG8_SB(b, h) ((4 + (b) * 2 + (h)) * HTB)
#define PG8_STAGE(bufoff, gbase, voff) do { _Pragma("unroll") for (int _i = 0; _i < 2; ++_i) \
        __builtin_amdgcn_global_load_lds((const unsigned*)((const char*)(gbase) + (voff)[_i]), (PG8_LAS unsigned*)(lds + (bufoff) + ldsw + _i * 8192), 16, 0, 0); } while (0)
#define PG8_LDA(dst, b, h) do { _Pragma("unroll") for (int m = 0; m < 4; ++m) _Pragma("unroll") for (int k = 0; k < 2; ++k) dst[m][k] = *(const PG8_LAS bf16x8*)(lds + PG8_SA(b, h) + aoff + m * 2048 + k * 1024); } while (0)
#define PG8_LDB(dst, b, h) do { _Pragma("unroll") for (int n = 0; n < 2; ++n) _Pragma("unroll") for (int k = 0; k < 2; ++k) dst[n][k] = *(const PG8_LAS bf16x8*)(lds + PG8_SB(b, h) + boff + n * 2048 + k * 1024); } while (0)
#define PG8_MMA(ai, bj, At, Bt) do { __builtin_amdgcn_s_setprio(1); _Pragma("unroll") for (int m = 0; m < 4; ++m) _Pragma("unroll") for (int n = 0; n < 2; ++n) _Pragma("unroll") for (int k = 0; k < 2; ++k) \
        acc[ai][bj][m][n] = __builtin_amdgcn_mfma_f32_16x16x32_bf16(Bt[n][k], At[m][k], acc[ai][bj][m][n], 0, 0, 0); __builtin_amdgcn_s_setprio(0); } while (0)
#define PG8_WAIT_V(n) asm volatile("s_waitcnt vmcnt(" #n ")" ::: "memory")
#define PG8_WAIT_L(n) asm volatile("s_waitcnt lgkmcnt(" #n ")" ::: "memory")
#define PG8_BAR __builtin_amdgcn_s_barrier()
#define PG8_SCHED __builtin_amdgcn_sched_barrier(0)
    Unit cur, nxt; int ui = 0;
    if (!S.next(0, cur)) return;
    f32x4 acc[2][2][4][2];
#pragma unroll
    for (int a = 0; a < 2; ++a)
#pragma unroll
        for (int b = 0; b < 2; ++b)
#pragma unroll
            for (int m = 0; m < 4; ++m)
#pragma unroll
                for (int n = 0; n < 2; ++n) acc[a][b][m][n] = (f32x4){0.f, 0.f, 0.f, 0.f};
    bf16x8 At[4][2], B0[2][2], B1[2][2];
    const char* cA = (const char*)g.A + (size_t)cur.pm * tstep; const char* cB = (const char*)g.Bt + (size_t)cur.pn * tstep;
    S.a_ready(cur);
    if constexpr (SP2) {
        PG8_STAGE(PG8_SB(0, 0), cB, voffB); PG8_STAGE(PG8_SB(0, 1), cB + hstep, voffB); PG8_STAGE(PG8_SA(0, 0), cA, voffA); PG8_STAGE(PG8_SA(0, 1), cA + hstep, voffA);
        if (wr == 1) PG8_BAR;
        PG8_WAIT_V(2); PG8_BAR;
        PG8_STAGE(PG8_SB(1, 0), cB + kstep, voffB); PG8_STAGE(PG8_SA(1, 0), cA + kstep, voffA); PG8_STAGE(PG8_SB(1, 1), cB + hstep + kstep, voffB);
        PG8_WAIT_V(6); PG8_BAR;
    } else {
        PG8_STAGE(PG8_SB(0, 0), cB, voffB); PG8_STAGE(PG8_SA(0, 0), cA, voffA); PG8_STAGE(PG8_SB(0, 1), cB + hstep, voffB); PG8_STAGE(PG8_SA(0, 1), cA + hstep, voffA);
        if (wr == 1) PG8_BAR;
        PG8_WAIT_V(4); PG8_BAR;
        PG8_STAGE(PG8_SB(1, 0), cB + kstep, voffB); PG8_STAGE(PG8_SA(1, 0), cA + kstep, voffA); PG8_STAGE(PG8_SB(1, 1), cB + hstep + kstep, voffB);
        PG8_WAIT_V(6); PG8_BAR;
    }
    for (;;) {
        const bool has_next = S.next(ui + 1, nxt);
        const char* nA = has_next ? (const char*)g.A + (size_t)nxt.pm * tstep : cA; const char* nB = has_next ? (const char*)g.Bt + (size_t)nxt.pn * tstep : cB;
        for (int t = 0; t < nt; t += 2) {
            const bool last = (t == nt - 2);
            const char* a1 = cA + (size_t)(t + 1) * kstep;
            const char* a2 = last ? nA : cA + (size_t)(t + 2) * kstep; const char* b2 = last ? nB : cB + (size_t)(t + 2) * kstep;
            const char* a3 = a2 + kstep; const char* b3 = b2 + kstep;
            if (last && has_next) S.a_ready(nxt);
            if constexpr (SP2) {
            PG8_LDB(B0, 0, 0); PG8_LDB(B1, 0, 1); PG8_SCHED; PG8_LDA(At, 0, 0); PG8_STAGE(PG8_SA(1, 1), a1 + hstep, voffA);
            PG8_WAIT_V(8); PG8_WAIT_L(0); PG8_BAR; PG8_MMA(0, 0, At, B0); PG8_MMA(0, 1, At, B1); PG8_BAR; PG8_SCHED;
            PG8_LDA(At, 0, 1); PG8_STAGE(PG8_SB(0, 0), b2, voffB); PG8_STAGE(PG8_SB(0, 1), b2 + hstep, voffB); PG8_STAGE(PG8_SA(0, 0), a2, voffA);
            PG8_WAIT_V(8); PG8_WAIT_L(0); PG8_BAR; PG8_MMA(1, 0, At, B0); PG8_MMA(1, 1, At, B1); PG8_BAR; PG8_SCHED;
            PG8_LDB(B0, 1, 0); PG8_LDB(B1, 1, 1); PG8_SCHED; PG8_LDA(At, 1, 0); PG8_STAGE(PG8_SA(0, 1), a2 + hstep, voffA);
            PG8_WAIT_V(8); PG8_WAIT_L(0); PG8_BAR; PG8_MMA(0, 0, At, B0); PG8_MMA(0, 1, At, B1); PG8_BAR; PG8_SCHED;
            PG8_LDA(At, 1, 1); PG8_STAGE(PG8_SB(1, 0), b3, voffB); PG8_STAGE(PG8_SB(1, 1), b3 + hstep, voffB); PG8_STAGE(PG8_SA(1, 0), a3, voffA);
            PG8_WAIT_V(8); PG8_WAIT_L(0); PG8_BAR; PG8_MMA(1, 0, At, B0); PG8_MMA(1, 1, At, B1); PG8_BAR; PG8_SCHED;
            } else {
            PG8_LDB(B0, 0, 0); PG8_SCHED; PG8_LDA(At, 0, 0); PG8_STAGE(PG8_SA(1, 1), a1 + hstep, voffA);
            PG8_WAIT_L(8); PG8_BAR; PG8_WAIT_L(0); PG8_MMA(0, 0, At, B0); PG8_BAR; PG8_SCHED;
            PG8_LDB(B1, 0, 1); PG8_STAGE(PG8_SB(0, 0), b2, voffB);
            PG8_BAR; PG8_WAIT_L(0); PG8_MMA(0, 1, At, B1); PG8_BAR;
            PG8_LDA(At, 0, 1); PG8_STAGE(PG8_SA(0, 0), a2, voffA);
            PG8_BAR; PG8_WAIT_L(0); PG8_MMA(1, 0, At, B0); PG8_BAR; PG8_SCHED;
            PG8_STAGE(PG8_SB(0, 1), b2 + hstep, voffB);
            PG8_WAIT_V(6); PG8_BAR; PG8_MMA(1, 1, At, B1); PG8_BAR;
            PG8_LDB(B0, 1, 0); PG8_SCHED; PG8_LDA(At, 1, 0); PG8_STAGE(PG8_SA(0, 1), a2 + hstep, voffA);
            PG8_WAIT_L(8); PG8_BAR; PG8_WAIT_L(0); PG8_MMA(0, 0, At, B0); PG8_BAR; PG8_SCHED;
            PG8_LDB(B1, 1, 1); PG8_STAGE(PG8_SB(1, 0), b3, voffB);
            PG8_BAR; PG8_WAIT_L(0); PG8_MMA(0, 1, At, B1); PG8_BAR;
            PG8_LDA(At, 1, 1); PG8_STAGE(PG8_SA(1, 0), a3, voffA);
            PG8_BAR; PG8_WAIT_L(0); PG8_MMA(1, 0, At, B0); PG8_BAR; PG8_SCHED;
            PG8_STAGE(PG8_SB(1, 1), b3 + hstep, voffB);
            PG8_WAIT_V(6); PG8_BAR; PG8_MMA(1, 1, At, B1); PG8_BAR;
            }
        }
        if constexpr (ALIGN_EPI) { if (wr == 0) PG8_BAR; }
        if constexpr (!Epi::AFTER_DRAIN) { E(acc, cur, wr, wc, fr, fq); S.done(cur); }
        if (!has_next) break;
#pragma unroll
        for (int a = 0; a < 2; ++a)
#pragma unroll
            for (int b = 0; b < 2; ++b)
#pragma unroll
                for (int m = 0; m < 4; ++m)
#pragma unroll
                    for (int n = 0; n < 2; ++n) acc[a][b][m][n] = (f32x4){0.f, 0.f, 0.f, 0.f};
        cur = nxt; cA = nA; cB = nB; ++ui;
        if constexpr (ALIGN_EPI) { if (wr == 1) PG8_BAR; }
    }
    PG8_WAIT_V(0);
    if constexpr (!ALIGN_EPI) { if (wr == 0) PG8_BAR; }
    PG8_BAR;
    if constexpr (Epi::AFTER_DRAIN) { E.fused(acc, cur, wr, wc, fr, fq, lds, wid, lane); S.done(cur); }
#undef PG8_SA
#undef PG8_SB
#undef PG8_STAGE
#undef PG8_LDA
#undef PG8_LDB
#undef PG8_MMA
#undef PG8_WAIT_V
#undef PG8_WAIT_L
#undef PG8_BAR
#undef PG8_SCHED
}
}

namespace att {
using bf16 = __hip_bfloat16;
constexpr int   D = 128, NW = 8, QBLK = 32, KVBLK = 64;
constexpr float SCALE = 0.088388347648318440f;
constexpr float THR = 8.f;
constexpr int SDEPTH = 2;
constexpr int LDQ = 3072, LDK = 3072, LDO = 2048;
constexpr size_t SHM_V = KVBLK * D * 2, SHM_K = KVBLK * D * 2, SHM_ATTN = 2 * SHM_V + 2 * SHM_K + NW * 64 * 4;
using bf16x8 = __attribute__((ext_vector_type(8))) short;
using s16x4  = __attribute__((ext_vector_type(4))) short;
using f32x16 = __attribute__((ext_vector_type(16))) float;
using f32x8  = __attribute__((ext_vector_type(8))) float;
using u32x4  = __attribute__((ext_vector_type(4))) unsigned;
#define KSWZ(row, colB) ((row) * 256 + ((colB) ^ (((row) & 7) << 4)))
#define SBAR() __builtin_amdgcn_sched_barrier(0)
__device__ __forceinline__ int crow(int r, int hi) { return (r & 3) + 8 * (r >> 2) + 4 * hi; }
__device__ __forceinline__ unsigned cvtpk(float lo, float hi) {
  unsigned r; asm volatile("v_cvt_pk_bf16_f32 %0, %1, %2" : "=v"(r) : "v"(lo), "v"(hi)); return r;
}
template <typename TIn> struct Stage;
template <> struct Stage<bf16>  { using T = bf16x8;
  __device__ static __forceinline__ T ld8(const bf16* p) { return *reinterpret_cast<const bf16x8*>(p); }
  __device__ static __forceinline__ bf16x8 tobf(T x) { return x; } };
template <> struct Stage<float> { using T = f32x8;
  __device__ static __forceinline__ T ld8(const float* p) { return *reinterpret_cast<const f32x8*>(p); }
  __device__ static __forceinline__ bf16x8 tobf(T x) {
    u32x4 w = {cvtpk(x[0], x[1]), cvtpk(x[2], x[3]), cvtpk(x[4], x[5]), cvtpk(x[6], x[7])}; return *reinterpret_cast<bf16x8*>(&w); } };

__device__ __forceinline__ void partialSM(f32x16& p0, f32x16& p1, float& m_reg, float& mn, float& alpha) {
  constexpr float C = SCALE * 1.4426950408889634f;
  float pmax = p0[0]; for (int r = 1; r < 16; ++r) pmax = fmaxf(pmax, p0[r]); for (int r = 0; r < 16; ++r) pmax = fmaxf(pmax, p1[r]);
  { auto rr = __builtin_amdgcn_permlane32_swap(__float_as_uint(pmax), __float_as_uint(pmax), false, false);
    pmax = fmaxf(__uint_as_float(rr[0]), __uint_as_float(rr[1])); }
  if (__builtin_expect(__all(pmax - m_reg <= THR / SCALE), 1)) { mn = m_reg; alpha = 1.f; }
  else { mn = fmaxf(m_reg, pmax); alpha = __builtin_amdgcn_exp2f((m_reg - mn) * C); m_reg = mn; }
  float mnC = -mn * C;
  for (int r = 0; r < 16; ++r) p0[r] = fmaf(p0[r], C, mnC); for (int r = 0; r < 16; ++r) p1[r] = fmaf(p1[r], C, mnC);
  for (int r = 0; r < 16; ++r) p0[r] = __builtin_amdgcn_exp2f(p0[r]);
}
__device__ __forceinline__ void finishSM(f32x16& p0, f32x16& p1, float alpha, float& l_reg, bf16x8& pa0, bf16x8& pa1, bf16x8& pa2, bf16x8& pa3) {
  for (int r = 0; r < 16; ++r) p1[r] = __builtin_amdgcn_exp2f(p1[r]);
  float ps = 0; for (int r = 0; r < 16; ++r) ps += p0[r]; for (int r = 0; r < 16; ++r) ps += p1[r];
  { auto rr = __builtin_amdgcn_permlane32_swap(__float_as_uint(ps), __float_as_uint(ps), false, false);
    ps = __uint_as_float(rr[0]) + __uint_as_float(rr[1]); }
  l_reg = l_reg * alpha + ps;
#define PK4(P, BASE, OUT) do { unsigned a0 = cvtpk(P[BASE + 0], P[BASE + 1]), a1 = cvtpk(P[BASE + 2], P[BASE + 3]);   \
    unsigned b0 = cvtpk(P[BASE + 4], P[BASE + 5]), b1 = cvtpk(P[BASE + 6], P[BASE + 7]);                              \
    auto r0 = __builtin_amdgcn_permlane32_swap(a0, b0, false, false); auto r1 = __builtin_amdgcn_permlane32_swap(a1, b1, false, false); \
    u32x4 w = {r0[0], r1[0], r0[1], r1[1]}; OUT = *reinterpret_cast<bf16x8*>(&w); } while (0)
  PK4(p0, 0, pa0); PK4(p0, 8, pa1); PK4(p1, 0, pa2); PK4(p1, 8, pa3);
#undef PK4
}
__device__ __forceinline__ void qkt(f32x16& p0, f32x16& p1, const bf16* Ks, const bf16x8* qr, int r32, int hi) {
  p0 = f32x16{}; p1 = f32x16{};
  for (int d0 = 0; d0 < 8; ++d0) { int cb = (d0 * 16 + hi * 8) * 2;
    bf16x8 b0 = *reinterpret_cast<const bf16x8*>((const char*)Ks + KSWZ(r32, cb));
    bf16x8 b1 = *reinterpret_cast<const bf16x8*>((const char*)Ks + KSWZ(32 + r32, cb));
    p0 = __builtin_amdgcn_mfma_f32_32x32x16_bf16(b0, qr[d0], p0, 0, 0, 0);
    p1 = __builtin_amdgcn_mfma_f32_32x32x16_bf16(b1, qr[d0], p1, 0, 0, 0); }
}
__device__ __forceinline__ int v_st(int k, int c) { const int kk = (k & ~0xC) | ((k & 4) << 1) | ((k & 8) >> 1); return ((kk >> 3) * 4 + (c >> 5)) * 512 + ((kk & 7) * 32 + (c & 31)) * 2; }
__device__ __forceinline__ int v_rd_base(int lane) { return ((lane & 3) << 3) | (((lane >> 2) & 3) << 6) | (((lane >> 4) & 1) << 5) | (((lane >> 5) & 1) << 8); }
constexpr int v_rd_off(int d0, int ks, int half) { return d0 * 512 + ks * 4096 + half * 2048; }
template <int OFF> __device__ __forceinline__ s16x4 tr_read(int vb) {
  s16x4 r; asm volatile("ds_read_b64_tr_b16 %0, %1 offset:%2" : "=&v"(r) : "v"(vb), "i"(OFF) : "memory"); return r;
}
template <int D0> __device__ __forceinline__ void pv_one(f32x16& od, int vb, bf16x8 pa0, bf16x8 pa1, bf16x8 pa2, bf16x8 pa3) {
  const s16x4 l0 = tr_read<v_rd_off(D0, 0, 0)>(vb), h0 = tr_read<v_rd_off(D0, 0, 1)>(vb), l1 = tr_read<v_rd_off(D0, 1, 0)>(vb), h1 = tr_read<v_rd_off(D0, 1, 1)>(vb);
  const s16x4 l2 = tr_read<v_rd_off(D0, 2, 0)>(vb), h2 = tr_read<v_rd_off(D0, 2, 1)>(vb), l3 = tr_read<v_rd_off(D0, 3, 0)>(vb), h3 = tr_read<v_rd_off(D0, 3, 1)>(vb);
  asm volatile("s_waitcnt lgkmcnt(0)" ::: "memory"); SBAR();
#define PK(L, H) (bf16x8){L[0], L[1], L[2], L[3], H[0], H[1], H[2], H[3]}
  od = __builtin_amdgcn_mfma_f32_32x32x16_bf16(pa0, PK(l0, h0), od, 0, 0, 0);
  od = __builtin_amdgcn_mfma_f32_32x32x16_bf16(pa1, PK(l1, h1), od, 0, 0, 0);
  od = __builtin_amdgcn_mfma_f32_32x32x16_bf16(pa2, PK(l2, h2), od, 0, 0, 0);
  od = __builtin_amdgcn_mfma_f32_32x32x16_bf16(pa3, PK(l3, h3), od, 0, 0, 0);
#undef PK
}
__device__ __forceinline__ void pv_d0(f32x16* o, int vb, bf16x8 pa0, bf16x8 pa1, bf16x8 pa2, bf16x8 pa3) {
  pv_one<0>(o[0], vb, pa0, pa1, pa2, pa3); pv_one<1>(o[1], vb, pa0, pa1, pa2, pa3); pv_one<2>(o[2], vb, pa0, pa1, pa2, pa3); pv_one<3>(o[3], vb, pa0, pa1, pa2, pa3);
}

template <typename TQ>
__device__ __forceinline__ void attn_dense_body(const TQ* __restrict__ Qb, const bf16* __restrict__ Kh, const bf16* __restrict__ Vh,
                                                unsigned short* __restrict__ Ob, int seq, char* lds) {
  using St = Stage<bf16>; using SQ = Stage<TQ>;
  const int tid = mk_tid(), wid = tid >> 6, lane = tid & 63, r32 = lane & 31, hi = lane >> 5;
  bf16* V_lds = (bf16*)lds; bf16* K_lds = (bf16*)(lds + 2 * SHM_V);
  float* ws = (float*)(lds + 2 * SHM_V + 2 * SHM_K) + wid * 64; float* li_l = ws; float* al_l = ws + 32;
  float m_reg = -1e30f, l_reg = 0; f32x16 o[4] = {}; bf16x8 qr[8];
  const TQ* Qw = Qb + (long)(wid * QBLK + r32) * LDQ + hi * 8;
#pragma unroll
  for (int d0 = 0; d0 < 8; ++d0) qr[d0] = SQ::tobf(SQ::ld8(Qw + d0 * 16));
  const int sr = tid >> 4, sc = (tid & 15) * 8, vst0 = v_st(sr, sc), vst1 = v_st(32 + sr, sc);
  const int vb0 = (int)(uintptr_t)V_lds + v_rd_base(lane);
  struct { typename St::T vs0, vs1, ks0, ks1; } sr_[SDEPTH];
#define SLOAD(i, k0) do { sr_[i].vs0 = St::ld8(&Vh[(long)((k0) + sr) * LDK + sc]); sr_[i].vs1 = St::ld8(&Vh[(long)((k0) + 32 + sr) * LDK + sc]); \
    sr_[i].ks0 = St::ld8(&Kh[(long)((k0) + sr) * LDK + sc]); sr_[i].ks1 = St::ld8(&Kh[(long)((k0) + 32 + sr) * LDK + sc]); } while (0)
#define SWRITE(b, i) do { *(bf16x8*)((char*)V_lds + (b) * SHM_V + vst0) = St::tobf(sr_[i].vs0);          \
    *(bf16x8*)((char*)V_lds + (b) * SHM_V + vst1) = St::tobf(sr_[i].vs1); int kc = sc * 2;               \
    *(bf16x8*)((char*)K_lds + (b) * SHM_K + KSWZ(sr, kc)) = St::tobf(sr_[i].ks0);                       \
    *(bf16x8*)((char*)K_lds + (b) * SHM_K + KSWZ(32 + sr, kc)) = St::tobf(sr_[i].ks1); } while (0)
#define SWAIT() do { if constexpr (SDEPTH == 2) asm volatile("s_waitcnt vmcnt(4)" ::: "memory"); else asm volatile("s_waitcnt vmcnt(0)" ::: "memory"); } while (0)
#define RESC(a) do { if (__any((a) < 1.f)) { if (hi == 0) al_l[r32] = (a); asm volatile("s_waitcnt lgkmcnt(0)" ::: "memory"); \
    for (int d = 0; d < 4; ++d) for (int r = 0; r < 16; ++r) o[d][r] *= al_l[crow(r, hi)]; } } while (0)
  f32x16 pA0, pA1, pB0, pB1; float mnA, mnB, alA, alB; bf16x8 pa0, pa1, pa2, pa3; const int NT = seq / KVBLK;
  constexpr int SE = 0, SO = SDEPTH - 1;
  SLOAD(SE, 0); asm volatile("s_waitcnt vmcnt(0)" ::: "memory"); SWRITE(0, SE); __syncthreads();
  qkt(pA0, pA1, K_lds, qr, r32, hi); partialSM(pA0, pA1, m_reg, mnA, alA);
  SLOAD(SO, KVBLK); if constexpr (SDEPTH == 2) { if (2 < NT) SLOAD(SE, 2 * KVBLK); }
  SWAIT(); SWRITE(1, SO); __syncthreads();
  for (int j = 1; j + 1 < NT; j += 2) {
    SBAR(); qkt(pB0, pB1, (bf16*)((char*)K_lds + SHM_K), qr, r32, hi);
    finishSM(pA0, pA1, alA, l_reg, pa0, pa1, pa2, pa3); SBAR();
    SLOAD(SO, (j + SDEPTH) * KVBLK); SBAR();
    pv_d0(o, vb0, pa0, pa1, pa2, pa3); partialSM(pB0, pB1, m_reg, mnB, alB);
    __syncthreads(); SWAIT(); SWRITE(0, SE);
    RESC(alB); __syncthreads();
    SBAR(); qkt(pA0, pA1, K_lds, qr, r32, hi);
    finishSM(pB0, pB1, alB, l_reg, pa0, pa1, pa2, pa3); SBAR();
    if (SDEPTH == 1 || j + 3 < NT) SLOAD(SE, (j + 1 + SDEPTH) * KVBLK); SBAR();
    pv_d0(o, vb0 + (int)SHM_V, pa0, pa1, pa2, pa3); partialSM(pA0, pA1, m_reg, mnA, alA);
    __syncthreads(); SWAIT(); SWRITE(1, SO);
    RESC(alA); __syncthreads();
  }
  SBAR(); qkt(pB0, pB1, (bf16*)((char*)K_lds + SHM_K), qr, r32, hi);
  finishSM(pA0, pA1, alA, l_reg, pa0, pa1, pa2, pa3); SBAR();
  pv_d0(o, vb0, pa0, pa1, pa2, pa3); partialSM(pB0, pB1, m_reg, mnB, alB);
  __syncthreads(); RESC(alB);
  finishSM(pB0, pB1, alB, l_reg, pa0, pa1, pa2, pa3); SBAR();
  pv_d0(o, vb0 + (int)SHM_V, pa0, pa1, pa2, pa3);
  if (hi == 0) li_l[r32] = l_reg; asm volatile("s_waitcnt lgkmcnt(0)" ::: "memory");
  float rli[16];
#pragma unroll
  for (int r = 0; r < 16; ++r) rli[r] = __builtin_amdgcn_rcpf(li_l[crow(r, hi)]);
  unsigned short* Ow = Ob + (long)(wid * QBLK) * LDO;
#pragma unroll
  for (int r = 0; r < 16; ++r) { int orow = crow(r, hi);
    for (int d0 = 0; d0 < 4; ++d0) Ow[(long)orow * LDO + d0 * 32 + r32] = (unsigned short)(cvtpk(o[d0][r] * rli[r], 0.f) & 0xffffu); }
#undef SLOAD
#undef SWRITE
#undef SWAIT
#undef RESC
}

}
__device__ __forceinline__ int mk_tid() { int t = threadIdx.x; asm volatile("" : "+v"(t)); return t; }
namespace mk {
#define LAS __attribute__((address_space(3)))
typedef unsigned short bf16;
typedef short bf16x8 __attribute__((ext_vector_type(8)));
typedef float f32x4 __attribute__((ext_vector_type(4)));
typedef unsigned u32x4 __attribute__((ext_vector_type(4)));
typedef unsigned u32x2 __attribute__((ext_vector_type(2)));
#define XB_TMO      128
#define XB_XCNT(j)  (256  + 64 * (j))
#define XB_XSUB(j)  (1280 + 64 * (j))
#define XB_XGEN(j)  (2304 + 64 * (j))
#define XB_TOP      3328
#define XB_TOPGEN   3392
#define XCD_BAR_WORDS 3456
#define XB_SPIN_CAP (1u << 18)

__device__ __forceinline__ unsigned xb_ld(unsigned* p)              { return __hip_atomic_load(p, __ATOMIC_RELAXED, __HIP_MEMORY_SCOPE_AGENT); }
__device__ __forceinline__ unsigned xb_add(unsigned* p, unsigned v) { return __hip_atomic_fetch_add(p, v, __ATOMIC_RELAXED, __HIP_MEMORY_SCOPE_AGENT); }
__device__ __forceinline__ unsigned xb_xcc_id() { return (unsigned)__builtin_amdgcn_s_getreg((3 << 11) | 20) & 0xFu; }
#define XB_SPIN(cond, bar) do { unsigned _sp = 0; while (cond) { __builtin_amdgcn_s_sleep(1); \
    if ((++_sp & 255u) == 0u) { if (xb_ld(&(bar)[XB_TMO])) break; if (_sp > XB_SPIN_CAP) { atomicAdd(&(bar)[XB_TMO], 1u); break; } } } } while (0)

struct XcdBarrier {
    unsigned* bar; unsigned x;
    volatile LAS unsigned* st;
};

__device__ __forceinline__ XcdBarrier xcd_barrier_post(unsigned* bar, volatile LAS unsigned* st) {
    XcdBarrier b; b.bar = bar; b.x = xb_xcc_id(); b.st = st;
    if (mk_tid() == 0) (void)xb_add(&bar[XB_XCNT(b.x)], 1u);
    return b;
}
__device__ __forceinline__ void xcd_barrier_complete(unsigned* bar, unsigned x, unsigned& nloc, unsigned& nx) {
    const unsigned G = gridDim.x * gridDim.y * gridDim.z;
    unsigned sum, cnt, mine, sp = 0u;
    for (;;) {
        sum = 0u; cnt = 0u; mine = 0u;
#pragma unroll
        for (unsigned j = 0; j < 16; ++j) { const unsigned c = xb_ld(&bar[XB_XCNT(j)]); sum += c; cnt += (c > 0u) ? 1u : 0u; mine = (j == x) ? c : mine; }
        if (sum == G) break;
        __builtin_amdgcn_s_sleep(1);
        if ((++sp & 255u) == 0u) { if (xb_ld(&bar[XB_TMO])) break; if (sp > XB_SPIN_CAP) { atomicAdd(&bar[XB_TMO], 1u); break; } }
    }
    nloc = mine > 0u ? mine : 1u; nx = cnt > 0u ? cnt : 1u;
}

__device__ __forceinline__ void xcd_barrier(const XcdBarrier& b) {
    asm volatile("s_waitcnt vmcnt(0)" ::: "memory");
    __syncthreads();
    if (mk_tid() == 0) {
        unsigned* bar = b.bar;
        __builtin_amdgcn_s_waitcnt(0);
        unsigned nloc = b.st[0], nx = b.st[1];
        if (nloc == 0u) { xcd_barrier_complete(bar, b.x, nloc, nx); b.st[0] = nloc; b.st[1] = nx; }
        const unsigned old = xb_add(&bar[XB_XSUB(b.x)], 1u);
        const unsigned gen = old / nloc;
        if (old + 1u == (gen + 1u) * nloc) {
            __builtin_amdgcn_fence(__ATOMIC_RELEASE, "agent");
            asm volatile("s_waitcnt vmcnt(0)" ::: "memory");
            const unsigned og = xb_add(&bar[XB_TOP], 1u);
            const unsigned tg = og / nx;
            if (og + 1u == (tg + 1u) * nx) xb_add(&bar[XB_TOPGEN], 1u);
            else XB_SPIN(xb_ld(&bar[XB_TOPGEN]) == tg, bar);
            __builtin_amdgcn_fence(__ATOMIC_ACQUIRE, "agent");
            xb_add(&bar[XB_XGEN(b.x)], 1u);
            asm volatile("s_waitcnt vmcnt(0)" ::: "memory");
        } else {
            XB_SPIN(xb_ld(&bar[XB_XGEN(b.x)]) == gen, bar);
            __builtin_amdgcn_fence(__ATOMIC_ACQUIRE, "agent");
            asm volatile("s_waitcnt vmcnt(0)" ::: "memory");
        }
    }
    __syncthreads();
}


constexpr int D = 2048, M = 8192, SEQ = 4096, NW = 8;
constexpr int ABW = 3072, CW = 8224, FF2 = 11264, FF = 5632;
constexpr float EPS = 1e-6f;
constexpr size_t MiB = 1u << 20;
constexpr size_t WS_AB = 0, WS_BD = 12 * MiB, WS_OAB = 13 * MiB, WS_C = 21 * MiB  , WS_OC = 54 * MiB;
constexpr size_t WS_UP0 = 62 * MiB, WS_UP1 = 106 * MiB, WS_DN0 = 150 * MiB, WS_DN1 = 172 * MiB;
constexpr size_t WS_XN = 194 * MiB, WS_GATES = 226 * MiB, WS_S = 228 * MiB;
constexpr size_t WS_PROJ = WS_S, WS_POOLED = WS_S + 48 * MiB, WS_CAT = WS_S + 56 * MiB;
constexpr size_t WS_QK = WS_S, WS_OG = WS_S + 64 * MiB, WS_KVT = WS_S + 96 * MiB, WS_HF = WS_S + 160 * MiB, WS_Y = WS_S + 288 * MiB;
constexpr size_t WS_U = WS_S, WS_ACT = WS_S + 176 * MiB;
constexpr size_t WS_END = WS_S + 320 * MiB;
constexpr int LDS_ML = 154112 + 1024, LDS_MISC = LDS_ML, LDS_BYTES = LDS_ML + 64;
constexpr size_t WS_BAR = WS_BD + 768 * 1024, BAR_BYTES = 16384;

#define LDSWAIT() asm volatile("s_waitcnt lgkmcnt(0)" ::: "memory")
__device__ __forceinline__ unsigned f2bf(float f) { unsigned u = __float_as_uint(f); return (u + 0x7fffu + ((u >> 16) & 1u)) >> 16; }
__device__ __forceinline__ unsigned pk2(float lo, float hi) { unsigned r; asm volatile("v_cvt_pk_bf16_f32 %0, %1, %2" : "=v"(r) : "v"(lo), "v"(hi)); return r; }
__device__ __forceinline__ float bflo(unsigned w) { return __uint_as_float(w << 16); }
__device__ __forceinline__ float bfhi(unsigned w) { return __uint_as_float(w & 0xffff0000u); }
__device__ __forceinline__ float wave_sum(float v) {
#pragma unroll
    for (int o = 1; o < 64; o <<= 1) v += __shfl_xor(v, o);
    return v;
}

__device__ __forceinline__ void transpose_item64(const float* __restrict__ W, int ldw, int K, int nblk, bf16* __restrict__ WT, LAS float* scr, int item, int lane, bool upperm) {
    const int kb = item / nblk, nb = item - kb * nblk, k0 = 64 * kb, n0 = 64 * nb;
    const int d0 = !upperm ? n0 : (n0 < FF ? 256 * (n0 >> 7) + (n0 & 127) : 256 * ((n0 - FF) >> 7) + 128 + ((n0 - FF) & 127));
    f32x4 v[16];
#pragma unroll
    for (int i = 0; i < 16; ++i) { const int kk = 4 * i + (lane >> 4); v[i] = *(const f32x4*)(W + (size_t)(k0 + kk) * ldw + n0 + 4 * (lane & 15)); }
#pragma unroll
    for (int i = 0; i < 16; ++i) { const int kk = 4 * i + (lane >> 4); LAS float* s = scr + kk * 65 + 4 * (lane & 15); s[0] = v[i].x; s[1] = v[i].y; s[2] = v[i].z; s[3] = v[i].w; }
    LDSWAIT();
    const int c = lane & 7, q = lane >> 3;
#pragma unroll
    for (int j = 0; j < 8; ++j) { const int n = q + 8 * j; const LAS float* s = scr + (8 * c) * 65 + n;
        u32x4 o; o.x = pk2(s[0], s[65]); o.y = pk2(s[130], s[195]); o.z = pk2(s[260], s[325]); o.w = pk2(s[390], s[455]);
        *(u32x4*)(WT + (size_t)(d0 + n) * K + k0 + 8 * c) = o; }
    LDSWAIT();
}

__device__ __forceinline__ void rmsnorm_rows(const float* __restrict__ src, const float* __restrict__ gain, bf16* __restrict__ dst, int gw, int ngw, int lane) {
    f32x4 g[8];
#pragma unroll
    for (int j = 0; j < 8; ++j) g[j] = *(const f32x4*)(gain + 4 * lane + 256 * j);
    for (int m = gw; m < M; m += ngw) {
        const f32x4* xr = (const f32x4*)(src + (size_t)m * D) + lane; f32x4 v[8]; float s = 0.f;
#pragma unroll
        for (int j = 0; j < 8; ++j) { v[j] = xr[64 * j]; s += (v[j].x * v[j].x + v[j].y * v[j].y) + (v[j].z * v[j].z + v[j].w * v[j].w); }
        const float rstd = 1.0f / sqrtf(wave_sum(s) * (1.0f / D) + EPS);
        u32x2* o = (u32x2*)(dst + (size_t)m * D) + lane;
#pragma unroll
        for (int j = 0; j < 8; ++j) { u32x2 w; w.x = pk2(v[j].x * rstd * g[j].x, v[j].y * rstd * g[j].y); w.y = pk2(v[j].z * rstd * g[j].z, v[j].w * rstd * g[j].w); o[64 * j] = w; }
    }
}

struct In { const float *x, *norm_mix, *norm_ffn, *w_in_ab, *pool_w, *pool_scale, *q_norm, *k_norm, *w_out_ab, *w_in_c, *b_gate, *h_norm, *w_out_c, *w_up, *conv_w, *conv_b, *w_down; };

__device__ __forceinline__ void prologue(const In& I, unsigned char* ws, LAS unsigned char* lds, int gw, int ngw, int wave, int lane) {
    LAS float* scr = (LAS float*)(lds + wave * 16640);
    for (int it = gw; it < 24576; it += ngw) {
        const float* W; int ldw, K, nblk; bf16* WT; int r = it;
        if (r < 1536) { W = I.w_in_ab; ldw = ABW; K = D; nblk = 48; WT = (bf16*)(ws + WS_AB); }
        else if (r < 2560) { r -= 1536; W = I.w_out_ab; ldw = D; K = D; nblk = 32; WT = (bf16*)(ws + WS_OAB); }
        else if (r < 6656) { r -= 2560; W = I.w_in_c; ldw = CW; K = D; nblk = 128; WT = (bf16*)(ws + WS_C); }
        else if (r < 7680) { r -= 6656; W = I.w_out_c; ldw = D; K = D; nblk = 32; WT = (bf16*)(ws + WS_OC); }
        else if (r < 13312) { r -= 7680; W = I.w_up; ldw = FF2; K = D; nblk = 176; WT = (bf16*)(ws + WS_UP0); }
        else if (r < 18944) { r -= 13312; W = I.w_up + (size_t)D * FF2; ldw = FF2; K = D; nblk = 176; WT = (bf16*)(ws + WS_UP1); }
        else if (r < 21760) { r -= 18944; W = I.w_down; ldw = D; K = FF; nblk = 32; WT = (bf16*)(ws + WS_DN0); }
        else { r -= 21760; W = I.w_down + (size_t)FF * D; ldw = D; K = FF; nblk = 32; WT = (bf16*)(ws + WS_DN1); }
        transpose_item64(W, ldw, K, nblk, WT, scr, r, lane, (it >= 7680 && it < 18944));
    }
    const int gt = gw * 64 + lane, ngt = ngw * 64;
    { bf16* WG = (bf16*)(ws + WS_C) + (size_t)8192 * D;
      for (int idx = gt; idx < 32 * D; idx += ngt) { const int j = idx >> 11, k = idx & 2047; WG[idx] = (bf16)f2bf(I.w_in_c[(size_t)k * CW + 8192 + j]); } }
    { bf16* BD = (bf16*)(ws + WS_BD);
      for (int idx = gt; idx < 512 * 512; idx += ngt) { const int n = idx >> 9, k = idx & 511, gn = n >> 7, gk = k >> 7;
          const float v = (gn == gk) ? I.pool_w[(size_t)(gn * 128 + (k & 127)) * 128 + (n & 127)] * I.pool_scale[n] : 0.f; BD[idx] = (bf16)f2bf(v); } }
    rmsnorm_rows(I.x, I.norm_mix, (bf16*)(ws + WS_XN), gw, ngw, lane);
}

__device__ __forceinline__ void qk_rope_pool(bf16* __restrict__ PROJ, const float* __restrict__ qn, const float* __restrict__ kn, bf16* __restrict__ POOLED, int gw, int ngw, int lane) {
    const int l = lane & 31, hsel = lane >> 5, part = (l >> 4) & 1; const bool first = (l & 8) == 0;
    float inv[4];
#pragma unroll
    for (int e = 0; e < 4; ++e) inv[e] = exp2f(-(float)(4 * (l & 7) + e) * (13.287712379549449f / 32.0f));
    const f32x4 gq = *(const f32x4*)(qn + 4 * l), gk = *(const f32x4*)(kn + 4 * l);
    for (int it = gw; it < M * 8; it += ngw) {
        const int t = it >> 3, hh = (it & 7) * 2 + hsel;
        bf16* p = PROJ + (size_t)t * ABW + 512 + hh * 128 + 4 * l;
        const u32x2 w = *(const u32x2*)p;
        float x[4] = {bflo(w.x), bfhi(w.x), bflo(w.y), bfhi(w.y)};
        float ss = (x[0] * x[0] + x[1] * x[1]) + (x[2] * x[2] + x[3] * x[3]);
#pragma unroll
        for (int o = 1; o < 32; o <<= 1) ss += __shfl_xor(ss, o);
        const float rstd = 1.0f / sqrtf(ss * (1.0f / 128.0f) + EPS);
        const f32x4 g = (hh < 12) ? gq : gk;
        const int pos = t & (SEQ - 1); const float pp = part ? (float)(pos & 63) : (float)(pos >> 6);
        float y[4] = {x[0] * rstd * g.x, x[1] * rstd * g.y, x[2] * rstd * g.z, x[3] * rstd * g.w}, o4[4];
#pragma unroll
        for (int e = 0; e < 4; ++e) { const float yp = __shfl_xor(y[e], 8); const float ang = pp * inv[e]; const float sn = __sinf(ang), cs = __cosf(ang);
            o4[e] = y[e] * cs + (first ? -yp : yp) * sn; }
        u32x2 ow; ow.x = pk2(o4[0], o4[1]); ow.y = pk2(o4[2], o4[3]); *(u32x2*)p = ow;
    }
    const int gt = gw * 64 + lane, ngt = ngw * 64;
    for (int it = gt; it < M * 64; it += ngt) {
        const int t = it >> 6, c8 = (it & 63) * 8, g = c8 >> 7, w2 = 1 << g, pos = t & (SEQ - 1), base = t - pos;
        const int lo = max(pos - w2, 0), hi = min(pos + w2, SEQ);
        float acc[8] = {0.f, 0.f, 0.f, 0.f, 0.f, 0.f, 0.f, 0.f};
        for (int pz = lo; pz < hi; ++pz) { const u32x4 v = *(const u32x4*)(PROJ + (size_t)(base + pz) * ABW + c8);
            acc[0] += bflo(v.x); acc[1] += bfhi(v.x); acc[2] += bflo(v.y); acc[3] += bfhi(v.y); acc[4] += bflo(v.z); acc[5] += bfhi(v.z); acc[6] += bflo(v.w); acc[7] += bfhi(v.w); }
        const u32x4 sv = *(const u32x4*)(PROJ + (size_t)t * ABW + c8); const float iv = 1.0f / (float)(hi - lo);
        u32x4 o; o.x = pk2(acc[0] * iv - bflo(sv.x), acc[1] * iv - bfhi(sv.x)); o.y = pk2(acc[2] * iv - bflo(sv.y), acc[3] * iv - bfhi(sv.y));
        o.z = pk2(acc[4] * iv - bflo(sv.z), acc[5] * iv - bfhi(sv.z)); o.w = pk2(acc[6] * iv - bflo(sv.w), acc[7] * iv - bfhi(sv.w));
        *(u32x4*)(POOLED + (size_t)t * 512 + c8) = o;
    }
}

__device__ __forceinline__ void conv_fix(const bf16* __restrict__ HALO, const float* __restrict__ cw, const float* __restrict__ cb, bf16* __restrict__ ACT, int gt, int ngt) {
    for (int it = gt; it < 256 * 704; it += ngt) {
        const int jc = it % 704, re = it / 704, blk = re >> 1, last = re & 1, j = jc * 8;
        const int t = blk * 64 + (last ? 63 : 0), pos = t & (SEQ - 1);
        const bf16* rc = HALO + ((size_t)blk * 4 + (last ? 3 : 0)) * FF2 + j;
        const bf16* ru = last ? rc - FF2 : HALO + ((size_t)(blk - 1) * 4 + 3) * FF2 + j;
        const bf16* rd = last ? HALO + ((size_t)(blk + 1) * 4) * FF2 + j : rc + FF2;
        const u32x4 z = {0u, 0u, 0u, 0u};
        const u32x4 g1 = *(const u32x4*)rc, v1 = *(const u32x4*)(rc + FF);
        const u32x4 g0 = pos > 0 ? *(const u32x4*)ru : z, v0 = pos > 0 ? *(const u32x4*)(ru + FF) : z;
        const u32x4 g2 = pos < SEQ - 1 ? *(const u32x4*)rd : z, v2 = pos < SEQ - 1 ? *(const u32x4*)(rd + FF) : z;
        float o[8];
#pragma unroll
        for (int q = 0; q < 4; ++q) {
            const int ja = j + 2 * q, jb = ja + 1;
            const float ga = cw[ja] * bflo(g0[q]) + cw[FF2 + ja] * bflo(g1[q]) + cw[2 * FF2 + ja] * bflo(g2[q]) + cb[ja];
            const float gb = cw[jb] * bfhi(g0[q]) + cw[FF2 + jb] * bfhi(g1[q]) + cw[2 * FF2 + jb] * bfhi(g2[q]) + cb[jb];
            const float va = cw[FF + ja] * bflo(v0[q]) + cw[FF2 + FF + ja] * bflo(v1[q]) + cw[2 * FF2 + FF + ja] * bflo(v2[q]) + cb[FF + ja];
            const float vb = cw[FF + jb] * bfhi(v0[q]) + cw[FF2 + FF + jb] * bfhi(v1[q]) + cw[2 * FF2 + FF + jb] * bfhi(v2[q]) + cb[FF + jb];
            o[2 * q] = ga / (1.0f + __expf(-ga)) * va; o[2 * q + 1] = gb / (1.0f + __expf(-gb)) * vb;
        }
        u32x4 ow; ow.x = pk2(o[0], o[1]); ow.y = pk2(o[2], o[3]); ow.z = pk2(o[4], o[5]); ow.w = pk2(o[6], o[7]);
        *(u32x4*)(ACT + (size_t)t * FF + j) = ow;
    }
}

__device__ __forceinline__ void gates_phase(const bf16* __restrict__ XN, const bf16* __restrict__ WG, const float* __restrict__ bg, float* __restrict__ GATES, LAS float* red, int bid, int nblk) {
    const int tid = mk_tid(), wid = tid >> 6, lane = tid & 63, fr = lane & 15, fq = lane >> 4;
    const int tile = wid & 3, tt = tile & 1, jt = tile >> 1, kh = wid >> 2;
    for (int grp = bid; grp < 256; grp += nblk) {
        f32x4 acc = {0.f, 0.f, 0.f, 0.f};
        const bf16* ap = WG + (size_t)(jt * 16 + fr) * D + kh * 1024 + fq * 8;
        const bf16* bp = XN + (size_t)(grp * 32 + tt * 16 + fr) * D + kh * 1024 + fq * 8;
#pragma unroll 8
        for (int ks = 0; ks < 32; ++ks) { const bf16x8 a = *(const bf16x8*)(ap + ks * 32), b = *(const bf16x8*)(bp + ks * 32); acc = __builtin_amdgcn_mfma_f32_16x16x32_bf16(a, b, acc, 0, 0, 0); }
        if (kh == 1) { LAS float* r = red + (tile * 64 + lane) * 4; r[0] = acc[0]; r[1] = acc[1]; r[2] = acc[2]; r[3] = acc[3]; }
        __syncthreads();
        if (kh == 0) { const LAS float* r = red + (tile * 64 + lane) * 4; const int t = grp * 32 + tt * 16 + fr, j = jt * 16 + 4 * fq;
            const f32x4 b4 = *(const f32x4*)(bg + j); f32x4 o; o.x = acc[0] + r[0] + b4.x; o.y = acc[1] + r[1] + b4.y; o.z = acc[2] + r[2] + b4.z; o.w = acc[3] + r[3] + b4.w;
            *(f32x4*)(GATES + (size_t)t * 32 + j) = o; }
        __syncthreads();
    }
}

__device__ __forceinline__ void headnorm_phase(const float* __restrict__ HF, const bf16* __restrict__ OG, const float* __restrict__ hn, bf16* __restrict__ Y, int gw, int ngw, int lane) {
    for (int it = gw; it < M * 8; it += ngw) {
        const int t = it >> 3, h = it & 7; const size_t off = (size_t)t * D + h * 256 + 4 * lane;
        const f32x4 a = *(const f32x4*)(HF + off), b = *(const f32x4*)(HF + (size_t)M * D + off); const f32x4 s = a + b;
        const float ss = wave_sum((s.x * s.x + s.y * s.y) + (s.z * s.z + s.w * s.w));
        const float rstd = 1.0f / sqrtf(ss * (1.0f / 256.0f) + EPS);
        const f32x4 g = *(const f32x4*)(hn + h * 256 + 4 * lane); const u32x2 ow = *(const u32x2*)(OG + off);
        const float o0 = bflo(ow.x), o1 = bfhi(ow.x), o2 = bflo(ow.y), o3 = bfhi(ow.y);
        u32x2 w; w.x = pk2(s.x * rstd * g.x / (1.0f + __expf(-o0)), s.y * rstd * g.y / (1.0f + __expf(-o1)));
        w.y = pk2(s.z * rstd * g.z / (1.0f + __expf(-o2)), s.w * rstd * g.w / (1.0f + __expf(-o3)));
        *(u32x2*)(Y + off) = w;
    }
}

namespace ml {
constexpr int LQ = 264, LS = 72;
constexpr int OFF_Q = 0, OFF_K = 33792, OFF_KT = 67584, OFF_VT = 104448, OFF_VTW = 111360, OFF_P = 118272, OFF_CT = 127488, OFF_SC = 152832;
static_assert(OFF_SC + 1280 + 1024 == LDS_ML, "mlstm lds map");
#define ML_BAR() do { asm volatile("s_waitcnt lgkmcnt(0)" ::: "memory"); __builtin_amdgcn_s_barrier(); asm volatile("" ::: "memory"); } while (0)
#define ML_MFMA(a, b, c) __builtin_amdgcn_mfma_f32_16x16x32_bf16(a, b, c, 0, 0, 0)

__device__ __forceinline__ void mlstm_phase(LAS unsigned char* lds, const bf16* __restrict__ QK, const bf16* __restrict__ KVT, const float* __restrict__ GATES, float* __restrict__ HF, int bid, int nblk) {
    const int tid = mk_tid(), wid = tid >> 6, lane = tid & 63, fr = lane & 15, fq = lane >> 4;
    LAS bf16* Qs = (LAS bf16*)(lds + OFF_Q); LAS bf16* Ks = (LAS bf16*)(lds + OFF_K); LAS bf16* KTs = (LAS bf16*)(lds + OFF_KT);
    LAS bf16* VTs = (LAS bf16*)(lds + OFF_VT); LAS bf16* VTw = (LAS bf16*)(lds + OFF_VTW); LAS bf16* Ps = (LAS bf16*)(lds + OFF_P); LAS bf16* CTs = (LAS bf16*)(lds + OFF_CT);
    LAS float* sA = (LAS float*)(lds + OFF_SC); LAS float* sM = sA + 64; LAS float* sAI = sM + 64; LAS float* sEM = sAI + 64; LAS float* sWS = (LAS float*)(lds + OFF_SC + 1280);
    const int tt = wid & 3, sh = wid >> 2;
    for (int it0 = bid; it0 < 256; it0 += nblk) {
        const int item = (nblk == 256) ? (((it0 & 7) * 4 + (it0 >> 6)) * 8 + ((it0 >> 3) & 7)) : it0;
        const int es = item & 7, dir = (item >> 3) & 1, h = (item >> 4) & 7, b = (item >> 7) & 1;
        for (int i = tid; i < 48 * LQ / 2; i += 512) ((LAS unsigned*)CTs)[i] = 0u;
        for (int i = tid; i < 16 * LS; i += 512) { VTs[32 * LS + i] = (i < LS) ? (bf16)0x3F80 : (bf16)0; VTw[32 * LS + i] = (bf16)0; }
        f32x4 ct[2][3];
#pragma unroll
        for (int a = 0; a < 2; ++a)
#pragma unroll
            for (int e = 0; e < 3; ++e) ct[a][e] = (f32x4){0.f, 0.f, 0.f, 0.f};
        float m_st = 0.f, decay = 1.f;
        bf16x8 rq[4], rk[4], rkt[4], rvt = {0, 0, 0, 0, 0, 0, 0, 0}; float gi = 0.f, gf = 0.f;
        const unsigned voffQ = (unsigned)(((tid >> 5) * 4096 + (tid & 31) * 8) * 2), voffT = (unsigned)(((tid >> 3) * M + (tid & 7) * 8) * 2), voffG = (unsigned)((dir ? 63 - lane : lane) * 128);
#define ML_LOAD(c) do { const int ncn_ = dir ? 63 - (c) : (c); const size_t trow_ = (size_t)b * SEQ + (size_t)ncn_ * 64; \
        const char* qb_ = (const char*)(QK + trow_ * 4096 + h * 256); \
        _Pragma("unroll") for (int i_ = 0; i_ < 4; ++i_) { rq[i_] = *(const bf16x8*)(qb_ + (size_t)i_ * 131072 + voffQ); rk[i_] = *(const bf16x8*)(qb_ + 4096 + (size_t)i_ * 131072 + voffQ); } \
        const char* tb_ = (const char*)(KVT + (size_t)(h * 256) * M + trow_); \
        _Pragma("unroll") for (int i_ = 0; i_ < 4; ++i_) rkt[i_] = *(const bf16x8*)(tb_ + (size_t)i_ * (64 * M * 2) + voffT); \
        if (tid < 256) rvt = *(const bf16x8*)((const char*)(KVT + (size_t)(2048 + h * 256 + es * 32) * M + trow_) + voffT); \
        { const float* gp_ = GATES + trow_ * 32 + dir * 16 + h; gi = *(const float*)((const char*)gp_ + voffG); gf = *(const float*)((const char*)gp_ + 32 + voffG); } } while (0)
#define ML_STORE() do { \
        const float lf_ = fminf(gf, 0.f) - log1pf(__expf(-fabsf(gf))); float bc_ = lf_; \
        _Pragma("unroll") for (int o_ = 1; o_ < 64; o_ <<= 1) { const float t_ = __shfl_up(bc_, o_); if (lane >= o_) bc_ += t_; } \
        const float a_ = gi - bc_; float cm_ = a_; \
        _Pragma("unroll") for (int o_ = 1; o_ < 64; o_ <<= 1) { const float t_ = __shfl_up(cm_, o_); if (lane >= o_) cm_ = fmaxf(cm_, t_); } \
        const float Mv_ = fmaxf(m_st, cm_), blast_ = __shfl(bc_, 63), cml_ = __shfl(cm_, 63), Mn_ = fmaxf(m_st, cml_); \
        const float ai_ = __expf(m_st - Mv_), em_ = __expf(-(bc_ + Mv_)), wsv_ = __expf(a_ - Mn_); decay = __expf(m_st - Mn_); m_st = blast_ + Mn_; \
        const int rr_ = dir ? 63 - lane : lane; \
        if (wid == 0) { sA[rr_] = a_; sM[rr_] = Mv_; sAI[rr_] = ai_; sEM[rr_] = em_; VTw[32 * LS + rr_] = (bf16)f2bf(wsv_); } \
        _Pragma("unroll") for (int i_ = 0; i_ < 4; ++i_) { const int q_ = tid + 512 * i_, r_ = q_ >> 5, cc_ = (q_ & 31) * 8; \
            *(LAS bf16x8*)(Qs + r_ * LQ + cc_) = rq[i_]; *(LAS bf16x8*)(Ks + r_ * LQ + cc_) = rk[i_]; } \
        _Pragma("unroll") for (int i_ = 0; i_ < 4; ++i_) { const int q_ = tid + 512 * i_, d_ = q_ >> 3, cc_ = (q_ & 7) * 8; *(LAS bf16x8*)(KTs + d_ * LS + cc_) = rkt[i_]; } \
        if (tid < 256) { const int e_ = tid >> 3, cc_ = (tid & 7) * 8; *(LAS bf16x8*)(VTs + e_ * LS + cc_) = rvt; \
            LAS float* wsp_ = sWS + wid * 64; wsp_[rr_] = wsv_; asm volatile("s_waitcnt lgkmcnt(0)" ::: "memory"); \
            const f32x4 wa_ = *(const LAS f32x4*)(wsp_ + cc_), wb_ = *(const LAS f32x4*)(wsp_ + cc_ + 4); const float wv_[8] = {wa_.x, wa_.y, wa_.z, wa_.w, wb_.x, wb_.y, wb_.z, wb_.w}; \
            const u32x4 rv_ = __builtin_bit_cast(u32x4, rvt); u32x4 o_; \
            o_.x = pk2(bflo(rv_.x) * wv_[0], bfhi(rv_.x) * wv_[1]); o_.y = pk2(bflo(rv_.y) * wv_[2], bfhi(rv_.y) * wv_[3]); \
            o_.z = pk2(bflo(rv_.z) * wv_[4], bfhi(rv_.z) * wv_[5]); o_.w = pk2(bflo(rv_.w) * wv_[6], bfhi(rv_.w) * wv_[7]); \
            *(LAS u32x4*)(VTw + e_ * LS + cc_) = o_; } } while (0)
        ML_LOAD(0);
        ML_BAR();
        ML_STORE();
        ML_BAR();
        ML_LOAD(1);
        for (int c = 0; c < 64; ++c) {
            const int ncn = dir ? 63 - c : c; const size_t trow = (size_t)b * SEQ + (size_t)ncn * 64;
            const float dec_c = decay;
            f32x4 s0 = {0.f, 0.f, 0.f, 0.f}, s1 = s0, n3 = s0, d3 = s0;
            {
                const LAS bf16* qp = Qs + (tt * 16 + fr) * LQ + fq * 8;
                const LAS bf16* kp0 = Ks + ((2 * sh) * 16 + fr) * LQ + fq * 8; const LAS bf16* kp1 = kp0 + 16 * LQ;
                const LAS bf16* cp0 = CTs + (sh * 16 + fr) * LQ + fq * 8; const LAS bf16* cp2 = CTs + (32 + fr) * LQ + fq * 8;
#pragma unroll
                for (int hf = 0; hf < 4; ++hf) {
                    bf16x8 qf[2], k0[2], k1[2], c0[2], c2[2];
#pragma unroll
                    for (int k4 = 0; k4 < 2; ++k4) { const int ko = (hf * 2 + k4) * 32;
                        qf[k4] = *(const LAS bf16x8*)(qp + ko); k0[k4] = *(const LAS bf16x8*)(kp0 + ko); k1[k4] = *(const LAS bf16x8*)(kp1 + ko);
                        c0[k4] = *(const LAS bf16x8*)(cp0 + ko); c2[k4] = *(const LAS bf16x8*)(cp2 + ko); }
                    __builtin_amdgcn_sched_barrier(0);
#pragma unroll
                    for (int k4 = 0; k4 < 2; ++k4) { s0 = ML_MFMA(k0[k4], qf[k4], s0); s1 = ML_MFMA(k1[k4], qf[k4], s1); n3 = ML_MFMA(c0[k4], qf[k4], n3); d3 = ML_MFMA(c2[k4], qf[k4], d3); }
                }
            }
            const int t = tt * 16 + fr; const float Mt = sM[t];
            {
                const int sb0 = (2 * sh) * 16 + 4 * fq, sb1 = sb0 + 16;
                const f32x4 a0 = *(const LAS f32x4*)(sA + sb0), a1 = *(const LAS f32x4*)(sA + sb1);
                float p0[4], p1[4];
#pragma unroll
                for (int r = 0; r < 4; ++r) {
                    const int sa = sb0 + r, sbb = sb1 + r;
                    const bool ok0 = dir ? (sa >= t) : (sa <= t), ok1 = dir ? (sbb >= t) : (sbb <= t);
                    p0[r] = ok0 ? s0[r] * __expf(a0[r] - Mt) : 0.f; p1[r] = ok1 ? s1[r] * __expf(a1[r] - Mt) : 0.f;
                }
                u32x2 w0, w1; w0.x = pk2(p0[0], p0[1]); w0.y = pk2(p0[2], p0[3]); w1.x = pk2(p1[0], p1[1]); w1.y = pk2(p1[2], p1[3]);
                *(LAS u32x2*)(Ps + t * LS + sb0) = w0; *(LAS u32x2*)(Ps + t * LS + sb1) = w1;
            }
            ML_BAR();
            f32x4 n2 = {0.f, 0.f, 0.f, 0.f}, d2 = n2;
            {
                bf16x8 pf[2], v0[2], v2[2];
#pragma unroll
                for (int ks = 0; ks < 2; ++ks) { const int ko = ks * 32 + fq * 8;
                    pf[ks] = *(const LAS bf16x8*)(Ps + (tt * 16 + fr) * LS + ko); v0[ks] = *(const LAS bf16x8*)(VTs + (sh * 16 + fr) * LS + ko); v2[ks] = *(const LAS bf16x8*)(VTs + (32 + fr) * LS + ko); }
                __builtin_amdgcn_sched_barrier(0);
#pragma unroll
                for (int ks = 0; ks < 2; ++ks) { n2 = ML_MFMA(v0[ks], pf[ks], n2); d2 = ML_MFMA(v2[ks], pf[ks], d2); }
            }
            {
                const float ai = sAI[t], em = sEM[t];
                const float den0 = d2[0] + ai * d3[0];
                const float den = __shfl(den0, fr);
                const float rinv = 1.0f / fmaxf(fabsf(den), em);
                f32x4 hout; hout.x = (n2[0] + ai * n3[0]) * rinv; hout.y = (n2[1] + ai * n3[1]) * rinv; hout.z = (n2[2] + ai * n3[2]) * rinv; hout.w = (n2[3] + ai * n3[3]) * rinv;
                *(f32x4*)(HF + ((size_t)dir * M + trow + t) * D + h * 256 + es * 32 + sh * 16 + 4 * fq) = hout;
            }
#pragma unroll
            for (int a = 0; a < 2; ++a)
#pragma unroll
                for (int e = 0; e < 3; ++e) ct[a][e] = ct[a][e] * dec_c;
#pragma unroll
            for (int ks = 0; ks < 2; ++ks) { const int ko = ks * 32 + fq * 8; bf16x8 kt[2], vw[3];
#pragma unroll
                for (int a = 0; a < 2; ++a) kt[a] = *(const LAS bf16x8*)(KTs + ((2 * wid + a) * 16 + fr) * LS + ko);
#pragma unroll
                for (int e = 0; e < 3; ++e) vw[e] = *(const LAS bf16x8*)(VTw + (e * 16 + fr) * LS + ko);
                __builtin_amdgcn_sched_barrier(0);
#pragma unroll
                for (int a = 0; a < 2; ++a)
#pragma unroll
                    for (int e = 0; e < 3; ++e) ct[a][e] = ML_MFMA(kt[a], vw[e], ct[a][e]);
            }
#pragma unroll
            for (int a = 0; a < 2; ++a)
#pragma unroll
                for (int e = 0; e < 3; ++e) { u32x2 w; w.x = f2bf(ct[a][e][0]) | (f2bf(ct[a][e][1]) << 16); w.y = f2bf(ct[a][e][2]) | (f2bf(ct[a][e][3]) << 16);
                    *(LAS u32x2*)(CTs + (e * 16 + fr) * LQ + (2 * wid + a) * 16 + 4 * fq) = w; }
            ML_BAR();
            if (c + 1 < 64) { ML_STORE(); }
            ML_BAR();
            if (c + 2 < 64) { ML_LOAD(c + 2); }
        }
#undef ML_LOAD
#undef ML_STORE
    }
}
}
}

struct EpiRes {
    static constexpr bool PERM = false, AFTER_DRAIN = false;
    const float* base; float* out; int ldc;
    __device__ __forceinline__ void operator()(const pg8::f32x4 (&acc)[2][2][4][2], const pg8::Unit& u, int wr, int wc, int fr, int fq) const {
#pragma unroll
        for (int ai = 0; ai < 2; ++ai)
#pragma unroll
            for (int m = 0; m < 4; ++m) { const size_t ro = (size_t)(u.pm * 256 + ai * 128 + wr * 64 + m * 16 + fr) * ldc + u.pn * 256 + wc * 32 + 4 * fq;
#pragma unroll
                for (int bj = 0; bj < 2; ++bj)
#pragma unroll
                    for (int n = 0; n < 2; ++n) { const size_t off = ro + bj * 128 + n * 16; const pg8::f32x4 bs = *(const pg8::f32x4*)(base + off); *(pg8::f32x4*)(out + off) = bs + acc[ai][bj][m][n]; } }
    }
};

#define ROR1(x) __int_as_float(__builtin_amdgcn_update_dpp(0, __float_as_int(x), 0x121, 0xF, 0xF, false))
#define ROL1(x) __int_as_float(__builtin_amdgcn_update_dpp(0, __float_as_int(x), 0x12F, 0xF, 0xF, false))
struct EpiConv {
    static constexpr bool PERM = true, AFTER_DRAIN = false;
    unsigned short* ACT; unsigned short* HALO; const float* cw; const float* cb;
    __device__ __forceinline__ void operator()(const pg8::f32x4 (&acc)[2][2][4][2], const pg8::Unit& u, int wr, int wc, int fr, int fq) const {
        using mk::FF; using mk::FF2;
        const int jb = u.pn * 128 + wc * 32 + 8 * fq;
        mk::u32x2 keep[2][4];
#pragma unroll
        for (int n = 0; n < 2; ++n) {
            const int j = jb + 4 * n;
            const pg8::f32x4 c0g = *(const pg8::f32x4*)(cw + j), c1g = *(const pg8::f32x4*)(cw + FF2 + j), c2g = *(const pg8::f32x4*)(cw + 2 * FF2 + j), cbg = *(const pg8::f32x4*)(cb + j);
            const pg8::f32x4 c0v = *(const pg8::f32x4*)(cw + FF + j), c1v = *(const pg8::f32x4*)(cw + FF2 + FF + j), c2v = *(const pg8::f32x4*)(cw + 2 * FF2 + FF + j), cbv = *(const pg8::f32x4*)(cb + FF + j);
#pragma unroll
            for (int ai = 0; ai < 2; ++ai)
#pragma unroll
                for (int m = 0; m < 4; ++m) {
                    const int row = u.pm * 256 + ai * 128 + wr * 64 + m * 16 + fr;
                    float o[4];
#pragma unroll
                    for (int i = 0; i < 4; ++i) {
                        const float g = acc[ai][0][m][n][i], v = acc[ai][1][m][n][i];
                        float gu = ROR1(g), gd = ROL1(g), vu = ROR1(v), vd = ROL1(v);
                        if (m > 0) { const float ga = ROR1(acc[ai][0][m - 1][n][i]), va = ROR1(acc[ai][1][m - 1][n][i]); if (fr == 0) { gu = ga; vu = va; } }
                        if (m < 3) { const float ga = ROL1(acc[ai][0][m + 1][n][i]), va = ROL1(acc[ai][1][m + 1][n][i]); if (fr == 15) { gd = ga; vd = va; } }
                        const float G = c0g[i] * gu + c1g[i] * g + c2g[i] * gd + cbg[i];
                        const float V = c0v[i] * vu + c1v[i] * v + c2v[i] * vd + cbv[i];
                        o[i] = G / (1.0f + __expf(-G)) * V;
                    }
                    const bool edge = (m == 0 && fr == 0) || (m == 3 && fr == 15);
                    { mk::u32x2 w; w.x = mk::pk2(o[0], o[1]); w.y = mk::pk2(o[2], o[3]);
                      if (n == 0) keep[ai][m] = w;
                      else if (!edge) { mk::u32x4 w4; w4.x = keep[ai][m].x; w4.y = keep[ai][m].y; w4.z = w.x; w4.w = w.y; *(mk::u32x4*)(ACT + (size_t)row * FF + jb) = w4; } }
                    if ((m == 0 && fr < 2) || (m == 3 && fr > 13)) {
                        const int hr = (m == 0) ? fr : fr - 12;
                        unsigned short* hp = HALO + ((size_t)(row >> 6) * 4 + hr) * FF2 + j;
                        mk::u32x2 wg, wv; wg.x = mk::f2bf(acc[ai][0][m][n][0]) | (mk::f2bf(acc[ai][0][m][n][1]) << 16); wg.y = mk::f2bf(acc[ai][0][m][n][2]) | (mk::f2bf(acc[ai][0][m][n][3]) << 16);
                        wv.x = mk::f2bf(acc[ai][1][m][n][0]) | (mk::f2bf(acc[ai][1][m][n][1]) << 16); wv.y = mk::f2bf(acc[ai][1][m][n][2]) | (mk::f2bf(acc[ai][1][m][n][3]) << 16);
                        *(mk::u32x2*)hp = wg; *(mk::u32x2*)(hp + FF) = wv;
                    }
                }
        }
    }
};

struct EpiBf16T {
    static constexpr bool PERM = true, AFTER_DRAIN = false;
    unsigned short* O; int ldc; int split_cols; float scale0; unsigned short* T; int tcol0; int ldt;
    __device__ __forceinline__ void operator()(const pg8::f32x4 (&acc)[2][2][4][2], const pg8::Unit& u, int wr, int wc, int fr, int fq) const {
        const int row0 = u.pm * 256 + wr * 64 + fr, colt = u.pn * 256, col0 = colt + wc * 32 + 8 * fq;
        const float sc = (colt < split_cols) ? scale0 : 1.f;
#pragma unroll
        for (int ai = 0; ai < 2; ++ai)
#pragma unroll
            for (int m = 0; m < 4; ++m) { unsigned short* rowp = O + (size_t)(row0 + ai * 128 + m * 16) * ldc + col0;
#pragma unroll
                for (int bj = 0; bj < 2; ++bj) { const pg8::f32x4 v0 = acc[ai][bj][m][0] * sc, v1 = acc[ai][bj][m][1] * sc;
                    mk::u32x4 w; w.x = mk::pk2(v0[0], v0[1]); w.y = mk::pk2(v0[2], v0[3]); w.z = mk::pk2(v1[0], v1[1]); w.w = mk::pk2(v1[2], v1[3]);
                    *(mk::u32x4*)(rowp + bj * 128) = w; } }
        if (colt >= tcol0) {
#pragma unroll
            for (int bj = 0; bj < 2; ++bj)
#pragma unroll
                for (int n = 0; n < 2; ++n)
#pragma unroll
                    for (int i = 0; i < 4; ++i) { unsigned short* tp = T + (size_t)(col0 - tcol0 + bj * 128 + 4 * n + i) * ldt + row0;
#pragma unroll
                        for (int ai = 0; ai < 2; ++ai)
#pragma unroll
                            for (int m = 0; m < 4; ++m) tp[ai * 128 + m * 16] = (unsigned short)mk::f2bf(acc[ai][bj][m][n][i]); }
        }
    }
};

struct GemmDesc { const unsigned short* A; const unsigned short* Bt; int Mg, Ng, Kg; int kind; unsigned short* O; int ldc; int split_cols; float scale0; const float* base; float* out; int G, c; };

#ifndef REPEAT_PH
#define REPEAT_PH 1000
#define N_REPEAT 0
#else
#define N_REPEAT 1
#endif
struct Params { const float* in[17]; float* out; unsigned char* ws; int ph_lo, ph_hi; };
constexpr int N_PHASES = 18;

__global__ void __launch_bounds__(512, 2) fwd_mega(Params p) {
    extern __shared__ __attribute__((aligned(16))) unsigned char lds_raw[];
    using namespace mk;
    cg::grid_group grid = cg::this_grid();
    LAS unsigned char* lds = (LAS unsigned char*)lds_raw;
    const int bid = blockIdx.x, nblk = gridDim.x;
    const int ph_lo = p.ph_lo, ph_hi = p.ph_hi;
    { volatile LAS unsigned* misc = (volatile LAS unsigned*)(lds + LDS_MISC); if (mk_tid() < 16) misc[mk_tid()] = 0u; }
    __syncthreads();
    (void)xcd_barrier_post((unsigned*)(p.ws + WS_BAR), (volatile LAS unsigned*)(lds + LDS_MISC) + 8);
    grid.sync();
#ifdef PROBE_PH
    const unsigned long long t_start = __builtin_amdgcn_s_memrealtime();
#endif
#pragma unroll 1
    for (int ph_it = ph_lo; ph_it < ph_hi + N_REPEAT; ++ph_it) {
        const int ph = ph_it <= REPEAT_PH ? ph_it : ph_it - N_REPEAT;
        typedef const __attribute__((address_space(4))) Params* KP;
        KP kp = (KP)__builtin_amdgcn_kernarg_segment_ptr(); asm volatile("" : "+s"(kp));
        unsigned char* ws = kp->ws; float* OUT = kp->out; bf16* XN = (bf16*)(ws + WS_XN);
        In I; I.x = kp->in[0]; I.norm_mix = kp->in[1]; I.norm_ffn = kp->in[2]; I.w_in_ab = kp->in[3]; I.pool_w = kp->in[4]; I.pool_scale = kp->in[5]; I.q_norm = kp->in[6]; I.k_norm = kp->in[7];
        I.w_out_ab = kp->in[8]; I.w_in_c = kp->in[9]; I.b_gate = kp->in[10]; I.h_norm = kp->in[11]; I.w_out_c = kp->in[12]; I.w_up = kp->in[13]; I.conv_w = kp->in[14]; I.conv_b = kp->in[15]; I.w_down = kp->in[16];
        int nb_ = nblk; asm volatile("" : "+s"(nb_)); const int ngw = nb_ * NW, ngt = nb_ * 512;
        const int tid = mk_tid(), lane = tid & 63, wave = __builtin_amdgcn_readfirstlane(tid >> 6), gw = bid * NW + wave, gt = bid * 512 + tid;
#ifndef NO_THIN
        if (ph == 0) prologue(I, ws, lds, gw, ngw, wave, lane);
        if (ph == 5 || ph == 9 || ph == 14) rmsnorm_rows(OUT, ph == 5 ? I.norm_ffn : (ph == 9 ? I.norm_mix + D : I.norm_ffn + D), XN, gw, ngw, lane);
        if (ph == 2) qk_rope_pool((bf16*)(ws + WS_PROJ), I.q_norm, I.k_norm, (bf16*)(ws + WS_POOLED), gw, ngw, lane);
#endif
#ifndef NO_ATT
        if (ph == 3) {
            const bf16* PROJ = (const bf16*)(ws + WS_PROJ); bf16* CAT = (bf16*)(ws + WS_CAT);
            for (int u0 = bid; u0 < 384; u0 += nblk) {
                int u = u0;
                if (nblk == 256) { const int xcd = u0 & 7, j = (u0 >> 3) & 31, rnd = u0 >> 8; const int jj = j + 32 * rnd;
                    if (jj >= 48) continue; u = (xcd >> 2) * 192 + ((xcd & 3) * 3 + (jj >> 4)) * 16 + (jj & 15); }
                const int qb = u & 15, hq = (u >> 4) % 12, b = u / 192;
                const size_t r0 = (size_t)b * SEQ + (size_t)qb * 256;
                att::attn_dense_body<att::bf16>((const att::bf16*)(PROJ + r0 * ABW + 512 + hq * 128), (const att::bf16*)(PROJ + (size_t)b * SEQ * ABW + 2048 + (hq / 3) * 128),
                                                (const att::bf16*)(PROJ + (size_t)b * SEQ * ABW + 2560 + (hq / 3) * 128), CAT + r0 * D + 512 + hq * 128, SEQ, (char*)lds_raw);
                __syncthreads();
            }
        }
#endif
#ifndef NO_THIN
        if (ph == 7 || ph == 16) { const int l = ph == 7 ? 0 : 1; conv_fix((const bf16*)(ws + WS_U), I.conv_w + (size_t)l * 3 * FF2, I.conv_b + (size_t)l * FF2, (bf16*)(ws + WS_ACT), gt, ngt); }
        if (ph == 10) gates_phase(XN, (const bf16*)(ws + WS_C) + (size_t)8192 * D, I.b_gate, (float*)(ws + WS_GATES), (LAS float*)lds, bid, nblk);
#endif
#ifndef NO_ML
        if (ph == 11) ml::mlstm_phase(lds, (const bf16*)(ws + WS_QK), (const bf16*)(ws + WS_KVT), (const float*)(ws + WS_GATES), (float*)(ws + WS_HF), bid, nblk);
#endif
#ifndef NO_THIN
        if (ph == 12) headnorm_phase((const float*)(ws + WS_HF), (const bf16*)(ws + WS_OG), I.h_norm, (bf16*)(ws + WS_Y), gw, ngw, lane);
#endif
#pragma unroll 1
        for (int gi = 0; gi < 3; ++gi) {
            GemmDesc d; d.kind = -1; d.G = nblk; d.c = bid; d.split_cols = 0; d.scale0 = 1.f; d.base = nullptr; d.out = nullptr; d.O = nullptr; d.ldc = 0; d.A = nullptr; d.Bt = nullptr; d.Mg = M; d.Ng = 0; d.Kg = D;
            if (gi == 0) {
                if (ph == 1) { d.kind = 0; d.A = XN; d.Bt = (bf16*)(ws + WS_AB); d.Ng = ABW; d.O = (bf16*)(ws + WS_PROJ); d.ldc = ABW; }
                else if (ph == 3) { d.kind = 0; d.A = (bf16*)(ws + WS_POOLED); d.Bt = (bf16*)(ws + WS_BD); d.Ng = 512; d.Kg = 512; d.O = (bf16*)(ws + WS_CAT); d.ldc = D;
                    if (nblk == 256) { const int slot = bid >> 3; d.G = 64; d.c = (slot - 16) * 8 + (bid & 7); if (slot < 16 || slot >= 24) d.kind = -1; } }
                else if (ph == 4) { d.kind = 1; d.A = (bf16*)(ws + WS_CAT); d.Bt = (bf16*)(ws + WS_OAB); d.Ng = D; d.base = I.x; d.out = OUT; }
                else if (ph == 6 || ph == 15) { d.kind = 2; d.A = XN; d.Bt = (bf16*)(ws + (ph == 6 ? WS_UP0 : WS_UP1)); d.Ng = FF2; d.O = (bf16*)(ws + WS_U); d.ldc = FF2; d.base = I.conv_w + (size_t)(ph == 6 ? 0 : 1) * 3 * FF2; d.out = (float*)(I.conv_b + (size_t)(ph == 6 ? 0 : 1) * FF2); }
                else if (ph == 8 || ph == 17) { d.kind = 1; d.A = (bf16*)(ws + WS_ACT); d.Bt = (bf16*)(ws + (ph == 8 ? WS_DN0 : WS_DN1)); d.Ng = D; d.Kg = FF; d.base = OUT; d.out = OUT; }
                else if (ph == 10) { d.kind = 3; d.A = XN; d.Bt = (bf16*)(ws + WS_C); d.Ng = 4096; d.O = (bf16*)(ws + WS_QK); d.ldc = 4096; d.split_cols = 2048; d.scale0 = 0.0625f; }
                else if (ph == 13) { d.kind = 1; d.A = (bf16*)(ws + WS_Y); d.Bt = (bf16*)(ws + WS_OC); d.Ng = D; d.base = OUT; d.out = OUT; }
            } else if (ph == 10) {
                if (gi == 1) { d.kind = 0; d.A = XN; d.Bt = (bf16*)(ws + WS_C) + (size_t)6144 * D; d.Ng = D; d.O = (bf16*)(ws + WS_OG); d.ldc = D; }
                else { d.kind = 0; d.A = (bf16*)(ws + WS_C) + (size_t)4096 * D; d.Bt = XN; d.Mg = 2048; d.Ng = M; d.O = (bf16*)(ws + WS_KVT) + (size_t)2048 * M; d.ldc = M; }
            }
#ifndef NO_GEMM
            if (d.kind == 0) {
                pg8::Gemm g{d.A, d.Bt, d.Mg, d.Ng, d.Kg}; pg8::StaticOrder S; S.init(d.Mg, d.Ng, d.G, d.c);
                pg8::EpiBf16<0> E{d.O, d.ldc, nullptr, d.split_cols, (size_t)d.split_cols, d.scale0};
                pg8::gemm_phase<pg8::EpiBf16<0>, pg8::StaticOrder, true, true>(lds, g, S, E);
            } else if (d.kind == 3) {
                pg8::Gemm g{d.A, d.Bt, d.Mg, d.Ng, d.Kg}; pg8::StaticOrder S; S.init(d.Mg, d.Ng, d.G, d.c);
                EpiBf16T E{d.O, d.ldc, d.split_cols, d.scale0, (bf16*)(ws + WS_KVT), 2048, M};
                pg8::gemm_phase<EpiBf16T, pg8::StaticOrder, true, true>(lds, g, S, E);
            } else if (d.kind == 2) {
                pg8::Gemm g{d.A, d.Bt, d.Mg, d.Ng, d.Kg}; pg8::StaticOrder S; S.init(d.Mg, d.Ng, d.G, d.c);
                EpiConv E{(bf16*)(ws + WS_ACT), d.O, d.base, (const float*)d.out};
                pg8::gemm_phase<EpiConv, pg8::StaticOrder, true, true>(lds, g, S, E);
            } else if (d.kind == 1) {
                pg8::Gemm g{d.A, d.Bt, d.Mg, d.Ng, d.Kg}; pg8::StaticOrder S; S.init(d.Mg, d.Ng, d.G, d.c);
                EpiRes E{d.base, d.out, D};
                pg8::gemm_phase<EpiRes, pg8::StaticOrder, true, true>(lds, g, S, E);
            }
#endif
            __syncthreads();
        }
        if (ph_it + 1 < ph_hi + N_REPEAT) { XcdBarrier xbar; xbar.bar = (unsigned*)(ws + WS_BAR); xbar.x = xb_xcc_id(); xbar.st = (volatile LAS unsigned*)(lds + LDS_MISC) + 8; xcd_barrier(xbar);
#ifdef SYNC2
            xcd_barrier(xbar);
#endif
        }
#ifdef PROBE_PH
        if (bid == 0 && tid == 0) { unsigned long long* ts = (unsigned long long*)(ws + WS_BD + 768 * 1024); ts[ph + 1] = __builtin_amdgcn_s_memrealtime(); if (ph == 0) ts[0] = t_start;
            if (ph + 1 == ph_hi) { OUT[0] = (float)(ts[PROBE_PH + 1] - ts[PROBE_PH]) * 0.01f; } }
#endif
    }
}

#ifndef MK_MULTI
#define MK_MULTI 0
#endif
extern "C" void kernel_launch(void* const* d_in, const int* in_sizes, int n_in, void* d_out, int out_size, void* d_ws, size_t ws_size, hipStream_t stream) {
    static int grid = 0;
    if (grid == 0) {
        if (n_in != 17 || out_size != mk::M * mk::D || ws_size < mk::WS_END) { fprintf(stderr, "kernel_launch: unexpected shapes n_in %d out %d ws %zu (need %zu)\n", n_in, out_size, ws_size, (size_t)mk::WS_END); grid = -1; return; }
        int dev = 0, cus = 0, per_cu = 0;
        (void)hipGetDevice(&dev); (void)hipDeviceGetAttribute(&cus, hipDeviceAttributeMultiprocessorCount, dev);
        if (hipFuncSetAttribute((const void*)fwd_mega, hipFuncAttributeMaxDynamicSharedMemorySize, mk::LDS_BYTES) != hipSuccess) { fprintf(stderr, "kernel_launch: hipFuncSetAttribute failed\n"); grid = -1; return; }
        if (hipOccupancyMaxActiveBlocksPerMultiprocessor(&per_cu, (const void*)fwd_mega, 512, mk::LDS_BYTES) != hipSuccess || per_cu < 1) { fprintf(stderr, "kernel_launch: occupancy query gave %d\n", per_cu); per_cu = 1; }
        (void)hipGetLastError();
        if (cus <= 0) cus = 256;
        grid = cus * per_cu; if (grid > 256) grid = 256;
        fprintf(stderr, "kernel_launch: cus %d per_cu %d grid %d\n", cus, per_cu, grid);
    }
    if (grid < 0) return;
    if (hipMemsetAsync((char*)d_ws + mk::WS_BAR, 0, mk::BAR_BYTES, stream) != hipSuccess) { fprintf(stderr, "kernel_launch: memset failed\n"); return; }
    Params p{};
    for (int i = 0; i < 17; ++i) p.in[i] = (const float*)d_in[i];
    p.out = (float*)d_out; p.ws = (unsigned char*)d_ws;
#if MK_MULTI
    for (int ph = 0; ph < N_PHASES; ++ph) { p.ph_lo = ph; p.ph_hi = ph + 1; hipLaunchKernelGGL(fwd_mega, dim3(grid), dim3(512), mk::LDS_BYTES, stream, p); }
#else
    p.ph_lo = 0; p.ph_hi = N_PHASES;
    void* args[] = {&p};
    const hipError_t e = hipLaunchCooperativeKernel((const void*)fwd_mega, dim3(grid), dim3(512), args, mk::LDS_BYTES, stream);
    if (e != hipSuccess) fprintf(stderr, "kernel_launch: cooperative launch failed: %s (grid %d)\n", hipGetErrorString(e), grid);
#endif
}
```

```cpp
#include <hip/hip_runtime.h>
#include <hip/hip_cooperative_groups.h>
#include <hip/hip_bf16.h>
#include <cstdio>
#include <cstdint>
#include <cmath>
namespace cg = cooperative_groups;
__device__ __forceinline__ int mk_tid();
namespace pg8 {
#define PG8_LAS __attribute__((address_space(3)))
typedef unsigned short bf16_t;
typedef short bf16x8 __attribute__((ext_vector_type(8)));
typedef float f32x4 __attribute__((ext_vector_type(4)));
typedef unsigned u32x4 __attribute__((ext_vector_type(4)));
constexpr int BM = 256, BK = 64, HALF = 128, HTB = HALF * BK * 2  , STAGE_BYTES = 8 * HTB, NXCD = 8, WGM = 8;

__host__ __device__ __forceinline__ int lds_byte(int r, int c) { const int st = (r >> 4) * 2 + (c >> 5), rr = r & 15, cc = c & 31, ob = rr * 64 + cc * 2; return st * 1024 + (ob ^ (((ob >> 9) & 1) << 5)); }
__host__ __device__ __forceinline__ void stage_rc(int b, int& R, int& C) { const int st = b / 1024, sb = b % 1024, swz = sb ^ (((sb >> 9) & 1) << 5); R = (st >> 1) * 16 + swz / 64; C = (st & 1) * 32 + (swz % 64) / 2; }
__host__ __device__ __forceinline__ int perm32(int rho) { const int n = rho >> 4, i = rho & 15; return 8 * (i >> 2) + 4 * n + (i & 3); }

struct Unit { int pm, pn; };
struct Gemm { const bf16_t* A; const bf16_t* Bt; int M, N, K; };

struct StaticOrder {
    int nM, nN, nwg, G, c;
    __host__ __device__ void init(int M, int N, int G_, int c_) { nM = M / BM; nN = N / BM; nwg = nM * nN; G = G_; c = c_; }
    __host__ __device__ bool next(int i, Unit& u) const {
        const long L = (long)i * G + c; if (L >= nwg) return false;
        int wgid = (int)L; { const int q = nwg / NXCD, r = nwg % NXCD, xcd = wgid % NXCD, off = wgid / NXCD; wgid = (xcd < r ? xcd * (q + 1) : r * (q + 1) + (xcd - r) * q) + off; }
        const int nig = WGM * nN, gid = wgid / nig, fm = gid * WGM, gsz = (nM - fm) < WGM ? (nM - fm) : WGM;
        u.pm = fm + ((wgid % nig) % gsz); u.pn = (wgid % nig) / gsz; return true;
    }
    __device__ __forceinline__ void a_ready(const Unit&) const {}
    __device__ __forceinline__ void done(const Unit&) const {}
};

__device__ __forceinline__ unsigned cvt_pk_bf16(float lo, float hi) { unsigned r; asm volatile("v_cvt_pk_bf16_f32 %0, %1, %2" : "=v"(r) : "v"(lo), "v"(hi)); return r; }
typedef float f32x2 __attribute__((ext_vector_type(2)));
__device__ __forceinline__ f32x2 gelu_pk(f32x2 v) {
    const f32x2 av = __builtin_elementwise_abs(v), d = av * 0.2316418882f + 1.0f;
    f32x2 t; t.x = __builtin_amdgcn_rcpf(d.x); t.y = __builtin_amdgcn_rcpf(d.y);
    f32x2 q = t * 0.5307027145f + (-0.7265760135f); q = q * t + 0.7107068705f; q = q * t + (-0.142248368f); q = q * t + 0.127414796f; q = q * t;
    const f32x2 s = (v * v) * (-0.72134752044f);
    f32x2 e; e.x = __builtin_amdgcn_exp2f(s.x); e.y = __builtin_amdgcn_exp2f(s.y);
    const f32x2 m = v * (q * e), r = v - m;
    f32x2 o; o.x = v.x < 0.f ? m.x : r.x; o.y = v.y < 0.f ? m.y : r.y; return o;
}

template <int ACT  > struct EpiBf16 {
    static constexpr bool PERM = true, AFTER_DRAIN = false; static_assert(ACT == 0 || ACT == 1, "EpiBf16: ACT is 0 (none) or 1 (gelu_pk)");
    bf16_t* O; int ldc; const float* bias; int split_cols; size_t split_stride; float scale0;
    __device__ __forceinline__ void operator()(const f32x4 (&acc)[2][2][4][2], const Unit& u, int wr, int wc, int fr, int fq) const {
        const int row0 = u.pm * BM + wr * 64 + fr; int colt = u.pn * BM; bf16_t* base = O;
        float sc = 1.f; if (split_cols) { const int t = colt / split_cols; base += (size_t)t * split_stride; colt -= t * split_cols; if (t == 0) sc = scale0; }
        const int col0 = colt + wc * 32 + 8 * fq, bcol0 = u.pn * BM + wc * 32 + 8 * fq;
        f32x4 bv[2][2];
#pragma unroll
        for (int bj = 0; bj < 2; ++bj)
#pragma unroll
            for (int n = 0; n < 2; ++n) bv[bj][n] = bias ? *(const f32x4*)(bias + bcol0 + bj * HALF + 4 * n) : (f32x4){0.f, 0.f, 0.f, 0.f};
#pragma unroll
        for (int ai = 0; ai < 2; ++ai)
#pragma unroll
            for (int m = 0; m < 4; ++m) { bf16_t* rowp = base + (size_t)(row0 + ai * HALF + m * 16) * ldc + col0;
#pragma unroll
                for (int bj = 0; bj < 2; ++bj) { f32x4 v0 = acc[ai][bj][m][0] + bv[bj][0], v1 = acc[ai][bj][m][1] + bv[bj][1];
                    if (ACT == 1) { f32x2 a = gelu_pk((f32x2){v0[0], v0[1]}), b = gelu_pk((f32x2){v0[2], v0[3]}), c = gelu_pk((f32x2){v1[0], v1[1]}), d = gelu_pk((f32x2){v1[2], v1[3]});
                        v0 = (f32x4){a.x, a.y, b.x, b.y}; v1 = (f32x4){c.x, c.y, d.x, d.y}; }
                    v0 = v0 * sc; v1 = v1 * sc; u32x4 w; w.x = cvt_pk_bf16(v0[0], v0[1]); w.y = cvt_pk_bf16(v0[2], v0[3]); w.z = cvt_pk_bf16(v1[0], v1[1]); w.w = cvt_pk_bf16(v1[2], v1[3]);
                    *(u32x4*)(rowp + bj * HALF) = w; } }
    }
};

template <class Epi, class Sched, bool ALIGN_EPI = false, bool SP2 = false>
__device__ __forceinline__ void gemm_phase(PG8_LAS unsigned char* lds, const Gemm g, const Sched& S, const Epi& E) {
    const int tid = mk_tid(), wid = __builtin_amdgcn_readfirstlane(tid >> 6), lane = tid & 63, wr = wid >> 2, wc = wid & 3, fr = lane & 15, fq = lane >> 4;
    const int K = g.K, nt = K / BK;
    unsigned voffA[2], voffB[2];
#pragma unroll
    for (int i = 0; i < 2; ++i) { int R, C; stage_rc(tid * 16 + i * 8192, R, C); const int Rb = Epi::PERM ? ((R & ~31) + perm32(R & 31)) : R;
        voffA[i] = (unsigned)(R * K + C) * 2u; voffB[i] = (unsigned)(Rb * K + C) * 2u; }
    const size_t kstep = (size_t)(BK * 2);
    const size_t hstep = (size_t)HALF * K * 2;
    const size_t tstep = 2 * hstep;
    const unsigned ldsw = (unsigned)wid * 1024u;
    const int aoff = lds_byte(wr * 64 + fr, fq * 8), boff = lds_byte(wc * 32 + fr, fq * 8);
#define PG8_SA(b, h) (((b) * 2 + (h)) * HTB)
#define PG8_SB(b, h) ((4 + (b) * 2 + (h)) * HTB)
#define PG8_STAGE(bufoff, gbase, voff) do { _Pragma("unroll") for (int _i = 0; _i < 2; ++_i) \
        __builtin_amdgcn_global_load_lds((const unsigned*)((const char*)(gbase) + (voff)[_i]), (PG8_LAS unsigned*)(lds + (bufoff) + ldsw + _i * 8192), 16, 0, 0); } while (0)
#define PG8_LDA(dst, b, h) do { _Pragma("unroll") for (int m = 0; m < 4; ++m) _Pragma("unroll") for (int k = 0; k < 2; ++k) dst[m][k] = *(const PG8_LAS bf16x8*)(lds + PG8_SA(b, h) + aoff + m * 2048 + k * 1024); } while (0)
#define PG8_LDB(dst, b, h) do { _Pragma("unroll") for (int n = 0; n < 2; ++n) _Pragma("unroll") for (int k = 0; k < 2; ++k) dst[n][k] = *(const PG8_LAS bf16x8*)(lds + PG8_SB(b, h) + boff + n * 2048 + k * 1024); } while (0)
#define PG8_MMA(ai, bj, At, Bt) do { __builtin_amdgcn_s_setprio(1); _Pragma("unroll") for (int m = 0; m < 4; ++m) _Pragma("unroll") for (int n = 0; n < 2; ++n) _Pragma("unroll") for (int k = 0; k < 2; ++k) \
        acc[ai][bj][m][n] = __builtin_amdgcn_mfma_f32_16x16x32_bf16(Bt[n][k], At[m][k], acc[ai][bj][m][n], 0, 0, 0); __builtin_amdgcn_s_setprio(0); } while (0)
#define PG8_WAIT_V(n) asm volatile("s_waitcnt vmcnt(" #n ")" ::: "memory")
#define PG8_WAIT_L(n) asm volatile("s_waitcnt lgkmcnt(" #n ")" ::: "memory")
#define PG8_BAR __builtin_amdgcn_s_barrier()
#define PG8_SCHED __builtin_amdgcn_sched_barrier(0)
    Unit cur, nxt; int ui = 0;
    if (!S.next(0, cur)) return;
    f32x4 acc[2][2][4][2];
#pragma unroll
    for (int a = 0; a < 2; ++a)
#pragma unroll
        for (int b = 0; b < 2; ++b)
#pragma unroll
            for (int m = 0; m < 4; ++m)
#pragma unroll
                for (int n = 0; n < 2; ++n) acc[a][b][m][n] = (f32x4){0.f, 0.f, 0.f, 0.f};
    bf16x8 At[4][2], B0[2][2], B1[2][2];
    const char* cA = (const char*)g.A + (size_t)cur.pm * tstep; const char* cB = (const char*)g.Bt + (size_t)cur.pn * tstep;
    S.a_ready(cur);
    if constexpr (SP2) {
        PG8_STAGE(PG8_SB(0, 0), cB, voffB); PG8_STAGE(PG8_SB(0, 1), cB + hstep, voffB); PG8_STAGE(PG8_SA(0, 0), cA, voffA); PG8_STAGE(PG8_SA(0, 1), cA + hstep, voffA);
        if (wr == 1) PG8_BAR;
        PG8_WAIT_V(2); PG8_BAR;
        PG8_STAGE(PG8_SB(1, 0), cB + kstep, voffB); PG8_STAGE(PG8_SA(1, 0), cA + kstep, voffA); PG8_STAGE(PG8_SB(1, 1), cB + hstep + kstep, voffB);
        PG8_WAIT_V(6); PG8_BAR;
    } else {
        PG8_STAGE(PG8_SB(0, 0), cB, voffB); PG8_STAGE(PG8_SA(0, 0), cA, voffA); PG8_STAGE(PG8_SB(0, 1), cB + hstep, voffB); PG8_STAGE(PG8_SA(0, 1), cA + hstep, voffA);
        if (wr == 1) PG8_BAR;
        PG8_WAIT_V(4); PG8_BAR;
        PG8_STAGE(PG8_SB(1, 0), cB + kstep, voffB); PG8_STAGE(PG8_SA(1, 0), cA + kstep, voffA); PG8_STAGE(PG8_SB(1, 1), cB + hstep + kstep, voffB);
        PG8_WAIT_V(6); PG8_BAR;
    }
    for (;;) {
        const bool has_next = S.next(ui + 1, nxt);
        const char* nA = has_next ? (const char*)g.A + (size_t)nxt.pm * tstep : cA; const char* nB = has_next ? (const char*)g.Bt + (size_t)nxt.pn * tstep : cB;
        for (int t = 0; t < nt; t += 2) {
            const bool last = (t == nt - 2);
            const char* a1 = cA + (size_t)(t + 1) * kstep;
            const char* a2 = last ? nA : cA + (size_t)(t + 2) * kstep; const char* b2 = last ? nB : cB + (size_t)(t + 2) * kstep;
            const char* a3 = a2 + kstep; const char* b3 = b2 + kstep;
            if (last && has_next) S.a_ready(nxt);
            if constexpr (SP2) {
            PG8_LDB(B0, 0, 0); PG8_LDB(B1, 0, 1); PG8_SCHED; PG8_LDA(At, 0, 0); PG8_STAGE(PG8_SA(1, 1), a1 + hstep, voffA);
            PG8_WAIT_V(8); PG8_WAIT_L(0); PG8_BAR; PG8_MMA(0, 0, At, B0); PG8_MMA(0, 1, At, B1); PG8_BAR; PG8_SCHED;
            PG8_LDA(At, 0, 1); PG8_STAGE(PG8_SB(0, 0), b2, voffB); PG8_STAGE(PG8_SB(0, 1), b2 + hstep, voffB); PG8_STAGE(PG8_SA(0, 0), a2, voffA);
            PG8_WAIT_V(8); PG8_WAIT_L(0); PG8_BAR; PG8_MMA(1, 0, At, B0); PG8_MMA(1, 1, At, B1); PG8_BAR; PG8_SCHED;
            PG8_LDB(B0, 1, 0); PG8_LDB(B1, 1, 1); PG8_SCHED; PG8_LDA(At, 1, 0); PG8_STAGE(PG8_SA(0, 1), a2 + hstep, voffA);
            PG8_WAIT_V(8); PG8_WAIT_L(0); PG8_BAR; PG8_MMA(0, 0, At, B0); PG8_MMA(0, 1, At, B1); PG8_BAR; PG8_SCHED;
            PG8_LDA(At, 1, 1); PG8_STAGE(PG8_SB(1, 0), b3, voffB); PG8_STAGE(PG8_SB(1, 1), b3 + hstep, voffB); PG8_STAGE(PG8_SA(1, 0), a3, voffA);
            PG8_WAIT_V(8); PG8_WAIT_L(0); PG8_BAR; PG8_MMA(1, 0, At, B0); PG8_MMA(1, 1, At, B1); PG8_BAR; PG8_SCHED;
            } else {
            PG8_LDB(B0, 0, 0); PG8_SCHED; PG8_LDA(At, 0, 0); PG8_STAGE(PG8_SA(1, 1), a1 + hstep, voffA);
            PG8_WAIT_L(8); PG8_BAR; PG8_WAIT_L(0); PG8_MMA(0, 0, At, B0); PG8_BAR; PG8_SCHED;
            PG8_LDB(B1, 0, 1); PG8_STAGE(PG8_SB(0, 0), b2, voffB);
            PG8_BAR; PG8_WAIT_L(0); PG8_MMA(0, 1, At, B1); PG8_BAR;
            PG8_LDA(At, 0, 1); PG8_STAGE(PG8_SA(0, 0), a2, voffA);
            PG8_BAR; PG8_WAIT_L(0); PG8_MMA(1, 0, At, B0); PG8_BAR; PG8_SCHED;
            PG8_STAGE(PG8_SB(0, 1), b2 + hstep, voffB);
            PG8_WAIT_V(6); PG8_BAR; PG8_MMA(1, 1, At, B1); PG8_BAR;
            PG8_LDB(B0, 1, 0); PG8_SCHED; PG8_LDA(At, 1, 0); PG8_STAGE(PG8_SA(0, 1), a2 + hstep, voffA);
            PG8_WAIT_L(8); PG8_BAR; PG8_WAIT_L(0); PG8_MMA(0, 0, At, B0); PG8_BAR; PG8_SCHED;
            PG8_LDB(B1, 1, 1); PG8_STAGE(PG8_SB(1, 0), b3, voffB);
            PG8_BAR; PG8_WAIT_L(0); PG8_MMA(0, 1, At, B1); PG8_BAR;
            PG8_LDA(At, 1, 1); PG8_STAGE(PG8_SA(1, 0), a3, voffA);
            PG8_BAR; PG8_WAIT_L(0); PG8_MMA(1, 0, At, B0); PG8_BAR; PG8_SCHED;
            PG8_STAGE(PG8_SB(1, 1), b3 + hstep, voffB);
            PG8_WAIT_V(6); PG8_BAR; PG8_MMA(1, 1, At, B1); PG8_BAR;
            }
        }
        if constexpr (ALIGN_EPI) { if (wr == 0) PG8_BAR; }
        if constexpr (!Epi::AFTER_DRAIN) { E(acc, cur, wr, wc, fr, fq); S.done(cur); }
        if (!has_next) break;
#pragma unroll
        for (int a = 0; a < 2; ++a)
#pragma unroll
            for (int b = 0; b < 2; ++b)
#pragma unroll
                for (int m = 0; m < 4; ++m)
#pragma unroll
                    for (int n = 0; n < 2; ++n) acc[a][b][m][n] = (f32x4){0.f, 0.f, 0.f, 0.f};
        cur = nxt; cA = nA; cB = nB; ++ui;
        if constexpr (ALIGN_EPI) { if (wr == 1) PG8_BAR; }
    }
    PG8_WAIT_V(0);
    if constexpr (!ALIGN_EPI) { if (wr == 0) PG8_BAR; }
    PG8_BAR;
    if constexpr (Epi::AFTER_DRAIN) { E.fused(acc, cur, wr, wc, fr, fq, lds, wid, lane); S.done(cur); }
#undef PG8_SA
#undef PG8_SB
#undef PG8_STAGE
#undef PG8_LDA
#undef PG8_LDB
#undef PG8_MMA
#undef PG8_WAIT_V
#undef PG8_WAIT_L
#undef PG8_BAR
#undef PG8_SCHED
}
}

namespace att {
using bf16 = __hip_bfloat16;
constexpr int   D = 128, NW = 8, QBLK = 32, KVBLK = 64;
constexpr float SCALE = 0.088388347648318440f;
constexpr float THR = 8.f;
constexpr int SDEPTH = 2;
constexpr int LDQ = 3072, LDK = 3072, LDO = 2048;
constexpr size_t SHM_V = KVBLK * D * 2, SHM_K = KVBLK * D * 2, SHM_ATTN = 2 * SHM_V + 2 * SHM_K + NW * 64 * 4;
using bf16x8 = __attribute__((ext_vector_type(8))) short;
using s16x4  = __attribute__((ext_vector_type(4))) short;
using f32x16 = __attribute__((ext_vector_type(16))) float;
using f32x8  = __attribute__((ext_vector_type(8))) float;
using u32x4  = __attribute__((ext_vector_type(4))) unsigned;
#define KSWZ(row, colB) ((row) * 256 + ((colB) ^ (((row) & 7) << 4)))
#define SBAR() __builtin_amdgcn_sched_barrier(0)
__device__ __forceinline__ int crow(int r, int hi) { return (r & 3) + 8 * (r >> 2) + 4 * hi; }
__device__ __forceinline__ unsigned cvtpk(float lo, float hi) {
  unsigned r; asm volatile("v_cvt_pk_bf16_f32 %0, %1, %2" : "=v"(r) : "v"(lo), "v"(hi)); return r;
}
template <typename TIn> struct Stage;
template <> struct Stage<bf16>  { using T = bf16x8;
  __device__ static __forceinline__ T ld8(const bf16* p) { return *reinterpret_cast<const bf16x8*>(p); }
  __device__ static __forceinline__ bf16x8 tobf(T x) { return x; } };
template <> struct Stage<float> { using T = f32x8;
  __device__ static __forceinline__ T ld8(const float* p) { return *reinterpret_cast<const f32x8*>(p); }
  __device__ static __forceinline__ bf16x8 tobf(T x) {
    u32x4 w = {cvtpk(x[0], x[1]), cvtpk(x[2], x[3]), cvtpk(x[4], x[5]), cvtpk(x[6], x[7])}; return *reinterpret_cast<bf16x8*>(&w); } };

__device__ __forceinline__ void partialSM(f32x16& p0, f32x16& p1, float& m_reg, float& mn, float& alpha) {
  constexpr float C = SCALE * 1.4426950408889634f;
  float pmax = p0[0]; for (int r = 1; r < 16; ++r) pmax = fmaxf(pmax, p0[r]); for (int r = 0; r < 16; ++r) pmax = fmaxf(pmax, p1[r]);
  { auto rr = __builtin_amdgcn_permlane32_swap(__float_as_uint(pmax), __float_as_uint(pmax), false, false);
    pmax = fmaxf(__uint_as_float(rr[0]), __uint_as_float(rr[1])); }
  if (__builtin_expect(__all(pmax - m_reg <= THR / SCALE), 1)) { mn = m_reg; alpha = 1.f; }
  else { mn = fmaxf(m_reg, pmax); alpha = __builtin_amdgcn_exp2f((m_reg - mn) * C); m_reg = mn; }
  float mnC = -mn * C;
  for (int r = 0; r < 16; ++r) p0[r] = fmaf(p0[r], C, mnC); for (int r = 0; r < 16; ++r) p1[r] = fmaf(p1[r], C, mnC);
  for (int r = 0; r < 16; ++r) p0[r] = __builtin_amdgcn_exp2f(p0[r]);
}
__device__ __forceinline__ void finishSM(f32x16& p0, f32x16& p1, float alpha, float& l_reg, bf16x8& pa0, bf16x8& pa1, bf16x8& pa2, bf16x8& pa3) {
  for (int r = 0; r < 16; ++r) p1[r] = __builtin_amdgcn_exp2f(p1[r]);
  float ps = 0; for (int r = 0; r < 16; ++r) ps += p0[r]; for (int r = 0; r < 16; ++r) ps += p1[r];
  { auto rr = __builtin_amdgcn_permlane32_swap(__float_as_uint(ps), __float_as_uint(ps), false, false);
    ps = __uint_as_float(rr[0]) + __uint_as_float(rr[1]); }
  l_reg = l_reg * alpha + ps;
#define PK4(P, BASE, OUT) do { unsigned a0 = cvtpk(P[BASE + 0], P[BASE + 1]), a1 = cvtpk(P[BASE + 2], P[BASE + 3]);   \
    unsigned b0 = cvtpk(P[BASE + 4], P[BASE + 5]), b1 = cvtpk(P[BASE + 6], P[BASE + 7]);                              \
    auto r0 = __builtin_amdgcn_permlane32_swap(a0, b0, false, false); auto r1 = __builtin_amdgcn_permlane32_swap(a1, b1, false, false); \
    u32x4 w = {r0[0], r1[0], r0[1], r1[1]}; OUT = *reinterpret_cast<bf16x8*>(&w); } while (0)
  PK4(p0, 0, pa0); PK4(p0, 8, pa1); PK4(p1, 0, pa2); PK4(p1, 8, pa3);
#undef PK4
}
__device__ __forceinline__ void qkt(f32x16& p0, f32x16& p1, const bf16* Ks, const bf16x8* qr, int r32, int hi) {
  p0 = f32x16{}; p1 = f32x16{};
  for (int d0 = 0; d0 < 8; ++d0) { int cb = (d0 * 16 + hi * 8) * 2;
    bf16x8 b0 = *reinterpret_cast<const bf16x8*>((const char*)Ks + KSWZ(r32, cb));
    bf16x8 b1 = *reinterpret_cast<const bf16x8*>((const char*)Ks + KSWZ(32 + r32, cb));
    p0 = __builtin_amdgcn_mfma_f32_32x32x16_bf16(b0, qr[d0], p0, 0, 0, 0);
    p1 = __builtin_amdgcn_mfma_f32_32x32x16_bf16(b1, qr[d0], p1, 0, 0, 0); }
}
__device__ __forceinline__ int v_st(int k, int c) { const int kk = (k & ~0xC) | ((k & 4) << 1) | ((k & 8) >> 1); return ((kk >> 3) * 4 + (c >> 5)) * 512 + ((kk & 7) * 32 + (c & 31)) * 2; }
__device__ __forceinline__ int v_rd_base(int lane) { return ((lane & 3) << 3) | (((lane >> 2) & 3) << 6) | (((lane >> 4) & 1) << 5) | (((lane >> 5) & 1) << 8); }
constexpr int v_rd_off(int d0, int ks, int half) { return d0 * 512 + ks * 4096 + half * 2048; }
template <int OFF> __device__ __forceinline__ s16x4 tr_read(int vb) {
  s16x4 r; asm volatile("ds_read_b64_tr_b16 %0, %1 offset:%2" : "=&v"(r) : "v"(vb), "i"(OFF) : "memory"); return r;
}
template <int D0> __device__ __forceinline__ void pv_one(f32x16& od, int vb, bf16x8 pa0, bf16x8 pa1, bf16x8 pa2, bf16x8 pa3) {
  const s16x4 l0 = tr_read<v_rd_off(D0, 0, 0)>(vb), h0 = tr_read<v_rd_off(D0, 0, 1)>(vb), l1 = tr_read<v_rd_off(D0, 1, 0)>(vb), h1 = tr_read<v_rd_off(D0, 1, 1)>(vb);
  const s16x4 l2 = tr_read<v_rd_off(D0, 2, 0)>(vb), h2 = tr_read<v_rd_off(D0, 2, 1)>(vb), l3 = tr_read<v_rd_off(D0, 3, 0)>(vb), h3 = tr_read<v_rd_off(D0, 3, 1)>(vb);
  asm volatile("s_waitcnt lgkmcnt(0)" ::: "memory"); SBAR();
#define PK(L, H) (bf16x8){L[0], L[1], L[2], L[3], H[0], H[1], H[2], H[3]}
  od = __builtin_amdgcn_mfma_f32_32x32x16_bf16(pa0, PK(l0, h0), od, 0, 0, 0);
  od = __builtin_amdgcn_mfma_f32_32x32x16_bf16(pa1, PK(l1, h1), od, 0, 0, 0);
  od = __builtin_amdgcn_mfma_f32_32x32x16_bf16(pa2, PK(l2, h2), od, 0, 0, 0);
  od = __builtin_amdgcn_mfma_f32_32x32x16_bf16(pa3, PK(l3, h3), od, 0, 0, 0);
#undef PK
}
__device__ __forceinline__ void pv_d0(f32x16* o, int vb, bf16x8 pa0, bf16x8 pa1, bf16x8 pa2, bf16x8 pa3) {
  pv_one<0>(o[0], vb, pa0, pa1, pa2, pa3); pv_one<1>(o[1], vb, pa0, pa1, pa2, pa3); pv_one<2>(o[2], vb, pa0, pa1, pa2, pa3); pv_one<3>(o[3], vb, pa0, pa1, pa2, pa3);
}

template <typename TQ>
__device__ __forceinline__ void attn_dense_body(const TQ* __restrict__ Qb, const bf16* __restrict__ Kh, const bf16* __restrict__ Vh,
                                                unsigned short* __restrict__ Ob, int seq, char* lds) {
  using St = Stage<bf16>; using SQ = Stage<TQ>;
  const int tid = mk_tid(), wid = tid >> 6, lane = tid & 63, r32 = lane & 31, hi = lane >> 5;
  bf16* V_lds = (bf16*)lds; bf16* K_lds = (bf16*)(lds + 2 * SHM_V);
  float* ws = (float*)(lds + 2 * SHM_V + 2 * SHM_K) + wid * 64; float* li_l = ws; float* al_l = ws + 32;
  float m_reg = -1e30f, l_reg = 0; f32x16 o[4] = {}; bf16x8 qr[8];
  const TQ* Qw = Qb + (long)(wid * QBLK + r32) * LDQ + hi * 8;
#pragma unroll
  for (int d0 = 0; d0 < 8; ++d0) qr[d0] = SQ::tobf(SQ::ld8(Qw + d0 * 16));
  const int sr = tid >> 4, sc = (tid & 15) * 8, vst0 = v_st(sr, sc), vst1 = v_st(32 + sr, sc);
  const int vb0 = (int)(uintptr_t)V_lds + v_rd_base(lane);
  struct { typename St::T vs0, vs1, ks0, ks1; } sr_[SDEPTH];
#define SLOAD(i, k0) do { sr_[i].vs0 = St::ld8(&Vh[(long)((k0) + sr) * LDK + sc]); sr_[i].vs1 = St::ld8(&Vh[(long)((k0) + 32 + sr) * LDK + sc]); \
    sr_[i].ks0 = St::ld8(&Kh[(long)((k0) + sr) * LDK + sc]); sr_[i].ks1 = St::ld8(&Kh[(long)((k0) + 32 + sr) * LDK + sc]); } while (0)
#define SWRITE(b, i) do { *(bf16x8*)((char*)V_lds + (b) * SHM_V + vst0) = St::tobf(sr_[i].vs0);          \
    *(bf16x8*)((char*)V_lds + (b) * SHM_V + vst1) = St::tobf(sr_[i].vs1); int kc = sc * 2;               \
    *(bf16x8*)((char*)K_lds + (b) * SHM_K + KSWZ(sr, kc)) = St::tobf(sr_[i].ks0);                       \
    *(bf16x8*)((char*)K_lds + (b) * SHM_K + KSWZ(32 + sr, kc)) = St::tobf(sr_[i].ks1); } while (0)
#define SWAIT() do { if constexpr (SDEPTH == 2) asm volatile("s_waitcnt vmcnt(4)" ::: "memory"); else asm volatile("s_waitcnt vmcnt(0)" ::: "memory"); } while (0)
#define RESC(a) do { if (__any((a) < 1.f)) { if (hi == 0) al_l[r32] = (a); asm volatile("s_waitcnt lgkmcnt(0)" ::: "memory"); \
    for (int d = 0; d < 4; ++d) for (int r = 0; r < 16; ++r) o[d][r] *= al_l[crow(r, hi)]; } } while (0)
  f32x16 pA0, pA1, pB0, pB1; float mnA, mnB, alA, alB; bf16x8 pa0, pa1, pa2, pa3; const int NT = seq / KVBLK;
  constexpr int SE = 0, SO = SDEPTH - 1;
  SLOAD(SE, 0); asm volatile("s_waitcnt vmcnt(0)" ::: "memory"); SWRITE(0, SE); __syncthreads();
  qkt(pA0, pA1, K_lds, qr, r32, hi); partialSM(pA0, pA1, m_reg, mnA, alA);
  SLOAD(SO, KVBLK); if constexpr (SDEPTH == 2) { if (2 < NT) SLOAD(SE, 2 * KVBLK); }
  SWAIT(); SWRITE(1, SO); __syncthreads();
  for (int j = 1; j + 1 < NT; j += 2) {
    SBAR(); qkt(pB0, pB1, (bf16*)((char*)K_lds + SHM_K), qr, r32, hi);
    finishSM(pA0, pA1, alA, l_reg, pa0, pa1, pa2, pa3); SBAR();
    SLOAD(SO, (j + SDEPTH) * KVBLK); SBAR();
    pv_d0(o, vb0, pa0, pa1, pa2, pa3); partialSM(pB0, pB1, m_reg, mnB, alB);
    __syncthreads(); SWAIT(); SWRITE(0, SE);
    RESC(alB); __syncthreads();
    SBAR(); qkt(pA0, pA1, K_lds, qr, r32, hi);
    finishSM(pB0, pB1, alB, l_reg, pa0, pa1, pa2, pa3); SBAR();
    if (SDEPTH == 1 || j + 3 < NT) SLOAD(SE, (j + 1 + SDEPTH) * KVBLK); SBAR();
    pv_d0(o, vb0 + (int)SHM_V, pa0, pa1, pa2, pa3); partialSM(pA0, pA1, m_reg, mnA, alA);
    __syncthreads(); SWAIT(); SWRITE(1, SO);
    RESC(alA); __syncthreads();
  }
  SBAR(); qkt(pB0, pB1, (bf16*)((char*)K_lds + SHM_K), qr, r32, hi);
  finishSM(pA0, pA1, alA, l_reg, pa0, pa1, pa2, pa3); SBAR();
  pv_d0(o, vb0, pa0, pa1, pa2, pa3); partialSM(pB0, pB1, m_reg, mnB, alB);
  __syncthreads(); RESC(alB);
  finishSM(pB0, pB1, alB, l_reg, pa0, pa1, pa2, pa3); SBAR();
  pv_d0(o, vb0 + (int)SHM_V, pa0, pa1, pa2, pa3);
  if (hi == 0) li_l[r32] = l_reg; asm volatile("s_waitcnt lgkmcnt(0)" ::: "memory");
  float rli[16];
#pragma unroll
  for (int r = 0; r < 16; ++r) rli[r] = __builtin_amdgcn_rcpf(li_l[crow(r, hi)]);
  unsigned short* Ow = Ob + (long)(wid * QBLK) * LDO;
#pragma unroll
  for (int r = 0; r < 16; ++r) { int orow = crow(r, hi);
    for (int d0 = 0; d0 < 4; ++d0) Ow[(long)orow * LDO + d0 * 32 + r32] = (unsigned short)(cvtpk(o[d0][r] * rli[r], 0.f) & 0xffffu); }
#undef SLOAD
#undef SWRITE
#undef SWAIT
#undef RESC
}

}
__device__ __forceinline__ int mk_tid() { int t = threadIdx.x; asm volatile("" : "+v"(t)); return t; }
namespace mk {
#define LAS __attribute__((address_space(3)))
typedef unsigned short bf16;
typedef short bf16x8 __attribute__((ext_vector_type(8)));
typedef float f32x4 __attribute__((ext_vector_type(4)));
typedef unsigned u32x4 __attribute__((ext_vector_type(4)));
typedef unsigned u32x2 __attribute__((ext_vector_type(2)));
#define XB_TMO      128
#define XB_XCNT(j)  (256  + 64 * (j))
#define XB_XSUB(j)  (1280 + 64 * (j))
#define XB_XGEN(j)  (2304 + 64 * (j))
#define XB_TOP      3328
#define XB_TOPGEN   3392
#define XCD_BAR_WORDS 3456
#define XB_SPIN_CAP (1u << 18)

__device__ __forceinline__ unsigned xb_ld(unsigned* p)              { return __hip_atomic_load(p, __ATOMIC_RELAXED, __HIP_MEMORY_SCOPE_AGENT); }
__device__ __forceinline__ unsigned xb_add(unsigned* p, unsigned v) { return __hip_atomic_fetch_add(p, v, __ATOMIC_RELAXED, __HIP_MEMORY_SCOPE_AGENT); }
__device__ __forceinline__ unsigned xb_xcc_id() { return (unsigned)__builtin_amdgcn_s_getreg((3 << 11) | 20) & 0xFu; }
#define XB_SPIN(cond, bar) do { unsigned _sp = 0; while (cond) { __builtin_amdgcn_s_sleep(1); \
    if ((++_sp & 255u) == 0u) { if (xb_ld(&(bar)[XB_TMO])) break; if (_sp > XB_SPIN_CAP) { atomicAdd(&(bar)[XB_TMO], 1u); break; } } } } while (0)

struct XcdBarrier {
    unsigned* bar; unsigned x;
    volatile LAS unsigned* st;
};

__device__ __forceinline__ XcdBarrier xcd_barrier_post(unsigned* bar, volatile LAS unsigned* st) {
    XcdBarrier b; b.bar = bar; b.x = xb_xcc_id(); b.st = st;
    if (mk_tid() == 0) (void)xb_add(&bar[XB_XCNT(b.x)], 1u);
    return b;
}
__device__ __forceinline__ void xcd_barrier_complete(unsigned* bar, unsigned x, unsigned& nloc, unsigned& nx) {
    const unsigned G = gridDim.x * gridDim.y * gridDim.z;
    unsigned sum, cnt, mine, sp = 0u;
    for (;;) {
        sum = 0u; cnt = 0u; mine = 0u;
#pragma unroll
        for (unsigned j = 0; j < 16; ++j) { const unsigned c = xb_ld(&bar[XB_XCNT(j)]); sum += c; cnt += (c > 0u) ? 1u : 0u; mine = (j == x) ? c : mine; }
        if (sum == G) break;
        __builtin_amdgcn_s_sleep(1);
        if ((++sp & 255u) == 0u) { if (xb_ld(&bar[XB_TMO])) break; if (sp > XB_SPIN_CAP) { atomicAdd(&bar[XB_TMO], 1u); break; } }
    }
    nloc = mine > 0u ? mine : 1u; nx = cnt > 0u ? cnt : 1u;
}

__device__ __forceinline__ void xcd_barrier(const XcdBarrier& b) {
    asm volatile("s_waitcnt vmcnt(0)" ::: "memory");
    __syncthreads();
    if (mk_tid() == 0) {
        unsigned* bar = b.bar;
        __builtin_amdgcn_s_waitcnt(0);
        unsigned nloc = b.st[0], nx = b.st[1];
        if (nloc == 0u) { xcd_barrier_complete(bar, b.x, nloc, nx); b.st[0] = nloc; b.st[1] = nx; }
        const unsigned old = xb_add(&bar[XB_XSUB(b.x)], 1u);
        const unsigned gen = old / nloc;
        if (old + 1u == (gen + 1u) * nloc) {
            __builtin_amdgcn_fence(__ATOMIC_RELEASE, "agent");
            asm volatile("s_waitcnt vmcnt(0)" ::: "memory");
            const unsigned og = xb_add(&bar[XB_TOP], 1u);
            const unsigned tg = og / nx;
            if (og + 1u == (tg + 1u) * nx) xb_add(&bar[XB_TOPGEN], 1u);
            else XB_SPIN(xb_ld(&bar[XB_TOPGEN]) == tg, bar);
            __builtin_amdgcn_fence(__ATOMIC_ACQUIRE, "agent");
            xb_add(&bar[XB_XGEN(b.x)], 1u);
            asm volatile("s_waitcnt vmcnt(0)" ::: "memory");
        } else {
            XB_SPIN(xb_ld(&bar[XB_XGEN(b.x)]) == gen, bar);
            __builtin_amdgcn_fence(__ATOMIC_ACQUIRE, "agent");
            asm volatile("s_waitcnt vmcnt(0)" ::: "memory");
        }
    }
    __syncthreads();
}


constexpr int D = 2048, M = 8192, SEQ = 4096, NW = 8;
constexpr int ABW = 3072, CW = 8224, FF2 = 11264, FF = 5632;
constexpr float EPS = 1e-6f;
constexpr size_t MiB = 1u << 20;
constexpr size_t WS_AB = 0, WS_BD = 12 * MiB, WS_OAB = 13 * MiB, WS_C = 21 * MiB  , WS_OC = 54 * MiB;
constexpr size_t WS_UP0 = 62 * MiB, WS_UP1 = 106 * MiB, WS_DN0 = 150 * MiB, WS_DN1 = 172 * MiB;
constexpr size_t WS_XN = 194 * MiB, WS_GATES = 226 * MiB, WS_S = 228 * MiB;
constexpr size_t WS_PROJ = WS_S, WS_POOLED = WS_S + 48 * MiB, WS_CAT = WS_S + 56 * MiB;
constexpr size_t WS_QK = WS_S, WS_OG = WS_S + 64 * MiB, WS_KVT = WS_S + 96 * MiB, WS_HF = WS_S + 160 * MiB, WS_Y = WS_S + 288 * MiB;
constexpr size_t WS_U = WS_S, WS_ACT = WS_S + 176 * MiB;
constexpr size_t WS_END = WS_S + 320 * MiB;
constexpr int LDS_ML = 154112 + 1024, LDS_MISC = LDS_ML, LDS_BYTES = LDS_ML + 64;
constexpr size_t WS_BAR = WS_BD + 768 * 1024, BAR_BYTES = 16384;

#define LDSWAIT() asm volatile("s_waitcnt lgkmcnt(0)" ::: "memory")
__device__ __forceinline__ unsigned f2bf(float f) { unsigned u = __float_as_uint(f); return (u + 0x7fffu + ((u >> 16) & 1u)) >> 16; }
__device__ __forceinline__ unsigned pk2(float lo, float hi) { unsigned r; asm volatile("v_cvt_pk_bf16_f32 %0, %1, %2" : "=v"(r) : "v"(lo), "v"(hi)); return r; }
__device__ __forceinline__ float bflo(unsigned w) { return __uint_as_float(w << 16); }
__device__ __forceinline__ float bfhi(unsigned w) { return __uint_as_float(w & 0xffff0000u); }
__device__ __forceinline__ float wave_sum(float v) {
#pragma unroll
    for (int o = 1; o < 64; o <<= 1) v += __shfl_xor(v, o);
    return v;
}

__device__ __forceinline__ void transpose_item64(const float* __restrict__ W, int ldw, int K, int nblk, bf16* __restrict__ WT, LAS float* scr, int item, int lane, bool upperm) {
    const int kb = item / nblk, nb = item - kb * nblk, k0 = 64 * kb, n0 = 64 * nb;
    const int d0 = !upperm ? n0 : (n0 < FF ? 256 * (n0 >> 7) + (n0 & 127) : 256 * ((n0 - FF) >> 7) + 128 + ((n0 - FF) & 127));
    f32x4 v[16];
#pragma unroll
    for (int i = 0; i < 16; ++i) { const int kk = 4 * i + (lane >> 4); v[i] = *(const f32x4*)(W + (size_t)(k0 + kk) * ldw + n0 + 4 * (lane & 15)); }
#pragma unroll
    for (int i = 0; i < 16; ++i) { const int kk = 4 * i + (lane >> 4); LAS float* s = scr + kk * 65 + 4 * (lane & 15); s[0] = v[i].x; s[1] = v[i].y; s[2] = v[i].z; s[3] = v[i].w; }
    LDSWAIT();
    const int c = lane & 7, q = lane >> 3;
#pragma unroll
    for (int j = 0; j < 8; ++j) { const int n = q + 8 * j; const LAS float* s = scr + (8 * c) * 65 + n;
        u32x4 o; o.x = pk2(s[0], s[65]); o.y = pk2(s[130], s[195]); o.z = pk2(s[260], s[325]); o.w = pk2(s[390], s[455]);
        *(u32x4*)(WT + (size_t)(d0 + n) * K + k0 + 8 * c) = o; }
    LDSWAIT();
}

__device__ __forceinline__ void rmsnorm_rows(const float* __restrict__ src, const float* __restrict__ gain, bf16* __restrict__ dst, int gw, int ngw, int lane) {
    f32x4 g[8];
#pragma unroll
    for (int j = 0; j < 8; ++j) g[j] = *(const f32x4*)(gain + 4 * lane + 256 * j);
    for (int m = gw; m < M; m += ngw) {
        const f32x4* xr = (const f32x4*)(src + (size_t)m * D) + lane; f32x4 v[8]; float s = 0.f;
#pragma unroll
        for (int j = 0; j < 8; ++j) { v[j] = xr[64 * j]; s += (v[j].x * v[j].x + v[j].y * v[j].y) + (v[j].z * v[j].z + v[j].w * v[j].w); }
        const float rstd = 1.0f / sqrtf(wave_sum(s) * (1.0f / D) + EPS);
        u32x2* o = (u32x2*)(dst + (size_t)m * D) + lane;
#pragma unroll
        for (int j = 0; j < 8; ++j) { u32x2 w; w.x = pk2(v[j].x * rstd * g[j].x, v[j].y * rstd * g[j].y); w.y = pk2(v[j].z * rstd * g[j].z, v[j].w * rstd * g[j].w); o[64 * j] = w; }
    }
}

struct In { const float *x, *norm_mix, *norm_ffn, *w_in_ab, *pool_w, *pool_scale, *q_norm, *k_norm, *w_out_ab, *w_in_c, *b_gate, *h_norm, *w_out_c, *w_up, *conv_w, *conv_b, *w_down; };

__device__ __forceinline__ void transposes(const In& I, unsigned char* ws, LAS unsigned char* lds, int first, int last, int w, int nw, int wave, int lane) {
    LAS float* scr = (LAS float*)(lds + wave * 16640);
    for (int it = first + w; it < last; it += nw) {
        const float* W; int ldw, K, nblk; bf16* WT; int r = it;
        if (r < 1536) { W = I.w_in_ab; ldw = ABW; K = D; nblk = 48; WT = (bf16*)(ws + WS_AB); }
        else if (r < 2560) { r -= 1536; W = I.w_out_ab; ldw = D; K = D; nblk = 32; WT = (bf16*)(ws + WS_OAB); }
        else if (r < 6656) { r -= 2560; W = I.w_in_c; ldw = CW; K = D; nblk = 128; WT = (bf16*)(ws + WS_C); }
        else if (r < 7680) { r -= 6656; W = I.w_out_c; ldw = D; K = D; nblk = 32; WT = (bf16*)(ws + WS_OC); }
        else if (r < 13312) { r -= 7680; W = I.w_up; ldw = FF2; K = D; nblk = 176; WT = (bf16*)(ws + WS_UP0); }
        else if (r < 18944) { r -= 13312; W = I.w_up + (size_t)D * FF2; ldw = FF2; K = D; nblk = 176; WT = (bf16*)(ws + WS_UP1); }
        else if (r < 21760) { r -= 18944; W = I.w_down; ldw = D; K = FF; nblk = 32; WT = (bf16*)(ws + WS_DN0); }
        else { r -= 21760; W = I.w_down + (size_t)FF * D; ldw = D; K = FF; nblk = 32; WT = (bf16*)(ws + WS_DN1); }
        transpose_item64(W, ldw, K, nblk, WT, scr, r, lane, (it >= 7680 && it < 18944));
    }
}
__device__ __forceinline__ void prologue(const In& I, unsigned char* ws, LAS unsigned char* lds, int gw, int ngw, int wave, int lane) {
    transposes(I, ws, lds, 0, 1536, gw, ngw, wave, lane);
    const int gt = gw * 64 + lane, ngt = ngw * 64;
    { bf16* WG = (bf16*)(ws + WS_C) + (size_t)8192 * D;
      for (int idx = gt; idx < 32 * D; idx += ngt) { const int j = idx >> 11, k = idx & 2047; WG[idx] = (bf16)f2bf(I.w_in_c[(size_t)k * CW + 8192 + j]); } }
    { bf16* BD = (bf16*)(ws + WS_BD);
      for (int idx = gt; idx < 512 * 512; idx += ngt) { const int n = idx >> 9, k = idx & 511, gn = n >> 7, gk = k >> 7;
          const float v = (gn == gk) ? I.pool_w[(size_t)(gn * 128 + (k & 127)) * 128 + (n & 127)] * I.pool_scale[n] : 0.f; BD[idx] = (bf16)f2bf(v); } }
    rmsnorm_rows(I.x, I.norm_mix, (bf16*)(ws + WS_XN), gw, ngw, lane);
}

__device__ __forceinline__ void qk_rope_pool(bf16* __restrict__ PROJ, const float* __restrict__ qn, const float* __restrict__ kn, bf16* __restrict__ POOLED, int gw, int ngw, int lane) {
    const int l = lane & 31, hsel = lane >> 5, part = (l >> 4) & 1; const bool first = (l & 8) == 0;
    float inv[4];
#pragma unroll
    for (int e = 0; e < 4; ++e) inv[e] = exp2f(-(float)(4 * (l & 7) + e) * (13.287712379549449f / 32.0f));
    const f32x4 gq = *(const f32x4*)(qn + 4 * l), gk = *(const f32x4*)(kn + 4 * l);
    for (int it = gw; it < M * 8; it += ngw) {
        const int t = it >> 3, hh = (it & 7) * 2 + hsel;
        bf16* p = PROJ + (size_t)t * ABW + 512 + hh * 128 + 4 * l;
        const u32x2 w = *(const u32x2*)p;
        float x[4] = {bflo(w.x), bfhi(w.x), bflo(w.y), bfhi(w.y)};
        float ss = (x[0] * x[0] + x[1] * x[1]) + (x[2] * x[2] + x[3] * x[3]);
#pragma unroll
        for (int o = 1; o < 32; o <<= 1) ss += __shfl_xor(ss, o);
        const float rstd = 1.0f / sqrtf(ss * (1.0f / 128.0f) + EPS);
        const f32x4 g = (hh < 12) ? gq : gk;
        const int pos = t & (SEQ - 1); const float pp = part ? (float)(pos & 63) : (float)(pos >> 6);
        float y[4] = {x[0] * rstd * g.x, x[1] * rstd * g.y, x[2] * rstd * g.z, x[3] * rstd * g.w}, o4[4];
#pragma unroll
        for (int e = 0; e < 4; ++e) { const float yp = __shfl_xor(y[e], 8); const float ang = pp * inv[e]; const float sn = __sinf(ang), cs = __cosf(ang);
            o4[e] = y[e] * cs + (first ? -yp : yp) * sn; }
        u32x2 ow; ow.x = pk2(o4[0], o4[1]); ow.y = pk2(o4[2], o4[3]); *(u32x2*)p = ow;
    }
    const int gt = gw * 64 + lane, ngt = ngw * 64;
    for (int it = gt; it < M * 64; it += ngt) {
        const int t = it >> 6, c8 = (it & 63) * 8, g = c8 >> 7, w2 = 1 << g, pos = t & (SEQ - 1), base = t - pos;
        const int lo = max(pos - w2, 0), hi = min(pos + w2, SEQ);
        float acc[8] = {0.f, 0.f, 0.f, 0.f, 0.f, 0.f, 0.f, 0.f};
        for (int pz = lo; pz < hi; ++pz) { const u32x4 v = *(const u32x4*)(PROJ + (size_t)(base + pz) * ABW + c8);
            acc[0] += bflo(v.x); acc[1] += bfhi(v.x); acc[2] += bflo(v.y); acc[3] += bfhi(v.y); acc[4] += bflo(v.z); acc[5] += bfhi(v.z); acc[6] += bflo(v.w); acc[7] += bfhi(v.w); }
        const u32x4 sv = *(const u32x4*)(PROJ + (size_t)t * ABW + c8); const float iv = 1.0f / (float)(hi - lo);
        u32x4 o; o.x = pk2(acc[0] * iv - bflo(sv.x), acc[1] * iv - bfhi(sv.x)); o.y = pk2(acc[2] * iv - bflo(sv.y), acc[3] * iv - bfhi(sv.y));
        o.z = pk2(acc[4] * iv - bflo(sv.z), acc[5] * iv - bfhi(sv.z)); o.w = pk2(acc[6] * iv - bflo(sv.w), acc[7] * iv - bfhi(sv.w));
        *(u32x4*)(POOLED + (size_t)t * 512 + c8) = o;
    }
}

__device__ __forceinline__ void conv_fix(const bf16* __restrict__ HALO, const float* __restrict__ cw, const float* __restrict__ cb, bf16* __restrict__ ACT, int gt, int ngt) {
    for (int it = gt; it < 256 * 704; it += ngt) {
        const int jc = it % 704, re = it / 704, blk = re >> 1, last = re & 1, j = jc * 8;
        const int t = blk * 64 + (last ? 63 : 0), pos = t & (SEQ - 1);
        const bf16* rc = HALO + ((size_t)blk * 4 + (last ? 3 : 0)) * FF2 + j;
        const bf16* ru = last ? rc - FF2 : HALO + ((size_t)(blk - 1) * 4 + 3) * FF2 + j;
        const bf16* rd = last ? HALO + ((size_t)(blk + 1) * 4) * FF2 + j : rc + FF2;
        const u32x4 z = {0u, 0u, 0u, 0u};
        const u32x4 g1 = *(const u32x4*)rc, v1 = *(const u32x4*)(rc + FF);
        const u32x4 g0 = pos > 0 ? *(const u32x4*)ru : z, v0 = pos > 0 ? *(const u32x4*)(ru + FF) : z;
        const u32x4 g2 = pos < SEQ - 1 ? *(const u32x4*)rd : z, v2 = pos < SEQ - 1 ? *(const u32x4*)(rd + FF) : z;
        float o[8];
#pragma unroll
        for (int q = 0; q < 4; ++q) {
            const int ja = j + 2 * q, jb = ja + 1;
            const float ga = cw[ja] * bflo(g0[q]) + cw[FF2 + ja] * bflo(g1[q]) + cw[2 * FF2 + ja] * bflo(g2[q]) + cb[ja];
            const float gb = cw[jb] * bfhi(g0[q]) + cw[FF2 + jb] * bfhi(g1[q]) + cw[2 * FF2 + jb] * bfhi(g2[q]) + cb[jb];
            const float va = cw[FF + ja] * bflo(v0[q]) + cw[FF2 + FF + ja] * bflo(v1[q]) + cw[2 * FF2 + FF + ja] * bflo(v2[q]) + cb[FF + ja];
            const float vb = cw[FF + jb] * bfhi(v0[q]) + cw[FF2 + FF + jb] * bfhi(v1[q]) + cw[2 * FF2 + FF + jb] * bfhi(v2[q]) + cb[FF + jb];
            o[2 * q] = ga / (1.0f + __expf(-ga)) * va; o[2 * q + 1] = gb / (1.0f + __expf(-gb)) * vb;
        }
        u32x4 ow; ow.x = pk2(o[0], o[1]); ow.y = pk2(o[2], o[3]); ow.z = pk2(o[4], o[5]); ow.w = pk2(o[6], o[7]);
        *(u32x4*)(ACT + (size_t)t * FF + j) = ow;
    }
}

__device__ __forceinline__ void gates_phase(const bf16* __restrict__ XN, const bf16* __restrict__ WG, const float* __restrict__ bg, float* __restrict__ GATES, LAS float* red, int bid, int nblk) {
    const int tid = mk_tid(), wid = tid >> 6, lane = tid & 63, fr = lane & 15, fq = lane >> 4;
    const int tile = wid & 3, tt = tile & 1, jt = tile >> 1, kh = wid >> 2;
    for (int grp = bid; grp < 256; grp += nblk) {
        f32x4 acc = {0.f, 0.f, 0.f, 0.f};
        const bf16* ap = WG + (size_t)(jt * 16 + fr) * D + kh * 1024 + fq * 8;
        const bf16* bp = XN + (size_t)(grp * 32 + tt * 16 + fr) * D + kh * 1024 + fq * 8;
#pragma unroll 8
        for (int ks = 0; ks < 32; ++ks) { const bf16x8 a = *(const bf16x8*)(ap + ks * 32), b = *(const bf16x8*)(bp + ks * 32); acc = __builtin_amdgcn_mfma_f32_16x16x32_bf16(a, b, acc, 0, 0, 0); }
        if (kh == 1) { LAS float* r = red + (tile * 64 + lane) * 4; r[0] = acc[0]; r[1] = acc[1]; r[2] = acc[2]; r[3] = acc[3]; }
        __syncthreads();
        if (kh == 0) { const LAS float* r = red + (tile * 64 + lane) * 4; const int t = grp * 32 + tt * 16 + fr, j = jt * 16 + 4 * fq;
            const f32x4 b4 = *(const f32x4*)(bg + j); f32x4 o; o.x = acc[0] + r[0] + b4.x; o.y = acc[1] + r[1] + b4.y; o.z = acc[2] + r[2] + b4.z; o.w = acc[3] + r[3] + b4.w;
            *(f32x4*)(GATES + (size_t)t * 32 + j) = o; }
        __syncthreads();
    }
}

__device__ __forceinline__ void headnorm_phase(const float* __restrict__ HF, const bf16* __restrict__ OG, const float* __restrict__ hn, bf16* __restrict__ Y, int gw, int ngw, int lane) {
    for (int it = gw; it < M * 8; it += ngw) {
        const int t = it >> 3, h = it & 7; const size_t off = (size_t)t * D + h * 256 + 4 * lane;
        const f32x4 a = *(const f32x4*)(HF + off), b = *(const f32x4*)(HF + (size_t)M * D + off); const f32x4 s = a + b;
        const float ss = wave_sum((s.x * s.x + s.y * s.y) + (s.z * s.z + s.w * s.w));
        const float rstd = 1.0f / sqrtf(ss * (1.0f / 256.0f) + EPS);
        const f32x4 g = *(const f32x4*)(hn + h * 256 + 4 * lane); const u32x2 ow = *(const u32x2*)(OG + off);
        const float o0 = bflo(ow.x), o1 = bfhi(ow.x), o2 = bflo(ow.y), o3 = bfhi(ow.y);
        u32x2 w; w.x = pk2(s.x * rstd * g.x / (1.0f + __expf(-o0)), s.y * rstd * g.y / (1.0f + __expf(-o1)));
        w.y = pk2(s.z * rstd * g.z / (1.0f + __expf(-o2)), s.w * rstd * g.w / (1.0f + __expf(-o3)));
        *(u32x2*)(Y + off) = w;
    }
}

namespace ml {
constexpr int LQ = 264, LS = 72;
constexpr int OFF_Q = 0, OFF_K = 33792, OFF_KT = 67584, OFF_VT = 104448, OFF_VTW = 111360, OFF_P = 118272, OFF_CT = 127488, OFF_SC = 152832;
static_assert(OFF_SC + 1280 + 1024 == LDS_ML, "mlstm lds map");
#define ML_BAR() do { asm volatile("s_waitcnt lgkmcnt(0)" ::: "memory"); __builtin_amdgcn_s_barrier(); asm volatile("" ::: "memory"); } while (0)
#define ML_MFMA(a, b, c) __builtin_amdgcn_mfma_f32_16x16x32_bf16(a, b, c, 0, 0, 0)

__device__ __forceinline__ void mlstm_phase(LAS unsigned char* lds, const bf16* __restrict__ QK, const bf16* __restrict__ KVT, const float* __restrict__ GATES, float* __restrict__ HF, int bid, int nblk) {
    const int tid = mk_tid(), wid = tid >> 6, lane = tid & 63, fr = lane & 15, fq = lane >> 4;
    LAS bf16* Qs = (LAS bf16*)(lds + OFF_Q); LAS bf16* Ks = (LAS bf16*)(lds + OFF_K); LAS bf16* KTs = (LAS bf16*)(lds + OFF_KT);
    LAS bf16* VTs = (LAS bf16*)(lds + OFF_VT); LAS bf16* VTw = (LAS bf16*)(lds + OFF_VTW); LAS bf16* Ps = (LAS bf16*)(lds + OFF_P); LAS bf16* CTs = (LAS bf16*)(lds + OFF_CT);
    LAS float* sA = (LAS float*)(lds + OFF_SC); LAS float* sM = sA + 64; LAS float* sAI = sM + 64; LAS float* sEM = sAI + 64; LAS float* sWS = (LAS float*)(lds + OFF_SC + 1280);
    const int tt = wid & 3, sh = wid >> 2;
    for (int it0 = bid; it0 < 256; it0 += nblk) {
        const int item = (nblk == 256) ? (((it0 & 7) * 4 + (it0 >> 6)) * 8 + ((it0 >> 3) & 7)) : it0;
        const int es = item & 7, dir = (item >> 3) & 1, h = (item >> 4) & 7, b = (item >> 7) & 1;
        for (int i = tid; i < 48 * LQ / 2; i += 512) ((LAS unsigned*)CTs)[i] = 0u;
        for (int i = tid; i < 16 * LS; i += 512) { VTs[32 * LS + i] = (i < LS) ? (bf16)0x3F80 : (bf16)0; VTw[32 * LS + i] = (bf16)0; }
        f32x4 ct[2][3];
#pragma unroll
        for (int a = 0; a < 2; ++a)
#pragma unroll
            for (int e = 0; e < 3; ++e) ct[a][e] = (f32x4){0.f, 0.f, 0.f, 0.f};
        float m_st = 0.f, decay = 1.f;
        bf16x8 rq[4], rk[4], rkt[4], rvt = {0, 0, 0, 0, 0, 0, 0, 0}; float gi = 0.f, gf = 0.f;
        const unsigned voffQ = (unsigned)(((tid >> 5) * 4096 + (tid & 31) * 8) * 2), voffT = (unsigned)(((tid >> 3) * M + (tid & 7) * 8) * 2), voffG = (unsigned)((dir ? 63 - lane : lane) * 128);
#define ML_LOAD(c) do { const int ncn_ = dir ? 63 - (c) : (c); const size_t trow_ = (size_t)b * SEQ + (size_t)ncn_ * 64; \
        const char* qb_ = (const char*)(QK + trow_ * 4096 + h * 256); \
        _Pragma("unroll") for (int i_ = 0; i_ < 4; ++i_) { rq[i_] = *(const bf16x8*)(qb_ + (size_t)i_ * 131072 + voffQ); rk[i_] = *(const bf16x8*)(qb_ + 4096 + (size_t)i_ * 131072 + voffQ); } \
        const char* tb_ = (const char*)(KVT + (size_t)(h * 256) * M + trow_); \
        _Pragma("unroll") for (int i_ = 0; i_ < 4; ++i_) rkt[i_] = *(const bf16x8*)(tb_ + (size_t)i_ * (64 * M * 2) + voffT); \
        if (tid < 256) rvt = *(const bf16x8*)((const char*)(KVT + (size_t)(2048 + h * 256 + es * 32) * M + trow_) + voffT); \
        { const float* gp_ = GATES + trow_ * 32 + dir * 16 + h; gi = *(const float*)((const char*)gp_ + voffG); gf = *(const float*)((const char*)gp_ + 32 + voffG); } } while (0)
#define ML_STORE() do { \
        const float lf_ = fminf(gf, 0.f) - log1pf(__expf(-fabsf(gf))); float bc_ = lf_; \
        _Pragma("unroll") for (int o_ = 1; o_ < 64; o_ <<= 1) { const float t_ = __shfl_up(bc_, o_); if (lane >= o_) bc_ += t_; } \
        const float a_ = gi - bc_; float cm_ = a_; \
        _Pragma("unroll") for (int o_ = 1; o_ < 64; o_ <<= 1) { const float t_ = __shfl_up(cm_, o_); if (lane >= o_) cm_ = fmaxf(cm_, t_); } \
        const float Mv_ = fmaxf(m_st, cm_), blast_ = __shfl(bc_, 63), cml_ = __shfl(cm_, 63), Mn_ = fmaxf(m_st, cml_); \
        const float ai_ = __expf(m_st - Mv_), em_ = __expf(-(bc_ + Mv_)), wsv_ = __expf(a_ - Mn_); decay = __expf(m_st - Mn_); m_st = blast_ + Mn_; \
        const int rr_ = dir ? 63 - lane : lane; \
        if (wid == 0) { sA[rr_] = a_; sM[rr_] = Mv_; sAI[rr_] = ai_; sEM[rr_] = em_; VTw[32 * LS + rr_] = (bf16)f2bf(wsv_); } \
        _Pragma("unroll") for (int i_ = 0; i_ < 4; ++i_) { const int q_ = tid + 512 * i_, r_ = q_ >> 5, cc_ = (q_ & 31) * 8; \
            *(LAS bf16x8*)(Qs + r_ * LQ + cc_) = rq[i_]; *(LAS bf16x8*)(Ks + r_ * LQ + cc_) = rk[i_]; } \
        _Pragma("unroll") for (int i_ = 0; i_ < 4; ++i_) { const int q_ = tid + 512 * i_, d_ = q_ >> 3, cc_ = (q_ & 7) * 8; *(LAS bf16x8*)(KTs + d_ * LS + cc_) = rkt[i_]; } \
        if (tid < 256) { const int e_ = tid >> 3, cc_ = (tid & 7) * 8; *(LAS bf16x8*)(VTs + e_ * LS + cc_) = rvt; \
            LAS float* wsp_ = sWS + wid * 64; wsp_[rr_] = wsv_; asm volatile("s_waitcnt lgkmcnt(0)" ::: "memory"); \
            const f32x4 wa_ = *(const LAS f32x4*)(wsp_ + cc_), wb_ = *(const LAS f32x4*)(wsp_ + cc_ + 4); const float wv_[8] = {wa_.x, wa_.y, wa_.z, wa_.w, wb_.x, wb_.y, wb_.z, wb_.w}; \
            const u32x4 rv_ = __builtin_bit_cast(u32x4, rvt); u32x4 o_; \
            o_.x = pk2(bflo(rv_.x) * wv_[0], bfhi(rv_.x) * wv_[1]); o_.y = pk2(bflo(rv_.y) * wv_[2], bfhi(rv_.y) * wv_[3]); \
            o_.z = pk2(bflo(rv_.z) * wv_[4], bfhi(rv_.z) * wv_[5]); o_.w = pk2(bflo(rv_.w) * wv_[6], bfhi(rv_.w) * wv_[7]); \
            *(LAS u32x4*)(VTw + e_ * LS + cc_) = o_; } } while (0)
        ML_LOAD(0);
        ML_BAR();
        ML_STORE();
        ML_BAR();
        ML_LOAD(1);
        for (int c = 0; c < 64; ++c) {
            const int ncn = dir ? 63 - c : c; const size_t trow = (size_t)b * SEQ + (size_t)ncn * 64;
            const float dec_c = decay;
            f32x4 s0 = {0.f, 0.f, 0.f, 0.f}, s1 = s0, n3 = s0, d3 = s0;
            {
                const LAS bf16* qp = Qs + (tt * 16 + fr) * LQ + fq * 8;
                const LAS bf16* kp0 = Ks + ((2 * sh) * 16 + fr) * LQ + fq * 8; const LAS bf16* kp1 = kp0 + 16 * LQ;
                const LAS bf16* cp0 = CTs + (sh * 16 + fr) * LQ + fq * 8; const LAS bf16* cp2 = CTs + (32 + fr) * LQ + fq * 8;
#pragma unroll
                for (int hf = 0; hf < 4; ++hf) {
                    bf16x8 qf[2], k0[2], k1[2], c0[2], c2[2];
#pragma unroll
                    for (int k4 = 0; k4 < 2; ++k4) { const int ko = (hf * 2 + k4) * 32;
                        qf[k4] = *(const LAS bf16x8*)(qp + ko); k0[k4] = *(const LAS bf16x8*)(kp0 + ko); k1[k4] = *(const LAS bf16x8*)(kp1 + ko);
                        c0[k4] = *(const LAS bf16x8*)(cp0 + ko); c2[k4] = *(const LAS bf16x8*)(cp2 + ko); }
                    __builtin_amdgcn_sched_barrier(0);
#pragma unroll
                    for (int k4 = 0; k4 < 2; ++k4) { s0 = ML_MFMA(k0[k4], qf[k4], s0); s1 = ML_MFMA(k1[k4], qf[k4], s1); n3 = ML_MFMA(c0[k4], qf[k4], n3); d3 = ML_MFMA(c2[k4], qf[k4], d3); }
                }
            }
            const int t = tt * 16 + fr; const float Mt = sM[t];
            {
                const int sb0 = (2 * sh) * 16 + 4 * fq, sb1 = sb0 + 16;
                const f32x4 a0 = *(const LAS f32x4*)(sA + sb0), a1 = *(const LAS f32x4*)(sA + sb1);
                float p0[4], p1[4];
#pragma unroll
                for (int r = 0; r < 4; ++r) {
                    const int sa = sb0 + r, sbb = sb1 + r;
                    const bool ok0 = dir ? (sa >= t) : (sa <= t), ok1 = dir ? (sbb >= t) : (sbb <= t);
                    p0[r] = ok0 ? s0[r] * __expf(a0[r] - Mt) : 0.f; p1[r] = ok1 ? s1[r] * __expf(a1[r] - Mt) : 0.f;
                }
                u32x2 w0, w1; w0.x = pk2(p0[0], p0[1]); w0.y = pk2(p0[2], p0[3]); w1.x = pk2(p1[0], p1[1]); w1.y = pk2(p1[2], p1[3]);
                *(LAS u32x2*)(Ps + t * LS + sb0) = w0; *(LAS u32x2*)(Ps + t * LS + sb1) = w1;
            }
            ML_BAR();
            f32x4 n2 = {0.f, 0.f, 0.f, 0.f}, d2 = n2;
            {
                bf16x8 pf[2], v0[2], v2[2];
#pragma unroll
                for (int ks = 0; ks < 2; ++ks) { const int ko = ks * 32 + fq * 8;
                    pf[ks] = *(const LAS bf16x8*)(Ps + (tt * 16 + fr) * LS + ko); v0[ks] = *(const LAS bf16x8*)(VTs + (sh * 16 + fr) * LS + ko); v2[ks] = *(const LAS bf16x8*)(VTs + (32 + fr) * LS + ko); }
                __builtin_amdgcn_sched_barrier(0);
#pragma unroll
                for (int ks = 0; ks < 2; ++ks) { n2 = ML_MFMA(v0[ks], pf[ks], n2); d2 = ML_MFMA(v2[ks], pf[ks], d2); }
            }
            {
                const float ai = sAI[t], em = sEM[t];
                const float den0 = d2[0] + ai * d3[0];
                const float den = __shfl(den0, fr);
                const float rinv = 1.0f / fmaxf(fabsf(den), em);
                f32x4 hout; hout.x = (n2[0] + ai * n3[0]) * rinv; hout.y = (n2[1] + ai * n3[1]) * rinv; hout.z = (n2[2] + ai * n3[2]) * rinv; hout.w = (n2[3] + ai * n3[3]) * rinv;
                *(f32x4*)(HF + ((size_t)dir * M + trow + t) * D + h * 256 + es * 32 + sh * 16 + 4 * fq) = hout;
            }
#pragma unroll
            for (int a = 0; a < 2; ++a)
#pragma unroll
                for (int e = 0; e < 3; ++e) ct[a][e] = ct[a][e] * dec_c;
#pragma unroll
            for (int ks = 0; ks < 2; ++ks) { const int ko = ks * 32 + fq * 8; bf16x8 kt[2], vw[3];
#pragma unroll
                for (int a = 0; a < 2; ++a) kt[a] = *(const LAS bf16x8*)(KTs + ((2 * wid + a) * 16 + fr) * LS + ko);
#pragma unroll
                for (int e = 0; e < 3; ++e) vw[e] = *(const LAS bf16x8*)(VTw + (e * 16 + fr) * LS + ko);
                __builtin_amdgcn_sched_barrier(0);
#pragma unroll
                for (int a = 0; a < 2; ++a)
#pragma unroll
                    for (int e = 0; e < 3; ++e) ct[a][e] = ML_MFMA(kt[a], vw[e], ct[a][e]);
            }
#pragma unroll
            for (int a = 0; a < 2; ++a)
#pragma unroll
                for (int e = 0; e < 3; ++e) { u32x2 w; w.x = f2bf(ct[a][e][0]) | (f2bf(ct[a][e][1]) << 16); w.y = f2bf(ct[a][e][2]) | (f2bf(ct[a][e][3]) << 16);
                    *(LAS u32x2*)(CTs + (e * 16 + fr) * LQ + (2 * wid + a) * 16 + 4 * fq) = w; }
            ML_BAR();
            if (c + 1 < 64) { ML_STORE(); }
            ML_BAR();
            if (c + 2 < 64) { ML_LOAD(c + 2); }
        }
#undef ML_LOAD
#undef ML_STORE
    }
}
}
}

struct EpiRes {
    static constexpr bool PERM = false, AFTER_DRAIN = false;
    const float* base; float* out; int ldc;
    __device__ __forceinline__ void operator()(const pg8::f32x4 (&acc)[2][2][4][2], const pg8::Unit& u, int wr, int wc, int fr, int fq) const {
#pragma unroll
        for (int ai = 0; ai < 2; ++ai)
#pragma unroll
            for (int m = 0; m < 4; ++m) { const size_t ro = (size_t)(u.pm * 256 + ai * 128 + wr * 64 + m * 16 + fr) * ldc + u.pn * 256 + wc * 32 + 4 * fq;
#pragma unroll
                for (int bj = 0; bj < 2; ++bj)
#pragma unroll
                    for (int n = 0; n < 2; ++n) { const size_t off = ro + bj * 128 + n * 16; const pg8::f32x4 bs = *(const pg8::f32x4*)(base + off); *(pg8::f32x4*)(out + off) = bs + acc[ai][bj][m][n]; } }
    }
};

#define ROR1(x) __int_as_float(__builtin_amdgcn_update_dpp(0, __float_as_int(x), 0x121, 0xF, 0xF, false))
#define ROL1(x) __int_as_float(__builtin_amdgcn_update_dpp(0, __float_as_int(x), 0x12F, 0xF, 0xF, false))
struct EpiConv {
    static constexpr bool PERM = true, AFTER_DRAIN = false;
    unsigned short* ACT; unsigned short* HALO; const float* cw; const float* cb;
    __device__ __forceinline__ void operator()(const pg8::f32x4 (&acc)[2][2][4][2], const pg8::Unit& u, int wr, int wc, int fr, int fq) const {
        using mk::FF; using mk::FF2;
        const int jb = u.pn * 128 + wc * 32 + 8 * fq;
        mk::u32x2 keep[2][4];
#pragma unroll
        for (int n = 0; n < 2; ++n) {
            const int j = jb + 4 * n;
            const pg8::f32x4 c0g = *(const pg8::f32x4*)(cw + j), c1g = *(const pg8::f32x4*)(cw + FF2 + j), c2g = *(const pg8::f32x4*)(cw + 2 * FF2 + j), cbg = *(const pg8::f32x4*)(cb + j);
            const pg8::f32x4 c0v = *(const pg8::f32x4*)(cw + FF + j), c1v = *(const pg8::f32x4*)(cw + FF2 + FF + j), c2v = *(const pg8::f32x4*)(cw + 2 * FF2 + FF + j), cbv = *(const pg8::f32x4*)(cb + FF + j);
#pragma unroll
            for (int ai = 0; ai < 2; ++ai)
#pragma unroll
                for (int m = 0; m < 4; ++m) {
                    const int row = u.pm * 256 + ai * 128 + wr * 64 + m * 16 + fr;
                    float o[4];
#pragma unroll
                    for (int i = 0; i < 4; ++i) {
                        const float g = acc[ai][0][m][n][i], v = acc[ai][1][m][n][i];
                        float gu = ROR1(g), gd = ROL1(g), vu = ROR1(v), vd = ROL1(v);
                        if (m > 0) { const float ga = ROR1(acc[ai][0][m - 1][n][i]), va = ROR1(acc[ai][1][m - 1][n][i]); if (fr == 0) { gu = ga; vu = va; } }
                        if (m < 3) { const float ga = ROL1(acc[ai][0][m + 1][n][i]), va = ROL1(acc[ai][1][m + 1][n][i]); if (fr == 15) { gd = ga; vd = va; } }
                        const float G = c0g[i] * gu + c1g[i] * g + c2g[i] * gd + cbg[i];
                        const float V = c0v[i] * vu + c1v[i] * v + c2v[i] * vd + cbv[i];
                        o[i] = G / (1.0f + __expf(-G)) * V;
                    }
                    const bool edge = (m == 0 && fr == 0) || (m == 3 && fr == 15);
                    { mk::u32x2 w; w.x = mk::pk2(o[0], o[1]); w.y = mk::pk2(o[2], o[3]);
                      if (n == 0) keep[ai][m] = w;
                      else if (!edge) { mk::u32x4 w4; w4.x = keep[ai][m].x; w4.y = keep[ai][m].y; w4.z = w.x; w4.w = w.y; *(mk::u32x4*)(ACT + (size_t)row * FF + jb) = w4; } }
                    if ((m == 0 && fr < 2) || (m == 3 && fr > 13)) {
                        const int hr = (m == 0) ? fr : fr - 12;
                        unsigned short* hp = HALO + ((size_t)(row >> 6) * 4 + hr) * FF2 + j;
                        mk::u32x2 wg, wv; wg.x = mk::f2bf(acc[ai][0][m][n][0]) | (mk::f2bf(acc[ai][0][m][n][1]) << 16); wg.y = mk::f2bf(acc[ai][0][m][n][2]) | (mk::f2bf(acc[ai][0][m][n][3]) << 16);
                        wv.x = mk::f2bf(acc[ai][1][m][n][0]) | (mk::f2bf(acc[ai][1][m][n][1]) << 16); wv.y = mk::f2bf(acc[ai][1][m][n][2]) | (mk::f2bf(acc[ai][1][m][n][3]) << 16);
                        *(mk::u32x2*)hp = wg; *(mk::u32x2*)(hp + FF) = wv;
                    }
                }
        }
    }
};

struct EpiBf16T {
    static constexpr bool PERM = true, AFTER_DRAIN = false;
    unsigned short* O; int ldc; int split_cols; float scale0; unsigned short* T; int tcol0; int ldt;
    __device__ __forceinline__ void operator()(const pg8::f32x4 (&acc)[2][2][4][2], const pg8::Unit& u, int wr, int wc, int fr, int fq) const {
        const int row0 = u.pm * 256 + wr * 64 + fr, colt = u.pn * 256, col0 = colt + wc * 32 + 8 * fq;
        const float sc = (colt < split_cols) ? scale0 : 1.f;
#pragma unroll
        for (int ai = 0; ai < 2; ++ai)
#pragma unroll
            for (int m = 0; m < 4; ++m) { unsigned short* rowp = O + (size_t)(row0 + ai * 128 + m * 16) * ldc + col0;
#pragma unroll
                for (int bj = 0; bj < 2; ++bj) { const pg8::f32x4 v0 = acc[ai][bj][m][0] * sc, v1 = acc[ai][bj][m][1] * sc;
                    mk::u32x4 w; w.x = mk::pk2(v0[0], v0[1]); w.y = mk::pk2(v0[2], v0[3]); w.z = mk::pk2(v1[0], v1[1]); w.w = mk::pk2(v1[2], v1[3]);
                    *(mk::u32x4*)(rowp + bj * 128) = w; } }
        if (colt >= tcol0) {
#pragma unroll
            for (int bj = 0; bj < 2; ++bj)
#pragma unroll
                for (int n = 0; n < 2; ++n)
#pragma unroll
                    for (int i = 0; i < 4; ++i) { unsigned short* tp = T + (size_t)(col0 - tcol0 + bj * 128 + 4 * n + i) * ldt + row0;
#pragma unroll
                        for (int ai = 0; ai < 2; ++ai)
#pragma unroll
                            for (int m = 0; m < 4; ++m) tp[ai * 128 + m * 16] = (unsigned short)mk::f2bf(acc[ai][bj][m][n][i]); }
        }
    }
};

struct GemmDesc { const unsigned short* A; const unsigned short* Bt; int Mg, Ng, Kg; int kind; unsigned short* O; int ldc; int split_cols; float scale0; const float* base; float* out; int G, c; };

#ifndef REPEAT_PH
#define REPEAT_PH 1000
#define N_REPEAT 0
#else
#define N_REPEAT 1
#endif
struct Params { const float* in[17]; float* out; unsigned char* ws; int ph_lo, ph_hi; };
constexpr int N_PHASES = 18;

__global__ void __launch_bounds__(512, 2) fwd_mega(Params p) {
    extern __shared__ __attribute__((aligned(16))) unsigned char lds_raw[];
    using namespace mk;
    cg::grid_group grid = cg::this_grid();
    LAS unsigned char* lds = (LAS unsigned char*)lds_raw;
    const int bid = blockIdx.x, nblk = gridDim.x;
    const int ph_lo = p.ph_lo, ph_hi = p.ph_hi;
    { volatile LAS unsigned* misc = (volatile LAS unsigned*)(lds + LDS_MISC); if (mk_tid() < 16) misc[mk_tid()] = 0u; }
    __syncthreads();
    (void)xcd_barrier_post((unsigned*)(p.ws + WS_BAR), (volatile LAS unsigned*)(lds + LDS_MISC) + 8);
    grid.sync();
#ifdef PROBE_PH
    const unsigned long long t_start = __builtin_amdgcn_s_memrealtime();
#endif
#pragma unroll 1
    for (int ph_it = ph_lo; ph_it < ph_hi + N_REPEAT; ++ph_it) {
        const int ph = ph_it <= REPEAT_PH ? ph_it : ph_it - N_REPEAT;
        typedef const __attribute__((address_space(4))) Params* KP;
        KP kp = (KP)__builtin_amdgcn_kernarg_segment_ptr(); asm volatile("" : "+s"(kp));
        unsigned char* ws = kp->ws; float* OUT = kp->out; bf16* XN = (bf16*)(ws + WS_XN);
        In I; I.x = kp->in[0]; I.norm_mix = kp->in[1]; I.norm_ffn = kp->in[2]; I.w_in_ab = kp->in[3]; I.pool_w = kp->in[4]; I.pool_scale = kp->in[5]; I.q_norm = kp->in[6]; I.k_norm = kp->in[7];
        I.w_out_ab = kp->in[8]; I.w_in_c = kp->in[9]; I.b_gate = kp->in[10]; I.h_norm = kp->in[11]; I.w_out_c = kp->in[12]; I.w_up = kp->in[13]; I.conv_w = kp->in[14]; I.conv_b = kp->in[15]; I.w_down = kp->in[16];
        int nb_ = nblk; asm volatile("" : "+s"(nb_)); const int ngw = nb_ * NW, ngt = nb_ * 512;
        const int tid = mk_tid(), lane = tid & 63, wave = __builtin_amdgcn_readfirstlane(tid >> 6), gw = bid * NW + wave, gt = bid * 512 + tid;
#ifndef NO_THIN
        if (ph == 0) prologue(I, ws, lds, gw, ngw, wave, lane);
        if (ph == 5 || ph == 9 || ph == 14) rmsnorm_rows(OUT, ph == 5 ? I.norm_ffn : (ph == 9 ? I.norm_mix + D : I.norm_ffn + D), XN, gw, ngw, lane);
        if (ph == 2) qk_rope_pool((bf16*)(ws + WS_PROJ), I.q_norm, I.k_norm, (bf16*)(ws + WS_POOLED), gw, ngw, lane);
#endif
#ifndef NO_ATT
        if (ph == 3) {
            const bf16* PROJ = (const bf16*)(ws + WS_PROJ); bf16* CAT = (bf16*)(ws + WS_CAT);
            for (int u0 = bid; u0 < 384; u0 += nblk) {
                int u = u0;
                if (nblk == 256) { const int xcd = u0 & 7, j = (u0 >> 3) & 31, rnd = u0 >> 8; const int jj = j + 32 * rnd;
                    if (jj >= 48) continue; u = (xcd >> 2) * 192 + ((xcd & 3) * 3 + (jj >> 4)) * 16 + (jj & 15); }
                const int qb = u & 15, hq = (u >> 4) % 12, b = u / 192;
                const size_t r0 = (size_t)b * SEQ + (size_t)qb * 256;
                att::attn_dense_body<att::bf16>((const att::bf16*)(PROJ + r0 * ABW + 512 + hq * 128), (const att::bf16*)(PROJ + (size_t)b * SEQ * ABW + 2048 + (hq / 3) * 128),
                                                (const att::bf16*)(PROJ + (size_t)b * SEQ * ABW + 2560 + (hq / 3) * 128), CAT + r0 * D + 512 + hq * 128, SEQ, (char*)lds_raw);
                __syncthreads();
            }
        }
#endif
#ifndef NO_THIN
        if (ph == 7 || ph == 16) { const int l = ph == 7 ? 0 : 1; conv_fix((const bf16*)(ws + WS_U), I.conv_w + (size_t)l * 3 * FF2, I.conv_b + (size_t)l * FF2, (bf16*)(ws + WS_ACT), gt, ngt); }
        if (ph == 10) gates_phase(XN, (const bf16*)(ws + WS_C) + (size_t)8192 * D, I.b_gate, (float*)(ws + WS_GATES), (LAS float*)lds, bid, nblk);
#endif
#ifndef NO_ML
        if (ph == 11) ml::mlstm_phase(lds, (const bf16*)(ws + WS_QK), (const bf16*)(ws + WS_KVT), (const float*)(ws + WS_GATES), (float*)(ws + WS_HF), bid, nblk);
#endif
#ifndef NO_THIN
        if (ph == 12) headnorm_phase((const float*)(ws + WS_HF), (const bf16*)(ws + WS_OG), I.h_norm, (bf16*)(ws + WS_Y), gw, ngw, lane);
#endif
#pragma unroll 1
        for (int gi = 0; gi < 3; ++gi) {
            GemmDesc d; d.kind = -1; d.G = nblk; d.c = bid; d.split_cols = 0; d.scale0 = 1.f; d.base = nullptr; d.out = nullptr; d.O = nullptr; d.ldc = 0; d.A = nullptr; d.Bt = nullptr; d.Mg = M; d.Ng = 0; d.Kg = D;
            if (gi == 0) {
                if (ph == 1) { d.kind = 0; d.A = XN; d.Bt = (bf16*)(ws + WS_AB); d.Ng = ABW; d.O = (bf16*)(ws + WS_PROJ); d.ldc = ABW; }
                else if (ph == 3) { d.kind = 0; d.A = (bf16*)(ws + WS_POOLED); d.Bt = (bf16*)(ws + WS_BD); d.Ng = 512; d.Kg = 512; d.O = (bf16*)(ws + WS_CAT); d.ldc = D;
                    if (nblk == 256) { const int slot = bid >> 3; d.G = 64; d.c = (slot - 16) * 8 + (bid & 7); if (slot < 16 || slot >= 24) d.kind = -1; } }
                else if (ph == 4) { d.kind = 1; d.A = (bf16*)(ws + WS_CAT); d.Bt = (bf16*)(ws + WS_OAB); d.Ng = D; d.base = I.x; d.out = OUT; }
                else if (ph == 6 || ph == 15) { d.kind = 2; d.A = XN; d.Bt = (bf16*)(ws + (ph == 6 ? WS_UP0 : WS_UP1)); d.Ng = FF2; d.O = (bf16*)(ws + WS_U); d.ldc = FF2; d.base = I.conv_w + (size_t)(ph == 6 ? 0 : 1) * 3 * FF2; d.out = (float*)(I.conv_b + (size_t)(ph == 6 ? 0 : 1) * FF2); }
                else if (ph == 8 || ph == 17) { d.kind = 1; d.A = (bf16*)(ws + WS_ACT); d.Bt = (bf16*)(ws + (ph == 8 ? WS_DN0 : WS_DN1)); d.Ng = D; d.Kg = FF; d.base = OUT; d.out = OUT; }
                else if (ph == 10) { d.kind = 3; d.A = XN; d.Bt = (bf16*)(ws + WS_C); d.Ng = 4096; d.O = (bf16*)(ws + WS_QK); d.ldc = 4096; d.split_cols = 2048; d.scale0 = 0.0625f; }
                else if (ph == 13) { d.kind = 1; d.A = (bf16*)(ws + WS_Y); d.Bt = (bf16*)(ws + WS_OC); d.Ng = D; d.base = OUT; d.out = OUT; }
            } else if (ph == 10) {
                if (gi == 1) { d.kind = 0; d.A = XN; d.Bt = (bf16*)(ws + WS_C) + (size_t)6144 * D; d.Ng = D; d.O = (bf16*)(ws + WS_OG); d.ldc = D; }
                else { d.kind = 0; d.A = (bf16*)(ws + WS_C) + (size_t)4096 * D; d.Bt = XN; d.Mg = 2048; d.Ng = M; d.O = (bf16*)(ws + WS_KVT) + (size_t)2048 * M; d.ldc = M; }
            }
#ifndef NO_GEMM
            if (d.kind == 0) {
                pg8::Gemm g{d.A, d.Bt, d.Mg, d.Ng, d.Kg}; pg8::StaticOrder S; S.init(d.Mg, d.Ng, d.G, d.c);
                pg8::EpiBf16<0> E{d.O, d.ldc, nullptr, d.split_cols, (size_t)d.split_cols, d.scale0};
                pg8::gemm_phase<pg8::EpiBf16<0>, pg8::StaticOrder, true, true>(lds, g, S, E);
            } else if (d.kind == 3) {
                pg8::Gemm g{d.A, d.Bt, d.Mg, d.Ng, d.Kg}; pg8::StaticOrder S; S.init(d.Mg, d.Ng, d.G, d.c);
                EpiBf16T E{d.O, d.ldc, d.split_cols, d.scale0, (bf16*)(ws + WS_KVT), 2048, M};
                pg8::gemm_phase<EpiBf16T, pg8::StaticOrder, true, true>(lds, g, S, E);
            } else if (d.kind == 2) {
                pg8::Gemm g{d.A, d.Bt, d.Mg, d.Ng, d.Kg}; pg8::StaticOrder S; S.init(d.Mg, d.Ng, d.G, d.c);
                EpiConv E{(bf16*)(ws + WS_ACT), d.O, d.base, (const float*)d.out};
                pg8::gemm_phase<EpiConv, pg8::StaticOrder, true, true>(lds, g, S, E);
            } else if (d.kind == 1) {
                pg8::Gemm g{d.A, d.Bt, d.Mg, d.Ng, d.Kg}; pg8::StaticOrder S; S.init(d.Mg, d.Ng, d.G, d.c);
                EpiRes E{d.base, d.out, D};
                pg8::gemm_phase<EpiRes, pg8::StaticOrder, true, true>(lds, g, S, E);
            }
#endif
            __syncthreads();
        }
#ifndef NO_THIN
        if (nb_ == 256) {
            if (ph == 1 && bid >= 128) { const int w = (bid - 128) * NW + wave; transposes(I, ws, lds, 1536, 2560, w, 128 * NW, wave, lane); transposes(I, ws, lds, 18944, 24576, w, 128 * NW, wave, lane); }
            if (ph == 3 && (bid >> 3) >= 16) { const int w = (((bid >> 3) - 16) * 8 + (bid & 7)) * NW + wave; transposes(I, ws, lds, 2560, 18944, w, 128 * NW, wave, lane); }
        } else if (ph == 1) transposes(I, ws, lds, 1536, 24576, gw, ngw, wave, lane);
#endif
        if (ph_it + 1 < ph_hi + N_REPEAT) { XcdBarrier xbar; xbar.bar = (unsigned*)(ws + WS_BAR); xbar.x = xb_xcc_id(); xbar.st = (volatile LAS unsigned*)(lds + LDS_MISC) + 8; xcd_barrier(xbar);
#ifdef SYNC2
            xcd_barrier(xbar);
#endif
        }
#ifdef PROBE_PH
        if (bid == 0 && tid == 0) { unsigned long long* ts = (unsigned long long*)(ws + WS_BD + 768 * 1024); ts[ph + 1] = __builtin_amdgcn_s_memrealtime(); if (ph == 0) ts[0] = t_start;
            if (ph + 1 == ph_hi) { OUT[0] = (float)(ts[PROBE_PH + 1] - ts[PROBE_PH]) * 0.01f; } }
#endif
    }
}

#ifndef MK_MULTI
#define MK_MULTI 0
#endif
extern "C" void kernel_launch(void* const* d_in, const int* in_sizes, int n_in, void* d_out, int out_size, void* d_ws, size_t ws_size, hipStream_t stream) {
    static int grid = 0;
    if (grid == 0) {
        if (n_in != 17 || out_size != mk::M * mk::D || ws_size < mk::WS_END) { fprintf(stderr, "kernel_launch: unexpected shapes n_in %d out %d ws %zu (need %zu)\n", n_in, out_size, ws_size, (size_t)mk::WS_END); grid = -1; return; }
        int dev = 0, cus = 0, per_cu = 0;
        (void)hipGetDevice(&dev); (void)hipDeviceGetAttribute(&cus, hipDeviceAttributeMultiprocessorCount, dev);
        if (hipFuncSetAttribute((const void*)fwd_mega, hipFuncAttributeMaxDynamicSharedMemorySize, mk::LDS_BYTES) != hipSuccess) { fprintf(stderr, "kernel_launch: hipFuncSetAttribute failed\n"); grid = -1; return; }
        if (hipOccupancyMaxActiveBlocksPerMultiprocessor(&per_cu, (const void*)fwd_mega, 512, mk::LDS_BYTES) != hipSuccess || per_cu < 1) { fprintf(stderr, "kernel_launch: occupancy query gave %d\n", per_cu); per_cu = 1; }
        (void)hipGetLastError();
        if (cus <= 0) cus = 256;
        grid = cus * per_cu; if (grid > 256) grid = 256;
        fprintf(stderr, "kernel_launch: cus %d per_cu %d grid %d\n", cus, per_cu, grid);
    }
    if (grid < 0) return;
    if (hipMemsetAsync((char*)d_ws + mk::WS_BAR, 0, mk::BAR_BYTES, stream) != hipSuccess) { fprintf(stderr, "kernel_launch: memset failed\n"); return; }
    Params p{};
    for (int i = 0; i < 17; ++i) p.in[i] = (const float*)d_in[i];
    p.out = (float*)d_out; p.ws = (unsigned char*)d_ws;
#if MK_MULTI
    for (int ph = 0; ph < N_PHASES; ++ph) { p.ph_lo = ph; p.ph_hi = ph + 1; hipLaunchKernelGGL(fwd_mega, dim3(grid), dim3(512), mk::LDS_BYTES, stream, p); }
#else
    p.ph_lo = 0; p.ph_hi = N_PHASES;
    void* args[] = {&p};
    const hipError_t e = hipLaunchCooperativeKernel((const void*)fwd_mega, dim3(grid), dim3(512), args, mk::LDS_BYTES, stream);
    if (e != hipSuccess) fprintf(stderr, "kernel_launch: cooperative launch failed: %s (grid %d)\n", hipGetErrorString(e), grid);
#endif
}
```

```cpp
#include <hip/hip_runtime.h>
#include <hip/hip_cooperative_groups.h>
#include <hip/hip_bf16.h>
#include <cstdio>
#include <cstdint>
#include <cmath>
namespace cg = cooperative_groups;
__device__ __forceinline__ int mk_tid();
namespace pg8 {
#define PG8_LAS __attribute__((address_space(3)))
typedef unsigned short bf16_t;
typedef short bf16x8 __attribute__((ext_vector_type(8)));
typedef float f32x4 __attribute__((ext_vector_type(4)));
typedef unsigned u32x4 __attribute__((ext_vector_type(4)));
constexpr int BM = 256, BK = 64, HALF = 128, HTB = HALF * BK * 2  , STAGE_BYTES = 8 * HTB, NXCD = 8, WGM = 8;

__host__ __device__ __forceinline__ int lds_byte(int r, int c) { const int st = (r >> 4) * 2 + (c >> 5), rr = r & 15, cc = c & 31, ob = rr * 64 + cc * 2; return st * 1024 + (ob ^ (((ob >> 9) & 1) << 5)); }
__host__ __device__ __forceinline__ void stage_rc(int b, int& R, int& C) { const int st = b / 1024, sb = b % 1024, swz = sb ^ (((sb >> 9) & 1) << 5); R = (st >> 1) * 16 + swz / 64; C = (st & 1) * 32 + (swz % 64) / 2; }
__host__ __device__ __forceinline__ int perm32(int rho) { const int n = rho >> 4, i = rho & 15; return 8 * (i >> 2) + 4 * n + (i & 3); }

struct Unit { int pm, pn; };
struct Gemm { const bf16_t* A; const bf16_t* Bt; int M, N, K; };

struct StaticOrder {
    int nM, nN, nwg, G, c;
    __host__ __device__ void init(int M, int N, int G_, int c_) { nM = M / BM; nN = N / BM; nwg = nM * nN; G = G_; c = c_; }
    __host__ __device__ bool next(int i, Unit& u) const {
        const long L = (long)i * G + c; if (L >= nwg) return false;
        int wgid = (int)L; { const int q = nwg / NXCD, r = nwg % NXCD, xcd = wgid % NXCD, off = wgid / NXCD; wgid = (xcd < r ? xcd * (q + 1) : r * (q + 1) + (xcd - r) * q) + off; }
        const int nig = WGM * nN, gid = wgid / nig, fm = gid * WGM, gsz = (nM - fm) < WGM ? (nM - fm) : WGM;
        u.pm = fm + ((wgid % nig) % gsz); u.pn = (wgid % nig) / gsz; return true;
    }
    __device__ __forceinline__ void a_ready(const Unit&) const {}
    __device__ __forceinline__ void done(const Unit&) const {}
};

__device__ __forceinline__ unsigned cvt_pk_bf16(float lo, float hi) { unsigned r; asm volatile("v_cvt_pk_bf16_f32 %0, %1, %2" : "=v"(r) : "v"(lo), "v"(hi)); return r; }
typedef float f32x2 __attribute__((ext_vector_type(2)));
__device__ __forceinline__ f32x2 gelu_pk(f32x2 v) {
    const f32x2 av = __builtin_elementwise_abs(v), d = av * 0.2316418882f + 1.0f;
    f32x2 t; t.x = __builtin_amdgcn_rcpf(d.x); t.y = __builtin_amdgcn_rcpf(d.y);
    f32x2 q = t * 0.5307027145f + (-0.7265760135f); q = q * t + 0.7107068705f; q = q * t + (-0.142248368f); q = q * t + 0.127414796f; q = q * t;
    const f32x2 s = (v * v) * (-0.72134752044f);
    f32x2 e; e.x = __builtin_amdgcn_exp2f(s.x); e.y = __builtin_amdgcn_exp2f(s.y);
    const f32x2 m = v * (q * e), r = v - m;
    f32x2 o; o.x = v.x < 0.f ? m.x : r.x; o.y = v.y < 0.f ? m.y : r.y; return o;
}

template <int ACT  > struct EpiBf16 {
    static constexpr bool PERM = true, AFTER_DRAIN = false; static_assert(ACT == 0 || ACT == 1, "EpiBf16: ACT is 0 (none) or 1 (gelu_pk)");
    bf16_t* O; int ldc; const float* bias; int split_cols; size_t split_stride; float scale0;
    __device__ __forceinline__ void operator()(const f32x4 (&acc)[2][2][4][2], const Unit& u, int wr, int wc, int fr, int fq) const {
        const int row0 = u.pm * BM + wr * 64 + fr; int colt = u.pn * BM; bf16_t* base = O;
        float sc = 1.f; if (split_cols) { const int t = colt / split_cols; base += (size_t)t * split_stride; colt -= t * split_cols; if (t == 0) sc = scale0; }
        const int col0 = colt + wc * 32 + 8 * fq, bcol0 = u.pn * BM + wc * 32 + 8 * fq;
        f32x4 bv[2][2];
#pragma unroll
        for (int bj = 0; bj < 2; ++bj)
#pragma unroll
            for (int n = 0; n < 2; ++n) bv[bj][n] = bias ? *(const f32x4*)(bias + bcol0 + bj * HALF + 4 * n) : (f32x4){0.f, 0.f, 0.f, 0.f};
#pragma unroll
        for (int ai = 0; ai < 2; ++ai)
#pragma unroll
            for (int m = 0; m < 4; ++m) { bf16_t* rowp = base + (size_t)(row0 + ai * HALF + m * 16) * ldc + col0;
#pragma unroll
                for (int bj = 0; bj < 2; ++bj) { f32x4 v0 = acc[ai][bj][m][0] + bv[bj][0], v1 = acc[ai][bj][m][1] + bv[bj][1];
                    if (ACT == 1) { f32x2 a = gelu_pk((f32x2){v0[0], v0[1]}), b = gelu_pk((f32x2){v0[2], v0[3]}), c = gelu_pk((f32x2){v1[0], v1[1]}), d = gelu_pk((f32x2){v1[2], v1[3]});
                        v0 = (f32x4){a.x, a.y, b.x, b.y}; v1 = (f32x4){c.x, c.y, d.x, d.y}; }
                    v0 = v0 * sc; v1 = v1 * sc; u32x4 w; w.x = cvt_pk_bf16(v0[0], v0[1]); w.y = cvt_pk_bf16(v0[2], v0[3]); w.z = cvt_pk_bf16(v1[0], v1[1]); w.w = cvt_pk_bf16(v1[2], v1[3]);
                    *(u32x4*)(rowp + bj * HALF) = w; } }
    }
};

template <class Epi, class Sched, bool ALIGN_EPI = false, bool SP2 = false>
__device__ __forceinline__ void gemm_phase(PG8_LAS unsigned char* lds, const Gemm g, const Sched& S, const Epi& E) {
    const int tid = mk_tid(), wid = __builtin_amdgcn_readfirstlane(tid >> 6), lane = tid & 63, wr = wid >> 2, wc = wid & 3, fr = lane & 15, fq = lane >> 4;
    const int K = g.K, nt = K / BK;
    unsigned voffA[2], voffB[2];
#pragma unroll
    for (int i = 0; i < 2; ++i) { int R, C; stage_rc(tid * 16 + i * 8192, R, C); const int Rb = Epi::PERM ? ((R & ~31) + perm32(R & 31)) : R;
        voffA[i] = (unsigned)(R * K + C) * 2u; voffB[i] = (unsigned)(Rb * K + C) * 2u; }
    const size_t kstep = (size_t)(BK * 2);
    const size_t hstep = (size_t)HALF * K * 2;
    const size_t tstep = 2 * hstep;
    const unsigned ldsw = (unsigned)wid * 1024u;
    const int aoff = lds_byte(wr * 64 + fr, fq * 8), boff = lds_byte(wc * 32 + fr, fq * 8);
#define PG8_SA(b, h) (((b) * 2 + (h)) * HTB)
#define PG8_SB(b, h) ((4 + (b) * 2 + (h)) * HTB)
#define PG8_STAGE(bufoff, gbase, voff) do { _Pragma("unroll") for (int _i = 0; _i < 2; ++_i) \
        __builtin_amdgcn_global_load_lds((const unsigned*)((const char*)(gbase) + (voff)[_i]), (PG8_LAS unsigned*)(lds + (bufoff) + ldsw + _i * 8192), 16, 0, 0); } while (0)
#define PG8_LDA(dst, b, h) do { _Pragma("unroll") for (int m = 0; m < 4; ++m) _Pragma("unroll") for (int k = 0; k < 2; ++k) dst[m][k] = *(const PG8_LAS bf16x8*)(lds + PG8_SA(b, h) + aoff + m * 2048 + k * 1024); } while (0)
#define PG8_LDB(dst, b, h) do { _Pragma("unroll") for (int n = 0; n < 2; ++n) _Pragma("unroll") for (int k = 0; k < 2; ++k) dst[n][k] = *(const PG8_LAS bf16x8*)(lds + PG8_SB(b, h) + boff + n * 2048 + k * 1024); } while (0)
#define PG8_MMA(ai, bj, At, Bt) do { __builtin_amdgcn_s_setprio(1); _Pragma("unroll") for (int m = 0; m < 4; ++m) _Pragma("unroll") for (int n = 0; n < 2; ++n) _Pragma("unroll") for (int k = 0; k < 2; ++k) \
        acc[ai][bj][m][n] = __builtin_amdgcn_mfma_f32_16x16x32_bf16(Bt[n][k], At[m][k], acc[ai][bj][m][n], 0, 0, 0); __builtin_amdgcn_s_setprio(0); } while (0)
#define PG8_WAIT_V(n) asm volatile("s_waitcnt vmcnt(" #n ")" ::: "memory")
#define PG8_WAIT_L(n) asm volatile("s_waitcnt lgkmcnt(" #n ")" ::: "memory")
#define PG8_BAR __builtin_amdgcn_s_barrier()
#define PG8_SCHED __builtin_amdgcn_sched_barrier(0)
    Unit cur, nxt; int ui = 0;
    if (!S.next(0, cur)) return;
    f32x4 acc[2][2][4][2];
#pragma unroll
    for (int a = 0; a < 2; ++a)
#pragma unroll
        for (int b = 0; b < 2; ++b)
#pragma unroll
            for (int m = 0; m < 4; ++m)
#pragma unroll
                for (int n = 0; n < 2; ++n) acc[a][b][m][n] = (f32x4){0.f, 0.f, 0.f, 0.f};
    bf16x8 At[4][2], B0[2][2], B1[2][2];
    const char* cA = (const char*)g.A + (size_t)cur.pm * tstep; const char* cB = (const char*)g.Bt + (size_t)cur.pn * tstep;
    S.a_ready(cur);
    if constexpr (SP2) {
        PG8_STAGE(PG8_SB(0, 0), cB, voffB); PG8_STAGE(PG8_SB(0, 1), cB + hstep, voffB); PG8_STAGE(PG8_SA(0, 0), cA, voffA); PG8_STAGE(PG8_SA(0, 1), cA + hstep, voffA);
        if (wr == 1) PG8_BAR;
        PG8_WAIT_V(2); PG8_BAR;
        PG8_STAGE(PG8_SB(1, 0), cB + kstep, voffB); PG8_STAGE(PG8_SA(1, 0), cA + kstep, voffA); PG8_STAGE(PG8_SB(1, 1), cB + hstep + kstep, voffB);
        PG8_WAIT_V(6); PG8_BAR;
    } else {
        PG8_STAGE(PG8_SB(0, 0), cB, voffB); PG8_STAGE(PG8_SA(0, 0), cA, voffA); PG8_STAGE(PG8_SB(0, 1), cB + hstep, voffB); PG8_STAGE(PG8_SA(0, 1), cA + hstep, voffA);
        if (wr == 1) PG8_BAR;
        PG8_WAIT_V(4); PG8_BAR;
        PG8_STAGE(PG8_SB(1, 0), cB + kstep, voffB); PG8_STAGE(PG8_SA(1, 0), cA + kstep, voffA); PG8_STAGE(PG8_SB(1, 1), cB + hstep + kstep, voffB);
        PG8_WAIT_V(6); PG8_BAR;
    }
    for (;;) {
        const bool has_next = S.next(ui + 1, nxt);
        const char* nA = has_next ? (const char*)g.A + (size_t)nxt.pm * tstep : cA; const char* nB = has_next ? (const char*)g.Bt + (size_t)nxt.pn * tstep : cB;
        for (int t = 0; t < nt; t += 2) {
            const bool last = (t == nt - 2);
            const char* a1 = cA + (size_t)(t + 1) * kstep;
            const char* a2 = last ? nA : cA + (size_t)(t + 2) * kstep; const char* b2 = last ? nB : cB + (size_t)(t + 2) * kstep;
            const char* a3 = a2 + kstep; const char* b3 = b2 + kstep;
            if (last && has_next) S.a_ready(nxt);
            if constexpr (SP2) {
            PG8_LDB(B0, 0, 0); PG8_LDB(B1, 0, 1); PG8_SCHED; PG8_LDA(At, 0, 0); PG8_STAGE(PG8_SA(1, 1), a1 + hstep, voffA);
            PG8_WAIT_V(8); PG8_WAIT_L(0); PG8_BAR; PG8_MMA(0, 0, At, B0); PG8_MMA(0, 1, At, B1); PG8_BAR; PG8_SCHED;
            PG8_LDA(At, 0, 1); PG8_STAGE(PG8_SB(0, 0), b2, voffB); PG8_STAGE(PG8_SB(0, 1), b2 + hstep, voffB); PG8_STAGE(PG8_SA(0, 0), a2, voffA);
            PG8_WAIT_V(8); PG8_WAIT_L(0); PG8_BAR; PG8_MMA(1, 0, At, B0); PG8_MMA(1, 1, At, B1); PG8_BAR; PG8_SCHED;
            PG8_LDB(B0, 1, 0); PG8_LDB(B1, 1, 1); PG8_SCHED; PG8_LDA(At, 1, 0); PG8_STAGE(PG8_SA(0, 1), a2 + hstep, voffA);
            PG8_WAIT_V(8); PG8_WAIT_L(0); PG8_BAR; PG8_MMA(0, 0, At, B0); PG8_MMA(0, 1, At, B1); PG8_BAR; PG8_SCHED;
            PG8_LDA(At, 1, 1); PG8_STAGE(PG8_SB(1, 0), b3, voffB); PG8_STAGE(PG8_SB(1, 1), b3 + hstep, voffB); PG8_STAGE(PG8_SA(1, 0), a3, voffA);
            PG8_WAIT_V(8); PG8_WAIT_L(0); PG8_BAR; PG8_MMA(1, 0, At, B0); PG8_MMA(1, 1, At, B1); PG8_BAR; PG8_SCHED;
            } else {
            PG8_LDB(B0, 0, 0); PG8_SCHED; PG8_LDA(At, 0, 0); PG8_STAGE(PG8_SA(1, 1), a1 + hstep, voffA);
            PG8_WAIT_L(8); PG8_BAR; PG8_WAIT_L(0); PG8_MMA(0, 0, At, B0); PG8_BAR; PG8_SCHED;
            PG8_LDB(B1, 0, 1); PG8_STAGE(PG8_SB(0, 0), b2, voffB);
            PG8_BAR; PG8_WAIT_L(0); PG8_MMA(0, 1, At, B1); PG8_BAR;
            PG8_LDA(At, 0, 1); PG8_STAGE(PG8_SA(0, 0), a2, voffA);
            PG8_BAR; PG8_WAIT_L(0); PG8_MMA(1, 0, At, B0); PG8_BAR; PG8_SCHED;
            PG8_STAGE(PG8_SB(0, 1), b2 + hstep, voffB);
            PG8_WAIT_V(6); PG8_BAR; PG8_MMA(1, 1, At, B1); PG8_BAR;
            PG8_LDB(B0, 1, 0); PG8_SCHED; PG8_LDA(At, 1, 0); PG8_STAGE(PG8_SA(0, 1), a2 + hstep, voffA);
            PG8_WAIT_L(8); PG8_BAR; PG8_WAIT_L(0); PG8_MMA(0, 0, At, B0); PG8_BAR; PG8_SCHED;
            PG8_LDB(B1, 1, 1); PG8_STAGE(PG8_SB(1, 0), b3, voffB);
            PG8_BAR; PG8_WAIT_L(0); PG8_MMA(0, 1, At, B1); PG8_BAR;
            PG8_LDA(At, 1, 1); PG8_STAGE(PG8_SA(1, 0), a3, voffA);
            PG8_BAR; PG8_WAIT_L(0); PG8_MMA(1, 0, At, B0); PG8_BAR; PG8_SCHED;
            PG8_STAGE(PG8_SB(1, 1), b3 + hstep, voffB);
            PG8_WAIT_V(6); PG8_BAR; PG8_MMA(1, 1, At, B1); PG8_BAR;
            }
        }
        if constexpr (ALIGN_EPI) { if (wr == 0) PG8_BAR; }
        if constexpr (!Epi::AFTER_DRAIN) { E(acc, cur, wr, wc, fr, fq); S.done(cur); }
        if (!has_next) break;
#pragma unroll
        for (int a = 0; a < 2; ++a)
#pragma unroll
            for (int b = 0; b < 2; ++b)
#pragma unroll
                for (int m = 0; m < 4; ++m)
#pragma unroll
                    for (int n = 0; n < 2; ++n) acc[a][b][m][n] = (f32x4){0.f, 0.f, 0.f, 0.f};
        cur = nxt; cA = nA; cB = nB; ++ui;
        if constexpr (ALIGN_EPI) { if (wr == 1) PG8_BAR; }
    }
    PG8_WAIT_V(0);
    if constexpr (!ALIGN_EPI) { if (wr == 0) PG8_BAR; }
    PG8_BAR;
    if constexpr (Epi::AFTER_DRAIN) { E.fused(acc, cur, wr, wc, fr, fq, lds, wid, lane); S.done(cur); }
#undef PG8_SA
#undef PG8_SB
#undef PG8_STAGE
#undef PG8_LDA
#undef PG8_LDB
#undef PG8_MMA
#undef PG8_WAIT_V
#undef PG8_WAIT_L
#undef PG8_BAR
#undef PG8_SCHED
}
}

namespace att {
using bf16 = __hip_bfloat16;
constexpr int   D = 128, NW = 8, QBLK = 32, KVBLK = 64;
constexpr float SCALE = 0.088388347648318440f;
constexpr float THR = 8.f;
constexpr int SDEPTH = 2;
constexpr int LDQ = 3072, LDK = 3072, LDO = 2048;
constexpr size_t SHM_V = KVBLK * D * 2, SHM_K = KVBLK * D * 2, SHM_ATTN = 2 * SHM_V + 2 * SHM_K + NW * 64 * 4;
using bf16x8 = __attribute__((ext_vector_type(8))) short;
using s16x4  = __attribute__((ext_vector_type(4))) short;
using f32x16 = __attribute__((ext_vector_type(16))) float;
using f32x8  = __attribute__((ext_vector_type(8))) float;
using u32x4  = __attribute__((ext_vector_type(4))) unsigned;
#define KSWZ(row, colB) ((row) * 256 + ((colB) ^ (((row) & 7) << 4)))
#define SBAR() __builtin_amdgcn_sched_barrier(0)
__device__ __forceinline__ int crow(int r, int hi) { return (r & 3) + 8 * (r >> 2) + 4 * hi; }
__device__ __forceinline__ unsigned cvtpk(float lo, float hi) {
  unsigned r; asm volatile("v_cvt_pk_bf16_f32 %0, %1, %2" : "=v"(r) : "v"(lo), "v"(hi)); return r;
}
template <typename TIn> struct Stage;
template <> struct Stage<bf16>  { using T = bf16x8;
  __device__ static __forceinline__ T ld8(const bf16* p) { return *reinterpret_cast<const bf16x8*>(p); }
  __device__ static __forceinline__ bf16x8 tobf(T x) { return x; } };
template <> struct Stage<float> { using T = f32x8;
  __device__ static __forceinline__ T ld8(const float* p) { return *reinterpret_cast<const f32x8*>(p); }
  __device__ static __forceinline__ bf16x8 tobf(T x) {
    u32x4 w = {cvtpk(x[0], x[1]), cvtpk(x[2], x[3]), cvtpk(x[4], x[5]), cvtpk(x[6], x[7])}; return *reinterpret_cast<bf16x8*>(&w); } };

__device__ __forceinline__ void partialSM(f32x16& p0, f32x16& p1, float& m_reg, float& mn, float& alpha) {
  constexpr float C = SCALE * 1.4426950408889634f;
  float pmax = p0[0]; for (int r = 1; r < 16; ++r) pmax = fmaxf(pmax, p0[r]); for (int r = 0; r < 16; ++r) pmax = fmaxf(pmax, p1[r]);
  { auto rr = __builtin_amdgcn_permlane32_swap(__float_as_uint(pmax), __float_as_uint(pmax), false, false);
    pmax = fmaxf(__uint_as_float(rr[0]), __uint_as_float(rr[1])); }
  if (__builtin_expect(__all(pmax - m_reg <= THR / SCALE), 1)) { mn = m_reg; alpha = 1.f; }
  else { mn = fmaxf(m_reg, pmax); alpha = __builtin_amdgcn_exp2f((m_reg - mn) * C); m_reg = mn; }
  float mnC = -mn * C;
  for (int r = 0; r < 16; ++r) p0[r] = fmaf(p0[r], C, mnC); for (int r = 0; r < 16; ++r) p1[r] = fmaf(p1[r], C, mnC);
  for (int r = 0; r < 16; ++r) p0[r] = __builtin_amdgcn_exp2f(p0[r]);
}
__device__ __forceinline__ void finishSM(f32x16& p0, f32x16& p1, float alpha, float& l_reg, bf16x8& pa0, bf16x8& pa1, bf16x8& pa2, bf16x8& pa3) {
  for (int r = 0; r < 16; ++r) p1[r] = __builtin_amdgcn_exp2f(p1[r]);
  float ps = 0; for (int r = 0; r < 16; ++r) ps += p0[r]; for (int r = 0; r < 16; ++r) ps += p1[r];
  { auto rr = __builtin_amdgcn_permlane32_swap(__float_as_uint(ps), __float_as_uint(ps), false, false);
    ps = __uint_as_float(rr[0]) + __uint_as_float(rr[1]); }
  l_reg = l_reg * alpha + ps;
#define PK4(P, BASE, OUT) do { unsigned a0 = cvtpk(P[BASE + 0], P[BASE + 1]), a1 = cvtpk(P[BASE + 2], P[BASE + 3]);   \
    unsigned b0 = cvtpk(P[BASE + 4], P[BASE + 5]), b1 = cvtpk(P[BASE + 6], P[BASE + 7]);                              \
    auto r0 = __builtin_amdgcn_permlane32_swap(a0, b0, false, false); auto r1 = __builtin_amdgcn_permlane32_swap(a1, b1, false, false); \
    u32x4 w = {r0[0], r1[0], r0[1], r1[1]}; OUT = *reinterpret_cast<bf16x8*>(&w); } while (0)
  PK4(p0, 0, pa0); PK4(p0, 8, pa1); PK4(p1, 0, pa2); PK4(p1, 8, pa3);
#undef PK4
}
__device__ __forceinline__ void qkt(f32x16& p0, f32x16& p1, const bf16* Ks, const bf16x8* qr, int r32, int hi) {
  p0 = f32x16{}; p1 = f32x16{};
  for (int d0 = 0; d0 < 8; ++d0) { int cb = (d0 * 16 + hi * 8) * 2;
    bf16x8 b0 = *reinterpret_cast<const bf16x8*>((const char*)Ks + KSWZ(r32, cb));
    bf16x8 b1 = *reinterpret_cast<const bf16x8*>((const char*)Ks + KSWZ(32 + r32, cb));
    p0 = __builtin_amdgcn_mfma_f32_32x32x16_bf16(b0, qr[d0], p0, 0, 0, 0);
    p1 = __builtin_amdgcn_mfma_f32_32x32x16_bf16(b1, qr[d0], p1, 0, 0, 0); }
}
__device__ __forceinline__ int v_st(int k, int c) { const int kk = (k & ~0xC) | ((k & 4) << 1) | ((k & 8) >> 1); return ((kk >> 3) * 4 + (c >> 5)) * 512 + ((kk & 7) * 32 + (c & 31)) * 2; }
__device__ __forceinline__ int v_rd_base(int lane) { return ((lane & 3) << 3) | (((lane >> 2) & 3) << 6) | (((lane >> 4) & 1) << 5) | (((lane >> 5) & 1) << 8); }
constexpr int v_rd_off(int d0, int ks, int half) { return d0 * 512 + ks * 4096 + half * 2048; }
template <int OFF> __device__ __forceinline__ s16x4 tr_read(int vb) {
  s16x4 r; asm volatile("ds_read_b64_tr_b16 %0, %1 offset:%2" : "=&v"(r) : "v"(vb), "i"(OFF) : "memory"); return r;
}
template <int D0> __device__ __forceinline__ void pv_one(f32x16& od, int vb, bf16x8 pa0, bf16x8 pa1, bf16x8 pa2, bf16x8 pa3) {
  const s16x4 l0 = tr_read<v_rd_off(D0, 0, 0)>(vb), h0 = tr_read<v_rd_off(D0, 0, 1)>(vb), l1 = tr_read<v_rd_off(D0, 1, 0)>(vb), h1 = tr_read<v_rd_off(D0, 1, 1)>(vb);
  const s16x4 l2 = tr_read<v_rd_off(D0, 2, 0)>(vb), h2 = tr_read<v_rd_off(D0, 2, 1)>(vb), l3 = tr_read<v_rd_off(D0, 3, 0)>(vb), h3 = tr_read<v_rd_off(D0, 3, 1)>(vb);
  asm volatile("s_waitcnt lgkmcnt(0)" ::: "memory"); SBAR();
#define PK(L, H) (bf16x8){L[0], L[1], L[2], L[3], H[0], H[1], H[2], H[3]}
  od = __builtin_amdgcn_mfma_f32_32x32x16_bf16(pa0, PK(l0, h0), od, 0, 0, 0);
  od = __builtin_amdgcn_mfma_f32_32x32x16_bf16(pa1, PK(l1, h1), od, 0, 0, 0);
  od = __builtin_amdgcn_mfma_f32_32x32x16_bf16(pa2, PK(l2, h2), od, 0, 0, 0);
  od = __builtin_amdgcn_mfma_f32_32x32x16_bf16(pa3, PK(l3, h3), od, 0, 0, 0);
#undef PK
}
__device__ __forceinline__ void pv_d0(f32x16* o, int vb, bf16x8 pa0, bf16x8 pa1, bf16x8 pa2, bf16x8 pa3) {
  pv_one<0>(o[0], vb, pa0, pa1, pa2, pa3); pv_one<1>(o[1], vb, pa0, pa1, pa2, pa3); pv_one<2>(o[2], vb, pa0, pa1, pa2, pa3); pv_one<3>(o[3], vb, pa0, pa1, pa2, pa3);
}

template <typename TQ>
__device__ __forceinline__ void attn_dense_body(const TQ* __restrict__ Qb, const bf16* __restrict__ Kh, const bf16* __restrict__ Vh,
                                                unsigned short* __restrict__ Ob, int seq, char* lds) {
  using St = Stage<bf16>; using SQ = Stage<TQ>;
  const int tid = mk_tid(), wid = tid >> 6, lane = tid & 63, r32 = lane & 31, hi = lane >> 5;
  bf16* V_lds = (bf16*)lds; bf16* K_lds = (bf16*)(lds + 2 * SHM_V);
  float* ws = (float*)(lds + 2 * SHM_V + 2 * SHM_K) + wid * 64; float* li_l = ws; float* al_l = ws + 32;
  float m_reg = -1e30f, l_reg = 0; f32x16 o[4] = {}; bf16x8 qr[8];
  const TQ* Qw = Qb + (long)(wid * QBLK + r32) * LDQ + hi * 8;
#pragma unroll
  for (int d0 = 0; d0 < 8; ++d0) qr[d0] = SQ::tobf(SQ::ld8(Qw + d0 * 16));
  const int sr = tid >> 4, sc = (tid & 15) * 8, vst0 = v_st(sr, sc), vst1 = v_st(32 + sr, sc);
  const int vb0 = (int)(uintptr_t)V_lds + v_rd_base(lane);
  struct { typename St::T vs0, vs1, ks0, ks1; } sr_[SDEPTH];
#define SLOAD(i, k0) do { sr_[i].vs0 = St::ld8(&Vh[(long)((k0) + sr) * LDK + sc]); sr_[i].vs1 = St::ld8(&Vh[(long)((k0) + 32 + sr) * LDK + sc]); \
    sr_[i].ks0 = St::ld8(&Kh[(long)((k0) + sr) * LDK + sc]); sr_[i].ks1 = St::ld8(&Kh[(long)((k0) + 32 + sr) * LDK + sc]); } while (0)
#define SWRITE(b, i) do { *(bf16x8*)((char*)V_lds + (b) * SHM_V + vst0) = St::tobf(sr_[i].vs0);          \
    *(bf16x8*)((char*)V_lds + (b) * SHM_V + vst1) = St::tobf(sr_[i].vs1); int kc = sc * 2;               \
    *(bf16x8*)((char*)K_lds + (b) * SHM_K + KSWZ(sr, kc)) = St::tobf(sr_[i].ks0);                       \
    *(bf16x8*)((char*)K_lds + (b) * SHM_K + KSWZ(32 + sr, kc)) = St::tobf(sr_[i].ks1); } while (0)
#define SWAIT() do { if constexpr (SDEPTH == 2) asm volatile("s_waitcnt vmcnt(4)" ::: "memory"); else asm volatile("s_waitcnt vmcnt(0)" ::: "memory"); } while (0)
#define RESC(a) do { if (__any((a) < 1.f)) { if (hi == 0) al_l[r32] = (a); asm volatile("s_waitcnt lgkmcnt(0)" ::: "memory"); \
    for (int d = 0; d < 4; ++d) for (int r = 0; r < 16; ++r) o[d][r] *= al_l[crow(r, hi)]; } } while (0)
  f32x16 pA0, pA1, pB0, pB1; float mnA, mnB, alA, alB; bf16x8 pa0, pa1, pa2, pa3; const int NT = seq / KVBLK;
  constexpr int SE = 0, SO = SDEPTH - 1;
  SLOAD(SE, 0); asm volatile("s_waitcnt vmcnt(0)" ::: "memory"); SWRITE(0, SE); __syncthreads();
  qkt(pA0, pA1, K_lds, qr, r32, hi); partialSM(pA0, pA1, m_reg, mnA, alA);
  SLOAD(SO, KVBLK); if constexpr (SDEPTH == 2) { if (2 < NT) SLOAD(SE, 2 * KVBLK); }
  SWAIT(); SWRITE(1, SO); __syncthreads();
  for (int j = 1; j + 1 < NT; j += 2) {
    SBAR(); qkt(pB0, pB1, (bf16*)((char*)K_lds + SHM_K), qr, r32, hi);
    finishSM(pA0, pA1, alA, l_reg, pa0, pa1, pa2, pa3); SBAR();
    SLOAD(SO, (j + SDEPTH) * KVBLK); SBAR();
    pv_d0(o, vb0, pa0, pa1, pa2, pa3); partialSM(pB0, pB1, m_reg, mnB, alB);
    __syncthreads(); SWAIT(); SWRITE(0, SE);
    RESC(alB); __syncthreads();
    SBAR(); qkt(pA0, pA1, K_lds, qr, r32, hi);
    finishSM(pB0, pB1, alB, l_reg, pa0, pa1, pa2, pa3); SBAR();
    if (SDEPTH == 1 || j + 3 < NT) SLOAD(SE, (j + 1 + SDEPTH) * KVBLK); SBAR();
    pv_d0(o, vb0 + (int)SHM_V, pa0, pa1, pa2, pa3); partialSM(pA0, pA1, m_reg, mnA, alA);
    __syncthreads(); SWAIT(); SWRITE(1, SO);
    RESC(alA); __syncthreads();
  }
  SBAR(); qkt(pB0, pB1, (bf16*)((char*)K_lds + SHM_K), qr, r32, hi);
  finishSM(pA0, pA1, alA, l_reg, pa0, pa1, pa2, pa3); SBAR();
  pv_d0(o, vb0, pa0, pa1, pa2, pa3); partialSM(pB0, pB1, m_reg, mnB, alB);
  __syncthreads(); RESC(alB);
  finishSM(pB0, pB1, alB, l_reg, pa0, pa1, pa2, pa3); SBAR();
  pv_d0(o, vb0 + (int)SHM_V, pa0, pa1, pa2, pa3);
  if (hi == 0) li_l[r32] = l_reg; asm volatile("s_waitcnt lgkmcnt(0)" ::: "memory");
  float rli[16];
#pragma unroll
  for (int r = 0; r < 16; ++r) rli[r] = __builtin_amdgcn_rcpf(li_l[crow(r, hi)]);
  unsigned short* Ow = Ob + (long)(wid * QBLK) * LDO;
#pragma unroll
  for (int r = 0; r < 16; ++r) { int orow = crow(r, hi);
    for (int d0 = 0; d0 < 4; ++d0) Ow[(long)orow * LDO + d0 * 32 + r32] = (unsigned short)(cvtpk(o[d0][r] * rli[r], 0.f) & 0xffffu); }
#undef SLOAD
#undef SWRITE
#undef SWAIT
#undef RESC
}

}
__device__ __forceinline__ int mk_tid() { int t = threadIdx.x; asm volatile("" : "+v"(t)); return t; }
namespace mk {
#define LAS __attribute__((address_space(3)))
typedef unsigned short bf16;
typedef short bf16x8 __attribute__((ext_vector_type(8)));
typedef float f32x4 __attribute__((ext_vector_type(4)));
typedef unsigned u32x4 __attribute__((ext_vector_type(4)));
typedef unsigned u32x2 __attribute__((ext_vector_type(2)));
#define XB_TMO      128
#define XB_XCNT(j)  (256  + 64 * (j))
#define XB_XSUB(j)  (1280 + 64 * (j))
#define XB_XGEN(j)  (2304 + 64 * (j))
#define XB_TOP      3328
#define XB_TOPGEN   3392
#define XCD_BAR_WORDS 3456
#define XB_SPIN_CAP (1u << 18)

__device__ __forceinline__ unsigned xb_ld(unsigned* p)              { return __hip_atomic_load(p, __ATOMIC_RELAXED, __HIP_MEMORY_SCOPE_AGENT); }
__device__ __forceinline__ unsigned xb_add(unsigned* p, unsigned v) { return __hip_atomic_fetch_add(p, v, __ATOMIC_RELAXED, __HIP_MEMORY_SCOPE_AGENT); }
__device__ __forceinline__ unsigned xb_xcc_id() { return (unsigned)__builtin_amdgcn_s_getreg((3 << 11) | 20) & 0xFu; }
#define XB_SPIN(cond, bar) do { unsigned _sp = 0; while (cond) { __builtin_amdgcn_s_sleep(1); \
    if ((++_sp & 255u) == 0u) { if (xb_ld(&(bar)[XB_TMO])) break; if (_sp > XB_SPIN_CAP) { atomicAdd(&(bar)[XB_TMO], 1u); break; } } } } while (0)

struct XcdBarrier {
    unsigned* bar; unsigned x;
    volatile LAS unsigned* st;
};

__device__ __forceinline__ XcdBarrier xcd_barrier_post(unsigned* bar, volatile LAS unsigned* st) {
    XcdBarrier b; b.bar = bar; b.x = xb_xcc_id(); b.st = st;
    if (mk_tid() == 0) (void)xb_add(&bar[XB_XCNT(b.x)], 1u);
    return b;
}
__device__ __forceinline__ void xcd_barrier_complete(unsigned* bar, unsigned x, unsigned& nloc, unsigned& nx) {
    const unsigned G = gridDim.x * gridDim.y * gridDim.z;
    unsigned sum, cnt, mine, sp = 0u;
    for (;;) {
        sum = 0u; cnt = 0u; mine = 0u;
#pragma unroll
        for (unsigned j = 0; j < 16; ++j) { const unsigned c = xb_ld(&bar[XB_XCNT(j)]); sum += c; cnt += (c > 0u) ? 1u : 0u; mine = (j == x) ? c : mine; }
        if (sum == G) break;
        __builtin_amdgcn_s_sleep(1);
        if ((++sp & 255u) == 0u) { if (xb_ld(&bar[XB_TMO])) break; if (sp > XB_SPIN_CAP) { atomicAdd(&bar[XB_TMO], 1u); break; } }
    }
    nloc = mine > 0u ? mine : 1u; nx = cnt > 0u ? cnt : 1u;
}

__device__ __forceinline__ void xcd_barrier(const XcdBarrier& b) {
    asm volatile("s_waitcnt vmcnt(0)" ::: "memory");
    __syncthreads();
    if (mk_tid() == 0) {
        unsigned* bar = b.bar;
        __builtin_amdgcn_s_waitcnt(0);
        unsigned nloc = b.st[0], nx = b.st[1];
        if (nloc == 0u) { xcd_barrier_complete(bar, b.x, nloc, nx); b.st[0] = nloc; b.st[1] = nx; }
        const unsigned old = xb_add(&bar[XB_XSUB(b.x)], 1u);
        const unsigned gen = old / nloc;
        if (old + 1u == (gen + 1u) * nloc) {
            __builtin_amdgcn_fence(__ATOMIC_RELEASE, "agent");
            asm volatile("s_waitcnt vmcnt(0)" ::: "memory");
            const unsigned og = xb_add(&bar[XB_TOP], 1u);
            const unsigned tg = og / nx;
            if (og + 1u == (tg + 1u) * nx) xb_add(&bar[XB_TOPGEN], 1u);
            else XB_SPIN(xb_ld(&bar[XB_TOPGEN]) == tg, bar);
            __builtin_amdgcn_fence(__ATOMIC_ACQUIRE, "agent");
            xb_add(&bar[XB_XGEN(b.x)], 1u);
            asm volatile("s_waitcnt vmcnt(0)" ::: "memory");
        } else {
            XB_SPIN(xb_ld(&bar[XB_XGEN(b.x)]) == gen, bar);
            __builtin_amdgcn_fence(__ATOMIC_ACQUIRE, "agent");
            asm volatile("s_waitcnt vmcnt(0)" ::: "memory");
        }
    }
    __syncthreads();
}


constexpr int D = 2048, M = 8192, SEQ = 4096, NW = 8;
constexpr int ABW = 3072, CW = 8224, FF2 = 11264, FF = 5632;
constexpr float EPS = 1e-6f;
constexpr size_t MiB = 1u << 20;
constexpr size_t WS_AB = 0, WS_BD = 12 * MiB, WS_OAB = 13 * MiB, WS_C = 21 * MiB  , WS_OC = 54 * MiB;
constexpr size_t WS_UP0 = 62 * MiB, WS_UP1 = 106 * MiB, WS_DN0 = 150 * MiB, WS_DN1 = 172 * MiB;
constexpr size_t WS_XN = 194 * MiB, WS_GATES = 226 * MiB, WS_S = 228 * MiB;
constexpr size_t WS_PROJ = WS_S, WS_POOLED = WS_S + 48 * MiB, WS_CAT = WS_S + 56 * MiB;
constexpr size_t WS_QK = WS_S, WS_OG = WS_S + 64 * MiB, WS_KVT = WS_S + 96 * MiB, WS_HF = WS_S + 160 * MiB, WS_Y = WS_S + 288 * MiB;
constexpr size_t WS_U = WS_S, WS_ACT = WS_S + 176 * MiB;
constexpr size_t WS_END = WS_S + 320 * MiB;
constexpr int LDS_ML = 154112 + 1024, LDS_MISC = LDS_ML, LDS_BYTES = LDS_ML + 64;
constexpr size_t WS_BAR = WS_BD + 768 * 1024, BAR_BYTES = 16384;

#define LDSWAIT() asm volatile("s_waitcnt lgkmcnt(0)" ::: "memory")
__device__ __forceinline__ unsigned f2bf(float f) { unsigned u = __float_as_uint(f); return (u + 0x7fffu + ((u >> 16) & 1u)) >> 16; }
__device__ __forceinline__ unsigned pk2(float lo, float hi) { unsigned r; asm volatile("v_cvt_pk_bf16_f32 %0, %1, %2" : "=v"(r) : "v"(lo), "v"(hi)); return r; }
__device__ __forceinline__ float bflo(unsigned w) { return __uint_as_float(w << 16); }
__device__ __forceinline__ float bfhi(unsigned w) { return __uint_as_float(w & 0xffff0000u); }
__device__ __forceinline__ float wave_sum(float v) {
#pragma unroll
    for (int o = 1; o < 64; o <<= 1) v += __shfl_xor(v, o);
    return v;
}

__device__ __forceinline__ void transpose_item64(const float* __restrict__ W, int ldw, int K, int nblk, bf16* __restrict__ WT, LAS float* scr, int item, int lane, bool upperm) {
    const int kb = item / nblk, nb = item - kb * nblk, k0 = 64 * kb, n0 = 64 * nb;
    const int d0 = !upperm ? n0 : (n0 < FF ? 256 * (n0 >> 7) + (n0 & 127) : 256 * ((n0 - FF) >> 7) + 128 + ((n0 - FF) & 127));
    f32x4 v[16];
#pragma unroll
    for (int i = 0; i < 16; ++i) { const int kk = 4 * i + (lane >> 4); v[i] = *(const f32x4*)(W + (size_t)(k0 + kk) * ldw + n0 + 4 * (lane & 15)); }
#pragma unroll
    for (int i = 0; i < 16; ++i) { const int kk = 4 * i + (lane >> 4); LAS float* s = scr + kk * 65 + 4 * (lane & 15); s[0] = v[i].x; s[1] = v[i].y; s[2] = v[i].z; s[3] = v[i].w; }
    LDSWAIT();
    const int c = lane & 7, q = lane >> 3;
#pragma unroll
    for (int j = 0; j < 8; ++j) { const int n = q + 8 * j; const LAS float* s = scr + (8 * c) * 65 + n;
        u32x4 o; o.x = pk2(s[0], s[65]); o.y = pk2(s[130], s[195]); o.z = pk2(s[260], s[325]); o.w = pk2(s[390], s[455]);
        *(u32x4*)(WT + (size_t)(d0 + n) * K + k0 + 8 * c) = o; }
    LDSWAIT();
}

__device__ __forceinline__ void rmsnorm_rows(const float* __restrict__ src, const float* __restrict__ gain, bf16* __restrict__ dst, int gw, int ngw, int lane) {
    f32x4 g[8];
#pragma unroll
    for (int j = 0; j < 8; ++j) g[j] = *(const f32x4*)(gain + 4 * lane + 256 * j);
    for (int m = gw; m < M; m += ngw) {
        const f32x4* xr = (const f32x4*)(src + (size_t)m * D) + lane; f32x4 v[8]; float s = 0.f;
#pragma unroll
        for (int j = 0; j < 8; ++j) { v[j] = xr[64 * j]; s += (v[j].x * v[j].x + v[j].y * v[j].y) + (v[j].z * v[j].z + v[j].w * v[j].w); }
        const float rstd = 1.0f / sqrtf(wave_sum(s) * (1.0f / D) + EPS);
        u32x2* o = (u32x2*)(dst + (size_t)m * D) + lane;
#pragma unroll
        for (int j = 0; j < 8; ++j) { u32x2 w; w.x = pk2(v[j].x * rstd * g[j].x, v[j].y * rstd * g[j].y); w.y = pk2(v[j].z * rstd * g[j].z, v[j].w * rstd * g[j].w); o[64 * j] = w; }
    }
}

struct In { const float *x, *norm_mix, *norm_ffn, *w_in_ab, *pool_w, *pool_scale, *q_norm, *k_norm, *w_out_ab, *w_in_c, *b_gate, *h_norm, *w_out_c, *w_up, *conv_w, *conv_b, *w_down; };

__device__ __forceinline__ void transposes(const In& I, unsigned char* ws, LAS unsigned char* lds, int first, int last, int w, int nw, int wave, int lane) {
    LAS float* scr = (LAS float*)(lds + wave * 16640);
    for (int it = first + w; it < last; it += nw) {
        const float* W; int ldw, K, nblk; bf16* WT; int r = it;
        if (r < 1536) { W = I.w_in_ab; ldw = ABW; K = D; nblk = 48; WT = (bf16*)(ws + WS_AB); }
        else if (r < 2560) { r -= 1536; W = I.w_out_ab; ldw = D; K = D; nblk = 32; WT = (bf16*)(ws + WS_OAB); }
        else if (r < 6656) { r -= 2560; W = I.w_in_c; ldw = CW; K = D; nblk = 128; WT = (bf16*)(ws + WS_C); }
        else if (r < 7680) { r -= 6656; W = I.w_out_c; ldw = D; K = D; nblk = 32; WT = (bf16*)(ws + WS_OC); }
        else if (r < 13312) { r -= 7680; W = I.w_up; ldw = FF2; K = D; nblk = 176; WT = (bf16*)(ws + WS_UP0); }
        else if (r < 18944) { r -= 13312; W = I.w_up + (size_t)D * FF2; ldw = FF2; K = D; nblk = 176; WT = (bf16*)(ws + WS_UP1); }
        else if (r < 21760) { r -= 18944; W = I.w_down; ldw = D; K = FF; nblk = 32; WT = (bf16*)(ws + WS_DN0); }
        else { r -= 21760; W = I.w_down + (size_t)FF * D; ldw = D; K = FF; nblk = 32; WT = (bf16*)(ws + WS_DN1); }
        transpose_item64(W, ldw, K, nblk, WT, scr, r, lane, (it >= 7680 && it < 18944));
    }
}
__device__ __forceinline__ void prologue(const In& I, unsigned char* ws, LAS unsigned char* lds, int gw, int ngw, int wave, int lane) {
    transposes(I, ws, lds, 0, 1536, gw, ngw, wave, lane);
    const int gt = gw * 64 + lane, ngt = ngw * 64;
    { bf16* WG = (bf16*)(ws + WS_C) + (size_t)8192 * D;
      for (int idx = gt; idx < 32 * D; idx += ngt) { const int j = idx >> 11, k = idx & 2047; WG[idx] = (bf16)f2bf(I.w_in_c[(size_t)k * CW + 8192 + j]); } }
    { bf16* BD = (bf16*)(ws + WS_BD);
      for (int idx = gt; idx < 512 * 512; idx += ngt) { const int n = idx >> 9, k = idx & 511, gn = n >> 7, gk = k >> 7;
          const float v = (gn == gk) ? I.pool_w[(size_t)(gn * 128 + (k & 127)) * 128 + (n & 127)] * I.pool_scale[n] : 0.f; BD[idx] = (bf16)f2bf(v); } }
    rmsnorm_rows(I.x, I.norm_mix, (bf16*)(ws + WS_XN), gw, ngw, lane);
}

__device__ __forceinline__ void qk_rope_pool(bf16* __restrict__ PROJ, const float* __restrict__ qn, const float* __restrict__ kn, bf16* __restrict__ POOLED, int gw, int ngw, int lane) {
    const int l = lane & 31, hsel = lane >> 5, part = (l >> 4) & 1; const bool first = (l & 8) == 0;
    float inv[4];
#pragma unroll
    for (int e = 0; e < 4; ++e) inv[e] = exp2f(-(float)(4 * (l & 7) + e) * (13.287712379549449f / 32.0f));
    const f32x4 gq = *(const f32x4*)(qn + 4 * l), gk = *(const f32x4*)(kn + 4 * l);
    for (int it = gw; it < M * 8; it += ngw) {
        const int t = it >> 3, hh = (it & 7) * 2 + hsel;
        bf16* p = PROJ + (size_t)t * ABW + 512 + hh * 128 + 4 * l;
        const u32x2 w = *(const u32x2*)p;
        float x[4] = {bflo(w.x), bfhi(w.x), bflo(w.y), bfhi(w.y)};
        float ss = (x[0] * x[0] + x[1] * x[1]) + (x[2] * x[2] + x[3] * x[3]);
#pragma unroll
        for (int o = 1; o < 32; o <<= 1) ss += __shfl_xor(ss, o);
        const float rstd = 1.0f / sqrtf(ss * (1.0f / 128.0f) + EPS);
        const f32x4 g = (hh < 12) ? gq : gk;
        const int pos = t & (SEQ - 1); const float pp = part ? (float)(pos & 63) : (float)(pos >> 6);
        float y[4] = {x[0] * rstd * g.x, x[1] * rstd * g.y, x[2] * rstd * g.z, x[3] * rstd * g.w}, o4[4];
#pragma unroll
        for (int e = 0; e < 4; ++e) { const float yp = __shfl_xor(y[e], 8); const float ang = pp * inv[e]; const float sn = __sinf(ang), cs = __cosf(ang);
            o4[e] = y[e] * cs + (first ? -yp : yp) * sn; }
        u32x2 ow; ow.x = pk2(o4[0], o4[1]); ow.y = pk2(o4[2], o4[3]); *(u32x2*)p = ow;
    }
    const int gt = gw * 64 + lane, ngt = ngw * 64;
    for (int it = gt; it < M * 64; it += ngt) {
        const int t = it >> 6, c8 = (it & 63) * 8, g = c8 >> 7, w2 = 1 << g, pos = t & (SEQ - 1), base = t - pos;
        const int lo = max(pos - w2, 0), hi = min(pos + w2, SEQ);
        float acc[8] = {0.f, 0.f, 0.f, 0.f, 0.f, 0.f, 0.f, 0.f};
        for (int pz = lo; pz < hi; ++pz) { const u32x4 v = *(const u32x4*)(PROJ + (size_t)(base + pz) * ABW + c8);
            acc[0] += bflo(v.x); acc[1] += bfhi(v.x); acc[2] += bflo(v.y); acc[3] += bfhi(v.y); acc[4] += bflo(v.z); acc[5] += bfhi(v.z); acc[6] += bflo(v.w); acc[7] += bfhi(v.w); }
        const u32x4 sv = *(const u32x4*)(PROJ + (size_t)t * ABW + c8); const float iv = 1.0f / (float)(hi - lo);
        u32x4 o; o.x = pk2(acc[0] * iv - bflo(sv.x), acc[1] * iv - bfhi(sv.x)); o.y = pk2(acc[2] * iv - bflo(sv.y), acc[3] * iv - bfhi(sv.y));
        o.z = pk2(acc[4] * iv - bflo(sv.z), acc[5] * iv - bfhi(sv.z)); o.w = pk2(acc[6] * iv - bflo(sv.w), acc[7] * iv - bfhi(sv.w));
        *(u32x4*)(POOLED + (size_t)t * 512 + c8) = o;
    }
}

__device__ __forceinline__ void conv_fix(const bf16* __restrict__ HALO, const float* __restrict__ cw, const float* __restrict__ cb, bf16* __restrict__ ACT, int gt, int ngt) {
    for (int it = gt; it < 256 * 704; it += ngt) {
        const int jc = it % 704, re = it / 704, blk = re >> 1, last = re & 1, j = jc * 8;
        const int t = blk * 64 + (last ? 63 : 0), pos = t & (SEQ - 1);
        const bf16* rc = HALO + ((size_t)blk * 4 + (last ? 3 : 0)) * FF2 + j;
        const bf16* ru = last ? rc - FF2 : HALO + ((size_t)(blk - 1) * 4 + 3) * FF2 + j;
        const bf16* rd = last ? HALO + ((size_t)(blk + 1) * 4) * FF2 + j : rc + FF2;
        const u32x4 z = {0u, 0u, 0u, 0u};
        const u32x4 g1 = *(const u32x4*)rc, v1 = *(const u32x4*)(rc + FF);
        const u32x4 g0 = pos > 0 ? *(const u32x4*)ru : z, v0 = pos > 0 ? *(const u32x4*)(ru + FF) : z;
        const u32x4 g2 = pos < SEQ - 1 ? *(const u32x4*)rd : z, v2 = pos < SEQ - 1 ? *(const u32x4*)(rd + FF) : z;
        float o[8];
#pragma unroll
        for (int q = 0; q < 4; ++q) {
            const int ja = j + 2 * q, jb = ja + 1;
            const float ga = cw[ja] * bflo(g0[q]) + cw[FF2 + ja] * bflo(g1[q]) + cw[2 * FF2 + ja] * bflo(g2[q]) + cb[ja];
            const float gb = cw[jb] * bfhi(g0[q]) + cw[FF2 + jb] * bfhi(g1[q]) + cw[2 * FF2 + jb] * bfhi(g2[q]) + cb[jb];
            const float va = cw[FF + ja] * bflo(v0[q]) + cw[FF2 + FF + ja] * bflo(v1[q]) + cw[2 * FF2 + FF + ja] * bflo(v2[q]) + cb[FF + ja];
            const float vb = cw[FF + jb] * bfhi(v0[q]) + cw[FF2 + FF + jb] * bfhi(v1[q]) + cw[2 * FF2 + FF + jb] * bfhi(v2[q]) + cb[FF + jb];
            o[2 * q] = ga / (1.0f + __expf(-ga)) * va; o[2 * q + 1] = gb / (1.0f + __expf(-gb)) * vb;
        }
        u32x4 ow; ow.x = pk2(o[0], o[1]); ow.y = pk2(o[2], o[3]); ow.z = pk2(o[4], o[5]); ow.w = pk2(o[6], o[7]);
        *(u32x4*)(ACT + (size_t)t * FF + j) = ow;
    }
}

__device__ __forceinline__ void gates_phase(const bf16* __restrict__ XN, const bf16* __restrict__ WG, const float* __restrict__ bg, float* __restrict__ GATES, LAS float* red, int bid, int nblk) {
    const int tid = mk_tid(), wid = tid >> 6, lane = tid & 63, fr = lane & 15, fq = lane >> 4;
    const int tile = wid & 3, tt = tile & 1, jt = tile >> 1, kh = wid >> 2;
    for (int grp = bid; grp < 256; grp += nblk) {
        f32x4 acc = {0.f, 0.f, 0.f, 0.f};
        const bf16* ap = WG + (size_t)(jt * 16 + fr) * D + kh * 1024 + fq * 8;
        const bf16* bp = XN + (size_t)(grp * 32 + tt * 16 + fr) * D + kh * 1024 + fq * 8;
#pragma unroll 8
        for (int ks = 0; ks < 32; ++ks) { const bf16x8 a = *(const bf16x8*)(ap + ks * 32), b = *(const bf16x8*)(bp + ks * 32); acc = __builtin_amdgcn_mfma_f32_16x16x32_bf16(a, b, acc, 0, 0, 0); }
        if (kh == 1) { LAS float* r = red + (tile * 64 + lane) * 4; r[0] = acc[0]; r[1] = acc[1]; r[2] = acc[2]; r[3] = acc[3]; }
        __syncthreads();
        if (kh == 0) { const LAS float* r = red + (tile * 64 + lane) * 4; const int t = grp * 32 + tt * 16 + fr, j = jt * 16 + 4 * fq;
            const f32x4 b4 = *(const f32x4*)(bg + j); f32x4 o; o.x = acc[0] + r[0] + b4.x; o.y = acc[1] + r[1] + b4.y; o.z = acc[2] + r[2] + b4.z; o.w = acc[3] + r[3] + b4.w;
            *(f32x4*)(GATES + (size_t)t * 32 + j) = o; }
        __syncthreads();
    }
}

__device__ __forceinline__ void headnorm_phase(const float* __restrict__ HF, const bf16* __restrict__ OG, const float* __restrict__ hn, bf16* __restrict__ Y, int gw, int ngw, int lane) {
    for (int it = gw; it < M * 8; it += ngw) {
        const int t = it >> 3, h = it & 7; const size_t off = (size_t)t * D + h * 256 + 4 * lane;
        const f32x4 a = *(const f32x4*)(HF + off), b = *(const f32x4*)(HF + (size_t)M * D + off); const f32x4 s = a + b;
        const float ss = wave_sum((s.x * s.x + s.y * s.y) + (s.z * s.z + s.w * s.w));
        const float rstd = 1.0f / sqrtf(ss * (1.0f / 256.0f) + EPS);
        const f32x4 g = *(const f32x4*)(hn + h * 256 + 4 * lane); const u32x2 ow = *(const u32x2*)(OG + off);
        const float o0 = bflo(ow.x), o1 = bfhi(ow.x), o2 = bflo(ow.y), o3 = bfhi(ow.y);
        u32x2 w; w.x = pk2(s.x * rstd * g.x / (1.0f + __expf(-o0)), s.y * rstd * g.y / (1.0f + __expf(-o1)));
        w.y = pk2(s.z * rstd * g.z / (1.0f + __expf(-o2)), s.w * rstd * g.w / (1.0f + __expf(-o3)));
        *(u32x2*)(Y + off) = w;
    }
}

namespace ml {
constexpr int LQ = 264, LS = 72;
constexpr int OFF_Q = 0, OFF_K = 33792, OFF_KT = 67584, OFF_VT = 104448, OFF_VTW = 111360, OFF_P = 118272, OFF_CT = 127488, OFF_SC = 152832;
static_assert(OFF_SC + 1280 + 1024 == LDS_ML, "mlstm lds map");
#define ML_BAR() do { asm volatile("s_waitcnt lgkmcnt(0)" ::: "memory"); __builtin_amdgcn_s_barrier(); asm volatile("" ::: "memory"); } while (0)
#define ML_MFMA(a, b, c) __builtin_amdgcn_mfma_f32_16x16x32_bf16(a, b, c, 0, 0, 0)

__device__ __forceinline__ void mlstm_phase(LAS unsigned char* lds, const bf16* __restrict__ QK, const bf16* __restrict__ KVT, const float* __restrict__ GATES, float* __restrict__ HF, int bid, int nblk) {
    const int tid = mk_tid(), wid = tid >> 6, lane = tid & 63, fr = lane & 15, fq = lane >> 4;
    LAS bf16* Qs = (LAS bf16*)(lds + OFF_Q); LAS bf16* Ks = (LAS bf16*)(lds + OFF_K); LAS bf16* KTs = (LAS bf16*)(lds + OFF_KT);
    LAS bf16* VTs = (LAS bf16*)(lds + OFF_VT); LAS bf16* VTw = (LAS bf16*)(lds + OFF_VTW); LAS bf16* Ps = (LAS bf16*)(lds + OFF_P); LAS bf16* CTs = (LAS bf16*)(lds + OFF_CT);
    LAS float* sA = (LAS float*)(lds + OFF_SC); LAS float* sM = sA + 64; LAS float* sAI = sM + 64; LAS float* sEM = sAI + 64; LAS float* sWS = (LAS float*)(lds + OFF_SC + 1280);
    const int tt = wid & 3, sh = wid >> 2;
    for (int it0 = bid; it0 < 256; it0 += nblk) {
        const int item = (nblk == 256) ? (((it0 & 7) * 4 + (it0 >> 6)) * 8 + ((it0 >> 3) & 7)) : it0;
        const int es = item & 7, dir = (item >> 3) & 1, h = (item >> 4) & 7, b = (item >> 7) & 1;
        for (int i = tid; i < 48 * LQ / 2; i += 512) ((LAS unsigned*)CTs)[i] = 0u;
        for (int i = tid; i < 16 * LS; i += 512) { VTs[32 * LS + i] = (i < LS) ? (bf16)0x3F80 : (bf16)0; VTw[32 * LS + i] = (bf16)0; }
        f32x4 ct[2][3];
#pragma unroll
        for (int a = 0; a < 2; ++a)
#pragma unroll
            for (int e = 0; e < 3; ++e) ct[a][e] = (f32x4){0.f, 0.f, 0.f, 0.f};
        float m_st = 0.f, decay = 1.f;
        bf16x8 rq[4], rk[4], rkt[4], rvt = {0, 0, 0, 0, 0, 0, 0, 0}; float gi = 0.f, gf = 0.f;
        const unsigned voffQ = (unsigned)(((tid >> 5) * 4096 + (tid & 31) * 8) * 2), voffT = (unsigned)(((tid >> 3) * M + (tid & 7) * 8) * 2), voffG = (unsigned)((dir ? 63 - lane : lane) * 128);
#define ML_LOAD(c) do { const int ncn_ = dir ? 63 - (c) : (c); const size_t trow_ = (size_t)b * SEQ + (size_t)ncn_ * 64; \
        const char* qb_ = (const char*)(QK + trow_ * 4096 + h * 256); \
        _Pragma("unroll") for (int i_ = 0; i_ < 4; ++i_) { rq[i_] = *(const bf16x8*)(qb_ + (size_t)i_ * 131072 + voffQ); rk[i_] = *(const bf16x8*)(qb_ + 4096 + (size_t)i_ * 131072 + voffQ); } \
        const char* tb_ = (const char*)(KVT + (size_t)(h * 256) * M + trow_); \
        _Pragma("unroll") for (int i_ = 0; i_ < 4; ++i_) rkt[i_] = *(const bf16x8*)(tb_ + (size_t)i_ * (64 * M * 2) + voffT); \
        if (tid < 256) rvt = *(const bf16x8*)((const char*)(KVT + (size_t)(2048 + h * 256 + es * 32) * M + trow_) + voffT); \
        { const float* gp_ = GATES + trow_ * 32 + dir * 16 + h; gi = *(const float*)((const char*)gp_ + voffG); gf = *(const float*)((const char*)gp_ + 32 + voffG); } } while (0)
#define ML_STORE() do { \
        const float lf_ = fminf(gf, 0.f) - log1pf(__expf(-fabsf(gf))); float bc_ = lf_; \
        _Pragma("unroll") for (int o_ = 1; o_ < 64; o_ <<= 1) { const float t_ = __shfl_up(bc_, o_); if (lane >= o_) bc_ += t_; } \
        const float a_ = gi - bc_; float cm_ = a_; \
        _Pragma("unroll") for (int o_ = 1; o_ < 64; o_ <<= 1) { const float t_ = __shfl_up(cm_, o_); if (lane >= o_) cm_ = fmaxf(cm_, t_); } \
        const float Mv_ = fmaxf(m_st, cm_), blast_ = __shfl(bc_, 63), cml_ = __shfl(cm_, 63), Mn_ = fmaxf(m_st, cml_); \
        const float ai_ = __expf(m_st - Mv_), em_ = __expf(-(bc_ + Mv_)), wsv_ = __expf(a_ - Mn_); decay = __expf(m_st - Mn_); m_st = blast_ + Mn_; \
        const int rr_ = dir ? 63 - lane : lane; \
        if (wid == 0) { sA[rr_] = a_; sM[rr_] = Mv_; sAI[rr_] = ai_; sEM[rr_] = em_; VTw[32 * LS + rr_] = (bf16)f2bf(wsv_); } \
        _Pragma("unroll") for (int i_ = 0; i_ < 4; ++i_) { const int q_ = tid + 512 * i_, r_ = q_ >> 5, cc_ = (q_ & 31) * 8; \
            *(LAS bf16x8*)(Qs + r_ * LQ + cc_) = rq[i_]; *(LAS bf16x8*)(Ks + r_ * LQ + cc_) = rk[i_]; } \
        _Pragma("unroll") for (int i_ = 0; i_ < 4; ++i_) { const int q_ = tid + 512 * i_, d_ = q_ >> 3, cc_ = (q_ & 7) * 8; *(LAS bf16x8*)(KTs + d_ * LS + cc_) = rkt[i_]; } \
        if (tid < 256) { const int e_ = tid >> 3, cc_ = (tid & 7) * 8; *(LAS bf16x8*)(VTs + e_ * LS + cc_) = rvt; \
            LAS float* wsp_ = sWS + wid * 64; wsp_[rr_] = wsv_; asm volatile("s_waitcnt lgkmcnt(0)" ::: "memory"); \
            const f32x4 wa_ = *(const LAS f32x4*)(wsp_ + cc_), wb_ = *(const LAS f32x4*)(wsp_ + cc_ + 4); const float wv_[8] = {wa_.x, wa_.y, wa_.z, wa_.w, wb_.x, wb_.y, wb_.z, wb_.w}; \
            const u32x4 rv_ = __builtin_bit_cast(u32x4, rvt); u32x4 o_; \
            o_.x = pk2(bflo(rv_.x) * wv_[0], bfhi(rv_.x) * wv_[1]); o_.y = pk2(bflo(rv_.y) * wv_[2], bfhi(rv_.y) * wv_[3]); \
            o_.z = pk2(bflo(rv_.z) * wv_[4], bfhi(rv_.z) * wv_[5]); o_.w = pk2(bflo(rv_.w) * wv_[6], bfhi(rv_.w) * wv_[7]); \
            *(LAS u32x4*)(VTw + e_ * LS + cc_) = o_; } } while (0)
        ML_LOAD(0);
        ML_BAR();
        ML_STORE();
        ML_BAR();
        ML_LOAD(1);
        for (int c = 0; c < 64; ++c) {
            const int ncn = dir ? 63 - c : c; const size_t trow = (size_t)b * SEQ + (size_t)ncn * 64;
            const float dec_c = decay;
            f32x4 s0 = {0.f, 0.f, 0.f, 0.f}, s1 = s0, n3 = s0, d3 = s0;
            {
                const LAS bf16* qp = Qs + (tt * 16 + fr) * LQ + fq * 8;
                const LAS bf16* kp0 = Ks + ((2 * sh) * 16 + fr) * LQ + fq * 8; const LAS bf16* kp1 = kp0 + 16 * LQ;
                const LAS bf16* cp0 = CTs + (sh * 16 + fr) * LQ + fq * 8; const LAS bf16* cp2 = CTs + (32 + fr) * LQ + fq * 8;
#pragma unroll
                for (int hf = 0; hf < 4; ++hf) {
                    bf16x8 qf[2], k0[2], k1[2], c0[2], c2[2];
#pragma unroll
                    for (int k4 = 0; k4 < 2; ++k4) { const int ko = (hf * 2 + k4) * 32;
                        qf[k4] = *(const LAS bf16x8*)(qp + ko); k0[k4] = *(const LAS bf16x8*)(kp0 + ko); k1[k4] = *(const LAS bf16x8*)(kp1 + ko);
                        c0[k4] = *(const LAS bf16x8*)(cp0 + ko); c2[k4] = *(const LAS bf16x8*)(cp2 + ko); }
                    __builtin_amdgcn_sched_barrier(0);
#pragma unroll
                    for (int k4 = 0; k4 < 2; ++k4) { s0 = ML_MFMA(k0[k4], qf[k4], s0); s1 = ML_MFMA(k1[k4], qf[k4], s1); n3 = ML_MFMA(c0[k4], qf[k4], n3); d3 = ML_MFMA(c2[k4], qf[k4], d3); }
                }
            }
            const int t = tt * 16 + fr; const float Mt = sM[t];
            {
                const int sb0 = (2 * sh) * 16 + 4 * fq, sb1 = sb0 + 16;
                const f32x4 a0 = *(const LAS f32x4*)(sA + sb0), a1 = *(const LAS f32x4*)(sA + sb1);
                float p0[4], p1[4];
#pragma unroll
                for (int r = 0; r < 4; ++r) {
                    const int sa = sb0 + r, sbb = sb1 + r;
                    const bool ok0 = dir ? (sa >= t) : (sa <= t), ok1 = dir ? (sbb >= t) : (sbb <= t);
                    p0[r] = ok0 ? s0[r] * __expf(a0[r] - Mt) : 0.f; p1[r] = ok1 ? s1[r] * __expf(a1[r] - Mt) : 0.f;
                }
                u32x2 w0, w1; w0.x = pk2(p0[0], p0[1]); w0.y = pk2(p0[2], p0[3]); w1.x = pk2(p1[0], p1[1]); w1.y = pk2(p1[2], p1[3]);
                *(LAS u32x2*)(Ps + t * LS + sb0) = w0; *(LAS u32x2*)(Ps + t * LS + sb1) = w1;
            }
            ML_BAR();
            f32x4 n2 = {0.f, 0.f, 0.f, 0.f}, d2 = n2;
            {
                bf16x8 pf[2], v0[2], v2[2];
#pragma unroll
                for (int ks = 0; ks < 2; ++ks) { const int ko = ks * 32 + fq * 8;
                    pf[ks] = *(const LAS bf16x8*)(Ps + (tt * 16 + fr) * LS + ko); v0[ks] = *(const LAS bf16x8*)(VTs + (sh * 16 + fr) * LS + ko); v2[ks] = *(const LAS bf16x8*)(VTs + (32 + fr) * LS + ko); }
                __builtin_amdgcn_sched_barrier(0);
#pragma unroll
                for (int ks = 0; ks < 2; ++ks) { n2 = ML_MFMA(v0[ks], pf[ks], n2); d2 = ML_MFMA(v2[ks], pf[ks], d2); }
            }
            {
                const float ai = sAI[t], em = sEM[t];
                const float den0 = d2[0] + ai * d3[0];
                const float den = __shfl(den0, fr);
                const float rinv = 1.0f / fmaxf(fabsf(den), em);
                f32x4 hout; hout.x = (n2[0] + ai * n3[0]) * rinv; hout.y = (n2[1] + ai * n3[1]) * rinv; hout.z = (n2[2] + ai * n3[2]) * rinv; hout.w = (n2[3] + ai * n3[3]) * rinv;
                *(f32x4*)(HF + ((size_t)dir * M + trow + t) * D + h * 256 + es * 32 + sh * 16 + 4 * fq) = hout;
            }
#pragma unroll
            for (int a = 0; a < 2; ++a)
#pragma unroll
                for (int e = 0; e < 3; ++e) ct[a][e] = ct[a][e] * dec_c;
#pragma unroll
            for (int ks = 0; ks < 2; ++ks) { const int ko = ks * 32 + fq * 8; bf16x8 kt[2], vw[3];
#pragma unroll
                for (int a = 0; a < 2; ++a) kt[a] = *(const LAS bf16x8*)(KTs + ((2 * wid + a) * 16 + fr) * LS + ko);
#pragma unroll
                for (int e = 0; e < 3; ++e) vw[e] = *(const LAS bf16x8*)(VTw + (e * 16 + fr) * LS + ko);
                __builtin_amdgcn_sched_barrier(0);
#pragma unroll
                for (int a = 0; a < 2; ++a)
#pragma unroll
                    for (int e = 0; e < 3; ++e) ct[a][e] = ML_MFMA(kt[a], vw[e], ct[a][e]);
            }
#pragma unroll
            for (int a = 0; a < 2; ++a)
#pragma unroll
                for (int e = 0; e < 3; ++e) { u32x2 w; w.x = f2bf(ct[a][e][0]) | (f2bf(ct[a][e][1]) << 16); w.y = f2bf(ct[a][e][2]) | (f2bf(ct[a][e][3]) << 16);
                    *(LAS u32x2*)(CTs + (e * 16 + fr) * LQ + (2 * wid + a) * 16 + 4 * fq) = w; }
            ML_BAR();
            if (c + 1 < 64) { ML_STORE(); }
            ML_BAR();
            if (c + 2 < 64) { ML_LOAD(c + 2); }
        }
#undef ML_LOAD
#undef ML_STORE
    }
}
}
}

struct EpiRes {
    static constexpr bool PERM = false, AFTER_DRAIN = false;
    const float* base; float* out; int ldc;
    __device__ __forceinline__ void operator()(const pg8::f32x4 (&acc)[2][2][4][2], const pg8::Unit& u, int wr, int wc, int fr, int fq) const {
#pragma unroll
        for (int ai = 0; ai < 2; ++ai)
#pragma unroll
            for (int m = 0; m < 4; ++m) { const size_t ro = (size_t)(u.pm * 256 + ai * 128 + wr * 64 + m * 16 + fr) * ldc + u.pn * 256 + wc * 32 + 4 * fq;
#pragma unroll
                for (int bj = 0; bj < 2; ++bj)
#pragma unroll
                    for (int n = 0; n < 2; ++n) { const size_t off = ro + bj * 128 + n * 16; const pg8::f32x4 bs = *(const pg8::f32x4*)(base + off); *(pg8::f32x4*)(out + off) = bs + acc[ai][bj][m][n]; } }
    }
};

#define ROR1(x) __int_as_float(__builtin_amdgcn_update_dpp(0, __float_as_int(x), 0x121, 0xF, 0xF, false))
#define ROL1(x) __int_as_float(__builtin_amdgcn_update_dpp(0, __float_as_int(x), 0x12F, 0xF, 0xF, false))
struct EpiConv {
    static constexpr bool PERM = true, AFTER_DRAIN = false;
    unsigned short* ACT; unsigned short* HALO; const float* cw; const float* cb;
    __device__ __forceinline__ void operator()(const pg8::f32x4 (&acc)[2][2][4][2], const pg8::Unit& u, int wr, int wc, int fr, int fq) const {
        using mk::FF; using mk::FF2;
        const int jb = u.pn * 128 + wc * 32 + 8 * fq;
        mk::u32x2 keep[2][4];
#pragma unroll
        for (int n = 0; n < 2; ++n) {
            const int j = jb + 4 * n;
            const pg8::f32x4 c0g = *(const pg8::f32x4*)(cw + j), c1g = *(const pg8::f32x4*)(cw + FF2 + j), c2g = *(const pg8::f32x4*)(cw + 2 * FF2 + j), cbg = *(const pg8::f32x4*)(cb + j);
            const pg8::f32x4 c0v = *(const pg8::f32x4*)(cw + FF + j), c1v = *(const pg8::f32x4*)(cw + FF2 + FF + j), c2v = *(const pg8::f32x4*)(cw + 2 * FF2 + FF + j), cbv = *(const pg8::f32x4*)(cb + FF + j);
#pragma unroll
            for (int ai = 0; ai < 2; ++ai)
#pragma unroll
                for (int m = 0; m < 4; ++m) {
                    const int row = u.pm * 256 + ai * 128 + wr * 64 + m * 16 + fr;
                    float o[4];
#pragma unroll
                    for (int i = 0; i < 4; ++i) {
                        const float g = acc[ai][0][m][n][i], v = acc[ai][1][m][n][i];
                        float gu = ROR1(g), gd = ROL1(g), vu = ROR1(v), vd = ROL1(v);
                        if (m > 0) { const float ga = ROR1(acc[ai][0][m - 1][n][i]), va = ROR1(acc[ai][1][m - 1][n][i]); if (fr == 0) { gu = ga; vu = va; } }
                        if (m < 3) { const float ga = ROL1(acc[ai][0][m + 1][n][i]), va = ROL1(acc[ai][1][m + 1][n][i]); if (fr == 15) { gd = ga; vd = va; } }
                        const float G = c0g[i] * gu + c1g[i] * g + c2g[i] * gd + cbg[i];
                        const float V = c0v[i] * vu + c1v[i] * v + c2v[i] * vd + cbv[i];
                        o[i] = G / (1.0f + __expf(-G)) * V;
                    }
                    const bool edge = (m == 0 && fr == 0) || (m == 3 && fr == 15);
                    { mk::u32x2 w; w.x = mk::pk2(o[0], o[1]); w.y = mk::pk2(o[2], o[3]);
                      if (n == 0) keep[ai][m] = w;
                      else if (!edge) { mk::u32x4 w4; w4.x = keep[ai][m].x; w4.y = keep[ai][m].y; w4.z = w.x; w4.w = w.y; *(mk::u32x4*)(ACT + (size_t)row * FF + jb) = w4; } }
                    if ((m == 0 && fr < 2) || (m == 3 && fr > 13)) {
                        const int hr = (m == 0) ? fr : fr - 12;
                        unsigned short* hp = HALO + ((size_t)(row >> 6) * 4 + hr) * FF2 + j;
                        mk::u32x2 wg, wv; wg.x = mk::f2bf(acc[ai][0][m][n][0]) | (mk::f2bf(acc[ai][0][m][n][1]) << 16); wg.y = mk::f2bf(acc[ai][0][m][n][2]) | (mk::f2bf(acc[ai][0][m][n][3]) << 16);
                        wv.x = mk::f2bf(acc[ai][1][m][n][0]) | (mk::f2bf(acc[ai][1][m][n][1]) << 16); wv.y = mk::f2bf(acc[ai][1][m][n][2]) | (mk::f2bf(acc[ai][1][m][n][3]) << 16);
                        *(mk::u32x2*)hp = wg; *(mk::u32x2*)(hp + FF) = wv;
                    }
                }
        }
    }
};

struct EpiBf16T {
    static constexpr bool PERM = true, AFTER_DRAIN = false;
    unsigned short* O; int ldc; int split_cols; float scale0; unsigned short* T; int tcol0; int ldt;
    __device__ __forceinline__ void operator()(const pg8::f32x4 (&acc)[2][2][4][2], const pg8::Unit& u, int wr, int wc, int fr, int fq) const {
        const int row0 = u.pm * 256 + wr * 64 + fr, colt = u.pn * 256, col0 = colt + wc * 32 + 8 * fq;
        const float sc = (colt < split_cols) ? scale0 : 1.f;
#pragma unroll
        for (int ai = 0; ai < 2; ++ai)
#pragma unroll
            for (int m = 0; m < 4; ++m) { unsigned short* rowp = O + (size_t)(row0 + ai * 128 + m * 16) * ldc + col0;
#pragma unroll
                for (int bj = 0; bj < 2; ++bj) { const pg8::f32x4 v0 = acc[ai][bj][m][0] * sc, v1 = acc[ai][bj][m][1] * sc;
                    mk::u32x4 w; w.x = mk::pk2(v0[0], v0[1]); w.y = mk::pk2(v0[2], v0[3]); w.z = mk::pk2(v1[0], v1[1]); w.w = mk::pk2(v1[2], v1[3]);
                    *(mk::u32x4*)(rowp + bj * 128) = w; } }
        if (colt >= tcol0) {
#pragma unroll
            for (int bj = 0; bj < 2; ++bj)
#pragma unroll
                for (int n = 0; n < 2; ++n)
#pragma unroll
                    for (int i = 0; i < 4; ++i) { unsigned short* tp = T + (size_t)(col0 - tcol0 + bj * 128 + 4 * n + i) * ldt + row0;
#pragma unroll
                        for (int ai = 0; ai < 2; ++ai)
#pragma unroll
                            for (int m = 0; m < 4; ++m) tp[ai * 128 + m * 16] = (unsigned short)mk::f2bf(acc[ai][bj][m][n][i]); }
        }
    }
};

struct GemmDesc { const unsigned short* A; const unsigned short* Bt; int Mg, Ng, Kg; int kind; unsigned short* O; int ldc; int split_cols; float scale0; const float* base; float* out; int G, c; };

#ifndef REPEAT_PH
#define REPEAT_PH 1000
#define N_REPEAT 0
#else
#define N_REPEAT 1
#endif
struct Params { const float* in[17]; float* out; unsigned char* ws; int ph_lo, ph_hi; };
constexpr int N_PHASES = 18;

__global__ void __launch_bounds__(512, 2) fwd_mega(Params p) {
    extern __shared__ __attribute__((aligned(16))) unsigned char lds_raw[];
    using namespace mk;
    cg::grid_group grid = cg::this_grid();
    LAS unsigned char* lds = (LAS unsigned char*)lds_raw;
    const int bid = blockIdx.x, nblk = gridDim.x;
    const int ph_lo = p.ph_lo, ph_hi = p.ph_hi;
    { volatile LAS unsigned* misc = (volatile LAS unsigned*)(lds + LDS_MISC); if (mk_tid() < 16) misc[mk_tid()] = 0u; }
    __syncthreads();
    (void)xcd_barrier_post((unsigned*)(p.ws + WS_BAR), (volatile LAS unsigned*)(lds + LDS_MISC) + 8);
    if (ph_lo < 0) grid.sync();
#ifdef PROBE_PH
    const unsigned long long t_start = __builtin_amdgcn_s_memrealtime();
#endif
#pragma unroll 1
    for (int ph_it = ph_lo; ph_it < ph_hi + N_REPEAT; ++ph_it) {
        const int ph = ph_it <= REPEAT_PH ? ph_it : ph_it - N_REPEAT;
        typedef const __attribute__((address_space(4))) Params* KP;
        KP kp = (KP)__builtin_amdgcn_kernarg_segment_ptr(); asm volatile("" : "+s"(kp));
        unsigned char* ws = kp->ws; float* OUT = kp->out; bf16* XN = (bf16*)(ws + WS_XN);
        In I; I.x = kp->in[0]; I.norm_mix = kp->in[1]; I.norm_ffn = kp->in[2]; I.w_in_ab = kp->in[3]; I.pool_w = kp->in[4]; I.pool_scale = kp->in[5]; I.q_norm = kp->in[6]; I.k_norm = kp->in[7];
        I.w_out_ab = kp->in[8]; I.w_in_c = kp->in[9]; I.b_gate = kp->in[10]; I.h_norm = kp->in[11]; I.w_out_c = kp->in[12]; I.w_up = kp->in[13]; I.conv_w = kp->in[14]; I.conv_b = kp->in[15]; I.w_down = kp->in[16];
        int nb_ = nblk; asm volatile("" : "+s"(nb_)); const int ngw = nb_ * NW, ngt = nb_ * 512;
        const int tid = mk_tid(), lane = tid & 63, wave = __builtin_amdgcn_readfirstlane(tid >> 6), gw = bid * NW + wave, gt = bid * 512 + tid;
#ifndef NO_THIN
        if (ph == 0) prologue(I, ws, lds, gw, ngw, wave, lane);
        if (ph == 5 || ph == 9 || ph == 14) rmsnorm_rows(OUT, ph == 5 ? I.norm_ffn : (ph == 9 ? I.norm_mix + D : I.norm_ffn + D), XN, gw, ngw, lane);
        if (ph == 2) qk_rope_pool((bf16*)(ws + WS_PROJ), I.q_norm, I.k_norm, (bf16*)(ws + WS_POOLED), gw, ngw, lane);
#endif
#ifndef NO_ATT
        if (ph == 3) {
            const bf16* PROJ = (const bf16*)(ws + WS_PROJ); bf16* CAT = (bf16*)(ws + WS_CAT);
            for (int u0 = bid; u0 < 384; u0 += nblk) {
                int u = u0;
                if (nblk == 256) { const int xcd = u0 & 7, j = (u0 >> 3) & 31, rnd = u0 >> 8; const int jj = j + 32 * rnd;
                    if (jj >= 48) continue; u = (xcd >> 2) * 192 + ((xcd & 3) * 3 + (jj >> 4)) * 16 + (jj & 15); }
                const int qb = u & 15, hq = (u >> 4) % 12, b = u / 192;
                const size_t r0 = (size_t)b * SEQ + (size_t)qb * 256;
                att::attn_dense_body<att::bf16>((const att::bf16*)(PROJ + r0 * ABW + 512 + hq * 128), (const att::bf16*)(PROJ + (size_t)b * SEQ * ABW + 2048 + (hq / 3) * 128),
                                                (const att::bf16*)(PROJ + (size_t)b * SEQ * ABW + 2560 + (hq / 3) * 128), CAT + r0 * D + 512 + hq * 128, SEQ, (char*)lds_raw);
                __syncthreads();
            }
        }
#endif
#ifndef NO_THIN
        if (ph == 7 || ph == 16) { const int l = ph == 7 ? 0 : 1; conv_fix((const bf16*)(ws + WS_U), I.conv_w + (size_t)l * 3 * FF2, I.conv_b + (size_t)l * FF2, (bf16*)(ws + WS_ACT), gt, ngt); }
        if (ph == 10) gates_phase(XN, (const bf16*)(ws + WS_C) + (size_t)8192 * D, I.b_gate, (float*)(ws + WS_GATES), (LAS float*)lds, bid, nblk);
#endif
#ifndef NO_ML
        if (ph == 11) ml::mlstm_phase(lds, (const bf16*)(ws + WS_QK), (const bf16*)(ws + WS_KVT), (const float*)(ws + WS_GATES), (float*)(ws + WS_HF), bid, nblk);
#endif
#ifndef NO_THIN
        if (ph == 12) headnorm_phase((const float*)(ws + WS_HF), (const bf16*)(ws + WS_OG), I.h_norm, (bf16*)(ws + WS_Y), gw, ngw, lane);
#endif
#pragma unroll 1
        for (int gi = 0; gi < 3; ++gi) {
            GemmDesc d; d.kind = -1; d.G = nblk; d.c = bid; d.split_cols = 0; d.scale0 = 1.f; d.base = nullptr; d.out = nullptr; d.O = nullptr; d.ldc = 0; d.A = nullptr; d.Bt = nullptr; d.Mg = M; d.Ng = 0; d.Kg = D;
            if (gi == 0) {
                if (ph == 1) { d.kind = 0; d.A = XN; d.Bt = (bf16*)(ws + WS_AB); d.Ng = ABW; d.O = (bf16*)(ws + WS_PROJ); d.ldc = ABW; }
                else if (ph == 3) { d.kind = 0; d.A = (bf16*)(ws + WS_POOLED); d.Bt = (bf16*)(ws + WS_BD); d.Ng = 512; d.Kg = 512; d.O = (bf16*)(ws + WS_CAT); d.ldc = D;
                    if (nblk == 256) { const int slot = bid >> 3; d.G = 64; d.c = (slot - 16) * 8 + (bid & 7); if (slot < 16 || slot >= 24) d.kind = -1; } }
                else if (ph == 4) { d.kind = 1; d.A = (bf16*)(ws + WS_CAT); d.Bt = (bf16*)(ws + WS_OAB); d.Ng = D; d.base = I.x; d.out = OUT; }
                else if (ph == 6 || ph == 15) { d.kind = 2; d.A = XN; d.Bt = (bf16*)(ws + (ph == 6 ? WS_UP0 : WS_UP1)); d.Ng = FF2; d.O = (bf16*)(ws + WS_U); d.ldc = FF2; d.base = I.conv_w + (size_t)(ph == 6 ? 0 : 1) * 3 * FF2; d.out = (float*)(I.conv_b + (size_t)(ph == 6 ? 0 : 1) * FF2); }
                else if (ph == 8 || ph == 17) { d.kind = 1; d.A = (bf16*)(ws + WS_ACT); d.Bt = (bf16*)(ws + (ph == 8 ? WS_DN0 : WS_DN1)); d.Ng = D; d.Kg = FF; d.base = OUT; d.out = OUT; }
                else if (ph == 10) { d.kind = 3; d.A = XN; d.Bt = (bf16*)(ws + WS_C); d.Ng = 4096; d.O = (bf16*)(ws + WS_QK); d.ldc = 4096; d.split_cols = 2048; d.scale0 = 0.0625f; }
                else if (ph == 13) { d.kind = 1; d.A = (bf16*)(ws + WS_Y); d.Bt = (bf16*)(ws + WS_OC); d.Ng = D; d.base = OUT; d.out = OUT; }
            } else if (ph == 10) {
                if (gi == 1) { d.kind = 0; d.A = XN; d.Bt = (bf16*)(ws + WS_C) + (size_t)6144 * D; d.Ng = D; d.O = (bf16*)(ws + WS_OG); d.ldc = D; }
                else { d.kind = 0; d.A = (bf16*)(ws + WS_C) + (size_t)4096 * D; d.Bt = XN; d.Mg = 2048; d.Ng = M; d.O = (bf16*)(ws + WS_KVT) + (size_t)2048 * M; d.ldc = M; }
            }
#ifndef NO_GEMM
            if (d.kind == 0) {
                pg8::Gemm g{d.A, d.Bt, d.Mg, d.Ng, d.Kg}; pg8::StaticOrder S; S.init(d.Mg, d.Ng, d.G, d.c);
                pg8::EpiBf16<0> E{d.O, d.ldc, nullptr, d.split_cols, (size_t)d.split_cols, d.scale0};
                pg8::gemm_phase<pg8::EpiBf16<0>, pg8::StaticOrder, true, true>(lds, g, S, E);
            } else if (d.kind == 3) {
                pg8::Gemm g{d.A, d.Bt, d.Mg, d.Ng, d.Kg}; pg8::StaticOrder S; S.init(d.Mg, d.Ng, d.G, d.c);
                EpiBf16T E{d.O, d.ldc, d.split_cols, d.scale0, (bf16*)(ws + WS_KVT), 2048, M};
                pg8::gemm_phase<EpiBf16T, pg8::StaticOrder, true, true>(lds, g, S, E);
            } else if (d.kind == 2) {
                pg8::Gemm g{d.A, d.Bt, d.Mg, d.Ng, d.Kg}; pg8::StaticOrder S; S.init(d.Mg, d.Ng, d.G, d.c);
                EpiConv E{(bf16*)(ws + WS_ACT), d.O, d.base, (const float*)d.out};
                pg8::gemm_phase<EpiConv, pg8::StaticOrder, true, true>(lds, g, S, E);
            } else if (d.kind == 1) {
                pg8::Gemm g{d.A, d.Bt, d.Mg, d.Ng, d.Kg}; pg8::StaticOrder S; S.init(d.Mg, d.Ng, d.G, d.c);
                EpiRes E{d.base, d.out, D};
                pg8::gemm_phase<EpiRes, pg8::StaticOrder, true, true>(lds, g, S, E);
            }
#endif
            __syncthreads();
        }
#ifndef NO_THIN
        if (nb_ == 256) {
            if (ph == 1 && bid >= 128) { const int w = (bid - 128) * NW + wave; transposes(I, ws, lds, 1536, 2560, w, 128 * NW, wave, lane); transposes(I, ws, lds, 18944, 24576, w, 128 * NW, wave, lane); }
            if (ph == 3 && (bid >> 3) >= 16) { const int w = (((bid >> 3) - 16) * 8 + (bid & 7)) * NW + wave; transposes(I, ws, lds, 2560, 18944, w, 128 * NW, wave, lane); }
        } else if (ph == 1) transposes(I, ws, lds, 1536, 24576, gw, ngw, wave, lane);
#endif
        if (ph_it + 1 < ph_hi + N_REPEAT) { XcdBarrier xbar; xbar.bar = (unsigned*)(ws + WS_BAR); xbar.x = xb_xcc_id(); xbar.st = (volatile LAS unsigned*)(lds + LDS_MISC) + 8; xcd_barrier(xbar);
#ifdef SYNC2
            xcd_barrier(xbar);
#endif
        }
#ifdef PROBE_PH
        if (bid == 0 && tid == 0) { unsigned long long* ts = (unsigned long long*)(ws + WS_BD + 768 * 1024); ts[ph + 1] = __builtin_amdgcn_s_memrealtime(); if (ph == 0) ts[0] = t_start;
            if (ph + 1 == ph_hi) { OUT[0] = (float)(ts[PROBE_PH + 1] - ts[PROBE_PH]) * 0.01f; } }
#endif
    }
}

#ifndef MK_MULTI
#define MK_MULTI 0
#endif
extern "C" void kernel_launch(void* const* d_in, const int* in_sizes, int n_in, void* d_out, int out_size, void* d_ws, size_t ws_size, hipStream_t stream) {
    static int grid = 0;
    if (grid == 0) {
        if (n_in != 17 || out_size != mk::M * mk::D || ws_size < mk::WS_END) { fprintf(stderr, "kernel_launch: unexpected shapes n_in %d out %d ws %zu (need %zu)\n", n_in, out_size, ws_size, (size_t)mk::WS_END); grid = -1; return; }
        int dev = 0, cus = 0, per_cu = 0;
        (void)hipGetDevice(&dev); (void)hipDeviceGetAttribute(&cus, hipDeviceAttributeMultiprocessorCount, dev);
        if (hipFuncSetAttribute((const void*)fwd_mega, hipFuncAttributeMaxDynamicSharedMemorySize, mk::LDS_BYTES) != hipSuccess) { fprintf(stderr, "kernel_launch: hipFuncSetAttribute failed\n"); grid = -1; return; }
        if (hipOccupancyMaxActiveBlocksPerMultiprocessor(&per_cu, (const void*)fwd_mega, 512, mk::LDS_BYTES) != hipSuccess || per_cu < 1) { fprintf(stderr, "kernel_launch: occupancy query gave %d\n", per_cu); per_cu = 1; }
        (void)hipGetLastError();
        if (cus <= 0) cus = 256;
        grid = cus * per_cu; if (grid > 256) grid = 256;
        fprintf(stderr, "kernel_launch: cus %d per_cu %d grid %d\n", cus, per_cu, grid);
    }
    if (grid < 0) return;
    if (hipMemsetAsync((char*)d_ws + mk::WS_BAR, 0, mk::BAR_BYTES, stream) != hipSuccess) { fprintf(stderr, "kernel_launch: memset failed\n"); return; }
    Params p{};
    for (int i = 0; i < 17; ++i) p.in[i] = (const float*)d_in[i];
    p.out = (float*)d_out; p.ws = (unsigned char*)d_ws;
#if MK_MULTI
    for (int ph = 0; ph < N_PHASES; ++ph) { p.ph_lo = ph; p.ph_hi = ph + 1; hipLaunchKernelGGL(fwd_mega, dim3(grid), dim3(512), mk::LDS_BYTES, stream, p); }
#else
    p.ph_lo = 0; p.ph_hi = N_PHASES;
    void* args[] = {&p};
    const hipError_t e = hipLaunchCooperativeKernel((const void*)fwd_mega, dim3(grid), dim3(512), args, mk::LDS_BYTES, stream);
    if (e != hipSuccess) fprintf(stderr, "kernel_launch: cooperative launch failed: %s (grid %d)\n", hipGetErrorString(e), grid);
#endif
}
```

```cpp
#include <hip/hip_runtime.h>
#include <hip/hip_cooperative_groups.h>
#include <hip/hip_bf16.h>
#include <cstdio>
#include <cstdint>
#include <cmath>
namespace cg = cooperative_groups;
__device__ __forceinline__ int mk_tid();
namespace pg8 {
#define PG8_LAS __attribute__((address_space(3)))
typedef unsigned short bf16_t;
typedef short bf16x8 __attribute__((ext_vector_type(8)));
typedef float f32x4 __attribute__((ext_vector_type(4)));
typedef unsigned u32x4 __attribute__((ext_vector_type(4)));
constexpr int BM = 256, BK = 64, HALF = 128, HTB = HALF * BK * 2  , STAGE_BYTES = 8 * HTB, NXCD = 8, WGM = 8;

__host__ __device__ __forceinline__ int lds_byte(int r, int c) { const int st = (r >> 4) * 2 + (c >> 5), rr = r & 15, cc = c & 31, ob = rr * 64 + cc * 2; return st * 1024 + (ob ^ (((ob >> 9) & 1) << 5)); }
__host__ __device__ __forceinline__ void stage_rc(int b, int& R, int& C) { const int st = b / 1024, sb = b % 1024, swz = sb ^ (((sb >> 9) & 1) << 5); R = (st >> 1) * 16 + swz / 64; C = (st & 1) * 32 + (swz % 64) / 2; }
__host__ __device__ __forceinline__ int perm32(int rho) { const int n = rho >> 4, i = rho & 15; return 8 * (i >> 2) + 4 * n + (i & 3); }

struct Unit { int pm, pn; };
struct Gemm { const bf16_t* A; const bf16_t* Bt; int M, N, K; };

struct StaticOrder {
    int nM, nN, nwg, G, c;
    __host__ __device__ void init(int M, int N, int G_, int c_) { nM = M / BM; nN = N / BM; nwg = nM * nN; G = G_; c = c_; }
    __host__ __device__ bool next(int i, Unit& u) const {
        const long L = (long)i * G + c; if (L >= nwg) return false;
        int wgid = (int)L; { const int q = nwg / NXCD, r = nwg % NXCD, xcd = wgid % NXCD, off = wgid / NXCD; wgid = (xcd < r ? xcd * (q + 1) : r * (q + 1) + (xcd - r) * q) + off; }
        const int nig = WGM * nN, gid = wgid / nig, fm = gid * WGM, gsz = (nM - fm) < WGM ? (nM - fm) : WGM;
        u.pm = fm + ((wgid % nig) % gsz); u.pn = (wgid % nig) / gsz; return true;
    }
    __device__ __forceinline__ void a_ready(const Unit&) const {}
    __device__ __forceinline__ void done(const Unit&) const {}
};

__device__ __forceinline__ unsigned cvt_pk_bf16(float lo, float hi) { unsigned r; asm volatile("v_cvt_pk_bf16_f32 %0, %1, %2" : "=v"(r) : "v"(lo), "v"(hi)); return r; }
typedef float f32x2 __attribute__((ext_vector_type(2)));
__device__ __forceinline__ f32x2 gelu_pk(f32x2 v) {
    const f32x2 av = __builtin_elementwise_abs(v), d = av * 0.2316418882f + 1.0f;
    f32x2 t; t.x = __builtin_amdgcn_rcpf(d.x); t.y = __builtin_amdgcn_rcpf(d.y);
    f32x2 q = t * 0.5307027145f + (-0.7265760135f); q = q * t + 0.7107068705f; q = q * t + (-0.142248368f); q = q * t + 0.127414796f; q = q * t;
    const f32x2 s = (v * v) * (-0.72134752044f);
    f32x2 e; e.x = __builtin_amdgcn_exp2f(s.x); e.y = __builtin_amdgcn_exp2f(s.y);
    const f32x2 m = v * (q * e), r = v - m;
    f32x2 o; o.x = v.x < 0.f ? m.x : r.x; o.y = v.y < 0.f ? m.y : r.y; return o;
}

template <int ACT  > struct EpiBf16 {
    static constexpr bool PERM = true, AFTER_DRAIN = false; static_assert(ACT == 0 || ACT == 1, "EpiBf16: ACT is 0 (none) or 1 (gelu_pk)");
    bf16_t* O; int ldc; const float* bias; int split_cols; size_t split_stride; float scale0;
    __device__ __forceinline__ void operator()(const f32x4 (&acc)[2][2][4][2], const Unit& u, int wr, int wc, int fr, int fq) const {
        const int row0 = u.pm * BM + wr * 64 + fr; int colt = u.pn * BM; bf16_t* base = O;
        float sc = 1.f; if (split_cols) { const int t = colt / split_cols; base += (size_t)t * split_stride; colt -= t * split_cols; if (t == 0) sc = scale0; }
        const int col0 = colt + wc * 32 + 8 * fq, bcol0 = u.pn * BM + wc * 32 + 8 * fq;
        f32x4 bv[2][2];
#pragma unroll
        for (int bj = 0; bj < 2; ++bj)
#pragma unroll
            for (int n = 0; n < 2; ++n) bv[bj][n] = bias ? *(const f32x4*)(bias + bcol0 + bj * HALF + 4 * n) : (f32x4){0.f, 0.f, 0.f, 0.f};
#pragma unroll
        for (int ai = 0; ai < 2; ++ai)
#pragma unroll
            for (int m = 0; m < 4; ++m) { bf16_t* rowp = base + (size_t)(row0 + ai * HALF + m * 16) * ldc + col0;
#pragma unroll
                for (int bj = 0; bj < 2; ++bj) { f32x4 v0 = acc[ai][bj][m][0] + bv[bj][0], v1 = acc[ai][bj][m][1] + bv[bj][1];
                    if (ACT == 1) { f32x2 a = gelu_pk((f32x2){v0[0], v0[1]}), b = gelu_pk((f32x2){v0[2], v0[3]}), c = gelu_pk((f32x2){v1[0], v1[1]}), d = gelu_pk((f32x2){v1[2], v1[3]});
                        v0 = (f32x4){a.x, a.y, b.x, b.y}; v1 = (f32x4){c.x, c.y, d.x, d.y}; }
                    v0 = v0 * sc; v1 = v1 * sc; u32x4 w; w.x = cvt_pk_bf16(v0[0], v0[1]); w.y = cvt_pk_bf16(v0[2], v0[3]); w.z = cvt_pk_bf16(v1[0], v1[1]); w.w = cvt_pk_bf16(v1[2], v1[3]);
                    *(u32x4*)(rowp + bj * HALF) = w; } }
    }
};

template <class Epi, class Sched, bool ALIGN_EPI = false, bool SP2 = false>
__device__ __forceinline__ void gemm_phase(PG8_LAS unsigned char* lds, const Gemm g, const Sched& S, const Epi& E) {
    const int tid = mk_tid(), wid = __builtin_amdgcn_readfirstlane(tid >> 6), lane = tid & 63, wr = wid >> 2, wc = wid & 3, fr = lane & 15, fq = lane >> 4;
    const int K = g.K, nt = K / BK;
    unsigned voffA[2], voffB[2];
#pragma unroll
    for (int i = 0; i < 2; ++i) { int R, C; stage_rc(tid * 16 + i * 8192, R, C); const int Rb = Epi::PERM ? ((R & ~31) + perm32(R & 31)) : R;
        voffA[i] = (unsigned)(R * K + C) * 2u; voffB[i] = (unsigned)(Rb * K + C) * 2u; }
    const size_t kstep = (size_t)(BK * 2);
    const size_t hstep = (size_t)HALF * K * 2;
    const size_t tstep = 2 * hstep;
    const unsigned ldsw = (unsigned)wid * 1024u;
    const int aoff = lds_byte(wr * 64 + fr, fq * 8), boff = lds_byte(wc * 32 + fr, fq * 8);
#define PG8_SA(b, h) (((b) * 2 + (h)) * HTB)
#define PG8_SB(b, h) ((4 + (b) * 2 + (h)) * HTB)
#define PG8_STAGE(bufoff, gbase, voff) do { _Pragma("unroll") for (int _i = 0; _i < 2; ++_i) \
        __builtin_amdgcn_global_load_lds((const unsigned*)((const char*)(gbase) + (voff)[_i]), (PG8_LAS unsigned*)(lds + (bufoff) + ldsw + _i * 8192), 16, 0, 0); } while (0)
#define PG8_LDA(dst, b, h) do { _Pragma("unroll") for (int m = 0; m < 4; ++m) _Pragma("unroll") for (int k = 0; k < 2; ++k) dst[m][k] = *(const PG8_LAS bf16x8*)(lds + PG8_SA(b, h) + aoff + m * 2048 + k * 1024); } while (0)
#define PG8_LDB(dst, b, h) do { _Pragma("unroll") for (int n = 0; n < 2; ++n) _Pragma("unroll") for (int k = 0; k < 2; ++k) dst[n][k] = *(const PG8_LAS bf16x8*)(lds + PG8_SB(b, h) + boff + n * 2048 + k * 1024); } while (0)
#define PG8_MMA(ai, bj, At, Bt) do { __builtin_amdgcn_s_setprio(1); _Pragma("unroll") for (int m = 0; m < 4; ++m) _Pragma("unroll") for (int n = 0; n < 2; ++n) _Pragma("unroll") for (int k = 0; k < 2; ++k) \
        acc[ai][bj][m][n] = __builtin_amdgcn_mfma_f32_16x16x32_bf16(Bt[n][k], At[m][k], acc[ai][bj][m][n], 0, 0, 0); __builtin_amdgcn_s_setprio(0); } while (0)
#define PG8_WAIT_V(n) asm volatile("s_waitcnt vmcnt(" #n ")" ::: "memory")
#define PG8_WAIT_L(n) asm volatile("s_waitcnt lgkmcnt(" #n ")" ::: "memory")
#define PG8_BAR __builtin_amdgcn_s_barrier()
#define PG8_SCHED __builtin_amdgcn_sched_barrier(0)
    Unit cur, nxt; int ui = 0;
    if (!S.next(0, cur)) return;
    f32x4 acc[2][2][4][2];
#pragma unroll
    for (int a = 0; a < 2; ++a)
#pragma unroll
        for (int b = 0; b < 2; ++b)
#pragma unroll
            for (int m = 0; m < 4; ++m)
#pragma unroll
                for (int n = 0; n < 2; ++n) acc[a][b][m][n] = (f32x4){0.f, 0.f, 0.f, 0.f};
    bf16x8 At[4][2], B0[2][2], B1[2][2];
    const char* cA = (const char*)g.A + (size_t)cur.pm * tstep; const char* cB = (const char*)g.Bt + (size_t)cur.pn * tstep;
    S.a_ready(cur);
    if constexpr (SP2) {
        PG8_STAGE(PG8_SB(0, 0), cB, voffB); PG8_STAGE(PG8_SB(0, 1), cB + hstep, voffB); PG8_STAGE(PG8_SA(0, 0), cA, voffA); PG8_STAGE(PG8_SA(0, 1), cA + hstep, voffA);
        if (wr == 1) PG8_BAR;
        PG8_WAIT_V(2); PG8_BAR;
        PG8_STAGE(PG8_SB(1, 0), cB + kstep, voffB); PG8_STAGE(PG8_SA(1, 0), cA + kstep, voffA); PG8_STAGE(PG8_SB(1, 1), cB + hstep + kstep, voffB);
        PG8_WAIT_V(6); PG8_BAR;
    } else {
        PG8_STAGE(PG8_SB(0, 0), cB, voffB); PG8_STAGE(PG8_SA(0, 0), cA, voffA); PG8_STAGE(PG8_SB(0, 1), cB + hstep, voffB); PG8_STAGE(PG8_SA(0, 1), cA + hstep, voffA);
        if (wr == 1) PG8_BAR;
        PG8_WAIT_V(4); PG8_BAR;
        PG8_STAGE(PG8_SB(1, 0), cB + kstep, voffB); PG8_STAGE(PG8_SA(1, 0), cA + kstep, voffA); PG8_STAGE(PG8_SB(1, 1), cB + hstep + kstep, voffB);
        PG8_WAIT_V(6); PG8_BAR;
    }
    for (;;) {
        const bool has_next = S.next(ui + 1, nxt);
        const char* nA = has_next ? (const char*)g.A + (size_t)nxt.pm * tstep : cA; const char* nB = has_next ? (const char*)g.Bt + (size_t)nxt.pn * tstep : cB;
        for (int t = 0; t < nt; t += 2) {
            const bool last = (t == nt - 2);
            const char* a1 = cA + (size_t)(t + 1) * kstep;
            const char* a2 = last ? nA : cA + (size_t)(t + 2) * kstep; const char* b2 = last ? nB : cB + (size_t)(t + 2) * kstep;
            const char* a3 = a2 + kstep; const char* b3 = b2 + kstep;
            if (last && has_next) S.a_ready(nxt);
            if constexpr (SP2) {
            PG8_LDB(B0, 0, 0); PG8_LDB(B1, 0, 1); PG8_SCHED; PG8_LDA(At, 0, 0); PG8_STAGE(PG8_SA(1, 1), a1 + hstep, voffA);
            PG8_WAIT_V(8); PG8_WAIT_L(0); PG8_BAR; PG8_MMA(0, 0, At, B0); PG8_MMA(0, 1, At, B1); PG8_BAR; PG8_SCHED;
            PG8_LDA(At, 0, 1); PG8_STAGE(PG8_SB(0, 0), b2, voffB); PG8_STAGE(PG8_SB(0, 1), b2 + hstep, voffB); PG8_STAGE(PG8_SA(0, 0), a2, voffA);
            PG8_WAIT_V(8); PG8_WAIT_L(0); PG8_BAR; PG8_MMA(1, 0, At, B0); PG8_MMA(1, 1, At, B1); PG8_BAR; PG8_SCHED;
            PG8_LDB(B0, 1, 0); PG8_LDB(B1, 1, 1); PG8_SCHED; PG8_LDA(At, 1, 0); PG8_STAGE(PG8_SA(0, 1), a2 + hstep, voffA);
            PG8_WAIT_V(8); PG8_WAIT_L(0); PG8_BAR; PG8_MMA(0, 0, At, B0); PG8_MMA(0, 1, At, B1); PG8_BAR; PG8_SCHED;
            PG8_LDA(At, 1, 1); PG8_STAGE(PG8_SB(1, 0), b3, voffB); PG8_STAGE(PG8_SB(1, 1), b3 + hstep, voffB); PG8_STAGE(PG8_SA(1, 0), a3, voffA);
            PG8_WAIT_V(8); PG8_WAIT_L(0); PG8_BAR; PG8_MMA(1, 0, At, B0); PG8_MMA(1, 1, At, B1); PG8_BAR; PG8_SCHED;
            } else {
            PG8_LDB(B0, 0, 0); PG8_SCHED; PG8_LDA(At, 0, 0); PG8_STAGE(PG8_SA(1, 1), a1 + hstep, voffA);
            PG8_WAIT_L(8); PG8_BAR; PG8_WAIT_L(0); PG8_MMA(0, 0, At, B0); PG8_BAR; PG8_SCHED;
            PG8_LDB(B1, 0, 1); PG8_STAGE(PG8_SB(0, 0), b2, voffB);
            PG8_BAR; PG8_WAIT_L(0); PG8_MMA(0, 1, At, B1); PG8_BAR;
            PG8_LDA(At, 0, 1); PG8_STAGE(PG8_SA(0, 0), a2, voffA);
            PG8_BAR; PG8_WAIT_L(0); PG8_MMA(1, 0, At, B0); PG8_BAR; PG8_SCHED;
            PG8_STAGE(PG8_SB(0, 1), b2 + hstep, voffB);
            PG8_WAIT_V(6); PG8_BAR; PG8_MMA(1, 1, At, B1); PG8_BAR;
            PG8_LDB(B0, 1, 0); PG8_SCHED; PG8_LDA(At, 1, 0); PG8_STAGE(PG8_SA(0, 1), a2 + hstep, voffA);
            PG8_WAIT_L(8); PG8_BAR; PG8_WAIT_L(0); PG8_MMA(0, 0, At, B0); PG8_BAR; PG8_SCHED;
            PG8_LDB(B1, 1, 1); PG8_STAGE(PG8_SB(1, 0), b3, voffB);
            PG8_BAR; PG8_WAIT_L(0); PG8_MMA(0, 1, At, B1); PG8_BAR;
            PG8_LDA(At, 1, 1); PG8_STAGE(PG8_SA(1, 0), a3, voffA);
            PG8_BAR; PG8_WAIT_L(0); PG8_MMA(1, 0, At, B0); PG8_BAR; PG8_SCHED;
            PG8_STAGE(PG8_SB(1, 1), b3 + hstep, voffB);
            PG8_WAIT_V(6); PG8_BAR; PG8_MMA(1, 1, At, B1); PG8_BAR;
            }
        }
        if constexpr (ALIGN_EPI) { if (wr == 0) PG8_BAR; }
        if constexpr (!Epi::AFTER_DRAIN) { E(acc, cur, wr, wc, fr, fq); S.done(cur); }
        if (!has_next) break;
#pragma unroll
        for (int a = 0; a < 2; ++a)
#pragma unroll
            for (int b = 0; b < 2; ++b)
#pragma unroll
                for (int m = 0; m < 4; ++m)
#pragma unroll
                    for (int n = 0; n < 2; ++n) acc[a][b][m][n] = (f32x4){0.f, 0.f, 0.f, 0.f};
        cur = nxt; cA = nA; cB = nB; ++ui;
        if constexpr (ALIGN_EPI) { if (wr == 1) PG8_BAR; }
    }
    PG8_WAIT_V(0);
    if constexpr (!ALIGN_EPI) { if (wr == 0) PG8_BAR; }
    PG8_BAR;
    if constexpr (Epi::AFTER_DRAIN) { E.fused(acc, cur, wr, wc, fr, fq, lds, wid, lane); S.done(cur); }
#undef PG8_SA
#undef PG8_SB
#undef PG8_STAGE
#undef PG8_LDA
#undef PG8_LDB
#undef PG8_MMA
#undef PG8_WAIT_V
#undef PG8_WAIT_L
#undef PG8_BAR
#undef PG8_SCHED
}
}

namespace att {
using bf16 = __hip_bfloat16;
constexpr int   D = 128, NW = 8, QBLK = 32, KVBLK = 64;
constexpr float SCALE = 0.088388347648318440f;
constexpr float THR = 8.f;
constexpr int SDEPTH = 2;
constexpr int LDQ = 3072, LDK = 3072, LDO = 2048;
constexpr size_t SHM_V = KVBLK * D * 2, SHM_K = KVBLK * D * 2, SHM_ATTN = 2 * SHM_V + 2 * SHM_K + NW * 64 * 4;
using bf16x8 = __attribute__((ext_vector_type(8))) short;
using s16x4  = __attribute__((ext_vector_type(4))) short;
using f32x16 = __attribute__((ext_vector_type(16))) float;
using f32x8  = __attribute__((ext_vector_type(8))) float;
using u32x4  = __attribute__((ext_vector_type(4))) unsigned;
#define KSWZ(row, colB) ((row) * 256 + ((colB) ^ (((row) & 7) << 4)))
#define SBAR() __builtin_amdgcn_sched_barrier(0)
__device__ __forceinline__ int crow(int r, int hi) { return (r & 3) + 8 * (r >> 2) + 4 * hi; }
__device__ __forceinline__ unsigned cvtpk(float lo, float hi) {
  unsigned r; asm volatile("v_cvt_pk_bf16_f32 %0, %1, %2" : "=v"(r) : "v"(lo), "v"(hi)); return r;
}
template <typename TIn> struct Stage;
template <> struct Stage<bf16>  { using T = bf16x8;
  __device__ static __forceinline__ T ld8(const bf16* p) { return *reinterpret_cast<const bf16x8*>(p); }
  __device__ static __forceinline__ bf16x8 tobf(T x) { return x; } };
template <> struct Stage<float> { using T = f32x8;
  __device__ static __forceinline__ T ld8(const float* p) { return *reinterpret_cast<const f32x8*>(p); }
  __device__ static __forceinline__ bf16x8 tobf(T x) {
    u32x4 w = {cvtpk(x[0], x[1]), cvtpk(x[2], x[3]), cvtpk(x[4], x[5]), cvtpk(x[6], x[7])}; return *reinterpret_cast<bf16x8*>(&w); } };

__device__ __forceinline__ void partialSM(f32x16& p0, f32x16& p1, float& m_reg, float& mn, float& alpha) {
  constexpr float C = SCALE * 1.4426950408889634f;
  float pmax = p0[0]; for (int r = 1; r < 16; ++r) pmax = fmaxf(pmax, p0[r]); for (int r = 0; r < 16; ++r) pmax = fmaxf(pmax, p1[r]);
  { auto rr = __builtin_amdgcn_permlane32_swap(__float_as_uint(pmax), __float_as_uint(pmax), false, false);
    pmax = fmaxf(__uint_as_float(rr[0]), __uint_as_float(rr[1])); }
  if (__builtin_expect(__all(pmax - m_reg <= THR / SCALE), 1)) { mn = m_reg; alpha = 1.f; }
  else { mn = fmaxf(m_reg, pmax); alpha = __builtin_amdgcn_exp2f((m_reg - mn) * C); m_reg = mn; }
  float mnC = -mn * C;
  for (int r = 0; r < 16; ++r) p0[r] = fmaf(p0[r], C, mnC); for (int r = 0; r < 16; ++r) p1[r] = fmaf(p1[r], C, mnC);
  for (int r = 0; r < 16; ++r) p0[r] = __builtin_amdgcn_exp2f(p0[r]);
}
__device__ __forceinline__ void finishSM(f32x16& p0, f32x16& p1, float alpha, float& l_reg, bf16x8& pa0, bf16x8& pa1, bf16x8& pa2, bf16x8& pa3) {
  for (int r = 0; r < 16; ++r) p1[r] = __builtin_amdgcn_exp2f(p1[r]);
  float ps = 0; for (int r = 0; r < 16; ++r) ps += p0[r]; for (int r = 0; r < 16; ++r) ps += p1[r];
  { auto rr = __builtin_amdgcn_permlane32_swap(__float_as_uint(ps), __float_as_uint(ps), false, false);
    ps = __uint_as_float(rr[0]) + __uint_as_float(rr[1]); }
  l_reg = l_reg * alpha + ps;
#define PK4(P, BASE, OUT) do { unsigned a0 = cvtpk(P[BASE + 0], P[BASE + 1]), a1 = cvtpk(P[BASE + 2], P[BASE + 3]);   \
    unsigned b0 = cvtpk(P[BASE + 4], P[BASE + 5]), b1 = cvtpk(P[BASE + 6], P[BASE + 7]);                              \
    auto r0 = __builtin_amdgcn_permlane32_swap(a0, b0, false, false); auto r1 = __builtin_amdgcn_permlane32_swap(a1, b1, false, false); \
    u32x4 w = {r0[0], r1[0], r0[1], r1[1]}; OUT = *reinterpret_cast<bf16x8*>(&w); } while (0)
  PK4(p0, 0, pa0); PK4(p0, 8, pa1); PK4(p1, 0, pa2); PK4(p1, 8, pa3);
#undef PK4
}
__device__ __forceinline__ void qkt(f32x16& p0, f32x16& p1, const bf16* Ks, const bf16x8* qr, int r32, int hi) {
  p0 = f32x16{}; p1 = f32x16{};
  for (int d0 = 0; d0 < 8; ++d0) { int cb = (d0 * 16 + hi * 8) * 2;
    bf16x8 b0 = *reinterpret_cast<const bf16x8*>((const char*)Ks + KSWZ(r32, cb));
    bf16x8 b1 = *reinterpret_cast<const bf16x8*>((const char*)Ks + KSWZ(32 + r32, cb));
    p0 = __builtin_amdgcn_mfma_f32_32x32x16_bf16(b0, qr[d0], p0, 0, 0, 0);
    p1 = __builtin_amdgcn_mfma_f32_32x32x16_bf16(b1, qr[d0], p1, 0, 0, 0); }
}
__device__ __forceinline__ int v_st(int k, int c) { const int kk = (k & ~0xC) | ((k & 4) << 1) | ((k & 8) >> 1); return ((kk >> 3) * 4 + (c >> 5)) * 512 + ((kk & 7) * 32 + (c & 31)) * 2; }
__device__ __forceinline__ int v_rd_base(int lane) { return ((lane & 3) << 3) | (((lane >> 2) & 3) << 6) | (((lane >> 4) & 1) << 5) | (((lane >> 5) & 1) << 8); }
constexpr int v_rd_off(int d0, int ks, int half) { return d0 * 512 + ks * 4096 + half * 2048; }
template <int OFF> __device__ __forceinline__ s16x4 tr_read(int vb) {
  s16x4 r; asm volatile("ds_read_b64_tr_b16 %0, %1 offset:%2" : "=&v"(r) : "v"(vb), "i"(OFF) : "memory"); return r;
}
template <int D0> __device__ __forceinline__ void pv_one(f32x16& od, int vb, bf16x8 pa0, bf16x8 pa1, bf16x8 pa2, bf16x8 pa3) {
  const s16x4 l0 = tr_read<v_rd_off(D0, 0, 0)>(vb), h0 = tr_read<v_rd_off(D0, 0, 1)>(vb), l1 = tr_read<v_rd_off(D0, 1, 0)>(vb), h1 = tr_read<v_rd_off(D0, 1, 1)>(vb);
  const s16x4 l2 = tr_read<v_rd_off(D0, 2, 0)>(vb), h2 = tr_read<v_rd_off(D0, 2, 1)>(vb), l3 = tr_read<v_rd_off(D0, 3, 0)>(vb), h3 = tr_read<v_rd_off(D0, 3, 1)>(vb);
  asm volatile("s_waitcnt lgkmcnt(0)" ::: "memory"); SBAR();
#define PK(L, H) (bf16x8){L[0], L[1], L[2], L[3], H[0], H[1], H[2], H[3]}
  od = __builtin_amdgcn_mfma_f32_32x32x16_bf16(pa0, PK(l0, h0), od, 0, 0, 0);
  od = __builtin_amdgcn_mfma_f32_32x32x16_bf16(pa1, PK(l1, h1), od, 0, 0, 0);
  od = __builtin_amdgcn_mfma_f32_32x32x16_bf16(pa2, PK(l2, h2), od, 0, 0, 0);
  od = __builtin_amdgcn_mfma_f32_32x32x16_bf16(pa3, PK(l3, h3), od, 0, 0, 0);
#undef PK
}
__device__ __forceinline__ void pv_d0(f32x16* o, int vb, bf16x8 pa0, bf16x8 pa1, bf16x8 pa2, bf16x8 pa3) {
  pv_one<0>(o[0], vb, pa0, pa1, pa2, pa3); pv_one<1>(o[1], vb, pa0, pa1, pa2, pa3); pv_one<2>(o[2], vb, pa0, pa1, pa2, pa3); pv_one<3>(o[3], vb, pa0, pa1, pa2, pa3);
}

template <typename TQ>
__device__ __forceinline__ void attn_dense_body(const TQ* __restrict__ Qb, const bf16* __restrict__ Kh, const bf16* __restrict__ Vh,
                                                unsigned short* __restrict__ Ob, int seq, char* lds) {
  using St = Stage<bf16>; using SQ = Stage<TQ>;
  const int tid = mk_tid(), wid = tid >> 6, lane = tid & 63, r32 = lane & 31, hi = lane >> 5;
  bf16* V_lds = (bf16*)lds; bf16* K_lds = (bf16*)(lds + 2 * SHM_V);
  float* ws = (float*)(lds + 2 * SHM_V + 2 * SHM_K) + wid * 64; float* li_l = ws; float* al_l = ws + 32;
  float m_reg = -1e30f, l_reg = 0; f32x16 o[4] = {}; bf16x8 qr[8];
  const TQ* Qw = Qb + (long)(wid * QBLK + r32) * LDQ + hi * 8;
#pragma unroll
  for (int d0 = 0; d0 < 8; ++d0) qr[d0] = SQ::tobf(SQ::ld8(Qw + d0 * 16));
  const int sr = tid >> 4, sc = (tid & 15) * 8, vst0 = v_st(sr, sc), vst1 = v_st(32 + sr, sc);
  const int vb0 = (int)(uintptr_t)V_lds + v_rd_base(lane);
  struct { typename St::T vs0, vs1, ks0, ks1; } sr_[SDEPTH];
#define SLOAD(i, k0) do { sr_[i].vs0 = St::ld8(&Vh[(long)((k0) + sr) * LDK + sc]); sr_[i].vs1 = St::ld8(&Vh[(long)((k0) + 32 + sr) * LDK + sc]); \
    sr_[i].ks0 = St::ld8(&Kh[(long)((k0) + sr) * LDK + sc]); sr_[i].ks1 = St::ld8(&Kh[(long)((k0) + 32 + sr) * LDK + sc]); } while (0)
#define SWRITE(b, i) do { *(bf16x8*)((char*)V_lds + (b) * SHM_V + vst0) = St::tobf(sr_[i].vs0);          \
    *(bf16x8*)((char*)V_lds + (b) * SHM_V + vst1) = St::tobf(sr_[i].vs1); int kc = sc * 2;               \
    *(bf16x8*)((char*)K_lds + (b) * SHM_K + KSWZ(sr, kc)) = St::tobf(sr_[i].ks0);                       \
    *(bf16x8*)((char*)K_lds + (b) * SHM_K + KSWZ(32 + sr, kc)) = St::tobf(sr_[i].ks1); } while (0)
#define SWAIT() do { if constexpr (SDEPTH == 2) asm volatile("s_waitcnt vmcnt(4)" ::: "memory"); else asm volatile("s_waitcnt vmcnt(0)" ::: "memory"); } while (0)
#define RESC(a) do { if (__any((a) < 1.f)) { if (hi == 0) al_l[r32] = (a); asm volatile("s_waitcnt lgkmcnt(0)" ::: "memory"); \
    for (int d = 0; d < 4; ++d) for (int r = 0; r < 16; ++r) o[d][r] *= al_l[crow(r, hi)]; } } while (0)
  f32x16 pA0, pA1, pB0, pB1; float mnA, mnB, alA, alB; bf16x8 pa0, pa1, pa2, pa3; const int NT = seq / KVBLK;
  constexpr int SE = 0, SO = SDEPTH - 1;
  SLOAD(SE, 0); asm volatile("s_waitcnt vmcnt(0)" ::: "memory"); SWRITE(0, SE); __syncthreads();
  qkt(pA0, pA1, K_lds, qr, r32, hi); partialSM(pA0, pA1, m_reg, mnA, alA);
  SLOAD(SO, KVBLK); if constexpr (SDEPTH == 2) { if (2 < NT) SLOAD(SE, 2 * KVBLK); }
  SWAIT(); SWRITE(1, SO); __syncthreads();
  for (int j = 1; j + 1 < NT; j += 2) {
    SBAR(); qkt(pB0, pB1, (bf16*)((char*)K_lds + SHM_K), qr, r32, hi);
    finishSM(pA0, pA1, alA, l_reg, pa0, pa1, pa2, pa3); SBAR();
    SLOAD(SO, (j + SDEPTH) * KVBLK); SBAR();
    pv_d0(o, vb0, pa0, pa1, pa2, pa3); partialSM(pB0, pB1, m_reg, mnB, alB);
    __syncthreads(); SWAIT(); SWRITE(0, SE);
    RESC(alB); __syncthreads();
    SBAR(); qkt(pA0, pA1, K_lds, qr, r32, hi);
    finishSM(pB0, pB1, alB, l_reg, pa0, pa1, pa2, pa3); SBAR();
    if (SDEPTH == 1 || j + 3 < NT) SLOAD(SE, (j + 1 + SDEPTH) * KVBLK); SBAR();
    pv_d0(o, vb0 + (int)SHM_V, pa0, pa1, pa2, pa3); partialSM(pA0, pA1, m_reg, mnA, alA);
    __syncthreads(); SWAIT(); SWRITE(1, SO);
    RESC(alA); __syncthreads();
  }
  SBAR(); qkt(pB0, pB1, (bf16*)((char*)K_lds + SHM_K), qr, r32, hi);
  finishSM(pA0, pA1, alA, l_reg, pa0, pa1, pa2, pa3); SBAR();
  pv_d0(o, vb0, pa0, pa1, pa2, pa3); partialSM(pB0, pB1, m_reg, mnB, alB);
  __syncthreads(); RESC(alB);
  finishSM(pB0, pB1, alB, l_reg, pa0, pa1, pa2, pa3); SBAR();
  pv_d0(o, vb0 + (int)SHM_V, pa0, pa1, pa2, pa3);
  if (hi == 0) li_l[r32] = l_reg; asm volatile("s_waitcnt lgkmcnt(0)" ::: "memory");
  float rli[16];
#pragma unroll
  for (int r = 0; r < 16; ++r) rli[r] = __builtin_amdgcn_rcpf(li_l[crow(r, hi)]);
  unsigned short* Ow = Ob + (long)(wid * QBLK) * LDO;
#pragma unroll
  for (int r = 0; r < 16; ++r) { int orow = crow(r, hi);
    for (int d0 = 0; d0 < 4; ++d0) Ow[(long)orow * LDO + d0 * 32 + r32] = (unsigned short)(cvtpk(o[d0][r] * rli[r], 0.f) & 0xffffu); }
#undef SLOAD
#undef SWRITE
#undef SWAIT
#undef RESC
}

}
__device__ __forceinline__ int mk_tid() { int t = threadIdx.x; asm volatile("" : "+v"(t)); return t; }
namespace mk {
#define LAS __attribute__((address_space(3)))
typedef unsigned short bf16;
typedef short bf16x8 __attribute__((ext_vector_type(8)));
typedef float f32x4 __attribute__((ext_vector_type(4)));
typedef unsigned u32x4 __attribute__((ext_vector_type(4)));
typedef unsigned u32x2 __attribute__((ext_vector_type(2)));
#define XB_TMO      128
#define XB_XCNT(j)  (256  + 64 * (j))
#define XB_XSUB(j)  (1280 + 64 * (j))
#define XB_XGEN(j)  (2304 + 64 * (j))
#define XB_TOP      3328
#define XB_TOPGEN   3392
#define XCD_BAR_WORDS 3456
#define XB_SPIN_CAP (1u << 18)

__device__ __forceinline__ unsigned xb_ld(unsigned* p)              { return __hip_atomic_load(p, __ATOMIC_RELAXED, __HIP_MEMORY_SCOPE_AGENT); }
__device__ __forceinline__ unsigned xb_add(unsigned* p, unsigned v) { return __hip_atomic_fetch_add(p, v, __ATOMIC_RELAXED, __HIP_MEMORY_SCOPE_AGENT); }
__device__ __forceinline__ unsigned xb_xcc_id() { return (unsigned)__builtin_amdgcn_s_getreg((3 << 11) | 20) & 0xFu; }
#define XB_SPIN(cond, bar) do { unsigned _sp = 0; while (cond) { __builtin_amdgcn_s_sleep(1); \
    if ((++_sp & 255u) == 0u) { if (xb_ld(&(bar)[XB_TMO])) break; if (_sp > XB_SPIN_CAP) { atomicAdd(&(bar)[XB_TMO], 1u); break; } } } } while (0)

struct XcdBarrier {
    unsigned* bar; unsigned x;
    volatile LAS unsigned* st;
};

__device__ __forceinline__ XcdBarrier xcd_barrier_post(unsigned* bar, volatile LAS unsigned* st) {
    XcdBarrier b; b.bar = bar; b.x = xb_xcc_id(); b.st = st;
    if (mk_tid() == 0) (void)xb_add(&bar[XB_XCNT(b.x)], 1u);
    return b;
}
__device__ __forceinline__ void xcd_barrier_complete(unsigned* bar, unsigned x, unsigned& nloc, unsigned& nx) {
    const unsigned G = gridDim.x * gridDim.y * gridDim.z;
    unsigned sum, cnt, mine, sp = 0u;
    for (;;) {
        sum = 0u; cnt = 0u; mine = 0u;
#pragma unroll
        for (unsigned j = 0; j < 16; ++j) { const unsigned c = xb_ld(&bar[XB_XCNT(j)]); sum += c; cnt += (c > 0u) ? 1u : 0u; mine = (j == x) ? c : mine; }
        if (sum == G) break;
        __builtin_amdgcn_s_sleep(1);
        if ((++sp & 255u) == 0u) { if (xb_ld(&bar[XB_TMO])) break; if (sp > XB_SPIN_CAP) { atomicAdd(&bar[XB_TMO], 1u); break; } }
    }
    nloc = mine > 0u ? mine : 1u; nx = cnt > 0u ? cnt : 1u;
}

__device__ __forceinline__ void xcd_barrier(const XcdBarrier& b) {
    asm volatile("s_waitcnt vmcnt(0)" ::: "memory");
    __syncthreads();
    if (mk_tid() == 0) {
        unsigned* bar = b.bar;
        __builtin_amdgcn_s_waitcnt(0);
        unsigned nloc = b.st[0], nx = b.st[1];
        if (nloc == 0u) { xcd_barrier_complete(bar, b.x, nloc, nx); b.st[0] = nloc; b.st[1] = nx; }
        const unsigned old = xb_add(&bar[XB_XSUB(b.x)], 1u);
        const unsigned gen = old / nloc;
        if (old + 1u == (gen + 1u) * nloc) {
            __builtin_amdgcn_fence(__ATOMIC_RELEASE, "agent");
            asm volatile("s_waitcnt vmcnt(0)" ::: "memory");
            const unsigned og = xb_add(&bar[XB_TOP], 1u);
            const unsigned tg = og / nx;
            if (og + 1u == (tg + 1u) * nx) xb_add(&bar[XB_TOPGEN], 1u);
            else XB_SPIN(xb_ld(&bar[XB_TOPGEN]) == tg, bar);
            __builtin_amdgcn_fence(__ATOMIC_ACQUIRE, "agent");
            xb_add(&bar[XB_XGEN(b.x)], 1u);
            asm volatile("s_waitcnt vmcnt(0)" ::: "memory");
        } else {
            XB_SPIN(xb_ld(&bar[XB_XGEN(b.x)]) == gen, bar);
            __builtin_amdgcn_fence(__ATOMIC_ACQUIRE, "agent");
            asm volatile("s_waitcnt vmcnt(0)" ::: "memory");
        }
    }
    __syncthreads();
}


constexpr int D = 2048, M = 8192, SEQ = 4096, NW = 8;
constexpr int ABW = 3072, CW = 8224, FF2 = 11264, FF = 5632;
constexpr float EPS = 1e-6f;
constexpr size_t MiB = 1u << 20;
constexpr size_t WS_AB = 0, WS_BD = 12 * MiB, WS_OAB = 13 * MiB, WS_C = 21 * MiB  , WS_OC = 54 * MiB;
constexpr size_t WS_UP0 = 62 * MiB, WS_UP1 = 106 * MiB, WS_DN0 = 150 * MiB, WS_DN1 = 172 * MiB;
constexpr size_t WS_XN = 194 * MiB, WS_GATES = 226 * MiB, WS_S = 228 * MiB;
constexpr size_t WS_PROJ = WS_S, WS_POOLED = WS_S + 48 * MiB, WS_CAT = WS_S + 56 * MiB;
constexpr size_t WS_QK = WS_S, WS_OG = WS_S + 64 * MiB, WS_KVT = WS_S + 96 * MiB, WS_HF = WS_S + 160 * MiB, WS_Y = WS_S + 288 * MiB;
constexpr size_t WS_U = WS_S, WS_ACT = WS_S + 176 * MiB;
constexpr size_t WS_END = WS_S + 320 * MiB;
constexpr int LDS_ML = 154112 + 1024, LDS_MISC = LDS_ML, LDS_BYTES = LDS_ML + 64;
constexpr size_t WS_BAR = WS_BD + 768 * 1024, BAR_BYTES = 16384;

#define LDSWAIT() asm volatile("s_waitcnt lgkmcnt(0)" ::: "memory")
__device__ __forceinline__ unsigned f2bf(float f) { unsigned u = __float_as_uint(f); return (u + 0x7fffu + ((u >> 16) & 1u)) >> 16; }
__device__ __forceinline__ unsigned pk2(float lo, float hi) { unsigned r; asm volatile("v_cvt_pk_bf16_f32 %0, %1, %2" : "=v"(r) : "v"(lo), "v"(hi)); return r; }
__device__ __forceinline__ float bflo(unsigned w) { return __uint_as_float(w << 16); }
__device__ __forceinline__ float bfhi(unsigned w) { return __uint_as_float(w & 0xffff0000u); }
__device__ __forceinline__ float wave_sum(float v) {
#pragma unroll
    for (int o = 1; o < 64; o <<= 1) v += __shfl_xor(v, o);
    return v;
}

__device__ __forceinline__ void transpose_item64(const float* __restrict__ W, int ldw, int K, int nblk, bf16* __restrict__ WT, LAS float* scr, int item, int lane, bool upperm) {
    const int kb = item / nblk, nb = item - kb * nblk, k0 = 64 * kb, n0 = 64 * nb;
    const int d0 = !upperm ? n0 : (n0 < FF ? 256 * (n0 >> 7) + (n0 & 127) : 256 * ((n0 - FF) >> 7) + 128 + ((n0 - FF) & 127));
    f32x4 v[16];
#pragma unroll
    for (int i = 0; i < 16; ++i) { const int kk = 4 * i + (lane >> 4); v[i] = *(const f32x4*)(W + (size_t)(k0 + kk) * ldw + n0 + 4 * (lane & 15)); }
#pragma unroll
    for (int i = 0; i < 16; ++i) { const int kk = 4 * i + (lane >> 4); LAS float* s = scr + kk * 65 + 4 * (lane & 15); s[0] = v[i].x; s[1] = v[i].y; s[2] = v[i].z; s[3] = v[i].w; }
    LDSWAIT();
    const int c = lane & 7, q = lane >> 3;
#pragma unroll
    for (int j = 0; j < 8; ++j) { const int n = q + 8 * j; const LAS float* s = scr + (8 * c) * 65 + n;
        u32x4 o; o.x = pk2(s[0], s[65]); o.y = pk2(s[130], s[195]); o.z = pk2(s[260], s[325]); o.w = pk2(s[390], s[455]);
        *(u32x4*)(WT + (size_t)(d0 + n) * K + k0 + 8 * c) = o; }
    LDSWAIT();
}

__device__ __forceinline__ void rmsnorm_rows(const float* __restrict__ src, const float* __restrict__ gain, bf16* __restrict__ dst, int gw, int ngw, int lane) {
    f32x4 g[8];
#pragma unroll
    for (int j = 0; j < 8; ++j) g[j] = *(const f32x4*)(gain + 4 * lane + 256 * j);
    for (int m = gw; m < M; m += ngw) {
        const f32x4* xr = (const f32x4*)(src + (size_t)m * D) + lane; f32x4 v[8]; float s = 0.f;
#pragma unroll
        for (int j = 0; j < 8; ++j) { v[j] = xr[64 * j]; s += (v[j].x * v[j].x + v[j].y * v[j].y) + (v[j].z * v[j].z + v[j].w * v[j].w); }
        const float rstd = 1.0f / sqrtf(wave_sum(s) * (1.0f / D) + EPS);
        u32x2* o = (u32x2*)(dst + (size_t)m * D) + lane;
#pragma unroll
        for (int j = 0; j < 8; ++j) { u32x2 w; w.x = pk2(v[j].x * rstd * g[j].x, v[j].y * rstd * g[j].y); w.y = pk2(v[j].z * rstd * g[j].z, v[j].w * rstd * g[j].w); o[64 * j] = w; }
    }
}

struct In { const float *x, *norm_mix, *norm_ffn, *w_in_ab, *pool_w, *pool_scale, *q_norm, *k_norm, *w_out_ab, *w_in_c, *b_gate, *h_norm, *w_out_c, *w_up, *conv_w, *conv_b, *w_down; };

__device__ __forceinline__ void transposes(const In& I, unsigned char* ws, LAS unsigned char* lds, int first, int last, int w, int nw, int wave, int lane) {
    LAS float* scr = (LAS float*)(lds + wave * 16640);
    for (int it = first + w; it < last; it += nw) {
        const float* W; int ldw, K, nblk; bf16* WT; int r = it;
        if (r < 1536) { W = I.w_in_ab; ldw = ABW; K = D; nblk = 48; WT = (bf16*)(ws + WS_AB); }
        else if (r < 2560) { r -= 1536; W = I.w_out_ab; ldw = D; K = D; nblk = 32; WT = (bf16*)(ws + WS_OAB); }
        else if (r < 6656) { r -= 2560; W = I.w_in_c; ldw = CW; K = D; nblk = 128; WT = (bf16*)(ws + WS_C); }
        else if (r < 7680) { r -= 6656; W = I.w_out_c; ldw = D; K = D; nblk = 32; WT = (bf16*)(ws + WS_OC); }
        else if (r < 13312) { r -= 7680; W = I.w_up; ldw = FF2; K = D; nblk = 176; WT = (bf16*)(ws + WS_UP0); }
        else if (r < 18944) { r -= 13312; W = I.w_up + (size_t)D * FF2; ldw = FF2; K = D; nblk = 176; WT = (bf16*)(ws + WS_UP1); }
        else if (r < 21760) { r -= 18944; W = I.w_down; ldw = D; K = FF; nblk = 32; WT = (bf16*)(ws + WS_DN0); }
        else { r -= 21760; W = I.w_down + (size_t)FF * D; ldw = D; K = FF; nblk = 32; WT = (bf16*)(ws + WS_DN1); }
        transpose_item64(W, ldw, K, nblk, WT, scr, r, lane, (it >= 7680 && it < 18944));
    }
}
__device__ __forceinline__ void prologue(const In& I, unsigned char* ws, LAS unsigned char* lds, int gw, int ngw, int wave, int lane) {
    transposes(I, ws, lds, 0, 1536, gw, ngw, wave, lane);
    const int gt = gw * 64 + lane, ngt = ngw * 64;
    { bf16* WG = (bf16*)(ws + WS_C) + (size_t)8192 * D;
      for (int idx = gt; idx < 32 * D; idx += ngt) { const int j = idx >> 11, k = idx & 2047; WG[idx] = (bf16)f2bf(I.w_in_c[(size_t)k * CW + 8192 + j]); } }
    { bf16* BD = (bf16*)(ws + WS_BD);
      for (int idx = gt; idx < 512 * 512; idx += ngt) { const int n = idx >> 9, k = idx & 511, gn = n >> 7, gk = k >> 7;
          const float v = (gn == gk) ? I.pool_w[(size_t)(gn * 128 + (k & 127)) * 128 + (n & 127)] * I.pool_scale[n] : 0.f; BD[idx] = (bf16)f2bf(v); } }
    rmsnorm_rows(I.x, I.norm_mix, (bf16*)(ws + WS_XN), gw, ngw, lane);
}

__device__ __forceinline__ void qk_rope_pool(bf16* __restrict__ PROJ, const float* __restrict__ qn, const float* __restrict__ kn, bf16* __restrict__ POOLED, int gw, int ngw, int lane) {
    const int l = lane & 31, hsel = lane >> 5, part = (l >> 4) & 1; const bool first = (l & 8) == 0;
    float inv[4];
#pragma unroll
    for (int e = 0; e < 4; ++e) inv[e] = exp2f(-(float)(4 * (l & 7) + e) * (13.287712379549449f / 32.0f));
    const f32x4 gq = *(const f32x4*)(qn + 4 * l), gk = *(const f32x4*)(kn + 4 * l);
    for (int it = gw; it < M * 8; it += ngw) {
        const int t = it >> 3, hh = (it & 7) * 2 + hsel;
        bf16* p = PROJ + (size_t)t * ABW + 512 + hh * 128 + 4 * l;
        const u32x2 w = *(const u32x2*)p;
        float x[4] = {bflo(w.x), bfhi(w.x), bflo(w.y), bfhi(w.y)};
        float ss = (x[0] * x[0] + x[1] * x[1]) + (x[2] * x[2] + x[3] * x[3]);
#pragma unroll
        for (int o = 1; o < 32; o <<= 1) ss += __shfl_xor(ss, o);
        const float rstd = 1.0f / sqrtf(ss * (1.0f / 128.0f) + EPS);
        const f32x4 g = (hh < 12) ? gq : gk;
        const int pos = t & (SEQ - 1); const float pp = part ? (float)(pos & 63) : (float)(pos >> 6);
        float y[4] = {x[0] * rstd * g.x, x[1] * rstd * g.y, x[2] * rstd * g.z, x[3] * rstd * g.w}, o4[4];
#pragma unroll
        for (int e = 0; e < 4; ++e) { const float yp = __shfl_xor(y[e], 8); const float ang = pp * inv[e]; const float sn = __sinf(ang), cs = __cosf(ang);
            o4[e] = y[e] * cs + (first ? -yp : yp) * sn; }
        u32x2 ow; ow.x = pk2(o4[0], o4[1]); ow.y = pk2(o4[2], o4[3]); *(u32x2*)p = ow;
    }
    const int gt = gw * 64 + lane, ngt = ngw * 64;
    for (int it = gt; it < M * 64; it += ngt) {
        const int t = it >> 6, c8 = (it & 63) * 8, g = c8 >> 7, w2 = 1 << g, pos = t & (SEQ - 1), base = t - pos;
        const int lo = max(pos - w2, 0), hi = min(pos + w2, SEQ);
        float acc[8] = {0.f, 0.f, 0.f, 0.f, 0.f, 0.f, 0.f, 0.f};
        for (int pz = lo; pz < hi; ++pz) { const u32x4 v = *(const u32x4*)(PROJ + (size_t)(base + pz) * ABW + c8);
            acc[0] += bflo(v.x); acc[1] += bfhi(v.x); acc[2] += bflo(v.y); acc[3] += bfhi(v.y); acc[4] += bflo(v.z); acc[5] += bfhi(v.z); acc[6] += bflo(v.w); acc[7] += bfhi(v.w); }
        const u32x4 sv = *(const u32x4*)(PROJ + (size_t)t * ABW + c8); const float iv = 1.0f / (float)(hi - lo);
        u32x4 o; o.x = pk2(acc[0] * iv - bflo(sv.x), acc[1] * iv - bfhi(sv.x)); o.y = pk2(acc[2] * iv - bflo(sv.y), acc[3] * iv - bfhi(sv.y));
        o.z = pk2(acc[4] * iv - bflo(sv.z), acc[5] * iv - bfhi(sv.z)); o.w = pk2(acc[6] * iv - bflo(sv.w), acc[7] * iv - bfhi(sv.w));
        *(u32x4*)(POOLED + (size_t)t * 512 + c8) = o;
    }
}

__device__ __forceinline__ void conv_fix(const bf16* __restrict__ HALO, const float* __restrict__ cw, const float* __restrict__ cb, bf16* __restrict__ ACT, int gt, int ngt) {
    for (int it = gt; it < 256 * 704; it += ngt) {
        const int jc = it % 704, re = it / 704, blk = re >> 1, last = re & 1, j = jc * 8;
        const int t = blk * 64 + (last ? 63 : 0), pos = t & (SEQ - 1);
        const bf16* rc = HALO + ((size_t)blk * 4 + (last ? 3 : 0)) * FF2 + j;
        const bf16* ru = last ? rc - FF2 : HALO + ((size_t)(blk - 1) * 4 + 3) * FF2 + j;
        const bf16* rd = last ? HALO + ((size_t)(blk + 1) * 4) * FF2 + j : rc + FF2;
        const u32x4 z = {0u, 0u, 0u, 0u};
        const u32x4 g1 = *(const u32x4*)rc, v1 = *(const u32x4*)(rc + FF);
        const u32x4 g0 = pos > 0 ? *(const u32x4*)ru : z, v0 = pos > 0 ? *(const u32x4*)(ru + FF) : z;
        const u32x4 g2 = pos < SEQ - 1 ? *(const u32x4*)rd : z, v2 = pos < SEQ - 1 ? *(const u32x4*)(rd + FF) : z;
        float o[8];
#pragma unroll
        for (int q = 0; q < 4; ++q) {
            const int ja = j + 2 * q, jb = ja + 1;
            const float ga = cw[ja] * bflo(g0[q]) + cw[FF2 + ja] * bflo(g1[q]) + cw[2 * FF2 + ja] * bflo(g2[q]) + cb[ja];
            const float gb = cw[jb] * bfhi(g0[q]) + cw[FF2 + jb] * bfhi(g1[q]) + cw[2 * FF2 + jb] * bfhi(g2[q]) + cb[jb];
            const float va = cw[FF + ja] * bflo(v0[q]) + cw[FF2 + FF + ja] * bflo(v1[q]) + cw[2 * FF2 + FF + ja] * bflo(v2[q]) + cb[FF + ja];
            const float vb = cw[FF + jb] * bfhi(v0[q]) + cw[FF2 + FF + jb] * bfhi(v1[q]) + cw[2 * FF2 + FF + jb] * bfhi(v2[q]) + cb[FF + jb];
            o[2 * q] = ga / (1.0f + __expf(-ga)) * va; o[2 * q + 1] = gb / (1.0f + __expf(-gb)) * vb;
        }
        u32x4 ow; ow.x = pk2(o[0], o[1]); ow.y = pk2(o[2], o[3]); ow.z = pk2(o[4], o[5]); ow.w = pk2(o[6], o[7]);
        *(u32x4*)(ACT + (size_t)t * FF + j) = ow;
    }
}

__device__ __forceinline__ void gates_phase(const bf16* __restrict__ XN, const bf16* __restrict__ WG, const float* __restrict__ bg, float* __restrict__ GATES, LAS float* red, int bid, int nblk) {
    const int tid = mk_tid(), wid = tid >> 6, lane = tid & 63, fr = lane & 15, fq = lane >> 4;
    const int tile = wid & 3, tt = tile & 1, jt = tile >> 1, kh = wid >> 2;
    for (int grp = bid; grp < 256; grp += nblk) {
        f32x4 acc = {0.f, 0.f, 0.f, 0.f};
        const bf16* ap = WG + (size_t)(jt * 16 + fr) * D + kh * 1024 + fq * 8;
        const bf16* bp = XN + (size_t)(grp * 32 + tt * 16 + fr) * D + kh * 1024 + fq * 8;
#pragma unroll 8
        for (int ks = 0; ks < 32; ++ks) { const bf16x8 a = *(const bf16x8*)(ap + ks * 32), b = *(const bf16x8*)(bp + ks * 32); acc = __builtin_amdgcn_mfma_f32_16x16x32_bf16(a, b, acc, 0, 0, 0); }
        if (kh == 1) { LAS float* r = red + (tile * 64 + lane) * 4; r[0] = acc[0]; r[1] = acc[1]; r[2] = acc[2]; r[3] = acc[3]; }
        __syncthreads();
        if (kh == 0) { const LAS float* r = red + (tile * 64 + lane) * 4; const int t = grp * 32 + tt * 16 + fr, j = jt * 16 + 4 * fq;
            const f32x4 b4 = *(const f32x4*)(bg + j); f32x4 o; o.x = acc[0] + r[0] + b4.x; o.y = acc[1] + r[1] + b4.y; o.z = acc[2] + r[2] + b4.z; o.w = acc[3] + r[3] + b4.w;
            *(f32x4*)(GATES + (size_t)t * 32 + j) = o; }
        __syncthreads();
    }
}

__device__ __forceinline__ void headnorm_phase(const float* __restrict__ HF, const bf16* __restrict__ OG, const float* __restrict__ hn, bf16* __restrict__ Y, int gw, int ngw, int lane) {
    for (int it = gw; it < M * 8; it += ngw) {
        const int t = it >> 3, h = it & 7; const size_t off = (size_t)t * D + h * 256 + 4 * lane;
        const f32x4 a = *(const f32x4*)(HF + off), b = *(const f32x4*)(HF + (size_t)M * D + off); const f32x4 s = a + b;
        const float ss = wave_sum((s.x * s.x + s.y * s.y) + (s.z * s.z + s.w * s.w));
        const float rstd = 1.0f / sqrtf(ss * (1.0f / 256.0f) + EPS);
        const f32x4 g = *(const f32x4*)(hn + h * 256 + 4 * lane); const u32x2 ow = *(const u32x2*)(OG + off);
        const float o0 = bflo(ow.x), o1 = bfhi(ow.x), o2 = bflo(ow.y), o3 = bfhi(ow.y);
        u32x2 w; w.x = pk2(s.x * rstd * g.x / (1.0f + __expf(-o0)), s.y * rstd * g.y / (1.0f + __expf(-o1)));
        w.y = pk2(s.z * rstd * g.z / (1.0f + __expf(-o2)), s.w * rstd * g.w / (1.0f + __expf(-o3)));
        *(u32x2*)(Y + off) = w;
    }
}

namespace ml {
constexpr int LQ = 264, LS = 72;
constexpr int OFF_Q = 0, OFF_K = 33792, OFF_KT = 67584, OFF_VT = 104448, OFF_VTW = 111360, OFF_P = 118272, OFF_CT = 127488, OFF_SC = 152832;
static_assert(OFF_SC + 1280 + 1024 == LDS_ML, "mlstm lds map");
#define ML_BAR() do { asm volatile("s_waitcnt lgkmcnt(0)" ::: "memory"); __builtin_amdgcn_s_barrier(); asm volatile("" ::: "memory"); } while (0)
#define ML_DPP(old, src, ctrl, rmask) __int_as_float(__builtin_amdgcn_update_dpp(__float_as_int(old), __float_as_int(src), ctrl, rmask, 0xF, false))
#define ML_MFMA(a, b, c) __builtin_amdgcn_mfma_f32_16x16x32_bf16(a, b, c, 0, 0, 0)

__device__ __forceinline__ void mlstm_phase(LAS unsigned char* lds, const bf16* __restrict__ QK, const bf16* __restrict__ KVT, const float* __restrict__ GATES, float* __restrict__ HF, int bid, int nblk) {
    const int tid = mk_tid(), wid = tid >> 6, lane = tid & 63, fr = lane & 15, fq = lane >> 4;
    LAS bf16* Qs = (LAS bf16*)(lds + OFF_Q); LAS bf16* Ks = (LAS bf16*)(lds + OFF_K); LAS bf16* KTs = (LAS bf16*)(lds + OFF_KT);
    LAS bf16* VTs = (LAS bf16*)(lds + OFF_VT); LAS bf16* VTw = (LAS bf16*)(lds + OFF_VTW); LAS bf16* Ps = (LAS bf16*)(lds + OFF_P); LAS bf16* CTs = (LAS bf16*)(lds + OFF_CT);
    LAS float* sA = (LAS float*)(lds + OFF_SC); LAS float* sM = sA + 64; LAS float* sAI = sM + 64; LAS float* sEM = sAI + 64; LAS float* sWS = (LAS float*)(lds + OFF_SC + 1280);
    const int tt = wid & 3, sh = wid >> 2;
    for (int it0 = bid; it0 < 256; it0 += nblk) {
        const int item = (nblk == 256) ? (((it0 & 7) * 4 + (it0 >> 6)) * 8 + ((it0 >> 3) & 7)) : it0;
        const int es = item & 7, dir = (item >> 3) & 1, h = (item >> 4) & 7, b = (item >> 7) & 1;
        for (int i = tid; i < 48 * LQ / 2; i += 512) ((LAS unsigned*)CTs)[i] = 0u;
        for (int i = tid; i < 16 * LS; i += 512) { VTs[32 * LS + i] = (i < LS) ? (bf16)0x3F80 : (bf16)0; VTw[32 * LS + i] = (bf16)0; }
        f32x4 ct[2][3];
#pragma unroll
        for (int a = 0; a < 2; ++a)
#pragma unroll
            for (int e = 0; e < 3; ++e) ct[a][e] = (f32x4){0.f, 0.f, 0.f, 0.f};
        float m_st = 0.f, decay = 1.f;
        bf16x8 rq[4], rk[4], rkt[4], rvt = {0, 0, 0, 0, 0, 0, 0, 0}; float gi = 0.f, gf = 0.f;
        const unsigned voffQ = (unsigned)(((tid >> 5) * 4096 + (tid & 31) * 8) * 2), voffT = (unsigned)(((tid >> 3) * M + (tid & 7) * 8) * 2), voffG = (unsigned)((dir ? 63 - lane : lane) * 128);
#define ML_LOAD(c) do { const int ncn_ = dir ? 63 - (c) : (c); const size_t trow_ = (size_t)b * SEQ + (size_t)ncn_ * 64; \
        const char* qb_ = (const char*)(QK + trow_ * 4096 + h * 256); \
        _Pragma("unroll") for (int i_ = 0; i_ < 4; ++i_) { rq[i_] = *(const bf16x8*)(qb_ + (size_t)i_ * 131072 + voffQ); rk[i_] = *(const bf16x8*)(qb_ + 4096 + (size_t)i_ * 131072 + voffQ); } \
        const char* tb_ = (const char*)(KVT + (size_t)(h * 256) * M + trow_); \
        _Pragma("unroll") for (int i_ = 0; i_ < 4; ++i_) rkt[i_] = *(const bf16x8*)(tb_ + (size_t)i_ * (64 * M * 2) + voffT); \
        if (tid < 256) rvt = *(const bf16x8*)((const char*)(KVT + (size_t)(2048 + h * 256 + es * 32) * M + trow_) + voffT); \
        { const float* gp_ = GATES + trow_ * 32 + dir * 16 + h; gi = *(const float*)((const char*)gp_ + voffG); gf = *(const float*)((const char*)gp_ + 32 + voffG); } } while (0)
#define ML_STORE() do { \
        const float lf_ = fminf(gf, 0.f) - log1pf(__expf(-fabsf(gf))); float bc_ = lf_; \
        bc_ += ML_DPP(0.f, bc_, 0x111, 0xF); bc_ += ML_DPP(0.f, bc_, 0x112, 0xF); bc_ += ML_DPP(0.f, bc_, 0x114, 0xF); bc_ += ML_DPP(0.f, bc_, 0x118, 0xF); \
        bc_ += ML_DPP(0.f, bc_, 0x142, 0xA); bc_ += ML_DPP(0.f, bc_, 0x143, 0xC); \
        const float a_ = gi - bc_; float cm_ = a_; \
        cm_ = fmaxf(cm_, ML_DPP(-3.0e38f, cm_, 0x111, 0xF)); cm_ = fmaxf(cm_, ML_DPP(-3.0e38f, cm_, 0x112, 0xF)); cm_ = fmaxf(cm_, ML_DPP(-3.0e38f, cm_, 0x114, 0xF)); cm_ = fmaxf(cm_, ML_DPP(-3.0e38f, cm_, 0x118, 0xF)); \
        cm_ = fmaxf(cm_, ML_DPP(-3.0e38f, cm_, 0x142, 0xA)); cm_ = fmaxf(cm_, ML_DPP(-3.0e38f, cm_, 0x143, 0xC)); \
        const float Mv_ = fmaxf(m_st, cm_), blast_ = __shfl(bc_, 63), cml_ = __shfl(cm_, 63), Mn_ = fmaxf(m_st, cml_); \
        const float ai_ = __expf(m_st - Mv_), em_ = __expf(-(bc_ + Mv_)), wsv_ = __expf(a_ - Mn_); decay = __expf(m_st - Mn_); m_st = blast_ + Mn_; \
        const int rr_ = dir ? 63 - lane : lane; \
        if (wid == 0) { sA[rr_] = a_; sM[rr_] = Mv_; sAI[rr_] = ai_; sEM[rr_] = em_; VTw[32 * LS + rr_] = (bf16)f2bf(wsv_); } \
        _Pragma("unroll") for (int i_ = 0; i_ < 4; ++i_) { const int q_ = tid + 512 * i_, r_ = q_ >> 5, cc_ = (q_ & 31) * 8; \
            *(LAS bf16x8*)(Qs + r_ * LQ + cc_) = rq[i_]; *(LAS bf16x8*)(Ks + r_ * LQ + cc_) = rk[i_]; } \
        _Pragma("unroll") for (int i_ = 0; i_ < 4; ++i_) { const int q_ = tid + 512 * i_, d_ = q_ >> 3, cc_ = (q_ & 7) * 8; *(LAS bf16x8*)(KTs + d_ * LS + cc_) = rkt[i_]; } \
        if (tid < 256) { const int e_ = tid >> 3, cc_ = (tid & 7) * 8; *(LAS bf16x8*)(VTs + e_ * LS + cc_) = rvt; \
            LAS float* wsp_ = sWS + wid * 64; wsp_[rr_] = wsv_; asm volatile("s_waitcnt lgkmcnt(0)" ::: "memory"); \
            const f32x4 wa_ = *(const LAS f32x4*)(wsp_ + cc_), wb_ = *(const LAS f32x4*)(wsp_ + cc_ + 4); const float wv_[8] = {wa_.x, wa_.y, wa_.z, wa_.w, wb_.x, wb_.y, wb_.z, wb_.w}; \
            const u32x4 rv_ = __builtin_bit_cast(u32x4, rvt); u32x4 o_; \
            o_.x = pk2(bflo(rv_.x) * wv_[0], bfhi(rv_.x) * wv_[1]); o_.y = pk2(bflo(rv_.y) * wv_[2], bfhi(rv_.y) * wv_[3]); \
            o_.z = pk2(bflo(rv_.z) * wv_[4], bfhi(rv_.z) * wv_[5]); o_.w = pk2(bflo(rv_.w) * wv_[6], bfhi(rv_.w) * wv_[7]); \
            *(LAS u32x4*)(VTw + e_ * LS + cc_) = o_; } } while (0)
        ML_LOAD(0);
        ML_BAR();
        ML_STORE();
        ML_BAR();
        ML_LOAD(1);
        for (int c = 0; c < 64; ++c) {
            const int ncn = dir ? 63 - c : c; const size_t trow = (size_t)b * SEQ + (size_t)ncn * 64;
            const float dec_c = decay;
            f32x4 s0 = {0.f, 0.f, 0.f, 0.f}, s1 = s0, n3 = s0, d3 = s0;
            {
                const LAS bf16* qp = Qs + (tt * 16 + fr) * LQ + fq * 8;
                const LAS bf16* kp0 = Ks + ((2 * sh) * 16 + fr) * LQ + fq * 8; const LAS bf16* kp1 = kp0 + 16 * LQ;
                const LAS bf16* cp0 = CTs + (sh * 16 + fr) * LQ + fq * 8; const LAS bf16* cp2 = CTs + (32 + fr) * LQ + fq * 8;
#pragma unroll
                for (int hf = 0; hf < 4; ++hf) {
                    bf16x8 qf[2], k0[2], k1[2], c0[2], c2[2];
#pragma unroll
                    for (int k4 = 0; k4 < 2; ++k4) { const int ko = (hf * 2 + k4) * 32;
                        qf[k4] = *(const LAS bf16x8*)(qp + ko); k0[k4] = *(const LAS bf16x8*)(kp0 + ko); k1[k4] = *(const LAS bf16x8*)(kp1 + ko);
                        c0[k4] = *(const LAS bf16x8*)(cp0 + ko); c2[k4] = *(const LAS bf16x8*)(cp2 + ko); }
                    __builtin_amdgcn_sched_barrier(0);
#pragma unroll
                    for (int k4 = 0; k4 < 2; ++k4) { s0 = ML_MFMA(k0[k4], qf[k4], s0); s1 = ML_MFMA(k1[k4], qf[k4], s1); n3 = ML_MFMA(c0[k4], qf[k4], n3); d3 = ML_MFMA(c2[k4], qf[k4], d3); }
                }
            }
            const int t = tt * 16 + fr; const float Mt = sM[t];
            {
                const int sb0 = (2 * sh) * 16 + 4 * fq, sb1 = sb0 + 16;
                const f32x4 a0 = *(const LAS f32x4*)(sA + sb0), a1 = *(const LAS f32x4*)(sA + sb1);
                float p0[4], p1[4];
#pragma unroll
                for (int r = 0; r < 4; ++r) {
                    const int sa = sb0 + r, sbb = sb1 + r;
                    const bool ok0 = dir ? (sa >= t) : (sa <= t), ok1 = dir ? (sbb >= t) : (sbb <= t);
                    p0[r] = ok0 ? s0[r] * __expf(a0[r] - Mt) : 0.f; p1[r] = ok1 ? s1[r] * __expf(a1[r] - Mt) : 0.f;
                }
                u32x2 w0, w1; w0.x = pk2(p0[0], p0[1]); w0.y = pk2(p0[2], p0[3]); w1.x = pk2(p1[0], p1[1]); w1.y = pk2(p1[2], p1[3]);
                *(LAS u32x2*)(Ps + t * LS + sb0) = w0; *(LAS u32x2*)(Ps + t * LS + sb1) = w1;
            }
            ML_BAR();
            f32x4 n2 = {0.f, 0.f, 0.f, 0.f}, d2 = n2;
            {
                bf16x8 pf[2], v0[2], v2[2];
#pragma unroll
                for (int ks = 0; ks < 2; ++ks) { const int ko = ks * 32 + fq * 8;
                    pf[ks] = *(const LAS bf16x8*)(Ps + (tt * 16 + fr) * LS + ko); v0[ks] = *(const LAS bf16x8*)(VTs + (sh * 16 + fr) * LS + ko); v2[ks] = *(const LAS bf16x8*)(VTs + (32 + fr) * LS + ko); }
                __builtin_amdgcn_sched_barrier(0);
#pragma unroll
                for (int ks = 0; ks < 2; ++ks) { n2 = ML_MFMA(v0[ks], pf[ks], n2); d2 = ML_MFMA(v2[ks], pf[ks], d2); }
            }
            {
                const float ai = sAI[t], em = sEM[t];
                const float den0 = d2[0] + ai * d3[0];
                const float den = __shfl(den0, fr);
                const float rinv = 1.0f / fmaxf(fabsf(den), em);
                f32x4 hout; hout.x = (n2[0] + ai * n3[0]) * rinv; hout.y = (n2[1] + ai * n3[1]) * rinv; hout.z = (n2[2] + ai * n3[2]) * rinv; hout.w = (n2[3] + ai * n3[3]) * rinv;
                *(f32x4*)(HF + ((size_t)dir * M + trow + t) * D + h * 256 + es * 32 + sh * 16 + 4 * fq) = hout;
            }
#pragma unroll
            for (int a = 0; a < 2; ++a)
#pragma unroll
                for (int e = 0; e < 3; ++e) ct[a][e] = ct[a][e] * dec_c;
#pragma unroll
            for (int ks = 0; ks < 2; ++ks) { const int ko = ks * 32 + fq * 8; bf16x8 kt[2], vw[3];
#pragma unroll
                for (int a = 0; a < 2; ++a) kt[a] = *(const LAS bf16x8*)(KTs + ((2 * wid + a) * 16 + fr) * LS + ko);
#pragma unroll
                for (int e = 0; e < 3; ++e) vw[e] = *(const LAS bf16x8*)(VTw + (e * 16 + fr) * LS + ko);
                __builtin_amdgcn_sched_barrier(0);
#pragma unroll
                for (int a = 0; a < 2; ++a)
#pragma unroll
                    for (int e = 0; e < 3; ++e) ct[a][e] = ML_MFMA(kt[a], vw[e], ct[a][e]);
            }
#pragma unroll
            for (int a = 0; a < 2; ++a)
#pragma unroll
                for (int e = 0; e < 3; ++e) { u32x2 w; w.x = f2bf(ct[a][e][0]) | (f2bf(ct[a][e][1]) << 16); w.y = f2bf(ct[a][e][2]) | (f2bf(ct[a][e][3]) << 16);
                    *(LAS u32x2*)(CTs + (e * 16 + fr) * LQ + (2 * wid + a) * 16 + 4 * fq) = w; }
            ML_BAR();
            if (c + 1 < 64) { ML_STORE(); }
            ML_BAR();
            if (c + 2 < 64) { ML_LOAD(c + 2); }
        }
#undef ML_LOAD
#undef ML_STORE
    }
}
}
}

struct EpiRes {
    static constexpr bool PERM = false, AFTER_DRAIN = false;
    const float* base; float* out; int ldc;
    __device__ __forceinline__ void operator()(const pg8::f32x4 (&acc)[2][2][4][2], const pg8::Unit& u, int wr, int wc, int fr, int fq) const {
#pragma unroll
        for (int ai = 0; ai < 2; ++ai)
#pragma unroll
            for (int m = 0; m < 4; ++m) { const size_t ro = (size_t)(u.pm * 256 + ai * 128 + wr * 64 + m * 16 + fr) * ldc + u.pn * 256 + wc * 32 + 4 * fq;
#pragma unroll
                for (int bj = 0; bj < 2; ++bj)
#pragma unroll
                    for (int n = 0; n < 2; ++n) { const size_t off = ro + bj * 128 + n * 16; const pg8::f32x4 bs = *(const pg8::f32x4*)(base + off); *(pg8::f32x4*)(out + off) = bs + acc[ai][bj][m][n]; } }
    }
};

#define ROR1(x) __int_as_float(__builtin_amdgcn_update_dpp(0, __float_as_int(x), 0x121, 0xF, 0xF, false))
#define ROL1(x) __int_as_float(__builtin_amdgcn_update_dpp(0, __float_as_int(x), 0x12F, 0xF, 0xF, false))
struct EpiConv {
    static constexpr bool PERM = true, AFTER_DRAIN = false;
    unsigned short* ACT; unsigned short* HALO; const float* cw; const float* cb;
    __device__ __forceinline__ void operator()(const pg8::f32x4 (&acc)[2][2][4][2], const pg8::Unit& u, int wr, int wc, int fr, int fq) const {
        using mk::FF; using mk::FF2;
        const int jb = u.pn * 128 + wc * 32 + 8 * fq;
        mk::u32x2 keep[2][4];
#pragma unroll
        for (int n = 0; n < 2; ++n) {
            const int j = jb + 4 * n;
            const pg8::f32x4 c0g = *(const pg8::f32x4*)(cw + j), c1g = *(const pg8::f32x4*)(cw + FF2 + j), c2g = *(const pg8::f32x4*)(cw + 2 * FF2 + j), cbg = *(const pg8::f32x4*)(cb + j);
            const pg8::f32x4 c0v = *(const pg8::f32x4*)(cw + FF + j), c1v = *(const pg8::f32x4*)(cw + FF2 + FF + j), c2v = *(const pg8::f32x4*)(cw + 2 * FF2 + FF + j), cbv = *(const pg8::f32x4*)(cb + FF + j);
#pragma unroll
            for (int ai = 0; ai < 2; ++ai)
#pragma unroll
                for (int m = 0; m < 4; ++m) {
                    const int row = u.pm * 256 + ai * 128 + wr * 64 + m * 16 + fr;
                    float o[4];
#pragma unroll
                    for (int i = 0; i < 4; ++i) {
                        const float g = acc[ai][0][m][n][i], v = acc[ai][1][m][n][i];
                        float gu = ROR1(g), gd = ROL1(g), vu = ROR1(v), vd = ROL1(v);
                        if (m > 0) { const float ga = ROR1(acc[ai][0][m - 1][n][i]), va = ROR1(acc[ai][1][m - 1][n][i]); if (fr == 0) { gu = ga; vu = va; } }
                        if (m < 3) { const float ga = ROL1(acc[ai][0][m + 1][n][i]), va = ROL1(acc[ai][1][m + 1][n][i]); if (fr == 15) { gd = ga; vd = va; } }
                        const float G = c0g[i] * gu + c1g[i] * g + c2g[i] * gd + cbg[i];
                        const float V = c0v[i] * vu + c1v[i] * v + c2v[i] * vd + cbv[i];
                        o[i] = G / (1.0f + __expf(-G)) * V;
                    }
                    const bool edge = (m == 0 && fr == 0) || (m == 3 && fr == 15);
                    { mk::u32x2 w; w.x = mk::pk2(o[0], o[1]); w.y = mk::pk2(o[2], o[3]);
                      if (n == 0) keep[ai][m] = w;
                      else if (!edge) { mk::u32x4 w4; w4.x = keep[ai][m].x; w4.y = keep[ai][m].y; w4.z = w.x; w4.w = w.y; *(mk::u32x4*)(ACT + (size_t)row * FF + jb) = w4; } }
                    if ((m == 0 && fr < 2) || (m == 3 && fr > 13)) {
                        const int hr = (m == 0) ? fr : fr - 12;
                        unsigned short* hp = HALO + ((size_t)(row >> 6) * 4 + hr) * FF2 + j;
                        mk::u32x2 wg, wv; wg.x = mk::f2bf(acc[ai][0][m][n][0]) | (mk::f2bf(acc[ai][0][m][n][1]) << 16); wg.y = mk::f2bf(acc[ai][0][m][n][2]) | (mk::f2bf(acc[ai][0][m][n][3]) << 16);
                        wv.x = mk::f2bf(acc[ai][1][m][n][0]) | (mk::f2bf(acc[ai][1][m][n][1]) << 16); wv.y = mk::f2bf(acc[ai][1][m][n][2]) | (mk::f2bf(acc[ai][1][m][n][3]) << 16);
                        *(mk::u32x2*)hp = wg; *(mk::u32x2*)(hp + FF) = wv;
                    }
                }
        }
    }
};

struct EpiBf16T {
    static constexpr bool PERM = true, AFTER_DRAIN = false;
    unsigned short* O; int ldc; int split_cols; float scale0; unsigned short* T; int tcol0; int ldt;
    __device__ __forceinline__ void operator()(const pg8::f32x4 (&acc)[2][2][4][2], const pg8::Unit& u, int wr, int wc, int fr, int fq) const {
        const int row0 = u.pm * 256 + wr * 64 + fr, colt = u.pn * 256, col0 = colt + wc * 32 + 8 * fq;
        const float sc = (colt < split_cols) ? scale0 : 1.f;
#pragma unroll
        for (int ai = 0; ai < 2; ++ai)
#pragma unroll
            for (int m = 0; m < 4; ++m) { unsigned short* rowp = O + (size_t)(row0 + ai * 128 + m * 16) * ldc + col0;
#pragma unroll
                for (int bj = 0; bj < 2; ++bj) { const pg8::f32x4 v0 = acc[ai][bj][m][0] * sc, v1 = acc[ai][bj][m][1] * sc;
                    mk::u32x4 w; w.x = mk::pk2(v0[0], v0[1]); w.y = mk::pk2(v0[2], v0[3]); w.z = mk::pk2(v1[0], v1[1]); w.w = mk::pk2(v1[2], v1[3]);
                    *(mk::u32x4*)(rowp + bj * 128) = w; } }
        if (colt >= tcol0) {
#pragma unroll
            for (int bj = 0; bj < 2; ++bj)
#pragma unroll
                for (int n = 0; n < 2; ++n)
#pragma unroll
                    for (int i = 0; i < 4; ++i) { unsigned short* tp = T + (size_t)(col0 - tcol0 + bj * 128 + 4 * n + i) * ldt + row0;
#pragma unroll
                        for (int ai = 0; ai < 2; ++ai)
#pragma unroll
                            for (int m = 0; m < 4; ++m) tp[ai * 128 + m * 16] = (unsigned short)mk::f2bf(acc[ai][bj][m][n][i]); }
        }
    }
};

struct GemmDesc { const unsigned short* A; const unsigned short* Bt; int Mg, Ng, Kg; int kind; unsigned short* O; int ldc; int split_cols; float scale0; const float* base; float* out; int G, c; };

#ifndef REPEAT_PH
#define REPEAT_PH 1000
#define N_REPEAT 0
#else
#define N_REPEAT 1
#endif
struct Params { const float* in[17]; float* out; unsigned char* ws; int ph_lo, ph_hi; };
constexpr int N_PHASES = 18;

__global__ void __launch_bounds__(512, 2) fwd_mega(Params p) {
    extern __shared__ __attribute__((aligned(16))) unsigned char lds_raw[];
    using namespace mk;
    cg::grid_group grid = cg::this_grid();
    LAS unsigned char* lds = (LAS unsigned char*)lds_raw;
    const int bid = blockIdx.x, nblk = gridDim.x;
    const int ph_lo = p.ph_lo, ph_hi = p.ph_hi;
    { volatile LAS unsigned* misc = (volatile LAS unsigned*)(lds + LDS_MISC); if (mk_tid() < 16) misc[mk_tid()] = 0u; }
    __syncthreads();
    (void)xcd_barrier_post((unsigned*)(p.ws + WS_BAR), (volatile LAS unsigned*)(lds + LDS_MISC) + 8);
    if (ph_lo < 0) grid.sync();
#ifdef PROBE_PH
    const unsigned long long t_start = __builtin_amdgcn_s_memrealtime();
#endif
#pragma unroll 1
    for (int ph_it = ph_lo; ph_it < ph_hi + N_REPEAT; ++ph_it) {
        const int ph = ph_it <= REPEAT_PH ? ph_it : ph_it - N_REPEAT;
        typedef const __attribute__((address_space(4))) Params* KP;
        KP kp = (KP)__builtin_amdgcn_kernarg_segment_ptr(); asm volatile("" : "+s"(kp));
        unsigned char* ws = kp->ws; float* OUT = kp->out; bf16* XN = (bf16*)(ws + WS_XN);
        In I; I.x = kp->in[0]; I.norm_mix = kp->in[1]; I.norm_ffn = kp->in[2]; I.w_in_ab = kp->in[3]; I.pool_w = kp->in[4]; I.pool_scale = kp->in[5]; I.q_norm = kp->in[6]; I.k_norm = kp->in[7];
        I.w_out_ab = kp->in[8]; I.w_in_c = kp->in[9]; I.b_gate = kp->in[10]; I.h_norm = kp->in[11]; I.w_out_c = kp->in[12]; I.w_up = kp->in[13]; I.conv_w = kp->in[14]; I.conv_b = kp->in[15]; I.w_down = kp->in[16];
        int nb_ = nblk; asm volatile("" : "+s"(nb_)); const int ngw = nb_ * NW, ngt = nb_ * 512;
        const int tid = mk_tid(), lane = tid & 63, wave = __builtin_amdgcn_readfirstlane(tid >> 6), gw = bid * NW + wave, gt = bid * 512 + tid;
#ifndef NO_THIN
        if (ph == 0) prologue(I, ws, lds, gw, ngw, wave, lane);
        if (ph == 5 || ph == 9 || ph == 14) rmsnorm_rows(OUT, ph == 5 ? I.norm_ffn : (ph == 9 ? I.norm_mix + D : I.norm_ffn + D), XN, gw, ngw, lane);
        if (ph == 2) qk_rope_pool((bf16*)(ws + WS_PROJ), I.q_norm, I.k_norm, (bf16*)(ws + WS_POOLED), gw, ngw, lane);
#endif
#ifndef NO_ATT
        if (ph == 3) {
            const bf16* PROJ = (const bf16*)(ws + WS_PROJ); bf16* CAT = (bf16*)(ws + WS_CAT);
            for (int u0 = bid; u0 < 384; u0 += nblk) {
                int u = u0;
                if (nblk == 256) { const int xcd = u0 & 7, j = (u0 >> 3) & 31, rnd = u0 >> 8; const int jj = j + 32 * rnd;
                    if (jj >= 48) continue; u = (xcd >> 2) * 192 + ((xcd & 3) * 3 + (jj >> 4)) * 16 + (jj & 15); }
                const int qb = u & 15, hq = (u >> 4) % 12, b = u / 192;
                const size_t r0 = (size_t)b * SEQ + (size_t)qb * 256;
                att::attn_dense_body<att::bf16>((const att::bf16*)(PROJ + r0 * ABW + 512 + hq * 128), (const att::bf16*)(PROJ + (size_t)b * SEQ * ABW + 2048 + (hq / 3) * 128),
                                                (const att::bf16*)(PROJ + (size_t)b * SEQ * ABW + 2560 + (hq / 3) * 128), CAT + r0 * D + 512 + hq * 128, SEQ, (char*)lds_raw);
                __syncthreads();
            }
        }
#endif
#ifndef NO_THIN
        if (ph == 7 || ph == 16) { const int l = ph == 7 ? 0 : 1; conv_fix((const bf16*)(ws + WS_U), I.conv_w + (size_t)l * 3 * FF2, I.conv_b + (size_t)l * FF2, (bf16*)(ws + WS_ACT), gt, ngt); }
        if (ph == 10) gates_phase(XN, (const bf16*)(ws + WS_C) + (size_t)8192 * D, I.b_gate, (float*)(ws + WS_GATES), (LAS float*)lds, bid, nblk);
#endif
#ifndef NO_ML
        if (ph == 11) ml::mlstm_phase(lds, (const bf16*)(ws + WS_QK), (const bf16*)(ws + WS_KVT), (const float*)(ws + WS_GATES), (float*)(ws + WS_HF), bid, nblk);
#endif
#ifndef NO_THIN
        if (ph == 12) headnorm_phase((const float*)(ws + WS_HF), (const bf16*)(ws + WS_OG), I.h_norm, (bf16*)(ws + WS_Y), gw, ngw, lane);
#endif
#pragma unroll 1
        for (int gi = 0; gi < 3; ++gi) {
            GemmDesc d; d.kind = -1; d.G = nblk; d.c = bid; d.split_cols = 0; d.scale0 = 1.f; d.base = nullptr; d.out = nullptr; d.O = nullptr; d.ldc = 0; d.A = nullptr; d.Bt = nullptr; d.Mg = M; d.Ng = 0; d.Kg = D;
            if (gi == 0) {
                if (ph == 1) { d.kind = 0; d.A = XN; d.Bt = (bf16*)(ws + WS_AB); d.Ng = ABW; d.O = (bf16*)(ws + WS_PROJ); d.ldc = ABW; }
                else if (ph == 3) { d.kind = 0; d.A = (bf16*)(ws + WS_POOLED); d.Bt = (bf16*)(ws + WS_BD); d.Ng = 512; d.Kg = 512; d.O = (bf16*)(ws + WS_CAT); d.ldc = D;
                    if (nblk == 256) { const int slot = bid >> 3; d.G = 64; d.c = (slot - 16) * 8 + (bid & 7); if (slot < 16 || slot >= 24) d.kind = -1; } }
                else if (ph == 4) { d.kind = 1; d.A = (bf16*)(ws + WS_CAT); d.Bt = (bf16*)(ws + WS_OAB); d.Ng = D; d.base = I.x; d.out = OUT; }
                else if (ph == 6 || ph == 15) { d.kind = 2; d.A = XN; d.Bt = (bf16*)(ws + (ph == 6 ? WS_UP0 : WS_UP1)); d.Ng = FF2; d.O = (bf16*)(ws + WS_U); d.ldc = FF2; d.base = I.conv_w + (size_t)(ph == 6 ? 0 : 1) * 3 * FF2; d.out = (float*)(I.conv_b + (size_t)(ph == 6 ? 0 : 1) * FF2); }
                else if (ph == 8 || ph == 17) { d.kind = 1; d.A = (bf16*)(ws + WS_ACT); d.Bt = (bf16*)(ws + (ph == 8 ? WS_DN0 : WS_DN1)); d.Ng = D; d.Kg = FF; d.base = OUT; d.out = OUT; }
                else if (ph == 10) { d.kind = 3; d.A = XN; d.Bt = (bf16*)(ws + WS_C); d.Ng = 4096; d.O = (bf16*)(ws + WS_QK); d.ldc = 4096; d.split_cols = 2048; d.scale0 = 0.0625f; }
                else if (ph == 13) { d.kind = 1; d.A = (bf16*)(ws + WS_Y); d.Bt = (bf16*)(ws + WS_OC); d.Ng = D; d.base = OUT; d.out = OUT; }
            } else if (ph == 10) {
                if (gi == 1) { d.kind = 0; d.A = XN; d.Bt = (bf16*)(ws + WS_C) + (size_t)6144 * D; d.Ng = D; d.O = (bf16*)(ws + WS_OG); d.ldc = D; }
                else { d.kind = 0; d.A = (bf16*)(ws + WS_C) + (size_t)4096 * D; d.Bt = XN; d.Mg = 2048; d.Ng = M; d.O = (bf16*)(ws + WS_KVT) + (size_t)2048 * M; d.ldc = M; }
            }
#ifndef NO_GEMM
            if (d.kind == 0) {
                pg8::Gemm g{d.A, d.Bt, d.Mg, d.Ng, d.Kg}; pg8::StaticOrder S; S.init(d.Mg, d.Ng, d.G, d.c);
                pg8::EpiBf16<0> E{d.O, d.ldc, nullptr, d.split_cols, (size_t)d.split_cols, d.scale0};
                pg8::gemm_phase<pg8::EpiBf16<0>, pg8::StaticOrder, true, true>(lds, g, S, E);
            } else if (d.kind == 3) {
                pg8::Gemm g{d.A, d.Bt, d.Mg, d.Ng, d.Kg}; pg8::StaticOrder S; S.init(d.Mg, d.Ng, d.G, d.c);
                EpiBf16T E{d.O, d.ldc, d.split_cols, d.scale0, (bf16*)(ws + WS_KVT), 2048, M};
                pg8::gemm_phase<EpiBf16T, pg8::StaticOrder, true, true>(lds, g, S, E);
            } else if (d.kind == 2) {
                pg8::Gemm g{d.A, d.Bt, d.Mg, d.Ng, d.Kg}; pg8::StaticOrder S; S.init(d.Mg, d.Ng, d.G, d.c);
                EpiConv E{(bf16*)(ws + WS_ACT), d.O, d.base, (const float*)d.out};
                pg8::gemm_phase<EpiConv, pg8::StaticOrder, true, true>(lds, g, S, E);
            } else if (d.kind == 1) {
                pg8::Gemm g{d.A, d.Bt, d.Mg, d.Ng, d.Kg}; pg8::StaticOrder S; S.init(d.Mg, d.Ng, d.G, d.c);
                EpiRes E{d.base, d.out, D};
                pg8::gemm_phase<EpiRes, pg8::StaticOrder, true, true>(lds, g, S, E);
            }
#endif
            __syncthreads();
        }
#ifndef NO_THIN
        if (nb_ == 256) {
            if (ph == 1 && bid >= 128) { const int w = (bid - 128) * NW + wave; transposes(I, ws, lds, 1536, 2560, w, 128 * NW, wave, lane); transposes(I, ws, lds, 18944, 24576, w, 128 * NW, wave, lane); }
            if (ph == 3 && (bid >> 3) >= 16) { const int w = (((bid >> 3) - 16) * 8 + (bid & 7)) * NW + wave; transposes(I, ws, lds, 2560, 18944, w, 128 * NW, wave, lane); }
        } else if (ph == 1) transposes(I, ws, lds, 1536, 24576, gw, ngw, wave, lane);
#endif
        if (ph_it + 1 < ph_hi + N_REPEAT) { XcdBarrier xbar; xbar.bar = (unsigned*)(ws + WS_BAR); xbar.x = xb_xcc_id(); xbar.st = (volatile LAS unsigned*)(lds + LDS_MISC) + 8; xcd_barrier(xbar);
#ifdef SYNC2
            xcd_barrier(xbar);
#endif
        }
#ifdef PROBE_PH
        if (bid == 0 && tid == 0) { unsigned long long* ts = (unsigned long long*)(ws + WS_BD + 768 * 1024); ts[ph + 1] = __builtin_amdgcn_s_memrealtime(); if (ph == 0) ts[0] = t_start;
            if (ph + 1 == ph_hi) { OUT[0] = (float)(ts[PROBE_PH + 1] - ts[PROBE_PH]) * 0.01f; } }
#endif
    }
}

#ifndef MK_MULTI
#define MK_MULTI 0
#endif
extern "C" void kernel_launch(void* const* d_in, const int* in_sizes, int n_in, void* d_out, int out_size, void* d_ws, size_t ws_size, hipStream_t stream) {
    static int grid = 0;
    if (grid == 0) {
        if (n_in != 17 || out_size != mk::M * mk::D || ws_size < mk::WS_END) { fprintf(stderr, "kernel_launch: unexpected shapes n_in %d out %d ws %zu (need %zu)\n", n_in, out_size, ws_size, (size_t)mk::WS_END); grid = -1; return; }
        int dev = 0, cus = 0, per_cu = 0;
        (void)hipGetDevice(&dev); (void)hipDeviceGetAttribute(&cus, hipDeviceAttributeMultiprocessorCount, dev);
        if (hipFuncSetAttribute((const void*)fwd_mega, hipFuncAttributeMaxDynamicSharedMemorySize, mk::LDS_BYTES) != hipSuccess) { fprintf(stderr, "kernel_launch: hipFuncSetAttribute failed\n"); grid = -1; return; }
        if (hipOccupancyMaxActiveBlocksPerMultiprocessor(&per_cu, (const void*)fwd_mega, 512, mk::LDS_BYTES) != hipSuccess || per_cu < 1) { fprintf(stderr, "kernel_launch: occupancy query gave %d\n", per_cu); per_cu = 1; }
        (void)hipGetLastError();
        if (cus <= 0) cus = 256;
        grid = cus * per_cu; if (grid > 256) grid = 256;
        fprintf(stderr, "kernel_launch: cus %d per_cu %d grid %d\n", cus, per_cu, grid);
    }
    if (grid < 0) return;
    if (hipMemsetAsync((char*)d_ws + mk::WS_BAR, 0, mk::BAR_BYTES, stream) != hipSuccess) { fprintf(stderr, "kernel_launch: memset failed\n"); return; }
    Params p{};
    for (int i = 0; i < 17; ++i) p.in[i] = (const float*)d_in[i];
    p.out = (float*)d_out; p.ws = (unsigned char*)d_ws;
#if MK_MULTI
    for (int ph = 0; ph < N_PHASES; ++ph) { p.ph_lo = ph; p.ph_hi = ph + 1; hipLaunchKernelGGL(fwd_mega, dim3(grid), dim3(512), mk::LDS_BYTES, stream, p); }
#else
    p.ph_lo = 0; p.ph_hi = N_PHASES;
    void* args[] = {&p};
    const hipError_t e = hipLaunchCooperativeKernel((const void*)fwd_mega, dim3(grid), dim3(512), args, mk::LDS_BYTES, stream);
    if (e != hipSuccess) fprintf(stderr, "kernel_launch: cooperative launch failed: %s (grid %d)\n", hipGetErrorString(e), grid);
#endif
}
```

```cpp
#include <hip/hip_runtime.h>
#include <hip/hip_cooperative_groups.h>
#include <hip/hip_bf16.h>
#include <cstdio>
#include <cstdint>
#include <cmath>
namespace cg = cooperative_groups;
__device__ __forceinline__ int mk_tid();
namespace pg8 {
#define PG8_LAS __attribute__((address_space(3)))
typedef unsigned short bf16_t;
typedef short bf16x8 __attribute__((ext_vector_type(8)));
typedef float f32x4 __attribute__((ext_vector_type(4)));
typedef unsigned u32x4 __attribute__((ext_vector_type(4)));
constexpr int BM = 256, BK = 64, HALF = 128, HTB = HALF * BK * 2  , STAGE_BYTES = 8 * HTB, NXCD = 8, WGM = 8;

__host__ __device__ __forceinline__ int lds_byte(int r, int c) { const int st = (r >> 4) * 2 + (c >> 5), rr = r & 15, cc = c & 31, ob = rr * 64 + cc * 2; return st * 1024 + (ob ^ (((ob >> 9) & 1) << 5)); }
__host__ __device__ __forceinline__ void stage_rc(int b, int& R, int& C) { const int st = b / 1024, sb = b % 1024, swz = sb ^ (((sb >> 9) & 1) << 5); R = (st >> 1) * 16 + swz / 64; C = (st & 1) * 32 + (swz % 64) / 2; }
__host__ __device__ __forceinline__ int perm32(int rho) { const int n = rho >> 4, i = rho & 15; return 8 * (i >> 2) + 4 * n + (i & 3); }

struct Unit { int pm, pn; };
struct Gemm { const bf16_t* A; const bf16_t* Bt; int M, N, K; };

struct StaticOrder {
    int nM, nN, nwg, G, c;
    __host__ __device__ void init(int M, int N, int G_, int c_) { nM = M / BM; nN = N / BM; nwg = nM * nN; G = G_; c = c_; }
    __host__ __device__ bool next(int i, Unit& u) const {
        const long L = (long)i * G + c; if (L >= nwg) return false;
        int wgid = (int)L; { const int q = nwg / NXCD, r = nwg % NXCD, xcd = wgid % NXCD, off = wgid / NXCD; wgid = (xcd < r ? xcd * (q + 1) : r * (q + 1) + (xcd - r) * q) + off; }
        const int nig = WGM * nN, gid = wgid / nig, fm = gid * WGM, gsz = (nM - fm) < WGM ? (nM - fm) : WGM;
        u.pm = fm + ((wgid % nig) % gsz); u.pn = (wgid % nig) / gsz; return true;
    }
    __device__ __forceinline__ void a_ready(const Unit&) const {}
    __device__ __forceinline__ void done(const Unit&) const {}
};

__device__ __forceinline__ unsigned cvt_pk_bf16(float lo, float hi) { unsigned r; asm volatile("v_cvt_pk_bf16_f32 %0, %1, %2" : "=v"(r) : "v"(lo), "v"(hi)); return r; }
typedef float f32x2 __attribute__((ext_vector_type(2)));
__device__ __forceinline__ f32x2 gelu_pk(f32x2 v) {
    const f32x2 av = __builtin_elementwise_abs(v), d = av * 0.2316418882f + 1.0f;
    f32x2 t; t.x = __builtin_amdgcn_rcpf(d.x); t.y = __builtin_amdgcn_rcpf(d.y);
    f32x2 q = t * 0.5307027145f + (-0.7265760135f); q = q * t + 0.7107068705f; q = q * t + (-0.142248368f); q = q * t + 0.127414796f; q = q * t;
    const f32x2 s = (v * v) * (-0.72134752044f);
    f32x2 e; e.x = __builtin_amdgcn_exp2f(s.x); e.y = __builtin_amdgcn_exp2f(s.y);
    const f32x2 m = v * (q * e), r = v - m;
    f32x2 o; o.x = v.x < 0.f ? m.x : r.x; o.y = v.y < 0.f ? m.y : r.y; return o;
}

template <int ACT  > struct EpiBf16 {
    static constexpr bool PERM = true, AFTER_DRAIN = false; static_assert(ACT == 0 || ACT == 1, "EpiBf16: ACT is 0 (none) or 1 (gelu_pk)");
    bf16_t* O; int ldc; const float* bias; int split_cols; size_t split_stride; float scale0;
    __device__ __forceinline__ void operator()(const f32x4 (&acc)[2][2][4][2], const Unit& u, int wr, int wc, int fr, int fq) const {
        const int row0 = u.pm * BM + wr * 64 + fr; int colt = u.pn * BM; bf16_t* base = O;
        float sc = 1.f; if (split_cols) { const int t = colt / split_cols; base += (size_t)t * split_stride; colt -= t * split_cols; if (t == 0) sc = scale0; }
        const int col0 = colt + wc * 32 + 8 * fq, bcol0 = u.pn * BM + wc * 32 + 8 * fq;
        f32x4 bv[2][2];
#pragma unroll
        for (int bj = 0; bj < 2; ++bj)
#pragma unroll
            for (int n = 0; n < 2; ++n) bv[bj][n] = bias ? *(const f32x4*)(bias + bcol0 + bj * HALF + 4 * n) : (f32x4){0.f, 0.f, 0.f, 0.f};
#pragma unroll
        for (int ai = 0; ai < 2; ++ai)
#pragma unroll
            for (int m = 0; m < 4; ++m) { bf16_t* rowp = base + (size_t)(row0 + ai * HALF + m * 16) * ldc + col0;
#pragma unroll
                for (int bj = 0; bj < 2; ++bj) { f32x4 v0 = acc[ai][bj][m][0] + bv[bj][0], v1 = acc[ai][bj][m][1] + bv[bj][1];
                    if (ACT == 1) { f32x2 a = gelu_pk((f32x2){v0[0], v0[1]}), b = gelu_pk((f32x2){v0[2], v0[3]}), c = gelu_pk((f32x2){v1[0], v1[1]}), d = gelu_pk((f32x2){v1[2], v1[3]});
                        v0 = (f32x4){a.x, a.y, b.x, b.y}; v1 = (f32x4){c.x, c.y, d.x, d.y}; }
                    v0 = v0 * sc; v1 = v1 * sc; u32x4 w; w.x = cvt_pk_bf16(v0[0], v0[1]); w.y = cvt_pk_bf16(v0[2], v0[3]); w.z = cvt_pk_bf16(v1[0], v1[1]); w.w = cvt_pk_bf16(v1[2], v1[3]);
                    *(u32x4*)(rowp + bj * HALF) = w; } }
    }
};

template <class Epi, class Sched, bool ALIGN_EPI = false, bool SP2 = false>
__device__ __forceinline__ void gemm_phase(PG8_LAS unsigned char* lds, const Gemm g, const Sched& S, const Epi& E) {
    const int tid = mk_tid(), wid = __builtin_amdgcn_readfirstlane(tid >> 6), lane = tid & 63, wr = wid >> 2, wc = wid & 3, fr = lane & 15, fq = lane >> 4;
    const int K = g.K, nt = K / BK;
    unsigned voffA[2], voffB[2];
#pragma unroll
    for (int i = 0; i < 2; ++i) { int R, C; stage_rc(tid * 16 + i * 8192, R, C); const int Rb = Epi::PERM ? ((R & ~31) + perm32(R & 31)) : R;
        voffA[i] = (unsigned)(R * K + C) * 2u; voffB[i] = (unsigned)(Rb * K + C) * 2u; }
    const size_t kstep = (size_t)(BK * 2);
    const size_t hstep = (size_t)HALF * K * 2;
    const size_t tstep = 2 * hstep;
    const unsigned ldsw = (unsigned)wid * 1024u;
    const int aoff = lds_byte(wr * 64 + fr, fq * 8), boff = lds_byte(wc * 32 + fr, fq * 8);
#define PG8_SA(b, h) (((b) * 2 + (h)) * HTB)
#define PG8_SB(b, h) ((4 + (b) * 2 + (h)) * HTB)
#define PG8_STAGE(bufoff, gbase, voff) do { _Pragma("unroll") for (int _i = 0; _i < 2; ++_i) \
        __builtin_amdgcn_global_load_lds((const unsigned*)((const char*)(gbase) + (voff)[_i]), (PG8_LAS unsigned*)(lds + (bufoff) + ldsw + _i * 8192), 16, 0, 0); } while (0)
#define PG8_LDA(dst, b, h) do { _Pragma("unroll") for (int m = 0; m < 4; ++m) _Pragma("unroll") for (int k = 0; k < 2; ++k) dst[m][k] = *(const PG8_LAS bf16x8*)(lds + PG8_SA(b, h) + aoff + m * 2048 + k * 1024); } while (0)
#define PG8_LDB(dst, b, h) do { _Pragma("unroll") for (int n = 0; n < 2; ++n) _Pragma("unroll") for (int k = 0; k < 2; ++k) dst[n][k] = *(const PG8_LAS bf16x8*)(lds + PG8_SB(b, h) + boff + n * 2048 + k * 1024); } while (0)
#define PG8_MMA(ai, bj, At, Bt) do { __builtin_amdgcn_s_setprio(1); _Pragma("unroll") for (int m = 0; m < 4; ++m) _Pragma("unroll") for (int n = 0; n < 2; ++n) _Pragma("unroll") for (int k = 0; k < 2; ++k) \
        acc[ai][bj][m][n] = __builtin_amdgcn_mfma_f32_16x16x32_bf16(Bt[n][k], At[m][k], acc[ai][bj][m][n], 0, 0, 0); __builtin_amdgcn_s_setprio(0); } while (0)
#define PG8_WAIT_V(n) asm volatile("s_waitcnt vmcnt(" #n ")" ::: "memory")
#define PG8_WAIT_L(n) asm volatile("s_waitcnt lgkmcnt(" #n ")" ::: "memory")
#define PG8_BAR __builtin_amdgcn_s_barrier()
#define PG8_SCHED __builtin_amdgcn_sched_barrier(0)
    Unit cur, nxt; int ui = 0;
    if (!S.next(0, cur)) return;
    f32x4 acc[2][2][4][2];
#pragma unroll
    for (int a = 0; a < 2; ++a)
#pragma unroll
        for (int b = 0; b < 2; ++b)
#pragma unroll
            for (int m = 0; m < 4; ++m)
#pragma unroll
                for (int n = 0; n < 2; ++n) acc[a][b][m][n] = (f32x4){0.f, 0.f, 0.f, 0.f};
    bf16x8 At[4][2], B0[2][2], B1[2][2];
    const char* cA = (const char*)g.A + (size_t)cur.pm * tstep; const char* cB = (const char*)g.Bt + (size_t)cur.pn * tstep;
    S.a_ready(cur);
    if constexpr (SP2) {
        PG8_STAGE(PG8_SB(0, 0), cB, voffB); PG8_STAGE(PG8_SB(0, 1), cB + hstep, voffB); PG8_STAGE(PG8_SA(0, 0), cA, voffA); PG8_STAGE(PG8_SA(0, 1), cA + hstep, voffA);
        if (wr == 1) PG8_BAR;
        PG8_WAIT_V(2); PG8_BAR;
        PG8_STAGE(PG8_SB(1, 0), cB + kstep, voffB); PG8_STAGE(PG8_SA(1, 0), cA + kstep, voffA); PG8_STAGE(PG8_SB(1, 1), cB + hstep + kstep, voffB);
        PG8_WAIT_V(6); PG8_BAR;
    } else {
        PG8_STAGE(PG8_SB(0, 0), cB, voffB); PG8_STAGE(PG8_SA(0, 0), cA, voffA); PG8_STAGE(PG8_SB(0, 1), cB + hstep, voffB); PG8_STAGE(PG8_SA(0, 1), cA + hstep, voffA);
        if (wr == 1) PG8_BAR;
        PG8_WAIT_V(4); PG8_BAR;
        PG8_STAGE(PG8_SB(1, 0), cB + kstep, voffB); PG8_STAGE(PG8_SA(1, 0), cA + kstep, voffA); PG8_STAGE(PG8_SB(1, 1), cB + hstep + kstep, voffB);
        PG8_WAIT_V(6); PG8_BAR;
    }
    for (;;) {
        const bool has_next = S.next(ui + 1, nxt);
        const char* nA = has_next ? (const char*)g.A + (size_t)nxt.pm * tstep : cA; const char* nB = has_next ? (const char*)g.Bt + (size_t)nxt.pn * tstep : cB;
        for (int t = 0; t < nt; t += 2) {
            const bool last = (t == nt - 2);
            const char* a1 = cA + (size_t)(t + 1) * kstep;
            const char* a2 = last ? nA : cA + (size_t)(t + 2) * kstep; const char* b2 = last ? nB : cB + (size_t)(t + 2) * kstep;
            const char* a3 = a2 + kstep; const char* b3 = b2 + kstep;
            if (last && has_next) S.a_ready(nxt);
            if constexpr (SP2) {
            PG8_LDB(B0, 0, 0); PG8_LDB(B1, 0, 1); PG8_SCHED; PG8_LDA(At, 0, 0); PG8_STAGE(PG8_SA(1, 1), a1 + hstep, voffA);
            PG8_WAIT_V(8); PG8_WAIT_L(0); PG8_BAR; PG8_MMA(0, 0, At, B0); PG8_MMA(0, 1, At, B1); PG8_BAR; PG8_SCHED;
            PG8_LDA(At, 0, 1); PG8_STAGE(PG8_SB(0, 0), b2, voffB); PG8_STAGE(PG8_SB(0, 1), b2 + hstep, voffB); PG8_STAGE(PG8_SA(0, 0), a2, voffA);
            PG8_WAIT_V(8); PG8_WAIT_L(0); PG8_BAR; PG8_MMA(1, 0, At, B0); PG8_MMA(1, 1, At, B1); PG8_BAR; PG8_SCHED;
            PG8_LDB(B0, 1, 0); PG8_LDB(B1, 1, 1); PG8_SCHED; PG8_LDA(At, 1, 0); PG8_STAGE(PG8_SA(0, 1), a2 + hstep, voffA);
            PG8_WAIT_V(8); PG8_WAIT_L(0); PG8_BAR; PG8_MMA(0, 0, At, B0); PG8_MMA(0, 1, At, B1); PG8_BAR; PG8_SCHED;
            PG8_LDA(At, 1, 1); PG8_STAGE(PG8_SB(1, 0), b3, voffB); PG8_STAGE(PG8_SB(1, 1), b3 + hstep, voffB); PG8_STAGE(PG8_SA(1, 0), a3, voffA);
            PG8_WAIT_V(8); PG8_WAIT_L(0); PG8_BAR; PG8_MMA(1, 0, At, B0); PG8_MMA(1, 1, At, B1); PG8_BAR; PG8_SCHED;
            } else {
            PG8_LDB(B0, 0, 0); PG8_SCHED; PG8_LDA(At, 0, 0); PG8_STAGE(PG8_SA(1, 1), a1 + hstep, voffA);
            PG8_WAIT_L(8); PG8_BAR; PG8_WAIT_L(0); PG8_MMA(0, 0, At, B0); PG8_BAR; PG8_SCHED;
            PG8_LDB(B1, 0, 1); PG8_STAGE(PG8_SB(0, 0), b2, voffB);
            PG8_BAR; PG8_WAIT_L(0); PG8_MMA(0, 1, At, B1); PG8_BAR;
            PG8_LDA(At, 0, 1); PG8_STAGE(PG8_SA(0, 0), a2, voffA);
            PG8_BAR; PG8_WAIT_L(0); PG8_MMA(1, 0, At, B0); PG8_BAR; PG8_SCHED;
            PG8_STAGE(PG8_SB(0, 1), b2 + hstep, voffB);
            PG8_WAIT_V(6); PG8_BAR; PG8_MMA(1, 1, At, B1); PG8_BAR;
            PG8_LDB(B0, 1, 0); PG8_SCHED; PG8_LDA(At, 1, 0); PG8_STAGE(PG8_SA(0, 1), a2 + hstep, voffA);
            PG8_WAIT_L(8); PG8_BAR; PG8_WAIT_L(0); PG8_MMA(0, 0, At, B0); PG8_BAR; PG8_SCHED;
            PG8_LDB(B1, 1, 1); PG8_STAGE(PG8_SB(1, 0), b3, voffB);
            PG8_BAR; PG8_WAIT_L(0); PG8_MMA(0, 1, At, B1); PG8_BAR;
            PG8_LDA(At, 1, 1); PG8_STAGE(PG8_SA(1, 0), a3, voffA);
            PG8_BAR; PG8_WAIT_L(0); PG8_MMA(1, 0, At, B0); PG8_BAR; PG8_SCHED;
            PG8_STAGE(PG8_SB(1, 1), b3 + hstep, voffB);
            PG8_WAIT_V(6); PG8_BAR; PG8_MMA(1, 1, At, B1); PG8_BAR;
            }
        }
        if constexpr (ALIGN_EPI) { if (wr == 0) PG8_BAR; }
        if constexpr (!Epi::AFTER_DRAIN) { E(acc, cur, wr, wc, fr, fq); S.done(cur); }
        if (!has_next) break;
#pragma unroll
        for (int a = 0; a < 2; ++a)
#pragma unroll
            for (int b = 0; b < 2; ++b)
#pragma unroll
                for (int m = 0; m < 4; ++m)
#pragma unroll
                    for (int n = 0; n < 2; ++n) acc[a][b][m][n] = (f32x4){0.f, 0.f, 0.f, 0.f};
        cur = nxt; cA = nA; cB = nB; ++ui;
        if constexpr (ALIGN_EPI) { if (wr == 1) PG8_BAR; }
    }
    PG8_WAIT_V(0);
    if constexpr (!ALIGN_EPI) { if (wr == 0) PG8_BAR; }
    PG8_BAR;
    if constexpr (Epi::AFTER_DRAIN) { E.fused(acc, cur, wr, wc, fr, fq, lds, wid, lane); S.done(cur); }
#undef PG8_SA
#undef PG8_SB
#undef PG8_STAGE
#undef PG8_LDA
#undef PG8_LDB
#undef PG8_MMA
#undef PG8_WAIT_V
#undef PG8_WAIT_L
#undef PG8_BAR
#undef PG8_SCHED
}
}

namespace att {
using bf16 = __hip_bfloat16;
constexpr int   D = 128, NW = 8, QBLK = 32, KVBLK = 64;
constexpr float SCALE = 0.088388347648318440f;
constexpr float THR = 8.f;
constexpr int SDEPTH = 2;
constexpr int LDQ = 3072, LDK = 3072, LDO = 2048;
constexpr size_t SHM_V = KVBLK * D * 2, SHM_K = KVBLK * D * 2, SHM_ATTN = 2 * SHM_V + 2 * SHM_K + NW * 64 * 4;
using bf16x8 = __attribute__((ext_vector_type(8))) short;
using s16x4  = __attribute__((ext_vector_type(4))) short;
using f32x16 = __attribute__((ext_vector_type(16))) float;
using f32x8  = __attribute__((ext_vector_type(8))) float;
using u32x4  = __attribute__((ext_vector_type(4))) unsigned;
#define KSWZ(row, colB) ((row) * 256 + ((colB) ^ (((row) & 7) << 4)))
#define SBAR() __builtin_amdgcn_sched_barrier(0)
__device__ __forceinline__ int crow(int r, int hi) { return (r & 3) + 8 * (r >> 2) + 4 * hi; }
__device__ __forceinline__ unsigned cvtpk(float lo, float hi) {
  unsigned r; asm volatile("v_cvt_pk_bf16_f32 %0, %1, %2" : "=v"(r) : "v"(lo), "v"(hi)); return r;
}
template <typename TIn> struct Stage;
template <> struct Stage<bf16>  { using T = bf16x8;
  __device__ static __forceinline__ T ld8(const bf16* p) { return *reinterpret_cast<const bf16x8*>(p); }
  __device__ static __forceinline__ bf16x8 tobf(T x) { return x; } };
template <> struct Stage<float> { using T = f32x8;
  __device__ static __forceinline__ T ld8(const float* p) { return *reinterpret_cast<const f32x8*>(p); }
  __device__ static __forceinline__ bf16x8 tobf(T x) {
    u32x4 w = {cvtpk(x[0], x[1]), cvtpk(x[2], x[3]), cvtpk(x[4], x[5]), cvtpk(x[6], x[7])}; return *reinterpret_cast<bf16x8*>(&w); } };

__device__ __forceinline__ void partialSM(f32x16& p0, f32x16& p1, float& m_reg, float& mn, float& alpha) {
  constexpr float C = SCALE * 1.4426950408889634f;
  float pmax = p0[0]; for (int r = 1; r < 16; ++r) pmax = fmaxf(pmax, p0[r]); for (int r = 0; r < 16; ++r) pmax = fmaxf(pmax, p1[r]);
  { auto rr = __builtin_amdgcn_permlane32_swap(__float_as_uint(pmax), __float_as_uint(pmax), false, false);
    pmax = fmaxf(__uint_as_float(rr[0]), __uint_as_float(rr[1])); }
  if (__builtin_expect(__all(pmax - m_reg <= THR / SCALE), 1)) { mn = m_reg; alpha = 1.f; }
  else { mn = fmaxf(m_reg, pmax); alpha = __builtin_amdgcn_exp2f((m_reg - mn) * C); m_reg = mn; }
  float mnC = -mn * C;
  for (int r = 0; r < 16; ++r) p0[r] = fmaf(p0[r], C, mnC); for (int r = 0; r < 16; ++r) p1[r] = fmaf(p1[r], C, mnC);
  for (int r = 0; r < 16; ++r) p0[r] = __builtin_amdgcn_exp2f(p0[r]);
}
__device__ __forceinline__ void finishSM(f32x16& p0, f32x16& p1, float alpha, float& l_reg, bf16x8& pa0, bf16x8& pa1, bf16x8& pa2, bf16x8& pa3) {
  for (int r = 0; r < 16; ++r) p1[r] = __builtin_amdgcn_exp2f(p1[r]);
  float ps = 0; for (int r = 0; r < 16; ++r) ps += p0[r]; for (int r = 0; r < 16; ++r) ps += p1[r];
  { auto rr = __builtin_amdgcn_permlane32_swap(__float_as_uint(ps), __float_as_uint(ps), false, false);
    ps = __uint_as_float(rr[0]) + __uint_as_float(rr[1]); }
  l_reg = l_reg * alpha + ps;
#define PK4(P, BASE, OUT) do { unsigned a0 = cvtpk(P[BASE + 0], P[BASE + 1]), a1 = cvtpk(P[BASE + 2], P[BASE + 3]);   \
    unsigned b0 = cvtpk(P[BASE + 4], P[BASE + 5]), b1 = cvtpk(P[BASE + 6], P[BASE + 7]);                              \
    auto r0 = __builtin_amdgcn_permlane32_swap(a0, b0, false, false); auto r1 = __builtin_amdgcn_permlane32_swap(a1, b1, false, false); \
    u32x4 w = {r0[0], r1[0], r0[1], r1[1]}; OUT = *reinterpret_cast<bf16x8*>(&w); } while (0)
  PK4(p0, 0, pa0); PK4(p0, 8, pa1); PK4(p1, 0, pa2); PK4(p1, 8, pa3);
#undef PK4
}
__device__ __forceinline__ void qkt(f32x16& p0, f32x16& p1, const bf16* Ks, const bf16x8* qr, int r32, int hi) {
  p0 = f32x16{}; p1 = f32x16{};
  for (int d0 = 0; d0 < 8; ++d0) { int cb = (d0 * 16 + hi * 8) * 2;
    bf16x8 b0 = *reinterpret_cast<const bf16x8*>((const char*)Ks + KSWZ(r32, cb));
    bf16x8 b1 = *reinterpret_cast<const bf16x8*>((const char*)Ks + KSWZ(32 + r32, cb));
    p0 = __builtin_amdgcn_mfma_f32_32x32x16_bf16(b0, qr[d0], p0, 0, 0, 0);
    p1 = __builtin_amdgcn_mfma_f32_32x32x16_bf16(b1, qr[d0], p1, 0, 0, 0); }
}
__device__ __forceinline__ int v_st(int k, int c) { const int kk = (k & ~0xC) | ((k & 4) << 1) | ((k & 8) >> 1); return ((kk >> 3) * 4 + (c >> 5)) * 512 + ((kk & 7) * 32 + (c & 31)) * 2; }
__device__ __forceinline__ int v_rd_base(int lane) { return ((lane & 3) << 3) | (((lane >> 2) & 3) << 6) | (((lane >> 4) & 1) << 5) | (((lane >> 5) & 1) << 8); }
constexpr int v_rd_off(int d0, int ks, int half) { return d0 * 512 + ks * 4096 + half * 2048; }
template <int OFF> __device__ __forceinline__ s16x4 tr_read(int vb) {
  s16x4 r; asm volatile("ds_read_b64_tr_b16 %0, %1 offset:%2" : "=&v"(r) : "v"(vb), "i"(OFF) : "memory"); return r;
}
template <int D0> __device__ __forceinline__ void pv_one(f32x16& od, int vb, bf16x8 pa0, bf16x8 pa1, bf16x8 pa2, bf16x8 pa3) {
  const s16x4 l0 = tr_read<v_rd_off(D0, 0, 0)>(vb), h0 = tr_read<v_rd_off(D0, 0, 1)>(vb), l1 = tr_read<v_rd_off(D0, 1, 0)>(vb), h1 = tr_read<v_rd_off(D0, 1, 1)>(vb);
  const s16x4 l2 = tr_read<v_rd_off(D0, 2, 0)>(vb), h2 = tr_read<v_rd_off(D0, 2, 1)>(vb), l3 = tr_read<v_rd_off(D0, 3, 0)>(vb), h3 = tr_read<v_rd_off(D0, 3, 1)>(vb);
  asm volatile("s_waitcnt lgkmcnt(0)" ::: "memory"); SBAR();
#define PK(L, H) (bf16x8){L[0], L[1], L[2], L[3], H[0], H[1], H[2], H[3]}
  od = __builtin_amdgcn_mfma_f32_32x32x16_bf16(pa0, PK(l0, h0), od, 0, 0, 0);
  od = __builtin_amdgcn_mfma_f32_32x32x16_bf16(pa1, PK(l1, h1), od, 0, 0, 0);
  od = __builtin_amdgcn_mfma_f32_32x32x16_bf16(pa2, PK(l2, h2), od, 0, 0, 0);
  od = __builtin_amdgcn_mfma_f32_32x32x16_bf16(pa3, PK(l3, h3), od, 0, 0, 0);
#undef PK
}
__device__ __forceinline__ void pv_d0(f32x16* o, int vb, bf16x8 pa0, bf16x8 pa1, bf16x8 pa2, bf16x8 pa3) {
  pv_one<0>(o[0], vb, pa0, pa1, pa2, pa3); pv_one<1>(o[1], vb, pa0, pa1, pa2, pa3); pv_one<2>(o[2], vb, pa0, pa1, pa2, pa3); pv_one<3>(o[3], vb, pa0, pa1, pa2, pa3);
}

template <typename TQ>
__device__ __forceinline__ void attn_dense_body(const TQ* __restrict__ Qb, const bf16* __restrict__ Kh, const bf16* __restrict__ Vh,
                                                unsigned short* __restrict__ Ob, int seq, char* lds) {
  using St = Stage<bf16>; using SQ = Stage<TQ>;
  const int tid = mk_tid(), wid = tid >> 6, lane = tid & 63, r32 = lane & 31, hi = lane >> 5;
  bf16* V_lds = (bf16*)lds; bf16* K_lds = (bf16*)(lds + 2 * SHM_V);
  float* ws = (float*)(lds + 2 * SHM_V + 2 * SHM_K) + wid * 64; float* li_l = ws; float* al_l = ws + 32;
  float m_reg = -1e30f, l_reg = 0; f32x16 o[4] = {}; bf16x8 qr[8];
  const TQ* Qw = Qb + (long)(wid * QBLK + r32) * LDQ + hi * 8;
#pragma unroll
  for (int d0 = 0; d0 < 8; ++d0) qr[d0] = SQ::tobf(SQ::ld8(Qw + d0 * 16));
  const int sr = tid >> 4, sc = (tid & 15) * 8, vst0 = v_st(sr, sc), vst1 = v_st(32 + sr, sc);
  const int vb0 = (int)(uintptr_t)V_lds + v_rd_base(lane);
  struct { typename St::T vs0, vs1, ks0, ks1; } sr_[SDEPTH];
#define SLOAD(i, k0) do { sr_[i].vs0 = St::ld8(&Vh[(long)((k0) + sr) * LDK + sc]); sr_[i].vs1 = St::ld8(&Vh[(long)((k0) + 32 + sr) * LDK + sc]); \
    sr_[i].ks0 = St::ld8(&Kh[(long)((k0) + sr) * LDK + sc]); sr_[i].ks1 = St::ld8(&Kh[(long)((k0) + 32 + sr) * LDK + sc]); } while (0)
#define SWRITE(b, i) do { *(bf16x8*)((char*)V_lds + (b) * SHM_V + vst0) = St::tobf(sr_[i].vs0);          \
    *(bf16x8*)((char*)V_lds + (b) * SHM_V + vst1) = St::tobf(sr_[i].vs1); int kc = sc * 2;               \
    *(bf16x8*)((char*)K_lds + (b) * SHM_K + KSWZ(sr, kc)) = St::tobf(sr_[i].ks0);                       \
    *(bf16x8*)((char*)K_lds + (b) * SHM_K + KSWZ(32 + sr, kc)) = St::tobf(sr_[i].ks1); } while (0)
#define SWAIT() do { if constexpr (SDEPTH == 2) asm volatile("s_waitcnt vmcnt(4)" ::: "memory"); else asm volatile("s_waitcnt vmcnt(0)" ::: "memory"); } while (0)
#define RESC(a) do { if (__any((a) < 1.f)) { if (hi == 0) al_l[r32] = (a); asm volatile("s_waitcnt lgkmcnt(0)" ::: "memory"); \
    for (int d = 0; d < 4; ++d) for (int r = 0; r < 16; ++r) o[d][r] *= al_l[crow(r, hi)]; } } while (0)
  f32x16 pA0, pA1, pB0, pB1; float mnA, mnB, alA, alB; bf16x8 pa0, pa1, pa2, pa3; const int NT = seq / KVBLK;
  constexpr int SE = 0, SO = SDEPTH - 1;
  SLOAD(SE, 0); asm volatile("s_waitcnt vmcnt(0)" ::: "memory"); SWRITE(0, SE); __syncthreads();
  qkt(pA0, pA1, K_lds, qr, r32, hi); partialSM(pA0, pA1, m_reg, mnA, alA);
  SLOAD(SO, KVBLK); if constexpr (SDEPTH == 2) { if (2 < NT) SLOAD(SE, 2 * KVBLK); }
  SWAIT(); SWRITE(1, SO); __syncthreads();
  for (int j = 1; j + 1 < NT; j += 2) {
    SBAR(); qkt(pB0, pB1, (bf16*)((char*)K_lds + SHM_K), qr, r32, hi);
    finishSM(pA0, pA1, alA, l_reg, pa0, pa1, pa2, pa3); SBAR();
    SLOAD(SO, (j + SDEPTH) * KVBLK); SBAR();
    pv_d0(o, vb0, pa0, pa1, pa2, pa3); partialSM(pB0, pB1, m_reg, mnB, alB);
    __syncthreads(); SWAIT(); SWRITE(0, SE);
    RESC(alB); __syncthreads();
    SBAR(); qkt(pA0, pA1, K_lds, qr, r32, hi);
    finishSM(pB0, pB1, alB, l_reg, pa0, pa1, pa2, pa3); SBAR();
    if (SDEPTH == 1 || j + 3 < NT) SLOAD(SE, (j + 1 + SDEPTH) * KVBLK); SBAR();
    pv_d0(o, vb0 + (int)SHM_V, pa0, pa1, pa2, pa3); partialSM(pA0, pA1, m_reg, mnA, alA);
    __syncthreads(); SWAIT(); SWRITE(1, SO);
    RESC(alA); __syncthreads();
  }
  SBAR(); qkt(pB0, pB1, (bf16*)((char*)K_lds + SHM_K), qr, r32, hi);
  finishSM(pA0, pA1, alA, l_reg, pa0, pa1, pa2, pa3); SBAR();
  pv_d0(o, vb0, pa0, pa1, pa2, pa3); partialSM(pB0, pB1, m_reg, mnB, alB);
  __syncthreads(); RESC(alB);
  finishSM(pB0, pB1, alB, l_reg, pa0, pa1, pa2, pa3); SBAR();
  pv_d0(o, vb0 + (int)SHM_V, pa0, pa1, pa2, pa3);
  if (hi == 0) li_l[r32] = l_reg; asm volatile("s_waitcnt lgkmcnt(0)" ::: "memory");
  float rli[16];
#pragma unroll
  for (int r = 0; r < 16; ++r) rli[r] = __builtin_amdgcn_rcpf(li_l[crow(r, hi)]);
  unsigned short* Ow = Ob + (long)(wid * QBLK) * LDO;
#pragma unroll
  for (int r = 0; r < 16; ++r) { int orow = crow(r, hi);
    for (int d0 = 0; d0 < 4; ++d0) Ow[(long)orow * LDO + d0 * 32 + r32] = (unsigned short)(cvtpk(o[d0][r] * rli[r], 0.f) & 0xffffu); }
#undef SLOAD
#undef SWRITE
#undef SWAIT
#undef RESC
}

}
__device__ __forceinline__ int mk_tid() { int t = threadIdx.x; asm volatile("" : "+v"(t)); return t; }
namespace mk {
#define LAS __attribute__((address_space(3)))
typedef unsigned short bf16;
typedef short bf16x8 __attribute__((ext_vector_type(8)));
typedef float f32x4 __attribute__((ext_vector_type(4)));
typedef unsigned u32x4 __attribute__((ext_vector_type(4)));
typedef unsigned u32x2 __attribute__((ext_vector_type(2)));
#define XB_TMO      128
#define XB_XCNT(j)  (256  + 64 * (j))
#define XB_XSUB(j)  (1280 + 64 * (j))
#define XB_XGEN(j)  (2304 + 64 * (j))
#define XB_TOP      3328
#define XB_TOPGEN   3392
#define XCD_BAR_WORDS 3456
#define XB_SPIN_CAP (1u << 18)

__device__ __forceinline__ unsigned xb_ld(unsigned* p)              { return __hip_atomic_load(p, __ATOMIC_RELAXED, __HIP_MEMORY_SCOPE_AGENT); }
__device__ __forceinline__ unsigned xb_add(unsigned* p, unsigned v) { return __hip_atomic_fetch_add(p, v, __ATOMIC_RELAXED, __HIP_MEMORY_SCOPE_AGENT); }
__device__ __forceinline__ unsigned xb_xcc_id() { return (unsigned)__builtin_amdgcn_s_getreg((3 << 11) | 20) & 0xFu; }
#define XB_SPIN(cond, bar) do { unsigned _sp = 0; while (cond) { __builtin_amdgcn_s_sleep(1); \
    if ((++_sp & 255u) == 0u) { if (xb_ld(&(bar)[XB_TMO])) break; if (_sp > XB_SPIN_CAP) { atomicAdd(&(bar)[XB_TMO], 1u); break; } } } } while (0)

struct XcdBarrier {
    unsigned* bar; unsigned x;
    volatile LAS unsigned* st;
};

__device__ __forceinline__ XcdBarrier xcd_barrier_post(unsigned* bar, volatile LAS unsigned* st) {
    XcdBarrier b; b.bar = bar; b.x = xb_xcc_id(); b.st = st;
    if (mk_tid() == 0) (void)xb_add(&bar[XB_XCNT(b.x)], 1u);
    return b;
}
__device__ __forceinline__ void xcd_barrier_complete(unsigned* bar, unsigned x, unsigned& nloc, unsigned& nx) {
    const unsigned G = gridDim.x * gridDim.y * gridDim.z;
    unsigned sum, cnt, mine, sp = 0u;
    for (;;) {
        sum = 0u; cnt = 0u; mine = 0u;
#pragma unroll
        for (unsigned j = 0; j < 16; ++j) { const unsigned c = xb_ld(&bar[XB_XCNT(j)]); sum += c; cnt += (c > 0u) ? 1u : 0u; mine = (j == x) ? c : mine; }
        if (sum == G) break;
        __builtin_amdgcn_s_sleep(1);
        if ((++sp & 255u) == 0u) { if (xb_ld(&bar[XB_TMO])) break; if (sp > XB_SPIN_CAP) { atomicAdd(&bar[XB_TMO], 1u); break; } }
    }
    nloc = mine > 0u ? mine : 1u; nx = cnt > 0u ? cnt : 1u;
}

__device__ __forceinline__ void xcd_barrier(const XcdBarrier& b) {
    asm volatile("s_waitcnt vmcnt(0)" ::: "memory");
    __syncthreads();
    if (mk_tid() == 0) {
        unsigned* bar = b.bar;
        __builtin_amdgcn_s_waitcnt(0);
        unsigned nloc = b.st[0], nx = b.st[1];
        if (nloc == 0u) { xcd_barrier_complete(bar, b.x, nloc, nx); b.st[0] = nloc; b.st[1] = nx; }
        const unsigned old = xb_add(&bar[XB_XSUB(b.x)], 1u);
        const unsigned gen = old / nloc;
        if (old + 1u == (gen + 1u) * nloc) {
            __builtin_amdgcn_fence(__ATOMIC_RELEASE, "agent");
            asm volatile("s_waitcnt vmcnt(0)" ::: "memory");
            const unsigned og = xb_add(&bar[XB_TOP], 1u);
            const unsigned tg = og / nx;
            if (og + 1u == (tg + 1u) * nx) xb_add(&bar[XB_TOPGEN], 1u);
            else XB_SPIN(xb_ld(&bar[XB_TOPGEN]) == tg, bar);
            __builtin_amdgcn_fence(__ATOMIC_ACQUIRE, "agent");
            xb_add(&bar[XB_XGEN(b.x)], 1u);
            asm volatile("s_waitcnt vmcnt(0)" ::: "memory");
        } else {
            XB_SPIN(xb_ld(&bar[XB_XGEN(b.x)]) == gen, bar);
            __builtin_amdgcn_fence(__ATOMIC_ACQUIRE, "agent");
            asm volatile("s_waitcnt vmcnt(0)" ::: "memory");
        }
    }
    __syncthreads();
}


constexpr int D = 2048, M = 8192, SEQ = 4096, NW = 8;
constexpr int ABW = 3072, CW = 8224, FF2 = 11264, FF = 5632;
constexpr float EPS = 1e-6f;
constexpr size_t MiB = 1u << 20;
constexpr size_t WS_AB = 0, WS_BD = 12 * MiB, WS_OAB = 13 * MiB, WS_C = 21 * MiB  , WS_OC = 54 * MiB;
constexpr size_t WS_UP0 = 62 * MiB, WS_UP1 = 106 * MiB, WS_DN0 = 150 * MiB, WS_DN1 = 172 * MiB;
constexpr size_t WS_XN = 194 * MiB, WS_GATES = 226 * MiB, WS_S = 228 * MiB;
constexpr size_t WS_PROJ = WS_S, WS_POOLED = WS_S + 48 * MiB, WS_CAT = WS_S + 56 * MiB;
constexpr size_t WS_QK = WS_S, WS_OG = WS_S + 64 * MiB, WS_KVT = WS_S + 96 * MiB, WS_HF = WS_S + 160 * MiB, WS_Y = WS_S + 288 * MiB;
constexpr size_t WS_U = WS_S, WS_ACT = WS_S + 176 * MiB;
constexpr size_t WS_END = WS_S + 320 * MiB;
constexpr int LDS_ML = 154112 + 1024, LDS_MISC = LDS_ML, LDS_BYTES = LDS_ML + 64;
constexpr size_t WS_BAR = WS_BD + 768 * 1024, BAR_BYTES = 16384;

#define LDSWAIT() asm volatile("s_waitcnt lgkmcnt(0)" ::: "memory")
__device__ __forceinline__ unsigned f2bf(float f) { unsigned u = __float_as_uint(f); return (u + 0x7fffu + ((u >> 16) & 1u)) >> 16; }
__device__ __forceinline__ unsigned pk2(float lo, float hi) { unsigned r; asm volatile("v_cvt_pk_bf16_f32 %0, %1, %2" : "=v"(r) : "v"(lo), "v"(hi)); return r; }
__device__ __forceinline__ float bflo(unsigned w) { return __uint_as_float(w << 16); }
__device__ __forceinline__ float bfhi(unsigned w) { return __uint_as_float(w & 0xffff0000u); }
__device__ __forceinline__ float wave_sum(float v) {
#pragma unroll
    for (int o = 1; o < 64; o <<= 1) v += __shfl_xor(v, o);
    return v;
}

__device__ __forceinline__ void transpose_item64(const float* __restrict__ W, int ldw, int K, int nblk, bf16* __restrict__ WT, LAS float* scr, int item, int lane, bool upperm) {
    const int kb = item / nblk, nb = item - kb * nblk, k0 = 64 * kb, n0 = 64 * nb;
    const int d0 = !upperm ? n0 : (n0 < FF ? 256 * (n0 >> 7) + (n0 & 127) : 256 * ((n0 - FF) >> 7) + 128 + ((n0 - FF) & 127));
    f32x4 v[16];
#pragma unroll
    for (int i = 0; i < 16; ++i) { const int kk = 4 * i + (lane >> 4); v[i] = *(const f32x4*)(W + (size_t)(k0 + kk) * ldw + n0 + 4 * (lane & 15)); }
#pragma unroll
    for (int i = 0; i < 16; ++i) { const int kk = 4 * i + (lane >> 4); LAS float* s = scr + kk * 65 + 4 * (lane & 15); s[0] = v[i].x; s[1] = v[i].y; s[2] = v[i].z; s[3] = v[i].w; }
    LDSWAIT();
    const int c = lane & 7, q = lane >> 3;
#pragma unroll
    for (int j = 0; j < 8; ++j) { const int n = q + 8 * j; const LAS float* s = scr + (8 * c) * 65 + n;
        u32x4 o; o.x = pk2(s[0], s[65]); o.y = pk2(s[130], s[195]); o.z = pk2(s[260], s[325]); o.w = pk2(s[390], s[455]);
        *(u32x4*)(WT + (size_t)(d0 + n) * K + k0 + 8 * c) = o; }
    LDSWAIT();
}

__device__ __forceinline__ void rmsnorm_rows(const float* __restrict__ src, const float* __restrict__ gain, bf16* __restrict__ dst, int gw, int ngw, int lane) {
    f32x4 g[8];
#pragma unroll
    for (int j = 0; j < 8; ++j) g[j] = *(const f32x4*)(gain + 4 * lane + 256 * j);
    for (int m = gw; m < M; m += ngw) {
        const f32x4* xr = (const f32x4*)(src + (size_t)m * D) + lane; f32x4 v[8]; float s = 0.f;
#pragma unroll
        for (int j = 0; j < 8; ++j) { v[j] = xr[64 * j]; s += (v[j].x * v[j].x + v[j].y * v[j].y) + (v[j].z * v[j].z + v[j].w * v[j].w); }
        const float rstd = 1.0f / sqrtf(wave_sum(s) * (1.0f / D) + EPS);
        u32x2* o = (u32x2*)(dst + (size_t)m * D) + lane;
#pragma unroll
        for (int j = 0; j < 8; ++j) { u32x2 w; w.x = pk2(v[j].x * rstd * g[j].x, v[j].y * rstd * g[j].y); w.y = pk2(v[j].z * rstd * g[j].z, v[j].w * rstd * g[j].w); o[64 * j] = w; }
    }
}

struct In { const float *x, *norm_mix, *norm_ffn, *w_in_ab, *pool_w, *pool_scale, *q_norm, *k_norm, *w_out_ab, *w_in_c, *b_gate, *h_norm, *w_out_c, *w_up, *conv_w, *conv_b, *w_down; };

__device__ __forceinline__ void transposes(const In& I, unsigned char* ws, LAS unsigned char* lds, int first, int last, int w, int nw, int wave, int lane) {
    LAS float* scr = (LAS float*)(lds + wave * 16640);
    for (int it = first + w; it < last; it += nw) {
        const float* W; int ldw, K, nblk; bf16* WT; int r = it;
        if (r < 1536) { W = I.w_in_ab; ldw = ABW; K = D; nblk = 48; WT = (bf16*)(ws + WS_AB); }
        else if (r < 2560) { r -= 1536; W = I.w_out_ab; ldw = D; K = D; nblk = 32; WT = (bf16*)(ws + WS_OAB); }
        else if (r < 6656) { r -= 2560; W = I.w_in_c; ldw = CW; K = D; nblk = 128; WT = (bf16*)(ws + WS_C); }
        else if (r < 7680) { r -= 6656; W = I.w_out_c; ldw = D; K = D; nblk = 32; WT = (bf16*)(ws + WS_OC); }
        else if (r < 13312) { r -= 7680; W = I.w_up; ldw = FF2; K = D; nblk = 176; WT = (bf16*)(ws + WS_UP0); }
        else if (r < 18944) { r -= 13312; W = I.w_up + (size_t)D * FF2; ldw = FF2; K = D; nblk = 176; WT = (bf16*)(ws + WS_UP1); }
        else if (r < 21760) { r -= 18944; W = I.w_down; ldw = D; K = FF; nblk = 32; WT = (bf16*)(ws + WS_DN0); }
        else { r -= 21760; W = I.w_down + (size_t)FF * D; ldw = D; K = FF; nblk = 32; WT = (bf16*)(ws + WS_DN1); }
        transpose_item64(W, ldw, K, nblk, WT, scr, r, lane, (it >= 7680 && it < 18944));
    }
}
__device__ __forceinline__ void prologue(const In& I, unsigned char* ws, LAS unsigned char* lds, int gw, int ngw, int wave, int lane) {
    transposes(I, ws, lds, 0, 1536, gw, ngw, wave, lane);
    const int gt = gw * 64 + lane, ngt = ngw * 64;
    { bf16* WG = (bf16*)(ws + WS_C) + (size_t)8192 * D;
      for (int idx = gt; idx < 32 * D; idx += ngt) { const int j = idx >> 11, k = idx & 2047; WG[idx] = (bf16)f2bf(I.w_in_c[(size_t)k * CW + 8192 + j]); } }
    { bf16* BD = (bf16*)(ws + WS_BD);
      for (int idx = gt; idx < 512 * 512; idx += ngt) { const int n = idx >> 9, k = idx & 511, gn = n >> 7, gk = k >> 7;
          const float v = (gn == gk) ? I.pool_w[(size_t)(gn * 128 + (k & 127)) * 128 + (n & 127)] * I.pool_scale[n] : 0.f; BD[idx] = (bf16)f2bf(v); } }
    rmsnorm_rows(I.x, I.norm_mix, (bf16*)(ws + WS_XN), gw, ngw, lane);
}

__device__ __forceinline__ void qk_rope_pool(bf16* __restrict__ PROJ, const float* __restrict__ qn, const float* __restrict__ kn, bf16* __restrict__ POOLED, int gw, int ngw, int lane) {
    const int l = lane & 31, hsel = lane >> 5, part = (l >> 4) & 1; const bool first = (l & 8) == 0;
    float inv[4];
#pragma unroll
    for (int e = 0; e < 4; ++e) inv[e] = exp2f(-(float)(4 * (l & 7) + e) * (13.287712379549449f / 32.0f));
    const f32x4 gq = *(const f32x4*)(qn + 4 * l), gk = *(const f32x4*)(kn + 4 * l);
    for (int it = gw; it < M * 8; it += ngw) {
        const int t = it >> 3, hh = (it & 7) * 2 + hsel;
        bf16* p = PROJ + (size_t)t * ABW + 512 + hh * 128 + 4 * l;
        const u32x2 w = *(const u32x2*)p;
        float x[4] = {bflo(w.x), bfhi(w.x), bflo(w.y), bfhi(w.y)};
        float ss = (x[0] * x[0] + x[1] * x[1]) + (x[2] * x[2] + x[3] * x[3]);
#pragma unroll
        for (int o = 1; o < 32; o <<= 1) ss += __shfl_xor(ss, o);
        const float rstd = 1.0f / sqrtf(ss * (1.0f / 128.0f) + EPS);
        const f32x4 g = (hh < 12) ? gq : gk;
        const int pos = t & (SEQ - 1); const float pp = part ? (float)(pos & 63) : (float)(pos >> 6);
        float y[4] = {x[0] * rstd * g.x, x[1] * rstd * g.y, x[2] * rstd * g.z, x[3] * rstd * g.w}, o4[4];
#pragma unroll
        for (int e = 0; e < 4; ++e) { const float yp = __shfl_xor(y[e], 8); const float ang = pp * inv[e]; const float sn = __sinf(ang), cs = __cosf(ang);
            o4[e] = y[e] * cs + (first ? -yp : yp) * sn; }
        u32x2 ow; ow.x = pk2(o4[0], o4[1]); ow.y = pk2(o4[2], o4[3]); *(u32x2*)p = ow;
    }
    const int gt = gw * 64 + lane, ngt = ngw * 64;
    for (int it = gt; it < M * 64; it += ngt) {
        const int t = it >> 6, c8 = (it & 63) * 8, g = c8 >> 7, w2 = 1 << g, pos = t & (SEQ - 1), base = t - pos;
        const int lo = max(pos - w2, 0), hi = min(pos + w2, SEQ);
        float acc[8] = {0.f, 0.f, 0.f, 0.f, 0.f, 0.f, 0.f, 0.f};
        for (int pz = lo; pz < hi; ++pz) { const u32x4 v = *(const u32x4*)(PROJ + (size_t)(base + pz) * ABW + c8);
            acc[0] += bflo(v.x); acc[1] += bfhi(v.x); acc[2] += bflo(v.y); acc[3] += bfhi(v.y); acc[4] += bflo(v.z); acc[5] += bfhi(v.z); acc[6] += bflo(v.w); acc[7] += bfhi(v.w); }
        const u32x4 sv = *(const u32x4*)(PROJ + (size_t)t * ABW + c8); const float iv = 1.0f / (float)(hi - lo);
        u32x4 o; o.x = pk2(acc[0] * iv - bflo(sv.x), acc[1] * iv - bfhi(sv.x)); o.y = pk2(acc[2] * iv - bflo(sv.y), acc[3] * iv - bfhi(sv.y));
        o.z = pk2(acc[4] * iv - bflo(sv.z), acc[5] * iv - bfhi(sv.z)); o.w = pk2(acc[6] * iv - bflo(sv.w), acc[7] * iv - bfhi(sv.w));
        *(u32x4*)(POOLED + (size_t)t * 512 + c8) = o;
    }
}

__device__ __forceinline__ void conv_fix(const bf16* __restrict__ HALO, const float* __restrict__ cw, const float* __restrict__ cb, bf16* __restrict__ ACT, int gt, int ngt) {
    for (int it = gt; it < 256 * 704; it += ngt) {
        const int jc = it % 704, re = it / 704, blk = re >> 1, last = re & 1, j = jc * 8;
        const int t = blk * 64 + (last ? 63 : 0), pos = t & (SEQ - 1);
        const bf16* rc = HALO + ((size_t)blk * 4 + (last ? 3 : 0)) * FF2 + j;
        const bf16* ru = last ? rc - FF2 : HALO + ((size_t)(blk - 1) * 4 + 3) * FF2 + j;
        const bf16* rd = last ? HALO + ((size_t)(blk + 1) * 4) * FF2 + j : rc + FF2;
        const u32x4 z = {0u, 0u, 0u, 0u};
        const u32x4 g1 = *(const u32x4*)rc, v1 = *(const u32x4*)(rc + FF);
        const u32x4 g0 = pos > 0 ? *(const u32x4*)ru : z, v0 = pos > 0 ? *(const u32x4*)(ru + FF) : z;
        const u32x4 g2 = pos < SEQ - 1 ? *(const u32x4*)rd : z, v2 = pos < SEQ - 1 ? *(const u32x4*)(rd + FF) : z;
        float o[8];
#pragma unroll
        for (int q = 0; q < 4; ++q) {
            const int ja = j + 2 * q, jb = ja + 1;
            const float ga = cw[ja] * bflo(g0[q]) + cw[FF2 + ja] * bflo(g1[q]) + cw[2 * FF2 + ja] * bflo(g2[q]) + cb[ja];
            const float gb = cw[jb] * bfhi(g0[q]) + cw[FF2 + jb] * bfhi(g1[q]) + cw[2 * FF2 + jb] * bfhi(g2[q]) + cb[jb];
            const float va = cw[FF + ja] * bflo(v0[q]) + cw[FF2 + FF + ja] * bflo(v1[q]) + cw[2 * FF2 + FF + ja] * bflo(v2[q]) + cb[FF + ja];
            const float vb = cw[FF + jb] * bfhi(v0[q]) + cw[FF2 + FF + jb] * bfhi(v1[q]) + cw[2 * FF2 + FF + jb] * bfhi(v2[q]) + cb[FF + jb];
            o[2 * q] = ga / (1.0f + __expf(-ga)) * va; o[2 * q + 1] = gb / (1.0f + __expf(-gb)) * vb;
        }
        u32x4 ow; ow.x = pk2(o[0], o[1]); ow.y = pk2(o[2], o[3]); ow.z = pk2(o[4], o[5]); ow.w = pk2(o[6], o[7]);
        *(u32x4*)(ACT + (size_t)t * FF + j) = ow;
    }
}

__device__ __forceinline__ void gates_phase(const bf16* __restrict__ XN, const bf16* __restrict__ WG, const float* __restrict__ bg, float* __restrict__ GATES, LAS float* red, int bid, int nblk) {
    const int tid = mk_tid(), wid = tid >> 6, lane = tid & 63, fr = lane & 15, fq = lane >> 4;
    const int tile = wid & 3, tt = tile & 1, jt = tile >> 1, kh = wid >> 2;
    for (int grp = bid; grp < 256; grp += nblk) {
        f32x4 acc = {0.f, 0.f, 0.f, 0.f};
        const bf16* ap = WG + (size_t)(jt * 16 + fr) * D + kh * 1024 + fq * 8;
        const bf16* bp = XN + (size_t)(grp * 32 + tt * 16 + fr) * D + kh * 1024 + fq * 8;
#pragma unroll 8
        for (int ks = 0; ks < 32; ++ks) { const bf16x8 a = *(const bf16x8*)(ap + ks * 32), b = *(const bf16x8*)(bp + ks * 32); acc = __builtin_amdgcn_mfma_f32_16x16x32_bf16(a, b, acc, 0, 0, 0); }
        if (kh == 1) { LAS float* r = red + (tile * 64 + lane) * 4; r[0] = acc[0]; r[1] = acc[1]; r[2] = acc[2]; r[3] = acc[3]; }
        __syncthreads();
        if (kh == 0) { const LAS float* r = red + (tile * 64 + lane) * 4; const int t = grp * 32 + tt * 16 + fr, j = jt * 16 + 4 * fq;
            const f32x4 b4 = *(const f32x4*)(bg + j); f32x4 o; o.x = acc[0] + r[0] + b4.x; o.y = acc[1] + r[1] + b4.y; o.z = acc[2] + r[2] + b4.z; o.w = acc[3] + r[3] + b4.w;
            *(f32x4*)(GATES + (size_t)t * 32 + j) = o; }
        __syncthreads();
    }
}

__device__ __forceinline__ void headnorm_phase(const float* __restrict__ HF, const bf16* __restrict__ OG, const float* __restrict__ hn, bf16* __restrict__ Y, int gw, int ngw, int lane) {
    for (int it = gw; it < M * 8; it += ngw) {
        const int t = it >> 3, h = it & 7; const size_t off = (size_t)t * D + h * 256 + 4 * lane;
        const f32x4 a = *(const f32x4*)(HF + off), b = *(const f32x4*)(HF + (size_t)M * D + off); const f32x4 s = a + b;
        const float ss = wave_sum((s.x * s.x + s.y * s.y) + (s.z * s.z + s.w * s.w));
        const float rstd = 1.0f / sqrtf(ss * (1.0f / 256.0f) + EPS);
        const f32x4 g = *(const f32x4*)(hn + h * 256 + 4 * lane); const u32x2 ow = *(const u32x2*)(OG + off);
        const float o0 = bflo(ow.x), o1 = bfhi(ow.x), o2 = bflo(ow.y), o3 = bfhi(ow.y);
        u32x2 w; w.x = pk2(s.x * rstd * g.x / (1.0f + __expf(-o0)), s.y * rstd * g.y / (1.0f + __expf(-o1)));
        w.y = pk2(s.z * rstd * g.z / (1.0f + __expf(-o2)), s.w * rstd * g.w / (1.0f + __expf(-o3)));
        *(u32x2*)(Y + off) = w;
    }
}

namespace ml {
constexpr int LQ = 264, LS = 72;
constexpr int OFF_Q = 0, OFF_K = 33792, OFF_KT = 67584, OFF_VT = 104448, OFF_VTW = 111360, OFF_P = 118272, OFF_CT = 127488, OFF_SC = 152832;
static_assert(OFF_SC + 1280 + 1024 == LDS_ML, "mlstm lds map");
#define ML_BAR() do { asm volatile("s_waitcnt lgkmcnt(0)" ::: "memory"); __builtin_amdgcn_s_barrier(); asm volatile("" ::: "memory"); } while (0)
#define ML_DPP(old, src, ctrl, rmask) __int_as_float(__builtin_amdgcn_update_dpp(__float_as_int(old), __float_as_int(src), ctrl, rmask, 0xF, false))
#define ML_MFMA(a, b, c) __builtin_amdgcn_mfma_f32_16x16x32_bf16(a, b, c, 0, 0, 0)

__device__ __forceinline__ void mlstm_phase(LAS unsigned char* lds, const bf16* __restrict__ QK, const bf16* __restrict__ KVT, const float* __restrict__ GATES, float* __restrict__ HF, int bid, int nblk) {
    const int tid = mk_tid(), wid = tid >> 6, lane = tid & 63, fr = lane & 15, fq = lane >> 4;
    LAS bf16* Qs = (LAS bf16*)(lds + OFF_Q); LAS bf16* Ks = (LAS bf16*)(lds + OFF_K); LAS bf16* KTs = (LAS bf16*)(lds + OFF_KT);
    LAS bf16* VTs = (LAS bf16*)(lds + OFF_VT); LAS bf16* VTw = (LAS bf16*)(lds + OFF_VTW); LAS bf16* Ps = (LAS bf16*)(lds + OFF_P); LAS bf16* CTs = (LAS bf16*)(lds + OFF_CT);
    LAS float* sA = (LAS float*)(lds + OFF_SC); LAS float* sM = sA + 64; LAS float* sAI = sM + 64; LAS float* sEM = sAI + 64; LAS float* sWS = (LAS float*)(lds + OFF_SC + 1280);
    const int tt = wid & 3, sh = wid >> 2;
    for (int it0 = bid; it0 < 256; it0 += nblk) {
        const int item = (nblk == 256) ? (((it0 & 7) * 4 + (it0 >> 6)) * 8 + ((it0 >> 3) & 7)) : it0;
        const int es = item & 7, dir = (item >> 3) & 1, h = (item >> 4) & 7, b = (item >> 7) & 1;
        for (int i = tid; i < 48 * LQ / 2; i += 512) ((LAS unsigned*)CTs)[i] = 0u;
        for (int i = tid; i < 16 * LS; i += 512) { VTs[32 * LS + i] = (i < LS) ? (bf16)0x3F80 : (bf16)0; VTw[32 * LS + i] = (bf16)0; }
        f32x4 ct[2][3];
#pragma unroll
        for (int a = 0; a < 2; ++a)
#pragma unroll
            for (int e = 0; e < 3; ++e) ct[a][e] = (f32x4){0.f, 0.f, 0.f, 0.f};
        float m_st = 0.f, decay = 1.f;
        bf16x8 rq[4], rk[4], rkt[4], rvt = {0, 0, 0, 0, 0, 0, 0, 0}; float gi = 0.f, gf = 0.f;
        const unsigned voffQ = (unsigned)(((tid >> 5) * 4096 + (tid & 31) * 8) * 2), voffT = (unsigned)(((tid >> 3) * M + (tid & 7) * 8) * 2), voffG = (unsigned)((dir ? 63 - lane : lane) * 128);
#define ML_LOAD(c) do { const int ncn_ = dir ? 63 - (c) : (c); const size_t trow_ = (size_t)b * SEQ + (size_t)ncn_ * 64; \
        const char* qb_ = (const char*)(QK + trow_ * 4096 + h * 256); \
        _Pragma("unroll") for (int i_ = 0; i_ < 4; ++i_) { rq[i_] = *(const bf16x8*)(qb_ + (size_t)i_ * 131072 + voffQ); rk[i_] = *(const bf16x8*)(qb_ + 4096 + (size_t)i_ * 131072 + voffQ); } \
        const char* tb_ = (const char*)(KVT + (size_t)(h * 256) * M + trow_); \
        _Pragma("unroll") for (int i_ = 0; i_ < 4; ++i_) rkt[i_] = *(const bf16x8*)(tb_ + (size_t)i_ * (64 * M * 2) + voffT); \
        if (tid < 256) rvt = *(const bf16x8*)((const char*)(KVT + (size_t)(2048 + h * 256 + es * 32) * M + trow_) + voffT); \
        { const float* gp_ = GATES + trow_ * 32 + dir * 16 + h; gi = *(const float*)((const char*)gp_ + voffG); gf = *(const float*)((const char*)gp_ + 32 + voffG); } } while (0)
#define ML_STORE() do { \
        const float lf_ = fminf(gf, 0.f) - log1pf(__expf(-fabsf(gf))); float bc_ = lf_; \
        bc_ += ML_DPP(0.f, bc_, 0x111, 0xF); bc_ += ML_DPP(0.f, bc_, 0x112, 0xF); bc_ += ML_DPP(0.f, bc_, 0x114, 0xF); bc_ += ML_DPP(0.f, bc_, 0x118, 0xF); \
        bc_ += ML_DPP(0.f, bc_, 0x142, 0xA); bc_ += ML_DPP(0.f, bc_, 0x143, 0xC); \
        const float a_ = gi - bc_; float cm_ = a_; \
        cm_ = fmaxf(cm_, ML_DPP(-3.0e38f, cm_, 0x111, 0xF)); cm_ = fmaxf(cm_, ML_DPP(-3.0e38f, cm_, 0x112, 0xF)); cm_ = fmaxf(cm_, ML_DPP(-3.0e38f, cm_, 0x114, 0xF)); cm_ = fmaxf(cm_, ML_DPP(-3.0e38f, cm_, 0x118, 0xF)); \
        cm_ = fmaxf(cm_, ML_DPP(-3.0e38f, cm_, 0x142, 0xA)); cm_ = fmaxf(cm_, ML_DPP(-3.0e38f, cm_, 0x143, 0xC)); \
        const float Mv_ = fmaxf(m_st, cm_), blast_ = __shfl(bc_, 63), cml_ = __shfl(cm_, 63), Mn_ = fmaxf(m_st, cml_); \
        const float ai_ = __expf(m_st - Mv_), em_ = __expf(-(bc_ + Mv_)), wsv_ = __expf(a_ - Mn_); decay = __expf(m_st - Mn_); m_st = blast_ + Mn_; \
        const int rr_ = dir ? 63 - lane : lane; \
        if (wid == 0) { sA[rr_] = a_; sM[rr_] = Mv_; sAI[rr_] = ai_; sEM[rr_] = em_; VTw[32 * LS + rr_] = (bf16)f2bf(wsv_); } \
        _Pragma("unroll") for (int i_ = 0; i_ < 4; ++i_) { const int q_ = tid + 512 * i_, r_ = q_ >> 5, cc_ = (q_ & 31) * 8; \
            *(LAS bf16x8*)(Qs + r_ * LQ + cc_) = rq[i_]; *(LAS bf16x8*)(Ks + r_ * LQ + cc_) = rk[i_]; } \
        _Pragma("unroll") for (int i_ = 0; i_ < 4; ++i_) { const int q_ = tid + 512 * i_, d_ = q_ >> 3, cc_ = (q_ & 7) * 8; *(LAS bf16x8*)(KTs + d_ * LS + cc_) = rkt[i_]; } \
        if (tid < 256) { const int e_ = tid >> 3, cc_ = (tid & 7) * 8; *(LAS bf16x8*)(VTs + e_ * LS + cc_) = rvt; \
            LAS float* wsp_ = sWS + wid * 64; wsp_[rr_] = wsv_; asm volatile("s_waitcnt lgkmcnt(0)" ::: "memory"); \
            const f32x4 wa_ = *(const LAS f32x4*)(wsp_ + cc_), wb_ = *(const LAS f32x4*)(wsp_ + cc_ + 4); const float wv_[8] = {wa_.x, wa_.y, wa_.z, wa_.w, wb_.x, wb_.y, wb_.z, wb_.w}; \
            const u32x4 rv_ = __builtin_bit_cast(u32x4, rvt); u32x4 o_; \
            o_.x = pk2(bflo(rv_.x) * wv_[0], bfhi(rv_.x) * wv_[1]); o_.y = pk2(bflo(rv_.y) * wv_[2], bfhi(rv_.y) * wv_[3]); \
            o_.z = pk2(bflo(rv_.z) * wv_[4], bfhi(rv_.z) * wv_[5]); o_.w = pk2(bflo(rv_.w) * wv_[6], bfhi(rv_.w) * wv_[7]); \
            *(LAS u32x4*)(VTw + e_ * LS + cc_) = o_; } } while (0)
        ML_LOAD(0);
        ML_BAR();
        ML_STORE();
        ML_BAR();
        ML_LOAD(1);
        for (int c = 0; c < 64; ++c) {
            const int ncn = dir ? 63 - c : c; const size_t trow = (size_t)b * SEQ + (size_t)ncn * 64;
            const float dec_c = decay;
            f32x4 s0 = {0.f, 0.f, 0.f, 0.f}, s1 = s0, n3 = s0, d3 = s0;
            {
                const LAS bf16* qp = Qs + (tt * 16 + fr) * LQ + fq * 8;
                const LAS bf16* kp0 = Ks + ((2 * sh) * 16 + fr) * LQ + fq * 8; const LAS bf16* kp1 = kp0 + 16 * LQ;
                const LAS bf16* cp0 = CTs + (sh * 16 + fr) * LQ + fq * 8; const LAS bf16* cp2 = CTs + (32 + fr) * LQ + fq * 8;
#pragma unroll
                for (int hf = 0; hf < 4; ++hf) {
                    bf16x8 qf[2], k0[2], k1[2], c0[2], c2[2];
#pragma unroll
                    for (int k4 = 0; k4 < 2; ++k4) { const int ko = (hf * 2 + k4) * 32;
                        qf[k4] = *(const LAS bf16x8*)(qp + ko); k0[k4] = *(const LAS bf16x8*)(kp0 + ko); k1[k4] = *(const LAS bf16x8*)(kp1 + ko);
                        c0[k4] = *(const LAS bf16x8*)(cp0 + ko); c2[k4] = *(const LAS bf16x8*)(cp2 + ko); }
                    __builtin_amdgcn_sched_barrier(0);
#pragma unroll
                    for (int k4 = 0; k4 < 2; ++k4) { s0 = ML_MFMA(k0[k4], qf[k4], s0); s1 = ML_MFMA(k1[k4], qf[k4], s1); n3 = ML_MFMA(c0[k4], qf[k4], n3); d3 = ML_MFMA(c2[k4], qf[k4], d3); }
                }
            }
            const int t = tt * 16 + fr; const float Mt = sM[t];
            {
                const int sb0 = (2 * sh) * 16 + 4 * fq, sb1 = sb0 + 16;
                const f32x4 a0 = *(const LAS f32x4*)(sA + sb0), a1 = *(const LAS f32x4*)(sA + sb1);
                float p0[4], p1[4];
#pragma unroll
                for (int r = 0; r < 4; ++r) {
                    const int sa = sb0 + r, sbb = sb1 + r;
                    const bool ok0 = dir ? (sa >= t) : (sa <= t), ok1 = dir ? (sbb >= t) : (sbb <= t);
                    p0[r] = ok0 ? s0[r] * __expf(a0[r] - Mt) : 0.f; p1[r] = ok1 ? s1[r] * __expf(a1[r] - Mt) : 0.f;
                }
                u32x2 w0, w1; w0.x = pk2(p0[0], p0[1]); w0.y = pk2(p0[2], p0[3]); w1.x = pk2(p1[0], p1[1]); w1.y = pk2(p1[2], p1[3]);
                *(LAS u32x2*)(Ps + t * LS + sb0) = w0; *(LAS u32x2*)(Ps + t * LS + sb1) = w1;
            }
            ML_BAR();
            f32x4 n2 = {0.f, 0.f, 0.f, 0.f}, d2 = n2;
            {
                bf16x8 pf[2], v0[2], v2[2];
#pragma unroll
                for (int ks = 0; ks < 2; ++ks) { const int ko = ks * 32 + fq * 8;
                    pf[ks] = *(const LAS bf16x8*)(Ps + (tt * 16 + fr) * LS + ko); v0[ks] = *(const LAS bf16x8*)(VTs + (sh * 16 + fr) * LS + ko); v2[ks] = *(const LAS bf16x8*)(VTs + (32 + fr) * LS + ko); }
                __builtin_amdgcn_sched_barrier(0);
#pragma unroll
                for (int ks = 0; ks < 2; ++ks) { n2 = ML_MFMA(v0[ks], pf[ks], n2); d2 = ML_MFMA(v2[ks], pf[ks], d2); }
            }
            {
                const float ai = sAI[t], em = sEM[t];
                const float den0 = d2[0] + ai * d3[0];
                const float den = __shfl(den0, fr);
                const float rinv = 1.0f / fmaxf(fabsf(den), em);
                f32x4 hout; hout.x = (n2[0] + ai * n3[0]) * rinv; hout.y = (n2[1] + ai * n3[1]) * rinv; hout.z = (n2[2] + ai * n3[2]) * rinv; hout.w = (n2[3] + ai * n3[3]) * rinv;
                *(f32x4*)(HF + ((size_t)dir * M + trow + t) * D + h * 256 + es * 32 + sh * 16 + 4 * fq) = hout;
            }
#pragma unroll
            for (int a = 0; a < 2; ++a)
#pragma unroll
                for (int e = 0; e < 3; ++e) ct[a][e] = ct[a][e] * dec_c;
#pragma unroll
            for (int ks = 0; ks < 2; ++ks) { const int ko = ks * 32 + fq * 8; bf16x8 kt[2], vw[3];
#pragma unroll
                for (int a = 0; a < 2; ++a) kt[a] = *(const LAS bf16x8*)(KTs + ((2 * wid + a) * 16 + fr) * LS + ko);
#pragma unroll
                for (int e = 0; e < 3; ++e) vw[e] = *(const LAS bf16x8*)(VTw + (e * 16 + fr) * LS + ko);
                __builtin_amdgcn_sched_barrier(0);
#pragma unroll
                for (int a = 0; a < 2; ++a)
#pragma unroll
                    for (int e = 0; e < 3; ++e) ct[a][e] = ML_MFMA(kt[a], vw[e], ct[a][e]);
            }
#pragma unroll
            for (int a = 0; a < 2; ++a)
#pragma unroll
                for (int e = 0; e < 3; ++e) { u32x2 w; w.x = f2bf(ct[a][e][0]) | (f2bf(ct[a][e][1]) << 16); w.y = f2bf(ct[a][e][2]) | (f2bf(ct[a][e][3]) << 16);
                    *(LAS u32x2*)(CTs + (e * 16 + fr) * LQ + (2 * wid + a) * 16 + 4 * fq) = w; }
            ML_BAR();
            if (c + 1 < 64) { ML_STORE(); }
            ML_BAR();
            if (c + 2 < 64) { ML_LOAD(c + 2); }
        }
#undef ML_LOAD
#undef ML_STORE
    }
}
}
}

struct EpiRes {
    static constexpr bool PERM = false, AFTER_DRAIN = false;
    const float* base; float* out; int ldc;
    __device__ __forceinline__ void operator()(const pg8::f32x4 (&acc)[2][2][4][2], const pg8::Unit& u, int wr, int wc, int fr, int fq) const {
#pragma unroll
        for (int ai = 0; ai < 2; ++ai)
#pragma unroll
            for (int m = 0; m < 4; ++m) { const size_t ro = (size_t)(u.pm * 256 + ai * 128 + wr * 64 + m * 16 + fr) * ldc + u.pn * 256 + wc * 32 + 4 * fq;
#pragma unroll
                for (int bj = 0; bj < 2; ++bj)
#pragma unroll
                    for (int n = 0; n < 2; ++n) { const size_t off = ro + bj * 128 + n * 16; const pg8::f32x4 bs = *(const pg8::f32x4*)(base + off); *(pg8::f32x4*)(out + off) = bs + acc[ai][bj][m][n]; } }
    }
};

#define ROR1(x) __int_as_float(__builtin_amdgcn_update_dpp(0, __float_as_int(x), 0x121, 0xF, 0xF, false))
#define ROL1(x) __int_as_float(__builtin_amdgcn_update_dpp(0, __float_as_int(x), 0x12F, 0xF, 0xF, false))
struct EpiConv {
    static constexpr bool PERM = true, AFTER_DRAIN = false;
    unsigned short* ACT; unsigned short* HALO; const float* cw; const float* cb;
    __device__ __forceinline__ void operator()(const pg8::f32x4 (&acc)[2][2][4][2], const pg8::Unit& u, int wr, int wc, int fr, int fq) const {
        using mk::FF; using mk::FF2;
        const int jb = u.pn * 128 + wc * 32 + 8 * fq;
        mk::u32x2 keep[2][4];
#pragma unroll
        for (int n = 0; n < 2; ++n) {
            const int j = jb + 4 * n;
            const pg8::f32x4 c0g = *(const pg8::f32x4*)(cw + j), c1g = *(const pg8::f32x4*)(cw + FF2 + j), c2g = *(const pg8::f32x4*)(cw + 2 * FF2 + j), cbg = *(const pg8::f32x4*)(cb + j);
            const pg8::f32x4 c0v = *(const pg8::f32x4*)(cw + FF + j), c1v = *(const pg8::f32x4*)(cw + FF2 + FF + j), c2v = *(const pg8::f32x4*)(cw + 2 * FF2 + FF + j), cbv = *(const pg8::f32x4*)(cb + FF + j);
#pragma unroll
            for (int ai = 0; ai < 2; ++ai) {
                float gRp[4], vRp[4], gLc[4], vLc[4];
#pragma unroll
                for (int i = 0; i < 4; ++i) { gLc[i] = ROL1(acc[ai][0][0][n][i]); vLc[i] = ROL1(acc[ai][1][0][n][i]); gRp[i] = 0.f; vRp[i] = 0.f; }
#pragma unroll
                for (int m = 0; m < 4; ++m) {
                    const int row = u.pm * 256 + ai * 128 + wr * 64 + m * 16 + fr;
                    float o[4];
#pragma unroll
                    for (int i = 0; i < 4; ++i) {
                        const float g = acc[ai][0][m][n][i], v = acc[ai][1][m][n][i];
                        const float gRc = ROR1(g), vRc = ROR1(v);
                        float gLn = 0.f, vLn = 0.f; if (m < 3) { gLn = ROL1(acc[ai][0][m + 1][n][i]); vLn = ROL1(acc[ai][1][m + 1][n][i]); }
                        float gu = gRc, vu = vRc, gd = gLc[i], vd = vLc[i];
                        if (m > 0) { if (fr == 0) { gu = gRp[i]; vu = vRp[i]; } }
                        if (m < 3) { if (fr == 15) { gd = gLn; vd = vLn; } }
                        gRp[i] = gRc; vRp[i] = vRc; gLc[i] = gLn; vLc[i] = vLn;
                        const float G = c0g[i] * gu + c1g[i] * g + c2g[i] * gd + cbg[i];
                        const float V = c0v[i] * vu + c1v[i] * v + c2v[i] * vd + cbv[i];
                        o[i] = G * __builtin_amdgcn_rcpf(1.0f + __expf(-G)) * V;
                    }
                    const bool edge = (m == 0 && fr == 0) || (m == 3 && fr == 15);
                    { mk::u32x2 w; w.x = mk::pk2(o[0], o[1]); w.y = mk::pk2(o[2], o[3]);
                      if (n == 0) keep[ai][m] = w;
                      else if (!edge) { mk::u32x4 w4; w4.x = keep[ai][m].x; w4.y = keep[ai][m].y; w4.z = w.x; w4.w = w.y; *(mk::u32x4*)(ACT + (size_t)row * FF + jb) = w4; } }
                    if ((m == 0 && fr < 2) || (m == 3 && fr > 13)) {
                        const int hr = (m == 0) ? fr : fr - 12;
                        unsigned short* hp = HALO + ((size_t)(row >> 6) * 4 + hr) * FF2 + j;
                        mk::u32x2 wg, wv; wg.x = mk::f2bf(acc[ai][0][m][n][0]) | (mk::f2bf(acc[ai][0][m][n][1]) << 16); wg.y = mk::f2bf(acc[ai][0][m][n][2]) | (mk::f2bf(acc[ai][0][m][n][3]) << 16);
                        wv.x = mk::f2bf(acc[ai][1][m][n][0]) | (mk::f2bf(acc[ai][1][m][n][1]) << 16); wv.y = mk::f2bf(acc[ai][1][m][n][2]) | (mk::f2bf(acc[ai][1][m][n][3]) << 16);
                        *(mk::u32x2*)hp = wg; *(mk::u32x2*)(hp + FF) = wv;
                    }
                }
            }
        }
    }
};

struct EpiBf16T {
    static constexpr bool PERM = true, AFTER_DRAIN = false;
    unsigned short* O; int ldc; int split_cols; float scale0; unsigned short* T; int tcol0; int ldt;
    __device__ __forceinline__ void operator()(const pg8::f32x4 (&acc)[2][2][4][2], const pg8::Unit& u, int wr, int wc, int fr, int fq) const {
        const int row0 = u.pm * 256 + wr * 64 + fr, colt = u.pn * 256, col0 = colt + wc * 32 + 8 * fq;
        const float sc = (colt < split_cols) ? scale0 : 1.f;
#pragma unroll
        for (int ai = 0; ai < 2; ++ai)
#pragma unroll
            for (int m = 0; m < 4; ++m) { unsigned short* rowp = O + (size_t)(row0 + ai * 128 + m * 16) * ldc + col0;
#pragma unroll
                for (int bj = 0; bj < 2; ++bj) { const pg8::f32x4 v0 = acc[ai][bj][m][0] * sc, v1 = acc[ai][bj][m][1] * sc;
                    mk::u32x4 w; w.x = mk::pk2(v0[0], v0[1]); w.y = mk::pk2(v0[2], v0[3]); w.z = mk::pk2(v1[0], v1[1]); w.w = mk::pk2(v1[2], v1[3]);
                    *(mk::u32x4*)(rowp + bj * 128) = w; } }
        if (colt >= tcol0) {
#pragma unroll
            for (int bj = 0; bj < 2; ++bj)
#pragma unroll
                for (int n = 0; n < 2; ++n)
#pragma unroll
                    for (int i = 0; i < 4; ++i) { unsigned short* tp = T + (size_t)(col0 - tcol0 + bj * 128 + 4 * n + i) * ldt + row0;
#pragma unroll
                        for (int ai = 0; ai < 2; ++ai)
#pragma unroll
                            for (int m = 0; m < 4; ++m) tp[ai * 128 + m * 16] = (unsigned short)mk::f2bf(acc[ai][bj][m][n][i]); }
        }
    }
};

struct GemmDesc { const unsigned short* A; const unsigned short* Bt; int Mg, Ng, Kg; int kind; unsigned short* O; int ldc; int split_cols; float scale0; const float* base; float* out; int G, c; };

#ifndef REPEAT_PH
#define REPEAT_PH 1000
#define N_REPEAT 0
#else
#define N_REPEAT 1
#endif
struct Params { const float* in[17]; float* out; unsigned char* ws; int ph_lo, ph_hi; };
constexpr int N_PHASES = 18;

__global__ void __launch_bounds__(512, 2) fwd_mega(Params p) {
    extern __shared__ __attribute__((aligned(16))) unsigned char lds_raw[];
    using namespace mk;
    cg::grid_group grid = cg::this_grid();
    LAS unsigned char* lds = (LAS unsigned char*)lds_raw;
    const int bid = blockIdx.x, nblk = gridDim.x;
    const int ph_lo = p.ph_lo, ph_hi = p.ph_hi;
    { volatile LAS unsigned* misc = (volatile LAS unsigned*)(lds + LDS_MISC); if (mk_tid() < 16) misc[mk_tid()] = 0u; }
    __syncthreads();
    (void)xcd_barrier_post((unsigned*)(p.ws + WS_BAR), (volatile LAS unsigned*)(lds + LDS_MISC) + 8);
    if (ph_lo < 0) grid.sync();
#ifdef PROBE_PH
    const unsigned long long t_start = __builtin_amdgcn_s_memrealtime();
#endif
#pragma unroll 1
    for (int ph_it = ph_lo; ph_it < ph_hi + N_REPEAT; ++ph_it) {
        const int ph = ph_it <= REPEAT_PH ? ph_it : ph_it - N_REPEAT;
        typedef const __attribute__((address_space(4))) Params* KP;
        KP kp = (KP)__builtin_amdgcn_kernarg_segment_ptr(); asm volatile("" : "+s"(kp));
        unsigned char* ws = kp->ws; float* OUT = kp->out; bf16* XN = (bf16*)(ws + WS_XN);
        In I; I.x = kp->in[0]; I.norm_mix = kp->in[1]; I.norm_ffn = kp->in[2]; I.w_in_ab = kp->in[3]; I.pool_w = kp->in[4]; I.pool_scale = kp->in[5]; I.q_norm = kp->in[6]; I.k_norm = kp->in[7];
        I.w_out_ab = kp->in[8]; I.w_in_c = kp->in[9]; I.b_gate = kp->in[10]; I.h_norm = kp->in[11]; I.w_out_c = kp->in[12]; I.w_up = kp->in[13]; I.conv_w = kp->in[14]; I.conv_b = kp->in[15]; I.w_down = kp->in[16];
        int nb_ = nblk; asm volatile("" : "+s"(nb_)); const int ngw = nb_ * NW, ngt = nb_ * 512;
        const int tid = mk_tid(), lane = tid & 63, wave = __builtin_amdgcn_readfirstlane(tid >> 6), gw = bid * NW + wave, gt = bid * 512 + tid;
#ifndef NO_THIN
        if (ph == 0) prologue(I, ws, lds, gw, ngw, wave, lane);
        if (ph == 5 || ph == 9 || ph == 14) rmsnorm_rows(OUT, ph == 5 ? I.norm_ffn : (ph == 9 ? I.norm_mix + D : I.norm_ffn + D), XN, gw, ngw, lane);
        if (ph == 2) qk_rope_pool((bf16*)(ws + WS_PROJ), I.q_norm, I.k_norm, (bf16*)(ws + WS_POOLED), gw, ngw, lane);
#endif
#ifndef NO_ATT
        if (ph == 3) {
            const bf16* PROJ = (const bf16*)(ws + WS_PROJ); bf16* CAT = (bf16*)(ws + WS_CAT);
            for (int u0 = bid; u0 < 384; u0 += nblk) {
                int u = u0;
                if (nblk == 256) { const int xcd = u0 & 7, j = (u0 >> 3) & 31, rnd = u0 >> 8; const int jj = j + 32 * rnd;
                    if (jj >= 48) continue; u = (xcd >> 2) * 192 + ((xcd & 3) * 3 + (jj >> 4)) * 16 + (jj & 15); }
                const int qb = u & 15, hq = (u >> 4) % 12, b = u / 192;
                const size_t r0 = (size_t)b * SEQ + (size_t)qb * 256;
                att::attn_dense_body<att::bf16>((const att::bf16*)(PROJ + r0 * ABW + 512 + hq * 128), (const att::bf16*)(PROJ + (size_t)b * SEQ * ABW + 2048 + (hq / 3) * 128),
                                                (const att::bf16*)(PROJ + (size_t)b * SEQ * ABW + 2560 + (hq / 3) * 128), CAT + r0 * D + 512 + hq * 128, SEQ, (char*)lds_raw);
                __syncthreads();
            }
        }
#endif
#ifndef NO_THIN
        if (ph == 7 || ph == 16) { const int l = ph == 7 ? 0 : 1; conv_fix((const bf16*)(ws + WS_U), I.conv_w + (size_t)l * 3 * FF2, I.conv_b + (size_t)l * FF2, (bf16*)(ws + WS_ACT), gt, ngt); }
        if (ph == 10) gates_phase(XN, (const bf16*)(ws + WS_C) + (size_t)8192 * D, I.b_gate, (float*)(ws + WS_GATES), (LAS float*)lds, bid, nblk);
#endif
#ifndef NO_ML
        if (ph == 11) ml::mlstm_phase(lds, (const bf16*)(ws + WS_QK), (const bf16*)(ws + WS_KVT), (const float*)(ws + WS_GATES), (float*)(ws + WS_HF), bid, nblk);
#endif
#ifndef NO_THIN
        if (ph == 12) headnorm_phase((const float*)(ws + WS_HF), (const bf16*)(ws + WS_OG), I.h_norm, (bf16*)(ws + WS_Y), gw, ngw, lane);
#endif
#pragma unroll 1
        for (int gi = 0; gi < 3; ++gi) {
            GemmDesc d; d.kind = -1; d.G = nblk; d.c = bid; d.split_cols = 0; d.scale0 = 1.f; d.base = nullptr; d.out = nullptr; d.O = nullptr; d.ldc = 0; d.A = nullptr; d.Bt = nullptr; d.Mg = M; d.Ng = 0; d.Kg = D;
            if (gi == 0) {
                if (ph == 1) { d.kind = 0; d.A = XN; d.Bt = (bf16*)(ws + WS_AB); d.Ng = ABW; d.O = (bf16*)(ws + WS_PROJ); d.ldc = ABW; }
                else if (ph == 3) { d.kind = 0; d.A = (bf16*)(ws + WS_POOLED); d.Bt = (bf16*)(ws + WS_BD); d.Ng = 512; d.Kg = 512; d.O = (bf16*)(ws + WS_CAT); d.ldc = D;
                    if (nblk == 256) { const int slot = bid >> 3; d.G = 64; d.c = (slot - 16) * 8 + (bid & 7); if (slot < 16 || slot >= 24) d.kind = -1; } }
                else if (ph == 4) { d.kind = 1; d.A = (bf16*)(ws + WS_CAT); d.Bt = (bf16*)(ws + WS_OAB); d.Ng = D; d.base = I.x; d.out = OUT; }
                else if (ph == 6 || ph == 15) { d.kind = 2; d.A = XN; d.Bt = (bf16*)(ws + (ph == 6 ? WS_UP0 : WS_UP1)); d.Ng = FF2; d.O = (bf16*)(ws + WS_U); d.ldc = FF2; d.base = I.conv_w + (size_t)(ph == 6 ? 0 : 1) * 3 * FF2; d.out = (float*)(I.conv_b + (size_t)(ph == 6 ? 0 : 1) * FF2); }
                else if (ph == 8 || ph == 17) { d.kind = 1; d.A = (bf16*)(ws + WS_ACT); d.Bt = (bf16*)(ws + (ph == 8 ? WS_DN0 : WS_DN1)); d.Ng = D; d.Kg = FF; d.base = OUT; d.out = OUT; }
                else if (ph == 10) { d.kind = 3; d.A = XN; d.Bt = (bf16*)(ws + WS_C); d.Ng = 4096; d.O = (bf16*)(ws + WS_QK); d.ldc = 4096; d.split_cols = 2048; d.scale0 = 0.0625f; }
                else if (ph == 13) { d.kind = 1; d.A = (bf16*)(ws + WS_Y); d.Bt = (bf16*)(ws + WS_OC); d.Ng = D; d.base = OUT; d.out = OUT; }
            } else if (ph == 10) {
                if (gi == 1) { d.kind = 0; d.A = XN; d.Bt = (bf16*)(ws + WS_C) + (size_t)6144 * D; d.Ng = D; d.O = (bf16*)(ws + WS_OG); d.ldc = D; }
                else { d.kind = 0; d.A = (bf16*)(ws + WS_C) + (size_t)4096 * D; d.Bt = XN; d.Mg = 2048; d.Ng = M; d.O = (bf16*)(ws + WS_KVT) + (size_t)2048 * M; d.ldc = M; }
            }
#ifndef NO_GEMM
            if (d.kind == 0) {
                pg8::Gemm g{d.A, d.Bt, d.Mg, d.Ng, d.Kg}; pg8::StaticOrder S; S.init(d.Mg, d.Ng, d.G, d.c);
                pg8::EpiBf16<0> E{d.O, d.ldc, nullptr, d.split_cols, (size_t)d.split_cols, d.scale0};
                pg8::gemm_phase<pg8::EpiBf16<0>, pg8::StaticOrder, true, true>(lds, g, S, E);
            } else if (d.kind == 3) {
                pg8::Gemm g{d.A, d.Bt, d.Mg, d.Ng, d.Kg}; pg8::StaticOrder S; S.init(d.Mg, d.Ng, d.G, d.c);
                EpiBf16T E{d.O, d.ldc, d.split_cols, d.scale0, (bf16*)(ws + WS_KVT), 2048, M};
                pg8::gemm_phase<EpiBf16T, pg8::StaticOrder, true, true>(lds, g, S, E);
            } else if (d.kind == 2) {
                pg8::Gemm g{d.A, d.Bt, d.Mg, d.Ng, d.Kg}; pg8::StaticOrder S; S.init(d.Mg, d.Ng, d.G, d.c);
                EpiConv E{(bf16*)(ws + WS_ACT), d.O, d.base, (const float*)d.out};
                pg8::gemm_phase<EpiConv, pg8::StaticOrder, true, true>(lds, g, S, E);
            } else if (d.kind == 1) {
                pg8::Gemm g{d.A, d.Bt, d.Mg, d.Ng, d.Kg}; pg8::StaticOrder S; S.init(d.Mg, d.Ng, d.G, d.c);
                EpiRes E{d.base, d.out, D};
                pg8::gemm_phase<EpiRes, pg8::StaticOrder, true, true>(lds, g, S, E);
            }
#endif
            __syncthreads();
        }
#ifndef NO_THIN
        if (nb_ == 256) {
            if (ph == 1 && bid >= 128) { const int w = (bid - 128) * NW + wave; transposes(I, ws, lds, 1536, 2560, w, 128 * NW, wave, lane); transposes(I, ws, lds, 18944, 24576, w, 128 * NW, wave, lane); }
            if (ph == 3 && (bid >> 3) >= 16) { const int w = (((bid >> 3) - 16) * 8 + (bid & 7)) * NW + wave; transposes(I, ws, lds, 2560, 13312, w, 128 * NW, wave, lane); }
            if (ph == 6 && bid >= 128) { const int w = (bid - 128) * NW + wave; transposes(I, ws, lds, 13312, 18944, w, 128 * NW, wave, lane); }
        } else if (ph == 1) transposes(I, ws, lds, 1536, 24576, gw, ngw, wave, lane);
#endif
        if (ph_it + 1 < ph_hi + N_REPEAT) { XcdBarrier xbar; xbar.bar = (unsigned*)(ws + WS_BAR); xbar.x = xb_xcc_id(); xbar.st = (volatile LAS unsigned*)(lds + LDS_MISC) + 8; xcd_barrier(xbar);
#ifdef SYNC2
            xcd_barrier(xbar);
#endif
        }
#ifdef PROBE_PH
        if (bid == 0 && tid == 0) { unsigned long long* ts = (unsigned long long*)(ws + WS_BD + 768 * 1024); ts[ph + 1] = __builtin_amdgcn_s_memrealtime(); if (ph == 0) ts[0] = t_start;
            if (ph + 1 == ph_hi) { OUT[0] = (float)(ts[PROBE_PH + 1] - ts[PROBE_PH]) * 0.01f; } }
#endif
    }
}

#ifndef MK_MULTI
#define MK_MULTI 0
#endif
extern "C" void kernel_launch(void* const* d_in, const int* in_sizes, int n_in, void* d_out, int out_size, void* d_ws, size_t ws_size, hipStream_t stream) {
    static int grid = 0;
    if (grid == 0) {
        if (n_in != 17 || out_size != mk::M * mk::D || ws_size < mk::WS_END) { fprintf(stderr, "kernel_launch: unexpected shapes n_in %d out %d ws %zu (need %zu)\n", n_in, out_size, ws_size, (size_t)mk::WS_END); grid = -1; return; }
        int dev = 0, cus = 0, per_cu = 0;
        (void)hipGetDevice(&dev); (void)hipDeviceGetAttribute(&cus, hipDeviceAttributeMultiprocessorCount, dev);
        if (hipFuncSetAttribute((const void*)fwd_mega, hipFuncAttributeMaxDynamicSharedMemorySize, mk::LDS_BYTES) != hipSuccess) { fprintf(stderr, "kernel_launch: hipFuncSetAttribute failed\n"); grid = -1; return; }
        if (hipOccupancyMaxActiveBlocksPerMultiprocessor(&per_cu, (const void*)fwd_mega, 512, mk::LDS_BYTES) != hipSuccess || per_cu < 1) { fprintf(stderr, "kernel_launch: occupancy query gave %d\n", per_cu); per_cu = 1; }
        (void)hipGetLastError();
        if (cus <= 0) cus = 256;
        grid = cus * per_cu; if (grid > 256) grid = 256;
        fprintf(stderr, "kernel_launch: cus %d per_cu %d grid %d\n", cus, per_cu, grid);
    }
    if (grid < 0) return;
    if (hipMemsetAsync((char*)d_ws + mk::WS_BAR, 0, mk::BAR_BYTES, stream) != hipSuccess) { fprintf(stderr, "kernel_launch: memset failed\n"); return; }
    Params p{};
    for (int i = 0; i < 17; ++i) p.in[i] = (const float*)d_in[i];
    p.out = (float*)d_out; p.ws = (unsigned char*)d_ws;
#if MK_MULTI
    for (int ph = 0; ph < N_PHASES; ++ph) { p.ph_lo = ph; p.ph_hi = ph + 1; hipLaunchKernelGGL(fwd_mega, dim3(grid), dim3(512), mk::LDS_BYTES, stream, p); }
#else
    p.ph_lo = 0; p.ph_hi = N_PHASES;
    void* args[] = {&p};
    const hipError_t e = hipLaunchCooperativeKernel((const void*)fwd_mega, dim3(grid), dim3(512), args, mk::LDS_BYTES, stream);
    if (e != hipSuccess) fprintf(stderr, "kernel_launch: cooperative launch failed: %s (grid %d)\n", hipGetErrorString(e), grid);
#endif
}
```

```cpp
#include <hip/hip_runtime.h>
#include <hip/hip_cooperative_groups.h>
#include <hip/hip_bf16.h>
#include <cstdio>
#include <cstdint>
#include <cmath>
namespace cg = cooperative_groups;
__device__ __forceinline__ int mk_tid();
namespace pg8 {
#define PG8_LAS __attribute__((address_space(3)))
typedef unsigned short bf16_t;
typedef short bf16x8 __attribute__((ext_vector_type(8)));
typedef float f32x4 __attribute__((ext_vector_type(4)));
typedef unsigned u32x4 __attribute__((ext_vector_type(4)));
constexpr int BM = 256, BK = 64, HALF = 128, HTB = HALF * BK * 2  , STAGE_BYTES = 8 * HTB, NXCD = 8, WGM = 8;

__host__ __device__ __forceinline__ int lds_byte(int r, int c) { const int st = (r >> 4) * 2 + (c >> 5), rr = r & 15, cc = c & 31, ob = rr * 64 + cc * 2; return st * 1024 + (ob ^ (((ob >> 9) & 1) << 5)); }
__host__ __device__ __forceinline__ void stage_rc(int b, int& R, int& C) { const int st = b / 1024, sb = b % 1024, swz = sb ^ (((sb >> 9) & 1) << 5); R = (st >> 1) * 16 + swz / 64; C = (st & 1) * 32 + (swz % 64) / 2; }
__host__ __device__ __forceinline__ int perm32(int rho) { const int n = rho >> 4, i = rho & 15; return 8 * (i >> 2) + 4 * n + (i & 3); }

struct Unit { int pm, pn; };
struct Gemm { const bf16_t* A; const bf16_t* Bt; int M, N, K; };

struct StaticOrder {
    int nM, nN, nwg, G, c;
    __host__ __device__ void init(int M, int N, int G_, int c_) { nM = M / BM; nN = N / BM; nwg = nM * nN; G = G_; c = c_; }
    __host__ __device__ bool next(int i, Unit& u) const {
        const long L = (long)i * G + c; if (L >= nwg) return false;
        int wgid = (int)L; { const int q = nwg / NXCD, r = nwg % NXCD, xcd = wgid % NXCD, off = wgid / NXCD; wgid = (xcd < r ? xcd * (q + 1) : r * (q + 1) + (xcd - r) * q) + off; }
        const int nig = WGM * nN, gid = wgid / nig, fm = gid * WGM, gsz = (nM - fm) < WGM ? (nM - fm) : WGM;
        u.pm = fm + ((wgid % nig) % gsz); u.pn = (wgid % nig) / gsz; return true;
    }
    __device__ __forceinline__ void a_ready(const Unit&) const {}
    __device__ __forceinline__ void done(const Unit&) const {}
};

__device__ __forceinline__ unsigned cvt_pk_bf16(float lo, float hi) { unsigned r; asm volatile("v_cvt_pk_bf16_f32 %0, %1, %2" : "=v"(r) : "v"(lo), "v"(hi)); return r; }
typedef float f32x2 __attribute__((ext_vector_type(2)));
__device__ __forceinline__ f32x2 gelu_pk(f32x2 v) {
    const f32x2 av = __builtin_elementwise_abs(v), d = av * 0.2316418882f + 1.0f;
    f32x2 t; t.x = __builtin_amdgcn_rcpf(d.x); t.y = __builtin_amdgcn_rcpf(d.y);
    f32x2 q = t * 0.5307027145f + (-0.7265760135f); q = q * t + 0.7107068705f; q = q * t + (-0.142248368f); q = q * t + 0.127414796f; q = q * t;
    const f32x2 s = (v * v) * (-0.72134752044f);
    f32x2 e; e.x = __builtin_amdgcn_exp2f(s.x); e.y = __builtin_amdgcn_exp2f(s.y);
    const f32x2 m = v * (q * e), r = v - m;
    f32x2 o; o.x = v.x < 0.f ? m.x : r.x; o.y = v.y < 0.f ? m.y : r.y; return o;
}

template <int ACT  > struct EpiBf16 {
    static constexpr bool PERM = true, AFTER_DRAIN = false; static_assert(ACT == 0 || ACT == 1, "EpiBf16: ACT is 0 (none) or 1 (gelu_pk)");
    bf16_t* O; int ldc; const float* bias; int split_cols; size_t split_stride; float scale0;
    __device__ __forceinline__ void operator()(const f32x4 (&acc)[2][2][4][2], const Unit& u, int wr, int wc, int fr, int fq) const {
        const int row0 = u.pm * BM + wr * 64 + fr; int colt = u.pn * BM; bf16_t* base = O;
        float sc = 1.f; if (split_cols) { const int t = colt / split_cols; base += (size_t)t * split_stride; colt -= t * split_cols; if (t == 0) sc = scale0; }
        const int col0 = colt + wc * 32 + 8 * fq, bcol0 = u.pn * BM + wc * 32 + 8 * fq;
        f32x4 bv[2][2];
#pragma unroll
        for (int bj = 0; bj < 2; ++bj)
#pragma unroll
            for (int n = 0; n < 2; ++n) bv[bj][n] = bias ? *(const f32x4*)(bias + bcol0 + bj * HALF + 4 * n) : (f32x4){0.f, 0.f, 0.f, 0.f};
#pragma unroll
        for (int ai = 0; ai < 2; ++ai)
#pragma unroll
            for (int m = 0; m < 4; ++m) { bf16_t* rowp = base + (size_t)(row0 + ai * HALF + m * 16) * ldc + col0;
#pragma unroll
                for (int bj = 0; bj < 2; ++bj) { f32x4 v0 = acc[ai][bj][m][0] + bv[bj][0], v1 = acc[ai][bj][m][1] + bv[bj][1];
                    if (ACT == 1) { f32x2 a = gelu_pk((f32x2){v0[0], v0[1]}), b = gelu_pk((f32x2){v0[2], v0[3]}), c = gelu_pk((f32x2){v1[0], v1[1]}), d = gelu_pk((f32x2){v1[2], v1[3]});
                        v0 = (f32x4){a.x, a.y, b.x, b.y}; v1 = (f32x4){c.x, c.y, d.x, d.y}; }
                    v0 = v0 * sc; v1 = v1 * sc; u32x4 w; w.x = cvt_pk_bf16(v0[0], v0[1]); w.y = cvt_pk_bf16(v0[2], v0[3]); w.z = cvt_pk_bf16(v1[0], v1[1]); w.w = cvt_pk_bf16(v1[2], v1[3]);
                    *(u32x4*)(rowp + bj * HALF) = w; } }
    }
};

template <class Epi, class Sched, bool ALIGN_EPI = false, bool SP2 = false>
__device__ __forceinline__ void gemm_phase(PG8_LAS unsigned char* lds, const Gemm g, const Sched& S, const Epi& E) {
    const int tid = mk_tid(), wid = __builtin_amdgcn_readfirstlane(tid >> 6), lane = tid & 63, wr = wid >> 2, wc = wid & 3, fr = lane & 15, fq = lane >> 4;
    const int K = g.K, nt = K / BK;
    unsigned voffA[2], voffB[2];
#pragma unroll
    for (int i = 0; i < 2; ++i) { int R, C; stage_rc(tid * 16 + i * 8192, R, C); const int Rb = Epi::PERM ? ((R & ~31) + perm32(R & 31)) : R;
        voffA[i] = (unsigned)(R * K + C) * 2u; voffB[i] = (unsigned)(Rb * K + C) * 2u; }
    const size_t kstep = (size_t)(BK * 2);
    const size_t hstep = (size_t)HALF * K * 2;
    const size_t tstep = 2 * hstep;
    const unsigned ldsw = (unsigned)wid * 1024u;
    const int aoff = lds_byte(wr * 64 + fr, fq * 8), boff = lds_byte(wc * 32 + fr, fq * 8);
#define PG8_SA(b, h) (((b) * 2 + (h)) * HTB)
#define PG8_SB(b, h) ((4 + (b) * 2 + (h)) * HTB)
#define PG8_STAGE(bufoff, gbase, voff) do { _Pragma("unroll") for (int _i = 0; _i < 2; ++_i) \
        __builtin_amdgcn_global_load_lds((const unsigned*)((const char*)(gbase) + (voff)[_i]), (PG8_LAS unsigned*)(lds + (bufoff) + ldsw + _i * 8192), 16, 0, 0); } while (0)
#define PG8_LDA(dst, b, h) do { _Pragma("unroll") for (int m = 0; m < 4; ++m) _Pragma("unroll") for (int k = 0; k < 2; ++k) dst[m][k] = *(const PG8_LAS bf16x8*)(lds + PG8_SA(b, h) + aoff + m * 2048 + k * 1024); } while (0)
#define PG8_LDB(dst, b, h) do { _Pragma("unroll") for (int n = 0; n < 2; ++n) _Pragma("unroll") for (int k = 0; k < 2; ++k) dst[n][k] = *(const PG8_LAS bf16x8*)(lds + PG8_SB(b, h) + boff + n * 2048 + k * 1024); } while (0)
#define PG8_MMA(ai, bj, At, Bt) do { __builtin_amdgcn_s_setprio(1); _Pragma("unroll") for (int m = 0; m < 4; ++m) _Pragma("unroll") for (int n = 0; n < 2; ++n) _Pragma("unroll") for (int k = 0; k < 2; ++k) \
        acc[ai][bj][m][n] = __builtin_amdgcn_mfma_f32_16x16x32_bf16(Bt[n][k], At[m][k], acc[ai][bj][m][n], 0, 0, 0); __builtin_amdgcn_s_setprio(0); } while (0)
#define PG8_WAIT_V(n) asm volatile("s_waitcnt vmcnt(" #n ")" ::: "memory")
#define PG8_WAIT_L(n) asm volatile("s_waitcnt lgkmcnt(" #n ")" ::: "memory")
#define PG8_BAR __builtin_amdgcn_s_barrier()
#define PG8_SCHED __builtin_amdgcn_sched_barrier(0)
    Unit cur, nxt; int ui = 0;
    if (!S.next(0, cur)) return;
    f32x4 acc[2][2][4][2];
#pragma unroll
    for (int a = 0; a < 2; ++a)
#pragma unroll
        for (int b = 0; b < 2; ++b)
#pragma unroll
            for (int m = 0; m < 4; ++m)
#pragma unroll
                for (int n = 0; n < 2; ++n) acc[a][b][m][n] = (f32x4){0.f, 0.f, 0.f, 0.f};
    bf16x8 At[4][2], B0[2][2], B1[2][2];
    const char* cA = (const char*)g.A + (size_t)cur.pm * tstep; const char* cB = (const char*)g.Bt + (size_t)cur.pn * tstep;
    S.a_ready(cur);
    if constexpr (SP2) {
        PG8_STAGE(PG8_SB(0, 0), cB, voffB); PG8_STAGE(PG8_SB(0, 1), cB + hstep, voffB); PG8_STAGE(PG8_SA(0, 0), cA, voffA); PG8_STAGE(PG8_SA(0, 1), cA + hstep, voffA);
        if (wr == 1) PG8_BAR;
        PG8_WAIT_V(2); PG8_BAR;
        PG8_STAGE(PG8_SB(1, 0), cB + kstep, voffB); PG8_STAGE(PG8_SA(1, 0), cA + kstep, voffA); PG8_STAGE(PG8_SB(1, 1), cB + hstep + kstep, voffB);
        PG8_WAIT_V(6); PG8_BAR;
    } else {
        PG8_STAGE(PG8_SB(0, 0), cB, voffB); PG8_STAGE(PG8_SA(0, 0), cA, voffA); PG8_STAGE(PG8_SB(0, 1), cB + hstep, voffB); PG8_STAGE(PG8_SA(0, 1), cA + hstep, voffA);
        if (wr == 1) PG8_BAR;
        PG8_WAIT_V(4); PG8_BAR;
        PG8_STAGE(PG8_SB(1, 0), cB + kstep, voffB); PG8_STAGE(PG8_SA(1, 0), cA + kstep, voffA); PG8_STAGE(PG8_SB(1, 1), cB + hstep + kstep, voffB);
        PG8_WAIT_V(6); PG8_BAR;
    }
    for (;;) {
        const bool has_next = S.next(ui + 1, nxt);
        const char* nA = has_next ? (const char*)g.A + (size_t)nxt.pm * tstep : cA; const char* nB = has_next ? (const char*)g.Bt + (size_t)nxt.pn * tstep : cB;
        for (int t = 0; t < nt; t += 2) {
            const bool last = (t == nt - 2);
            const char* a1 = cA + (size_t)(t + 1) * kstep;
            const char* a2 = last ? nA : cA + (size_t)(t + 2) * kstep; const char* b2 = last ? nB : cB + (size_t)(t + 2) * kstep;
            const char* a3 = a2 + kstep; const char* b3 = b2 + kstep;
            if (last && has_next) S.a_ready(nxt);
            if constexpr (SP2) {
            PG8_LDB(B0, 0, 0); PG8_LDB(B1, 0, 1); PG8_SCHED; PG8_LDA(At, 0, 0); PG8_STAGE(PG8_SA(1, 1), a1 + hstep, voffA);
            PG8_WAIT_V(8); PG8_WAIT_L(0); PG8_BAR; PG8_MMA(0, 0, At, B0); PG8_MMA(0, 1, At, B1); PG8_BAR; PG8_SCHED;
            PG8_LDA(At, 0, 1); PG8_STAGE(PG8_SB(0, 0), b2, voffB); PG8_STAGE(PG8_SB(0, 1), b2 + hstep, voffB); PG8_STAGE(PG8_SA(0, 0), a2, voffA);
            PG8_WAIT_V(8); PG8_WAIT_L(0); PG8_BAR; PG8_MMA(1, 0, At, B0); PG8_MMA(1, 1, At, B1); PG8_BAR; PG8_SCHED;
            PG8_LDB(B0, 1, 0); PG8_LDB(B1, 1, 1); PG8_SCHED; PG8_LDA(At, 1, 0); PG8_STAGE(PG8_SA(0, 1), a2 + hstep, voffA);
            PG8_WAIT_V(8); PG8_WAIT_L(0); PG8_BAR; PG8_MMA(0, 0, At, B0); PG8_MMA(0, 1, At, B1); PG8_BAR; PG8_SCHED;
            PG8_LDA(At, 1, 1); PG8_STAGE(PG8_SB(1, 0), b3, voffB); PG8_STAGE(PG8_SB(1, 1), b3 + hstep, voffB); PG8_STAGE(PG8_SA(1, 0), a3, voffA);
            PG8_WAIT_V(8); PG8_WAIT_L(0); PG8_BAR; PG8_MMA(1, 0, At, B0); PG8_MMA(1, 1, At, B1); PG8_BAR; PG8_SCHED;
            } else {
            PG8_LDB(B0, 0, 0); PG8_SCHED; PG8_LDA(At, 0, 0); PG8_STAGE(PG8_SA(1, 1), a1 + hstep, voffA);
            PG8_WAIT_L(8); PG8_BAR; PG8_WAIT_L(0); PG8_MMA(0, 0, At, B0); PG8_BAR; PG8_SCHED;
            PG8_LDB(B1, 0, 1); PG8_STAGE(PG8_SB(0, 0), b2, voffB);
            PG8_BAR; PG8_WAIT_L(0); PG8_MMA(0, 1, At, B1); PG8_BAR;
            PG8_LDA(At, 0, 1); PG8_STAGE(PG8_SA(0, 0), a2, voffA);
            PG8_BAR; PG8_WAIT_L(0); PG8_MMA(1, 0, At, B0); PG8_BAR; PG8_SCHED;
            PG8_STAGE(PG8_SB(0, 1), b2 + hstep, voffB);
            PG8_WAIT_V(6); PG8_BAR; PG8_MMA(1, 1, At, B1); PG8_BAR;
            PG8_LDB(B0, 1, 0); PG8_SCHED; PG8_LDA(At, 1, 0); PG8_STAGE(PG8_SA(0, 1), a2 + hstep, voffA);
            PG8_WAIT_L(8); PG8_BAR; PG8_WAIT_L(0); PG8_MMA(0, 0, At, B0); PG8_BAR; PG8_SCHED;
            PG8_LDB(B1, 1, 1); PG8_STAGE(PG8_SB(1, 0), b3, voffB);
            PG8_BAR; PG8_WAIT_L(0); PG8_MMA(0, 1, At, B1); PG8_BAR;
            PG8_LDA(At, 1, 1); PG8_STAGE(PG8_SA(1, 0), a3, voffA);
            PG8_BAR; PG8_WAIT_L(0); PG8_MMA(1, 0, At, B0); PG8_BAR; PG8_SCHED;
            PG8_STAGE(PG8_SB(1, 1), b3 + hstep, voffB);
            PG8_WAIT_V(6); PG8_BAR; PG8_MMA(1, 1, At, B1); PG8_BAR;
            }
        }
        if constexpr (ALIGN_EPI) { if (wr == 0) PG8_BAR; }
        if constexpr (!Epi::AFTER_DRAIN) { E(acc, cur, wr, wc, fr, fq); S.done(cur); }
        if (!has_next) break;
#pragma unroll
        for (int a = 0; a < 2; ++a)
#pragma unroll
            for (int b = 0; b < 2; ++b)
#pragma unroll
                for (int m = 0; m < 4; ++m)
#pragma unroll
                    for (int n = 0; n < 2; ++n) acc[a][b][m][n] = (f32x4){0.f, 0.f, 0.f, 0.f};
        cur = nxt; cA = nA; cB = nB; ++ui;
        if constexpr (ALIGN_EPI) { if (wr == 1) PG8_BAR; }
    }
    PG8_WAIT_V(0);
    if constexpr (!ALIGN_EPI) { if (wr == 0) PG8_BAR; }
    PG8_BAR;
    if constexpr (Epi::AFTER_DRAIN) { E.fused(acc, cur, wr, wc, fr, fq, lds, wid, lane); S.done(cur); }
#undef PG8_SA
#undef PG8_SB
#undef PG8_STAGE
#undef PG8_LDA
#undef PG8_LDB
#undef PG8_MMA
#undef PG8_WAIT_V
#undef PG8_WAIT_L
#undef PG8_BAR
#undef PG8_SCHED
}
}

namespace att {
using bf16 = __hip_bfloat16;
constexpr int   D = 128, NW = 8, QBLK = 32, KVBLK = 64;
constexpr float SCALE = 0.088388347648318440f;
constexpr float THR = 8.f;
constexpr int SDEPTH = 2;
constexpr int LDQ = 3072, LDK = 3072, LDO = 2048;
constexpr size_t SHM_V = KVBLK * D * 2, SHM_K = KVBLK * D * 2, SHM_ATTN = 2 * SHM_V + 2 * SHM_K + NW * 64 * 4;
using bf16x8 = __attribute__((ext_vector_type(8))) short;
using s16x4  = __attribute__((ext_vector_type(4))) short;
using f32x16 = __attribute__((ext_vector_type(16))) float;
using f32x8  = __attribute__((ext_vector_type(8))) float;
using u32x4  = __attribute__((ext_vector_type(4))) unsigned;
#define KSWZ(row, colB) ((row) * 256 + ((colB) ^ (((row) & 7) << 4)))
#define SBAR() __builtin_amdgcn_sched_barrier(0)
__device__ __forceinline__ int crow(int r, int hi) { return (r & 3) + 8 * (r >> 2) + 4 * hi; }
__device__ __forceinline__ unsigned cvtpk(float lo, float hi) {
  unsigned r; asm volatile("v_cvt_pk_bf16_f32 %0, %1, %2" : "=v"(r) : "v"(lo), "v"(hi)); return r;
}
template <typename TIn> struct Stage;
template <> struct Stage<bf16>  { using T = bf16x8;
  __device__ static __forceinline__ T ld8(const bf16* p) { return *reinterpret_cast<const bf16x8*>(p); }
  __device__ static __forceinline__ bf16x8 tobf(T x) { return x; } };
template <> struct Stage<float> { using T = f32x8;
  __device__ static __forceinline__ T ld8(const float* p) { return *reinterpret_cast<const f32x8*>(p); }
  __device__ static __forceinline__ bf16x8 tobf(T x) {
    u32x4 w = {cvtpk(x[0], x[1]), cvtpk(x[2], x[3]), cvtpk(x[4], x[5]), cvtpk(x[6], x[7])}; return *reinterpret_cast<bf16x8*>(&w); } };

__device__ __forceinline__ void partialSM(f32x16& p0, f32x16& p1, float& m_reg, float& mn, float& alpha) {
  constexpr float C = SCALE * 1.4426950408889634f;
  float pmax = p0[0]; for (int r = 1; r < 16; ++r) pmax = fmaxf(pmax, p0[r]); for (int r = 0; r < 16; ++r) pmax = fmaxf(pmax, p1[r]);
  { auto rr = __builtin_amdgcn_permlane32_swap(__float_as_uint(pmax), __float_as_uint(pmax), false, false);
    pmax = fmaxf(__uint_as_float(rr[0]), __uint_as_float(rr[1])); }
  if (__builtin_expect(__all(pmax - m_reg <= THR / SCALE), 1)) { mn = m_reg; alpha = 1.f; }
  else { mn = fmaxf(m_reg, pmax); alpha = __builtin_amdgcn_exp2f((m_reg - mn) * C); m_reg = mn; }
  float mnC = -mn * C;
  for (int r = 0; r < 16; ++r) p0[r] = fmaf(p0[r], C, mnC); for (int r = 0; r < 16; ++r) p1[r] = fmaf(p1[r], C, mnC);
  for (int r = 0; r < 16; ++r) p0[r] = __builtin_amdgcn_exp2f(p0[r]);
}
__device__ __forceinline__ void finishSM(f32x16& p0, f32x16& p1, float alpha, float& l_reg, bf16x8& pa0, bf16x8& pa1, bf16x8& pa2, bf16x8& pa3) {
  for (int r = 0; r < 16; ++r) p1[r] = __builtin_amdgcn_exp2f(p1[r]);
  float ps = 0; for (int r = 0; r < 16; ++r) ps += p0[r]; for (int r = 0; r < 16; ++r) ps += p1[r];
  { auto rr = __builtin_amdgcn_permlane32_swap(__float_as_uint(ps), __float_as_uint(ps), false, false);
    ps = __uint_as_float(rr[0]) + __uint_as_float(rr[1]); }
  l_reg = l_reg * alpha + ps;
#define PK4(P, BASE, OUT) do { unsigned a0 = cvtpk(P[BASE + 0], P[BASE + 1]), a1 = cvtpk(P[BASE + 2], P[BASE + 3]);   \
    unsigned b0 = cvtpk(P[BASE + 4], P[BASE + 5]), b1 = cvtpk(P[BASE + 6], P[BASE + 7]);                              \
    auto r0 = __builtin_amdgcn_permlane32_swap(a0, b0, false, false); auto r1 = __builtin_amdgcn_permlane32_swap(a1, b1, false, false); \
    u32x4 w = {r0[0], r1[0], r0[1], r1[1]}; OUT = *reinterpret_cast<bf16x8*>(&w); } while (0)
  PK4(p0, 0, pa0); PK4(p0, 8, pa1); PK4(p1, 0, pa2); PK4(p1, 8, pa3);
#undef PK4
}
__device__ __forceinline__ void qkt(f32x16& p0, f32x16& p1, const bf16* Ks, const bf16x8* qr, int r32, int hi) {
  p0 = f32x16{}; p1 = f32x16{};
  for (int d0 = 0; d0 < 8; ++d0) { int cb = (d0 * 16 + hi * 8) * 2;
    bf16x8 b0 = *reinterpret_cast<const bf16x8*>((const char*)Ks + KSWZ(r32, cb));
    bf16x8 b1 = *reinterpret_cast<const bf16x8*>((const char*)Ks + KSWZ(32 + r32, cb));
    p0 = __builtin_amdgcn_mfma_f32_32x32x16_bf16(b0, qr[d0], p0, 0, 0, 0);
    p1 = __builtin_amdgcn_mfma_f32_32x32x16_bf16(b1, qr[d0], p1, 0, 0, 0); }
}
__device__ __forceinline__ int v_st(int k, int c) { const int kk = (k & ~0xC) | ((k & 4) << 1) | ((k & 8) >> 1); return ((kk >> 3) * 4 + (c >> 5)) * 512 + ((kk & 7) * 32 + (c & 31)) * 2; }
__device__ __forceinline__ int v_rd_base(int lane) { return ((lane & 3) << 3) | (((lane >> 2) & 3) << 6) | (((lane >> 4) & 1) << 5) | (((lane >> 5) & 1) << 8); }
constexpr int v_rd_off(int d0, int ks, int half) { return d0 * 512 + ks * 4096 + half * 2048; }
template <int OFF> __device__ __forceinline__ s16x4 tr_read(int vb) {
  s16x4 r; asm volatile("ds_read_b64_tr_b16 %0, %1 offset:%2" : "=&v"(r) : "v"(vb), "i"(OFF) : "memory"); return r;
}
template <int D0> __device__ __forceinline__ void pv_one(f32x16& od, int vb, bf16x8 pa0, bf16x8 pa1, bf16x8 pa2, bf16x8 pa3) {
  const s16x4 l0 = tr_read<v_rd_off(D0, 0, 0)>(vb), h0 = tr_read<v_rd_off(D0, 0, 1)>(vb), l1 = tr_read<v_rd_off(D0, 1, 0)>(vb), h1 = tr_read<v_rd_off(D0, 1, 1)>(vb);
  const s16x4 l2 = tr_read<v_rd_off(D0, 2, 0)>(vb), h2 = tr_read<v_rd_off(D0, 2, 1)>(vb), l3 = tr_read<v_rd_off(D0, 3, 0)>(vb), h3 = tr_read<v_rd_off(D0, 3, 1)>(vb);
  asm volatile("s_waitcnt lgkmcnt(0)" ::: "memory"); SBAR();
#define PK(L, H) (bf16x8){L[0], L[1], L[2], L[3], H[0], H[1], H[2], H[3]}
  od = __builtin_amdgcn_mfma_f32_32x32x16_bf16(pa0, PK(l0, h0), od, 0, 0, 0);
  od = __builtin_amdgcn_mfma_f32_32x32x16_bf16(pa1, PK(l1, h1), od, 0, 0, 0);
  od = __builtin_amdgcn_mfma_f32_32x32x16_bf16(pa2, PK(l2, h2), od, 0, 0, 0);
  od = __builtin_amdgcn_mfma_f32_32x32x16_bf16(pa3, PK(l3, h3), od, 0, 0, 0);
#undef PK
}
__device__ __forceinline__ void pv_d0(f32x16* o, int vb, bf16x8 pa0, bf16x8 pa1, bf16x8 pa2, bf16x8 pa3) {
  pv_one<0>(o[0], vb, pa0, pa1, pa2, pa3); pv_one<1>(o[1], vb, pa0, pa1, pa2, pa3); pv_one<2>(o[2], vb, pa0, pa1, pa2, pa3); pv_one<3>(o[3], vb, pa0, pa1, pa2, pa3);
}

template <typename TQ>
__device__ __forceinline__ void attn_dense_body(const TQ* __restrict__ Qb, const bf16* __restrict__ Kh, const bf16* __restrict__ Vh,
                                                unsigned short* __restrict__ Ob, int seq, char* lds) {
  using St = Stage<bf16>; using SQ = Stage<TQ>;
  const int tid = mk_tid(), wid = tid >> 6, lane = tid & 63, r32 = lane & 31, hi = lane >> 5;
  bf16* V_lds = (bf16*)lds; bf16* K_lds = (bf16*)(lds + 2 * SHM_V);
  float* ws = (float*)(lds + 2 * SHM_V + 2 * SHM_K) + wid * 64; float* li_l = ws; float* al_l = ws + 32;
  float m_reg = -1e30f, l_reg = 0; f32x16 o[4] = {}; bf16x8 qr[8];
  const TQ* Qw = Qb + (long)(wid * QBLK + r32) * LDQ + hi * 8;
#pragma unroll
  for (int d0 = 0; d0 < 8; ++d0) qr[d0] = SQ::tobf(SQ::ld8(Qw + d0 * 16));
  const int sr = tid >> 4, sc = (tid & 15) * 8, vst0 = v_st(sr, sc), vst1 = v_st(32 + sr, sc);
  const int vb0 = (int)(uintptr_t)V_lds + v_rd_base(lane);
  struct { typename St::T vs0, vs1, ks0, ks1; } sr_[SDEPTH];
#define SLOAD(i, k0) do { sr_[i].vs0 = St::ld8(&Vh[(long)((k0) + sr) * LDK + sc]); sr_[i].vs1 = St::ld8(&Vh[(long)((k0) + 32 + sr) * LDK + sc]); \
    sr_[i].ks0 = St::ld8(&Kh[(long)((k0) + sr) * LDK + sc]); sr_[i].ks1 = St::ld8(&Kh[(long)((k0) + 32 + sr) * LDK + sc]); } while (0)
#define SWRITE(b, i) do { *(bf16x8*)((char*)V_lds + (b) * SHM_V + vst0) = St::tobf(sr_[i].vs0);          \
    *(bf16x8*)((char*)V_lds + (b) * SHM_V + vst1) = St::tobf(sr_[i].vs1); int kc = sc * 2;               \
    *(bf16x8*)((char*)K_lds + (b) * SHM_K + KSWZ(sr, kc)) = St::tobf(sr_[i].ks0);                       \
    *(bf16x8*)((char*)K_lds + (b) * SHM_K + KSWZ(32 + sr, kc)) = St::tobf(sr_[i].ks1); } while (0)
#define SWAIT() do { if constexpr (SDEPTH == 2) asm volatile("s_waitcnt vmcnt(4)" ::: "memory"); else asm volatile("s_waitcnt vmcnt(0)" ::: "memory"); } while (0)
#define RESC(a) do { if (__any((a) < 1.f)) { if (hi == 0) al_l[r32] = (a); asm volatile("s_waitcnt lgkmcnt(0)" ::: "memory"); \
    for (int d = 0; d < 4; ++d) for (int r = 0; r < 16; ++r) o[d][r] *= al_l[crow(r, hi)]; } } while (0)
  f32x16 pA0, pA1, pB0, pB1; float mnA, mnB, alA, alB; bf16x8 pa0, pa1, pa2, pa3; const int NT = seq / KVBLK;
  constexpr int SE = 0, SO = SDEPTH - 1;
  SLOAD(SE, 0); asm volatile("s_waitcnt vmcnt(0)" ::: "memory"); SWRITE(0, SE); __syncthreads();
  qkt(pA0, pA1, K_lds, qr, r32, hi); partialSM(pA0, pA1, m_reg, mnA, alA);
  SLOAD(SO, KVBLK); if constexpr (SDEPTH == 2) { if (2 < NT) SLOAD(SE, 2 * KVBLK); }
  SWAIT(); SWRITE(1, SO); __syncthreads();
  for (int j = 1; j + 1 < NT; j += 2) {
    SBAR(); qkt(pB0, pB1, (bf16*)((char*)K_lds + SHM_K), qr, r32, hi);
    finishSM(pA0, pA1, alA, l_reg, pa0, pa1, pa2, pa3); SBAR();
    SLOAD(SO, (j + SDEPTH) * KVBLK); SBAR();
    pv_d0(o, vb0, pa0, pa1, pa2, pa3); partialSM(pB0, pB1, m_reg, mnB, alB);
    __syncthreads(); SWAIT(); SWRITE(0, SE);
    RESC(alB); __syncthreads();
    SBAR(); qkt(pA0, pA1, K_lds, qr, r32, hi);
    finishSM(pB0, pB1, alB, l_reg, pa0, pa1, pa2, pa3); SBAR();
    if (SDEPTH == 1 || j + 3 < NT) SLOAD(SE, (j + 1 + SDEPTH) * KVBLK); SBAR();
    pv_d0(o, vb0 + (int)SHM_V, pa0, pa1, pa2, pa3); partialSM(pA0, pA1, m_reg, mnA, alA);
    __syncthreads(); SWAIT(); SWRITE(1, SO);
    RESC(alA); __syncthreads();
  }
  SBAR(); qkt(pB0, pB1, (bf16*)((char*)K_lds + SHM_K), qr, r32, hi);
  finishSM(pA0, pA1, alA, l_reg, pa0, pa1, pa2, pa3); SBAR();
  pv_d0(o, vb0, pa0, pa1, pa2, pa3); partialSM(pB0, pB1, m_reg, mnB, alB);
  __syncthreads(); RESC(alB);
  finishSM(pB0, pB1, alB, l_reg, pa0, pa1, pa2, pa3); SBAR();
  pv_d0(o, vb0 + (int)SHM_V, pa0, pa1, pa2, pa3);
  if (hi == 0) li_l[r32] = l_reg; asm volatile("s_waitcnt lgkmcnt(0)" ::: "memory");
  float rli[16];
#pragma unroll
  for (int r = 0; r < 16; ++r) rli[r] = __builtin_amdgcn_rcpf(li_l[crow(r, hi)]);
  unsigned short* Ow = Ob + (long)(wid * QBLK) * LDO;
#pragma unroll
  for (int r = 0; r < 16; ++r) { int orow = crow(r, hi);
    for (int d0 = 0; d0 < 4; ++d0) Ow[(long)orow * LDO + d0 * 32 + r32] = (unsigned short)(cvtpk(o[d0][r] * rli[r], 0.f) & 0xffffu); }
#undef SLOAD
#undef SWRITE
#undef SWAIT
#undef RESC
}

}
__device__ __forceinline__ int mk_tid() { int t = threadIdx.x; asm volatile("" : "+v"(t)); return t; }
namespace mk {
#define LAS __attribute__((address_space(3)))
typedef unsigned short bf16;
typedef short bf16x8 __attribute__((ext_vector_type(8)));
typedef float f32x4 __attribute__((ext_vector_type(4)));
typedef unsigned u32x4 __attribute__((ext_vector_type(4)));
typedef unsigned u32x2 __attribute__((ext_vector_type(2)));
#define XB_TMO      128
#define XB_XCNT(j)  (256  + 64 * (j))
#define XB_XSUB(j)  (1280 + 64 * (j))
#define XB_XGEN(j)  (2304 + 64 * (j))
#define XB_TOP      3328
#define XB_TOPGEN   3392
#define XCD_BAR_WORDS 3456
#define XB_SPIN_CAP (1u << 18)

__device__ __forceinline__ unsigned xb_ld(unsigned* p)              { return __hip_atomic_load(p, __ATOMIC_RELAXED, __HIP_MEMORY_SCOPE_AGENT); }
__device__ __forceinline__ unsigned xb_add(unsigned* p, unsigned v) { return __hip_atomic_fetch_add(p, v, __ATOMIC_RELAXED, __HIP_MEMORY_SCOPE_AGENT); }
__device__ __forceinline__ unsigned xb_xcc_id() { return (unsigned)__builtin_amdgcn_s_getreg((3 << 11) | 20) & 0xFu; }
#define XB_SPIN(cond, bar) do { unsigned _sp = 0; while (cond) { __builtin_amdgcn_s_sleep(1); \
    if ((++_sp & 255u) == 0u) { if (xb_ld(&(bar)[XB_TMO])) break; if (_sp > XB_SPIN_CAP) { atomicAdd(&(bar)[XB_TMO], 1u); break; } } } } while (0)

struct XcdBarrier {
    unsigned* bar; unsigned x;
    volatile LAS unsigned* st;
};

__device__ __forceinline__ XcdBarrier xcd_barrier_post(unsigned* bar, volatile LAS unsigned* st) {
    XcdBarrier b; b.bar = bar; b.x = xb_xcc_id(); b.st = st;
    if (mk_tid() == 0) (void)xb_add(&bar[XB_XCNT(b.x)], 1u);
    return b;
}
__device__ __forceinline__ void xcd_barrier_complete(unsigned* bar, unsigned x, unsigned& nloc, unsigned& nx) {
    const unsigned G = gridDim.x * gridDim.y * gridDim.z;
    unsigned sum, cnt, mine, sp = 0u;
    for (;;) {
        sum = 0u; cnt = 0u; mine = 0u;
#pragma unroll
        for (unsigned j = 0; j < 16; ++j) { const unsigned c = xb_ld(&bar[XB_XCNT(j)]); sum += c; cnt += (c > 0u) ? 1u : 0u; mine = (j == x) ? c : mine; }
        if (sum == G) break;
        __builtin_amdgcn_s_sleep(1);
        if ((++sp & 255u) == 0u) { if (xb_ld(&bar[XB_TMO])) break; if (sp > XB_SPIN_CAP) { atomicAdd(&bar[XB_TMO], 1u); break; } }
    }
    nloc = mine > 0u ? mine : 1u; nx = cnt > 0u ? cnt : 1u;
}

__device__ __forceinline__ void xcd_barrier(const XcdBarrier& b) {
    asm volatile("s_waitcnt vmcnt(0)" ::: "memory");
    __syncthreads();
    if (mk_tid() == 0) {
        unsigned* bar = b.bar;
        __builtin_amdgcn_s_waitcnt(0);
        unsigned nloc = b.st[0], nx = b.st[1];
        if (nloc == 0u) { xcd_barrier_complete(bar, b.x, nloc, nx); b.st[0] = nloc; b.st[1] = nx; }
        const unsigned old = xb_add(&bar[XB_XSUB(b.x)], 1u);
        const unsigned gen = old / nloc;
        if (old + 1u == (gen + 1u) * nloc) {
            __builtin_amdgcn_fence(__ATOMIC_RELEASE, "agent");
            asm volatile("s_waitcnt vmcnt(0)" ::: "memory");
            const unsigned og = xb_add(&bar[XB_TOP], 1u);
            const unsigned tg = og / nx;
            if (og + 1u == (tg + 1u) * nx) xb_add(&bar[XB_TOPGEN], 1u);
            else XB_SPIN(xb_ld(&bar[XB_TOPGEN]) == tg, bar);
            __builtin_amdgcn_fence(__ATOMIC_ACQUIRE, "agent");
            xb_add(&bar[XB_XGEN(b.x)], 1u);
            asm volatile("s_waitcnt vmcnt(0)" ::: "memory");
        } else {
            XB_SPIN(xb_ld(&bar[XB_XGEN(b.x)]) == gen, bar);
            __builtin_amdgcn_fence(__ATOMIC_ACQUIRE, "agent");
            asm volatile("s_waitcnt vmcnt(0)" ::: "memory");
        }
    }
    __syncthreads();
}


constexpr int D = 2048, M = 8192, SEQ = 4096, NW = 8;
constexpr int ABW = 3072, CW = 8224, FF2 = 11264, FF = 5632;
constexpr float EPS = 1e-6f;
constexpr size_t MiB = 1u << 20;
constexpr size_t WS_AB = 0, WS_BD = 12 * MiB, WS_OAB = 13 * MiB, WS_C = 21 * MiB  , WS_OC = 54 * MiB;
constexpr size_t WS_UP0 = 62 * MiB, WS_UP1 = 106 * MiB, WS_DN0 = 150 * MiB, WS_DN1 = 172 * MiB;
constexpr size_t WS_XN = 194 * MiB, WS_GATES = 226 * MiB, WS_S = 228 * MiB;
constexpr size_t WS_PROJ = WS_S, WS_POOLED = WS_S + 48 * MiB, WS_CAT = WS_S + 56 * MiB;
constexpr size_t WS_QK = WS_S, WS_OG = WS_S + 64 * MiB, WS_KVT = WS_S + 96 * MiB, WS_HF = WS_S + 160 * MiB, WS_Y = WS_S + 288 * MiB;
constexpr size_t WS_U = WS_S, WS_ACT = WS_S + 176 * MiB;
constexpr size_t WS_END = WS_S + 320 * MiB;
constexpr int LDS_ML = 154112 + 1024, LDS_MISC = LDS_ML, LDS_BYTES = LDS_ML + 64;
constexpr size_t WS_BAR = WS_BD + 768 * 1024, BAR_BYTES = 16384;

#define LDSWAIT() asm volatile("s_waitcnt lgkmcnt(0)" ::: "memory")
__device__ __forceinline__ unsigned f2bf(float f) { unsigned u = __float_as_uint(f); return (u + 0x7fffu + ((u >> 16) & 1u)) >> 16; }
__device__ __forceinline__ unsigned pk2(float lo, float hi) { unsigned r; asm volatile("v_cvt_pk_bf16_f32 %0, %1, %2" : "=v"(r) : "v"(lo), "v"(hi)); return r; }
__device__ __forceinline__ float bflo(unsigned w) { return __uint_as_float(w << 16); }
__device__ __forceinline__ float bfhi(unsigned w) { return __uint_as_float(w & 0xffff0000u); }
__device__ __forceinline__ float wave_sum(float v) {
#pragma unroll
    for (int o = 1; o < 64; o <<= 1) v += __shfl_xor(v, o);
    return v;
}

__device__ __forceinline__ void transpose_item64(const float* __restrict__ W, int ldw, int K, int nblk, bf16* __restrict__ WT, LAS float* scr, int item, int lane, bool upperm) {
    const int kb = item / nblk, nb = item - kb * nblk, k0 = 64 * kb, n0 = 64 * nb;
    const int d0 = !upperm ? n0 : (n0 < FF ? 256 * (n0 >> 7) + (n0 & 127) : 256 * ((n0 - FF) >> 7) + 128 + ((n0 - FF) & 127));
    f32x4 v[16];
#pragma unroll
    for (int i = 0; i < 16; ++i) { const int kk = 4 * i + (lane >> 4); v[i] = *(const f32x4*)(W + (size_t)(k0 + kk) * ldw + n0 + 4 * (lane & 15)); }
#pragma unroll
    for (int i = 0; i < 16; ++i) { const int kk = 4 * i + (lane >> 4); LAS float* s = scr + kk * 65 + 4 * (lane & 15); s[0] = v[i].x; s[1] = v[i].y; s[2] = v[i].z; s[3] = v[i].w; }
    LDSWAIT();
    const int c = lane & 7, q = lane >> 3;
#pragma unroll
    for (int j = 0; j < 8; ++j) { const int n = q + 8 * j; const LAS float* s = scr + (8 * c) * 65 + n;
        u32x4 o; o.x = pk2(s[0], s[65]); o.y = pk2(s[130], s[195]); o.z = pk2(s[260], s[325]); o.w = pk2(s[390], s[455]);
        *(u32x4*)(WT + (size_t)(d0 + n) * K + k0 + 8 * c) = o; }
    LDSWAIT();
}

__device__ __forceinline__ void rmsnorm_rows(const float* __restrict__ src, const float* __restrict__ gain, bf16* __restrict__ dst, int gw, int ngw, int lane) {
    f32x4 g[8];
#pragma unroll
    for (int j = 0; j < 8; ++j) g[j] = *(const f32x4*)(gain + 4 * lane + 256 * j);
    for (int m = gw; m < M; m += ngw) {
        const f32x4* xr = (const f32x4*)(src + (size_t)m * D) + lane; f32x4 v[8]; float s = 0.f;
#pragma unroll
        for (int j = 0; j < 8; ++j) { v[j] = xr[64 * j]; s += (v[j].x * v[j].x + v[j].y * v[j].y) + (v[j].z * v[j].z + v[j].w * v[j].w); }
        const float rstd = 1.0f / sqrtf(wave_sum(s) * (1.0f / D) + EPS);
        u32x2* o = (u32x2*)(dst + (size_t)m * D) + lane;
#pragma unroll
        for (int j = 0; j < 8; ++j) { u32x2 w; w.x = pk2(v[j].x * rstd * g[j].x, v[j].y * rstd * g[j].y); w.y = pk2(v[j].z * rstd * g[j].z, v[j].w * rstd * g[j].w); o[64 * j] = w; }
    }
}

struct In { const float *x, *norm_mix, *norm_ffn, *w_in_ab, *pool_w, *pool_scale, *q_norm, *k_norm, *w_out_ab, *w_in_c, *b_gate, *h_norm, *w_out_c, *w_up, *conv_w, *conv_b, *w_down; };

__device__ __forceinline__ void transposes(const In& I, unsigned char* ws, LAS unsigned char* lds, int first, int last, int w, int nw, int wave, int lane) {
    LAS float* scr = (LAS float*)(lds + wave * 16640);
    for (int it = first + w; it < last; it += nw) {
        const float* W; int ldw, K, nblk; bf16* WT; int r = it;
        if (r < 1536) { W = I.w_in_ab; ldw = ABW; K = D; nblk = 48; WT = (bf16*)(ws + WS_AB); }
        else if (r < 2560) { r -= 1536; W = I.w_out_ab; ldw = D; K = D; nblk = 32; WT = (bf16*)(ws + WS_OAB); }
        else if (r < 6656) { r -= 2560; W = I.w_in_c; ldw = CW; K = D; nblk = 128; WT = (bf16*)(ws + WS_C); }
        else if (r < 7680) { r -= 6656; W = I.w_out_c; ldw = D; K = D; nblk = 32; WT = (bf16*)(ws + WS_OC); }
        else if (r < 13312) { r -= 7680; W = I.w_up; ldw = FF2; K = D; nblk = 176; WT = (bf16*)(ws + WS_UP0); }
        else if (r < 18944) { r -= 13312; W = I.w_up + (size_t)D * FF2; ldw = FF2; K = D; nblk = 176; WT = (bf16*)(ws + WS_UP1); }
        else if (r < 21760) { r -= 18944; W = I.w_down; ldw = D; K = FF; nblk = 32; WT = (bf16*)(ws + WS_DN0); }
        else { r -= 21760; W = I.w_down + (size_t)FF * D; ldw = D; K = FF; nblk = 32; WT = (bf16*)(ws + WS_DN1); }
        transpose_item64(W, ldw, K, nblk, WT, scr, r, lane, (it >= 7680 && it < 18944));
    }
}
__device__ __forceinline__ void prologue(const In& I, unsigned char* ws, LAS unsigned char* lds, int gw, int ngw, int wave, int lane) {
    transposes(I, ws, lds, 0, 1536, gw, ngw, wave, lane);
    const int gt = gw * 64 + lane, ngt = ngw * 64;
    { bf16* WG = (bf16*)(ws + WS_C) + (size_t)8192 * D;
      for (int idx = gt; idx < 32 * D; idx += ngt) { const int j = idx >> 11, k = idx & 2047; WG[idx] = (bf16)f2bf(I.w_in_c[(size_t)k * CW + 8192 + j]); } }
    { bf16* BD = (bf16*)(ws + WS_BD);
      for (int idx = gt; idx < 512 * 512; idx += ngt) { const int n = idx >> 9, k = idx & 511, gn = n >> 7, gk = k >> 7;
          const float v = (gn == gk) ? I.pool_w[(size_t)(gn * 128 + (k & 127)) * 128 + (n & 127)] * I.pool_scale[n] : 0.f; BD[idx] = (bf16)f2bf(v); } }
    rmsnorm_rows(I.x, I.norm_mix, (bf16*)(ws + WS_XN), gw, ngw, lane);
}

__device__ __forceinline__ void qk_rope_pool(bf16* __restrict__ PROJ, const float* __restrict__ qn, const float* __restrict__ kn, bf16* __restrict__ POOLED, int gw, int ngw, int lane) {
    const int l = lane & 31, hsel = lane >> 5, part = (l >> 4) & 1; const bool first = (l & 8) == 0;
    float inv[4];
#pragma unroll
    for (int e = 0; e < 4; ++e) inv[e] = exp2f(-(float)(4 * (l & 7) + e) * (13.287712379549449f / 32.0f));
    const f32x4 gq = *(const f32x4*)(qn + 4 * l), gk = *(const f32x4*)(kn + 4 * l);
    for (int it0 = gw; it0 < M * 8; it0 += 4 * ngw) {
        u32x2 wv[4]; bf16* pp4[4]; int tt4[4], hh4[4]; bool ok[4];
#pragma unroll
        for (int k = 0; k < 4; ++k) { const int it = it0 + k * ngw; ok[k] = it < M * 8; const int itc = ok[k] ? it : gw; tt4[k] = itc >> 3; hh4[k] = (itc & 7) * 2 + hsel;
            pp4[k] = PROJ + (size_t)tt4[k] * ABW + 512 + hh4[k] * 128 + 4 * l; wv[k] = *(const u32x2*)pp4[k]; }
#pragma unroll
        for (int k = 0; k < 4; ++k) {
            const u32x2 w = wv[k]; const int t = tt4[k], hh = hh4[k];
            float x[4] = {bflo(w.x), bfhi(w.x), bflo(w.y), bfhi(w.y)};
            float ss = (x[0] * x[0] + x[1] * x[1]) + (x[2] * x[2] + x[3] * x[3]);
#pragma unroll
            for (int o = 1; o < 32; o <<= 1) ss += __shfl_xor(ss, o);
            const float rstd = 1.0f / sqrtf(ss * (1.0f / 128.0f) + EPS);
            const f32x4 g = (hh < 12) ? gq : gk;
            const int pos = t & (SEQ - 1); const float pp = part ? (float)(pos & 63) : (float)(pos >> 6);
            float y[4] = {x[0] * rstd * g.x, x[1] * rstd * g.y, x[2] * rstd * g.z, x[3] * rstd * g.w}, o4[4];
#pragma unroll
            for (int e = 0; e < 4; ++e) { const float yp = __shfl_xor(y[e], 8); const float ang = pp * inv[e]; const float sn = __sinf(ang), cs = __cosf(ang);
                o4[e] = y[e] * cs + (first ? -yp : yp) * sn; }
            u32x2 ow; ow.x = pk2(o4[0], o4[1]); ow.y = pk2(o4[2], o4[3]); if (ok[k]) *(u32x2*)pp4[k] = ow;
        }
    }
    const int gt = gw * 64 + lane, ngt = ngw * 64;
    for (int it = gt; it < M * 64; it += ngt) {
        const int t = it >> 6, c8 = (it & 63) * 8, g = c8 >> 7, w2 = 1 << g, pos = t & (SEQ - 1), base = t - pos;
        const int lo = max(pos - w2, 0), hi = min(pos + w2, SEQ);
        float acc[8] = {0.f, 0.f, 0.f, 0.f, 0.f, 0.f, 0.f, 0.f};
        for (int pz = lo; pz < hi; ++pz) { const u32x4 v = *(const u32x4*)(PROJ + (size_t)(base + pz) * ABW + c8);
            acc[0] += bflo(v.x); acc[1] += bfhi(v.x); acc[2] += bflo(v.y); acc[3] += bfhi(v.y); acc[4] += bflo(v.z); acc[5] += bfhi(v.z); acc[6] += bflo(v.w); acc[7] += bfhi(v.w); }
        const u32x4 sv = *(const u32x4*)(PROJ + (size_t)t * ABW + c8); const float iv = 1.0f / (float)(hi - lo);
        u32x4 o; o.x = pk2(acc[0] * iv - bflo(sv.x), acc[1] * iv - bfhi(sv.x)); o.y = pk2(acc[2] * iv - bflo(sv.y), acc[3] * iv - bfhi(sv.y));
        o.z = pk2(acc[4] * iv - bflo(sv.z), acc[5] * iv - bfhi(sv.z)); o.w = pk2(acc[6] * iv - bflo(sv.w), acc[7] * iv - bfhi(sv.w));
        *(u32x4*)(POOLED + (size_t)t * 512 + c8) = o;
    }
}

__device__ __forceinline__ void conv_fix(const bf16* __restrict__ HALO, const float* __restrict__ cw, const float* __restrict__ cb, bf16* __restrict__ ACT, int gt, int ngt) {
    for (int it = gt; it < 256 * 704; it += ngt) {
        const int jc = it % 704, re = it / 704, blk = re >> 1, last = re & 1, j = jc * 8;
        const int t = blk * 64 + (last ? 63 : 0), pos = t & (SEQ - 1);
        const bf16* rc = HALO + ((size_t)blk * 4 + (last ? 3 : 0)) * FF2 + j;
        const bf16* ru = last ? rc - FF2 : HALO + ((size_t)(blk - 1) * 4 + 3) * FF2 + j;
        const bf16* rd = last ? HALO + ((size_t)(blk + 1) * 4) * FF2 + j : rc + FF2;
        const u32x4 z = {0u, 0u, 0u, 0u};
        const u32x4 g1 = *(const u32x4*)rc, v1 = *(const u32x4*)(rc + FF);
        const u32x4 g0 = pos > 0 ? *(const u32x4*)ru : z, v0 = pos > 0 ? *(const u32x4*)(ru + FF) : z;
        const u32x4 g2 = pos < SEQ - 1 ? *(const u32x4*)rd : z, v2 = pos < SEQ - 1 ? *(const u32x4*)(rd + FF) : z;
        float o[8];
#pragma unroll
        for (int q = 0; q < 4; ++q) {
            const int ja = j + 2 * q, jb = ja + 1;
            const float ga = cw[ja] * bflo(g0[q]) + cw[FF2 + ja] * bflo(g1[q]) + cw[2 * FF2 + ja] * bflo(g2[q]) + cb[ja];
            const float gb = cw[jb] * bfhi(g0[q]) + cw[FF2 + jb] * bfhi(g1[q]) + cw[2 * FF2 + jb] * bfhi(g2[q]) + cb[jb];
            const float va = cw[FF + ja] * bflo(v0[q]) + cw[FF2 + FF + ja] * bflo(v1[q]) + cw[2 * FF2 + FF + ja] * bflo(v2[q]) + cb[FF + ja];
            const float vb = cw[FF + jb] * bfhi(v0[q]) + cw[FF2 + FF + jb] * bfhi(v1[q]) + cw[2 * FF2 + FF + jb] * bfhi(v2[q]) + cb[FF + jb];
            o[2 * q] = ga / (1.0f + __expf(-ga)) * va; o[2 * q + 1] = gb / (1.0f + __expf(-gb)) * vb;
        }
        u32x4 ow; ow.x = pk2(o[0], o[1]); ow.y = pk2(o[2], o[3]); ow.z = pk2(o[4], o[5]); ow.w = pk2(o[6], o[7]);
        *(u32x4*)(ACT + (size_t)t * FF + j) = ow;
    }
}

__device__ __forceinline__ void gates_phase(const bf16* __restrict__ XN, const bf16* __restrict__ WG, const float* __restrict__ bg, float* __restrict__ GATES, LAS float* red, int bid, int nblk) {
    const int tid = mk_tid(), wid = tid >> 6, lane = tid & 63, fr = lane & 15, fq = lane >> 4;
    const int tile = wid & 3, tt = tile & 1, jt = tile >> 1, kh = wid >> 2;
    for (int grp = bid; grp < 256; grp += nblk) {
        f32x4 acc = {0.f, 0.f, 0.f, 0.f};
        const bf16* ap = WG + (size_t)(jt * 16 + fr) * D + kh * 1024 + fq * 8;
        const bf16* bp = XN + (size_t)(grp * 32 + tt * 16 + fr) * D + kh * 1024 + fq * 8;
#pragma unroll 8
        for (int ks = 0; ks < 32; ++ks) { const bf16x8 a = *(const bf16x8*)(ap + ks * 32), b = *(const bf16x8*)(bp + ks * 32); acc = __builtin_amdgcn_mfma_f32_16x16x32_bf16(a, b, acc, 0, 0, 0); }
        if (kh == 1) { LAS float* r = red + (tile * 64 + lane) * 4; r[0] = acc[0]; r[1] = acc[1]; r[2] = acc[2]; r[3] = acc[3]; }
        __syncthreads();
        if (kh == 0) { const LAS float* r = red + (tile * 64 + lane) * 4; const int t = grp * 32 + tt * 16 + fr, j = jt * 16 + 4 * fq;
            const f32x4 b4 = *(const f32x4*)(bg + j); f32x4 o; o.x = acc[0] + r[0] + b4.x; o.y = acc[1] + r[1] + b4.y; o.z = acc[2] + r[2] + b4.z; o.w = acc[3] + r[3] + b4.w;
            *(f32x4*)(GATES + (size_t)t * 32 + j) = o; }
        __syncthreads();
    }
}

__device__ __forceinline__ void headnorm_phase(const bf16* __restrict__ HF, const bf16* __restrict__ OG, const float* __restrict__ hn, bf16* __restrict__ Y, int gw, int ngw, int lane) {
    for (int it0 = gw; it0 < M * 8; it0 += 4 * ngw) {
        u32x2 a[4], b[4], ow[4]; f32x4 g[4]; size_t off[4]; bool ok[4];
#pragma unroll
        for (int k = 0; k < 4; ++k) { const int it = it0 + k * ngw; ok[k] = it < M * 8; const int itc = ok[k] ? it : gw; const int t = itc >> 3, h = itc & 7; off[k] = (size_t)t * D + h * 256 + 4 * lane;
            a[k] = *(const u32x2*)(HF + off[k]); b[k] = *(const u32x2*)(HF + (size_t)M * D + off[k]); ow[k] = *(const u32x2*)(OG + off[k]); g[k] = *(const f32x4*)(hn + h * 256 + 4 * lane); }
#pragma unroll
        for (int k = 0; k < 4; ++k) {
            f32x4 s; s.x = bflo(a[k].x) + bflo(b[k].x); s.y = bfhi(a[k].x) + bfhi(b[k].x); s.z = bflo(a[k].y) + bflo(b[k].y); s.w = bfhi(a[k].y) + bfhi(b[k].y);
            const float ss = wave_sum((s.x * s.x + s.y * s.y) + (s.z * s.z + s.w * s.w));
            const float rstd = 1.0f / sqrtf(ss * (1.0f / 256.0f) + EPS);
            const float o0 = bflo(ow[k].x), o1 = bfhi(ow[k].x), o2 = bflo(ow[k].y), o3 = bfhi(ow[k].y);
            u32x2 w; w.x = pk2(s.x * rstd * g[k].x * __builtin_amdgcn_rcpf(1.0f + __expf(-o0)), s.y * rstd * g[k].y * __builtin_amdgcn_rcpf(1.0f + __expf(-o1)));
            w.y = pk2(s.z * rstd * g[k].z * __builtin_amdgcn_rcpf(1.0f + __expf(-o2)), s.w * rstd * g[k].w * __builtin_amdgcn_rcpf(1.0f + __expf(-o3)));
            if (ok[k]) *(u32x2*)(Y + off[k]) = w;
        }
    }
}

namespace ml {
constexpr int LQ = 264, LS = 72;
constexpr int OFF_Q = 0, OFF_K = 33792, OFF_KT = 67584, OFF_VT = 104448, OFF_VTW = 111360, OFF_P = 118272, OFF_CT = 127488, OFF_SC = 152832;
static_assert(OFF_SC + 1280 + 1024 == LDS_ML, "mlstm lds map");
#define ML_BAR() do { asm volatile("s_waitcnt lgkmcnt(0)" ::: "memory"); __builtin_amdgcn_s_barrier(); asm volatile("" ::: "memory"); } while (0)
#define ML_DPP(old, src, ctrl, rmask) __int_as_float(__builtin_amdgcn_update_dpp(__float_as_int(old), __float_as_int(src), ctrl, rmask, 0xF, false))
#define ML_MFMA(a, b, c) __builtin_amdgcn_mfma_f32_16x16x32_bf16(a, b, c, 0, 0, 0)

__device__ __forceinline__ void mlstm_phase(LAS unsigned char* lds, const bf16* __restrict__ QK, const bf16* __restrict__ KVT, const float* __restrict__ GATES, bf16* __restrict__ HF, int bid, int nblk) {
    const int tid = mk_tid(), wid = tid >> 6, lane = tid & 63, fr = lane & 15, fq = lane >> 4;
    LAS bf16* Qs = (LAS bf16*)(lds + OFF_Q); LAS bf16* Ks = (LAS bf16*)(lds + OFF_K); LAS bf16* KTs = (LAS bf16*)(lds + OFF_KT);
    LAS bf16* VTs = (LAS bf16*)(lds + OFF_VT); LAS bf16* VTw = (LAS bf16*)(lds + OFF_VTW); LAS bf16* Ps = (LAS bf16*)(lds + OFF_P); LAS bf16* CTs = (LAS bf16*)(lds + OFF_CT);
    LAS float* sA = (LAS float*)(lds + OFF_SC); LAS float* sM = sA + 64; LAS float* sAI = sM + 64; LAS float* sEM = sAI + 64; LAS float* sWS = (LAS float*)(lds + OFF_SC + 1280);
    const int tt = wid & 3, sh = wid >> 2;
    for (int it0 = bid; it0 < 256; it0 += nblk) {
        const int item = (nblk == 256) ? (((it0 & 7) * 4 + (it0 >> 6)) * 8 + ((it0 >> 3) & 7)) : it0;
        const int es = item & 7, dir = (item >> 3) & 1, h = (item >> 4) & 7, b = (item >> 7) & 1;
        for (int i = tid; i < 48 * LQ / 2; i += 512) ((LAS unsigned*)CTs)[i] = 0u;
        for (int i = tid; i < 16 * LS; i += 512) { VTs[32 * LS + i] = (i < LS) ? (bf16)0x3F80 : (bf16)0; VTw[32 * LS + i] = (bf16)0; }
        f32x4 ct[2][3];
#pragma unroll
        for (int a = 0; a < 2; ++a)
#pragma unroll
            for (int e = 0; e < 3; ++e) ct[a][e] = (f32x4){0.f, 0.f, 0.f, 0.f};
        float m_st = 0.f, decay = 1.f;
        bf16x8 rq[4], rk[4], rkt[4], rvt = {0, 0, 0, 0, 0, 0, 0, 0}; float gi = 0.f, gf = 0.f;
        const unsigned voffQ = (unsigned)(((tid >> 5) * 4096 + (tid & 31) * 8) * 2), voffT = (unsigned)(((tid >> 3) * M + (tid & 7) * 8) * 2), voffG = (unsigned)((dir ? 63 - lane : lane) * 128);
#define ML_LOAD(c) do { const int ncn_ = dir ? 63 - (c) : (c); const size_t trow_ = (size_t)b * SEQ + (size_t)ncn_ * 64; \
        const char* qb_ = (const char*)(QK + trow_ * 4096 + h * 256); \
        _Pragma("unroll") for (int i_ = 0; i_ < 4; ++i_) { rq[i_] = *(const bf16x8*)(qb_ + (size_t)i_ * 131072 + voffQ); rk[i_] = *(const bf16x8*)(qb_ + 4096 + (size_t)i_ * 131072 + voffQ); } \
        const char* tb_ = (const char*)(KVT + (size_t)(h * 256) * M + trow_); \
        _Pragma("unroll") for (int i_ = 0; i_ < 4; ++i_) rkt[i_] = *(const bf16x8*)(tb_ + (size_t)i_ * (64 * M * 2) + voffT); \
        if (tid < 256) rvt = *(const bf16x8*)((const char*)(KVT + (size_t)(2048 + h * 256 + es * 32) * M + trow_) + voffT); \
        { const float* gp_ = GATES + trow_ * 32 + dir * 16 + h; gi = *(const float*)((const char*)gp_ + voffG); gf = *(const float*)((const char*)gp_ + 32 + voffG); } } while (0)
#define ML_STORE() do { \
        const float lf_ = fminf(gf, 0.f) - log1pf(__expf(-fabsf(gf))); float bc_ = lf_; \
        bc_ += ML_DPP(0.f, bc_, 0x111, 0xF); bc_ += ML_DPP(0.f, bc_, 0x112, 0xF); bc_ += ML_DPP(0.f, bc_, 0x114, 0xF); bc_ += ML_DPP(0.f, bc_, 0x118, 0xF); \
        bc_ += ML_DPP(0.f, bc_, 0x142, 0xA); bc_ += ML_DPP(0.f, bc_, 0x143, 0xC); \
        const float a_ = gi - bc_; float cm_ = a_; \
        cm_ = fmaxf(cm_, ML_DPP(-3.0e38f, cm_, 0x111, 0xF)); cm_ = fmaxf(cm_, ML_DPP(-3.0e38f, cm_, 0x112, 0xF)); cm_ = fmaxf(cm_, ML_DPP(-3.0e38f, cm_, 0x114, 0xF)); cm_ = fmaxf(cm_, ML_DPP(-3.0e38f, cm_, 0x118, 0xF)); \
        cm_ = fmaxf(cm_, ML_DPP(-3.0e38f, cm_, 0x142, 0xA)); cm_ = fmaxf(cm_, ML_DPP(-3.0e38f, cm_, 0x143, 0xC)); \
        const float Mv_ = fmaxf(m_st, cm_), blast_ = __shfl(bc_, 63), cml_ = __shfl(cm_, 63), Mn_ = fmaxf(m_st, cml_); \
        const float ai_ = __expf(m_st - Mv_), em_ = __expf(-(bc_ + Mv_)), wsv_ = __expf(a_ - Mn_); decay = __expf(m_st - Mn_); m_st = blast_ + Mn_; \
        const int rr_ = dir ? 63 - lane : lane; \
        if (wid == 0) { sA[rr_] = a_; sM[rr_] = Mv_; sAI[rr_] = ai_; sEM[rr_] = em_; VTw[32 * LS + rr_] = (bf16)f2bf(wsv_); } \
        _Pragma("unroll") for (int i_ = 0; i_ < 4; ++i_) { const int q_ = tid + 512 * i_, r_ = q_ >> 5, cc_ = (q_ & 31) * 8; \
            *(LAS bf16x8*)(Qs + r_ * LQ + cc_) = rq[i_]; *(LAS bf16x8*)(Ks + r_ * LQ + cc_) = rk[i_]; } \
        _Pragma("unroll") for (int i_ = 0; i_ < 4; ++i_) { const int q_ = tid + 512 * i_, d_ = q_ >> 3, cc_ = (q_ & 7) * 8; *(LAS bf16x8*)(KTs + d_ * LS + cc_) = rkt[i_]; } \
        if (tid < 256) { const int e_ = tid >> 3, cc_ = (tid & 7) * 8; *(LAS bf16x8*)(VTs + e_ * LS + cc_) = rvt; \
            LAS float* wsp_ = sWS + wid * 64; wsp_[rr_] = wsv_; asm volatile("s_waitcnt lgkmcnt(0)" ::: "memory"); \
            const f32x4 wa_ = *(const LAS f32x4*)(wsp_ + cc_), wb_ = *(const LAS f32x4*)(wsp_ + cc_ + 4); const float wv_[8] = {wa_.x, wa_.y, wa_.z, wa_.w, wb_.x, wb_.y, wb_.z, wb_.w}; \
            const u32x4 rv_ = __builtin_bit_cast(u32x4, rvt); u32x4 o_; \
            o_.x = pk2(bflo(rv_.x) * wv_[0], bfhi(rv_.x) * wv_[1]); o_.y = pk2(bflo(rv_.y) * wv_[2], bfhi(rv_.y) * wv_[3]); \
            o_.z = pk2(bflo(rv_.z) * wv_[4], bfhi(rv_.z) * wv_[5]); o_.w = pk2(bflo(rv_.w) * wv_[6], bfhi(rv_.w) * wv_[7]); \
            *(LAS u32x4*)(VTw + e_ * LS + cc_) = o_; } } while (0)
        ML_LOAD(0);
        ML_BAR();
        ML_STORE();
        ML_BAR();
        ML_LOAD(1);
        for (int c = 0; c < 64; ++c) {
            const int ncn = dir ? 63 - c : c; const size_t trow = (size_t)b * SEQ + (size_t)ncn * 64;
            const float dec_c = decay;
            f32x4 s0 = {0.f, 0.f, 0.f, 0.f}, s1 = s0, n3 = s0, d3 = s0;
            {
                const LAS bf16* qp = Qs + (tt * 16 + fr) * LQ + fq * 8;
                const LAS bf16* kp0 = Ks + ((2 * sh) * 16 + fr) * LQ + fq * 8; const LAS bf16* kp1 = kp0 + 16 * LQ;
                const LAS bf16* cp0 = CTs + (sh * 16 + fr) * LQ + fq * 8; const LAS bf16* cp2 = CTs + (32 + fr) * LQ + fq * 8;
#pragma unroll
                for (int hf = 0; hf < 4; ++hf) {
                    bf16x8 qf[2], k0[2], k1[2], c0[2], c2[2];
#pragma unroll
                    for (int k4 = 0; k4 < 2; ++k4) { const int ko = (hf * 2 + k4) * 32;
                        qf[k4] = *(const LAS bf16x8*)(qp + ko); k0[k4] = *(const LAS bf16x8*)(kp0 + ko); k1[k4] = *(const LAS bf16x8*)(kp1 + ko);
                        c0[k4] = *(const LAS bf16x8*)(cp0 + ko); c2[k4] = *(const LAS bf16x8*)(cp2 + ko); }
                    __builtin_amdgcn_sched_barrier(0);
#pragma unroll
                    for (int k4 = 0; k4 < 2; ++k4) { s0 = ML_MFMA(k0[k4], qf[k4], s0); s1 = ML_MFMA(k1[k4], qf[k4], s1); n3 = ML_MFMA(c0[k4], qf[k4], n3); d3 = ML_MFMA(c2[k4], qf[k4], d3); }
                }
            }
            const int t = tt * 16 + fr; const float Mt = sM[t];
            {
                const int sb0 = (2 * sh) * 16 + 4 * fq, sb1 = sb0 + 16;
                const f32x4 a0 = *(const LAS f32x4*)(sA + sb0), a1 = *(const LAS f32x4*)(sA + sb1);
                float p0[4], p1[4];
#pragma unroll
                for (int r = 0; r < 4; ++r) {
                    const int sa = sb0 + r, sbb = sb1 + r;
                    const bool ok0 = dir ? (sa >= t) : (sa <= t), ok1 = dir ? (sbb >= t) : (sbb <= t);
                    p0[r] = ok0 ? s0[r] * __expf(a0[r] - Mt) : 0.f; p1[r] = ok1 ? s1[r] * __expf(a1[r] - Mt) : 0.f;
                }
                u32x2 w0, w1; w0.x = pk2(p0[0], p0[1]); w0.y = pk2(p0[2], p0[3]); w1.x = pk2(p1[0], p1[1]); w1.y = pk2(p1[2], p1[3]);
                *(LAS u32x2*)(Ps + t * LS + sb0) = w0; *(LAS u32x2*)(Ps + t * LS + sb1) = w1;
            }
            ML_BAR();
            f32x4 n2 = {0.f, 0.f, 0.f, 0.f}, d2 = n2;
            {
                bf16x8 pf[2], v0[2], v2[2];
#pragma unroll
                for (int ks = 0; ks < 2; ++ks) { const int ko = ks * 32 + fq * 8;
                    pf[ks] = *(const LAS bf16x8*)(Ps + (tt * 16 + fr) * LS + ko); v0[ks] = *(const LAS bf16x8*)(VTs + (sh * 16 + fr) * LS + ko); v2[ks] = *(const LAS bf16x8*)(VTs + (32 + fr) * LS + ko); }
                __builtin_amdgcn_sched_barrier(0);
#pragma unroll
                for (int ks = 0; ks < 2; ++ks) { n2 = ML_MFMA(v0[ks], pf[ks], n2); d2 = ML_MFMA(v2[ks], pf[ks], d2); }
            }
            {
                const float ai = sAI[t], em = sEM[t];
                const float den0 = d2[0] + ai * d3[0];
                const float den = __shfl(den0, fr);
                const float rinv = 1.0f / fmaxf(fabsf(den), em);
                f32x4 hout; hout.x = (n2[0] + ai * n3[0]) * rinv; hout.y = (n2[1] + ai * n3[1]) * rinv; hout.z = (n2[2] + ai * n3[2]) * rinv; hout.w = (n2[3] + ai * n3[3]) * rinv;
                { u32x2 hw; hw.x = pk2(hout.x, hout.y); hw.y = pk2(hout.z, hout.w); *(u32x2*)(HF + ((size_t)dir * M + trow + t) * D + h * 256 + es * 32 + sh * 16 + 4 * fq) = hw; }
            }
#pragma unroll
            for (int a = 0; a < 2; ++a)
#pragma unroll
                for (int e = 0; e < 3; ++e) ct[a][e] = ct[a][e] * dec_c;
#pragma unroll
            for (int ks = 0; ks < 2; ++ks) { const int ko = ks * 32 + fq * 8; bf16x8 kt[2], vw[3];
#pragma unroll
                for (int a = 0; a < 2; ++a) kt[a] = *(const LAS bf16x8*)(KTs + ((2 * wid + a) * 16 + fr) * LS + ko);
#pragma unroll
                for (int e = 0; e < 3; ++e) vw[e] = *(const LAS bf16x8*)(VTw + (e * 16 + fr) * LS + ko);
                __builtin_amdgcn_sched_barrier(0);
#pragma unroll
                for (int a = 0; a < 2; ++a)
#pragma unroll
                    for (int e = 0; e < 3; ++e) ct[a][e] = ML_MFMA(kt[a], vw[e], ct[a][e]);
            }
#pragma unroll
            for (int a = 0; a < 2; ++a)
#pragma unroll
                for (int e = 0; e < 3; ++e) { u32x2 w; w.x = f2bf(ct[a][e][0]) | (f2bf(ct[a][e][1]) << 16); w.y = f2bf(ct[a][e][2]) | (f2bf(ct[a][e][3]) << 16);
                    *(LAS u32x2*)(CTs + (e * 16 + fr) * LQ + (2 * wid + a) * 16 + 4 * fq) = w; }
            ML_BAR();
            if (c + 1 < 64) { ML_STORE(); }
            ML_BAR();
            if (c + 2 < 64) { ML_LOAD(c + 2); }
        }
#undef ML_LOAD
#undef ML_STORE
    }
}
}
}

struct EpiRes {
    static constexpr bool PERM = false, AFTER_DRAIN = false;
    const float* base; float* out; int ldc;
    __device__ __forceinline__ void operator()(const pg8::f32x4 (&acc)[2][2][4][2], const pg8::Unit& u, int wr, int wc, int fr, int fq) const {
#pragma unroll
        for (int ai = 0; ai < 2; ++ai)
#pragma unroll
            for (int m = 0; m < 4; ++m) { const size_t ro = (size_t)(u.pm * 256 + ai * 128 + wr * 64 + m * 16 + fr) * ldc + u.pn * 256 + wc * 32 + 4 * fq;
#pragma unroll
                for (int bj = 0; bj < 2; ++bj)
#pragma unroll
                    for (int n = 0; n < 2; ++n) { const size_t off = ro + bj * 128 + n * 16; const pg8::f32x4 bs = *(const pg8::f32x4*)(base + off); *(pg8::f32x4*)(out + off) = bs + acc[ai][bj][m][n]; } }
    }
};

#define ROR1(x) __int_as_float(__builtin_amdgcn_update_dpp(0, __float_as_int(x), 0x121, 0xF, 0xF, false))
#define ROL1(x) __int_as_float(__builtin_amdgcn_update_dpp(0, __float_as_int(x), 0x12F, 0xF, 0xF, false))
struct EpiConv {
    static constexpr bool PERM = true, AFTER_DRAIN = false;
    unsigned short* ACT; unsigned short* HALO; const float* cw; const float* cb;
    __device__ __forceinline__ void operator()(const pg8::f32x4 (&acc)[2][2][4][2], const pg8::Unit& u, int wr, int wc, int fr, int fq) const {
        using mk::FF; using mk::FF2;
        const int jb = u.pn * 128 + wc * 32 + 8 * fq;
        mk::u32x2 keep[2][4];
#pragma unroll
        for (int n = 0; n < 2; ++n) {
            const int j = jb + 4 * n;
            const pg8::f32x4 c0g = *(const pg8::f32x4*)(cw + j), c1g = *(const pg8::f32x4*)(cw + FF2 + j), c2g = *(const pg8::f32x4*)(cw + 2 * FF2 + j), cbg = *(const pg8::f32x4*)(cb + j);
            const pg8::f32x4 c0v = *(const pg8::f32x4*)(cw + FF + j), c1v = *(const pg8::f32x4*)(cw + FF2 + FF + j), c2v = *(const pg8::f32x4*)(cw + 2 * FF2 + FF + j), cbv = *(const pg8::f32x4*)(cb + FF + j);
#pragma unroll
            for (int ai = 0; ai < 2; ++ai) {
                float gRp[4], vRp[4], gLc[4], vLc[4];
#pragma unroll
                for (int i = 0; i < 4; ++i) { gLc[i] = ROL1(acc[ai][0][0][n][i]); vLc[i] = ROL1(acc[ai][1][0][n][i]); gRp[i] = 0.f; vRp[i] = 0.f; }
#pragma unroll
                for (int m = 0; m < 4; ++m) {
                    const int row = u.pm * 256 + ai * 128 + wr * 64 + m * 16 + fr;
                    float o[4];
#pragma unroll
                    for (int i = 0; i < 4; ++i) {
                        const float g = acc[ai][0][m][n][i], v = acc[ai][1][m][n][i];
                        const float gRc = ROR1(g), vRc = ROR1(v);
                        float gLn = 0.f, vLn = 0.f; if (m < 3) { gLn = ROL1(acc[ai][0][m + 1][n][i]); vLn = ROL1(acc[ai][1][m + 1][n][i]); }
                        float gu = gRc, vu = vRc, gd = gLc[i], vd = vLc[i];
                        if (m > 0) { if (fr == 0) { gu = gRp[i]; vu = vRp[i]; } }
                        if (m < 3) { if (fr == 15) { gd = gLn; vd = vLn; } }
                        gRp[i] = gRc; vRp[i] = vRc; gLc[i] = gLn; vLc[i] = vLn;
                        const float G = c0g[i] * gu + c1g[i] * g + c2g[i] * gd + cbg[i];
                        const float V = c0v[i] * vu + c1v[i] * v + c2v[i] * vd + cbv[i];
                        o[i] = G * __builtin_amdgcn_rcpf(1.0f + __expf(-G)) * V;
                    }
                    const bool edge = (m == 0 && fr == 0) || (m == 3 && fr == 15);
                    { mk::u32x2 w; w.x = mk::pk2(o[0], o[1]); w.y = mk::pk2(o[2], o[3]);
                      if (n == 0) keep[ai][m] = w;
                      else if (!edge) { mk::u32x4 w4; w4.x = keep[ai][m].x; w4.y = keep[ai][m].y; w4.z = w.x; w4.w = w.y; *(mk::u32x4*)(ACT + (size_t)row * FF + jb) = w4; } }
                    if ((m == 0 && fr < 2) || (m == 3 && fr > 13)) {
                        const int hr = (m == 0) ? fr : fr - 12;
                        unsigned short* hp = HALO + ((size_t)(row >> 6) * 4 + hr) * FF2 + j;
                        mk::u32x2 wg, wv; wg.x = mk::f2bf(acc[ai][0][m][n][0]) | (mk::f2bf(acc[ai][0][m][n][1]) << 16); wg.y = mk::f2bf(acc[ai][0][m][n][2]) | (mk::f2bf(acc[ai][0][m][n][3]) << 16);
                        wv.x = mk::f2bf(acc[ai][1][m][n][0]) | (mk::f2bf(acc[ai][1][m][n][1]) << 16); wv.y = mk::f2bf(acc[ai][1][m][n][2]) | (mk::f2bf(acc[ai][1][m][n][3]) << 16);
                        *(mk::u32x2*)hp = wg; *(mk::u32x2*)(hp + FF) = wv;
                    }
                }
            }
        }
    }
};

struct EpiBf16T {
    static constexpr bool PERM = true, AFTER_DRAIN = false;
    unsigned short* O; int ldc; int split_cols; float scale0; unsigned short* T; int tcol0; int ldt;
    __device__ __forceinline__ void operator()(const pg8::f32x4 (&acc)[2][2][4][2], const pg8::Unit& u, int wr, int wc, int fr, int fq) const {
        const int row0 = u.pm * 256 + wr * 64 + fr, colt = u.pn * 256, col0 = colt + wc * 32 + 8 * fq;
        const float sc = (colt < split_cols) ? scale0 : 1.f;
#pragma unroll
        for (int ai = 0; ai < 2; ++ai)
#pragma unroll
            for (int m = 0; m < 4; ++m) { unsigned short* rowp = O + (size_t)(row0 + ai * 128 + m * 16) * ldc + col0;
#pragma unroll
                for (int bj = 0; bj < 2; ++bj) { const pg8::f32x4 v0 = acc[ai][bj][m][0] * sc, v1 = acc[ai][bj][m][1] * sc;
                    mk::u32x4 w; w.x = mk::pk2(v0[0], v0[1]); w.y = mk::pk2(v0[2], v0[3]); w.z = mk::pk2(v1[0], v1[1]); w.w = mk::pk2(v1[2], v1[3]);
                    *(mk::u32x4*)(rowp + bj * 128) = w; } }
        if (colt >= tcol0) {
#pragma unroll
            for (int bj = 0; bj < 2; ++bj)
#pragma unroll
                for (int n = 0; n < 2; ++n)
#pragma unroll
                    for (int i = 0; i < 4; ++i) { unsigned short* tp = T + (size_t)(col0 - tcol0 + bj * 128 + 4 * n + i) * ldt + row0;
#pragma unroll
                        for (int ai = 0; ai < 2; ++ai)
#pragma unroll
                            for (int m = 0; m < 4; ++m) tp[ai * 128 + m * 16] = (unsigned short)mk::f2bf(acc[ai][bj][m][n][i]); }
        }
    }
};

struct GemmDesc { const unsigned short* A; const unsigned short* Bt; int Mg, Ng, Kg; int kind; unsigned short* O; int ldc; int split_cols; float scale0; const float* base; float* out; int G, c; };

#ifndef REPEAT_PH
#define REPEAT_PH 1000
#define N_REPEAT 0
#else
#define N_REPEAT 1
#endif
struct Params { const float* in[17]; float* out; unsigned char* ws; int ph_lo, ph_hi; };
constexpr int N_PHASES = 18;

__global__ void __launch_bounds__(512, 2) fwd_mega(Params p) {
    extern __shared__ __attribute__((aligned(16))) unsigned char lds_raw[];
    using namespace mk;
    cg::grid_group grid = cg::this_grid();
    LAS unsigned char* lds = (LAS unsigned char*)lds_raw;
    const int bid = blockIdx.x, nblk = gridDim.x;
    const int ph_lo = p.ph_lo, ph_hi = p.ph_hi;
    { volatile LAS unsigned* misc = (volatile LAS unsigned*)(lds + LDS_MISC); if (mk_tid() < 16) misc[mk_tid()] = 0u; }
    __syncthreads();
    (void)xcd_barrier_post((unsigned*)(p.ws + WS_BAR), (volatile LAS unsigned*)(lds + LDS_MISC) + 8);
    if (ph_lo < 0) grid.sync();
#ifdef PROBE_PH
    const unsigned long long t_start = __builtin_amdgcn_s_memrealtime();
#endif
#pragma unroll 1
    for (int ph_it = ph_lo; ph_it < ph_hi + N_REPEAT; ++ph_it) {
        const int ph = ph_it <= REPEAT_PH ? ph_it : ph_it - N_REPEAT;
        typedef const __attribute__((address_space(4))) Params* KP;
        KP kp = (KP)__builtin_amdgcn_kernarg_segment_ptr(); asm volatile("" : "+s"(kp));
        unsigned char* ws = kp->ws; float* OUT = kp->out; bf16* XN = (bf16*)(ws + WS_XN);
        In I; I.x = kp->in[0]; I.norm_mix = kp->in[1]; I.norm_ffn = kp->in[2]; I.w_in_ab = kp->in[3]; I.pool_w = kp->in[4]; I.pool_scale = kp->in[5]; I.q_norm = kp->in[6]; I.k_norm = kp->in[7];
        I.w_out_ab = kp->in[8]; I.w_in_c = kp->in[9]; I.b_gate = kp->in[10]; I.h_norm = kp->in[11]; I.w_out_c = kp->in[12]; I.w_up = kp->in[13]; I.conv_w = kp->in[14]; I.conv_b = kp->in[15]; I.w_down = kp->in[16];
        int nb_ = nblk; asm volatile("" : "+s"(nb_)); const int ngw = nb_ * NW, ngt = nb_ * 512;
        const int tid = mk_tid(), lane = tid & 63, wave = __builtin_amdgcn_readfirstlane(tid >> 6), gw = bid * NW + wave, gt = bid * 512 + tid;
#ifndef NO_THIN
        if (ph == 0) prologue(I, ws, lds, gw, ngw, wave, lane);
        if (ph == 5 || ph == 9 || ph == 14) rmsnorm_rows(OUT, ph == 5 ? I.norm_ffn : (ph == 9 ? I.norm_mix + D : I.norm_ffn + D), XN, gw, ngw, lane);
        if (ph == 2) qk_rope_pool((bf16*)(ws + WS_PROJ), I.q_norm, I.k_norm, (bf16*)(ws + WS_POOLED), gw, ngw, lane);
#endif
#ifndef NO_ATT
        if (ph == 3) {
            const bf16* PROJ = (const bf16*)(ws + WS_PROJ); bf16* CAT = (bf16*)(ws + WS_CAT);
            for (int u0 = bid; u0 < 384; u0 += nblk) {
                int u = u0;
                if (nblk == 256) { const int xcd = u0 & 7, j = (u0 >> 3) & 31, rnd = u0 >> 8; const int jj = j + 32 * rnd;
                    if (jj >= 48) continue; u = (xcd >> 2) * 192 + ((xcd & 3) * 3 + (jj >> 4)) * 16 + (jj & 15); }
                const int qb = u & 15, hq = (u >> 4) % 12, b = u / 192;
                const size_t r0 = (size_t)b * SEQ + (size_t)qb * 256;
                att::attn_dense_body<att::bf16>((const att::bf16*)(PROJ + r0 * ABW + 512 + hq * 128), (const att::bf16*)(PROJ + (size_t)b * SEQ * ABW + 2048 + (hq / 3) * 128),
                                                (const att::bf16*)(PROJ + (size_t)b * SEQ * ABW + 2560 + (hq / 3) * 128), CAT + r0 * D + 512 + hq * 128, SEQ, (char*)lds_raw);
                __syncthreads();
            }
        }
#endif
#ifndef NO_THIN
        if (ph == 7 || ph == 16) { const int l = ph == 7 ? 0 : 1; conv_fix((const bf16*)(ws + WS_U), I.conv_w + (size_t)l * 3 * FF2, I.conv_b + (size_t)l * FF2, (bf16*)(ws + WS_ACT), gt, ngt); }
        if (ph == 10) gates_phase(XN, (const bf16*)(ws + WS_C) + (size_t)8192 * D, I.b_gate, (float*)(ws + WS_GATES), (LAS float*)lds, bid, nblk);
#endif
#ifndef NO_ML
        if (ph == 11) ml::mlstm_phase(lds, (const bf16*)(ws + WS_QK), (const bf16*)(ws + WS_KVT), (const float*)(ws + WS_GATES), (bf16*)(ws + WS_HF), bid, nblk);
#endif
#ifndef NO_THIN
        if (ph == 12) headnorm_phase((const bf16*)(ws + WS_HF), (const bf16*)(ws + WS_OG), I.h_norm, (bf16*)(ws + WS_Y), gw, ngw, lane);
#endif
#pragma unroll 1
        for (int gi = 0; gi < 3; ++gi) {
            GemmDesc d; d.kind = -1; d.G = nblk; d.c = bid; d.split_cols = 0; d.scale0 = 1.f; d.base = nullptr; d.out = nullptr; d.O = nullptr; d.ldc = 0; d.A = nullptr; d.Bt = nullptr; d.Mg = M; d.Ng = 0; d.Kg = D;
            if (gi == 0) {
                if (ph == 1) { d.kind = 0; d.A = XN; d.Bt = (bf16*)(ws + WS_AB); d.Ng = ABW; d.O = (bf16*)(ws + WS_PROJ); d.ldc = ABW; }
                else if (ph == 3) { d.kind = 0; d.A = (bf16*)(ws + WS_POOLED); d.Bt = (bf16*)(ws + WS_BD); d.Ng = 512; d.Kg = 512; d.O = (bf16*)(ws + WS_CAT); d.ldc = D;
                    if (nblk == 256) { const int slot = bid >> 3; d.G = 64; d.c = (slot - 16) * 8 + (bid & 7); if (slot < 16 || slot >= 24) d.kind = -1; } }
                else if (ph == 4) { d.kind = 1; d.A = (bf16*)(ws + WS_CAT); d.Bt = (bf16*)(ws + WS_OAB); d.Ng = D; d.base = I.x; d.out = OUT; }
                else if (ph == 6 || ph == 15) { d.kind = 2; d.A = XN; d.Bt = (bf16*)(ws + (ph == 6 ? WS_UP0 : WS_UP1)); d.Ng = FF2; d.O = (bf16*)(ws + WS_U); d.ldc = FF2; d.base = I.conv_w + (size_t)(ph == 6 ? 0 : 1) * 3 * FF2; d.out = (float*)(I.conv_b + (size_t)(ph == 6 ? 0 : 1) * FF2); }
                else if (ph == 8 || ph == 17) { d.kind = 1; d.A = (bf16*)(ws + WS_ACT); d.Bt = (bf16*)(ws + (ph == 8 ? WS_DN0 : WS_DN1)); d.Ng = D; d.Kg = FF; d.base = OUT; d.out = OUT; }
                else if (ph == 10) { d.kind = 3; d.A = XN; d.Bt = (bf16*)(ws + WS_C); d.Ng = 4096; d.O = (bf16*)(ws + WS_QK); d.ldc = 4096; d.split_cols = 2048; d.scale0 = 0.0625f; }
                else if (ph == 13) { d.kind = 1; d.A = (bf16*)(ws + WS_Y); d.Bt = (bf16*)(ws + WS_OC); d.Ng = D; d.base = OUT; d.out = OUT; }
            } else if (ph == 10) {
                if (gi == 1) { d.kind = 0; d.A = XN; d.Bt = (bf16*)(ws + WS_C) + (size_t)6144 * D; d.Ng = D; d.O = (bf16*)(ws + WS_OG); d.ldc = D; }
                else { d.kind = 0; d.A = (bf16*)(ws + WS_C) + (size_t)4096 * D; d.Bt = XN; d.Mg = 2048; d.Ng = M; d.O = (bf16*)(ws + WS_KVT) + (size_t)2048 * M; d.ldc = M; }
            }
#ifndef NO_GEMM
            if (d.kind == 0) {
                pg8::Gemm g{d.A, d.Bt, d.Mg, d.Ng, d.Kg}; pg8::StaticOrder S; S.init(d.Mg, d.Ng, d.G, d.c);
                pg8::EpiBf16<0> E{d.O, d.ldc, nullptr, d.split_cols, (size_t)d.split_cols, d.scale0};
                pg8::gemm_phase<pg8::EpiBf16<0>, pg8::StaticOrder, true, true>(lds, g, S, E);
            } else if (d.kind == 3) {
                pg8::Gemm g{d.A, d.Bt, d.Mg, d.Ng, d.Kg}; pg8::StaticOrder S; S.init(d.Mg, d.Ng, d.G, d.c);
                EpiBf16T E{d.O, d.ldc, d.split_cols, d.scale0, (bf16*)(ws + WS_KVT), 2048, M};
                pg8::gemm_phase<EpiBf16T, pg8::StaticOrder, true, true>(lds, g, S, E);
            } else if (d.kind == 2) {
                pg8::Gemm g{d.A, d.Bt, d.Mg, d.Ng, d.Kg}; pg8::StaticOrder S; S.init(d.Mg, d.Ng, d.G, d.c);
                EpiConv E{(bf16*)(ws + WS_ACT), d.O, d.base, (const float*)d.out};
                pg8::gemm_phase<EpiConv, pg8::StaticOrder, true, true>(lds, g, S, E);
            } else if (d.kind == 1) {
                pg8::Gemm g{d.A, d.Bt, d.Mg, d.Ng, d.Kg}; pg8::StaticOrder S; S.init(d.Mg, d.Ng, d.G, d.c);
                EpiRes E{d.base, d.out, D};
                pg8::gemm_phase<EpiRes, pg8::StaticOrder, true, true>(lds, g, S, E);
            }
#endif
            __syncthreads();
        }
#ifndef NO_THIN
        if (nb_ == 256) {
            if (ph == 1 && bid >= 128) { const int w = (bid - 128) * NW + wave; transposes(I, ws, lds, 1536, 2560, w, 128 * NW, wave, lane); transposes(I, ws, lds, 18944, 24576, w, 128 * NW, wave, lane); }
            if (ph == 3 && (bid >> 3) >= 16) { const int w = (((bid >> 3) - 16) * 8 + (bid & 7)) * NW + wave; transposes(I, ws, lds, 2560, 13312, w, 128 * NW, wave, lane); }
            if (ph == 6 && bid >= 128) { const int w = (bid - 128) * NW + wave; transposes(I, ws, lds, 13312, 18944, w, 128 * NW, wave, lane); }
        } else if (ph == 1) transposes(I, ws, lds, 1536, 24576, gw, ngw, wave, lane);
#endif
        if (ph_it + 1 < ph_hi + N_REPEAT) { XcdBarrier xbar; xbar.bar = (unsigned*)(ws + WS_BAR); xbar.x = xb_xcc_id(); xbar.st = (volatile LAS unsigned*)(lds + LDS_MISC) + 8; xcd_barrier(xbar);
#ifdef SYNC2
            xcd_barrier(xbar);
#endif
        }
#ifdef PROBE_PH
        if (bid == 0 && tid == 0) { unsigned long long* ts = (unsigned long long*)(ws + WS_BD + 768 * 1024); ts[ph + 1] = __builtin_amdgcn_s_memrealtime(); if (ph == 0) ts[0] = t_start;
            if (ph + 1 == ph_hi) { OUT[0] = (float)(ts[PROBE_PH + 1] - ts[PROBE_PH]) * 0.01f; } }
#endif
    }
}

#ifndef MK_MULTI
#define MK_MULTI 0
#endif
extern "C" void kernel_launch(void* const* d_in, const int* in_sizes, int n_in, void* d_out, int out_size, void* d_ws, size_t ws_size, hipStream_t stream) {
    static int grid = 0;
    if (grid == 0) {
        if (n_in != 17 || out_size != mk::M * mk::D || ws_size < mk::WS_END) { fprintf(stderr, "kernel_launch: unexpected shapes n_in %d out %d ws %zu (need %zu)\n", n_in, out_size, ws_size, (size_t)mk::WS_END); grid = -1; return; }
        int dev = 0, cus = 0, per_cu = 0;
        (void)hipGetDevice(&dev); (void)hipDeviceGetAttribute(&cus, hipDeviceAttributeMultiprocessorCount, dev);
        if (hipFuncSetAttribute((const void*)fwd_mega, hipFuncAttributeMaxDynamicSharedMemorySize, mk::LDS_BYTES) != hipSuccess) { fprintf(stderr, "kernel_launch: hipFuncSetAttribute failed\n"); grid = -1; return; }
        if (hipOccupancyMaxActiveBlocksPerMultiprocessor(&per_cu, (const void*)fwd_mega, 512, mk::LDS_BYTES) != hipSuccess || per_cu < 1) { fprintf(stderr, "kernel_launch: occupancy query gave %d\n", per_cu); per_cu = 1; }
        (void)hipGetLastError();
        if (cus <= 0) cus = 256;
        grid = cus * per_cu; if (grid > 256) grid = 256;
        fprintf(stderr, "kernel_launch: cus %d per_cu %d grid %d\n", cus, per_cu, grid);
    }
    if (grid < 0) return;
    if (hipMemsetAsync((char*)d_ws + mk::WS_BAR, 0, mk::BAR_BYTES, stream) != hipSuccess) { fprintf(stderr, "kernel_launch: memset failed\n"); return; }
    Params p{};
    for (int i = 0; i < 17; ++i) p.in[i] = (const float*)d_in[i];
    p.out = (float*)d_out; p.ws = (unsigned char*)d_ws;
#if MK_MULTI
    for (int ph = 0; ph < N_PHASES; ++ph) { p.ph_lo = ph; p.ph_hi = ph + 1; hipLaunchKernelGGL(fwd_mega, dim3(grid), dim3(512), mk::LDS_BYTES, stream, p); }
#else
    p.ph_lo = 0; p.ph_hi = N_PHASES;
    void* args[] = {&p};
    const hipError_t e = hipLaunchCooperativeKernel((const void*)fwd_mega, dim3(grid), dim3(512), args, mk::LDS_BYTES, stream);
    if (e != hipSuccess) fprintf(stderr, "kernel_launch: cooperative launch failed: %s (grid %d)\n", hipGetErrorString(e), grid);
#endif
}
```

```cpp
#include <hip/hip_runtime.h>
#include <hip/hip_cooperative_groups.h>
#include <hip/hip_bf16.h>
#include <cstdio>
#include <cstdint>
#include <cmath>
namespace cg = cooperative_groups;
__device__ __forceinline__ int mk_tid();
namespace pg8 {
#define PG8_LAS __attribute__((address_space(3)))
typedef unsigned short bf16_t;
typedef short bf16x8 __attribute__((ext_vector_type(8)));
typedef float f32x4 __attribute__((ext_vector_type(4)));
typedef unsigned u32x4 __attribute__((ext_vector_type(4)));
constexpr int BM = 256, BK = 64, HALF = 128, HTB = HALF * BK * 2  , STAGE_BYTES = 8 * HTB, NXCD = 8, WGM = 8;

__host__ __device__ __forceinline__ int lds_byte(int r, int c) { const int st = (r >> 4) * 2 + (c >> 5), rr = r & 15, cc = c & 31, ob = rr * 64 + cc * 2; return st * 1024 + (ob ^ (((ob >> 9) & 1) << 5)); }
__host__ __device__ __forceinline__ void stage_rc(int b, int& R, int& C) { const int st = b / 1024, sb = b % 1024, swz = sb ^ (((sb >> 9) & 1) << 5); R = (st >> 1) * 16 + swz / 64; C = (st & 1) * 32 + (swz % 64) / 2; }
__host__ __device__ __forceinline__ int perm32(int rho) { const int n = rho >> 4, i = rho & 15; return 8 * (i >> 2) + 4 * n + (i & 3); }

struct Unit { int pm, pn; };
struct Gemm { const bf16_t* A; const bf16_t* Bt; int M, N, K; };

struct StaticOrder {
    int nM, nN, nwg, G, c;
    __host__ __device__ void init(int M, int N, int G_, int c_) { nM = M / BM; nN = N / BM; nwg = nM * nN; G = G_; c = c_; }
    __host__ __device__ bool next(int i, Unit& u) const {
        const long L = (long)i * G + c; if (L >= nwg) return false;
        int wgid = (int)L; { const int q = nwg / NXCD, r = nwg % NXCD, xcd = wgid % NXCD, off = wgid / NXCD; wgid = (xcd < r ? xcd * (q + 1) : r * (q + 1) + (xcd - r) * q) + off; }
        const int nig = WGM * nN, gid = wgid / nig, fm = gid * WGM, gsz = (nM - fm) < WGM ? (nM - fm) : WGM;
        u.pm = fm + ((wgid % nig) % gsz); u.pn = (wgid % nig) / gsz; return true;
    }
    __device__ __forceinline__ void a_ready(const Unit&) const {}
    __device__ __forceinline__ void done(const Unit&) const {}
};

__device__ __forceinline__ unsigned cvt_pk_bf16(float lo, float hi) { unsigned r; asm volatile("v_cvt_pk_bf16_f32 %0, %1, %2" : "=v"(r) : "v"(lo), "v"(hi)); return r; }
typedef float f32x2 __attribute__((ext_vector_type(2)));
__device__ __forceinline__ f32x2 gelu_pk(f32x2 v) {
    const f32x2 av = __builtin_elementwise_abs(v), d = av * 0.2316418882f + 1.0f;
    f32x2 t; t.x = __builtin_amdgcn_rcpf(d.x); t.y = __builtin_amdgcn_rcpf(d.y);
    f32x2 q = t * 0.5307027145f + (-0.7265760135f); q = q * t + 0.7107068705f; q = q * t + (-0.142248368f); q = q * t + 0.127414796f; q = q * t;
    const f32x2 s = (v * v) * (-0.72134752044f);
    f32x2 e; e.x = __builtin_amdgcn_exp2f(s.x); e.y = __builtin_amdgcn_exp2f(s.y);
    const f32x2 m = v * (q * e), r = v - m;
    f32x2 o; o.x = v.x < 0.f ? m.x : r.x; o.y = v.y < 0.f ? m.y : r.y; return o;
}

template <int ACT  > struct EpiBf16 {
    static constexpr bool PERM = true, AFTER_DRAIN = false; static_assert(ACT == 0 || ACT == 1, "EpiBf16: ACT is 0 (none) or 1 (gelu_pk)");
    bf16_t* O; int ldc; const float* bias; int split_cols; size_t split_stride; float scale0;
    __device__ __forceinline__ void operator()(const f32x4 (&acc)[2][2][4][2], const Unit& u, int wr, int wc, int fr, int fq) const {
        const int row0 = u.pm * BM + wr * 64 + fr; int colt = u.pn * BM; bf16_t* base = O;
        float sc = 1.f; if (split_cols) { const int t = colt / split_cols; base += (size_t)t * split_stride; colt -= t * split_cols; if (t == 0) sc = scale0; }
        const int col0 = colt + wc * 32 + 8 * fq, bcol0 = u.pn * BM + wc * 32 + 8 * fq;
        f32x4 bv[2][2];
#pragma unroll
        for (int bj = 0; bj < 2; ++bj)
#pragma unroll
            for (int n = 0; n < 2; ++n) bv[bj][n] = bias ? *(const f32x4*)(bias + bcol0 + bj * HALF + 4 * n) : (f32x4){0.f, 0.f, 0.f, 0.f};
#pragma unroll
        for (int ai = 0; ai < 2; ++ai)
#pragma unroll
            for (int m = 0; m < 4; ++m) { bf16_t* rowp = base + (size_t)(row0 + ai * HALF + m * 16) * ldc + col0;
#pragma unroll
                for (int bj = 0; bj < 2; ++bj) { f32x4 v0 = acc[ai][bj][m][0] + bv[bj][0], v1 = acc[ai][bj][m][1] + bv[bj][1];
                    if (ACT == 1) { f32x2 a = gelu_pk((f32x2){v0[0], v0[1]}), b = gelu_pk((f32x2){v0[2], v0[3]}), c = gelu_pk((f32x2){v1[0], v1[1]}), d = gelu_pk((f32x2){v1[2], v1[3]});
                        v0 = (f32x4){a.x, a.y, b.x, b.y}; v1 = (f32x4){c.x, c.y, d.x, d.y}; }
                    v0 = v0 * sc; v1 = v1 * sc; u32x4 w; w.x = cvt_pk_bf16(v0[0], v0[1]); w.y = cvt_pk_bf16(v0[2], v0[3]); w.z = cvt_pk_bf16(v1[0], v1[1]); w.w = cvt_pk_bf16(v1[2], v1[3]);
                    *(u32x4*)(rowp + bj * HALF) = w; } }
    }
};

template <class Epi, class Sched, bool ALIGN_EPI = false, bool SP2 = false>
__device__ __forceinline__ void gemm_phase(PG8_LAS unsigned char* lds, const Gemm g, const Sched& S, const Epi& E) {
    const int tid = mk_tid(), wid = __builtin_amdgcn_readfirstlane(tid >> 6), lane = tid & 63, wr = wid >> 2, wc = wid & 3, fr = lane & 15, fq = lane >> 4;
    const int K = g.K, nt = K / BK;
    unsigned voffA[2], voffB[2];
#pragma unroll
    for (int i = 0; i < 2; ++i) { int R, C; stage_rc(tid * 16 + i * 8192, R, C); const int Rb = Epi::PERM ? ((R & ~31) + perm32(R & 31)) : R;
        voffA[i] = (unsigned)(R * K + C) * 2u; voffB[i] = (unsigned)(Rb * K + C) * 2u; }
    const size_t kstep = (size_t)(BK * 2);
    const size_t hstep = (size_t)HALF * K * 2;
    const size_t tstep = 2 * hstep;
    const unsigned ldsw = (unsigned)wid * 1024u;
    const int aoff = lds_byte(wr * 64 + fr, fq * 8), boff = lds_byte(wc * 32 + fr, fq * 8);
#define PG8_SA(b, h) (((b) * 2 + (h)) * HTB)
#define PG8_SB(b, h) ((4 + (b) * 2 + (h)) * HTB)
#define PG8_STAGE(bufoff, gbase, voff) do { _Pragma("unroll") for (int _i = 0; _i < 2; ++_i) \
        __builtin_amdgcn_global_load_lds((const unsigned*)((const char*)(gbase) + (voff)[_i]), (PG8_LAS unsigned*)(lds + (bufoff) + ldsw + _i * 8192), 16, 0, 0); } while (0)
#define PG8_LDA(dst, b, h) do { _Pragma("unroll") for (int m = 0; m < 4; ++m) _Pragma("unroll") for (int k = 0; k < 2; ++k) dst[m][k] = *(const PG8_LAS bf16x8*)(lds + PG8_SA(b, h) + aoff + m * 2048 + k * 1024); } while (0)
#define PG8_LDB(dst, b, h) do { _Pragma("unroll") for (int n = 0; n < 2; ++n) _Pragma("unroll") for (int k = 0; k < 2; ++k) dst[n][k] = *(const PG8_LAS bf16x8*)(lds + PG8_SB(b, h) + boff + n * 2048 + k * 1024); } while (0)
#define PG8_MMA(ai, bj, At, Bt) do { __builtin_amdgcn_s_setprio(1); _Pragma("unroll") for (int m = 0; m < 4; ++m) _Pragma("unroll") for (int n = 0; n < 2; ++n) _Pragma("unroll") for (int k = 0; k < 2; ++k) \
        acc[ai][bj][m][n] = __builtin_amdgcn_mfma_f32_16x16x32_bf16(Bt[n][k], At[m][k], acc[ai][bj][m][n], 0, 0, 0); __builtin_amdgcn_s_setprio(0); } while (0)
#define PG8_WAIT_V(n) asm volatile("s_waitcnt vmcnt(" #n ")" ::: "memory")
#define PG8_WAIT_L(n) asm volatile("s_waitcnt lgkmcnt(" #n ")" ::: "memory")
#define PG8_BAR __builtin_amdgcn_s_barrier()
#define PG8_SCHED __builtin_amdgcn_sched_barrier(0)
    Unit cur, nxt; int ui = 0;
    if (!S.next(0, cur)) return;
    f32x4 acc[2][2][4][2];
#pragma unroll
    for (int a = 0; a < 2; ++a)
#pragma unroll
        for (int b = 0; b < 2; ++b)
#pragma unroll
            for (int m = 0; m < 4; ++m)
#pragma unroll
                for (int n = 0; n < 2; ++n) acc[a][b][m][n] = (f32x4){0.f, 0.f, 0.f, 0.f};
    bf16x8 At[4][2], B0[2][2], B1[2][2];
    const char* cA = (const char*)g.A + (size_t)cur.pm * tstep; const char* cB = (const char*)g.Bt + (size_t)cur.pn * tstep;
    S.a_ready(cur);
    if constexpr (SP2) {
        PG8_STAGE(PG8_SB(0, 0), cB, voffB); PG8_STAGE(PG8_SB(0, 1), cB + hstep, voffB); PG8_STAGE(PG8_SA(0, 0), cA, voffA); PG8_STAGE(PG8_SA(0, 1), cA + hstep, voffA);
        if (wr == 1) PG8_BAR;
        PG8_WAIT_V(2); PG8_BAR;
        PG8_STAGE(PG8_SB(1, 0), cB + kstep, voffB); PG8_STAGE(PG8_SA(1, 0), cA + kstep, voffA); PG8_STAGE(PG8_SB(1, 1), cB + hstep + kstep, voffB);
        PG8_WAIT_V(6); PG8_BAR;
    } else {
        PG8_STAGE(PG8_SB(0, 0), cB, voffB); PG8_STAGE(PG8_SA(0, 0), cA, voffA); PG8_STAGE(PG8_SB(0, 1), cB + hstep, voffB); PG8_STAGE(PG8_SA(0, 1), cA + hstep, voffA);
        if (wr == 1) PG8_BAR;
        PG8_WAIT_V(4); PG8_BAR;
        PG8_STAGE(PG8_SB(1, 0), cB + kstep, voffB); PG8_STAGE(PG8_SA(1, 0), cA + kstep, voffA); PG8_STAGE(PG8_SB(1, 1), cB + hstep + kstep, voffB);
        PG8_WAIT_V(6); PG8_BAR;
    }
    for (;;) {
        const bool has_next = S.next(ui + 1, nxt);
        const char* nA = has_next ? (const char*)g.A + (size_t)nxt.pm * tstep : cA; const char* nB = has_next ? (const char*)g.Bt + (size_t)nxt.pn * tstep : cB;
        for (int t = 0; t < nt; t += 2) {
            const bool last = (t == nt - 2);
            const char* a1 = cA + (size_t)(t + 1) * kstep;
            const char* a2 = last ? nA : cA + (size_t)(t + 2) * kstep; const char* b2 = last ? nB : cB + (size_t)(t + 2) * kstep;
            const char* a3 = a2 + kstep; const char* b3 = b2 + kstep;
            if (last && has_next) S.a_ready(nxt);
            if constexpr (SP2) {
            PG8_LDB(B0, 0, 0); PG8_LDB(B1, 0, 1); PG8_SCHED; PG8_LDA(At, 0, 0); PG8_STAGE(PG8_SA(1, 1), a1 + hstep, voffA);
            PG8_WAIT_V(8); PG8_WAIT_L(0); PG8_BAR; PG8_MMA(0, 0, At, B0); PG8_MMA(0, 1, At, B1); PG8_BAR; PG8_SCHED;
            PG8_LDA(At, 0, 1); PG8_STAGE(PG8_SB(0, 0), b2, voffB); PG8_STAGE(PG8_SB(0, 1), b2 + hstep, voffB); PG8_STAGE(PG8_SA(0, 0), a2, voffA);
            PG8_WAIT_V(8); PG8_WAIT_L(0); PG8_BAR; PG8_MMA(1, 0, At, B0); PG8_MMA(1, 1, At, B1); PG8_BAR; PG8_SCHED;
            PG8_LDB(B0, 1, 0); PG8_LDB(B1, 1, 1); PG8_SCHED; PG8_LDA(At, 1, 0); PG8_STAGE(PG8_SA(0, 1), a2 + hstep, voffA);
            PG8_WAIT_V(8); PG8_WAIT_L(0); PG8_BAR; PG8_MMA(0, 0, At, B0); PG8_MMA(0, 1, At, B1); PG8_BAR; PG8_SCHED;
            PG8_LDA(At, 1, 1); PG8_STAGE(PG8_SB(1, 0), b3, voffB); PG8_STAGE(PG8_SB(1, 1), b3 + hstep, voffB); PG8_STAGE(PG8_SA(1, 0), a3, voffA);
            PG8_WAIT_V(8); PG8_WAIT_L(0); PG8_BAR; PG8_MMA(1, 0, At, B0); PG8_MMA(1, 1, At, B1); PG8_BAR; PG8_SCHED;
            } else {
            PG8_LDB(B0, 0, 0); PG8_SCHED; PG8_LDA(At, 0, 0); PG8_STAGE(PG8_SA(1, 1), a1 + hstep, voffA);
            PG8_WAIT_L(8); PG8_BAR; PG8_WAIT_L(0); PG8_MMA(0, 0, At, B0); PG8_BAR; PG8_SCHED;
            PG8_LDB(B1, 0, 1); PG8_STAGE(PG8_SB(0, 0), b2, voffB);
            PG8_BAR; PG8_WAIT_L(0); PG8_MMA(0, 1, At, B1); PG8_BAR;
            PG8_LDA(At, 0, 1); PG8_STAGE(PG8_SA(0, 0), a2, voffA);
            PG8_BAR; PG8_WAIT_L(0); PG8_MMA(1, 0, At, B0); PG8_BAR; PG8_SCHED;
            PG8_STAGE(PG8_SB(0, 1), b2 + hstep, voffB);
            PG8_WAIT_V(6); PG8_BAR; PG8_MMA(1, 1, At, B1); PG8_BAR;
            PG8_LDB(B0, 1, 0); PG8_SCHED; PG8_LDA(At, 1, 0); PG8_STAGE(PG8_SA(0, 1), a2 + hstep, voffA);
            PG8_WAIT_L(8); PG8_BAR; PG8_WAIT_L(0); PG8_MMA(0, 0, At, B0); PG8_BAR; PG8_SCHED;
            PG8_LDB(B1, 1, 1); PG8_STAGE(PG8_SB(1, 0), b3, voffB);
            PG8_BAR; PG8_WAIT_L(0); PG8_MMA(0, 1, At, B1); PG8_BAR;
            PG8_LDA(At, 1, 1); PG8_STAGE(PG8_SA(1, 0), a3, voffA);
            PG8_BAR; PG8_WAIT_L(0); PG8_MMA(1, 0, At, B0); PG8_BAR; PG8_SCHED;
            PG8_STAGE(PG8_SB(1, 1), b3 + hstep, voffB);
            PG8_WAIT_V(6); PG8_BAR; PG8_MMA(1, 1, At, B1); PG8_BAR;
            }
        }
        if constexpr (ALIGN_EPI) { if (wr == 0) PG8_BAR; }
        if constexpr (!Epi::AFTER_DRAIN) { E(acc, cur, wr, wc, fr, fq); S.done(cur); }
        if (!has_next) break;
#pragma unroll
        for (int a = 0; a < 2; ++a)
#pragma unroll
            for (int b = 0; b < 2; ++b)
#pragma unroll
                for (int m = 0; m < 4; ++m)
#pragma unroll
                    for (int n = 0; n < 2; ++n) acc[a][b][m][n] = (f32x4){0.f, 0.f, 0.f, 0.f};
        cur = nxt; cA = nA; cB = nB; ++ui;
        if constexpr (ALIGN_EPI) { if (wr == 1) PG8_BAR; }
    }
    PG8_WAIT_V(0);
    if constexpr (!ALIGN_EPI) { if (wr == 0) PG8_BAR; }
    PG8_BAR;
    if constexpr (Epi::AFTER_DRAIN) { E.fused(acc, cur, wr, wc, fr, fq, lds, wid, lane); S.done(cur); }
#undef PG8_SA
#undef PG8_SB
#undef PG8_STAGE
#undef PG8_LDA
#undef PG8_LDB
#undef PG8_MMA
#undef PG8_WAIT_V
#undef PG8_WAIT_L
#undef PG8_BAR
#undef PG8_SCHED
}
}

namespace att {
using bf16 = __hip_bfloat16;
constexpr int   D = 128, NW = 8, QBLK = 32, KVBLK = 64;
constexpr float SCALE = 0.088388347648318440f;
constexpr float THR = 8.f;
constexpr int SDEPTH = 2;
constexpr int LDQ = 3072, LDK = 3072, LDO = 2048;
constexpr size_t SHM_V = KVBLK * D * 2, SHM_K = KVBLK * D * 2, SHM_ATTN = 2 * SHM_V + 2 * SHM_K + NW * 64 * 4;
using bf16x8 = __attribute__((ext_vector_type(8))) short;
using s16x4  = __attribute__((ext_vector_type(4))) short;
using f32x16 = __attribute__((ext_vector_type(16))) float;
using f32x8  = __attribute__((ext_vector_type(8))) float;
using u32x4  = __attribute__((ext_vector_type(4))) unsigned;
#define KSWZ(row, colB) ((row) * 256 + ((colB) ^ (((row) & 7) << 4)))
#define SBAR() __builtin_amdgcn_sched_barrier(0)
__device__ __forceinline__ int crow(int r, int hi) { return (r & 3) + 8 * (r >> 2) + 4 * hi; }
__device__ __forceinline__ unsigned cvtpk(float lo, float hi) {
  unsigned r; asm volatile("v_cvt_pk_bf16_f32 %0, %1, %2" : "=v"(r) : "v"(lo), "v"(hi)); return r;
}
template <typename TIn> struct Stage;
template <> struct Stage<bf16>  { using T = bf16x8;
  __device__ static __forceinline__ T ld8(const bf16* p) { return *reinterpret_cast<const bf16x8*>(p); }
  __device__ static __forceinline__ bf16x8 tobf(T x) { return x; } };
template <> struct Stage<float> { using T = f32x8;
  __device__ static __forceinline__ T ld8(const float* p) { return *reinterpret_cast<const f32x8*>(p); }
  __device__ static __forceinline__ bf16x8 tobf(T x) {
    u32x4 w = {cvtpk(x[0], x[1]), cvtpk(x[2], x[3]), cvtpk(x[4], x[5]), cvtpk(x[6], x[7])}; return *reinterpret_cast<bf16x8*>(&w); } };

__device__ __forceinline__ void partialSM(f32x16& p0, f32x16& p1, float& m_reg, float& mn, float& alpha) {
  constexpr float C = SCALE * 1.4426950408889634f;
  float pmax = p0[0]; for (int r = 1; r < 16; ++r) pmax = fmaxf(pmax, p0[r]); for (int r = 0; r < 16; ++r) pmax = fmaxf(pmax, p1[r]);
  { auto rr = __builtin_amdgcn_permlane32_swap(__float_as_uint(pmax), __float_as_uint(pmax), false, false);
    pmax = fmaxf(__uint_as_float(rr[0]), __uint_as_float(rr[1])); }
  if (__builtin_expect(__all(pmax - m_reg <= THR / SCALE), 1)) { mn = m_reg; alpha = 1.f; }
  else { mn = fmaxf(m_reg, pmax); alpha = __builtin_amdgcn_exp2f((m_reg - mn) * C); m_reg = mn; }
  float mnC = -mn * C;
  for (int r = 0; r < 16; ++r) p0[r] = fmaf(p0[r], C, mnC); for (int r = 0; r < 16; ++r) p1[r] = fmaf(p1[r], C, mnC);
  for (int r = 0; r < 16; ++r) p0[r] = __builtin_amdgcn_exp2f(p0[r]);
}
__device__ __forceinline__ void finishSM(f32x16& p0, f32x16& p1, float alpha, float& l_reg, bf16x8& pa0, bf16x8& pa1, bf16x8& pa2, bf16x8& pa3) {
  for (int r = 0; r < 16; ++r) p1[r] = __builtin_amdgcn_exp2f(p1[r]);
  float ps = 0; for (int r = 0; r < 16; ++r) ps += p0[r]; for (int r = 0; r < 16; ++r) ps += p1[r];
  { auto rr = __builtin_amdgcn_permlane32_swap(__float_as_uint(ps), __float_as_uint(ps), false, false);
    ps = __uint_as_float(rr[0]) + __uint_as_float(rr[1]); }
  l_reg = l_reg * alpha + ps;
#define PK4(P, BASE, OUT) do { unsigned a0 = cvtpk(P[BASE + 0], P[BASE + 1]), a1 = cvtpk(P[BASE + 2], P[BASE + 3]);   \
    unsigned b0 = cvtpk(P[BASE + 4], P[BASE + 5]), b1 = cvtpk(P[BASE + 6], P[BASE + 7]);                              \
    auto r0 = __builtin_amdgcn_permlane32_swap(a0, b0, false, false); auto r1 = __builtin_amdgcn_permlane32_swap(a1, b1, false, false); \
    u32x4 w = {r0[0], r1[0], r0[1], r1[1]}; OUT = *reinterpret_cast<bf16x8*>(&w); } while (0)
  PK4(p0, 0, pa0); PK4(p0, 8, pa1); PK4(p1, 0, pa2); PK4(p1, 8, pa3);
#undef PK4
}
__device__ __forceinline__ void qkt(f32x16& p0, f32x16& p1, const bf16* Ks, const bf16x8* qr, int r32, int hi) {
  p0 = f32x16{}; p1 = f32x16{};
  for (int d0 = 0; d0 < 8; ++d0) { int cb = (d0 * 16 + hi * 8) * 2;
    bf16x8 b0 = *reinterpret_cast<const bf16x8*>((const char*)Ks + KSWZ(r32, cb));
    bf16x8 b1 = *reinterpret_cast<const bf16x8*>((const char*)Ks + KSWZ(32 + r32, cb));
    p0 = __builtin_amdgcn_mfma_f32_32x32x16_bf16(b0, qr[d0], p0, 0, 0, 0);
    p1 = __builtin_amdgcn_mfma_f32_32x32x16_bf16(b1, qr[d0], p1, 0, 0, 0); }
}
__device__ __forceinline__ int v_st(int k, int c) { const int kk = (k & ~0xC) | ((k & 4) << 1) | ((k & 8) >> 1); return ((kk >> 3) * 4 + (c >> 5)) * 512 + ((kk & 7) * 32 + (c & 31)) * 2; }
__device__ __forceinline__ int v_rd_base(int lane) { return ((lane & 3) << 3) | (((lane >> 2) & 3) << 6) | (((lane >> 4) & 1) << 5) | (((lane >> 5) & 1) << 8); }
constexpr int v_rd_off(int d0, int ks, int half) { return d0 * 512 + ks * 4096 + half * 2048; }
template <int OFF> __device__ __forceinline__ s16x4 tr_read(int vb) {
  s16x4 r; asm volatile("ds_read_b64_tr_b16 %0, %1 offset:%2" : "=&v"(r) : "v"(vb), "i"(OFF) : "memory"); return r;
}
template <int D0> __device__ __forceinline__ void pv_one(f32x16& od, int vb, bf16x8 pa0, bf16x8 pa1, bf16x8 pa2, bf16x8 pa3) {
  const s16x4 l0 = tr_read<v_rd_off(D0, 0, 0)>(vb), h0 = tr_read<v_rd_off(D0, 0, 1)>(vb), l1 = tr_read<v_rd_off(D0, 1, 0)>(vb), h1 = tr_read<v_rd_off(D0, 1, 1)>(vb);
  const s16x4 l2 = tr_read<v_rd_off(D0, 2, 0)>(vb), h2 = tr_read<v_rd_off(D0, 2, 1)>(vb), l3 = tr_read<v_rd_off(D0, 3, 0)>(vb), h3 = tr_read<v_rd_off(D0, 3, 1)>(vb);
  asm volatile("s_waitcnt lgkmcnt(0)" ::: "memory"); SBAR();
#define PK(L, H) (bf16x8){L[0], L[1], L[2], L[3], H[0], H[1], H[2], H[3]}
  od = __builtin_amdgcn_mfma_f32_32x32x16_bf16(pa0, PK(l0, h0), od, 0, 0, 0);
  od = __builtin_amdgcn_mfma_f32_32x32x16_bf16(pa1, PK(l1, h1), od, 0, 0, 0);
  od = __builtin_amdgcn_mfma_f32_32x32x16_bf16(pa2, PK(l2, h2), od, 0, 0, 0);
  od = __builtin_amdgcn_mfma_f32_32x32x16_bf16(pa3, PK(l3, h3), od, 0, 0, 0);
#undef PK
}
__device__ __forceinline__ void pv_d0(f32x16* o, int vb, bf16x8 pa0, bf16x8 pa1, bf16x8 pa2, bf16x8 pa3) {
  pv_one<0>(o[0], vb, pa0, pa1, pa2, pa3); pv_one<1>(o[1], vb, pa0, pa1, pa2, pa3); pv_one<2>(o[2], vb, pa0, pa1, pa2, pa3); pv_one<3>(o[3], vb, pa0, pa1, pa2, pa3);
}

template <typename TQ>
__device__ __forceinline__ void attn_dense_body(const TQ* __restrict__ Qb, const bf16* __restrict__ Kh, const bf16* __restrict__ Vh,
                                                unsigned short* __restrict__ Ob, int seq, char* lds) {
  using St = Stage<bf16>; using SQ = Stage<TQ>;
  const int tid = mk_tid(), wid = tid >> 6, lane = tid & 63, r32 = lane & 31, hi = lane >> 5;
  bf16* V_lds = (bf16*)lds; bf16* K_lds = (bf16*)(lds + 2 * SHM_V);
  float* ws = (float*)(lds + 2 * SHM_V + 2 * SHM_K) + wid * 64; float* li_l = ws; float* al_l = ws + 32;
  float m_reg = -1e30f, l_reg = 0; f32x16 o[4] = {}; bf16x8 qr[8];
  const TQ* Qw = Qb + (long)(wid * QBLK + r32) * LDQ + hi * 8;
#pragma unroll
  for (int d0 = 0; d0 < 8; ++d0) qr[d0] = SQ::tobf(SQ::ld8(Qw + d0 * 16));
  const int sr = tid >> 4, sc = (tid & 15) * 8, vst0 = v_st(sr, sc), vst1 = v_st(32 + sr, sc);
  const int vb0 = (int)(uintptr_t)V_lds + v_rd_base(lane);
  struct { typename St::T vs0, vs1, ks0, ks1; } sr_[SDEPTH];
#define SLOAD(i, k0) do { sr_[i].vs0 = St::ld8(&Vh[(long)((k0) + sr) * LDK + sc]); sr_[i].vs1 = St::ld8(&Vh[(long)((k0) + 32 + sr) * LDK + sc]); \
    sr_[i].ks0 = St::ld8(&Kh[(long)((k0) + sr) * LDK + sc]); sr_[i].ks1 = St::ld8(&Kh[(long)((k0) + 32 + sr) * LDK + sc]); } while (0)
#define SWRITE(b, i) do { *(bf16x8*)((char*)V_lds + (b) * SHM_V + vst0) = St::tobf(sr_[i].vs0);          \
    *(bf16x8*)((char*)V_lds + (b) * SHM_V + vst1) = St::tobf(sr_[i].vs1); int kc = sc * 2;               \
    *(bf16x8*)((char*)K_lds + (b) * SHM_K + KSWZ(sr, kc)) = St::tobf(sr_[i].ks0);                       \
    *(bf16x8*)((char*)K_lds + (b) * SHM_K + KSWZ(32 + sr, kc)) = St::tobf(sr_[i].ks1); } while (0)
#define SWAIT() do { if constexpr (SDEPTH == 2) asm volatile("s_waitcnt vmcnt(4)" ::: "memory"); else asm volatile("s_waitcnt vmcnt(0)" ::: "memory"); } while (0)
#define RESC(a) do { if (__any((a) < 1.f)) { if (hi == 0) al_l[r32] = (a); asm volatile("s_waitcnt lgkmcnt(0)" ::: "memory"); \
    for (int d = 0; d < 4; ++d) for (int r = 0; r < 16; ++r) o[d][r] *= al_l[crow(r, hi)]; } } while (0)
  f32x16 pA0, pA1, pB0, pB1; float mnA, mnB, alA, alB; bf16x8 pa0, pa1, pa2, pa3; const int NT = seq / KVBLK;
  constexpr int SE = 0, SO = SDEPTH - 1;
  SLOAD(SE, 0); asm volatile("s_waitcnt vmcnt(0)" ::: "memory"); SWRITE(0, SE); __syncthreads();
  qkt(pA0, pA1, K_lds, qr, r32, hi); partialSM(pA0, pA1, m_reg, mnA, alA);
  SLOAD(SO, KVBLK); if constexpr (SDEPTH == 2) { if (2 < NT) SLOAD(SE, 2 * KVBLK); }
  SWAIT(); SWRITE(1, SO); __syncthreads();
  for (int j = 1; j + 1 < NT; j += 2) {
    SBAR(); qkt(pB0, pB1, (bf16*)((char*)K_lds + SHM_K), qr, r32, hi);
    finishSM(pA0, pA1, alA, l_reg, pa0, pa1, pa2, pa3); SBAR();
    SLOAD(SO, (j + SDEPTH) * KVBLK); SBAR();
    pv_d0(o, vb0, pa0, pa1, pa2, pa3); partialSM(pB0, pB1, m_reg, mnB, alB);
    __syncthreads(); SWAIT(); SWRITE(0, SE);
    RESC(alB); __syncthreads();
    SBAR(); qkt(pA0, pA1, K_lds, qr, r32, hi);
    finishSM(pB0, pB1, alB, l_reg, pa0, pa1, pa2, pa3); SBAR();
    if (SDEPTH == 1 || j + 3 < NT) SLOAD(SE, (j + 1 + SDEPTH) * KVBLK); SBAR();
    pv_d0(o, vb0 + (int)SHM_V, pa0, pa1, pa2, pa3); partialSM(pA0, pA1, m_reg, mnA, alA);
    __syncthreads(); SWAIT(); SWRITE(1, SO);
    RESC(alA); __syncthreads();
  }
  SBAR(); qkt(pB0, pB1, (bf16*)((char*)K_lds + SHM_K), qr, r32, hi);
  finishSM(pA0, pA1, alA, l_reg, pa0, pa1, pa2, pa3); SBAR();
  pv_d0(o, vb0, pa0, pa1, pa2, pa3); partialSM(pB0, pB1, m_reg, mnB, alB);
  __syncthreads(); RESC(alB);
  finishSM(pB0, pB1, alB, l_reg, pa0, pa1, pa2, pa3); SBAR();
  pv_d0(o, vb0 + (int)SHM_V, pa0, pa1, pa2, pa3);
  if (hi == 0) li_l[r32] = l_reg; asm volatile("s_waitcnt lgkmcnt(0)" ::: "memory");
  float rli[16];
#pragma unroll
  for (int r = 0; r < 16; ++r) rli[r] = __builtin_amdgcn_rcpf(li_l[crow(r, hi)]);
  unsigned short* Ow = Ob + (long)(wid * QBLK) * LDO;
#pragma unroll
  for (int r = 0; r < 16; ++r) { int orow = crow(r, hi);
    for (int d0 = 0; d0 < 4; ++d0) Ow[(long)orow * LDO + d0 * 32 + r32] = (unsigned short)(cvtpk(o[d0][r] * rli[r], 0.f) & 0xffffu); }
#undef SLOAD
#undef SWRITE
#undef SWAIT
#undef RESC
}

}
__device__ __forceinline__ int mk_tid() { int t = threadIdx.x; asm volatile("" : "+v"(t)); return t; }
namespace mk {
#define LAS __attribute__((address_space(3)))
typedef unsigned short bf16;
typedef short bf16x8 __attribute__((ext_vector_type(8)));
typedef float f32x4 __attribute__((ext_vector_type(4)));
typedef unsigned u32x4 __attribute__((ext_vector_type(4)));
typedef unsigned u32x2 __attribute__((ext_vector_type(2)));
#define XB_TMO      128
#define XB_XCNT(j)  (256  + 64 * (j))
#define XB_XSUB(j)  (1280 + 64 * (j))
#define XB_XGEN(j)  (2304 + 64 * (j))
#define XB_TOP      3328
#define XB_TOPGEN   3392
#define XCD_BAR_WORDS 3456
#define XB_SPIN_CAP (1u << 18)

__device__ __forceinline__ unsigned xb_ld(unsigned* p)              { return __hip_atomic_load(p, __ATOMIC_RELAXED, __HIP_MEMORY_SCOPE_AGENT); }
__device__ __forceinline__ unsigned xb_add(unsigned* p, unsigned v) { return __hip_atomic_fetch_add(p, v, __ATOMIC_RELAXED, __HIP_MEMORY_SCOPE_AGENT); }
__device__ __forceinline__ unsigned xb_xcc_id() { return (unsigned)__builtin_amdgcn_s_getreg((3 << 11) | 20) & 0xFu; }
#define XB_SPIN(cond, bar) do { unsigned _sp = 0; while (cond) { __builtin_amdgcn_s_sleep(1); \
    if ((++_sp & 255u) == 0u) { if (xb_ld(&(bar)[XB_TMO])) break; if (_sp > XB_SPIN_CAP) { atomicAdd(&(bar)[XB_TMO], 1u); break; } } } } while (0)

struct XcdBarrier {
    unsigned* bar; unsigned x;
    volatile LAS unsigned* st;
};

__device__ __forceinline__ XcdBarrier xcd_barrier_post(unsigned* bar, volatile LAS unsigned* st) {
    XcdBarrier b; b.bar = bar; b.x = xb_xcc_id(); b.st = st;
    if (mk_tid() == 0) (void)xb_add(&bar[XB_XCNT(b.x)], 1u);
    return b;
}
__device__ __forceinline__ void xcd_barrier_complete(unsigned* bar, unsigned x, unsigned& nloc, unsigned& nx) {
    const unsigned G = gridDim.x * gridDim.y * gridDim.z;
    unsigned sum, cnt, mine, sp = 0u;
    for (;;) {
        sum = 0u; cnt = 0u; mine = 0u;
#pragma unroll
        for (unsigned j = 0; j < 16; ++j) { const unsigned c = xb_ld(&bar[XB_XCNT(j)]); sum += c; cnt += (c > 0u) ? 1u : 0u; mine = (j == x) ? c : mine; }
        if (sum == G) break;
        __builtin_amdgcn_s_sleep(1);
        if ((++sp & 255u) == 0u) { if (xb_ld(&bar[XB_TMO])) break; if (sp > XB_SPIN_CAP) { atomicAdd(&bar[XB_TMO], 1u); break; } }
    }
    nloc = mine > 0u ? mine : 1u; nx = cnt > 0u ? cnt : 1u;
}

__device__ __forceinline__ void xcd_barrier(const XcdBarrier& b) {
    asm volatile("s_waitcnt vmcnt(0)" ::: "memory");
    __syncthreads();
    if (mk_tid() == 0) {
        unsigned* bar = b.bar;
        __builtin_amdgcn_s_waitcnt(0);
        unsigned nloc = b.st[0], nx = b.st[1];
        if (nloc == 0u) { xcd_barrier_complete(bar, b.x, nloc, nx); b.st[0] = nloc; b.st[1] = nx; }
        const unsigned old = xb_add(&bar[XB_XSUB(b.x)], 1u);
        const unsigned gen = old / nloc;
        if (old + 1u == (gen + 1u) * nloc) {
            __builtin_amdgcn_fence(__ATOMIC_RELEASE, "agent");
            asm volatile("s_waitcnt vmcnt(0)" ::: "memory");
            const unsigned og = xb_add(&bar[XB_TOP], 1u);
            const unsigned tg = og / nx;
            if (og + 1u == (tg + 1u) * nx) xb_add(&bar[XB_TOPGEN], 1u);
            else XB_SPIN(xb_ld(&bar[XB_TOPGEN]) == tg, bar);
            __builtin_amdgcn_fence(__ATOMIC_ACQUIRE, "agent");
            xb_add(&bar[XB_XGEN(b.x)], 1u);
            asm volatile("s_waitcnt vmcnt(0)" ::: "memory");
        } else {
            XB_SPIN(xb_ld(&bar[XB_XGEN(b.x)]) == gen, bar);
            __builtin_amdgcn_fence(__ATOMIC_ACQUIRE, "agent");
            asm volatile("s_waitcnt vmcnt(0)" ::: "memory");
        }
    }
    __syncthreads();
}


constexpr int D = 2048, M = 8192, SEQ = 4096, NW = 8;
constexpr int ABW = 3072, CW = 8224, FF2 = 11264, FF = 5632;
constexpr float EPS = 1e-6f;
constexpr size_t MiB = 1u << 20;
constexpr size_t WS_AB = 0, WS_BD = 12 * MiB, WS_OAB = 13 * MiB, WS_C = 21 * MiB  , WS_OC = 54 * MiB;
constexpr size_t WS_UP0 = 62 * MiB, WS_UP1 = 106 * MiB, WS_DN0 = 150 * MiB, WS_DN1 = 172 * MiB;
constexpr size_t WS_XN = 194 * MiB, WS_GATES = 226 * MiB, WS_S = 228 * MiB;
constexpr size_t WS_PROJ = WS_S, WS_POOLED = WS_S + 48 * MiB, WS_CAT = WS_S + 56 * MiB;
constexpr size_t WS_QK = WS_S, WS_OG = WS_S + 64 * MiB, WS_KVT = WS_S + 96 * MiB, WS_HF = WS_S + 160 * MiB, WS_Y = WS_S + 288 * MiB;
constexpr size_t WS_U = WS_S, WS_ACT = WS_S + 176 * MiB;
constexpr size_t WS_END = WS_S + 320 * MiB;
constexpr int LDS_ML = 154112 + 1024, LDS_MISC = LDS_ML, LDS_BYTES = LDS_ML + 64;
constexpr size_t WS_BAR = WS_BD + 768 * 1024, BAR_BYTES = 16384;

#define LDSWAIT() asm volatile("s_waitcnt lgkmcnt(0)" ::: "memory")
__device__ __forceinline__ unsigned f2bf(float f) { unsigned u = __float_as_uint(f); return (u + 0x7fffu + ((u >> 16) & 1u)) >> 16; }
__device__ __forceinline__ unsigned pk2(float lo, float hi) { unsigned r; asm volatile("v_cvt_pk_bf16_f32 %0, %1, %2" : "=v"(r) : "v"(lo), "v"(hi)); return r; }
__device__ __forceinline__ float bflo(unsigned w) { return __uint_as_float(w << 16); }
__device__ __forceinline__ float bfhi(unsigned w) { return __uint_as_float(w & 0xffff0000u); }
__device__ __forceinline__ float wave_sum(float v) {
#pragma unroll
    for (int o = 1; o < 64; o <<= 1) v += __shfl_xor(v, o);
    return v;
}

__device__ __forceinline__ void transpose_item64(const float* __restrict__ W, int ldw, int K, int nblk, bf16* __restrict__ WT, LAS float* scr, int item, int lane, bool upperm) {
    const int kb = item / nblk, nb = item - kb * nblk, k0 = 64 * kb, n0 = 64 * nb;
    const int d0 = !upperm ? n0 : (n0 < FF ? 256 * (n0 >> 7) + (n0 & 127) : 256 * ((n0 - FF) >> 7) + 128 + ((n0 - FF) & 127));
    f32x4 v[16];
#pragma unroll
    for (int i = 0; i < 16; ++i) { const int kk = 4 * i + (lane >> 4); v[i] = *(const f32x4*)(W + (size_t)(k0 + kk) * ldw + n0 + 4 * (lane & 15)); }
#pragma unroll
    for (int i = 0; i < 16; ++i) { const int kk = 4 * i + (lane >> 4); LAS float* s = scr + kk * 65 + 4 * (lane & 15); s[0] = v[i].x; s[1] = v[i].y; s[2] = v[i].z; s[3] = v[i].w; }
    LDSWAIT();
    const int c = lane & 7, q = lane >> 3;
#pragma unroll
    for (int j = 0; j < 8; ++j) { const int n = q + 8 * j; const LAS float* s = scr + (8 * c) * 65 + n;
        u32x4 o; o.x = pk2(s[0], s[65]); o.y = pk2(s[130], s[195]); o.z = pk2(s[260], s[325]); o.w = pk2(s[390], s[455]);
        *(u32x4*)(WT + (size_t)(d0 + n) * K + k0 + 8 * c) = o; }
    LDSWAIT();
}

__device__ __forceinline__ void rmsnorm_rows(const float* __restrict__ src, const float* __restrict__ gain, bf16* __restrict__ dst, int gw, int ngw, int lane) {
    f32x4 g[8];
#pragma unroll
    for (int j = 0; j < 8; ++j) g[j] = *(const f32x4*)(gain + 4 * lane + 256 * j);
    for (int m = gw; m < M; m += ngw) {
        const f32x4* xr = (const f32x4*)(src + (size_t)m * D) + lane; f32x4 v[8]; float s = 0.f;
#pragma unroll
        for (int j = 0; j < 8; ++j) { v[j] = xr[64 * j]; s += (v[j].x * v[j].x + v[j].y * v[j].y) + (v[j].z * v[j].z + v[j].w * v[j].w); }
        const float rstd = 1.0f / sqrtf(wave_sum(s) * (1.0f / D) + EPS);
        u32x2* o = (u32x2*)(dst + (size_t)m * D) + lane;
#pragma unroll
        for (int j = 0; j < 8; ++j) { u32x2 w; w.x = pk2(v[j].x * rstd * g[j].x, v[j].y * rstd * g[j].y); w.y = pk2(v[j].z * rstd * g[j].z, v[j].w * rstd * g[j].w); o[64 * j] = w; }
    }
}

struct In { const float *x, *norm_mix, *norm_ffn, *w_in_ab, *pool_w, *pool_scale, *q_norm, *k_norm, *w_out_ab, *w_in_c, *b_gate, *h_norm, *w_out_c, *w_up, *conv_w, *conv_b, *w_down; };

__device__ __forceinline__ void transposes(const In& I, unsigned char* ws, LAS unsigned char* lds, int first, int last, int w, int nw, int wave, int lane) {
    LAS float* scr = (LAS float*)(lds + wave * 16640);
    for (int it = first + w; it < last; it += nw) {
        const float* W; int ldw, K, nblk; bf16* WT; int r = it;
        if (r < 1536) { W = I.w_in_ab; ldw = ABW; K = D; nblk = 48; WT = (bf16*)(ws + WS_AB); }
        else if (r < 2560) { r -= 1536; W = I.w_out_ab; ldw = D; K = D; nblk = 32; WT = (bf16*)(ws + WS_OAB); }
        else if (r < 6656) { r -= 2560; W = I.w_in_c; ldw = CW; K = D; nblk = 128; WT = (bf16*)(ws + WS_C); }
        else if (r < 7680) { r -= 6656; W = I.w_out_c; ldw = D; K = D; nblk = 32; WT = (bf16*)(ws + WS_OC); }
        else if (r < 13312) { r -= 7680; W = I.w_up; ldw = FF2; K = D; nblk = 176; WT = (bf16*)(ws + WS_UP0); }
        else if (r < 18944) { r -= 13312; W = I.w_up + (size_t)D * FF2; ldw = FF2; K = D; nblk = 176; WT = (bf16*)(ws + WS_UP1); }
        else if (r < 21760) { r -= 18944; W = I.w_down; ldw = D; K = FF; nblk = 32; WT = (bf16*)(ws + WS_DN0); }
        else { r -= 21760; W = I.w_down + (size_t)FF * D; ldw = D; K = FF; nblk = 32; WT = (bf16*)(ws + WS_DN1); }
        transpose_item64(W, ldw, K, nblk, WT, scr, r, lane, (it >= 7680 && it < 18944));
    }
}
__device__ __forceinline__ void prologue(const In& I, unsigned char* ws, LAS unsigned char* lds, int gw, int ngw, int wave, int lane) {
    transposes(I, ws, lds, 0, 1536, gw, ngw, wave, lane);
    const int gt = gw * 64 + lane, ngt = ngw * 64;
    { bf16* WG = (bf16*)(ws + WS_C) + (size_t)8192 * D;
      for (int idx = gt; idx < 32 * D; idx += ngt) { const int j = idx >> 11, k = idx & 2047; WG[idx] = (bf16)f2bf(I.w_in_c[(size_t)k * CW + 8192 + j]); } }
    { bf16* BD = (bf16*)(ws + WS_BD);
      for (int idx = gt; idx < 512 * 512; idx += ngt) { const int n = idx >> 9, k = idx & 511, gn = n >> 7, gk = k >> 7;
          const float v = (gn == gk) ? I.pool_w[(size_t)(gn * 128 + (k & 127)) * 128 + (n & 127)] * I.pool_scale[n] : 0.f; BD[idx] = (bf16)f2bf(v); } }
    rmsnorm_rows(I.x, I.norm_mix, (bf16*)(ws + WS_XN), gw, ngw, lane);
}

__device__ __forceinline__ void qk_rope_pool(bf16* __restrict__ PROJ, const float* __restrict__ qn, const float* __restrict__ kn, bf16* __restrict__ POOLED, int gw, int ngw, int lane) {
    const int l = lane & 31, hsel = lane >> 5, part = (l >> 4) & 1; const bool first = (l & 8) == 0;
    float inv[4];
#pragma unroll
    for (int e = 0; e < 4; ++e) inv[e] = exp2f(-(float)(4 * (l & 7) + e) * (13.287712379549449f / 32.0f));
    const f32x4 gq = *(const f32x4*)(qn + 4 * l), gk = *(const f32x4*)(kn + 4 * l);
    for (int it0 = gw; it0 < M * 8; it0 += 4 * ngw) {
        u32x2 wv[4]; bf16* pp4[4]; int tt4[4], hh4[4]; bool ok[4];
#pragma unroll
        for (int k = 0; k < 4; ++k) { const int it = it0 + k * ngw; ok[k] = it < M * 8; const int itc = ok[k] ? it : gw; tt4[k] = itc >> 3; hh4[k] = (itc & 7) * 2 + hsel;
            pp4[k] = PROJ + (size_t)tt4[k] * ABW + 512 + hh4[k] * 128 + 4 * l; wv[k] = *(const u32x2*)pp4[k]; }
#pragma unroll
        for (int k = 0; k < 4; ++k) {
            const u32x2 w = wv[k]; const int t = tt4[k], hh = hh4[k];
            float x[4] = {bflo(w.x), bfhi(w.x), bflo(w.y), bfhi(w.y)};
            float ss = (x[0] * x[0] + x[1] * x[1]) + (x[2] * x[2] + x[3] * x[3]);
#pragma unroll
            for (int o = 1; o < 32; o <<= 1) ss += __shfl_xor(ss, o);
            const float rstd = 1.0f / sqrtf(ss * (1.0f / 128.0f) + EPS);
            const f32x4 g = (hh < 12) ? gq : gk;
            const int pos = t & (SEQ - 1); const float pp = part ? (float)(pos & 63) : (float)(pos >> 6);
            float y[4] = {x[0] * rstd * g.x, x[1] * rstd * g.y, x[2] * rstd * g.z, x[3] * rstd * g.w}, o4[4];
#pragma unroll
            for (int e = 0; e < 4; ++e) { const float yp = __shfl_xor(y[e], 8); const float ang = pp * inv[e]; const float sn = __sinf(ang), cs = __cosf(ang);
                o4[e] = y[e] * cs + (first ? -yp : yp) * sn; }
            u32x2 ow; ow.x = pk2(o4[0], o4[1]); ow.y = pk2(o4[2], o4[3]); if (ok[k]) *(u32x2*)pp4[k] = ow;
        }
    }
    const int gt = gw * 64 + lane, ngt = ngw * 64;
    for (int it = gt; it < M * 64; it += ngt) {
        const int t = it >> 6, c8 = (it & 63) * 8, g = c8 >> 7, w2 = 1 << g, pos = t & (SEQ - 1), base = t - pos;
        const int lo = max(pos - w2, 0), hi = min(pos + w2, SEQ);
        float acc[8] = {0.f, 0.f, 0.f, 0.f, 0.f, 0.f, 0.f, 0.f};
        u32x4 wv[16];
#pragma unroll
        for (int k = 0; k < 16; ++k) { const int pz = pos - w2 + k; const bool okk = (k < 2 * w2) && pz >= 0 && pz < SEQ; const u32x4 z = {0u, 0u, 0u, 0u};
            wv[k] = okk ? *(const u32x4*)(PROJ + (size_t)(base + pz) * ABW + c8) : z; }
#pragma unroll
        for (int k = 0; k < 16; ++k) { const u32x4 v = wv[k];
            acc[0] += bflo(v.x); acc[1] += bfhi(v.x); acc[2] += bflo(v.y); acc[3] += bfhi(v.y); acc[4] += bflo(v.z); acc[5] += bfhi(v.z); acc[6] += bflo(v.w); acc[7] += bfhi(v.w); }
        const u32x4 sv = *(const u32x4*)(PROJ + (size_t)t * ABW + c8); const float iv = 1.0f / (float)(hi - lo);
        u32x4 o; o.x = pk2(acc[0] * iv - bflo(sv.x), acc[1] * iv - bfhi(sv.x)); o.y = pk2(acc[2] * iv - bflo(sv.y), acc[3] * iv - bfhi(sv.y));
        o.z = pk2(acc[4] * iv - bflo(sv.z), acc[5] * iv - bfhi(sv.z)); o.w = pk2(acc[6] * iv - bflo(sv.w), acc[7] * iv - bfhi(sv.w));
        *(u32x4*)(POOLED + (size_t)t * 512 + c8) = o;
    }
}

__device__ __forceinline__ void conv_fix(const bf16* __restrict__ HALO, const float* __restrict__ cw, const float* __restrict__ cb, bf16* __restrict__ ACT, int gt, int ngt) {
    for (int it = gt; it < 256 * 704; it += ngt) {
        const int jc = it % 704, re = it / 704, blk = re >> 1, last = re & 1, j = jc * 8;
        const int t = blk * 64 + (last ? 63 : 0), pos = t & (SEQ - 1);
        const bf16* rc = HALO + ((size_t)blk * 4 + (last ? 3 : 0)) * FF2 + j;
        const bf16* ru = last ? rc - FF2 : HALO + ((size_t)(blk - 1) * 4 + 3) * FF2 + j;
        const bf16* rd = last ? HALO + ((size_t)(blk + 1) * 4) * FF2 + j : rc + FF2;
        const u32x4 z = {0u, 0u, 0u, 0u};
        const u32x4 g1 = *(const u32x4*)rc, v1 = *(const u32x4*)(rc + FF);
        const u32x4 g0 = pos > 0 ? *(const u32x4*)ru : z, v0 = pos > 0 ? *(const u32x4*)(ru + FF) : z;
        const u32x4 g2 = pos < SEQ - 1 ? *(const u32x4*)rd : z, v2 = pos < SEQ - 1 ? *(const u32x4*)(rd + FF) : z;
        float o[8];
#pragma unroll
        for (int q = 0; q < 4; ++q) {
            const int ja = j + 2 * q, jb = ja + 1;
            const float ga = cw[ja] * bflo(g0[q]) + cw[FF2 + ja] * bflo(g1[q]) + cw[2 * FF2 + ja] * bflo(g2[q]) + cb[ja];
            const float gb = cw[jb] * bfhi(g0[q]) + cw[FF2 + jb] * bfhi(g1[q]) + cw[2 * FF2 + jb] * bfhi(g2[q]) + cb[jb];
            const float va = cw[FF + ja] * bflo(v0[q]) + cw[FF2 + FF + ja] * bflo(v1[q]) + cw[2 * FF2 + FF + ja] * bflo(v2[q]) + cb[FF + ja];
            const float vb = cw[FF + jb] * bfhi(v0[q]) + cw[FF2 + FF + jb] * bfhi(v1[q]) + cw[2 * FF2 + FF + jb] * bfhi(v2[q]) + cb[FF + jb];
            o[2 * q] = ga / (1.0f + __expf(-ga)) * va; o[2 * q + 1] = gb / (1.0f + __expf(-gb)) * vb;
        }
        u32x4 ow; ow.x = pk2(o[0], o[1]); ow.y = pk2(o[2], o[3]); ow.z = pk2(o[4], o[5]); ow.w = pk2(o[6], o[7]);
        *(u32x4*)(ACT + (size_t)t * FF + j) = ow;
    }
}

__device__ __forceinline__ void gates_phase(const bf16* __restrict__ XN, const bf16* __restrict__ WG, const float* __restrict__ bg, float* __restrict__ GATES, LAS float* red, int bid, int nblk) {
    const int tid = mk_tid(), wid = tid >> 6, lane = tid & 63, fr = lane & 15, fq = lane >> 4;
    const int tile = wid & 3, tt = tile & 1, jt = tile >> 1, kh = wid >> 2;
    for (int grp = bid; grp < 256; grp += nblk) {
        f32x4 acc = {0.f, 0.f, 0.f, 0.f};
        const bf16* ap = WG + (size_t)(jt * 16 + fr) * D + kh * 1024 + fq * 8;
        const bf16* bp = XN + (size_t)(grp * 32 + tt * 16 + fr) * D + kh * 1024 + fq * 8;
#pragma unroll 8
        for (int ks = 0; ks < 32; ++ks) { const bf16x8 a = *(const bf16x8*)(ap + ks * 32), b = *(const bf16x8*)(bp + ks * 32); acc = __builtin_amdgcn_mfma_f32_16x16x32_bf16(a, b, acc, 0, 0, 0); }
        if (kh == 1) { LAS float* r = red + (tile * 64 + lane) * 4; r[0] = acc[0]; r[1] = acc[1]; r[2] = acc[2]; r[3] = acc[3]; }
        __syncthreads();
        if (kh == 0) { const LAS float* r = red + (tile * 64 + lane) * 4; const int t = grp * 32 + tt * 16 + fr, j = jt * 16 + 4 * fq;
            const f32x4 b4 = *(const f32x4*)(bg + j); f32x4 o; o.x = acc[0] + r[0] + b4.x; o.y = acc[1] + r[1] + b4.y; o.z = acc[2] + r[2] + b4.z; o.w = acc[3] + r[3] + b4.w;
            *(f32x4*)(GATES + (size_t)t * 32 + j) = o; }
        __syncthreads();
    }
}

__device__ __forceinline__ void headnorm_phase(const bf16* __restrict__ HF, const bf16* __restrict__ OG, const float* __restrict__ hn, bf16* __restrict__ Y, int gw, int ngw, int lane) {
    for (int it0 = gw; it0 < M * 8; it0 += 4 * ngw) {
        u32x2 a[4], b[4], ow[4]; f32x4 g[4]; size_t off[4]; bool ok[4];
#pragma unroll
        for (int k = 0; k < 4; ++k) { const int it = it0 + k * ngw; ok[k] = it < M * 8; const int itc = ok[k] ? it : gw; const int t = itc >> 3, h = itc & 7; off[k] = (size_t)t * D + h * 256 + 4 * lane;
            a[k] = *(const u32x2*)(HF + off[k]); b[k] = *(const u32x2*)(HF + (size_t)M * D + off[k]); ow[k] = *(const u32x2*)(OG + off[k]); g[k] = *(const f32x4*)(hn + h * 256 + 4 * lane); }
#pragma unroll
        for (int k = 0; k < 4; ++k) {
            f32x4 s; s.x = bflo(a[k].x) + bflo(b[k].x); s.y = bfhi(a[k].x) + bfhi(b[k].x); s.z = bflo(a[k].y) + bflo(b[k].y); s.w = bfhi(a[k].y) + bfhi(b[k].y);
            const float ss = wave_sum((s.x * s.x + s.y * s.y) + (s.z * s.z + s.w * s.w));
            const float rstd = 1.0f / sqrtf(ss * (1.0f / 256.0f) + EPS);
            const float o0 = bflo(ow[k].x), o1 = bfhi(ow[k].x), o2 = bflo(ow[k].y), o3 = bfhi(ow[k].y);
            u32x2 w; w.x = pk2(s.x * rstd * g[k].x * __builtin_amdgcn_rcpf(1.0f + __expf(-o0)), s.y * rstd * g[k].y * __builtin_amdgcn_rcpf(1.0f + __expf(-o1)));
            w.y = pk2(s.z * rstd * g[k].z * __builtin_amdgcn_rcpf(1.0f + __expf(-o2)), s.w * rstd * g[k].w * __builtin_amdgcn_rcpf(1.0f + __expf(-o3)));
            if (ok[k]) *(u32x2*)(Y + off[k]) = w;
        }
    }
}

namespace ml {
constexpr int LQ = 264, LS = 72;
constexpr int OFF_Q = 0, OFF_K = 33792, OFF_KT = 67584, OFF_VT = 104448, OFF_VTW = 111360, OFF_P = 118272, OFF_CT = 127488, OFF_SC = 152832;
static_assert(OFF_SC + 1280 + 1024 == LDS_ML, "mlstm lds map");
#define ML_BAR() do { asm volatile("s_waitcnt lgkmcnt(0)" ::: "memory"); __builtin_amdgcn_s_barrier(); asm volatile("" ::: "memory"); } while (0)
#define ML_DPP(old, src, ctrl, rmask) __int_as_float(__builtin_amdgcn_update_dpp(__float_as_int(old), __float_as_int(src), ctrl, rmask, 0xF, false))
#define ML_MFMA(a, b, c) __builtin_amdgcn_mfma_f32_16x16x32_bf16(a, b, c, 0, 0, 0)

__device__ __forceinline__ void mlstm_phase(LAS unsigned char* lds, const bf16* __restrict__ QK, const bf16* __restrict__ KVT, const float* __restrict__ GATES, bf16* __restrict__ HF, int bid, int nblk) {
    const int tid = mk_tid(), wid = tid >> 6, lane = tid & 63, fr = lane & 15, fq = lane >> 4;
    LAS bf16* Qs = (LAS bf16*)(lds + OFF_Q); LAS bf16* Ks = (LAS bf16*)(lds + OFF_K); LAS bf16* KTs = (LAS bf16*)(lds + OFF_KT);
    LAS bf16* VTs = (LAS bf16*)(lds + OFF_VT); LAS bf16* VTw = (LAS bf16*)(lds + OFF_VTW); LAS bf16* Ps = (LAS bf16*)(lds + OFF_P); LAS bf16* CTs = (LAS bf16*)(lds + OFF_CT);
    LAS float* sA = (LAS float*)(lds + OFF_SC); LAS float* sM = sA + 64; LAS float* sAI = sM + 64; LAS float* sEM = sAI + 64; LAS float* sWS = (LAS float*)(lds + OFF_SC + 1280);
    const int tt = wid & 3, sh = wid >> 2;
    for (int it0 = bid; it0 < 256; it0 += nblk) {
        const int item = (nblk == 256) ? (((it0 & 7) * 4 + (it0 >> 6)) * 8 + ((it0 >> 3) & 7)) : it0;
        const int es = item & 7, dir = (item >> 3) & 1, h = (item >> 4) & 7, b = (item >> 7) & 1;
        for (int i = tid; i < 48 * LQ / 2; i += 512) ((LAS unsigned*)CTs)[i] = 0u;
        for (int i = tid; i < 16 * LS; i += 512) { VTs[32 * LS + i] = (i < LS) ? (bf16)0x3F80 : (bf16)0; VTw[32 * LS + i] = (bf16)0; }
        f32x4 ct[2][3];
#pragma unroll
        for (int a = 0; a < 2; ++a)
#pragma unroll
            for (int e = 0; e < 3; ++e) ct[a][e] = (f32x4){0.f, 0.f, 0.f, 0.f};
        float m_st = 0.f, decay = 1.f;
        bf16x8 rq[4], rk[4], rkt[4], rvt = {0, 0, 0, 0, 0, 0, 0, 0}; float gi = 0.f, gf = 0.f;
        const unsigned voffQ = (unsigned)(((tid >> 5) * 4096 + (tid & 31) * 8) * 2), voffT = (unsigned)(((tid >> 3) * M + (tid & 7) * 8) * 2), voffG = (unsigned)((dir ? 63 - lane : lane) * 128);
#define ML_LOAD(c) do { const int ncn_ = dir ? 63 - (c) : (c); const size_t trow_ = (size_t)b * SEQ + (size_t)ncn_ * 64; \
        const char* qb_ = (const char*)(QK + trow_ * 4096 + h * 256); \
        _Pragma("unroll") for (int i_ = 0; i_ < 4; ++i_) { rq[i_] = *(const bf16x8*)(qb_ + (size_t)i_ * 131072 + voffQ); rk[i_] = *(const bf16x8*)(qb_ + 4096 + (size_t)i_ * 131072 + voffQ); } \
        const char* tb_ = (const char*)(KVT + (size_t)(h * 256) * M + trow_); \
        _Pragma("unroll") for (int i_ = 0; i_ < 4; ++i_) rkt[i_] = *(const bf16x8*)(tb_ + (size_t)i_ * (64 * M * 2) + voffT); \
        if (tid < 256) rvt = *(const bf16x8*)((const char*)(KVT + (size_t)(2048 + h * 256 + es * 32) * M + trow_) + voffT); \
        { const float* gp_ = GATES + trow_ * 32 + dir * 16 + h; gi = *(const float*)((const char*)gp_ + voffG); gf = *(const float*)((const char*)gp_ + 32 + voffG); } } while (0)
#define ML_STORE() do { \
        const float lf_ = fminf(gf, 0.f) - log1pf(__expf(-fabsf(gf))); float bc_ = lf_; \
        bc_ += ML_DPP(0.f, bc_, 0x111, 0xF); bc_ += ML_DPP(0.f, bc_, 0x112, 0xF); bc_ += ML_DPP(0.f, bc_, 0x114, 0xF); bc_ += ML_DPP(0.f, bc_, 0x118, 0xF); \
        bc_ += ML_DPP(0.f, bc_, 0x142, 0xA); bc_ += ML_DPP(0.f, bc_, 0x143, 0xC); \
        const float a_ = gi - bc_; float cm_ = a_; \
        cm_ = fmaxf(cm_, ML_DPP(-3.0e38f, cm_, 0x111, 0xF)); cm_ = fmaxf(cm_, ML_DPP(-3.0e38f, cm_, 0x112, 0xF)); cm_ = fmaxf(cm_, ML_DPP(-3.0e38f, cm_, 0x114, 0xF)); cm_ = fmaxf(cm_, ML_DPP(-3.0e38f, cm_, 0x118, 0xF)); \
        cm_ = fmaxf(cm_, ML_DPP(-3.0e38f, cm_, 0x142, 0xA)); cm_ = fmaxf(cm_, ML_DPP(-3.0e38f, cm_, 0x143, 0xC)); \
        const float Mv_ = fmaxf(m_st, cm_), blast_ = __shfl(bc_, 63), cml_ = __shfl(cm_, 63), Mn_ = fmaxf(m_st, cml_); \
        const float ai_ = __expf(m_st - Mv_), em_ = __expf(-(bc_ + Mv_)), wsv_ = __expf(a_ - Mn_); decay = __expf(m_st - Mn_); m_st = blast_ + Mn_; \
        const int rr_ = dir ? 63 - lane : lane; \
        if (wid == 0) { sA[rr_] = a_; sM[rr_] = Mv_; sAI[rr_] = ai_; sEM[rr_] = em_; VTw[32 * LS + rr_] = (bf16)f2bf(wsv_); } \
        _Pragma("unroll") for (int i_ = 0; i_ < 4; ++i_) { const int q_ = tid + 512 * i_, r_ = q_ >> 5, cc_ = (q_ & 31) * 8; \
            *(LAS bf16x8*)(Qs + r_ * LQ + cc_) = rq[i_]; *(LAS bf16x8*)(Ks + r_ * LQ + cc_) = rk[i_]; } \
        _Pragma("unroll") for (int i_ = 0; i_ < 4; ++i_) { const int q_ = tid + 512 * i_, d_ = q_ >> 3, cc_ = (q_ & 7) * 8; *(LAS bf16x8*)(KTs + d_ * LS + cc_) = rkt[i_]; } \
        if (tid < 256) { const int e_ = tid >> 3, cc_ = (tid & 7) * 8; *(LAS bf16x8*)(VTs + e_ * LS + cc_) = rvt; \
            LAS float* wsp_ = sWS + wid * 64; wsp_[rr_] = wsv_; asm volatile("s_waitcnt lgkmcnt(0)" ::: "memory"); \
            const f32x4 wa_ = *(const LAS f32x4*)(wsp_ + cc_), wb_ = *(const LAS f32x4*)(wsp_ + cc_ + 4); const float wv_[8] = {wa_.x, wa_.y, wa_.z, wa_.w, wb_.x, wb_.y, wb_.z, wb_.w}; \
            const u32x4 rv_ = __builtin_bit_cast(u32x4, rvt); u32x4 o_; \
            o_.x = pk2(bflo(rv_.x) * wv_[0], bfhi(rv_.x) * wv_[1]); o_.y = pk2(bflo(rv_.y) * wv_[2], bfhi(rv_.y) * wv_[3]); \
            o_.z = pk2(bflo(rv_.z) * wv_[4], bfhi(rv_.z) * wv_[5]); o_.w = pk2(bflo(rv_.w) * wv_[6], bfhi(rv_.w) * wv_[7]); \
            *(LAS u32x4*)(VTw + e_ * LS + cc_) = o_; } } while (0)
        ML_LOAD(0);
        ML_BAR();
        ML_STORE();
        ML_BAR();
        ML_LOAD(1);
        for (int c = 0; c < 64; ++c) {
            const int ncn = dir ? 63 - c : c; const size_t trow = (size_t)b * SEQ + (size_t)ncn * 64;
            const float dec_c = decay;
            f32x4 s0 = {0.f, 0.f, 0.f, 0.f}, s1 = s0, n3 = s0, d3 = s0;
            {
                const LAS bf16* qp = Qs + (tt * 16 + fr) * LQ + fq * 8;
                const LAS bf16* kp0 = Ks + ((2 * sh) * 16 + fr) * LQ + fq * 8; const LAS bf16* kp1 = kp0 + 16 * LQ;
                const LAS bf16* cp0 = CTs + (sh * 16 + fr) * LQ + fq * 8; const LAS bf16* cp2 = CTs + (32 + fr) * LQ + fq * 8;
#pragma unroll
                for (int hf = 0; hf < 4; ++hf) {
                    bf16x8 qf[2], k0[2], k1[2], c0[2], c2[2];
#pragma unroll
                    for (int k4 = 0; k4 < 2; ++k4) { const int ko = (hf * 2 + k4) * 32;
                        qf[k4] = *(const LAS bf16x8*)(qp + ko); k0[k4] = *(const LAS bf16x8*)(kp0 + ko); k1[k4] = *(const LAS bf16x8*)(kp1 + ko);
                        c0[k4] = *(const LAS bf16x8*)(cp0 + ko); c2[k4] = *(const LAS bf16x8*)(cp2 + ko); }
                    __builtin_amdgcn_sched_barrier(0);
#pragma unroll
                    for (int k4 = 0; k4 < 2; ++k4) { s0 = ML_MFMA(k0[k4], qf[k4], s0); s1 = ML_MFMA(k1[k4], qf[k4], s1); n3 = ML_MFMA(c0[k4], qf[k4], n3); d3 = ML_MFMA(c2[k4], qf[k4], d3); }
                }
            }
            const int t = tt * 16 + fr; const float Mt = sM[t];
            {
                const int sb0 = (2 * sh) * 16 + 4 * fq, sb1 = sb0 + 16;
                const f32x4 a0 = *(const LAS f32x4*)(sA + sb0), a1 = *(const LAS f32x4*)(sA + sb1);
                float p0[4], p1[4];
#pragma unroll
                for (int r = 0; r < 4; ++r) {
                    const int sa = sb0 + r, sbb = sb1 + r;
                    const bool ok0 = dir ? (sa >= t) : (sa <= t), ok1 = dir ? (sbb >= t) : (sbb <= t);
                    p0[r] = ok0 ? s0[r] * __expf(a0[r] - Mt) : 0.f; p1[r] = ok1 ? s1[r] * __expf(a1[r] - Mt) : 0.f;
                }
                u32x2 w0, w1; w0.x = pk2(p0[0], p0[1]); w0.y = pk2(p0[2], p0[3]); w1.x = pk2(p1[0], p1[1]); w1.y = pk2(p1[2], p1[3]);
                *(LAS u32x2*)(Ps + t * LS + sb0) = w0; *(LAS u32x2*)(Ps + t * LS + sb1) = w1;
            }
            ML_BAR();
            f32x4 n2 = {0.f, 0.f, 0.f, 0.f}, d2 = n2;
            {
                bf16x8 pf[2], v0[2], v2[2];
#pragma unroll
                for (int ks = 0; ks < 2; ++ks) { const int ko = ks * 32 + fq * 8;
                    pf[ks] = *(const LAS bf16x8*)(Ps + (tt * 16 + fr) * LS + ko); v0[ks] = *(const LAS bf16x8*)(VTs + (sh * 16 + fr) * LS + ko); v2[ks] = *(const LAS bf16x8*)(VTs + (32 + fr) * LS + ko); }
                __builtin_amdgcn_sched_barrier(0);
#pragma unroll
                for (int ks = 0; ks < 2; ++ks) { n2 = ML_MFMA(v0[ks], pf[ks], n2); d2 = ML_MFMA(v2[ks], pf[ks], d2); }
            }
            {
                const float ai = sAI[t], em = sEM[t];
                const float den0 = d2[0] + ai * d3[0];
                const float den = __shfl(den0, fr);
                const float rinv = 1.0f / fmaxf(fabsf(den), em);
                f32x4 hout; hout.x = (n2[0] + ai * n3[0]) * rinv; hout.y = (n2[1] + ai * n3[1]) * rinv; hout.z = (n2[2] + ai * n3[2]) * rinv; hout.w = (n2[3] + ai * n3[3]) * rinv;
                { u32x2 hw; hw.x = pk2(hout.x, hout.y); hw.y = pk2(hout.z, hout.w); *(u32x2*)(HF + ((size_t)dir * M + trow + t) * D + h * 256 + es * 32 + sh * 16 + 4 * fq) = hw; }
            }
#pragma unroll
            for (int a = 0; a < 2; ++a)
#pragma unroll
                for (int e = 0; e < 3; ++e) ct[a][e] = ct[a][e] * dec_c;
#pragma unroll
            for (int ks = 0; ks < 2; ++ks) { const int ko = ks * 32 + fq * 8; bf16x8 kt[2], vw[3];
#pragma unroll
                for (int a = 0; a < 2; ++a) kt[a] = *(const LAS bf16x8*)(KTs + ((2 * wid + a) * 16 + fr) * LS + ko);
#pragma unroll
                for (int e = 0; e < 3; ++e) vw[e] = *(const LAS bf16x8*)(VTw + (e * 16 + fr) * LS + ko);
                __builtin_amdgcn_sched_barrier(0);
#pragma unroll
                for (int a = 0; a < 2; ++a)
#pragma unroll
                    for (int e = 0; e < 3; ++e) ct[a][e] = ML_MFMA(kt[a], vw[e], ct[a][e]);
            }
#pragma unroll
            for (int a = 0; a < 2; ++a)
#pragma unroll
                for (int e = 0; e < 3; ++e) { u32x2 w; w.x = f2bf(ct[a][e][0]) | (f2bf(ct[a][e][1]) << 16); w.y = f2bf(ct[a][e][2]) | (f2bf(ct[a][e][3]) << 16);
                    *(LAS u32x2*)(CTs + (e * 16 + fr) * LQ + (2 * wid + a) * 16 + 4 * fq) = w; }
            ML_BAR();
            if (c + 1 < 64) { ML_STORE(); }
            ML_BAR();
            if (c + 2 < 64) { ML_LOAD(c + 2); }
        }
#undef ML_LOAD
#undef ML_STORE
    }
}
}
}

struct EpiRes {
    static constexpr bool PERM = false, AFTER_DRAIN = false;
    const float* base; float* out; int ldc;
    __device__ __forceinline__ void operator()(const pg8::f32x4 (&acc)[2][2][4][2], const pg8::Unit& u, int wr, int wc, int fr, int fq) const {
#pragma unroll
        for (int ai = 0; ai < 2; ++ai)
#pragma unroll
            for (int m = 0; m < 4; ++m) { const size_t ro = (size_t)(u.pm * 256 + ai * 128 + wr * 64 + m * 16 + fr) * ldc + u.pn * 256 + wc * 32 + 4 * fq;
#pragma unroll
                for (int bj = 0; bj < 2; ++bj)
#pragma unroll
                    for (int n = 0; n < 2; ++n) { const size_t off = ro + bj * 128 + n * 16; const pg8::f32x4 bs = *(const pg8::f32x4*)(base + off); *(pg8::f32x4*)(out + off) = bs + acc[ai][bj][m][n]; } }
    }
};

#define ROR1(x) __int_as_float(__builtin_amdgcn_update_dpp(0, __float_as_int(x), 0x121, 0xF, 0xF, false))
#define ROL1(x) __int_as_float(__builtin_amdgcn_update_dpp(0, __float_as_int(x), 0x12F, 0xF, 0xF, false))
struct EpiConv {
    static constexpr bool PERM = true, AFTER_DRAIN = false;
    unsigned short* ACT; unsigned short* HALO; const float* cw; const float* cb;
    __device__ __forceinline__ void operator()(const pg8::f32x4 (&acc)[2][2][4][2], const pg8::Unit& u, int wr, int wc, int fr, int fq) const {
        using mk::FF; using mk::FF2;
        const int jb = u.pn * 128 + wc * 32 + 8 * fq;
        mk::u32x2 keep[2][4];
#pragma unroll
        for (int n = 0; n < 2; ++n) {
            const int j = jb + 4 * n;
            const pg8::f32x4 c0g = *(const pg8::f32x4*)(cw + j), c1g = *(const pg8::f32x4*)(cw + FF2 + j), c2g = *(const pg8::f32x4*)(cw + 2 * FF2 + j), cbg = *(const pg8::f32x4*)(cb + j);
            const pg8::f32x4 c0v = *(const pg8::f32x4*)(cw + FF + j), c1v = *(const pg8::f32x4*)(cw + FF2 + FF + j), c2v = *(const pg8::f32x4*)(cw + 2 * FF2 + FF + j), cbv = *(const pg8::f32x4*)(cb + FF + j);
#pragma unroll
            for (int ai = 0; ai < 2; ++ai) {
                float gRp[4], vRp[4], gLc[4], vLc[4];
#pragma unroll
                for (int i = 0; i < 4; ++i) { gLc[i] = ROL1(acc[ai][0][0][n][i]); vLc[i] = ROL1(acc[ai][1][0][n][i]); gRp[i] = 0.f; vRp[i] = 0.f; }
#pragma unroll
                for (int m = 0; m < 4; ++m) {
                    const int row = u.pm * 256 + ai * 128 + wr * 64 + m * 16 + fr;
                    float o[4];
#pragma unroll
                    for (int i = 0; i < 4; ++i) {
                        const float g = acc[ai][0][m][n][i], v = acc[ai][1][m][n][i];
                        const float gRc = ROR1(g), vRc = ROR1(v);
                        float gLn = 0.f, vLn = 0.f; if (m < 3) { gLn = ROL1(acc[ai][0][m + 1][n][i]); vLn = ROL1(acc[ai][1][m + 1][n][i]); }
                        float gu = gRc, vu = vRc, gd = gLc[i], vd = vLc[i];
                        if (m > 0) { if (fr == 0) { gu = gRp[i]; vu = vRp[i]; } }
                        if (m < 3) { if (fr == 15) { gd = gLn; vd = vLn; } }
                        gRp[i] = gRc; vRp[i] = vRc; gLc[i] = gLn; vLc[i] = vLn;
                        const float G = c0g[i] * gu + c1g[i] * g + c2g[i] * gd + cbg[i];
                        const float V = c0v[i] * vu + c1v[i] * v + c2v[i] * vd + cbv[i];
                        o[i] = G * __builtin_amdgcn_rcpf(1.0f + __expf(-G)) * V;
                    }
                    const bool edge = (m == 0 && fr == 0) || (m == 3 && fr == 15);
                    { mk::u32x2 w; w.x = mk::pk2(o[0], o[1]); w.y = mk::pk2(o[2], o[3]);
                      if (n == 0) keep[ai][m] = w;
                      else if (!edge) { mk::u32x4 w4; w4.x = keep[ai][m].x; w4.y = keep[ai][m].y; w4.z = w.x; w4.w = w.y; *(mk::u32x4*)(ACT + (size_t)row * FF + jb) = w4; } }
                    if ((m == 0 && fr < 2) || (m == 3 && fr > 13)) {
                        const int hr = (m == 0) ? fr : fr - 12;
                        unsigned short* hp = HALO + ((size_t)(row >> 6) * 4 + hr) * FF2 + j;
                        mk::u32x2 wg, wv; wg.x = mk::f2bf(acc[ai][0][m][n][0]) | (mk::f2bf(acc[ai][0][m][n][1]) << 16); wg.y = mk::f2bf(acc[ai][0][m][n][2]) | (mk::f2bf(acc[ai][0][m][n][3]) << 16);
                        wv.x = mk::f2bf(acc[ai][1][m][n][0]) | (mk::f2bf(acc[ai][1][m][n][1]) << 16); wv.y = mk::f2bf(acc[ai][1][m][n][2]) | (mk::f2bf(acc[ai][1][m][n][3]) << 16);
                        *(mk::u32x2*)hp = wg; *(mk::u32x2*)(hp + FF) = wv;
                    }
                }
            }
        }
    }
};

struct EpiBf16T {
    static constexpr bool PERM = true, AFTER_DRAIN = false;
    unsigned short* O; int ldc; int split_cols; float scale0; unsigned short* T; int tcol0; int ldt;
    __device__ __forceinline__ void operator()(const pg8::f32x4 (&acc)[2][2][4][2], const pg8::Unit& u, int wr, int wc, int fr, int fq) const {
        const int row0 = u.pm * 256 + wr * 64 + fr, colt = u.pn * 256, col0 = colt + wc * 32 + 8 * fq;
        const float sc = (colt < split_cols) ? scale0 : 1.f;
#pragma unroll
        for (int ai = 0; ai < 2; ++ai)
#pragma unroll
            for (int m = 0; m < 4; ++m) { unsigned short* rowp = O + (size_t)(row0 + ai * 128 + m * 16) * ldc + col0;
#pragma unroll
                for (int bj = 0; bj < 2; ++bj) { const pg8::f32x4 v0 = acc[ai][bj][m][0] * sc, v1 = acc[ai][bj][m][1] * sc;
                    mk::u32x4 w; w.x = mk::pk2(v0[0], v0[1]); w.y = mk::pk2(v0[2], v0[3]); w.z = mk::pk2(v1[0], v1[1]); w.w = mk::pk2(v1[2], v1[3]);
                    *(mk::u32x4*)(rowp + bj * 128) = w; } }
        if (colt >= tcol0) {
#pragma unroll
            for (int bj = 0; bj < 2; ++bj)
#pragma unroll
                for (int n = 0; n < 2; ++n)
#pragma unroll
                    for (int i = 0; i < 4; ++i) { unsigned short* tp = T + (size_t)(col0 - tcol0 + bj * 128 + 4 * n + i) * ldt + row0;
#pragma unroll
                        for (int ai = 0; ai < 2; ++ai)
#pragma unroll
                            for (int m = 0; m < 4; ++m) tp[ai * 128 + m * 16] = (unsigned short)mk::f2bf(acc[ai][bj][m][n][i]); }
        }
    }
};

struct GemmDesc { const unsigned short* A; const unsigned short* Bt; int Mg, Ng, Kg; int kind; unsigned short* O; int ldc; int split_cols; float scale0; const float* base; float* out; int G, c; };

#ifndef REPEAT_PH
#define REPEAT_PH 1000
#define N_REPEAT 0
#else
#define N_REPEAT 1
#endif
struct Params { const float* in[17]; float* out; unsigned char* ws; int ph_lo, ph_hi; };
constexpr int N_PHASES = 18;

__global__ void __launch_bounds__(512, 2) fwd_mega(Params p) {
    extern __shared__ __attribute__((aligned(16))) unsigned char lds_raw[];
    using namespace mk;
    cg::grid_group grid = cg::this_grid();
    LAS unsigned char* lds = (LAS unsigned char*)lds_raw;
    const int bid = blockIdx.x, nblk = gridDim.x;
    const int ph_lo = p.ph_lo, ph_hi = p.ph_hi;
    { volatile LAS unsigned* misc = (volatile LAS unsigned*)(lds + LDS_MISC); if (mk_tid() < 16) misc[mk_tid()] = 0u; }
    __syncthreads();
    (void)xcd_barrier_post((unsigned*)(p.ws + WS_BAR), (volatile LAS unsigned*)(lds + LDS_MISC) + 8);
    if (ph_lo < 0) grid.sync();
#ifdef PROBE_PH
    const unsigned long long t_start = __builtin_amdgcn_s_memrealtime();
#endif
#pragma unroll 1
    for (int ph_it = ph_lo; ph_it < ph_hi + N_REPEAT; ++ph_it) {
        const int ph = ph_it <= REPEAT_PH ? ph_it : ph_it - N_REPEAT;
        typedef const __attribute__((address_space(4))) Params* KP;
        KP kp = (KP)__builtin_amdgcn_kernarg_segment_ptr(); asm volatile("" : "+s"(kp));
        unsigned char* ws = kp->ws; float* OUT = kp->out; bf16* XN = (bf16*)(ws + WS_XN);
        In I; I.x = kp->in[0]; I.norm_mix = kp->in[1]; I.norm_ffn = kp->in[2]; I.w_in_ab = kp->in[3]; I.pool_w = kp->in[4]; I.pool_scale = kp->in[5]; I.q_norm = kp->in[6]; I.k_norm = kp->in[7];
        I.w_out_ab = kp->in[8]; I.w_in_c = kp->in[9]; I.b_gate = kp->in[10]; I.h_norm = kp->in[11]; I.w_out_c = kp->in[12]; I.w_up = kp->in[13]; I.conv_w = kp->in[14]; I.conv_b = kp->in[15]; I.w_down = kp->in[16];
        int nb_ = nblk; asm volatile("" : "+s"(nb_)); const int ngw = nb_ * NW, ngt = nb_ * 512;
        const int tid = mk_tid(), lane = tid & 63, wave = __builtin_amdgcn_readfirstlane(tid >> 6), gw = bid * NW + wave, gt = bid * 512 + tid;
#ifndef NO_THIN
        if (ph == 0) prologue(I, ws, lds, gw, ngw, wave, lane);
        if (ph == 5 || ph == 9 || ph == 14) rmsnorm_rows(OUT, ph == 5 ? I.norm_ffn : (ph == 9 ? I.norm_mix + D : I.norm_ffn + D), XN, gw, ngw, lane);
        if (ph == 2) qk_rope_pool((bf16*)(ws + WS_PROJ), I.q_norm, I.k_norm, (bf16*)(ws + WS_POOLED), gw, ngw, lane);
#endif
#ifndef NO_ATT
        if (ph == 3) {
            const bf16* PROJ = (const bf16*)(ws + WS_PROJ); bf16* CAT = (bf16*)(ws + WS_CAT);
            for (int u0 = bid; u0 < 384; u0 += nblk) {
                int u = u0;
                if (nblk == 256) { const int xcd = u0 & 7, j = (u0 >> 3) & 31, rnd = u0 >> 8; const int jj = j + 32 * rnd;
                    if (jj >= 48) continue; u = (xcd >> 2) * 192 + ((xcd & 3) * 3 + (jj >> 4)) * 16 + (jj & 15); }
                const int qb = u & 15, hq = (u >> 4) % 12, b = u / 192;
                const size_t r0 = (size_t)b * SEQ + (size_t)qb * 256;
                att::attn_dense_body<att::bf16>((const att::bf16*)(PROJ + r0 * ABW + 512 + hq * 128), (const att::bf16*)(PROJ + (size_t)b * SEQ * ABW + 2048 + (hq / 3) * 128),
                                                (const att::bf16*)(PROJ + (size_t)b * SEQ * ABW + 2560 + (hq / 3) * 128), CAT + r0 * D + 512 + hq * 128, SEQ, (char*)lds_raw);
                __syncthreads();
            }
        }
#endif
#ifndef NO_THIN
        if (ph == 7 || ph == 16) { const int l = ph == 7 ? 0 : 1; conv_fix((const bf16*)(ws + WS_U), I.conv_w + (size_t)l * 3 * FF2, I.conv_b + (size_t)l * FF2, (bf16*)(ws + WS_ACT), gt, ngt); }
        if (ph == 10) gates_phase(XN, (const bf16*)(ws + WS_C) + (size_t)8192 * D, I.b_gate, (float*)(ws + WS_GATES), (LAS float*)lds, bid, nblk);
#endif
#ifndef NO_ML
        if (ph == 11) ml::mlstm_phase(lds, (const bf16*)(ws + WS_QK), (const bf16*)(ws + WS_KVT), (const float*)(ws + WS_GATES), (bf16*)(ws + WS_HF), bid, nblk);
#endif
#ifndef NO_THIN
        if (ph == 12) headnorm_phase((const bf16*)(ws + WS_HF), (const bf16*)(ws + WS_OG), I.h_norm, (bf16*)(ws + WS_Y), gw, ngw, lane);
#endif
#pragma unroll 1
        for (int gi = 0; gi < 3; ++gi) {
            GemmDesc d; d.kind = -1; d.G = nblk; d.c = bid; d.split_cols = 0; d.scale0 = 1.f; d.base = nullptr; d.out = nullptr; d.O = nullptr; d.ldc = 0; d.A = nullptr; d.Bt = nullptr; d.Mg = M; d.Ng = 0; d.Kg = D;
            if (gi == 0) {
                if (ph == 1) { d.kind = 0; d.A = XN; d.Bt = (bf16*)(ws + WS_AB); d.Ng = ABW; d.O = (bf16*)(ws + WS_PROJ); d.ldc = ABW; }
                else if (ph == 3) { d.kind = 0; d.A = (bf16*)(ws + WS_POOLED); d.Bt = (bf16*)(ws + WS_BD); d.Ng = 512; d.Kg = 512; d.O = (bf16*)(ws + WS_CAT); d.ldc = D;
                    if (nblk == 256) { const int slot = bid >> 3; d.G = 64; d.c = (slot - 16) * 8 + (bid & 7); if (slot < 16 || slot >= 24) d.kind = -1; } }
                else if (ph == 4) { d.kind = 1; d.A = (bf16*)(ws + WS_CAT); d.Bt = (bf16*)(ws + WS_OAB); d.Ng = D; d.base = I.x; d.out = OUT; }
                else if (ph == 6 || ph == 15) { d.kind = 2; d.A = XN; d.Bt = (bf16*)(ws + (ph == 6 ? WS_UP0 : WS_UP1)); d.Ng = FF2; d.O = (bf16*)(ws + WS_U); d.ldc = FF2; d.base = I.conv_w + (size_t)(ph == 6 ? 0 : 1) * 3 * FF2; d.out = (float*)(I.conv_b + (size_t)(ph == 6 ? 0 : 1) * FF2); }
                else if (ph == 8 || ph == 17) { d.kind = 1; d.A = (bf16*)(ws + WS_ACT); d.Bt = (bf16*)(ws + (ph == 8 ? WS_DN0 : WS_DN1)); d.Ng = D; d.Kg = FF; d.base = OUT; d.out = OUT; }
                else if (ph == 10) { d.kind = 3; d.A = XN; d.Bt = (bf16*)(ws + WS_C); d.Ng = 4096; d.O = (bf16*)(ws + WS_QK); d.ldc = 4096; d.split_cols = 2048; d.scale0 = 0.0625f; }
                else if (ph == 13) { d.kind = 1; d.A = (bf16*)(ws + WS_Y); d.Bt = (bf16*)(ws + WS_OC); d.Ng = D; d.base = OUT; d.out = OUT; }
            } else if (ph == 10) {
                if (gi == 1) { d.kind = 0; d.A = XN; d.Bt = (bf16*)(ws + WS_C) + (size_t)6144 * D; d.Ng = D; d.O = (bf16*)(ws + WS_OG); d.ldc = D; }
                else { d.kind = 0; d.A = (bf16*)(ws + WS_C) + (size_t)4096 * D; d.Bt = XN; d.Mg = 2048; d.Ng = M; d.O = (bf16*)(ws + WS_KVT) + (size_t)2048 * M; d.ldc = M; }
            }
#ifndef NO_GEMM
            if (d.kind == 0) {
                pg8::Gemm g{d.A, d.Bt, d.Mg, d.Ng, d.Kg}; pg8::StaticOrder S; S.init(d.Mg, d.Ng, d.G, d.c);
                pg8::EpiBf16<0> E{d.O, d.ldc, nullptr, d.split_cols, (size_t)d.split_cols, d.scale0};
                pg8::gemm_phase<pg8::EpiBf16<0>, pg8::StaticOrder, true, true>(lds, g, S, E);
            } else if (d.kind == 3) {
                pg8::Gemm g{d.A, d.Bt, d.Mg, d.Ng, d.Kg}; pg8::StaticOrder S; S.init(d.Mg, d.Ng, d.G, d.c);
                EpiBf16T E{d.O, d.ldc, d.split_cols, d.scale0, (bf16*)(ws + WS_KVT), 2048, M};
                pg8::gemm_phase<EpiBf16T, pg8::StaticOrder, true, true>(lds, g, S, E);
            } else if (d.kind == 2) {
                pg8::Gemm g{d.A, d.Bt, d.Mg, d.Ng, d.Kg}; pg8::StaticOrder S; S.init(d.Mg, d.Ng, d.G, d.c);
                EpiConv E{(bf16*)(ws + WS_ACT), d.O, d.base, (const float*)d.out};
                pg8::gemm_phase<EpiConv, pg8::StaticOrder, true, true>(lds, g, S, E);
            } else if (d.kind == 1) {
                pg8::Gemm g{d.A, d.Bt, d.Mg, d.Ng, d.Kg}; pg8::StaticOrder S; S.init(d.Mg, d.Ng, d.G, d.c);
                EpiRes E{d.base, d.out, D};
                pg8::gemm_phase<EpiRes, pg8::StaticOrder, true, true>(lds, g, S, E);
            }
#endif
            __syncthreads();
        }
#ifndef NO_THIN
        if (nb_ == 256) {
            if (ph == 1 && bid >= 128) { const int w = (bid - 128) * NW + wave; transposes(I, ws, lds, 1536, 2560, w, 128 * NW, wave, lane); transposes(I, ws, lds, 18944, 24576, w, 128 * NW, wave, lane); }
            if (ph == 3 && (bid >> 3) >= 16) { const int w = (((bid >> 3) - 16) * 8 + (bid & 7)) * NW + wave; transposes(I, ws, lds, 2560, 13312, w, 128 * NW, wave, lane); }
            if (ph == 6 && bid >= 128) { const int w = (bid - 128) * NW + wave; transposes(I, ws, lds, 13312, 18944, w, 128 * NW, wave, lane); }
        } else if (ph == 1) transposes(I, ws, lds, 1536, 24576, gw, ngw, wave, lane);
#endif
        if (ph_it + 1 < ph_hi + N_REPEAT) { XcdBarrier xbar; xbar.bar = (unsigned*)(ws + WS_BAR); xbar.x = xb_xcc_id(); xbar.st = (volatile LAS unsigned*)(lds + LDS_MISC) + 8; xcd_barrier(xbar);
#ifdef SYNC2
            xcd_barrier(xbar);
#endif
        }
#ifdef PROBE_PH
        if (bid == 0 && tid == 0) { unsigned long long* ts = (unsigned long long*)(ws + WS_BD + 768 * 1024); ts[ph + 1] = __builtin_amdgcn_s_memrealtime(); if (ph == 0) ts[0] = t_start;
            if (ph + 1 == ph_hi) { OUT[0] = (float)(ts[PROBE_PH + 1] - ts[PROBE_PH]) * 0.01f; } }
#endif
    }
}

#ifndef MK_MULTI
#define MK_MULTI 0
#endif
extern "C" void kernel_launch(void* const* d_in, const int* in_sizes, int n_in, void* d_out, int out_size, void* d_ws, size_t ws_size, hipStream_t stream) {
    static int grid = 0;
    if (grid == 0) {
        if (n_in != 17 || out_size != mk::M * mk::D || ws_size < mk::WS_END) { fprintf(stderr, "kernel_launch: unexpected shapes n_in %d out %d ws %zu (need %zu)\n", n_in, out_size, ws_size, (size_t)mk::WS_END); grid = -1; return; }
        int dev = 0, cus = 0, per_cu = 0;
        (void)hipGetDevice(&dev); (void)hipDeviceGetAttribute(&cus, hipDeviceAttributeMultiprocessorCount, dev);
        if (hipFuncSetAttribute((const void*)fwd_mega, hipFuncAttributeMaxDynamicSharedMemorySize, mk::LDS_BYTES) != hipSuccess) { fprintf(stderr, "kernel_launch: hipFuncSetAttribute failed\n"); grid = -1; return; }
        if (hipOccupancyMaxActiveBlocksPerMultiprocessor(&per_cu, (const void*)fwd_mega, 512, mk::LDS_BYTES) != hipSuccess || per_cu < 1) { fprintf(stderr, "kernel_launch: occupancy query gave %d\n", per_cu); per_cu = 1; }
        (void)hipGetLastError();
        if (cus <= 0) cus = 256;
        grid = cus * per_cu; if (grid > 256) grid = 256;
        fprintf(stderr, "kernel_launch: cus %d per_cu %d grid %d\n", cus, per_cu, grid);
    }
    if (grid < 0) return;
    if (hipMemsetAsync((char*)d_ws + mk::WS_BAR, 0, mk::BAR_BYTES, stream) != hipSuccess) { fprintf(stderr, "kernel_launch: memset failed\n"); return; }
    Params p{};
    for (int i = 0; i < 17; ++i) p.in[i] = (const float*)d_in[i];
    p.out = (float*)d_out; p.ws = (unsigned char*)d_ws;
#if MK_MULTI
    for (int ph = 0; ph < N_PHASES; ++ph) { p.ph_lo = ph; p.ph_hi = ph + 1; hipLaunchKernelGGL(fwd_mega, dim3(grid), dim3(512), mk::LDS_BYTES, stream, p); }
#else
    p.ph_lo = 0; p.ph_hi = N_PHASES;
    void* args[] = {&p};
    const hipError_t e = hipLaunchCooperativeKernel((const void*)fwd_mega, dim3(grid), dim3(512), args, mk::LDS_BYTES, stream);
    if (e != hipSuccess) fprintf(stderr, "kernel_launch: cooperative launch failed: %s (grid %d)\n", hipGetErrorString(e), grid);
#endif
}
```

```cpp
#include <hip/hip_runtime.h>
#include <hip/hip_cooperative_groups.h>
#include <hip/hip_bf16.h>
#include <cstdio>
#include <cstdint>
#include <cmath>
namespace cg = cooperative_groups;
__device__ __forceinline__ int mk_tid();
namespace pg8 {
#define PG8_LAS __attribute__((address_space(3)))
typedef unsigned short bf16_t;
typedef short bf16x8 __attribute__((ext_vector_type(8)));
typedef float f32x4 __attribute__((ext_vector_type(4)));
typedef unsigned u32x4 __attribute__((ext_vector_type(4)));
constexpr int BM = 256, BK = 64, HALF = 128, HTB = HALF * BK * 2  , STAGE_BYTES = 8 * HTB, NXCD = 8, WGM = 8;

__host__ __device__ __forceinline__ int lds_byte(int r, int c) { const int st = (r >> 4) * 2 + (c >> 5), rr = r & 15, cc = c & 31, ob = rr * 64 + cc * 2; return st * 1024 + (ob ^ (((ob >> 9) & 1) << 5)); }
__host__ __device__ __forceinline__ void stage_rc(int b, int& R, int& C) { const int st = b / 1024, sb = b % 1024, swz = sb ^ (((sb >> 9) & 1) << 5); R = (st >> 1) * 16 + swz / 64; C = (st & 1) * 32 + (swz % 64) / 2; }
__host__ __device__ __forceinline__ int perm32(int rho) { const int n = rho >> 4, i = rho & 15; return 8 * (i >> 2) + 4 * n + (i & 3); }

struct Unit { int pm, pn; };
struct Gemm { const bf16_t* A; const bf16_t* Bt; int M, N, K; };

struct StaticOrder {
    int nM, nN, nwg, G, c;
    __host__ __device__ void init(int M, int N, int G_, int c_) { nM = M / BM; nN = N / BM; nwg = nM * nN; G = G_; c = c_; }
    __host__ __device__ bool next(int i, Unit& u) const {
        const long L = (long)i * G + c; if (L >= nwg) return false;
        int wgid = (int)L; { const int q = nwg / NXCD, r = nwg % NXCD, xcd = wgid % NXCD, off = wgid / NXCD; wgid = (xcd < r ? xcd * (q + 1) : r * (q + 1) + (xcd - r) * q) + off; }
        const int nig = WGM * nN, gid = wgid / nig, fm = gid * WGM, gsz = (nM - fm) < WGM ? (nM - fm) : WGM;
        u.pm = fm + ((wgid % nig) % gsz); u.pn = (wgid % nig) / gsz; return true;
    }
    __device__ __forceinline__ void a_ready(const Unit&) const {}
    __device__ __forceinline__ void done(const Unit&) const {}
};

__device__ __forceinline__ unsigned cvt_pk_bf16(float lo, float hi) { unsigned r; asm volatile("v_cvt_pk_bf16_f32 %0, %1, %2" : "=v"(r) : "v"(lo), "v"(hi)); return r; }
typedef float f32x2 __attribute__((ext_vector_type(2)));
__device__ __forceinline__ f32x2 gelu_pk(f32x2 v) {
    const f32x2 av = __builtin_elementwise_abs(v), d = av * 0.2316418882f + 1.0f;
    f32x2 t; t.x = __builtin_amdgcn_rcpf(d.x); t.y = __builtin_amdgcn_rcpf(d.y);
    f32x2 q = t * 0.5307027145f + (-0.7265760135f); q = q * t + 0.7107068705f; q = q * t + (-0.142248368f); q = q * t + 0.127414796f; q = q * t;
    const f32x2 s = (v * v) * (-0.72134752044f);
    f32x2 e; e.x = __builtin_amdgcn_exp2f(s.x); e.y = __builtin_amdgcn_exp2f(s.y);
    const f32x2 m = v * (q * e), r = v - m;
    f32x2 o; o.x = v.x < 0.f ? m.x : r.x; o.y = v.y < 0.f ? m.y : r.y; return o;
}

template <int ACT  > struct EpiBf16 {
    static constexpr bool PERM = true, AFTER_DRAIN = false; static_assert(ACT == 0 || ACT == 1, "EpiBf16: ACT is 0 (none) or 1 (gelu_pk)");
    bf16_t* O; int ldc; const float* bias; int split_cols; size_t split_stride; float scale0;
    __device__ __forceinline__ void operator()(const f32x4 (&acc)[2][2][4][2], const Unit& u, int wr, int wc, int fr, int fq) const {
        const int row0 = u.pm * BM + wr * 64 + fr; int colt = u.pn * BM; bf16_t* base = O;
        float sc = 1.f; if (split_cols) { const int t = colt / split_cols; base += (size_t)t * split_stride; colt -= t * split_cols; if (t == 0) sc = scale0; }
        const int col0 = colt + wc * 32 + 8 * fq, bcol0 = u.pn * BM + wc * 32 + 8 * fq;
        f32x4 bv[2][2];
#pragma unroll
        for (int bj = 0; bj < 2; ++bj)
#pragma unroll
            for (int n = 0; n < 2; ++n) bv[bj][n] = bias ? *(const f32x4*)(bias + bcol0 + bj * HALF + 4 * n) : (f32x4){0.f, 0.f, 0.f, 0.f};
#pragma unroll
        for (int ai = 0; ai < 2; ++ai)
#pragma unroll
            for (int m = 0; m < 4; ++m) { bf16_t* rowp = base + (size_t)(row0 + ai * HALF + m * 16) * ldc + col0;
#pragma unroll
                for (int bj = 0; bj < 2; ++bj) { f32x4 v0 = acc[ai][bj][m][0] + bv[bj][0], v1 = acc[ai][bj][m][1] + bv[bj][1];
                    if (ACT == 1) { f32x2 a = gelu_pk((f32x2){v0[0], v0[1]}), b = gelu_pk((f32x2){v0[2], v0[3]}), c = gelu_pk((f32x2){v1[0], v1[1]}), d = gelu_pk((f32x2){v1[2], v1[3]});
                        v0 = (f32x4){a.x, a.y, b.x, b.y}; v1 = (f32x4){c.x, c.y, d.x, d.y}; }
                    v0 = v0 * sc; v1 = v1 * sc; u32x4 w; w.x = cvt_pk_bf16(v0[0], v0[1]); w.y = cvt_pk_bf16(v0[2], v0[3]); w.z = cvt_pk_bf16(v1[0], v1[1]); w.w = cvt_pk_bf16(v1[2], v1[3]);
                    *(u32x4*)(rowp + bj * HALF) = w; } }
    }
};

template <class Epi, class Sched, bool ALIGN_EPI = false, bool SP2 = false>
__device__ __forceinline__ void gemm_phase(PG8_LAS unsigned char* lds, const Gemm g, const Sched& S, const Epi& E) {
    const int tid = mk_tid(), wid = __builtin_amdgcn_readfirstlane(tid >> 6), lane = tid & 63, wr = wid >> 2, wc = wid & 3, fr = lane & 15, fq = lane >> 4;
    const int K = g.K, nt = K / BK;
    unsigned voffA[2], voffB[2];
#pragma unroll
    for (int i = 0; i < 2; ++i) { int R, C; stage_rc(tid * 16 + i * 8192, R, C); const int Rb = Epi::PERM ? ((R & ~31) + perm32(R & 31)) : R;
        voffA[i] = (unsigned)(R * K + C) * 2u; voffB[i] = (unsigned)(Rb * K + C) * 2u; }
    const size_t kstep = (size_t)(BK * 2);
    const size_t hstep = (size_t)HALF * K * 2;
    const size_t tstep = 2 * hstep;
    const unsigned ldsw = (unsigned)wid * 1024u;
    const int aoff = lds_byte(wr * 64 + fr, fq * 8), boff = lds_byte(wc * 32 + fr, fq * 8);
#define PG8_SA(b, h) (((b) * 2 + (h)) * HTB)
#define PG8_SB(b, h) ((4 + (b) * 2 + (h)) * HTB)
#define PG8_STAGE(bufoff, gbase, voff) do { _Pragma("unroll") for (int _i = 0; _i < 2; ++_i) \
        __builtin_amdgcn_global_load_lds((const unsigned*)((const char*)(gbase) + (voff)[_i]), (PG8_LAS unsigned*)(lds + (bufoff) + ldsw + _i * 8192), 16, 0, 0); } while (0)
#define PG8_LDA(dst, b, h) do { _Pragma("unroll") for (int m = 0; m < 4; ++m) _Pragma("unroll") for (int k = 0; k < 2; ++k) dst[m][k] = *(const PG8_LAS bf16x8*)(lds + PG8_SA(b, h) + aoff + m * 2048 + k * 1024); } while (0)
#define PG8_LDB(dst, b, h) do { _Pragma("unroll") for (int n = 0; n < 2; ++n) _Pragma("unroll") for (int k = 0; k < 2; ++k) dst[n][k] = *(const PG8_LAS bf16x8*)(lds + PG8_SB(b, h) + boff + n * 2048 + k * 1024); } while (0)
#define PG8_MMA(ai, bj, At, Bt) do { __builtin_amdgcn_s_setprio(1); _Pragma("unroll") for (int m = 0; m < 4; ++m) _Pragma("unroll") for (int n = 0; n < 2; ++n) _Pragma("unroll") for (int k = 0; k < 2; ++k) \
        acc[ai][bj][m][n] = __builtin_amdgcn_mfma_f32_16x16x32_bf16(Bt[n][k], At[m][k], acc[ai][bj][m][n], 0, 0, 0); __builtin_amdgcn_s_setprio(0); } while (0)
#define PG8_WAIT_V(n) asm volatile("s_waitcnt vmcnt(" #n ")" ::: "memory")
#define PG8_WAIT_L(n) asm volatile("s_waitcnt lgkmcnt(" #n ")" ::: "memory")
#define PG8_BAR __builtin_amdgcn_s_barrier()
#define PG8_SCHED __builtin_amdgcn_sched_barrier(0)
    Unit cur, nxt; int ui = 0;
    if (!S.next(0, cur)) return;
    f32x4 acc[2][2][4][2];
#pragma unroll
    for (int a = 0; a < 2; ++a)
#pragma unroll
        for (int b = 0; b < 2; ++b)
#pragma unroll
            for (int m = 0; m < 4; ++m)
#pragma unroll
                for (int n = 0; n < 2; ++n) acc[a][b][m][n] = (f32x4){0.f, 0.f, 0.f, 0.f};
    bf16x8 At[4][2], B0[2][2], B1[2][2];
    const char* cA = (const char*)g.A + (size_t)cur.pm * tstep; const char* cB = (const char*)g.Bt + (size_t)cur.pn * tstep;
    S.a_ready(cur);
    if constexpr (SP2) {
        PG8_STAGE(PG8_SB(0, 0), cB, voffB); PG8_STAGE(PG8_SB(0, 1), cB + hstep, voffB); PG8_STAGE(PG8_SA(0, 0), cA, voffA); PG8_STAGE(PG8_SA(0, 1), cA + hstep, voffA);
        if (wr == 1) PG8_BAR;
        PG8_WAIT_V(2); PG8_BAR;
        PG8_STAGE(PG8_SB(1, 0), cB + kstep, voffB); PG8_STAGE(PG8_SA(1, 0), cA + kstep, voffA); PG8_STAGE(PG8_SB(1, 1), cB + hstep + kstep, voffB);
        PG8_WAIT_V(6); PG8_BAR;
    } else {
        PG8_STAGE(PG8_SB(0, 0), cB, voffB); PG8_STAGE(PG8_SA(0, 0), cA, voffA); PG8_STAGE(PG8_SB(0, 1), cB + hstep, voffB); PG8_STAGE(PG8_SA(0, 1), cA + hstep, voffA);
        if (wr == 1) PG8_BAR;
        PG8_WAIT_V(4); PG8_BAR;
        PG8_STAGE(PG8_SB(1, 0), cB + kstep, voffB); PG8_STAGE(PG8_SA(1, 0), cA + kstep, voffA); PG8_STAGE(PG8_SB(1, 1), cB + hstep + kstep, voffB);
        PG8_WAIT_V(6); PG8_BAR;
    }
    for (;;) {
        const bool has_next = S.next(ui + 1, nxt);
        const char* nA = has_next ? (const char*)g.A + (size_t)nxt.pm * tstep : cA; const char* nB = has_next ? (const char*)g.Bt + (size_t)nxt.pn * tstep : cB;
        for (int t = 0; t < nt; t += 2) {
            const bool last = (t == nt - 2);
            const char* a1 = cA + (size_t)(t + 1) * kstep;
            const char* a2 = last ? nA : cA + (size_t)(t + 2) * kstep; const char* b2 = last ? nB : cB + (size_t)(t + 2) * kstep;
            const char* a3 = a2 + kstep; const char* b3 = b2 + kstep;
            if (last && has_next) S.a_ready(nxt);
            if constexpr (SP2) {
            PG8_LDB(B0, 0, 0); PG8_LDB(B1, 0, 1); PG8_SCHED; PG8_LDA(At, 0, 0); PG8_STAGE(PG8_SA(1, 1), a1 + hstep, voffA);
            PG8_WAIT_V(8); PG8_WAIT_L(0); PG8_BAR; PG8_MMA(0, 0, At, B0); PG8_MMA(0, 1, At, B1); PG8_BAR; PG8_SCHED;
            PG8_LDA(At, 0, 1); PG8_STAGE(PG8_SB(0, 0), b2, voffB); PG8_STAGE(PG8_SB(0, 1), b2 + hstep, voffB); PG8_STAGE(PG8_SA(0, 0), a2, voffA);
            PG8_WAIT_V(8); PG8_WAIT_L(0); PG8_BAR; PG8_MMA(1, 0, At, B0); PG8_MMA(1, 1, At, B1); PG8_BAR; PG8_SCHED;
            PG8_LDB(B0, 1, 0); PG8_LDB(B1, 1, 1); PG8_SCHED; PG8_LDA(At, 1, 0); PG8_STAGE(PG8_SA(0, 1), a2 + hstep, voffA);
            PG8_WAIT_V(8); PG8_WAIT_L(0); PG8_BAR; PG8_MMA(0, 0, At, B0); PG8_MMA(0, 1, At, B1); PG8_BAR; PG8_SCHED;
            PG8_LDA(At, 1, 1); PG8_STAGE(PG8_SB(1, 0), b3, voffB); PG8_STAGE(PG8_SB(1, 1), b3 + hstep, voffB); PG8_STAGE(PG8_SA(1, 0), a3, voffA);
            PG8_WAIT_V(8); PG8_WAIT_L(0); PG8_BAR; PG8_MMA(1, 0, At, B0); PG8_MMA(1, 1, At, B1); PG8_BAR; PG8_SCHED;
            } else {
            PG8_LDB(B0, 0, 0); PG8_SCHED; PG8_LDA(At, 0, 0); PG8_STAGE(PG8_SA(1, 1), a1 + hstep, voffA);
            PG8_WAIT_L(8); PG8_BAR; PG8_WAIT_L(0); PG8_MMA(0, 0, At, B0); PG8_BAR; PG8_SCHED;
            PG8_LDB(B1, 0, 1); PG8_STAGE(PG8_SB(0, 0), b2, voffB);
            PG8_BAR; PG8_WAIT_L(0); PG8_MMA(0, 1, At, B1); PG8_BAR;
            PG8_LDA(At, 0, 1); PG8_STAGE(PG8_SA(0, 0), a2, voffA);
            PG8_BAR; PG8_WAIT_L(0); PG8_MMA(1, 0, At, B0); PG8_BAR; PG8_SCHED;
            PG8_STAGE(PG8_SB(0, 1), b2 + hstep, voffB);
            PG8_WAIT_V(6); PG8_BAR; PG8_MMA(1, 1, At, B1); PG8_BAR;
            PG8_LDB(B0, 1, 0); PG8_SCHED; PG8_LDA(At, 1, 0); PG8_STAGE(PG8_SA(0, 1), a2 + hstep, voffA);
            PG8_WAIT_L(8); PG8_BAR; PG8_WAIT_L(0); PG8_MMA(0, 0, At, B0); PG8_BAR; PG8_SCHED;
            PG8_LDB(B1, 1, 1); PG8_STAGE(PG8_SB(1, 0), b3, voffB);
            PG8_BAR; PG8_WAIT_L(0); PG8_MMA(0, 1, At, B1); PG8_BAR;
            PG8_LDA(At, 1, 1); PG8_STAGE(PG8_SA(1, 0), a3, voffA);
            PG8_BAR; PG8_WAIT_L(0); PG8_MMA(1, 0, At, B0); PG8_BAR; PG8_SCHED;
            PG8_STAGE(PG8_SB(1, 1), b3 + hstep, voffB);
            PG8_WAIT_V(6); PG8_BAR; PG8_MMA(1, 1, At, B1); PG8_BAR;
            }
        }
        if constexpr (ALIGN_EPI) { if (wr == 0) PG8_BAR; }
        if constexpr (!Epi::AFTER_DRAIN) { E(acc, cur, wr, wc, fr, fq); S.done(cur); }
        if (!has_next) break;
#pragma unroll
        for (int a = 0; a < 2; ++a)
#pragma unroll
            for (int b = 0; b < 2; ++b)
#pragma unroll
                for (int m = 0; m < 4; ++m)
#pragma unroll
                    for (int n = 0; n < 2; ++n) acc[a][b][m][n] = (f32x4){0.f, 0.f, 0.f, 0.f};
        cur = nxt; cA = nA; cB = nB; ++ui;
        if constexpr (ALIGN_EPI) { if (wr == 1) PG8_BAR; }
    }
    PG8_WAIT_V(0);
    if constexpr (!ALIGN_EPI) { if (wr == 0) PG8_BAR; }
    PG8_BAR;
    if constexpr (Epi::AFTER_DRAIN) { E.fused(acc, cur, wr, wc, fr, fq, lds, wid, lane); S.done(cur); }
#undef PG8_SA
#undef PG8_SB
#undef PG8_STAGE
#undef PG8_LDA
#undef PG8_LDB
#undef PG8_MMA
#undef PG8_WAIT_V
#undef PG8_WAIT_L
#undef PG8_BAR
#undef PG8_SCHED
}
}

namespace att {
using bf16 = __hip_bfloat16;
constexpr int   D = 128, NW = 8, QBLK = 32, KVBLK = 64;
constexpr float SCALE = 0.088388347648318440f;
constexpr float THR = 8.f;
constexpr int SDEPTH = 2;
constexpr int LDQ = 3072, LDK = 3072, LDO = 2048;
constexpr size_t SHM_V = KVBLK * D * 2, SHM_K = KVBLK * D * 2, SHM_ATTN = 2 * SHM_V + 2 * SHM_K + NW * 64 * 4;
using bf16x8 = __attribute__((ext_vector_type(8))) short;
using s16x4  = __attribute__((ext_vector_type(4))) short;
using f32x16 = __attribute__((ext_vector_type(16))) float;
using f32x8  = __attribute__((ext_vector_type(8))) float;
using u32x4  = __attribute__((ext_vector_type(4))) unsigned;
#define KSWZ(row, colB) ((row) * 256 + ((colB) ^ (((row) & 7) << 4)))
#define SBAR() __builtin_amdgcn_sched_barrier(0)
__device__ __forceinline__ int crow(int r, int hi) { return (r & 3) + 8 * (r >> 2) + 4 * hi; }
__device__ __forceinline__ unsigned cvtpk(float lo, float hi) {
  unsigned r; asm volatile("v_cvt_pk_bf16_f32 %0, %1, %2" : "=v"(r) : "v"(lo), "v"(hi)); return r;
}
template <typename TIn> struct Stage;
template <> struct Stage<bf16>  { using T = bf16x8;
  __device__ static __forceinline__ T ld8(const bf16* p) { return *reinterpret_cast<const bf16x8*>(p); }
  __device__ static __forceinline__ bf16x8 tobf(T x) { return x; } };
template <> struct Stage<float> { using T = f32x8;
  __device__ static __forceinline__ T ld8(const float* p) { return *reinterpret_cast<const f32x8*>(p); }
  __device__ static __forceinline__ bf16x8 tobf(T x) {
    u32x4 w = {cvtpk(x[0], x[1]), cvtpk(x[2], x[3]), cvtpk(x[4], x[5]), cvtpk(x[6], x[7])}; return *reinterpret_cast<bf16x8*>(&w); } };

__device__ __forceinline__ void partialSM(f32x16& p0, f32x16& p1, float& m_reg, float& mn, float& alpha) {
  constexpr float C = SCALE * 1.4426950408889634f;
  float pmax = p0[0]; for (int r = 1; r < 16; ++r) pmax = fmaxf(pmax, p0[r]); for (int r = 0; r < 16; ++r) pmax = fmaxf(pmax, p1[r]);
  { auto rr = __builtin_amdgcn_permlane32_swap(__float_as_uint(pmax), __float_as_uint(pmax), false, false);
    pmax = fmaxf(__uint_as_float(rr[0]), __uint_as_float(rr[1])); }
  if (__builtin_expect(__all(pmax - m_reg <= THR / SCALE), 1)) { mn = m_reg; alpha = 1.f; }
  else { mn = fmaxf(m_reg, pmax); alpha = __builtin_amdgcn_exp2f((m_reg - mn) * C); m_reg = mn; }
  float mnC = -mn * C;
  for (int r = 0; r < 16; ++r) p0[r] = fmaf(p0[r], C, mnC); for (int r = 0; r < 16; ++r) p1[r] = fmaf(p1[r], C, mnC);
  for (int r = 0; r < 16; ++r) p0[r] = __builtin_amdgcn_exp2f(p0[r]);
}
__device__ __forceinline__ void finishSM(f32x16& p0, f32x16& p1, float alpha, float& l_reg, bf16x8& pa0, bf16x8& pa1, bf16x8& pa2, bf16x8& pa3) {
  for (int r = 0; r < 16; ++r) p1[r] = __builtin_amdgcn_exp2f(p1[r]);
  float ps = 0; for (int r = 0; r < 16; ++r) ps += p0[r]; for (int r = 0; r < 16; ++r) ps += p1[r];
  { auto rr = __builtin_amdgcn_permlane32_swap(__float_as_uint(ps), __float_as_uint(ps), false, false);
    ps = __uint_as_float(rr[0]) + __uint_as_float(rr[1]); }
  l_reg = l_reg * alpha + ps;
#define PK4(P, BASE, OUT) do { unsigned a0 = cvtpk(P[BASE + 0], P[BASE + 1]), a1 = cvtpk(P[BASE + 2], P[BASE + 3]);   \
    unsigned b0 = cvtpk(P[BASE + 4], P[BASE + 5]), b1 = cvtpk(P[BASE + 6], P[BASE + 7]);                              \
    auto r0 = __builtin_amdgcn_permlane32_swap(a0, b0, false, false); auto r1 = __builtin_amdgcn_permlane32_swap(a1, b1, false, false); \
    u32x4 w = {r0[0], r1[0], r0[1], r1[1]}; OUT = *reinterpret_cast<bf16x8*>(&w); } while (0)
  PK4(p0, 0, pa0); PK4(p0, 8, pa1); PK4(p1, 0, pa2); PK4(p1, 8, pa3);
#undef PK4
}
__device__ __forceinline__ void qkt(f32x16& p0, f32x16& p1, const bf16* Ks, const bf16x8* qr, int r32, int hi) {
  p0 = f32x16{}; p1 = f32x16{};
  for (int d0 = 0; d0 < 8; ++d0) { int cb = (d0 * 16 + hi * 8) * 2;
    bf16x8 b0 = *reinterpret_cast<const bf16x8*>((const char*)Ks + KSWZ(r32, cb));
    bf16x8 b1 = *reinterpret_cast<const bf16x8*>((const char*)Ks + KSWZ(32 + r32, cb));
    p0 = __builtin_amdgcn_mfma_f32_32x32x16_bf16(b0, qr[d0], p0, 0, 0, 0);
    p1 = __builtin_amdgcn_mfma_f32_32x32x16_bf16(b1, qr[d0], p1, 0, 0, 0); }
}
__device__ __forceinline__ int v_st(int k, int c) { const int kk = (k & ~0xC) | ((k & 4) << 1) | ((k & 8) >> 1); return ((kk >> 3) * 4 + (c >> 5)) * 512 + ((kk & 7) * 32 + (c & 31)) * 2; }
__device__ __forceinline__ int v_rd_base(int lane) { return ((lane & 3) << 3) | (((lane >> 2) & 3) << 6) | (((lane >> 4) & 1) << 5) | (((lane >> 5) & 1) << 8); }
constexpr int v_rd_off(int d0, int ks, int half) { return d0 * 512 + ks * 4096 + half * 2048; }
template <int OFF> __device__ __forceinline__ s16x4 tr_read(int vb) {
  s16x4 r; asm volatile("ds_read_b64_tr_b16 %0, %1 offset:%2" : "=&v"(r) : "v"(vb), "i"(OFF) : "memory"); return r;
}
template <int D0> __device__ __forceinline__ void pv_one(f32x16& od, int vb, bf16x8 pa0, bf16x8 pa1, bf16x8 pa2, bf16x8 pa3) {
  const s16x4 l0 = tr_read<v_rd_off(D0, 0, 0)>(vb), h0 = tr_read<v_rd_off(D0, 0, 1)>(vb), l1 = tr_read<v_rd_off(D0, 1, 0)>(vb), h1 = tr_read<v_rd_off(D0, 1, 1)>(vb);
  const s16x4 l2 = tr_read<v_rd_off(D0, 2, 0)>(vb), h2 = tr_read<v_rd_off(D0, 2, 1)>(vb), l3 = tr_read<v_rd_off(D0, 3, 0)>(vb), h3 = tr_read<v_rd_off(D0, 3, 1)>(vb);
  asm volatile("s_waitcnt lgkmcnt(0)" ::: "memory"); SBAR();
#define PK(L, H) (bf16x8){L[0], L[1], L[2], L[3], H[0], H[1], H[2], H[3]}
  od = __builtin_amdgcn_mfma_f32_32x32x16_bf16(pa0, PK(l0, h0), od, 0, 0, 0);
  od = __builtin_amdgcn_mfma_f32_32x32x16_bf16(pa1, PK(l1, h1), od, 0, 0, 0);
  od = __builtin_amdgcn_mfma_f32_32x32x16_bf16(pa2, PK(l2, h2), od, 0, 0, 0);
  od = __builtin_amdgcn_mfma_f32_32x32x16_bf16(pa3, PK(l3, h3), od, 0, 0, 0);
#undef PK
}
__device__ __forceinline__ void pv_d0(f32x16* o, int vb, bf16x8 pa0, bf16x8 pa1, bf16x8 pa2, bf16x8 pa3) {
  pv_one<0>(o[0], vb, pa0, pa1, pa2, pa3); pv_one<1>(o[1], vb, pa0, pa1, pa2, pa3); pv_one<2>(o[2], vb, pa0, pa1, pa2, pa3); pv_one<3>(o[3], vb, pa0, pa1, pa2, pa3);
}

template <typename TQ>
__device__ __forceinline__ void attn_dense_body(const TQ* __restrict__ Qb, const bf16* __restrict__ Kh, const bf16* __restrict__ Vh,
                                                unsigned short* __restrict__ Ob, int seq, char* lds) {
  using St = Stage<bf16>; using SQ = Stage<TQ>;
  const int tid = mk_tid(), wid = tid >> 6, lane = tid & 63, r32 = lane & 31, hi = lane >> 5;
  bf16* V_lds = (bf16*)lds; bf16* K_lds = (bf16*)(lds + 2 * SHM_V);
  float* ws = (float*)(lds + 2 * SHM_V + 2 * SHM_K) + wid * 64; float* li_l = ws; float* al_l = ws + 32;
  float m_reg = -1e30f, l_reg = 0; f32x16 o[4] = {}; bf16x8 qr[8];
  const TQ* Qw = Qb + (long)(wid * QBLK + r32) * LDQ + hi * 8;
#pragma unroll
  for (int d0 = 0; d0 < 8; ++d0) qr[d0] = SQ::tobf(SQ::ld8(Qw + d0 * 16));
  const int sr = tid >> 4, sc = (tid & 15) * 8, vst0 = v_st(sr, sc), vst1 = v_st(32 + sr, sc);
  const int vb0 = (int)(uintptr_t)V_lds + v_rd_base(lane);
  struct { typename St::T vs0, vs1, ks0, ks1; } sr_[SDEPTH];
#define SLOAD(i, k0) do { sr_[i].vs0 = St::ld8(&Vh[(long)((k0) + sr) * LDK + sc]); sr_[i].vs1 = St::ld8(&Vh[(long)((k0) + 32 + sr) * LDK + sc]); \
    sr_[i].ks0 = St::ld8(&Kh[(long)((k0) + sr) * LDK + sc]); sr_[i].ks1 = St::ld8(&Kh[(long)((k0) + 32 + sr) * LDK + sc]); } while (0)
#define SWRITE(b, i) do { *(bf16x8*)((char*)V_lds + (b) * SHM_V + vst0) = St::tobf(sr_[i].vs0);          \
    *(bf16x8*)((char*)V_lds + (b) * SHM_V + vst1) = St::tobf(sr_[i].vs1); int kc = sc * 2;               \
    *(bf16x8*)((char*)K_lds + (b) * SHM_K + KSWZ(sr, kc)) = St::tobf(sr_[i].ks0);                       \
    *(bf16x8*)((char*)K_lds + (b) * SHM_K + KSWZ(32 + sr, kc)) = St::tobf(sr_[i].ks1); } while (0)
#define SWAIT() do { if constexpr (SDEPTH == 2) asm volatile("s_waitcnt vmcnt(4)" ::: "memory"); else asm volatile("s_waitcnt vmcnt(0)" ::: "memory"); } while (0)
#define RESC(a) do { if (__any((a) < 1.f)) { if (hi == 0) al_l[r32] = (a); asm volatile("s_waitcnt lgkmcnt(0)" ::: "memory"); \
    for (int d = 0; d < 4; ++d) for (int r = 0; r < 16; ++r) o[d][r] *= al_l[crow(r, hi)]; } } while (0)
  f32x16 pA0, pA1, pB0, pB1; float mnA, mnB, alA, alB; bf16x8 pa0, pa1, pa2, pa3; const int NT = seq / KVBLK;
  constexpr int SE = 0, SO = SDEPTH - 1;
  SLOAD(SE, 0); asm volatile("s_waitcnt vmcnt(0)" ::: "memory"); SWRITE(0, SE); __syncthreads();
  qkt(pA0, pA1, K_lds, qr, r32, hi); partialSM(pA0, pA1, m_reg, mnA, alA);
  SLOAD(SO, KVBLK); if constexpr (SDEPTH == 2) { if (2 < NT) SLOAD(SE, 2 * KVBLK); }
  SWAIT(); SWRITE(1, SO); __syncthreads();
  for (int j = 1; j + 1 < NT; j += 2) {
    SBAR(); qkt(pB0, pB1, (bf16*)((char*)K_lds + SHM_K), qr, r32, hi);
    finishSM(pA0, pA1, alA, l_reg, pa0, pa1, pa2, pa3); SBAR();
    SLOAD(SO, (j + SDEPTH) * KVBLK); SBAR();
    pv_d0(o, vb0, pa0, pa1, pa2, pa3); partialSM(pB0, pB1, m_reg, mnB, alB);
    __syncthreads(); SWAIT(); SWRITE(0, SE);
    RESC(alB); __syncthreads();
    SBAR(); qkt(pA0, pA1, K_lds, qr, r32, hi);
    finishSM(pB0, pB1, alB, l_reg, pa0, pa1, pa2, pa3); SBAR();
    if (SDEPTH == 1 || j + 3 < NT) SLOAD(SE, (j + 1 + SDEPTH) * KVBLK); SBAR();
    pv_d0(o, vb0 + (int)SHM_V, pa0, pa1, pa2, pa3); partialSM(pA0, pA1, m_reg, mnA, alA);
    __syncthreads(); SWAIT(); SWRITE(1, SO);
    RESC(alA); __syncthreads();
  }
  SBAR(); qkt(pB0, pB1, (bf16*)((char*)K_lds + SHM_K), qr, r32, hi);
  finishSM(pA0, pA1, alA, l_reg, pa0, pa1, pa2, pa3); SBAR();
  pv_d0(o, vb0, pa0, pa1, pa2, pa3); partialSM(pB0, pB1, m_reg, mnB, alB);
  __syncthreads(); RESC(alB);
  finishSM(pB0, pB1, alB, l_reg, pa0, pa1, pa2, pa3); SBAR();
  pv_d0(o, vb0 + (int)SHM_V, pa0, pa1, pa2, pa3);
  if (hi == 0) li_l[r32] = l_reg; asm volatile("s_waitcnt lgkmcnt(0)" ::: "memory");
  float rli[16];
#pragma unroll
  for (int r = 0; r < 16; ++r) rli[r] = __builtin_amdgcn_rcpf(li_l[crow(r, hi)]);
  unsigned short* Ow = Ob + (long)(wid * QBLK) * LDO;
#pragma unroll
  for (int r = 0; r < 16; ++r) { int orow = crow(r, hi);
    for (int d0 = 0; d0 < 4; ++d0) Ow[(long)orow * LDO + d0 * 32 + r32] = (unsigned short)(cvtpk(o[d0][r] * rli[r], 0.f) & 0xffffu); }
#undef SLOAD
#undef SWRITE
#undef SWAIT
#undef RESC
}

}
__device__ __forceinline__ int mk_tid() { int t = threadIdx.x; asm volatile("" : "+v"(t)); return t; }
namespace mk {
#define LAS __attribute__((address_space(3)))
typedef unsigned short bf16;
typedef short bf16x8 __attribute__((ext_vector_type(8)));
typedef float f32x4 __attribute__((ext_vector_type(4)));
typedef unsigned u32x4 __attribute__((ext_vector_type(4)));
typedef unsigned u32x2 __attribute__((ext_vector_type(2)));
#define XB_TMO      128
#define XB_XCNT(j)  (256  + 64 * (j))
#define XB_XSUB(j)  (1280 + 64 * (j))
#define XB_XGEN(j)  (2304 + 64 * (j))
#define XB_TOP      3328
#define XB_TOPGEN   3392
#define XCD_BAR_WORDS 3456
#define XB_SPIN_CAP (1u << 18)

__device__ __forceinline__ unsigned xb_ld(unsigned* p)              { return __hip_atomic_load(p, __ATOMIC_RELAXED, __HIP_MEMORY_SCOPE_AGENT); }
__device__ __forceinline__ unsigned xb_add(unsigned* p, unsigned v) { return __hip_atomic_fetch_add(p, v, __ATOMIC_RELAXED, __HIP_MEMORY_SCOPE_AGENT); }
__device__ __forceinline__ unsigned xb_xcc_id() { return (unsigned)__builtin_amdgcn_s_getreg((3 << 11) | 20) & 0xFu; }
#define XB_SPIN(cond, bar) do { unsigned _sp = 0; while (cond) { __builtin_amdgcn_s_sleep(1); \
    if ((++_sp & 255u) == 0u) { if (xb_ld(&(bar)[XB_TMO])) break; if (_sp > XB_SPIN_CAP) { atomicAdd(&(bar)[XB_TMO], 1u); break; } } } } while (0)

struct XcdBarrier {
    unsigned* bar; unsigned x;
    volatile LAS unsigned* st;
};

__device__ __forceinline__ XcdBarrier xcd_barrier_post(unsigned* bar, volatile LAS unsigned* st) {
    XcdBarrier b; b.bar = bar; b.x = xb_xcc_id(); b.st = st;
    if (mk_tid() == 0) (void)xb_add(&bar[XB_XCNT(b.x)], 1u);
    return b;
}
__device__ __forceinline__ void xcd_barrier_complete(unsigned* bar, unsigned x, unsigned& nloc, unsigned& nx) {
    const unsigned G = gridDim.x * gridDim.y * gridDim.z;
    unsigned sum, cnt, mine, sp = 0u;
    for (;;) {
        sum = 0u; cnt = 0u; mine = 0u;
#pragma unroll
        for (unsigned j = 0; j < 16; ++j) { const unsigned c = xb_ld(&bar[XB_XCNT(j)]); sum += c; cnt += (c > 0u) ? 1u : 0u; mine = (j == x) ? c : mine; }
        if (sum == G) break;
        __builtin_amdgcn_s_sleep(1);
        if ((++sp & 255u) == 0u) { if (xb_ld(&bar[XB_TMO])) break; if (sp > XB_SPIN_CAP) { atomicAdd(&bar[XB_TMO], 1u); break; } }
    }
    nloc = mine > 0u ? mine : 1u; nx = cnt > 0u ? cnt : 1u;
}

__device__ __forceinline__ void xcd_barrier(const XcdBarrier& b) {
    asm volatile("s_waitcnt vmcnt(0)" ::: "memory");
    __syncthreads();
    if (mk_tid() == 0) {
        unsigned* bar = b.bar;
        __builtin_amdgcn_s_waitcnt(0);
        unsigned nloc = b.st[0], nx = b.st[1];
        if (nloc == 0u) { xcd_barrier_complete(bar, b.x, nloc, nx); b.st[0] = nloc; b.st[1] = nx; }
        const unsigned old = xb_add(&bar[XB_XSUB(b.x)], 1u);
        const unsigned gen = old / nloc;
        if (old + 1u == (gen + 1u) * nloc) {
            __builtin_amdgcn_fence(__ATOMIC_RELEASE, "agent");
            asm volatile("s_waitcnt vmcnt(0)" ::: "memory");
            const unsigned og = xb_add(&bar[XB_TOP], 1u);
            const unsigned tg = og / nx;
            if (og + 1u == (tg + 1u) * nx) xb_add(&bar[XB_TOPGEN], 1u);
            else XB_SPIN(xb_ld(&bar[XB_TOPGEN]) == tg, bar);
            __builtin_amdgcn_fence(__ATOMIC_ACQUIRE, "agent");
            xb_add(&bar[XB_XGEN(b.x)], 1u);
            asm volatile("s_waitcnt vmcnt(0)" ::: "memory");
        } else {
            XB_SPIN(xb_ld(&bar[XB_XGEN(b.x)]) == gen, bar);
            __builtin_amdgcn_fence(__ATOMIC_ACQUIRE, "agent");
            asm volatile("s_waitcnt vmcnt(0)" ::: "memory");
        }
    }
    __syncthreads();
}


constexpr int D = 2048, M = 8192, SEQ = 4096, NW = 8;
constexpr int ABW = 3072, CW = 8224, FF2 = 11264, FF = 5632;
constexpr float EPS = 1e-6f;
constexpr size_t MiB = 1u << 20;
constexpr size_t WS_AB = 0, WS_BD = 12 * MiB, WS_OAB = 13 * MiB, WS_C = 21 * MiB  , WS_OC = 54 * MiB;
constexpr size_t WS_UP0 = 62 * MiB, WS_UP1 = 106 * MiB, WS_DN0 = 150 * MiB, WS_DN1 = 172 * MiB;
constexpr size_t WS_XN = 194 * MiB, WS_GATES = 226 * MiB, WS_S = 228 * MiB;
constexpr size_t WS_PROJ = WS_S, WS_POOLED = WS_S + 48 * MiB, WS_CAT = WS_S + 56 * MiB;
constexpr size_t WS_QK = WS_S, WS_OG = WS_S + 64 * MiB, WS_KVT = WS_S + 96 * MiB, WS_HF = WS_S + 160 * MiB, WS_Y = WS_S + 288 * MiB;
constexpr size_t WS_U = WS_S, WS_ACT = WS_S + 176 * MiB;
constexpr size_t WS_END = WS_S + 320 * MiB;
constexpr int LDS_ML = 154112 + 1024, LDS_MISC = LDS_ML, LDS_BYTES = LDS_ML + 64;
constexpr size_t WS_BAR = WS_BD + 768 * 1024, BAR_BYTES = 16384;

#define LDSWAIT() asm volatile("s_waitcnt lgkmcnt(0)" ::: "memory")
__device__ __forceinline__ unsigned f2bf(float f) { unsigned u = __float_as_uint(f); return (u + 0x7fffu + ((u >> 16) & 1u)) >> 16; }
__device__ __forceinline__ unsigned pk2(float lo, float hi) { unsigned r; asm volatile("v_cvt_pk_bf16_f32 %0, %1, %2" : "=v"(r) : "v"(lo), "v"(hi)); return r; }
__device__ __forceinline__ float bflo(unsigned w) { return __uint_as_float(w << 16); }
__device__ __forceinline__ float bfhi(unsigned w) { return __uint_as_float(w & 0xffff0000u); }
__device__ __forceinline__ float wave_sum(float v) {
#pragma unroll
    for (int o = 1; o < 64; o <<= 1) v += __shfl_xor(v, o);
    return v;
}

__device__ __forceinline__ void transpose_item64(const float* __restrict__ W, int ldw, int K, int nblk, bf16* __restrict__ WT, LAS float* scr, int item, int lane, bool upperm) {
    const int kb = item / nblk, nb = item - kb * nblk, k0 = 64 * kb, n0 = 64 * nb;
    const int d0 = !upperm ? n0 : (n0 < FF ? 256 * (n0 >> 7) + (n0 & 127) : 256 * ((n0 - FF) >> 7) + 128 + ((n0 - FF) & 127));
    f32x4 v[16];
#pragma unroll
    for (int i = 0; i < 16; ++i) { const int kk = 4 * i + (lane >> 4); v[i] = *(const f32x4*)(W + (size_t)(k0 + kk) * ldw + n0 + 4 * (lane & 15)); }
#pragma unroll
    for (int i = 0; i < 16; ++i) { const int kk = 4 * i + (lane >> 4); LAS float* s = scr + kk * 65 + 4 * (lane & 15); s[0] = v[i].x; s[1] = v[i].y; s[2] = v[i].z; s[3] = v[i].w; }
    LDSWAIT();
    const int c = lane & 7, q = lane >> 3;
#pragma unroll
    for (int j = 0; j < 8; ++j) { const int n = q + 8 * j; const LAS float* s = scr + (8 * c) * 65 + n;
        u32x4 o; o.x = pk2(s[0], s[65]); o.y = pk2(s[130], s[195]); o.z = pk2(s[260], s[325]); o.w = pk2(s[390], s[455]);
        *(u32x4*)(WT + (size_t)(d0 + n) * K + k0 + 8 * c) = o; }
    LDSWAIT();
}

__device__ __forceinline__ void rmsnorm_rows(const float* __restrict__ src, const float* __restrict__ gain, bf16* __restrict__ dst, int gw, int ngw, int lane) {
    f32x4 g[8];
#pragma unroll
    for (int j = 0; j < 8; ++j) g[j] = *(const f32x4*)(gain + 4 * lane + 256 * j);
    for (int m = gw; m < M; m += ngw) {
        const f32x4* xr = (const f32x4*)(src + (size_t)m * D) + lane; f32x4 v[8]; float s = 0.f;
#pragma unroll
        for (int j = 0; j < 8; ++j) { v[j] = xr[64 * j]; s += (v[j].x * v[j].x + v[j].y * v[j].y) + (v[j].z * v[j].z + v[j].w * v[j].w); }
        const float rstd = 1.0f / sqrtf(wave_sum(s) * (1.0f / D) + EPS);
        u32x2* o = (u32x2*)(dst + (size_t)m * D) + lane;
#pragma unroll
        for (int j = 0; j < 8; ++j) { u32x2 w; w.x = pk2(v[j].x * rstd * g[j].x, v[j].y * rstd * g[j].y); w.y = pk2(v[j].z * rstd * g[j].z, v[j].w * rstd * g[j].w); o[64 * j] = w; }
    }
}

struct In { const float *x, *norm_mix, *norm_ffn, *w_in_ab, *pool_w, *pool_scale, *q_norm, *k_norm, *w_out_ab, *w_in_c, *b_gate, *h_norm, *w_out_c, *w_up, *conv_w, *conv_b, *w_down; };

__device__ __forceinline__ void transposes(const In& I, unsigned char* ws, LAS unsigned char* lds, int first, int last, int w, int nw, int wave, int lane) {
    LAS float* scr = (LAS float*)(lds + wave * 16640);
    for (int it = first + w; it < last; it += nw) {
        const float* W; int ldw, K, nblk; bf16* WT; int r = it;
        if (r < 1536) { W = I.w_in_ab; ldw = ABW; K = D; nblk = 48; WT = (bf16*)(ws + WS_AB); }
        else if (r < 2560) { r -= 1536; W = I.w_out_ab; ldw = D; K = D; nblk = 32; WT = (bf16*)(ws + WS_OAB); }
        else if (r < 6656) { r -= 2560; W = I.w_in_c; ldw = CW; K = D; nblk = 128; WT = (bf16*)(ws + WS_C); }
        else if (r < 7680) { r -= 6656; W = I.w_out_c; ldw = D; K = D; nblk = 32; WT = (bf16*)(ws + WS_OC); }
        else if (r < 13312) { r -= 7680; W = I.w_up; ldw = FF2; K = D; nblk = 176; WT = (bf16*)(ws + WS_UP0); }
        else if (r < 18944) { r -= 13312; W = I.w_up + (size_t)D * FF2; ldw = FF2; K = D; nblk = 176; WT = (bf16*)(ws + WS_UP1); }
        else if (r < 21760) { r -= 18944; W = I.w_down; ldw = D; K = FF; nblk = 32; WT = (bf16*)(ws + WS_DN0); }
        else { r -= 21760; W = I.w_down + (size_t)FF * D; ldw = D; K = FF; nblk = 32; WT = (bf16*)(ws + WS_DN1); }
        transpose_item64(W, ldw, K, nblk, WT, scr, r, lane, (it >= 7680 && it < 18944));
    }
}
__device__ __forceinline__ void prologue(const In& I, unsigned char* ws, LAS unsigned char* lds, int gw, int ngw, int wave, int lane) {
    transposes(I, ws, lds, 0, 1536, gw, ngw, wave, lane);
    const int gt = gw * 64 + lane, ngt = ngw * 64;
    { bf16* WG = (bf16*)(ws + WS_C) + (size_t)8192 * D;
      for (int idx = gt; idx < 32 * D; idx += ngt) { const int j = idx >> 11, k = idx & 2047; WG[idx] = (bf16)f2bf(I.w_in_c[(size_t)k * CW + 8192 + j]); } }
    { bf16* BD = (bf16*)(ws + WS_BD);
      for (int idx = gt; idx < 512 * 512; idx += ngt) { const int n = idx >> 9, k = idx & 511, gn = n >> 7, gk = k >> 7;
          const float v = (gn == gk) ? I.pool_w[(size_t)(gn * 128 + (k & 127)) * 128 + (n & 127)] * I.pool_scale[n] : 0.f; BD[idx] = (bf16)f2bf(v); } }
    rmsnorm_rows(I.x, I.norm_mix, (bf16*)(ws + WS_XN), gw, ngw, lane);
}

__device__ __forceinline__ void qk_rope_pool(bf16* __restrict__ PROJ, const float* __restrict__ qn, const float* __restrict__ kn, bf16* __restrict__ POOLED, int gw, int ngw, int lane) {
    const int l = lane & 31, hsel = lane >> 5, part = (l >> 4) & 1; const bool first = (l & 8) == 0;
    float inv[4];
#pragma unroll
    for (int e = 0; e < 4; ++e) inv[e] = exp2f(-(float)(4 * (l & 7) + e) * (13.287712379549449f / 32.0f));
    const f32x4 gq = *(const f32x4*)(qn + 4 * l), gk = *(const f32x4*)(kn + 4 * l);
    for (int it0 = gw; it0 < M * 8; it0 += 4 * ngw) {
        u32x2 wv[4]; bf16* pp4[4]; int tt4[4], hh4[4]; bool ok[4];
#pragma unroll
        for (int k = 0; k < 4; ++k) { const int it = it0 + k * ngw; ok[k] = it < M * 8; const int itc = ok[k] ? it : gw; tt4[k] = itc >> 3; hh4[k] = (itc & 7) * 2 + hsel;
            pp4[k] = PROJ + (size_t)tt4[k] * ABW + 512 + hh4[k] * 128 + 4 * l; wv[k] = *(const u32x2*)pp4[k]; }
#pragma unroll
        for (int k = 0; k < 4; ++k) {
            const u32x2 w = wv[k]; const int t = tt4[k], hh = hh4[k];
            float x[4] = {bflo(w.x), bfhi(w.x), bflo(w.y), bfhi(w.y)};
            float ss = (x[0] * x[0] + x[1] * x[1]) + (x[2] * x[2] + x[3] * x[3]);
#pragma unroll
            for (int o = 1; o < 32; o <<= 1) ss += __shfl_xor(ss, o);
            const float rstd = 1.0f / sqrtf(ss * (1.0f / 128.0f) + EPS);
            const f32x4 g = (hh < 12) ? gq : gk;
            const int pos = t & (SEQ - 1); const float pp = part ? (float)(pos & 63) : (float)(pos >> 6);
            float y[4] = {x[0] * rstd * g.x, x[1] * rstd * g.y, x[2] * rstd * g.z, x[3] * rstd * g.w}, o4[4];
#pragma unroll
            for (int e = 0; e < 4; ++e) { const float yp = __shfl_xor(y[e], 8); const float ang = pp * inv[e]; const float sn = __sinf(ang), cs = __cosf(ang);
                o4[e] = y[e] * cs + (first ? -yp : yp) * sn; }
            u32x2 ow; ow.x = pk2(o4[0], o4[1]); ow.y = pk2(o4[2], o4[3]); if (ok[k]) *(u32x2*)pp4[k] = ow;
        }
    }
    const int gt = gw * 64 + lane, ngt = ngw * 64;
    for (int it = gt; it < M * 64; it += ngt) {
        const int t = it >> 6, c8 = (it & 63) * 8, g = c8 >> 7, w2 = 1 << g, pos = t & (SEQ - 1), base = t - pos;
        const int lo = max(pos - w2, 0), hi = min(pos + w2, SEQ);
        float acc[8] = {0.f, 0.f, 0.f, 0.f, 0.f, 0.f, 0.f, 0.f};
        u32x4 wv[16];
#pragma unroll
        for (int k = 0; k < 16; ++k) { const int pz = pos - w2 + k; const bool okk = (k < 2 * w2) && pz >= 0 && pz < SEQ; const u32x4 z = {0u, 0u, 0u, 0u};
            wv[k] = okk ? *(const u32x4*)(PROJ + (size_t)(base + pz) * ABW + c8) : z; }
#pragma unroll
        for (int k = 0; k < 16; ++k) { const u32x4 v = wv[k];
            acc[0] += bflo(v.x); acc[1] += bfhi(v.x); acc[2] += bflo(v.y); acc[3] += bfhi(v.y); acc[4] += bflo(v.z); acc[5] += bfhi(v.z); acc[6] += bflo(v.w); acc[7] += bfhi(v.w); }
        const u32x4 sv = *(const u32x4*)(PROJ + (size_t)t * ABW + c8); const float iv = 1.0f / (float)(hi - lo);
        u32x4 o; o.x = pk2(acc[0] * iv - bflo(sv.x), acc[1] * iv - bfhi(sv.x)); o.y = pk2(acc[2] * iv - bflo(sv.y), acc[3] * iv - bfhi(sv.y));
        o.z = pk2(acc[4] * iv - bflo(sv.z), acc[5] * iv - bfhi(sv.z)); o.w = pk2(acc[6] * iv - bflo(sv.w), acc[7] * iv - bfhi(sv.w));
        *(u32x4*)(POOLED + (size_t)t * 512 + c8) = o;
    }
}

__device__ __forceinline__ void conv_fix(const bf16* __restrict__ HALO, const float* __restrict__ cw, const float* __restrict__ cb, bf16* __restrict__ ACT, int gt, int ngt) {
    for (int it = gt; it < 256 * 704; it += ngt) {
        const int jc = it % 704, re = it / 704, blk = re >> 1, last = re & 1, j = jc * 8;
        const int t = blk * 64 + (last ? 63 : 0), pos = t & (SEQ - 1);
        const bf16* rc = HALO + ((size_t)blk * 4 + (last ? 3 : 0)) * FF2 + j;
        const bf16* ru = last ? rc - FF2 : HALO + ((size_t)(blk - 1) * 4 + 3) * FF2 + j;
        const bf16* rd = last ? HALO + ((size_t)(blk + 1) * 4) * FF2 + j : rc + FF2;
        const u32x4 z = {0u, 0u, 0u, 0u};
        const u32x4 g1 = *(const u32x4*)rc, v1 = *(const u32x4*)(rc + FF);
        const u32x4 g0 = pos > 0 ? *(const u32x4*)ru : z, v0 = pos > 0 ? *(const u32x4*)(ru + FF) : z;
        const u32x4 g2 = pos < SEQ - 1 ? *(const u32x4*)rd : z, v2 = pos < SEQ - 1 ? *(const u32x4*)(rd + FF) : z;
        float o[8];
#pragma unroll
        for (int q = 0; q < 4; ++q) {
            const int ja = j + 2 * q, jb = ja + 1;
            const float ga = cw[ja] * bflo(g0[q]) + cw[FF2 + ja] * bflo(g1[q]) + cw[2 * FF2 + ja] * bflo(g2[q]) + cb[ja];
            const float gb = cw[jb] * bfhi(g0[q]) + cw[FF2 + jb] * bfhi(g1[q]) + cw[2 * FF2 + jb] * bfhi(g2[q]) + cb[jb];
            const float va = cw[FF + ja] * bflo(v0[q]) + cw[FF2 + FF + ja] * bflo(v1[q]) + cw[2 * FF2 + FF + ja] * bflo(v2[q]) + cb[FF + ja];
            const float vb = cw[FF + jb] * bfhi(v0[q]) + cw[FF2 + FF + jb] * bfhi(v1[q]) + cw[2 * FF2 + FF + jb] * bfhi(v2[q]) + cb[FF + jb];
            o[2 * q] = ga / (1.0f + __expf(-ga)) * va; o[2 * q + 1] = gb / (1.0f + __expf(-gb)) * vb;
        }
        u32x4 ow; ow.x = pk2(o[0], o[1]); ow.y = pk2(o[2], o[3]); ow.z = pk2(o[4], o[5]); ow.w = pk2(o[6], o[7]);
        *(u32x4*)(ACT + (size_t)t * FF + j) = ow;
    }
}

__device__ __forceinline__ void gates_phase(const bf16* __restrict__ XN, const bf16* __restrict__ WG, const float* __restrict__ bg, float* __restrict__ GATES, LAS float* red, int bid, int nblk) {
    const int tid = mk_tid(), wid = tid >> 6, lane = tid & 63, fr = lane & 15, fq = lane >> 4;
    const int tile = wid & 3, tt = tile & 1, jt = tile >> 1, kh = wid >> 2;
    for (int grp = bid; grp < 256; grp += nblk) {
        f32x4 acc = {0.f, 0.f, 0.f, 0.f};
        const bf16* ap = WG + (size_t)(jt * 16 + fr) * D + kh * 1024 + fq * 8;
        const bf16* bp = XN + (size_t)(grp * 32 + tt * 16 + fr) * D + kh * 1024 + fq * 8;
#pragma unroll 8
        for (int ks = 0; ks < 32; ++ks) { const bf16x8 a = *(const bf16x8*)(ap + ks * 32), b = *(const bf16x8*)(bp + ks * 32); acc = __builtin_amdgcn_mfma_f32_16x16x32_bf16(a, b, acc, 0, 0, 0); }
        if (kh == 1) { LAS float* r = red + (tile * 64 + lane) * 4; r[0] = acc[0]; r[1] = acc[1]; r[2] = acc[2]; r[3] = acc[3]; }
        __syncthreads();
        if (kh == 0) { const LAS float* r = red + (tile * 64 + lane) * 4; const int t = grp * 32 + tt * 16 + fr, j = jt * 16 + 4 * fq;
            const f32x4 b4 = *(const f32x4*)(bg + j); f32x4 o; o.x = acc[0] + r[0] + b4.x; o.y = acc[1] + r[1] + b4.y; o.z = acc[2] + r[2] + b4.z; o.w = acc[3] + r[3] + b4.w;
            *(f32x4*)(GATES + (size_t)t * 32 + j) = o; }
        __syncthreads();
    }
}

__device__ __forceinline__ void headnorm_phase(const bf16* __restrict__ HF, const bf16* __restrict__ OG, const float* __restrict__ hn, bf16* __restrict__ Y, int gw, int ngw, int lane) {
    for (int it0 = gw; it0 < M * 8; it0 += 4 * ngw) {
        u32x2 a[4], b[4], ow[4]; f32x4 g[4]; size_t off[4]; bool ok[4];
#pragma unroll
        for (int k = 0; k < 4; ++k) { const int it = it0 + k * ngw; ok[k] = it < M * 8; const int itc = ok[k] ? it : gw; const int t = itc >> 3, h = itc & 7; off[k] = (size_t)t * D + h * 256 + 4 * lane;
            a[k] = *(const u32x2*)(HF + off[k]); b[k] = *(const u32x2*)(HF + (size_t)M * D + off[k]); ow[k] = *(const u32x2*)(OG + off[k]); g[k] = *(const f32x4*)(hn + h * 256 + 4 * lane); }
#pragma unroll
        for (int k = 0; k < 4; ++k) {
            f32x4 s; s.x = bflo(a[k].x) + bflo(b[k].x); s.y = bfhi(a[k].x) + bfhi(b[k].x); s.z = bflo(a[k].y) + bflo(b[k].y); s.w = bfhi(a[k].y) + bfhi(b[k].y);
            const float ss = wave_sum((s.x * s.x + s.y * s.y) + (s.z * s.z + s.w * s.w));
            const float rstd = 1.0f / sqrtf(ss * (1.0f / 256.0f) + EPS);
            const float o0 = bflo(ow[k].x), o1 = bfhi(ow[k].x), o2 = bflo(ow[k].y), o3 = bfhi(ow[k].y);
            u32x2 w; w.x = pk2(s.x * rstd * g[k].x * __builtin_amdgcn_rcpf(1.0f + __expf(-o0)), s.y * rstd * g[k].y * __builtin_amdgcn_rcpf(1.0f + __expf(-o1)));
            w.y = pk2(s.z * rstd * g[k].z * __builtin_amdgcn_rcpf(1.0f + __expf(-o2)), s.w * rstd * g[k].w * __builtin_amdgcn_rcpf(1.0f + __expf(-o3)));
            if (ok[k]) *(u32x2*)(Y + off[k]) = w;
        }
    }
}

namespace ml {
constexpr int LQ = 264, LS = 72;
constexpr int OFF_Q = 0, OFF_K = 33792, OFF_KT = 67584, OFF_VT = 104448, OFF_VTW = 111360, OFF_P = 118272, OFF_CT = 127488, OFF_SC = 152832;
static_assert(OFF_SC + 1280 + 1024 == LDS_ML, "mlstm lds map");
#define ML_BAR() do { asm volatile("s_waitcnt lgkmcnt(0)" ::: "memory"); __builtin_amdgcn_s_barrier(); asm volatile("" ::: "memory"); } while (0)
#define ML_DPP(old, src, ctrl, rmask) __int_as_float(__builtin_amdgcn_update_dpp(__float_as_int(old), __float_as_int(src), ctrl, rmask, 0xF, false))
#define ML_MFMA(a, b, c) __builtin_amdgcn_mfma_f32_16x16x32_bf16(a, b, c, 0, 0, 0)

__device__ __forceinline__ void mlstm_phase(LAS unsigned char* lds, const bf16* __restrict__ QK, const bf16* __restrict__ KVT, const float* __restrict__ GATES, bf16* __restrict__ HF, int bid, int nblk) {
    const int tid = mk_tid(), wid = tid >> 6, lane = tid & 63, fr = lane & 15, fq = lane >> 4;
    LAS bf16* Qs = (LAS bf16*)(lds + OFF_Q); LAS bf16* Ks = (LAS bf16*)(lds + OFF_K); LAS bf16* KTs = (LAS bf16*)(lds + OFF_KT);
    LAS bf16* VTs = (LAS bf16*)(lds + OFF_VT); LAS bf16* VTw = (LAS bf16*)(lds + OFF_VTW); LAS bf16* Ps = (LAS bf16*)(lds + OFF_P); LAS bf16* CTs = (LAS bf16*)(lds + OFF_CT);
    LAS float* sA = (LAS float*)(lds + OFF_SC); LAS float* sM = sA + 64; LAS float* sAI = sM + 64; LAS float* sEM = sAI + 64; LAS float* sWS = (LAS float*)(lds + OFF_SC + 1280);
    const int tt = wid & 3, sh = wid >> 2;
    for (int it0 = bid; it0 < 256; it0 += nblk) {
        const int item = (nblk == 256) ? (((it0 & 7) * 4 + (it0 >> 6)) * 8 + ((it0 >> 3) & 7)) : it0;
        const int es = item & 7, dir = (item >> 3) & 1, h = (item >> 4) & 7, b = (item >> 7) & 1;
        for (int i = tid; i < 48 * LQ / 2; i += 512) ((LAS unsigned*)CTs)[i] = 0u;
        for (int i = tid; i < 16 * LS; i += 512) { VTs[32 * LS + i] = (i < LS) ? (bf16)0x3F80 : (bf16)0; VTw[32 * LS + i] = (bf16)0; }
        f32x4 ct[2][3];
#pragma unroll
        for (int a = 0; a < 2; ++a)
#pragma unroll
            for (int e = 0; e < 3; ++e) ct[a][e] = (f32x4){0.f, 0.f, 0.f, 0.f};
        float m_st = 0.f, decay = 1.f;
        bf16x8 rq[4], rk[4], rkt[4], rvt = {0, 0, 0, 0, 0, 0, 0, 0}; float gi = 0.f, gf = 0.f;
        const unsigned voffQ = (unsigned)(((tid >> 5) * 4096 + (tid & 31) * 8) * 2), voffT = (unsigned)(((tid >> 3) * M + (tid & 7) * 8) * 2), voffG = (unsigned)((dir ? 63 - lane : lane) * 128);
#define ML_LOAD(c) do { const int ncn_ = dir ? 63 - (c) : (c); const size_t trow_ = (size_t)b * SEQ + (size_t)ncn_ * 64; \
        const char* qb_ = (const char*)(QK + trow_ * 4096 + h * 256); \
        _Pragma("unroll") for (int i_ = 0; i_ < 4; ++i_) { rq[i_] = *(const bf16x8*)(qb_ + (size_t)i_ * 131072 + voffQ); rk[i_] = *(const bf16x8*)(qb_ + 4096 + (size_t)i_ * 131072 + voffQ); } \
        const char* tb_ = (const char*)(KVT + (size_t)(h * 256) * M + trow_); \
        _Pragma("unroll") for (int i_ = 0; i_ < 4; ++i_) rkt[i_] = *(const bf16x8*)(tb_ + (size_t)i_ * (64 * M * 2) + voffT); \
        if (tid < 256) rvt = *(const bf16x8*)((const char*)(KVT + (size_t)(2048 + h * 256 + es * 32) * M + trow_) + voffT); \
        { const float* gp_ = GATES + trow_ * 32 + dir * 16 + h; gi = *(const float*)((const char*)gp_ + voffG); gf = *(const float*)((const char*)gp_ + 32 + voffG); } } while (0)
#define ML_STORE() do { \
        const float lf_ = fminf(gf, 0.f) - log1pf(__expf(-fabsf(gf))); float bc_ = lf_; \
        bc_ += ML_DPP(0.f, bc_, 0x111, 0xF); bc_ += ML_DPP(0.f, bc_, 0x112, 0xF); bc_ += ML_DPP(0.f, bc_, 0x114, 0xF); bc_ += ML_DPP(0.f, bc_, 0x118, 0xF); \
        bc_ += ML_DPP(0.f, bc_, 0x142, 0xA); bc_ += ML_DPP(0.f, bc_, 0x143, 0xC); \
        const float a_ = gi - bc_; float cm_ = a_; \
        cm_ = fmaxf(cm_, ML_DPP(-3.0e38f, cm_, 0x111, 0xF)); cm_ = fmaxf(cm_, ML_DPP(-3.0e38f, cm_, 0x112, 0xF)); cm_ = fmaxf(cm_, ML_DPP(-3.0e38f, cm_, 0x114, 0xF)); cm_ = fmaxf(cm_, ML_DPP(-3.0e38f, cm_, 0x118, 0xF)); \
        cm_ = fmaxf(cm_, ML_DPP(-3.0e38f, cm_, 0x142, 0xA)); cm_ = fmaxf(cm_, ML_DPP(-3.0e38f, cm_, 0x143, 0xC)); \
        const float Mv_ = fmaxf(m_st, cm_), blast_ = __shfl(bc_, 63), cml_ = __shfl(cm_, 63), Mn_ = fmaxf(m_st, cml_); \
        const float ai_ = __expf(m_st - Mv_), em_ = __expf(-(bc_ + Mv_)), wsv_ = __expf(a_ - Mn_); decay = __expf(m_st - Mn_); m_st = blast_ + Mn_; \
        const int rr_ = dir ? 63 - lane : lane; \
        if (wid == 0) { sA[rr_] = a_; sM[rr_] = Mv_; sAI[rr_] = ai_; sEM[rr_] = em_; VTw[32 * LS + rr_] = (bf16)f2bf(wsv_); } \
        _Pragma("unroll") for (int i_ = 0; i_ < 4; ++i_) { const int q_ = tid + 512 * i_, r_ = q_ >> 5, cc_ = (q_ & 31) * 8; \
            *(LAS bf16x8*)(Qs + r_ * LQ + cc_) = rq[i_]; *(LAS bf16x8*)(Ks + r_ * LQ + cc_) = rk[i_]; } \
        _Pragma("unroll") for (int i_ = 0; i_ < 4; ++i_) { const int q_ = tid + 512 * i_, d_ = q_ >> 3, cc_ = (q_ & 7) * 8; *(LAS bf16x8*)(KTs + d_ * LS + cc_) = rkt[i_]; } \
        if (tid < 256) { const int e_ = tid >> 3, cc_ = (tid & 7) * 8; *(LAS bf16x8*)(VTs + e_ * LS + cc_) = rvt; \
            LAS float* wsp_ = sWS + wid * 64; wsp_[rr_] = wsv_; asm volatile("s_waitcnt lgkmcnt(0)" ::: "memory"); \
            const f32x4 wa_ = *(const LAS f32x4*)(wsp_ + cc_), wb_ = *(const LAS f32x4*)(wsp_ + cc_ + 4); const float wv_[8] = {wa_.x, wa_.y, wa_.z, wa_.w, wb_.x, wb_.y, wb_.z, wb_.w}; \
            const u32x4 rv_ = __builtin_bit_cast(u32x4, rvt); u32x4 o_; \
            o_.x = pk2(bflo(rv_.x) * wv_[0], bfhi(rv_.x) * wv_[1]); o_.y = pk2(bflo(rv_.y) * wv_[2], bfhi(rv_.y) * wv_[3]); \
            o_.z = pk2(bflo(rv_.z) * wv_[4], bfhi(rv_.z) * wv_[5]); o_.w = pk2(bflo(rv_.w) * wv_[6], bfhi(rv_.w) * wv_[7]); \
            *(LAS u32x4*)(VTw + e_ * LS + cc_) = o_; } } while (0)
        ML_LOAD(0);
        ML_BAR();
        ML_STORE();
        ML_BAR();
        ML_LOAD(1);
        for (int c = 0; c < 64; ++c) {
            const int ncn = dir ? 63 - c : c; const size_t trow = (size_t)b * SEQ + (size_t)ncn * 64;
            const float dec_c = decay;
            f32x4 s0 = {0.f, 0.f, 0.f, 0.f}, s1 = s0, n3 = s0, d3 = s0;
            {
                const LAS bf16* qp = Qs + (tt * 16 + fr) * LQ + fq * 8;
                const LAS bf16* kp0 = Ks + ((2 * sh) * 16 + fr) * LQ + fq * 8; const LAS bf16* kp1 = kp0 + 16 * LQ;
                const LAS bf16* cp0 = CTs + (sh * 16 + fr) * LQ + fq * 8; const LAS bf16* cp2 = CTs + (32 + fr) * LQ + fq * 8;
#pragma unroll
                for (int hf = 0; hf < 4; ++hf) {
                    bf16x8 qf[2], k0[2], k1[2], c0[2], c2[2];
#pragma unroll
                    for (int k4 = 0; k4 < 2; ++k4) { const int ko = (hf * 2 + k4) * 32;
                        qf[k4] = *(const LAS bf16x8*)(qp + ko); k0[k4] = *(const LAS bf16x8*)(kp0 + ko); k1[k4] = *(const LAS bf16x8*)(kp1 + ko);
                        c0[k4] = *(const LAS bf16x8*)(cp0 + ko); c2[k4] = *(const LAS bf16x8*)(cp2 + ko); }
                    __builtin_amdgcn_sched_barrier(0);
#pragma unroll
                    for (int k4 = 0; k4 < 2; ++k4) { s0 = ML_MFMA(k0[k4], qf[k4], s0); s1 = ML_MFMA(k1[k4], qf[k4], s1); n3 = ML_MFMA(c0[k4], qf[k4], n3); d3 = ML_MFMA(c2[k4], qf[k4], d3); }
                }
            }
            const int t = tt * 16 + fr; const float Mt = sM[t];
            {
                const int sb0 = (2 * sh) * 16 + 4 * fq, sb1 = sb0 + 16;
                const f32x4 a0 = *(const LAS f32x4*)(sA + sb0), a1 = *(const LAS f32x4*)(sA + sb1);
                float p0[4], p1[4];
#pragma unroll
                for (int r = 0; r < 4; ++r) {
                    const int sa = sb0 + r, sbb = sb1 + r;
                    const bool ok0 = dir ? (sa >= t) : (sa <= t), ok1 = dir ? (sbb >= t) : (sbb <= t);
                    p0[r] = ok0 ? s0[r] * __expf(a0[r] - Mt) : 0.f; p1[r] = ok1 ? s1[r] * __expf(a1[r] - Mt) : 0.f;
                }
                u32x2 w0, w1; w0.x = pk2(p0[0], p0[1]); w0.y = pk2(p0[2], p0[3]); w1.x = pk2(p1[0], p1[1]); w1.y = pk2(p1[2], p1[3]);
                *(LAS u32x2*)(Ps + t * LS + sb0) = w0; *(LAS u32x2*)(Ps + t * LS + sb1) = w1;
            }
            ML_BAR();
            f32x4 n2 = {0.f, 0.f, 0.f, 0.f}, d2 = n2;
            {
                bf16x8 pf[2], v0[2], v2[2];
#pragma unroll
                for (int ks = 0; ks < 2; ++ks) { const int ko = ks * 32 + fq * 8;
                    pf[ks] = *(const LAS bf16x8*)(Ps + (tt * 16 + fr) * LS + ko); v0[ks] = *(const LAS bf16x8*)(VTs + (sh * 16 + fr) * LS + ko); v2[ks] = *(const LAS bf16x8*)(VTs + (32 + fr) * LS + ko); }
                __builtin_amdgcn_sched_barrier(0);
#pragma unroll
                for (int ks = 0; ks < 2; ++ks) { n2 = ML_MFMA(v0[ks], pf[ks], n2); d2 = ML_MFMA(v2[ks], pf[ks], d2); }
            }
            {
                const float ai = sAI[t], em = sEM[t];
                const float den0 = d2[0] + ai * d3[0];
                const float den = __shfl(den0, fr);
                const float rinv = 1.0f / fmaxf(fabsf(den), em);
                f32x4 hout; hout.x = (n2[0] + ai * n3[0]) * rinv; hout.y = (n2[1] + ai * n3[1]) * rinv; hout.z = (n2[2] + ai * n3[2]) * rinv; hout.w = (n2[3] + ai * n3[3]) * rinv;
                { u32x2 hw; hw.x = pk2(hout.x, hout.y); hw.y = pk2(hout.z, hout.w); *(u32x2*)(HF + ((size_t)dir * M + trow + t) * D + h * 256 + es * 32 + sh * 16 + 4 * fq) = hw; }
            }
#pragma unroll
            for (int a = 0; a < 2; ++a)
#pragma unroll
                for (int e = 0; e < 3; ++e) ct[a][e] = ct[a][e] * dec_c;
#pragma unroll
            for (int ks = 0; ks < 2; ++ks) { const int ko = ks * 32 + fq * 8; bf16x8 kt[2], vw[3];
#pragma unroll
                for (int a = 0; a < 2; ++a) kt[a] = *(const LAS bf16x8*)(KTs + ((2 * wid + a) * 16 + fr) * LS + ko);
#pragma unroll
                for (int e = 0; e < 3; ++e) vw[e] = *(const LAS bf16x8*)(VTw + (e * 16 + fr) * LS + ko);
                __builtin_amdgcn_sched_barrier(0);
#pragma unroll
                for (int a = 0; a < 2; ++a)
#pragma unroll
                    for (int e = 0; e < 3; ++e) ct[a][e] = ML_MFMA(kt[a], vw[e], ct[a][e]);
            }
#pragma unroll
            for (int a = 0; a < 2; ++a)
#pragma unroll
                for (int e = 0; e < 3; ++e) { u32x2 w; w.x = f2bf(ct[a][e][0]) | (f2bf(ct[a][e][1]) << 16); w.y = f2bf(ct[a][e][2]) | (f2bf(ct[a][e][3]) << 16);
                    *(LAS u32x2*)(CTs + (e * 16 + fr) * LQ + (2 * wid + a) * 16 + 4 * fq) = w; }
            ML_BAR();
            if (c + 1 < 64) { ML_STORE(); }
            ML_BAR();
            if (c + 2 < 64) { ML_LOAD(c + 2); }
        }
#undef ML_LOAD
#undef ML_STORE
    }
}
}
}

struct EpiRes {
    static constexpr bool PERM = false, AFTER_DRAIN = false;
    const float* base; float* out; int ldc;
    __device__ __forceinline__ void operator()(const pg8::f32x4 (&acc)[2][2][4][2], const pg8::Unit& u, int wr, int wc, int fr, int fq) const {
#pragma unroll
        for (int ai = 0; ai < 2; ++ai)
#pragma unroll
            for (int m = 0; m < 4; ++m) { const size_t ro = (size_t)(u.pm * 256 + ai * 128 + wr * 64 + m * 16 + fr) * ldc + u.pn * 256 + wc * 32 + 4 * fq;
#pragma unroll
                for (int bj = 0; bj < 2; ++bj)
#pragma unroll
                    for (int n = 0; n < 2; ++n) { const size_t off = ro + bj * 128 + n * 16; const pg8::f32x4 bs = *(const pg8::f32x4*)(base + off); *(pg8::f32x4*)(out + off) = bs + acc[ai][bj][m][n]; } }
    }
};

#define ROR1(x) __int_as_float(__builtin_amdgcn_update_dpp(0, __float_as_int(x), 0x121, 0xF, 0xF, false))
#define ROL1(x) __int_as_float(__builtin_amdgcn_update_dpp(0, __float_as_int(x), 0x12F, 0xF, 0xF, false))
struct EpiConv {
    static constexpr bool PERM = true, AFTER_DRAIN = false;
    unsigned short* ACT; unsigned short* HALO; const float* cw; const float* cb;
    __device__ __forceinline__ void operator()(const pg8::f32x4 (&acc)[2][2][4][2], const pg8::Unit& u, int wr, int wc, int fr, int fq) const {
        using mk::FF; using mk::FF2;
        const int jb = u.pn * 128 + wc * 32 + 8 * fq;
        mk::u32x2 keep[2][4];
        pg8::f32x4 cf[2][8];
#pragma unroll
        for (int n = 0; n < 2; ++n) { const int j = jb + 4 * n;
            cf[n][0] = *(const pg8::f32x4*)(cw + j); cf[n][1] = *(const pg8::f32x4*)(cw + FF2 + j); cf[n][2] = *(const pg8::f32x4*)(cw + 2 * FF2 + j); cf[n][3] = *(const pg8::f32x4*)(cb + j);
            cf[n][4] = *(const pg8::f32x4*)(cw + FF + j); cf[n][5] = *(const pg8::f32x4*)(cw + FF2 + FF + j); cf[n][6] = *(const pg8::f32x4*)(cw + 2 * FF2 + FF + j); cf[n][7] = *(const pg8::f32x4*)(cb + FF + j); }
#pragma unroll
        for (int n = 0; n < 2; ++n) {
            const int j = jb + 4 * n;
            const pg8::f32x4 c0g = cf[n][0], c1g = cf[n][1], c2g = cf[n][2], cbg = cf[n][3], c0v = cf[n][4], c1v = cf[n][5], c2v = cf[n][6], cbv = cf[n][7];
#pragma unroll
            for (int ai = 0; ai < 2; ++ai) {
                float gRp[4], vRp[4], gLc[4], vLc[4];
#pragma unroll
                for (int i = 0; i < 4; ++i) { gLc[i] = ROL1(acc[ai][0][0][n][i]); vLc[i] = ROL1(acc[ai][1][0][n][i]); gRp[i] = 0.f; vRp[i] = 0.f; }
#pragma unroll
                for (int m = 0; m < 4; ++m) {
                    const int row = u.pm * 256 + ai * 128 + wr * 64 + m * 16 + fr;
                    float o[4];
#pragma unroll
                    for (int i = 0; i < 4; ++i) {
                        const float g = acc[ai][0][m][n][i], v = acc[ai][1][m][n][i];
                        const float gRc = ROR1(g), vRc = ROR1(v);
                        float gLn = 0.f, vLn = 0.f; if (m < 3) { gLn = ROL1(acc[ai][0][m + 1][n][i]); vLn = ROL1(acc[ai][1][m + 1][n][i]); }
                        float gu = gRc, vu = vRc, gd = gLc[i], vd = vLc[i];
                        if (m > 0) { if (fr == 0) { gu = gRp[i]; vu = vRp[i]; } }
                        if (m < 3) { if (fr == 15) { gd = gLn; vd = vLn; } }
                        gRp[i] = gRc; vRp[i] = vRc; gLc[i] = gLn; vLc[i] = vLn;
                        const float G = c0g[i] * gu + c1g[i] * g + c2g[i] * gd + cbg[i];
                        const float V = c0v[i] * vu + c1v[i] * v + c2v[i] * vd + cbv[i];
                        o[i] = G * __builtin_amdgcn_rcpf(1.0f + __expf(-G)) * V;
                    }
                    const bool edge = (m == 0 && fr == 0) || (m == 3 && fr == 15);
                    { mk::u32x2 w; w.x = mk::pk2(o[0], o[1]); w.y = mk::pk2(o[2], o[3]);
                      if (n == 0) keep[ai][m] = w;
                      else if (!edge) { mk::u32x4 w4; w4.x = keep[ai][m].x; w4.y = keep[ai][m].y; w4.z = w.x; w4.w = w.y; *(mk::u32x4*)(ACT + (size_t)row * FF + jb) = w4; } }
                    if ((m == 0 && fr < 2) || (m == 3 && fr > 13)) {
                        const int hr = (m == 0) ? fr : fr - 12;
                        unsigned short* hp = HALO + ((size_t)(row >> 6) * 4 + hr) * FF2 + j;
                        mk::u32x2 wg, wv; wg.x = mk::f2bf(acc[ai][0][m][n][0]) | (mk::f2bf(acc[ai][0][m][n][1]) << 16); wg.y = mk::f2bf(acc[ai][0][m][n][2]) | (mk::f2bf(acc[ai][0][m][n][3]) << 16);
                        wv.x = mk::f2bf(acc[ai][1][m][n][0]) | (mk::f2bf(acc[ai][1][m][n][1]) << 16); wv.y = mk::f2bf(acc[ai][1][m][n][2]) | (mk::f2bf(acc[ai][1][m][n][3]) << 16);
                        *(mk::u32x2*)hp = wg; *(mk::u32x2*)(hp + FF) = wv;
                    }
                }
            }
        }
    }
};

struct EpiBf16T {
    static constexpr bool PERM = true, AFTER_DRAIN = false;
    unsigned short* O; int ldc; int split_cols; float scale0; unsigned short* T; int tcol0; int ldt;
    __device__ __forceinline__ void operator()(const pg8::f32x4 (&acc)[2][2][4][2], const pg8::Unit& u, int wr, int wc, int fr, int fq) const {
        const int row0 = u.pm * 256 + wr * 64 + fr, colt = u.pn * 256, col0 = colt + wc * 32 + 8 * fq;
        const float sc = (colt < split_cols) ? scale0 : 1.f;
#pragma unroll
        for (int ai = 0; ai < 2; ++ai)
#pragma unroll
            for (int m = 0; m < 4; ++m) { unsigned short* rowp = O + (size_t)(row0 + ai * 128 + m * 16) * ldc + col0;
#pragma unroll
                for (int bj = 0; bj < 2; ++bj) { const pg8::f32x4 v0 = acc[ai][bj][m][0] * sc, v1 = acc[ai][bj][m][1] * sc;
                    mk::u32x4 w; w.x = mk::pk2(v0[0], v0[1]); w.y = mk::pk2(v0[2], v0[3]); w.z = mk::pk2(v1[0], v1[1]); w.w = mk::pk2(v1[2], v1[3]);
                    *(mk::u32x4*)(rowp + bj * 128) = w; } }
        if (colt >= tcol0) {
#pragma unroll
            for (int bj = 0; bj < 2; ++bj)
#pragma unroll
                for (int n = 0; n < 2; ++n)
#pragma unroll
                    for (int i = 0; i < 4; ++i) { unsigned short* tp = T + (size_t)(col0 - tcol0 + bj * 128 + 4 * n + i) * ldt + row0;
#pragma unroll
                        for (int ai = 0; ai < 2; ++ai)
#pragma unroll
                            for (int m = 0; m < 4; ++m) tp[ai * 128 + m * 16] = (unsigned short)mk::f2bf(acc[ai][bj][m][n][i]); }
        }
    }
};

struct GemmDesc { const unsigned short* A; const unsigned short* Bt; int Mg, Ng, Kg; int kind; unsigned short* O; int ldc; int split_cols; float scale0; const float* base; float* out; int G, c; };

#ifndef REPEAT_PH
#define REPEAT_PH 1000
#define N_REPEAT 0
#else
#define N_REPEAT 1
#endif
struct Params { const float* in[17]; float* out; unsigned char* ws; int ph_lo, ph_hi; };
constexpr int N_PHASES = 18;

__global__ void __launch_bounds__(512, 2) fwd_mega(Params p) {
    extern __shared__ __attribute__((aligned(16))) unsigned char lds_raw[];
    using namespace mk;
    cg::grid_group grid = cg::this_grid();
    LAS unsigned char* lds = (LAS unsigned char*)lds_raw;
    const int bid = blockIdx.x, nblk = gridDim.x;
    const int ph_lo = p.ph_lo, ph_hi = p.ph_hi;
    { volatile LAS unsigned* misc = (volatile LAS unsigned*)(lds + LDS_MISC); if (mk_tid() < 16) misc[mk_tid()] = 0u; }
    __syncthreads();
    (void)xcd_barrier_post((unsigned*)(p.ws + WS_BAR), (volatile LAS unsigned*)(lds + LDS_MISC) + 8);
    if (ph_lo < 0) grid.sync();
#ifdef PROBE_PH
    const unsigned long long t_start = __builtin_amdgcn_s_memrealtime();
#endif
#pragma unroll 1
    for (int ph_it = ph_lo; ph_it < ph_hi + N_REPEAT; ++ph_it) {
        const int ph = ph_it <= REPEAT_PH ? ph_it : ph_it - N_REPEAT;
        typedef const __attribute__((address_space(4))) Params* KP;
        KP kp = (KP)__builtin_amdgcn_kernarg_segment_ptr(); asm volatile("" : "+s"(kp));
        unsigned char* ws = kp->ws; float* OUT = kp->out; bf16* XN = (bf16*)(ws + WS_XN);
        In I; I.x = kp->in[0]; I.norm_mix = kp->in[1]; I.norm_ffn = kp->in[2]; I.w_in_ab = kp->in[3]; I.pool_w = kp->in[4]; I.pool_scale = kp->in[5]; I.q_norm = kp->in[6]; I.k_norm = kp->in[7];
        I.w_out_ab = kp->in[8]; I.w_in_c = kp->in[9]; I.b_gate = kp->in[10]; I.h_norm = kp->in[11]; I.w_out_c = kp->in[12]; I.w_up = kp->in[13]; I.conv_w = kp->in[14]; I.conv_b = kp->in[15]; I.w_down = kp->in[16];
        int nb_ = nblk; asm volatile("" : "+s"(nb_)); const int ngw = nb_ * NW, ngt = nb_ * 512;
        const int tid = mk_tid(), lane = tid & 63, wave = __builtin_amdgcn_readfirstlane(tid >> 6), gw = bid * NW + wave, gt = bid * 512 + tid;
#ifndef NO_THIN
        if (ph == 0) prologue(I, ws, lds, gw, ngw, wave, lane);
        if (ph == 5 || ph == 9 || ph == 14) rmsnorm_rows(OUT, ph == 5 ? I.norm_ffn : (ph == 9 ? I.norm_mix + D : I.norm_ffn + D), XN, gw, ngw, lane);
        if (ph == 2) qk_rope_pool((bf16*)(ws + WS_PROJ), I.q_norm, I.k_norm, (bf16*)(ws + WS_POOLED), gw, ngw, lane);
#endif
#ifndef NO_ATT
        if (ph == 3) {
            const bf16* PROJ = (const bf16*)(ws + WS_PROJ); bf16* CAT = (bf16*)(ws + WS_CAT);
            for (int u0 = bid; u0 < 384; u0 += nblk) {
                int u = u0;
                if (nblk == 256) { const int xcd = u0 & 7, j = (u0 >> 3) & 31, rnd = u0 >> 8; const int jj = j + 32 * rnd;
                    if (jj >= 48) continue; u = (xcd >> 2) * 192 + ((xcd & 3) * 3 + (jj >> 4)) * 16 + (jj & 15); }
                const int qb = u & 15, hq = (u >> 4) % 12, b = u / 192;
                const size_t r0 = (size_t)b * SEQ + (size_t)qb * 256;
                att::attn_dense_body<att::bf16>((const att::bf16*)(PROJ + r0 * ABW + 512 + hq * 128), (const att::bf16*)(PROJ + (size_t)b * SEQ * ABW + 2048 + (hq / 3) * 128),
                                                (const att::bf16*)(PROJ + (size_t)b * SEQ * ABW + 2560 + (hq / 3) * 128), CAT + r0 * D + 512 + hq * 128, SEQ, (char*)lds_raw);
                __syncthreads();
            }
        }
#endif
#ifndef NO_THIN
        if (ph == 7 || ph == 16) { const int l = ph == 7 ? 0 : 1; conv_fix((const bf16*)(ws + WS_U), I.conv_w + (size_t)l * 3 * FF2, I.conv_b + (size_t)l * FF2, (bf16*)(ws + WS_ACT), gt, ngt); }
        if (ph == 10) gates_phase(XN, (const bf16*)(ws + WS_C) + (size_t)8192 * D, I.b_gate, (float*)(ws + WS_GATES), (LAS float*)lds, bid, nblk);
#endif
#ifndef NO_ML
        if (ph == 11) ml::mlstm_phase(lds, (const bf16*)(ws + WS_QK), (const bf16*)(ws + WS_KVT), (const float*)(ws + WS_GATES), (bf16*)(ws + WS_HF), bid, nblk);
#endif
#ifndef NO_THIN
        if (ph == 12) headnorm_phase((const bf16*)(ws + WS_HF), (const bf16*)(ws + WS_OG), I.h_norm, (bf16*)(ws + WS_Y), gw, ngw, lane);
#endif
#pragma unroll 1
        for (int gi = 0; gi < 3; ++gi) {
            GemmDesc d; d.kind = -1; d.G = nblk; d.c = bid; d.split_cols = 0; d.scale0 = 1.f; d.base = nullptr; d.out = nullptr; d.O = nullptr; d.ldc = 0; d.A = nullptr; d.Bt = nullptr; d.Mg = M; d.Ng = 0; d.Kg = D;
            if (gi == 0) {
                if (ph == 1) { d.kind = 0; d.A = XN; d.Bt = (bf16*)(ws + WS_AB); d.Ng = ABW; d.O = (bf16*)(ws + WS_PROJ); d.ldc = ABW; }
                else if (ph == 3) { d.kind = 0; d.A = (bf16*)(ws + WS_POOLED); d.Bt = (bf16*)(ws + WS_BD); d.Ng = 512; d.Kg = 512; d.O = (bf16*)(ws + WS_CAT); d.ldc = D;
                    if (nblk == 256) { const int slot = bid >> 3; d.G = 64; d.c = (slot - 16) * 8 + (bid & 7); if (slot < 16 || slot >= 24) d.kind = -1; } }
                else if (ph == 4) { d.kind = 1; d.A = (bf16*)(ws + WS_CAT); d.Bt = (bf16*)(ws + WS_OAB); d.Ng = D; d.base = I.x; d.out = OUT; }
                else if (ph == 6 || ph == 15) { d.kind = 2; d.A = XN; d.Bt = (bf16*)(ws + (ph == 6 ? WS_UP0 : WS_UP1)); d.Ng = FF2; d.O = (bf16*)(ws + WS_U); d.ldc = FF2; d.base = I.conv_w + (size_t)(ph == 6 ? 0 : 1) * 3 * FF2; d.out = (float*)(I.conv_b + (size_t)(ph == 6 ? 0 : 1) * FF2); }
                else if (ph == 8 || ph == 17) { d.kind = 1; d.A = (bf16*)(ws + WS_ACT); d.Bt = (bf16*)(ws + (ph == 8 ? WS_DN0 : WS_DN1)); d.Ng = D; d.Kg = FF; d.base = OUT; d.out = OUT; }
                else if (ph == 10) { d.kind = 3; d.A = XN; d.Bt = (bf16*)(ws + WS_C); d.Ng = 4096; d.O = (bf16*)(ws + WS_QK); d.ldc = 4096; d.split_cols = 2048; d.scale0 = 0.0625f; }
                else if (ph == 13) { d.kind = 1; d.A = (bf16*)(ws + WS_Y); d.Bt = (bf16*)(ws + WS_OC); d.Ng = D; d.base = OUT; d.out = OUT; }
            } else if (ph == 10) {
                if (gi == 1) { d.kind = 0; d.A = XN; d.Bt = (bf16*)(ws + WS_C) + (size_t)6144 * D; d.Ng = D; d.O = (bf16*)(ws + WS_OG); d.ldc = D; }
                else { d.kind = 0; d.A = (bf16*)(ws + WS_C) + (size_t)4096 * D; d.Bt = XN; d.Mg = 2048; d.Ng = M; d.O = (bf16*)(ws + WS_KVT) + (size_t)2048 * M; d.ldc = M; }
            }
#ifndef NO_GEMM
            if (d.kind == 0) {
                pg8::Gemm g{d.A, d.Bt, d.Mg, d.Ng, d.Kg}; pg8::StaticOrder S; S.init(d.Mg, d.Ng, d.G, d.c);
                pg8::EpiBf16<0> E{d.O, d.ldc, nullptr, d.split_cols, (size_t)d.split_cols, d.scale0};
                pg8::gemm_phase<pg8::EpiBf16<0>, pg8::StaticOrder, true, true>(lds, g, S, E);
            } else if (d.kind == 3) {
                pg8::Gemm g{d.A, d.Bt, d.Mg, d.Ng, d.Kg}; pg8::StaticOrder S; S.init(d.Mg, d.Ng, d.G, d.c);
                EpiBf16T E{d.O, d.ldc, d.split_cols, d.scale0, (bf16*)(ws + WS_KVT), 2048, M};
                pg8::gemm_phase<EpiBf16T, pg8::StaticOrder, true, true>(lds, g, S, E);
            } else if (d.kind == 2) {
                pg8::Gemm g{d.A, d.Bt, d.Mg, d.Ng, d.Kg}; pg8::StaticOrder S; S.init(d.Mg, d.Ng, d.G, d.c);
                EpiConv E{(bf16*)(ws + WS_ACT), d.O, d.base, (const float*)d.out};
                pg8::gemm_phase<EpiConv, pg8::StaticOrder, true, true>(lds, g, S, E);
            } else if (d.kind == 1) {
                pg8::Gemm g{d.A, d.Bt, d.Mg, d.Ng, d.Kg}; pg8::StaticOrder S; S.init(d.Mg, d.Ng, d.G, d.c);
                EpiRes E{d.base, d.out, D};
                pg8::gemm_phase<EpiRes, pg8::StaticOrder, true, true>(lds, g, S, E);
            }
#endif
            __syncthreads();
        }
#ifndef NO_THIN
        if (nb_ == 256) {
            if (ph == 1 && bid >= 128) { const int w = (bid - 128) * NW + wave; transposes(I, ws, lds, 1536, 2560, w, 128 * NW, wave, lane); transposes(I, ws, lds, 18944, 24576, w, 128 * NW, wave, lane); }
            if (ph == 3 && (bid >> 3) >= 16) { const int w = (((bid >> 3) - 16) * 8 + (bid & 7)) * NW + wave; transposes(I, ws, lds, 2560, 13312, w, 128 * NW, wave, lane); }
            if (ph == 6 && bid >= 128) { const int w = (bid - 128) * NW + wave; transposes(I, ws, lds, 13312, 18944, w, 128 * NW, wave, lane); }
        } else if (ph == 1) transposes(I, ws, lds, 1536, 24576, gw, ngw, wave, lane);
#endif
        if (ph_it + 1 < ph_hi + N_REPEAT) { XcdBarrier xbar; xbar.bar = (unsigned*)(ws + WS_BAR); xbar.x = xb_xcc_id(); xbar.st = (volatile LAS unsigned*)(lds + LDS_MISC) + 8; xcd_barrier(xbar);
#ifdef SYNC2
            xcd_barrier(xbar);
#endif
        }
#ifdef PROBE_PH
        if (bid == 0 && tid == 0) { unsigned long long* ts = (unsigned long long*)(ws + WS_BD + 768 * 1024); ts[ph + 1] = __builtin_amdgcn_s_memrealtime(); if (ph == 0) ts[0] = t_start;
            if (ph + 1 == ph_hi) { OUT[0] = (float)(ts[PROBE_PH + 1] - ts[PROBE_PH]) * 0.01f; } }
#endif
    }
}

#ifndef MK_MULTI
#define MK_MULTI 0
#endif
extern "C" void kernel_launch(void* const* d_in, const int* in_sizes, int n_in, void* d_out, int out_size, void* d_ws, size_t ws_size, hipStream_t stream) {
    static int grid = 0;
    if (grid == 0) {
        if (n_in != 17 || out_size != mk::M * mk::D || ws_size < mk::WS_END) { fprintf(stderr, "kernel_launch: unexpected shapes n_in %d out %d ws %zu (need %zu)\n", n_in, out_size, ws_size, (size_t)mk::WS_END); grid = -1; return; }
        int dev = 0, cus = 0, per_cu = 0;
        (void)hipGetDevice(&dev); (void)hipDeviceGetAttribute(&cus, hipDeviceAttributeMultiprocessorCount, dev);
        if (hipFuncSetAttribute((const void*)fwd_mega, hipFuncAttributeMaxDynamicSharedMemorySize, mk::LDS_BYTES) != hipSuccess) { fprintf(stderr, "kernel_launch: hipFuncSetAttribute failed\n"); grid = -1; return; }
        if (hipOccupancyMaxActiveBlocksPerMultiprocessor(&per_cu, (const void*)fwd_mega, 512, mk::LDS_BYTES) != hipSuccess || per_cu < 1) { fprintf(stderr, "kernel_launch: occupancy query gave %d\n", per_cu); per_cu = 1; }
        (void)hipGetLastError();
        if (cus <= 0) cus = 256;
        grid = cus * per_cu; if (grid > 256) grid = 256;
        fprintf(stderr, "kernel_launch: cus %d per_cu %d grid %d\n", cus, per_cu, grid);
    }
    if (grid < 0) return;
    if (hipMemsetAsync((char*)d_ws + mk::WS_BAR, 0, mk::BAR_BYTES, stream) != hipSuccess) { fprintf(stderr, "kernel_launch: memset failed\n"); return; }
    Params p{};
    for (int i = 0; i < 17; ++i) p.in[i] = (const float*)d_in[i];
    p.out = (float*)d_out; p.ws = (unsigned char*)d_ws;
#if MK_MULTI
    for (int ph = 0; ph < N_PHASES; ++ph) { p.ph_lo = ph; p.ph_hi = ph + 1; hipLaunchKernelGGL(fwd_mega, dim3(grid), dim3(512), mk::LDS_BYTES, stream, p); }
#else
    p.ph_lo = 0; p.ph_hi = N_PHASES;
    void* args[] = {&p};
    const hipError_t e = hipLaunchCooperativeKernel((const void*)fwd_mega, dim3(grid), dim3(512), args, mk::LDS_BYTES, stream);
    if (e != hipSuccess) fprintf(stderr, "kernel_launch: cooperative launch failed: %s (grid %d)\n", hipGetErrorString(e), grid);
#endif
}
```

```cpp
#include <hip/hip_runtime.h>
#include <hip/hip_cooperative_groups.h>
#include <hip/hip_bf16.h>
#include <cstdio>
#include <cstdint>
#include <cmath>
namespace cg = cooperative_groups;
__device__ __forceinline__ int mk_tid();
namespace pg8 {
#define PG8_LAS __attribute__((address_space(3)))
typedef unsigned short bf16_t;
typedef short bf16x8 __attribute__((ext_vector_type(8)));
typedef float f32x4 __attribute__((ext_vector_type(4)));
typedef unsigned u32x4 __attribute__((ext_vector_type(4)));
constexpr int BM = 256, BK = 64, HALF = 128, HTB = HALF * BK * 2  , STAGE_BYTES = 8 * HTB, NXCD = 8, WGM = 8;

__host__ __device__ __forceinline__ int lds_byte(int r, int c) { const int st = (r >> 4) * 2 + (c >> 5), rr = r & 15, cc = c & 31, ob = rr * 64 + cc * 2; return st * 1024 + (ob ^ (((ob >> 9) & 1) << 5)); }
__host__ __device__ __forceinline__ void stage_rc(int b, int& R, int& C) { const int st = b / 1024, sb = b % 1024, swz = sb ^ (((sb >> 9) & 1) << 5); R = (st >> 1) * 16 + swz / 64; C = (st & 1) * 32 + (swz % 64) / 2; }
__host__ __device__ __forceinline__ int perm32(int rho) { const int n = rho >> 4, i = rho & 15; return 8 * (i >> 2) + 4 * n + (i & 3); }

struct Unit { int pm, pn; };
struct Gemm { const bf16_t* A; const bf16_t* Bt; int M, N, K; };

struct StaticOrder {
    int nM, nN, nwg, G, c;
    __host__ __device__ void init(int M, int N, int G_, int c_) { nM = M / BM; nN = N / BM; nwg = nM * nN; G = G_; c = c_; }
    __host__ __device__ bool next(int i, Unit& u) const {
        const long L = (long)i * G + c; if (L >= nwg) return false;
        int wgid = (int)L; { const int q = nwg / NXCD, r = nwg % NXCD, xcd = wgid % NXCD, off = wgid / NXCD; wgid = (xcd < r ? xcd * (q + 1) : r * (q + 1) + (xcd - r) * q) + off; }
        const int nig = WGM * nN, gid = wgid / nig, fm = gid * WGM, gsz = (nM - fm) < WGM ? (nM - fm) : WGM;
        u.pm = fm + ((wgid % nig) % gsz); u.pn = (wgid % nig) / gsz; return true;
    }
    __device__ __forceinline__ void a_ready(const Unit&) const {}
    __device__ __forceinline__ void done(const Unit&) const {}
};

__device__ __forceinline__ unsigned cvt_pk_bf16(float lo, float hi) { unsigned r; asm volatile("v_cvt_pk_bf16_f32 %0, %1, %2" : "=v"(r) : "v"(lo), "v"(hi)); return r; }
typedef float f32x2 __attribute__((ext_vector_type(2)));
__device__ __forceinline__ f32x2 gelu_pk(f32x2 v) {
    const f32x2 av = __builtin_elementwise_abs(v), d = av * 0.2316418882f + 1.0f;
    f32x2 t; t.x = __builtin_amdgcn_rcpf(d.x); t.y = __builtin_amdgcn_rcpf(d.y);
    f32x2 q = t * 0.5307027145f + (-0.7265760135f); q = q * t + 0.7107068705f; q = q * t + (-0.142248368f); q = q * t + 0.127414796f; q = q * t;
    const f32x2 s = (v * v) * (-0.72134752044f);
    f32x2 e; e.x = __builtin_amdgcn_exp2f(s.x); e.y = __builtin_amdgcn_exp2f(s.y);
    const f32x2 m = v * (q * e), r = v - m;
    f32x2 o; o.x = v.x < 0.f ? m.x : r.x; o.y = v.y < 0.f ? m.y : r.y; return o;
}

template <int ACT  > struct EpiBf16 {
    static constexpr bool PERM = true, AFTER_DRAIN = false; static_assert(ACT == 0 || ACT == 1, "EpiBf16: ACT is 0 (none) or 1 (gelu_pk)");
    bf16_t* O; int ldc; const float* bias; int split_cols; size_t split_stride; float scale0;
    __device__ __forceinline__ void operator()(const f32x4 (&acc)[2][2][4][2], const Unit& u, int wr, int wc, int fr, int fq) const {
        const int row0 = u.pm * BM + wr * 64 + fr; int colt = u.pn * BM; bf16_t* base = O;
        float sc = 1.f; if (split_cols) { const int t = colt / split_cols; base += (size_t)t * split_stride; colt -= t * split_cols; if (t == 0) sc = scale0; }
        const int col0 = colt + wc * 32 + 8 * fq, bcol0 = u.pn * BM + wc * 32 + 8 * fq;
        f32x4 bv[2][2];
#pragma unroll
        for (int bj = 0; bj < 2; ++bj)
#pragma unroll
            for (int n = 0; n < 2; ++n) bv[bj][n] = bias ? *(const f32x4*)(bias + bcol0 + bj * HALF + 4 * n) : (f32x4){0.f, 0.f, 0.f, 0.f};
#pragma unroll
        for (int ai = 0; ai < 2; ++ai)
#pragma unroll
            for (int m = 0; m < 4; ++m) { bf16_t* rowp = base + (size_t)(row0 + ai * HALF + m * 16) * ldc + col0;
#pragma unroll
                for (int bj = 0; bj < 2; ++bj) { f32x4 v0 = acc[ai][bj][m][0] + bv[bj][0], v1 = acc[ai][bj][m][1] + bv[bj][1];
                    if (ACT == 1) { f32x2 a = gelu_pk((f32x2){v0[0], v0[1]}), b = gelu_pk((f32x2){v0[2], v0[3]}), c = gelu_pk((f32x2){v1[0], v1[1]}), d = gelu_pk((f32x2){v1[2], v1[3]});
                        v0 = (f32x4){a.x, a.y, b.x, b.y}; v1 = (f32x4){c.x, c.y, d.x, d.y}; }
                    v0 = v0 * sc; v1 = v1 * sc; u32x4 w; w.x = cvt_pk_bf16(v0[0], v0[1]); w.y = cvt_pk_bf16(v0[2], v0[3]); w.z = cvt_pk_bf16(v1[0], v1[1]); w.w = cvt_pk_bf16(v1[2], v1[3]);
                    *(u32x4*)(rowp + bj * HALF) = w; } }
    }
};

template <class Epi, class Sched, bool ALIGN_EPI = false, bool SP2 = false>
__device__ __forceinline__ void gemm_phase(PG8_LAS unsigned char* lds, const Gemm g, const Sched& S, const Epi& E) {
    const int tid = mk_tid(), wid = __builtin_amdgcn_readfirstlane(tid >> 6), lane = tid & 63, wr = wid >> 2, wc = wid & 3, fr = lane & 15, fq = lane >> 4;
    const int K = g.K, nt = K / BK;
    unsigned voffA[2], voffB[2];
#pragma unroll
    for (int i = 0; i < 2; ++i) { int R, C; stage_rc(tid * 16 + i * 8192, R, C); const int Rb = Epi::PERM ? ((R & ~31) + perm32(R & 31)) : R;
        voffA[i] = (unsigned)(R * K + C) * 2u; voffB[i] = (unsigned)(Rb * K + C) * 2u; }
    const size_t kstep = (size_t)(BK * 2);
    const size_t hstep = (size_t)HALF * K * 2;
    const size_t tstep = 2 * hstep;
    const unsigned ldsw = (unsigned)wid * 1024u;
    const int aoff = lds_byte(wr * 64 + fr, fq * 8), boff = lds_byte(wc * 32 + fr, fq * 8);
#define PG8_SA(b, h) (((b) * 2 + (h)) * HTB)
#define PG8_SB(b, h) ((4 + (b) * 2 + (h)) * HTB)
#define PG8_STAGE(bufoff, gbase, voff) do { _Pragma("unroll") for (int _i = 0; _i < 2; ++_i) \
        __builtin_amdgcn_global_load_lds((const unsigned*)((const char*)(gbase) + (voff)[_i]), (PG8_LAS unsigned*)(lds + (bufoff) + ldsw + _i * 8192), 16, 0, 0); } while (0)
#define PG8_LDA(dst, b, h) do { _Pragma("unroll") for (int m = 0; m < 4; ++m) _Pragma("unroll") for (int k = 0; k < 2; ++k) dst[m][k] = *(const PG8_LAS bf16x8*)(lds + PG8_SA(b, h) + aoff + m * 2048 + k * 1024); } while (0)
#define PG8_LDB(dst, b, h) do { _Pragma("unroll") for (int n = 0; n < 2; ++n) _Pragma("unroll") for (int k = 0; k < 2; ++k) dst[n][k] = *(const PG8_LAS bf16x8*)(lds + PG8_SB(b, h) + boff + n * 2048 + k * 1024); } while (0)
#define PG8_MMA(ai, bj, At, Bt) do { __builtin_amdgcn_s_setprio(1); _Pragma("unroll") for (int m = 0; m < 4; ++m) _Pragma("unroll") for (int n = 0; n < 2; ++n) _Pragma("unroll") for (int k = 0; k < 2; ++k) \
        acc[ai][bj][m][n] = __builtin_amdgcn_mfma_f32_16x16x32_bf16(Bt[n][k], At[m][k], acc[ai][bj][m][n], 0, 0, 0); __builtin_amdgcn_s_setprio(0); } while (0)
#define PG8_WAIT_V(n) asm volatile("s_waitcnt vmcnt(" #n ")" ::: "memory")
#define PG8_WAIT_L(n) asm volatile("s_waitcnt lgkmcnt(" #n ")" ::: "memory")
#define PG8_BAR __builtin_amdgcn_s_barrier()
#define PG8_SCHED __builtin_amdgcn_sched_barrier(0)
    Unit cur, nxt; int ui = 0;
    if (!S.next(0, cur)) return;
    f32x4 acc[2][2][4][2];
#pragma unroll
    for (int a = 0; a < 2; ++a)
#pragma unroll
        for (int b = 0; b < 2; ++b)
#pragma unroll
            for (int m = 0; m < 4; ++m)
#pragma unroll
                for (int n = 0; n < 2; ++n) acc[a][b][m][n] = (f32x4){0.f, 0.f, 0.f, 0.f};
    bf16x8 At[4][2], B0[2][2], B1[2][2];
    const char* cA = (const char*)g.A + (size_t)cur.pm * tstep; const char* cB = (const char*)g.Bt + (size_t)cur.pn * tstep;
    S.a_ready(cur);
    if constexpr (SP2) {
        PG8_STAGE(PG8_SB(0, 0), cB, voffB); PG8_STAGE(PG8_SB(0, 1), cB + hstep, voffB); PG8_STAGE(PG8_SA(0, 0), cA, voffA); PG8_STAGE(PG8_SA(0, 1), cA + hstep, voffA);
        if (wr == 1) PG8_BAR;
        PG8_WAIT_V(2); PG8_BAR;
        PG8_STAGE(PG8_SB(1, 0), cB + kstep, voffB); PG8_STAGE(PG8_SA(1, 0), cA + kstep, voffA); PG8_STAGE(PG8_SB(1, 1), cB + hstep + kstep, voffB);
        PG8_WAIT_V(6); PG8_BAR;
    } else {
        PG8_STAGE(PG8_SB(0, 0), cB, voffB); PG8_STAGE(PG8_SA(0, 0), cA, voffA); PG8_STAGE(PG8_SB(0, 1), cB + hstep, voffB); PG8_STAGE(PG8_SA(0, 1), cA + hstep, voffA);
        if (wr == 1) PG8_BAR;
        PG8_WAIT_V(4); PG8_BAR;
        PG8_STAGE(PG8_SB(1, 0), cB + kstep, voffB); PG8_STAGE(PG8_SA(1, 0), cA + kstep, voffA); PG8_STAGE(PG8_SB(1, 1), cB + hstep + kstep, voffB);
        PG8_WAIT_V(6); PG8_BAR;
    }
    for (;;) {
        const bool has_next = S.next(ui + 1, nxt);
        const char* nA = has_next ? (const char*)g.A + (size_t)nxt.pm * tstep : cA; const char* nB = has_next ? (const char*)g.Bt + (size_t)nxt.pn * tstep : cB;
        for (int t = 0; t < nt; t += 2) {
            const bool last = (t == nt - 2);
            const char* a1 = cA + (size_t)(t + 1) * kstep;
            const char* a2 = last ? nA : cA + (size_t)(t + 2) * kstep; const char* b2 = last ? nB : cB + (size_t)(t + 2) * kstep;
            const char* a3 = a2 + kstep; const char* b3 = b2 + kstep;
            if (last && has_next) S.a_ready(nxt);
            if constexpr (SP2) {
            PG8_LDB(B0, 0, 0); PG8_LDB(B1, 0, 1); PG8_SCHED; PG8_LDA(At, 0, 0); PG8_STAGE(PG8_SA(1, 1), a1 + hstep, voffA);
            PG8_WAIT_V(8); PG8_WAIT_L(0); PG8_BAR; PG8_MMA(0, 0, At, B0); PG8_MMA(0, 1, At, B1); PG8_BAR; PG8_SCHED;
            PG8_LDA(At, 0, 1); PG8_STAGE(PG8_SB(0, 0), b2, voffB); PG8_STAGE(PG8_SB(0, 1), b2 + hstep, voffB); PG8_STAGE(PG8_SA(0, 0), a2, voffA);
            PG8_WAIT_V(8); PG8_WAIT_L(0); PG8_BAR; PG8_MMA(1, 0, At, B0); PG8_MMA(1, 1, At, B1); PG8_BAR; PG8_SCHED;
            PG8_LDB(B0, 1, 0); PG8_LDB(B1, 1, 1); PG8_SCHED; PG8_LDA(At, 1, 0); PG8_STAGE(PG8_SA(0, 1), a2 + hstep, voffA);
            PG8_WAIT_V(8); PG8_WAIT_L(0); PG8_BAR; PG8_MMA(0, 0, At, B0); PG8_MMA(0, 1, At, B1); PG8_BAR; PG8_SCHED;
            PG8_LDA(At, 1, 1); PG8_STAGE(PG8_SB(1, 0), b3, voffB); PG8_STAGE(PG8_SB(1, 1), b3 + hstep, voffB); PG8_STAGE(PG8_SA(1, 0), a3, voffA);
            PG8_WAIT_V(8); PG8_WAIT_L(0); PG8_BAR; PG8_MMA(1, 0, At, B0); PG8_MMA(1, 1, At, B1); PG8_BAR; PG8_SCHED;
            } else {
            PG8_LDB(B0, 0, 0); PG8_SCHED; PG8_LDA(At, 0, 0); PG8_STAGE(PG8_SA(1, 1), a1 + hstep, voffA);
            PG8_WAIT_L(8); PG8_BAR; PG8_WAIT_L(0); PG8_MMA(0, 0, At, B0); PG8_BAR; PG8_SCHED;
            PG8_LDB(B1, 0, 1); PG8_STAGE(PG8_SB(0, 0), b2, voffB);
            PG8_BAR; PG8_WAIT_L(0); PG8_MMA(0, 1, At, B1); PG8_BAR;
            PG8_LDA(At, 0, 1); PG8_STAGE(PG8_SA(0, 0), a2, voffA);
            PG8_BAR; PG8_WAIT_L(0); PG8_MMA(1, 0, At, B0); PG8_BAR; PG8_SCHED;
            PG8_STAGE(PG8_SB(0, 1), b2 + hstep, voffB);
            PG8_WAIT_V(6); PG8_BAR; PG8_MMA(1, 1, At, B1); PG8_BAR;
            PG8_LDB(B0, 1, 0); PG8_SCHED; PG8_LDA(At, 1, 0); PG8_STAGE(PG8_SA(0, 1), a2 + hstep, voffA);
            PG8_WAIT_L(8); PG8_BAR; PG8_WAIT_L(0); PG8_MMA(0, 0, At, B0); PG8_BAR; PG8_SCHED;
            PG8_LDB(B1, 1, 1); PG8_STAGE(PG8_SB(1, 0), b3, voffB);
            PG8_BAR; PG8_WAIT_L(0); PG8_MMA(0, 1, At, B1); PG8_BAR;
            PG8_LDA(At, 1, 1); PG8_STAGE(PG8_SA(1, 0), a3, voffA);
            PG8_BAR; PG8_WAIT_L(0); PG8_MMA(1, 0, At, B0); PG8_BAR; PG8_SCHED;
            PG8_STAGE(PG8_SB(1, 1), b3 + hstep, voffB);
            PG8_WAIT_V(6); PG8_BAR; PG8_MMA(1, 1, At, B1); PG8_BAR;
            }
        }
        if constexpr (ALIGN_EPI) { if (wr == 0) PG8_BAR; }
        if constexpr (!Epi::AFTER_DRAIN) { E(acc, cur, wr, wc, fr, fq); S.done(cur); }
        if (!has_next) break;
#pragma unroll
        for (int a = 0; a < 2; ++a)
#pragma unroll
            for (int b = 0; b < 2; ++b)
#pragma unroll
                for (int m = 0; m < 4; ++m)
#pragma unroll
                    for (int n = 0; n < 2; ++n) acc[a][b][m][n] = (f32x4){0.f, 0.f, 0.f, 0.f};
        cur = nxt; cA = nA; cB = nB; ++ui;
        if constexpr (ALIGN_EPI) { if (wr == 1) PG8_BAR; }
    }
    PG8_WAIT_V(0);
    if constexpr (!ALIGN_EPI) { if (wr == 0) PG8_BAR; }
    PG8_BAR;
    if constexpr (Epi::AFTER_DRAIN) { E.fused(acc, cur, wr, wc, fr, fq, lds, wid, lane); S.done(cur); }
#undef PG8_SA
#undef PG8_SB
#undef PG8_STAGE
#undef PG8_LDA
#undef PG8_LDB
#undef PG8_MMA
#undef PG8_WAIT_V
#undef PG8_WAIT_L
#undef PG8_BAR
#undef PG8_SCHED
}
}

namespace att {
using bf16 = __hip_bfloat16;
constexpr int   D = 128, NW = 8, QBLK = 32, KVBLK = 64;
constexpr float SCALE = 0.088388347648318440f;
constexpr float THR = 8.f;
constexpr int SDEPTH = 2;
constexpr int LDQ = 3072, LDK = 3072, LDO = 2048;
constexpr size_t SHM_V = KVBLK * D * 2, SHM_K = KVBLK * D * 2, SHM_ATTN = 2 * SHM_V + 2 * SHM_K + NW * 64 * 4;
using bf16x8 = __attribute__((ext_vector_type(8))) short;
using s16x4  = __attribute__((ext_vector_type(4))) short;
using f32x16 = __attribute__((ext_vector_type(16))) float;
using f32x8  = __attribute__((ext_vector_type(8))) float;
using u32x4  = __attribute__((ext_vector_type(4))) unsigned;
#define KSWZ(row, colB) ((row) * 256 + ((colB) ^ (((row) & 7) << 4)))
#define SBAR() __builtin_amdgcn_sched_barrier(0)
__device__ __forceinline__ int crow(int r, int hi) { return (r & 3) + 8 * (r >> 2) + 4 * hi; }
__device__ __forceinline__ unsigned cvtpk(float lo, float hi) {
  unsigned r; asm volatile("v_cvt_pk_bf16_f32 %0, %1, %2" : "=v"(r) : "v"(lo), "v"(hi)); return r;
}
template <typename TIn> struct Stage;
template <> struct Stage<bf16>  { using T = bf16x8;
  __device__ static __forceinline__ T ld8(const bf16* p) { return *reinterpret_cast<const bf16x8*>(p); }
  __device__ static __forceinline__ bf16x8 tobf(T x) { return x; } };
template <> struct Stage<float> { using T = f32x8;
  __device__ static __forceinline__ T ld8(const float* p) { return *reinterpret_cast<const f32x8*>(p); }
  __device__ static __forceinline__ bf16x8 tobf(T x) {
    u32x4 w = {cvtpk(x[0], x[1]), cvtpk(x[2], x[3]), cvtpk(x[4], x[5]), cvtpk(x[6], x[7])}; return *reinterpret_cast<bf16x8*>(&w); } };

__device__ __forceinline__ void partialSM(f32x16& p0, f32x16& p1, float& m_reg, float& mn, float& alpha) {
  constexpr float C = SCALE * 1.4426950408889634f;
  float pmax = p0[0]; for (int r = 1; r < 16; ++r) pmax = fmaxf(pmax, p0[r]); for (int r = 0; r < 16; ++r) pmax = fmaxf(pmax, p1[r]);
  { auto rr = __builtin_amdgcn_permlane32_swap(__float_as_uint(pmax), __float_as_uint(pmax), false, false);
    pmax = fmaxf(__uint_as_float(rr[0]), __uint_as_float(rr[1])); }
  if (__builtin_expect(__all(pmax - m_reg <= THR / SCALE), 1)) { mn = m_reg; alpha = 1.f; }
  else { mn = fmaxf(m_reg, pmax); alpha = __builtin_amdgcn_exp2f((m_reg - mn) * C); m_reg = mn; }
  float mnC = -mn * C;
  for (int r = 0; r < 16; ++r) p0[r] = fmaf(p0[r], C, mnC); for (int r = 0; r < 16; ++r) p1[r] = fmaf(p1[r], C, mnC);
  for (int r = 0; r < 16; ++r) p0[r] = __builtin_amdgcn_exp2f(p0[r]);
}
__device__ __forceinline__ void finishSM(f32x16& p0, f32x16& p1, float alpha, float& l_reg, bf16x8& pa0, bf16x8& pa1, bf16x8& pa2, bf16x8& pa3) {
  for (int r = 0; r < 16; ++r) p1[r] = __builtin_amdgcn_exp2f(p1[r]);
  float ps = 0; for (int r = 0; r < 16; ++r) ps += p0[r]; for (int r = 0; r < 16; ++r) ps += p1[r];
  { auto rr = __builtin_amdgcn_permlane32_swap(__float_as_uint(ps), __float_as_uint(ps), false, false);
    ps = __uint_as_float(rr[0]) + __uint_as_float(rr[1]); }
  l_reg = l_reg * alpha + ps;
#define PK4(P, BASE, OUT) do { unsigned a0 = cvtpk(P[BASE + 0], P[BASE + 1]), a1 = cvtpk(P[BASE + 2], P[BASE + 3]);   \
    unsigned b0 = cvtpk(P[BASE + 4], P[BASE + 5]), b1 = cvtpk(P[BASE + 6], P[BASE + 7]);                              \
    auto r0 = __builtin_amdgcn_permlane32_swap(a0, b0, false, false); auto r1 = __builtin_amdgcn_permlane32_swap(a1, b1, false, false); \
    u32x4 w = {r0[0], r1[0], r0[1], r1[1]}; OUT = *reinterpret_cast<bf16x8*>(&w); } while (0)
  PK4(p0, 0, pa0); PK4(p0, 8, pa1); PK4(p1, 0, pa2); PK4(p1, 8, pa3);
#undef PK4
}
__device__ __forceinline__ void qkt(f32x16& p0, f32x16& p1, const bf16* Ks, const bf16x8* qr, int r32, int hi) {
  p0 = f32x16{}; p1 = f32x16{};
  for (int d0 = 0; d0 < 8; ++d0) { int cb = (d0 * 16 + hi * 8) * 2;
    bf16x8 b0 = *reinterpret_cast<const bf16x8*>((const char*)Ks + KSWZ(r32, cb));
    bf16x8 b1 = *reinterpret_cast<const bf16x8*>((const char*)Ks + KSWZ(32 + r32, cb));
    p0 = __builtin_amdgcn_mfma_f32_32x32x16_bf16(b0, qr[d0], p0, 0, 0, 0);
    p1 = __builtin_amdgcn_mfma_f32_32x32x16_bf16(b1, qr[d0], p1, 0, 0, 0); }
}
__device__ __forceinline__ int v_st(int k, int c) { const int kk = (k & ~0xC) | ((k & 4) << 1) | ((k & 8) >> 1); return ((kk >> 3) * 4 + (c >> 5)) * 512 + ((kk & 7) * 32 + (c & 31)) * 2; }
__device__ __forceinline__ int v_rd_base(int lane) { return ((lane & 3) << 3) | (((lane >> 2) & 3) << 6) | (((lane >> 4) & 1) << 5) | (((lane >> 5) & 1) << 8); }
constexpr int v_rd_off(int d0, int ks, int half) { return d0 * 512 + ks * 4096 + half * 2048; }
template <int OFF> __device__ __forceinline__ s16x4 tr_read(int vb) {
  s16x4 r; asm volatile("ds_read_b64_tr_b16 %0, %1 offset:%2" : "=&v"(r) : "v"(vb), "i"(OFF) : "memory"); return r;
}
template <int D0> __device__ __forceinline__ void pv_one(f32x16& od, int vb, bf16x8 pa0, bf16x8 pa1, bf16x8 pa2, bf16x8 pa3) {
  const s16x4 l0 = tr_read<v_rd_off(D0, 0, 0)>(vb), h0 = tr_read<v_rd_off(D0, 0, 1)>(vb), l1 = tr_read<v_rd_off(D0, 1, 0)>(vb), h1 = tr_read<v_rd_off(D0, 1, 1)>(vb);
  const s16x4 l2 = tr_read<v_rd_off(D0, 2, 0)>(vb), h2 = tr_read<v_rd_off(D0, 2, 1)>(vb), l3 = tr_read<v_rd_off(D0, 3, 0)>(vb), h3 = tr_read<v_rd_off(D0, 3, 1)>(vb);
  asm volatile("s_waitcnt lgkmcnt(0)" ::: "memory"); SBAR();
#define PK(L, H) (bf16x8){L[0], L[1], L[2], L[3], H[0], H[1], H[2], H[3]}
  od = __builtin_amdgcn_mfma_f32_32x32x16_bf16(pa0, PK(l0, h0), od, 0, 0, 0);
  od = __builtin_amdgcn_mfma_f32_32x32x16_bf16(pa1, PK(l1, h1), od, 0, 0, 0);
  od = __builtin_amdgcn_mfma_f32_32x32x16_bf16(pa2, PK(l2, h2), od, 0, 0, 0);
  od = __builtin_amdgcn_mfma_f32_32x32x16_bf16(pa3, PK(l3, h3), od, 0, 0, 0);
#undef PK
}
__device__ __forceinline__ void pv_d0(f32x16* o, int vb, bf16x8 pa0, bf16x8 pa1, bf16x8 pa2, bf16x8 pa3) {
  pv_one<0>(o[0], vb, pa0, pa1, pa2, pa3); pv_one<1>(o[1], vb, pa0, pa1, pa2, pa3); pv_one<2>(o[2], vb, pa0, pa1, pa2, pa3); pv_one<3>(o[3], vb, pa0, pa1, pa2, pa3);
}

template <typename TQ>
__device__ __forceinline__ void attn_dense_body(const TQ* __restrict__ Qb, const bf16* __restrict__ Kh, const bf16* __restrict__ Vh,
                                                unsigned short* __restrict__ Ob, int seq, char* lds) {
  using St = Stage<bf16>; using SQ = Stage<TQ>;
  const int tid = mk_tid(), wid = tid >> 6, lane = tid & 63, r32 = lane & 31, hi = lane >> 5;
  bf16* V_lds = (bf16*)lds; bf16* K_lds = (bf16*)(lds + 2 * SHM_V);
  float* ws = (float*)(lds + 2 * SHM_V + 2 * SHM_K) + wid * 64; float* li_l = ws; float* al_l = ws + 32;
  float m_reg = -1e30f, l_reg = 0; f32x16 o[4] = {}; bf16x8 qr[8];
  const TQ* Qw = Qb + (long)(wid * QBLK + r32) * LDQ + hi * 8;
#pragma unroll
  for (int d0 = 0; d0 < 8; ++d0) qr[d0] = SQ::tobf(SQ::ld8(Qw + d0 * 16));
  const int sr = tid >> 4, sc = (tid & 15) * 8, vst0 = v_st(sr, sc), vst1 = v_st(32 + sr, sc);
  const int vb0 = (int)(uintptr_t)V_lds + v_rd_base(lane);
  struct { typename St::T vs0, vs1, ks0, ks1; } sr_[SDEPTH];
#define SLOAD(i, k0) do { sr_[i].vs0 = St::ld8(&Vh[(long)((k0) + sr) * LDK + sc]); sr_[i].vs1 = St::ld8(&Vh[(long)((k0) + 32 + sr) * LDK + sc]); \
    sr_[i].ks0 = St::ld8(&Kh[(long)((k0) + sr) * LDK + sc]); sr_[i].ks1 = St::ld8(&Kh[(long)((k0) + 32 + sr) * LDK + sc]); } while (0)
#define SWRITE(b, i) do { *(bf16x8*)((char*)V_lds + (b) * SHM_V + vst0) = St::tobf(sr_[i].vs0);          \
    *(bf16x8*)((char*)V_lds + (b) * SHM_V + vst1) = St::tobf(sr_[i].vs1); int kc = sc * 2;               \
    *(bf16x8*)((char*)K_lds + (b) * SHM_K + KSWZ(sr, kc)) = St::tobf(sr_[i].ks0);                       \
    *(bf16x8*)((char*)K_lds + (b) * SHM_K + KSWZ(32 + sr, kc)) = St::tobf(sr_[i].ks1); } while (0)
#define SWAIT() do { if constexpr (SDEPTH == 2) asm volatile("s_waitcnt vmcnt(4)" ::: "memory"); else asm volatile("s_waitcnt vmcnt(0)" ::: "memory"); } while (0)
#define RESC(a) do { if (__any((a) < 1.f)) { if (hi == 0) al_l[r32] = (a); asm volatile("s_waitcnt lgkmcnt(0)" ::: "memory"); \
    for (int d = 0; d < 4; ++d) for (int r = 0; r < 16; ++r) o[d][r] *= al_l[crow(r, hi)]; } } while (0)
  f32x16 pA0, pA1, pB0, pB1; float mnA, mnB, alA, alB; bf16x8 pa0, pa1, pa2, pa3; const int NT = seq / KVBLK;
  constexpr int SE = 0, SO = SDEPTH - 1;
  SLOAD(SE, 0); asm volatile("s_waitcnt vmcnt(0)" ::: "memory"); SWRITE(0, SE); __syncthreads();
  qkt(pA0, pA1, K_lds, qr, r32, hi); partialSM(pA0, pA1, m_reg, mnA, alA);
  SLOAD(SO, KVBLK); if constexpr (SDEPTH == 2) { if (2 < NT) SLOAD(SE, 2 * KVBLK); }
  SWAIT(); SWRITE(1, SO); __syncthreads();
  for (int j = 1; j + 1 < NT; j += 2) {
    SBAR(); qkt(pB0, pB1, (bf16*)((char*)K_lds + SHM_K), qr, r32, hi);
    finishSM(pA0, pA1, alA, l_reg, pa0, pa1, pa2, pa3); SBAR();
    SLOAD(SO, (j + SDEPTH) * KVBLK); SBAR();
    pv_d0(o, vb0, pa0, pa1, pa2, pa3); partialSM(pB0, pB1, m_reg, mnB, alB);
    __syncthreads(); SWAIT(); SWRITE(0, SE);
    RESC(alB); __syncthreads();
    SBAR(); qkt(pA0, pA1, K_lds, qr, r32, hi);
    finishSM(pB0, pB1, alB, l_reg, pa0, pa1, pa2, pa3); SBAR();
    if (SDEPTH == 1 || j + 3 < NT) SLOAD(SE, (j + 1 + SDEPTH) * KVBLK); SBAR();
    pv_d0(o, vb0 + (int)SHM_V, pa0, pa1, pa2, pa3); partialSM(pA0, pA1, m_reg, mnA, alA);
    __syncthreads(); SWAIT(); SWRITE(1, SO);
    RESC(alA); __syncthreads();
  }
  SBAR(); qkt(pB0, pB1, (bf16*)((char*)K_lds + SHM_K), qr, r32, hi);
  finishSM(pA0, pA1, alA, l_reg, pa0, pa1, pa2, pa3); SBAR();
  pv_d0(o, vb0, pa0, pa1, pa2, pa3); partialSM(pB0, pB1, m_reg, mnB, alB);
  __syncthreads(); RESC(alB);
  finishSM(pB0, pB1, alB, l_reg, pa0, pa1, pa2, pa3); SBAR();
  pv_d0(o, vb0 + (int)SHM_V, pa0, pa1, pa2, pa3);
  if (hi == 0) li_l[r32] = l_reg; asm volatile("s_waitcnt lgkmcnt(0)" ::: "memory");
  float rli[16];
#pragma unroll
  for (int r = 0; r < 16; ++r) rli[r] = __builtin_amdgcn_rcpf(li_l[crow(r, hi)]);
  unsigned short* Ow = Ob + (long)(wid * QBLK) * LDO;
#pragma unroll
  for (int r = 0; r < 16; ++r) { int orow = crow(r, hi);
    for (int d0 = 0; d0 < 4; ++d0) Ow[(long)orow * LDO + d0 * 32 + r32] = (unsigned short)(cvtpk(o[d0][r] * rli[r], 0.f) & 0xffffu); }
#undef SLOAD
#undef SWRITE
#undef SWAIT
#undef RESC
}

}
__device__ __forceinline__ int mk_tid() { int t = threadIdx.x; asm volatile("" : "+v"(t)); return t; }
namespace mk {
#define LAS __attribute__((address_space(3)))
typedef unsigned short bf16;
typedef short bf16x8 __attribute__((ext_vector_type(8)));
typedef float f32x4 __attribute__((ext_vector_type(4)));
typedef unsigned u32x4 __attribute__((ext_vector_type(4)));
typedef unsigned u32x2 __attribute__((ext_vector_type(2)));
#define XB_TMO      128
#define XB_XCNT(j)  (256  + 64 * (j))
#define XB_XSUB(j)  (1280 + 64 * (j))
#define XB_XGEN(j)  (2304 + 64 * (j))
#define XB_TOP      3328
#define XB_TOPGEN   3392
#define XCD_BAR_WORDS 3456
#define XB_SPIN_CAP (1u << 18)

__device__ __forceinline__ unsigned xb_ld(unsigned* p)              { return __hip_atomic_load(p, __ATOMIC_RELAXED, __HIP_MEMORY_SCOPE_AGENT); }
__device__ __forceinline__ unsigned xb_add(unsigned* p, unsigned v) { return __hip_atomic_fetch_add(p, v, __ATOMIC_RELAXED, __HIP_MEMORY_SCOPE_AGENT); }
__device__ __forceinline__ unsigned xb_xcc_id() { return (unsigned)__builtin_amdgcn_s_getreg((3 << 11) | 20) & 0xFu; }
#define XB_SPIN(cond, bar) do { unsigned _sp = 0; while (cond) { __builtin_amdgcn_s_sleep(1); \
    if ((++_sp & 255u) == 0u) { if (xb_ld(&(bar)[XB_TMO])) break; if (_sp > XB_SPIN_CAP) { atomicAdd(&(bar)[XB_TMO], 1u); break; } } } } while (0)

struct XcdBarrier {
    unsigned* bar; unsigned x;
    volatile LAS unsigned* st;
};

__device__ __forceinline__ XcdBarrier xcd_barrier_post(unsigned* bar, volatile LAS unsigned* st) {
    XcdBarrier b; b.bar = bar; b.x = xb_xcc_id(); b.st = st;
    if (mk_tid() == 0) (void)xb_add(&bar[XB_XCNT(b.x)], 1u);
    return b;
}
__device__ __forceinline__ void xcd_barrier_complete(unsigned* bar, unsigned x, unsigned& nloc, unsigned& nx) {
    const unsigned G = gridDim.x * gridDim.y * gridDim.z;
    unsigned sum, cnt, mine, sp = 0u;
    for (;;) {
        sum = 0u; cnt = 0u; mine = 0u;
#pragma unroll
        for (unsigned j = 0; j < 16; ++j) { const unsigned c = xb_ld(&bar[XB_XCNT(j)]); sum += c; cnt += (c > 0u) ? 1u : 0u; mine = (j == x) ? c : mine; }
        if (sum == G) break;
        __builtin_amdgcn_s_sleep(1);
        if ((++sp & 255u) == 0u) { if (xb_ld(&bar[XB_TMO])) break; if (sp > XB_SPIN_CAP) { atomicAdd(&bar[XB_TMO], 1u); break; } }
    }
    nloc = mine > 0u ? mine : 1u; nx = cnt > 0u ? cnt : 1u;
}

__device__ __forceinline__ void xcd_barrier(const XcdBarrier& b) {
    asm volatile("s_waitcnt vmcnt(0)" ::: "memory");
    __syncthreads();
    if (mk_tid() == 0) {
        unsigned* bar = b.bar;
        __builtin_amdgcn_s_waitcnt(0);
        unsigned nloc = b.st[0], nx = b.st[1];
        if (nloc == 0u) { xcd_barrier_complete(bar, b.x, nloc, nx); b.st[0] = nloc; b.st[1] = nx; }
        const unsigned old = xb_add(&bar[XB_XSUB(b.x)], 1u);
        const unsigned gen = old / nloc;
        if (old + 1u == (gen + 1u) * nloc) {
            __builtin_amdgcn_fence(__ATOMIC_RELEASE, "agent");
            asm volatile("s_waitcnt vmcnt(0)" ::: "memory");
            const unsigned og = xb_add(&bar[XB_TOP], 1u);
            const unsigned tg = og / nx;
            if (og + 1u == (tg + 1u) * nx) xb_add(&bar[XB_TOPGEN], 1u);
            else XB_SPIN(xb_ld(&bar[XB_TOPGEN]) == tg, bar);
            __builtin_amdgcn_fence(__ATOMIC_ACQUIRE, "agent");
            xb_add(&bar[XB_XGEN(b.x)], 1u);
            asm volatile("s_waitcnt vmcnt(0)" ::: "memory");
        } else {
            XB_SPIN(xb_ld(&bar[XB_XGEN(b.x)]) == gen, bar);
            __builtin_amdgcn_fence(__ATOMIC_ACQUIRE, "agent");
            asm volatile("s_waitcnt vmcnt(0)" ::: "memory");
        }
    }
    __syncthreads();
}


constexpr int D = 2048, M = 8192, SEQ = 4096, NW = 8;
constexpr int ABW = 3072, CW = 8224, FF2 = 11264, FF = 5632;
constexpr float EPS = 1e-6f;
constexpr size_t MiB = 1u << 20;
constexpr size_t WS_AB = 0, WS_BD = 12 * MiB, WS_OAB = 13 * MiB, WS_C = 21 * MiB  , WS_OC = 54 * MiB;
constexpr size_t WS_UP0 = 62 * MiB, WS_UP1 = 106 * MiB, WS_DN0 = 150 * MiB, WS_DN1 = 172 * MiB;
constexpr size_t WS_XN = 194 * MiB, WS_GATES = 226 * MiB, WS_S = 228 * MiB;
constexpr size_t WS_PROJ = WS_S, WS_POOLED = WS_S + 48 * MiB, WS_CAT = WS_S + 56 * MiB;
constexpr size_t WS_QK = WS_S, WS_OG = WS_S + 64 * MiB, WS_KVT = WS_S + 96 * MiB, WS_HF = WS_S + 160 * MiB, WS_Y = WS_S + 288 * MiB;
constexpr size_t WS_U = WS_S, WS_ACT = WS_S + 176 * MiB;
constexpr size_t WS_PB = WS_S + 320 * MiB, WS_SC = WS_S + 336 * MiB;
constexpr size_t WS_END = WS_S + 338 * MiB;
constexpr int LDS_ML = 154112 + 1024, LDS_MISC = LDS_ML, LDS_BYTES = LDS_ML + 64;
constexpr size_t WS_BAR = WS_BD + 768 * 1024, BAR_BYTES = 16384;

#define LDSWAIT() asm volatile("s_waitcnt lgkmcnt(0)" ::: "memory")
__device__ __forceinline__ unsigned f2bf(float f) { unsigned u = __float_as_uint(f); return (u + 0x7fffu + ((u >> 16) & 1u)) >> 16; }
__device__ __forceinline__ unsigned pk2(float lo, float hi) { unsigned r; asm volatile("v_cvt_pk_bf16_f32 %0, %1, %2" : "=v"(r) : "v"(lo), "v"(hi)); return r; }
__device__ __forceinline__ float bflo(unsigned w) { return __uint_as_float(w << 16); }
__device__ __forceinline__ float bfhi(unsigned w) { return __uint_as_float(w & 0xffff0000u); }
__device__ __forceinline__ float wave_sum(float v) {
#pragma unroll
    for (int o = 1; o < 64; o <<= 1) v += __shfl_xor(v, o);
    return v;
}

__device__ __forceinline__ void transpose_item64(const float* __restrict__ W, int ldw, int K, int nblk, bf16* __restrict__ WT, LAS float* scr, int item, int lane, bool upperm) {
    const int kb = item / nblk, nb = item - kb * nblk, k0 = 64 * kb, n0 = 64 * nb;
    const int d0 = !upperm ? n0 : (n0 < FF ? 256 * (n0 >> 7) + (n0 & 127) : 256 * ((n0 - FF) >> 7) + 128 + ((n0 - FF) & 127));
    f32x4 v[16];
#pragma unroll
    for (int i = 0; i < 16; ++i) { const int kk = 4 * i + (lane >> 4); v[i] = *(const f32x4*)(W + (size_t)(k0 + kk) * ldw + n0 + 4 * (lane & 15)); }
#pragma unroll
    for (int i = 0; i < 16; ++i) { const int kk = 4 * i + (lane >> 4); LAS float* s = scr + kk * 65 + 4 * (lane & 15); s[0] = v[i].x; s[1] = v[i].y; s[2] = v[i].z; s[3] = v[i].w; }
    LDSWAIT();
    const int c = lane & 7, q = lane >> 3;
#pragma unroll
    for (int j = 0; j < 8; ++j) { const int n = q + 8 * j; const LAS float* s = scr + (8 * c) * 65 + n;
        u32x4 o; o.x = pk2(s[0], s[65]); o.y = pk2(s[130], s[195]); o.z = pk2(s[260], s[325]); o.w = pk2(s[390], s[455]);
        *(u32x4*)(WT + (size_t)(d0 + n) * K + k0 + 8 * c) = o; }
    LDSWAIT();
}

__device__ __forceinline__ void rmsnorm_rows(const float* __restrict__ src, const float* __restrict__ gain, bf16* __restrict__ dst, int gw, int ngw, int lane) {
    f32x4 g[8];
#pragma unroll
    for (int j = 0; j < 8; ++j) g[j] = *(const f32x4*)(gain + 4 * lane + 256 * j);
    for (int m = gw; m < M; m += ngw) {
        const f32x4* xr = (const f32x4*)(src + (size_t)m * D) + lane; f32x4 v[8]; float s = 0.f;
#pragma unroll
        for (int j = 0; j < 8; ++j) { v[j] = xr[64 * j]; s += (v[j].x * v[j].x + v[j].y * v[j].y) + (v[j].z * v[j].z + v[j].w * v[j].w); }
        const float rstd = 1.0f / sqrtf(wave_sum(s) * (1.0f / D) + EPS);
        u32x2* o = (u32x2*)(dst + (size_t)m * D) + lane;
#pragma unroll
        for (int j = 0; j < 8; ++j) { u32x2 w; w.x = pk2(v[j].x * rstd * g[j].x, v[j].y * rstd * g[j].y); w.y = pk2(v[j].z * rstd * g[j].z, v[j].w * rstd * g[j].w); o[64 * j] = w; }
    }
}

struct In { const float *x, *norm_mix, *norm_ffn, *w_in_ab, *pool_w, *pool_scale, *q_norm, *k_norm, *w_out_ab, *w_in_c, *b_gate, *h_norm, *w_out_c, *w_up, *conv_w, *conv_b, *w_down; };

__device__ __forceinline__ void transposes(const In& I, unsigned char* ws, LAS unsigned char* lds, int first, int last, int w, int nw, int wave, int lane) {
    LAS float* scr = (LAS float*)(lds + wave * 16640);
    for (int it = first + w; it < last; it += nw) {
        const float* W; int ldw, K, nblk; bf16* WT; int r = it;
        if (r < 1536) { W = I.w_in_ab; ldw = ABW; K = D; nblk = 48; WT = (bf16*)(ws + WS_AB); }
        else if (r < 2560) { r -= 1536; W = I.w_out_ab; ldw = D; K = D; nblk = 32; WT = (bf16*)(ws + WS_OAB); }
        else if (r < 6656) { r -= 2560; W = I.w_in_c; ldw = CW; K = D; nblk = 128; WT = (bf16*)(ws + WS_C); }
        else if (r < 7680) { r -= 6656; W = I.w_out_c; ldw = D; K = D; nblk = 32; WT = (bf16*)(ws + WS_OC); }
        else if (r < 13312) { r -= 7680; W = I.w_up; ldw = FF2; K = D; nblk = 176; WT = (bf16*)(ws + WS_UP0); }
        else if (r < 18944) { r -= 13312; W = I.w_up + (size_t)D * FF2; ldw = FF2; K = D; nblk = 176; WT = (bf16*)(ws + WS_UP1); }
        else if (r < 21760) { r -= 18944; W = I.w_down; ldw = D; K = FF; nblk = 32; WT = (bf16*)(ws + WS_DN0); }
        else { r -= 21760; W = I.w_down + (size_t)FF * D; ldw = D; K = FF; nblk = 32; WT = (bf16*)(ws + WS_DN1); }
        transpose_item64(W, ldw, K, nblk, WT, scr, r, lane, (it >= 7680 && it < 18944));
    }
}
__device__ __forceinline__ void prologue(const In& I, unsigned char* ws, LAS unsigned char* lds, int gw, int ngw, int wave, int lane) {
    transposes(I, ws, lds, 0, 1536, gw, ngw, wave, lane);
    const int gt = gw * 64 + lane, ngt = ngw * 64;
    { bf16* WG = (bf16*)(ws + WS_C) + (size_t)8192 * D;
      for (int idx = gt; idx < 32 * D; idx += ngt) { const int j = idx >> 11, k = idx & 2047; WG[idx] = (bf16)f2bf(I.w_in_c[(size_t)k * CW + 8192 + j]); } }
    { bf16* BD = (bf16*)(ws + WS_BD);
      for (int idx = gt; idx < 512 * 512; idx += ngt) { const int n = idx >> 9, k = idx & 511, gn = n >> 7, gk = k >> 7;
          const float v = (gn == gk) ? I.pool_w[(size_t)(gn * 128 + (k & 127)) * 128 + (n & 127)] * I.pool_scale[n] : 0.f; BD[idx] = (bf16)f2bf(v); } }
    rmsnorm_rows(I.x, I.norm_mix, (bf16*)(ws + WS_XN), gw, ngw, lane);
}

__device__ __forceinline__ void qk_rope_pool(bf16* __restrict__ PROJ, const float* __restrict__ qn, const float* __restrict__ kn, bf16* __restrict__ POOLED, int gw, int ngw, int lane) {
    const int l = lane & 31, hsel = lane >> 5, part = (l >> 4) & 1; const bool first = (l & 8) == 0;
    float inv[4];
#pragma unroll
    for (int e = 0; e < 4; ++e) inv[e] = exp2f(-(float)(4 * (l & 7) + e) * (13.287712379549449f / 32.0f));
    const f32x4 gq = *(const f32x4*)(qn + 4 * l), gk = *(const f32x4*)(kn + 4 * l);
    for (int it0 = gw; it0 < M * 8; it0 += 4 * ngw) {
        u32x2 wv[4]; bf16* pp4[4]; int tt4[4], hh4[4]; bool ok[4];
#pragma unroll
        for (int k = 0; k < 4; ++k) { const int it = it0 + k * ngw; ok[k] = it < M * 8; const int itc = ok[k] ? it : gw; tt4[k] = itc >> 3; hh4[k] = (itc & 7) * 2 + hsel;
            pp4[k] = PROJ + (size_t)tt4[k] * ABW + 512 + hh4[k] * 128 + 4 * l; wv[k] = *(const u32x2*)pp4[k]; }
#pragma unroll
        for (int k = 0; k < 4; ++k) {
            const u32x2 w = wv[k]; const int t = tt4[k], hh = hh4[k];
            float x[4] = {bflo(w.x), bfhi(w.x), bflo(w.y), bfhi(w.y)};
            float ss = (x[0] * x[0] + x[1] * x[1]) + (x[2] * x[2] + x[3] * x[3]);
#pragma unroll
            for (int o = 1; o < 32; o <<= 1) ss += __shfl_xor(ss, o);
            const float rstd = 1.0f / sqrtf(ss * (1.0f / 128.0f) + EPS);
            const f32x4 g = (hh < 12) ? gq : gk;
            const int pos = t & (SEQ - 1); const float pp = part ? (float)(pos & 63) : (float)(pos >> 6);
            float y[4] = {x[0] * rstd * g.x, x[1] * rstd * g.y, x[2] * rstd * g.z, x[3] * rstd * g.w}, o4[4];
#pragma unroll
            for (int e = 0; e < 4; ++e) { const float yp = __shfl_xor(y[e], 8); const float ang = pp * inv[e]; const float sn = __sinf(ang), cs = __cosf(ang);
                o4[e] = y[e] * cs + (first ? -yp : yp) * sn; }
            u32x2 ow; ow.x = pk2(o4[0], o4[1]); ow.y = pk2(o4[2], o4[3]); if (ok[k]) *(u32x2*)pp4[k] = ow;
        }
    }
    const int gt = gw * 64 + lane, ngt = ngw * 64;
    for (int it = gt; it < M * 64; it += ngt) {
        const int t = it >> 6, c8 = (it & 63) * 8, g = c8 >> 7, w2 = 1 << g, pos = t & (SEQ - 1), base = t - pos;
        const int lo = max(pos - w2, 0), hi = min(pos + w2, SEQ);
        float acc[8] = {0.f, 0.f, 0.f, 0.f, 0.f, 0.f, 0.f, 0.f};
        u32x4 wv[16];
#pragma unroll
        for (int k = 0; k < 16; ++k) { const int pz = pos - w2 + k; const bool okk = (k < 2 * w2) && pz >= 0 && pz < SEQ; const u32x4 z = {0u, 0u, 0u, 0u};
            wv[k] = okk ? *(const u32x4*)(PROJ + (size_t)(base + pz) * ABW + c8) : z; }
#pragma unroll
        for (int k = 0; k < 16; ++k) { const u32x4 v = wv[k];
            acc[0] += bflo(v.x); acc[1] += bfhi(v.x); acc[2] += bflo(v.y); acc[3] += bfhi(v.y); acc[4] += bflo(v.z); acc[5] += bfhi(v.z); acc[6] += bflo(v.w); acc[7] += bfhi(v.w); }
        const u32x4 sv = *(const u32x4*)(PROJ + (size_t)t * ABW + c8); const float iv = 1.0f / (float)(hi - lo);
        u32x4 o; o.x = pk2(acc[0] * iv - bflo(sv.x), acc[1] * iv - bfhi(sv.x)); o.y = pk2(acc[2] * iv - bflo(sv.y), acc[3] * iv - bfhi(sv.y));
        o.z = pk2(acc[4] * iv - bflo(sv.z), acc[5] * iv - bfhi(sv.z)); o.w = pk2(acc[6] * iv - bflo(sv.w), acc[7] * iv - bfhi(sv.w));
        *(u32x4*)(POOLED + (size_t)t * 512 + c8) = o;
    }
}

__device__ __forceinline__ void conv_fix(const bf16* __restrict__ HALO, const float* __restrict__ cw, const float* __restrict__ cb, bf16* __restrict__ ACT, int gt, int ngt) {
    for (int it = gt; it < 256 * 704; it += ngt) {
        const int jc = it % 704, re = it / 704, blk = re >> 1, last = re & 1, j = jc * 8;
        const int t = blk * 64 + (last ? 63 : 0), pos = t & (SEQ - 1);
        const bf16* rc = HALO + ((size_t)blk * 4 + (last ? 3 : 0)) * FF2 + j;
        const bf16* ru = last ? rc - FF2 : HALO + ((size_t)(blk - 1) * 4 + 3) * FF2 + j;
        const bf16* rd = last ? HALO + ((size_t)(blk + 1) * 4) * FF2 + j : rc + FF2;
        const u32x4 z = {0u, 0u, 0u, 0u};
        const u32x4 g1 = *(const u32x4*)rc, v1 = *(const u32x4*)(rc + FF);
        const u32x4 g0 = pos > 0 ? *(const u32x4*)ru : z, v0 = pos > 0 ? *(const u32x4*)(ru + FF) : z;
        const u32x4 g2 = pos < SEQ - 1 ? *(const u32x4*)rd : z, v2 = pos < SEQ - 1 ? *(const u32x4*)(rd + FF) : z;
        float o[8];
#pragma unroll
        for (int q = 0; q < 4; ++q) {
            const int ja = j + 2 * q, jb = ja + 1;
            const float ga = cw[ja] * bflo(g0[q]) + cw[FF2 + ja] * bflo(g1[q]) + cw[2 * FF2 + ja] * bflo(g2[q]) + cb[ja];
            const float gb = cw[jb] * bfhi(g0[q]) + cw[FF2 + jb] * bfhi(g1[q]) + cw[2 * FF2 + jb] * bfhi(g2[q]) + cb[jb];
            const float va = cw[FF + ja] * bflo(v0[q]) + cw[FF2 + FF + ja] * bflo(v1[q]) + cw[2 * FF2 + FF + ja] * bflo(v2[q]) + cb[FF + ja];
            const float vb = cw[FF + jb] * bfhi(v0[q]) + cw[FF2 + FF + jb] * bfhi(v1[q]) + cw[2 * FF2 + FF + jb] * bfhi(v2[q]) + cb[FF + jb];
            o[2 * q] = ga / (1.0f + __expf(-ga)) * va; o[2 * q + 1] = gb / (1.0f + __expf(-gb)) * vb;
        }
        u32x4 ow; ow.x = pk2(o[0], o[1]); ow.y = pk2(o[2], o[3]); ow.z = pk2(o[4], o[5]); ow.w = pk2(o[6], o[7]);
        *(u32x4*)(ACT + (size_t)t * FF + j) = ow;
    }
}

__device__ __forceinline__ void gates_phase(const bf16* __restrict__ XN, const bf16* __restrict__ WG, const float* __restrict__ bg, float* __restrict__ GATES, LAS float* red, int bid, int nblk) {
    const int tid = mk_tid(), wid = tid >> 6, lane = tid & 63, fr = lane & 15, fq = lane >> 4;
    const int tile = wid & 3, tt = tile & 1, jt = tile >> 1, kh = wid >> 2;
    for (int grp = bid; grp < 256; grp += nblk) {
        f32x4 acc = {0.f, 0.f, 0.f, 0.f};
        const bf16* ap = WG + (size_t)(jt * 16 + fr) * D + kh * 1024 + fq * 8;
        const bf16* bp = XN + (size_t)(grp * 32 + tt * 16 + fr) * D + kh * 1024 + fq * 8;
#pragma unroll 8
        for (int ks = 0; ks < 32; ++ks) { const bf16x8 a = *(const bf16x8*)(ap + ks * 32), b = *(const bf16x8*)(bp + ks * 32); acc = __builtin_amdgcn_mfma_f32_16x16x32_bf16(a, b, acc, 0, 0, 0); }
        if (kh == 1) { LAS float* r = red + (tile * 64 + lane) * 4; r[0] = acc[0]; r[1] = acc[1]; r[2] = acc[2]; r[3] = acc[3]; }
        __syncthreads();
        if (kh == 0) { const LAS float* r = red + (tile * 64 + lane) * 4; const int t = grp * 32 + tt * 16 + fr, j = jt * 16 + 4 * fq;
            const f32x4 b4 = *(const f32x4*)(bg + j); f32x4 o; o.x = acc[0] + r[0] + b4.x; o.y = acc[1] + r[1] + b4.y; o.z = acc[2] + r[2] + b4.z; o.w = acc[3] + r[3] + b4.w;
            *(f32x4*)(GATES + (size_t)t * 32 + j) = o; }
        __syncthreads();
    }
}

__device__ __forceinline__ void headnorm_phase(const bf16* __restrict__ HF, const bf16* __restrict__ OG, const float* __restrict__ hn, bf16* __restrict__ Y, int gw, int ngw, int lane) {
    for (int it0 = gw; it0 < M * 8; it0 += 4 * ngw) {
        u32x2 a[4], b[4], ow[4]; f32x4 g[4]; size_t off[4]; bool ok[4];
#pragma unroll
        for (int k = 0; k < 4; ++k) { const int it = it0 + k * ngw; ok[k] = it < M * 8; const int itc = ok[k] ? it : gw; const int t = itc >> 3, h = itc & 7; off[k] = (size_t)t * D + h * 256 + 4 * lane;
            a[k] = *(const u32x2*)(HF + off[k]); b[k] = *(const u32x2*)(HF + (size_t)M * D + off[k]); ow[k] = *(const u32x2*)(OG + off[k]); g[k] = *(const f32x4*)(hn + h * 256 + 4 * lane); }
#pragma unroll
        for (int k = 0; k < 4; ++k) {
            f32x4 s; s.x = bflo(a[k].x) + bflo(b[k].x); s.y = bfhi(a[k].x) + bfhi(b[k].x); s.z = bflo(a[k].y) + bflo(b[k].y); s.w = bfhi(a[k].y) + bfhi(b[k].y);
            const float ss = wave_sum((s.x * s.x + s.y * s.y) + (s.z * s.z + s.w * s.w));
            const float rstd = 1.0f / sqrtf(ss * (1.0f / 256.0f) + EPS);
            const float o0 = bflo(ow[k].x), o1 = bfhi(ow[k].x), o2 = bflo(ow[k].y), o3 = bfhi(ow[k].y);
            u32x2 w; w.x = pk2(s.x * rstd * g[k].x * __builtin_amdgcn_rcpf(1.0f + __expf(-o0)), s.y * rstd * g[k].y * __builtin_amdgcn_rcpf(1.0f + __expf(-o1)));
            w.y = pk2(s.z * rstd * g[k].z * __builtin_amdgcn_rcpf(1.0f + __expf(-o2)), s.w * rstd * g[k].w * __builtin_amdgcn_rcpf(1.0f + __expf(-o3)));
            if (ok[k]) *(u32x2*)(Y + off[k]) = w;
        }
    }
}

namespace ml {
constexpr int LQ = 264, LS = 72;
constexpr int OFF_Q = 0, OFF_KT = 33792, OFF_VT = 70656, OFF_VTW = 77568, OFF_P = 84480, OFF_CT0 = 93696, CT_BYTES = 25344, OFF_SC = OFF_CT0 + 2 * CT_BYTES  , OFF_WS = OFF_SC + 512, ML_LDS_END = OFF_WS + 1024;
static_assert(ML_LDS_END <= LDS_ML, "mlstm lds map");
#define ML_BAR() do { asm volatile("s_waitcnt lgkmcnt(0)" ::: "memory"); __builtin_amdgcn_s_barrier(); asm volatile("" ::: "memory"); } while (0)
#define ML_DPP(old, src, ctrl, rmask) __int_as_float(__builtin_amdgcn_update_dpp(__float_as_int(old), __float_as_int(src), ctrl, rmask, 0xF, false))
#define ML_MFMA(a, b, c) __builtin_amdgcn_mfma_f32_16x16x32_bf16(a, b, c, 0, 0, 0)

__device__ __forceinline__ void mlstm_pre(LAS unsigned char* lds, const bf16* __restrict__ QK, const float* __restrict__ GATES, bf16* __restrict__ PB, float* __restrict__ SC, int bid, int nblk) {
    const int tid = mk_tid(), wid = tid >> 6, lane = tid & 63, fr = lane & 15, fq = lane >> 4;
    LAS float* sa = (LAS float*)(lds + wid * 512); LAS float* sm = sa + 64;
    for (int wg = bid; wg < 256; wg += nblk) {
        const int seq = wg >> 3, c = (wg & 7) * 8 + wid, dir = seq & 1, h = (seq >> 1) & 7, b = seq >> 4, item = seq * 64 + c;
        const int rr = dir ? 63 - lane : lane;
        const float* gbase = GATES + (size_t)b * SEQ * 32 + dir * 16 + h;
        float m_st = 0.f, a_c = 0.f, Mv_c = 0.f, ai_c = 0.f, em_c = 0.f, ws_c = 0.f, dec_c = 1.f;
        for (int k0 = 0; k0 <= c; k0 += 8) {
            float gi[8], gf[8];
#pragma unroll
            for (int j = 0; j < 8; ++j) { const int k = k0 + j, ncn = dir ? 63 - k : k; const float* gp = gbase + (size_t)(ncn * 64 + rr) * 32; gi[j] = gp[0]; gf[j] = gp[8]; }
#pragma unroll
            for (int j = 0; j < 8; ++j) { const int k = k0 + j;
                if (k <= c) {
                    const float lf = fminf(gf[j], 0.f) - log1pf(__expf(-fabsf(gf[j]))); float bc = lf;
                    bc += ML_DPP(0.f, bc, 0x111, 0xF); bc += ML_DPP(0.f, bc, 0x112, 0xF); bc += ML_DPP(0.f, bc, 0x114, 0xF); bc += ML_DPP(0.f, bc, 0x118, 0xF);
                    bc += ML_DPP(0.f, bc, 0x142, 0xA); bc += ML_DPP(0.f, bc, 0x143, 0xC);
                    const float a = gi[j] - bc; float cm = a;
                    cm = fmaxf(cm, ML_DPP(-3.0e38f, cm, 0x111, 0xF)); cm = fmaxf(cm, ML_DPP(-3.0e38f, cm, 0x112, 0xF)); cm = fmaxf(cm, ML_DPP(-3.0e38f, cm, 0x114, 0xF)); cm = fmaxf(cm, ML_DPP(-3.0e38f, cm, 0x118, 0xF));
                    cm = fmaxf(cm, ML_DPP(-3.0e38f, cm, 0x142, 0xA)); cm = fmaxf(cm, ML_DPP(-3.0e38f, cm, 0x143, 0xC));
                    const float Mv = fmaxf(m_st, cm), blast = __shfl(bc, 63), cml = __shfl(cm, 63), Mn = fmaxf(m_st, cml);
                    if (k == c) { a_c = a; Mv_c = Mv; ai_c = __expf(m_st - Mv); em_c = __expf(-(bc + Mv)); ws_c = __expf(a - Mn); dec_c = __expf(m_st - Mn); }
                    m_st = blast + Mn;
                }
            }
        }
        { float* sc = SC + (size_t)item * 256; sc[rr] = ai_c; sc[64 + rr] = em_c; sc[128 + rr] = ws_c; sc[192 + rr] = dec_c; }
        sa[rr] = a_c; sm[rr] = Mv_c;
        asm volatile("s_waitcnt lgkmcnt(0)" ::: "memory");
        const int ncn = dir ? 63 - c : c; const size_t trow = (size_t)b * SEQ + (size_t)ncn * 64;
        const bf16* Qb = QK + trow * 4096 + h * 256 + (size_t)fr * 4096 + fq * 8; const bf16* Kb = Qb + 2048;
        f32x4 acc[4][4];
#pragma unroll
        for (int tq = 0; tq < 4; ++tq)
#pragma unroll
            for (int sq = 0; sq < 4; ++sq) acc[tq][sq] = (f32x4){0.f, 0.f, 0.f, 0.f};
#pragma unroll 2
        for (int ks = 0; ks < 8; ++ks) {
            bf16x8 qf[4], kf[4];
#pragma unroll
            for (int q = 0; q < 4; ++q) { qf[q] = *(const bf16x8*)(Qb + (size_t)q * 16 * 4096 + ks * 32); kf[q] = *(const bf16x8*)(Kb + (size_t)q * 16 * 4096 + ks * 32); }
#pragma unroll
            for (int tq = 0; tq < 4; ++tq)
#pragma unroll
                for (int sq = 0; sq < 4; ++sq) acc[tq][sq] = ML_MFMA(kf[sq], qf[tq], acc[tq][sq]);
        }
        bf16* pb = PB + (size_t)item * 4096;
#pragma unroll
        for (int tq = 0; tq < 4; ++tq) { const int t = tq * 16 + fr; const float Mt = sm[t];
#pragma unroll
            for (int sq = 0; sq < 4; ++sq) { const int s0 = sq * 16 + 4 * fq; const f32x4 a4 = *(const LAS f32x4*)(sa + s0); float p[4];
#pragma unroll
                for (int r = 0; r < 4; ++r) { const int s = s0 + r; const bool ok = dir ? (s >= t) : (s <= t); p[r] = ok ? acc[tq][sq][r] * __expf(a4[r] - Mt) : 0.f; }
                u32x2 w; w.x = pk2(p[0], p[1]); w.y = pk2(p[2], p[3]); *(u32x2*)(pb + t * 64 + s0) = w; } }
        asm volatile("s_waitcnt lgkmcnt(0)" ::: "memory");
    }
}

__device__ __forceinline__ void mlstm_seq(LAS unsigned char* lds, const bf16* __restrict__ QK, const bf16* __restrict__ KVT, const bf16* __restrict__ PB, const float* __restrict__ SC, bf16* __restrict__ HF, int bid, int nblk) {
    const int tid = mk_tid(), wid = tid >> 6, lane = tid & 63, fr = lane & 15, fq = lane >> 4;
    LAS bf16* Qs = (LAS bf16*)(lds + OFF_Q); LAS bf16* KTs = (LAS bf16*)(lds + OFF_KT);
    LAS bf16* VTs = (LAS bf16*)(lds + OFF_VT); LAS bf16* VTw = (LAS bf16*)(lds + OFF_VTW); LAS bf16* Ps = (LAS bf16*)(lds + OFF_P);
    LAS float* sAI = (LAS float*)(lds + OFF_SC); LAS float* sEM = sAI + 64; LAS float* sWS = (LAS float*)(lds + OFF_WS);
    const int tt = wid & 3, sh = wid >> 2;
    for (int it0 = bid; it0 < 256; it0 += nblk) {
        const int itm = (nblk == 256) ? (((it0 & 7) * 4 + (it0 >> 6)) * 8 + ((it0 >> 3) & 7)) : it0;
        const int es = itm & 7, seq = itm >> 3, dir = seq & 1, h = (seq >> 1) & 7, b = seq >> 4;
        for (int i = tid; i < 48 * LQ / 2; i += 512) ((LAS unsigned*)(lds + OFF_CT0))[i] = 0u;
        for (int i = tid; i < 16 * LS; i += 512) { VTs[32 * LS + i] = (i < LS) ? (bf16)0x3F80 : (bf16)0; VTw[32 * LS + i] = (bf16)0; }
        f32x4 ct[2][3];
#pragma unroll
        for (int a = 0; a < 2; ++a)
#pragma unroll
            for (int e = 0; e < 3; ++e) ct[a][e] = (f32x4){0.f, 0.f, 0.f, 0.f};
        float decay = 1.f;
        bf16x8 rq[4], rkt[4], rvt = {0, 0, 0, 0, 0, 0, 0, 0}, rp; float r_ai = 0.f, r_em = 0.f, r_ws = 0.f, r_dec = 1.f;
        const unsigned voffQ = (unsigned)(((tid >> 5) * 4096 + (tid & 31) * 8) * 2), voffT = (unsigned)(((tid >> 3) * M + (tid & 7) * 8) * 2), voffP = (unsigned)(tid * 16), voffS = (unsigned)(lane * 4);
#define ML_LOAD(c) do { const int ncn_ = dir ? 63 - (c) : (c); const size_t trow_ = (size_t)b * SEQ + (size_t)ncn_ * 64; \
        const char* qb_ = (const char*)(QK + trow_ * 4096 + h * 256); \
        _Pragma("unroll") for (int i_ = 0; i_ < 4; ++i_) rq[i_] = *(const bf16x8*)(qb_ + (size_t)i_ * 131072 + voffQ); \
        const char* tb_ = (const char*)(KVT + (size_t)(h * 256) * M + trow_); \
        _Pragma("unroll") for (int i_ = 0; i_ < 4; ++i_) rkt[i_] = *(const bf16x8*)(tb_ + (size_t)i_ * (64 * M * 2) + voffT); \
        if (tid < 256) rvt = *(const bf16x8*)((const char*)(KVT + (size_t)(2048 + h * 256 + es * 32) * M + trow_) + voffT); \
        rp = *(const bf16x8*)((const char*)(PB + (size_t)(seq * 64 + (c)) * 4096) + voffP); \
        { const char* sp_ = (const char*)(SC + (size_t)(seq * 64 + (c)) * 256); r_ai = *(const float*)(sp_ + voffS); r_em = *(const float*)(sp_ + 256 + voffS); r_ws = *(const float*)(sp_ + 512 + voffS); r_dec = *(const float*)(sp_ + 768 + voffS); } } while (0)
#define ML_STORE() do { \
        decay = __uint_as_float(__builtin_amdgcn_readfirstlane(__float_as_uint(r_dec))); \
        if (wid == 0) { sAI[lane] = r_ai; sEM[lane] = r_em; VTw[32 * LS + lane] = (bf16)f2bf(r_ws); } \
        _Pragma("unroll") for (int i_ = 0; i_ < 4; ++i_) { const int q_ = tid + 512 * i_, r_ = q_ >> 5, cc_ = (q_ & 31) * 8; *(LAS bf16x8*)(Qs + r_ * LQ + cc_) = rq[i_]; } \
        _Pragma("unroll") for (int i_ = 0; i_ < 4; ++i_) { const int q_ = tid + 512 * i_, d_ = q_ >> 3, cc_ = (q_ & 7) * 8; *(LAS bf16x8*)(KTs + d_ * LS + cc_) = rkt[i_]; } \
        { const int r_ = tid >> 3, cc_ = (tid & 7) * 8; *(LAS bf16x8*)(Ps + r_ * LS + cc_) = rp; } \
        if (tid < 256) { const int e_ = tid >> 3, cc_ = (tid & 7) * 8; *(LAS bf16x8*)(VTs + e_ * LS + cc_) = rvt; \
            LAS float* wsp_ = sWS + wid * 64; wsp_[lane] = r_ws; asm volatile("s_waitcnt lgkmcnt(0)" ::: "memory"); \
            const f32x4 wa_ = *(const LAS f32x4*)(wsp_ + cc_), wb_ = *(const LAS f32x4*)(wsp_ + cc_ + 4); const float wv_[8] = {wa_.x, wa_.y, wa_.z, wa_.w, wb_.x, wb_.y, wb_.z, wb_.w}; \
            const u32x4 rv_ = __builtin_bit_cast(u32x4, rvt); u32x4 o_; \
            o_.x = pk2(bflo(rv_.x) * wv_[0], bfhi(rv_.x) * wv_[1]); o_.y = pk2(bflo(rv_.y) * wv_[2], bfhi(rv_.y) * wv_[3]); \
            o_.z = pk2(bflo(rv_.z) * wv_[4], bfhi(rv_.z) * wv_[5]); o_.w = pk2(bflo(rv_.w) * wv_[6], bfhi(rv_.w) * wv_[7]); \
            *(LAS u32x4*)(VTw + e_ * LS + cc_) = o_; } } while (0)
        ML_LOAD(0);
        ML_BAR();
        ML_STORE();
        ML_BAR();
        ML_LOAD(1);
        for (int c = 0; c < 64; ++c) {
            const int ncn = dir ? 63 - c : c; const size_t trow = (size_t)b * SEQ + (size_t)ncn * 64;
            const float dec_c = decay;
            LAS bf16* CTr = (LAS bf16*)(lds + OFF_CT0 + (c & 1) * CT_BYTES); LAS bf16* CTw = (LAS bf16*)(lds + OFF_CT0 + ((c & 1) ^ 1) * CT_BYTES);
            f32x4 n3 = {0.f, 0.f, 0.f, 0.f}, d3 = n3, n2 = n3, d2 = n3;
            {
                const LAS bf16* qp = Qs + (tt * 16 + fr) * LQ + fq * 8;
                const LAS bf16* cp0 = CTr + (sh * 16 + fr) * LQ + fq * 8; const LAS bf16* cp2 = CTr + (32 + fr) * LQ + fq * 8;
                bf16x8 pf[2], v0[2], v2[2];
#pragma unroll
                for (int ks = 0; ks < 2; ++ks) { const int ko = ks * 32 + fq * 8;
                    pf[ks] = *(const LAS bf16x8*)(Ps + (tt * 16 + fr) * LS + ko); v0[ks] = *(const LAS bf16x8*)(VTs + (sh * 16 + fr) * LS + ko); v2[ks] = *(const LAS bf16x8*)(VTs + (32 + fr) * LS + ko); }
#pragma unroll
                for (int hf = 0; hf < 2; ++hf) {
                    bf16x8 qf[4], c0[4], c2[4];
#pragma unroll
                    for (int k4 = 0; k4 < 4; ++k4) { const int ko = (hf * 4 + k4) * 32; qf[k4] = *(const LAS bf16x8*)(qp + ko); c0[k4] = *(const LAS bf16x8*)(cp0 + ko); c2[k4] = *(const LAS bf16x8*)(cp2 + ko); }
                    __builtin_amdgcn_sched_barrier(0);
                    if (hf == 0) {
#pragma unroll
                        for (int ks = 0; ks < 2; ++ks) { n2 = ML_MFMA(v0[ks], pf[ks], n2); d2 = ML_MFMA(v2[ks], pf[ks], d2); }
                    }
#pragma unroll
                    for (int k4 = 0; k4 < 4; ++k4) { n3 = ML_MFMA(c0[k4], qf[k4], n3); d3 = ML_MFMA(c2[k4], qf[k4], d3); }
                }
            }
            const int t = tt * 16 + fr;
            {
                const float ai = sAI[t], em = sEM[t];
                const float den0 = d2[0] + ai * d3[0];
                const float den = __shfl(den0, fr);
                const float rinv = 1.0f / fmaxf(fabsf(den), em);
                f32x4 hout; hout.x = (n2[0] + ai * n3[0]) * rinv; hout.y = (n2[1] + ai * n3[1]) * rinv; hout.z = (n2[2] + ai * n3[2]) * rinv; hout.w = (n2[3] + ai * n3[3]) * rinv;
                u32x2 hw; hw.x = pk2(hout.x, hout.y); hw.y = pk2(hout.z, hout.w); *(u32x2*)(HF + ((size_t)dir * M + trow + t) * D + h * 256 + es * 32 + sh * 16 + 4 * fq) = hw;
            }
#pragma unroll
            for (int a = 0; a < 2; ++a)
#pragma unroll
                for (int e = 0; e < 3; ++e) ct[a][e] = ct[a][e] * dec_c;
#pragma unroll
            for (int ks = 0; ks < 2; ++ks) { const int ko = ks * 32 + fq * 8; bf16x8 kt[2], vw[3];
#pragma unroll
                for (int a = 0; a < 2; ++a) kt[a] = *(const LAS bf16x8*)(KTs + ((2 * wid + a) * 16 + fr) * LS + ko);
#pragma unroll
                for (int e = 0; e < 3; ++e) vw[e] = *(const LAS bf16x8*)(VTw + (e * 16 + fr) * LS + ko);
                __builtin_amdgcn_sched_barrier(0);
#pragma unroll
                for (int a = 0; a < 2; ++a)
#pragma unroll
                    for (int e = 0; e < 3; ++e) ct[a][e] = ML_MFMA(kt[a], vw[e], ct[a][e]);
            }
#pragma unroll
            for (int a = 0; a < 2; ++a)
#pragma unroll
                for (int e = 0; e < 3; ++e) { u32x2 w; w.x = f2bf(ct[a][e][0]) | (f2bf(ct[a][e][1]) << 16); w.y = f2bf(ct[a][e][2]) | (f2bf(ct[a][e][3]) << 16);
                    *(LAS u32x2*)(CTw + (e * 16 + fr) * LQ + (2 * wid + a) * 16 + 4 * fq) = w; }
            ML_BAR();
            if (c + 1 < 64) { ML_STORE(); }
            ML_BAR();
            if (c + 2 < 64) { ML_LOAD(c + 2); }
        }
#undef ML_LOAD
#undef ML_STORE
    }
}
}
}

struct EpiRes {
    static constexpr bool PERM = false, AFTER_DRAIN = false;
    const float* base; float* out; int ldc;
    __device__ __forceinline__ void operator()(const pg8::f32x4 (&acc)[2][2][4][2], const pg8::Unit& u, int wr, int wc, int fr, int fq) const {
#pragma unroll
        for (int ai = 0; ai < 2; ++ai)
#pragma unroll
            for (int m = 0; m < 4; ++m) { const size_t ro = (size_t)(u.pm * 256 + ai * 128 + wr * 64 + m * 16 + fr) * ldc + u.pn * 256 + wc * 32 + 4 * fq;
#pragma unroll
                for (int bj = 0; bj < 2; ++bj)
#pragma unroll
                    for (int n = 0; n < 2; ++n) { const size_t off = ro + bj * 128 + n * 16; const pg8::f32x4 bs = *(const pg8::f32x4*)(base + off); *(pg8::f32x4*)(out + off) = bs + acc[ai][bj][m][n]; } }
    }
};

#define ROR1(x) __int_as_float(__builtin_amdgcn_update_dpp(0, __float_as_int(x), 0x121, 0xF, 0xF, false))
#define ROL1(x) __int_as_float(__builtin_amdgcn_update_dpp(0, __float_as_int(x), 0x12F, 0xF, 0xF, false))
struct EpiConv {
    static constexpr bool PERM = true, AFTER_DRAIN = false;
    unsigned short* ACT; unsigned short* HALO; const float* cw; const float* cb;
    __device__ __forceinline__ void operator()(const pg8::f32x4 (&acc)[2][2][4][2], const pg8::Unit& u, int wr, int wc, int fr, int fq) const {
        using mk::FF; using mk::FF2;
        const int jb = u.pn * 128 + wc * 32 + 8 * fq;
        mk::u32x2 keep[2][4];
        pg8::f32x4 cf[2][8];
#pragma unroll
        for (int n = 0; n < 2; ++n) { const int j = jb + 4 * n;
            cf[n][0] = *(const pg8::f32x4*)(cw + j); cf[n][1] = *(const pg8::f32x4*)(cw + FF2 + j); cf[n][2] = *(const pg8::f32x4*)(cw + 2 * FF2 + j); cf[n][3] = *(const pg8::f32x4*)(cb + j);
            cf[n][4] = *(const pg8::f32x4*)(cw + FF + j); cf[n][5] = *(const pg8::f32x4*)(cw + FF2 + FF + j); cf[n][6] = *(const pg8::f32x4*)(cw + 2 * FF2 + FF + j); cf[n][7] = *(const pg8::f32x4*)(cb + FF + j); }
#pragma unroll
        for (int n = 0; n < 2; ++n) {
            const int j = jb + 4 * n;
            const pg8::f32x4 c0g = cf[n][0], c1g = cf[n][1], c2g = cf[n][2], cbg = cf[n][3], c0v = cf[n][4], c1v = cf[n][5], c2v = cf[n][6], cbv = cf[n][7];
#pragma unroll
            for (int ai = 0; ai < 2; ++ai) {
                float gRp[4], vRp[4], gLc[4], vLc[4];
#pragma unroll
                for (int i = 0; i < 4; ++i) { gLc[i] = ROL1(acc[ai][0][0][n][i]); vLc[i] = ROL1(acc[ai][1][0][n][i]); gRp[i] = 0.f; vRp[i] = 0.f; }
#pragma unroll
                for (int m = 0; m < 4; ++m) {
                    const int row = u.pm * 256 + ai * 128 + wr * 64 + m * 16 + fr;
                    float o[4];
#pragma unroll
                    for (int i = 0; i < 4; ++i) {
                        const float g = acc[ai][0][m][n][i], v = acc[ai][1][m][n][i];
                        const float gRc = ROR1(g), vRc = ROR1(v);
                        float gLn = 0.f, vLn = 0.f; if (m < 3) { gLn = ROL1(acc[ai][0][m + 1][n][i]); vLn = ROL1(acc[ai][1][m + 1][n][i]); }
                        float gu = gRc, vu = vRc, gd = gLc[i], vd = vLc[i];
                        if (m > 0) { if (fr == 0) { gu = gRp[i]; vu = vRp[i]; } }
                        if (m < 3) { if (fr == 15) { gd = gLn; vd = vLn; } }
                        gRp[i] = gRc; vRp[i] = vRc; gLc[i] = gLn; vLc[i] = vLn;
                        const float G = c0g[i] * gu + c1g[i] * g + c2g[i] * gd + cbg[i];
                        const float V = c0v[i] * vu + c1v[i] * v + c2v[i] * vd + cbv[i];
                        o[i] = G * __builtin_amdgcn_rcpf(1.0f + __expf(-G)) * V;
                    }
                    const bool edge = (m == 0 && fr == 0) || (m == 3 && fr == 15);
                    { mk::u32x2 w; w.x = mk::pk2(o[0], o[1]); w.y = mk::pk2(o[2], o[3]);
                      if (n == 0) keep[ai][m] = w;
                      else if (!edge) { mk::u32x4 w4; w4.x = keep[ai][m].x; w4.y = keep[ai][m].y; w4.z = w.x; w4.w = w.y; *(mk::u32x4*)(ACT + (size_t)row * FF + jb) = w4; } }
                    if ((m == 0 && fr < 2) || (m == 3 && fr > 13)) {
                        const int hr = (m == 0) ? fr : fr - 12;
                        unsigned short* hp = HALO + ((size_t)(row >> 6) * 4 + hr) * FF2 + j;
                        mk::u32x2 wg, wv; wg.x = mk::f2bf(acc[ai][0][m][n][0]) | (mk::f2bf(acc[ai][0][m][n][1]) << 16); wg.y = mk::f2bf(acc[ai][0][m][n][2]) | (mk::f2bf(acc[ai][0][m][n][3]) << 16);
                        wv.x = mk::f2bf(acc[ai][1][m][n][0]) | (mk::f2bf(acc[ai][1][m][n][1]) << 16); wv.y = mk::f2bf(acc[ai][1][m][n][2]) | (mk::f2bf(acc[ai][1][m][n][3]) << 16);
                        *(mk::u32x2*)hp = wg; *(mk::u32x2*)(hp + FF) = wv;
                    }
                }
            }
        }
    }
};

struct EpiBf16T {
    static constexpr bool PERM = true, AFTER_DRAIN = false;
    unsigned short* O; int ldc; int split_cols; float scale0; unsigned short* T; int tcol0; int ldt;
    __device__ __forceinline__ void operator()(const pg8::f32x4 (&acc)[2][2][4][2], const pg8::Unit& u, int wr, int wc, int fr, int fq) const {
        const int row0 = u.pm * 256 + wr * 64 + fr, colt = u.pn * 256, col0 = colt + wc * 32 + 8 * fq;
        const float sc = (colt < split_cols) ? scale0 : 1.f;
#pragma unroll
        for (int ai = 0; ai < 2; ++ai)
#pragma unroll
            for (int m = 0; m < 4; ++m) { unsigned short* rowp = O + (size_t)(row0 + ai * 128 + m * 16) * ldc + col0;
#pragma unroll
                for (int bj = 0; bj < 2; ++bj) { const pg8::f32x4 v0 = acc[ai][bj][m][0] * sc, v1 = acc[ai][bj][m][1] * sc;
                    mk::u32x4 w; w.x = mk::pk2(v0[0], v0[1]); w.y = mk::pk2(v0[2], v0[3]); w.z = mk::pk2(v1[0], v1[1]); w.w = mk::pk2(v1[2], v1[3]);
                    *(mk::u32x4*)(rowp + bj * 128) = w; } }
        if (colt >= tcol0) {
#pragma unroll
            for (int bj = 0; bj < 2; ++bj)
#pragma unroll
                for (int n = 0; n < 2; ++n)
#pragma unroll
                    for (int i = 0; i < 4; ++i) { unsigned short* tp = T + (size_t)(col0 - tcol0 + bj * 128 + 4 * n + i) * ldt + row0;
#pragma unroll
                        for (int ai = 0; ai < 2; ++ai)
#pragma unroll
                            for (int m = 0; m < 4; ++m) tp[ai * 128 + m * 16] = (unsigned short)mk::f2bf(acc[ai][bj][m][n][i]); }
        }
    }
};

struct GemmDesc { const unsigned short* A; const unsigned short* Bt; int Mg, Ng, Kg; int kind; unsigned short* O; int ldc; int split_cols; float scale0; const float* base; float* out; int G, c; };

#ifndef REPEAT_PH
#define REPEAT_PH 1000
#define N_REPEAT 0
#else
#define N_REPEAT 1
#endif
struct Params { const float* in[17]; float* out; unsigned char* ws; int ph_lo, ph_hi; };
constexpr int N_PHASES = 18;

__global__ void __launch_bounds__(512, 2) fwd_mega(Params p) {
    extern __shared__ __attribute__((aligned(16))) unsigned char lds_raw[];
    using namespace mk;
    cg::grid_group grid = cg::this_grid();
    LAS unsigned char* lds = (LAS unsigned char*)lds_raw;
    const int bid = blockIdx.x, nblk = gridDim.x;
    const int ph_lo = p.ph_lo, ph_hi = p.ph_hi;
    { volatile LAS unsigned* misc = (volatile LAS unsigned*)(lds + LDS_MISC); if (mk_tid() < 16) misc[mk_tid()] = 0u; }
    __syncthreads();
    (void)xcd_barrier_post((unsigned*)(p.ws + WS_BAR), (volatile LAS unsigned*)(lds + LDS_MISC) + 8);
    if (ph_lo < 0) grid.sync();
#ifdef PROBE_PH
    const unsigned long long t_start = __builtin_amdgcn_s_memrealtime();
#endif
#pragma unroll 1
    for (int ph_it = ph_lo; ph_it < ph_hi + N_REPEAT; ++ph_it) {
        const int ph = ph_it <= REPEAT_PH ? ph_it : ph_it - N_REPEAT;
        typedef const __attribute__((address_space(4))) Params* KP;
        KP kp = (KP)__builtin_amdgcn_kernarg_segment_ptr(); asm volatile("" : "+s"(kp));
        unsigned char* ws = kp->ws; float* OUT = kp->out; bf16* XN = (bf16*)(ws + WS_XN);
        In I; I.x = kp->in[0]; I.norm_mix = kp->in[1]; I.norm_ffn = kp->in[2]; I.w_in_ab = kp->in[3]; I.pool_w = kp->in[4]; I.pool_scale = kp->in[5]; I.q_norm = kp->in[6]; I.k_norm = kp->in[7];
        I.w_out_ab = kp->in[8]; I.w_in_c = kp->in[9]; I.b_gate = kp->in[10]; I.h_norm = kp->in[11]; I.w_out_c = kp->in[12]; I.w_up = kp->in[13]; I.conv_w = kp->in[14]; I.conv_b = kp->in[15]; I.w_down = kp->in[16];
        int nb_ = nblk; asm volatile("" : "+s"(nb_)); const int ngw = nb_ * NW, ngt = nb_ * 512;
        const int tid = mk_tid(), lane = tid & 63, wave = __builtin_amdgcn_readfirstlane(tid >> 6), gw = bid * NW + wave, gt = bid * 512 + tid;
#ifndef NO_THIN
        if (ph == 0) prologue(I, ws, lds, gw, ngw, wave, lane);
        if (ph == 5 || ph == 9 || ph == 14) rmsnorm_rows(OUT, ph == 5 ? I.norm_ffn : (ph == 9 ? I.norm_mix + D : I.norm_ffn + D), XN, gw, ngw, lane);
        if (ph == 2) qk_rope_pool((bf16*)(ws + WS_PROJ), I.q_norm, I.k_norm, (bf16*)(ws + WS_POOLED), gw, ngw, lane);
#endif
#ifndef NO_ATT
        if (ph == 3) {
            const bf16* PROJ = (const bf16*)(ws + WS_PROJ); bf16* CAT = (bf16*)(ws + WS_CAT);
            for (int u0 = bid; u0 < 384; u0 += nblk) {
                int u = u0;
                if (nblk == 256) { const int xcd = u0 & 7, j = (u0 >> 3) & 31, rnd = u0 >> 8; const int jj = j + 32 * rnd;
                    if (jj >= 48) continue; u = (xcd >> 2) * 192 + ((xcd & 3) * 3 + (jj >> 4)) * 16 + (jj & 15); }
                const int qb = u & 15, hq = (u >> 4) % 12, b = u / 192;
                const size_t r0 = (size_t)b * SEQ + (size_t)qb * 256;
                att::attn_dense_body<att::bf16>((const att::bf16*)(PROJ + r0 * ABW + 512 + hq * 128), (const att::bf16*)(PROJ + (size_t)b * SEQ * ABW + 2048 + (hq / 3) * 128),
                                                (const att::bf16*)(PROJ + (size_t)b * SEQ * ABW + 2560 + (hq / 3) * 128), CAT + r0 * D + 512 + hq * 128, SEQ, (char*)lds_raw);
                __syncthreads();
            }
        }
#endif
#ifndef NO_THIN
        if (ph == 7 || ph == 16) { const int l = ph == 7 ? 0 : 1; conv_fix((const bf16*)(ws + WS_U), I.conv_w + (size_t)l * 3 * FF2, I.conv_b + (size_t)l * FF2, (bf16*)(ws + WS_ACT), gt, ngt); }
        if (ph == 10) gates_phase(XN, (const bf16*)(ws + WS_C) + (size_t)8192 * D, I.b_gate, (float*)(ws + WS_GATES), (LAS float*)lds, bid, nblk);
#endif
#ifndef NO_ML
        if (ph == 11) {
            ml::mlstm_pre(lds, (const bf16*)(ws + WS_QK), (const float*)(ws + WS_GATES), (bf16*)(ws + WS_PB), (float*)(ws + WS_SC), bid, nblk);
            { XcdBarrier xb2; xb2.bar = (unsigned*)(ws + WS_BAR); xb2.x = xb_xcc_id(); xb2.st = (volatile LAS unsigned*)(lds + LDS_MISC) + 8; xcd_barrier(xb2); }
            ml::mlstm_seq(lds, (const bf16*)(ws + WS_QK), (const bf16*)(ws + WS_KVT), (const bf16*)(ws + WS_PB), (const float*)(ws + WS_SC), (bf16*)(ws + WS_HF), bid, nblk);
        }
#endif
#ifndef NO_THIN
        if (ph == 12) headnorm_phase((const bf16*)(ws + WS_HF), (const bf16*)(ws + WS_OG), I.h_norm, (bf16*)(ws + WS_Y), gw, ngw, lane);
#endif
#pragma unroll 1
        for (int gi = 0; gi < 3; ++gi) {
            GemmDesc d; d.kind = -1; d.G = nblk; d.c = bid; d.split_cols = 0; d.scale0 = 1.f; d.base = nullptr; d.out = nullptr; d.O = nullptr; d.ldc = 0; d.A = nullptr; d.Bt = nullptr; d.Mg = M; d.Ng = 0; d.Kg = D;
            if (gi == 0) {
                if (ph == 1) { d.kind = 0; d.A = XN; d.Bt = (bf16*)(ws + WS_AB); d.Ng = ABW; d.O = (bf16*)(ws + WS_PROJ); d.ldc = ABW; }
                else if (ph == 3) { d.kind = 0; d.A = (bf16*)(ws + WS_POOLED); d.Bt = (bf16*)(ws + WS_BD); d.Ng = 512; d.Kg = 512; d.O = (bf16*)(ws + WS_CAT); d.ldc = D;
                    if (nblk == 256) { const int slot = bid >> 3; d.G = 64; d.c = (slot - 16) * 8 + (bid & 7); if (slot < 16 || slot >= 24) d.kind = -1; } }
                else if (ph == 4) { d.kind = 1; d.A = (bf16*)(ws + WS_CAT); d.Bt = (bf16*)(ws + WS_OAB); d.Ng = D; d.base = I.x; d.out = OUT; }
                else if (ph == 6 || ph == 15) { d.kind = 2; d.A = XN; d.Bt = (bf16*)(ws + (ph == 6 ? WS_UP0 : WS_UP1)); d.Ng = FF2; d.O = (bf16*)(ws + WS_U); d.ldc = FF2; d.base = I.conv_w + (size_t)(ph == 6 ? 0 : 1) * 3 * FF2; d.out = (float*)(I.conv_b + (size_t)(ph == 6 ? 0 : 1) * FF2); }
                else if (ph == 8 || ph == 17) { d.kind = 1; d.A = (bf16*)(ws + WS_ACT); d.Bt = (bf16*)(ws + (ph == 8 ? WS_DN0 : WS_DN1)); d.Ng = D; d.Kg = FF; d.base = OUT; d.out = OUT; }
                else if (ph == 10) { d.kind = 3; d.A = XN; d.Bt = (bf16*)(ws + WS_C); d.Ng = 4096; d.O = (bf16*)(ws + WS_QK); d.ldc = 4096; d.split_cols = 2048; d.scale0 = 0.0625f; }
                else if (ph == 13) { d.kind = 1; d.A = (bf16*)(ws + WS_Y); d.Bt = (bf16*)(ws + WS_OC); d.Ng = D; d.base = OUT; d.out = OUT; }
            } else if (ph == 10) {
                if (gi == 1) { d.kind = 0; d.A = XN; d.Bt = (bf16*)(ws + WS_C) + (size_t)6144 * D; d.Ng = D; d.O = (bf16*)(ws + WS_OG); d.ldc = D; }
                else { d.kind = 0; d.A = (bf16*)(ws + WS_C) + (size_t)4096 * D; d.Bt = XN; d.Mg = 2048; d.Ng = M; d.O = (bf16*)(ws + WS_KVT) + (size_t)2048 * M; d.ldc = M; }
            }
#ifndef NO_GEMM
            if (d.kind == 0) {
                pg8::Gemm g{d.A, d.Bt, d.Mg, d.Ng, d.Kg}; pg8::StaticOrder S; S.init(d.Mg, d.Ng, d.G, d.c);
                pg8::EpiBf16<0> E{d.O, d.ldc, nullptr, d.split_cols, (size_t)d.split_cols, d.scale0};
                pg8::gemm_phase<pg8::EpiBf16<0>, pg8::StaticOrder, true, true>(lds, g, S, E);
            } else if (d.kind == 3) {
                pg8::Gemm g{d.A, d.Bt, d.Mg, d.Ng, d.Kg}; pg8::StaticOrder S; S.init(d.Mg, d.Ng, d.G, d.c);
                EpiBf16T E{d.O, d.ldc, d.split_cols, d.scale0, (bf16*)(ws + WS_KVT), 2048, M};
                pg8::gemm_phase<EpiBf16T, pg8::StaticOrder, true, true>(lds, g, S, E);
            } else if (d.kind == 2) {
                pg8::Gemm g{d.A, d.Bt, d.Mg, d.Ng, d.Kg}; pg8::StaticOrder S; S.init(d.Mg, d.Ng, d.G, d.c);
                EpiConv E{(bf16*)(ws + WS_ACT), d.O, d.base, (const float*)d.out};
                pg8::gemm_phase<EpiConv, pg8::StaticOrder, true, true>(lds, g, S, E);
            } else if (d.kind == 1) {
                pg8::Gemm g{d.A, d.Bt, d.Mg, d.Ng, d.Kg}; pg8::StaticOrder S; S.init(d.Mg, d.Ng, d.G, d.c);
                EpiRes E{d.base, d.out, D};
                pg8::gemm_phase<EpiRes, pg8::StaticOrder, true, true>(lds, g, S, E);
            }
#endif
            __syncthreads();
        }
#ifndef NO_THIN
        if (nb_ == 256) {
            if (ph == 1 && bid >= 128) { const int w = (bid - 128) * NW + wave; transposes(I, ws, lds, 1536, 2560, w, 128 * NW, wave, lane); transposes(I, ws, lds, 18944, 24576, w, 128 * NW, wave, lane); }
            if (ph == 3 && (bid >> 3) >= 16) { const int w = (((bid >> 3) - 16) * 8 + (bid & 7)) * NW + wave; transposes(I, ws, lds, 2560, 13312, w, 128 * NW, wave, lane); }
            if (ph == 6 && bid >= 128) { const int w = (bid - 128) * NW + wave; transposes(I, ws, lds, 13312, 18944, w, 128 * NW, wave, lane); }
        } else if (ph == 1) transposes(I, ws, lds, 1536, 24576, gw, ngw, wave, lane);
#endif
        if (ph_it + 1 < ph_hi + N_REPEAT) { XcdBarrier xbar; xbar.bar = (unsigned*)(ws + WS_BAR); xbar.x = xb_xcc_id(); xbar.st = (volatile LAS unsigned*)(lds + LDS_MISC) + 8; xcd_barrier(xbar);
#ifdef SYNC2
            xcd_barrier(xbar);
#endif
        }
#ifdef PROBE_PH
        if (bid == 0 && tid == 0) { unsigned long long* ts = (unsigned long long*)(ws + WS_BD + 768 * 1024); ts[ph + 1] = __builtin_amdgcn_s_memrealtime(); if (ph == 0) ts[0] = t_start;
            if (ph + 1 == ph_hi) { OUT[0] = (float)(ts[PROBE_PH + 1] - ts[PROBE_PH]) * 0.01f; } }
#endif
    }
}

#ifndef MK_MULTI
#define MK_MULTI 0
#endif
extern "C" void kernel_launch(void* const* d_in, const int* in_sizes, int n_in, void* d_out, int out_size, void* d_ws, size_t ws_size, hipStream_t stream) {
    static int grid = 0;
    if (grid == 0) {
        if (n_in != 17 || out_size != mk::M * mk::D || ws_size < mk::WS_END) { fprintf(stderr, "kernel_launch: unexpected shapes n_in %d out %d ws %zu (need %zu)\n", n_in, out_size, ws_size, (size_t)mk::WS_END); grid = -1; return; }
        int dev = 0, cus = 0, per_cu = 0;
        (void)hipGetDevice(&dev); (void)hipDeviceGetAttribute(&cus, hipDeviceAttributeMultiprocessorCount, dev);
        if (hipFuncSetAttribute((const void*)fwd_mega, hipFuncAttributeMaxDynamicSharedMemorySize, mk::LDS_BYTES) != hipSuccess) { fprintf(stderr, "kernel_launch: hipFuncSetAttribute failed\n"); grid = -1; return; }
        if (hipOccupancyMaxActiveBlocksPerMultiprocessor(&per_cu, (const void*)fwd_mega, 512, mk::LDS_BYTES) != hipSuccess || per_cu < 1) { fprintf(stderr, "kernel_launch: occupancy query gave %d\n", per_cu); per_cu = 1; }
        (void)hipGetLastError();
        if (cus <= 0) cus = 256;
        grid = cus * per_cu; if (grid > 256) grid = 256;
        fprintf(stderr, "kernel_launch: cus %d per_cu %d grid %d\n", cus, per_cu, grid);
    }
    if (grid < 0) return;
    if (hipMemsetAsync((char*)d_ws + mk::WS_BAR, 0, mk::BAR_BYTES, stream) != hipSuccess) { fprintf(stderr, "kernel_launch: memset failed\n"); return; }
    Params p{};
    for (int i = 0; i < 17; ++i) p.in[i] = (const float*)d_in[i];
    p.out = (float*)d_out; p.ws = (unsigned char*)d_ws;
#if MK_MULTI
    for (int ph = 0; ph < N_PHASES; ++ph) { p.ph_lo = ph; p.ph_hi = ph + 1; hipLaunchKernelGGL(fwd_mega, dim3(grid), dim3(512), mk::LDS_BYTES, stream, p); }
#else
    p.ph_lo = 0; p.ph_hi = N_PHASES;
    void* args[] = {&p};
    const hipError_t e = hipLaunchCooperativeKernel((const void*)fwd_mega, dim3(grid), dim3(512), args, mk::LDS_BYTES, stream);
    if (e != hipSuccess) fprintf(stderr, "kernel_launch: cooperative launch failed: %s (grid %d)\n", hipGetErrorString(e), grid);
#endif
}
```

```cpp
#include <hip/hip_runtime.h>
#include <hip/hip_cooperative_groups.h>
#include <hip/hip_bf16.h>
#include <cstdio>
#include <cstdint>
#include <cmath>
namespace cg = cooperative_groups;
__device__ __forceinline__ int mk_tid();
namespace pg8 {
#define PG8_LAS __attribute__((address_space(3)))
typedef unsigned short bf16_t;
typedef short bf16x8 __attribute__((ext_vector_type(8)));
typedef float f32x4 __attribute__((ext_vector_type(4)));
typedef unsigned u32x4 __attribute__((ext_vector_type(4)));
constexpr int BM = 256, BK = 64, HALF = 128, HTB = HALF * BK * 2  , STAGE_BYTES = 8 * HTB, NXCD = 8, WGM = 8;

__host__ __device__ __forceinline__ int lds_byte(int r, int c) { const int st = (r >> 4) * 2 + (c >> 5), rr = r & 15, cc = c & 31, ob = rr * 64 + cc * 2; return st * 1024 + (ob ^ (((ob >> 9) & 1) << 5)); }
__host__ __device__ __forceinline__ void stage_rc(int b, int& R, int& C) { const int st = b / 1024, sb = b % 1024, swz = sb ^ (((sb >> 9) & 1) << 5); R = (st >> 1) * 16 + swz / 64; C = (st & 1) * 32 + (swz % 64) / 2; }
__host__ __device__ __forceinline__ int perm32(int rho) { const int n = rho >> 4, i = rho & 15; return 8 * (i >> 2) + 4 * n + (i & 3); }

struct Unit { int pm, pn; };
struct Gemm { const bf16_t* A; const bf16_t* Bt; int M, N, K; };

struct StaticOrder {
    int nM, nN, nwg, G, c;
    __host__ __device__ void init(int M, int N, int G_, int c_) { nM = M / BM; nN = N / BM; nwg = nM * nN; G = G_; c = c_; }
    __host__ __device__ bool next(int i, Unit& u) const {
        const long L = (long)i * G + c; if (L >= nwg) return false;
        int wgid = (int)L; { const int q = nwg / NXCD, r = nwg % NXCD, xcd = wgid % NXCD, off = wgid / NXCD; wgid = (xcd < r ? xcd * (q + 1) : r * (q + 1) + (xcd - r) * q) + off; }
        const int nig = WGM * nN, gid = wgid / nig, fm = gid * WGM, gsz = (nM - fm) < WGM ? (nM - fm) : WGM;
        u.pm = fm + ((wgid % nig) % gsz); u.pn = (wgid % nig) / gsz; return true;
    }
    __device__ __forceinline__ void a_ready(const Unit&) const {}
    __device__ __forceinline__ void done(const Unit&) const {}
};

__device__ __forceinline__ unsigned cvt_pk_bf16(float lo, float hi) { unsigned r; asm volatile("v_cvt_pk_bf16_f32 %0, %1, %2" : "=v"(r) : "v"(lo), "v"(hi)); return r; }
typedef float f32x2 __attribute__((ext_vector_type(2)));
__device__ __forceinline__ f32x2 gelu_pk(f32x2 v) {
    const f32x2 av = __builtin_elementwise_abs(v), d = av * 0.2316418882f + 1.0f;
    f32x2 t; t.x = __builtin_amdgcn_rcpf(d.x); t.y = __builtin_amdgcn_rcpf(d.y);
    f32x2 q = t * 0.5307027145f + (-0.7265760135f); q = q * t + 0.7107068705f; q = q * t + (-0.142248368f); q = q * t + 0.127414796f; q = q * t;
    const f32x2 s = (v * v) * (-0.72134752044f);
    f32x2 e; e.x = __builtin_amdgcn_exp2f(s.x); e.y = __builtin_amdgcn_exp2f(s.y);
    const f32x2 m = v * (q * e), r = v - m;
    f32x2 o; o.x = v.x < 0.f ? m.x : r.x; o.y = v.y < 0.f ? m.y : r.y; return o;
}

template <int ACT  > struct EpiBf16 {
    static constexpr bool PERM = true, AFTER_DRAIN = false; static_assert(ACT == 0 || ACT == 1, "EpiBf16: ACT is 0 (none) or 1 (gelu_pk)");
    bf16_t* O; int ldc; const float* bias; int split_cols; size_t split_stride; float scale0;
    __device__ __forceinline__ void operator()(const f32x4 (&acc)[2][2][4][2], const Unit& u, int wr, int wc, int fr, int fq) const {
        const int row0 = u.pm * BM + wr * 64 + fr; int colt = u.pn * BM; bf16_t* base = O;
        float sc = 1.f; if (split_cols) { const int t = colt / split_cols; base += (size_t)t * split_stride; colt -= t * split_cols; if (t == 0) sc = scale0; }
        const int col0 = colt + wc * 32 + 8 * fq, bcol0 = u.pn * BM + wc * 32 + 8 * fq;
        f32x4 bv[2][2];
#pragma unroll
        for (int bj = 0; bj < 2; ++bj)
#pragma unroll
            for (int n = 0; n < 2; ++n) bv[bj][n] = bias ? *(const f32x4*)(bias + bcol0 + bj * HALF + 4 * n) : (f32x4){0.f, 0.f, 0.f, 0.f};
#pragma unroll
        for (int ai = 0; ai < 2; ++ai)
#pragma unroll
            for (int m = 0; m < 4; ++m) { bf16_t* rowp = base + (size_t)(row0 + ai * HALF + m * 16) * ldc + col0;
#pragma unroll
                for (int bj = 0; bj < 2; ++bj) { f32x4 v0 = acc[ai][bj][m][0] + bv[bj][0], v1 = acc[ai][bj][m][1] + bv[bj][1];
                    if (ACT == 1) { f32x2 a = gelu_pk((f32x2){v0[0], v0[1]}), b = gelu_pk((f32x2){v0[2], v0[3]}), c = gelu_pk((f32x2){v1[0], v1[1]}), d = gelu_pk((f32x2){v1[2], v1[3]});
                        v0 = (f32x4){a.x, a.y, b.x, b.y}; v1 = (f32x4){c.x, c.y, d.x, d.y}; }
                    v0 = v0 * sc; v1 = v1 * sc; u32x4 w; w.x = cvt_pk_bf16(v0[0], v0[1]); w.y = cvt_pk_bf16(v0[2], v0[3]); w.z = cvt_pk_bf16(v1[0], v1[1]); w.w = cvt_pk_bf16(v1[2], v1[3]);
                    *(u32x4*)(rowp + bj * HALF) = w; } }
    }
};

template <class Epi, class Sched, bool ALIGN_EPI = false, bool SP2 = false>
__device__ __forceinline__ void gemm_phase(PG8_LAS unsigned char* lds, const Gemm g, const Sched& S, const Epi& E) {
    const int tid = mk_tid(), wid = __builtin_amdgcn_readfirstlane(tid >> 6), lane = tid & 63, wr = wid >> 2, wc = wid & 3, fr = lane & 15, fq = lane >> 4;
    const int K = g.K, nt = K / BK;
    unsigned voffA[2], voffB[2];
#pragma unroll
    for (int i = 0; i < 2; ++i) { int R, C; stage_rc(tid * 16 + i * 8192, R, C); const int Rb = Epi::PERM ? ((R & ~31) + perm32(R & 31)) : R;
        voffA[i] = (unsigned)(R * K + C) * 2u; voffB[i] = (unsigned)(Rb * K + C) * 2u; }
    const size_t kstep = (size_t)(BK * 2);
    const size_t hstep = (size_t)HALF * K * 2;
    const size_t tstep = 2 * hstep;
    const unsigned ldsw = (unsigned)wid * 1024u;
    const int aoff = lds_byte(wr * 64 + fr, fq * 8), boff = lds_byte(wc * 32 + fr, fq * 8);
#define PG8_SA(b, h) (((b) * 2 + (h)) * HTB)
#define PG8_SB(b, h) ((4 + (b) * 2 + (h)) * HTB)
#define PG8_STAGE(bufoff, gbase, voff) do { _Pragma("unroll") for (int _i = 0; _i < 2; ++_i) \
        __builtin_amdgcn_global_load_lds((const unsigned*)((const char*)(gbase) + (voff)[_i]), (PG8_LAS unsigned*)(lds + (bufoff) + ldsw + _i * 8192), 16, 0, 0); } while (0)
#define PG8_LDA(dst, b, h) do { _Pragma("unroll") for (int m = 0; m < 4; ++m) _Pragma("unroll") for (int k = 0; k < 2; ++k) dst[m][k] = *(const PG8_LAS bf16x8*)(lds + PG8_SA(b, h) + aoff + m * 2048 + k * 1024); } while (0)
#define PG8_LDB(dst, b, h) do { _Pragma("unroll") for (int n = 0; n < 2; ++n) _Pragma("unroll") for (int k = 0; k < 2; ++k) dst[n][k] = *(const PG8_LAS bf16x8*)(lds + PG8_SB(b, h) + boff + n * 2048 + k * 1024); } while (0)
#define PG8_MMA(ai, bj, At, Bt) do { __builtin_amdgcn_s_setprio(1); _Pragma("unroll") for (int m = 0; m < 4; ++m) _Pragma("unroll") for (int n = 0; n < 2; ++n) _Pragma("unroll") for (int k = 0; k < 2; ++k) \
        acc[ai][bj][m][n] = __builtin_amdgcn_mfma_f32_16x16x32_bf16(Bt[n][k], At[m][k], acc[ai][bj][m][n], 0, 0, 0); __builtin_amdgcn_s_setprio(0); } while (0)
#define PG8_WAIT_V(n) asm volatile("s_waitcnt vmcnt(" #n ")" ::: "memory")
#define PG8_WAIT_L(n) asm volatile("s_waitcnt lgkmcnt(" #n ")" ::: "memory")
#define PG8_BAR __builtin_amdgcn_s_barrier()
#define PG8_SCHED __builtin_amdgcn_sched_barrier(0)
    Unit cur, nxt; int ui = 0;
    if (!S.next(0, cur)) return;
    f32x4 acc[2][2][4][2];
#pragma unroll
    for (int a = 0; a < 2; ++a)
#pragma unroll
        for (int b = 0; b < 2; ++b)
#pragma unroll
            for (int m = 0; m < 4; ++m)
#pragma unroll
                for (int n = 0; n < 2; ++n) acc[a][b][m][n] = (f32x4){0.f, 0.f, 0.f, 0.f};
    bf16x8 At[4][2], B0[2][2], B1[2][2];
    const char* cA = (const char*)g.A + (size_t)cur.pm * tstep; const char* cB = (const char*)g.Bt + (size_t)cur.pn * tstep;
    S.a_ready(cur);
    if constexpr (SP2) {
        PG8_STAGE(PG8_SB(0, 0), cB, voffB); PG8_STAGE(PG8_SB(0, 1), cB + hstep, voffB); PG8_STAGE(PG8_SA(0, 0), cA, voffA); PG8_STAGE(PG8_SA(0, 1), cA + hstep, voffA);
        if (wr == 1) PG8_BAR;
        PG8_WAIT_V(2); PG8_BAR;
        PG8_STAGE(PG8_SB(1, 0), cB + kstep, voffB); PG8_STAGE(PG8_SA(1, 0), cA + kstep, voffA); PG8_STAGE(PG8_SB(1, 1), cB + hstep + kstep, voffB);
        PG8_WAIT_V(6); PG8_BAR;
    } else {
        PG8_STAGE(PG8_SB(0, 0), cB, voffB); PG8_STAGE(PG8_SA(0, 0), cA, voffA); PG8_STAGE(PG8_SB(0, 1), cB + hstep, voffB); PG8_STAGE(PG8_SA(0, 1), cA + hstep, voffA);
        if (wr == 1) PG8_BAR;
        PG8_WAIT_V(4); PG8_BAR;
        PG8_STAGE(PG8_SB(1, 0), cB + kstep, voffB); PG8_STAGE(PG8_SA(1, 0), cA + kstep, voffA); PG8_STAGE(PG8_SB(1, 1), cB + hstep + kstep, voffB);
        PG8_WAIT_V(6); PG8_BAR;
    }
    for (;;) {
        const bool has_next = S.next(ui + 1, nxt);
        const char* nA = has_next ? (const char*)g.A + (size_t)nxt.pm * tstep : cA; const char* nB = has_next ? (const char*)g.Bt + (size_t)nxt.pn * tstep : cB;
        for (int t = 0; t < nt; t += 2) {
            const bool last = (t == nt - 2);
            const char* a1 = cA + (size_t)(t + 1) * kstep;
            const char* a2 = last ? nA : cA + (size_t)(t + 2) * kstep; const char* b2 = last ? nB : cB + (size_t)(t + 2) * kstep;
            const char* a3 = a2 + kstep; const char* b3 = b2 + kstep;
            if (last && has_next) S.a_ready(nxt);
            if constexpr (SP2) {
            PG8_LDB(B0, 0, 0); PG8_LDB(B1, 0, 1); PG8_SCHED; PG8_LDA(At, 0, 0); PG8_STAGE(PG8_SA(1, 1), a1 + hstep, voffA);
            PG8_WAIT_V(8); PG8_WAIT_L(0); PG8_BAR; PG8_MMA(0, 0, At, B0); PG8_MMA(0, 1, At, B1); PG8_BAR; PG8_SCHED;
            PG8_LDA(At, 0, 1); PG8_STAGE(PG8_SB(0, 0), b2, voffB); PG8_STAGE(PG8_SB(0, 1), b2 + hstep, voffB); PG8_STAGE(PG8_SA(0, 0), a2, voffA);
            PG8_WAIT_V(8); PG8_WAIT_L(0); PG8_BAR; PG8_MMA(1, 0, At, B0); PG8_MMA(1, 1, At, B1); PG8_BAR; PG8_SCHED;
            PG8_LDB(B0, 1, 0); PG8_LDB(B1, 1, 1); PG8_SCHED; PG8_LDA(At, 1, 0); PG8_STAGE(PG8_SA(0, 1), a2 + hstep, voffA);
            PG8_WAIT_V(8); PG8_WAIT_L(0); PG8_BAR; PG8_MMA(0, 0, At, B0); PG8_MMA(0, 1, At, B1); PG8_BAR; PG8_SCHED;
            PG8_LDA(At, 1, 1); PG8_STAGE(PG8_SB(1, 0), b3, voffB); PG8_STAGE(PG8_SB(1, 1), b3 + hstep, voffB); PG8_STAGE(PG8_SA(1, 0), a3, voffA);
            PG8_WAIT_V(8); PG8_WAIT_L(0); PG8_BAR; PG8_MMA(1, 0, At, B0); PG8_MMA(1, 1, At, B1); PG8_BAR; PG8_SCHED;
            } else {
            PG8_LDB(B0, 0, 0); PG8_SCHED; PG8_LDA(At, 0, 0); PG8_STAGE(PG8_SA(1, 1), a1 + hstep, voffA);
            PG8_WAIT_L(8); PG8_BAR; PG8_WAIT_L(0); PG8_MMA(0, 0, At, B0); PG8_BAR; PG8_SCHED;
            PG8_LDB(B1, 0, 1); PG8_STAGE(PG8_SB(0, 0), b2, voffB);
            PG8_BAR; PG8_WAIT_L(0); PG8_MMA(0, 1, At, B1); PG8_BAR;
            PG8_LDA(At, 0, 1); PG8_STAGE(PG8_SA(0, 0), a2, voffA);
            PG8_BAR; PG8_WAIT_L(0); PG8_MMA(1, 0, At, B0); PG8_BAR; PG8_SCHED;
            PG8_STAGE(PG8_SB(0, 1), b2 + hstep, voffB);
            PG8_WAIT_V(6); PG8_BAR; PG8_MMA(1, 1, At, B1); PG8_BAR;
            PG8_LDB(B0, 1, 0); PG8_SCHED; PG8_LDA(At, 1, 0); PG8_STAGE(PG8_SA(0, 1), a2 + hstep, voffA);
            PG8_WAIT_L(8); PG8_BAR; PG8_WAIT_L(0); PG8_MMA(0, 0, At, B0); PG8_BAR; PG8_SCHED;
            PG8_LDB(B1, 1, 1); PG8_STAGE(PG8_SB(1, 0), b3, voffB);
            PG8_BAR; PG8_WAIT_L(0); PG8_MMA(0, 1, At, B1); PG8_BAR;
            PG8_LDA(At, 1, 1); PG8_STAGE(PG8_SA(1, 0), a3, voffA);
            PG8_BAR; PG8_WAIT_L(0); PG8_MMA(1, 0, At, B0); PG8_BAR; PG8_SCHED;
            PG8_STAGE(PG8_SB(1, 1), b3 + hstep, voffB);
            PG8_WAIT_V(6); PG8_BAR; PG8_MMA(1, 1, At, B1); PG8_BAR;
            }
        }
        if constexpr (ALIGN_EPI) { if (wr == 0) PG8_BAR; }
        if constexpr (!Epi::AFTER_DRAIN) { E(acc, cur, wr, wc, fr, fq); S.done(cur); }
        if (!has_next) break;
#pragma unroll
        for (int a = 0; a < 2; ++a)
#pragma unroll
            for (int b = 0; b < 2; ++b)
#pragma unroll
                for (int m = 0; m < 4; ++m)
#pragma unroll
                    for (int n = 0; n < 2; ++n) acc[a][b][m][n] = (f32x4){0.f, 0.f, 0.f, 0.f};
        cur = nxt; cA = nA; cB = nB; ++ui;
        if constexpr (ALIGN_EPI) { if (wr == 1) PG8_BAR; }
    }
    PG8_WAIT_V(0);
    if constexpr (!ALIGN_EPI) { if (wr == 0) PG8_BAR; }
    PG8_BAR;
    if constexpr (Epi::AFTER_DRAIN) { E.fused(acc, cur, wr, wc, fr, fq, lds, wid, lane); S.done(cur); }
#undef PG8_SA
#undef PG8_SB
#undef PG8_STAGE
#undef PG8_LDA
#undef PG8_LDB
#undef PG8_MMA
#undef PG8_WAIT_V
#undef PG8_WAIT_L
#undef PG8_BAR
#undef PG8_SCHED
}
}

namespace att {
using bf16 = __hip_bfloat16;
constexpr int   D = 128, NW = 8, QBLK = 32, KVBLK = 64;
constexpr float SCALE = 0.088388347648318440f;
constexpr float THR = 8.f;
constexpr int SDEPTH = 2;
constexpr int LDQ = 3072, LDK = 3072, LDO = 2048;
constexpr size_t SHM_V = KVBLK * D * 2, SHM_K = KVBLK * D * 2, SHM_ATTN = 2 * SHM_V + 2 * SHM_K + NW * 64 * 4;
using bf16x8 = __attribute__((ext_vector_type(8))) short;
using s16x4  = __attribute__((ext_vector_type(4))) short;
using f32x16 = __attribute__((ext_vector_type(16))) float;
using f32x8  = __attribute__((ext_vector_type(8))) float;
using u32x4  = __attribute__((ext_vector_type(4))) unsigned;
#define KSWZ(row, colB) ((row) * 256 + ((colB) ^ (((row) & 7) << 4)))
#define SBAR() __builtin_amdgcn_sched_barrier(0)
__device__ __forceinline__ int crow(int r, int hi) { return (r & 3) + 8 * (r >> 2) + 4 * hi; }
__device__ __forceinline__ unsigned cvtpk(float lo, float hi) {
  unsigned r; asm volatile("v_cvt_pk_bf16_f32 %0, %1, %2" : "=v"(r) : "v"(lo), "v"(hi)); return r;
}
template <typename TIn> struct Stage;
template <> struct Stage<bf16>  { using T = bf16x8;
  __device__ static __forceinline__ T ld8(const bf16* p) { return *reinterpret_cast<const bf16x8*>(p); }
  __device__ static __forceinline__ bf16x8 tobf(T x) { return x; } };
template <> struct Stage<float> { using T = f32x8;
  __device__ static __forceinline__ T ld8(const float* p) { return *reinterpret_cast<const f32x8*>(p); }
  __device__ static __forceinline__ bf16x8 tobf(T x) {
    u32x4 w = {cvtpk(x[0], x[1]), cvtpk(x[2], x[3]), cvtpk(x[4], x[5]), cvtpk(x[6], x[7])}; return *reinterpret_cast<bf16x8*>(&w); } };

__device__ __forceinline__ void partialSM(f32x16& p0, f32x16& p1, float& m_reg, float& mn, float& alpha) {
  constexpr float C = SCALE * 1.4426950408889634f;
  float pmax = p0[0]; for (int r = 1; r < 16; ++r) pmax = fmaxf(pmax, p0[r]); for (int r = 0; r < 16; ++r) pmax = fmaxf(pmax, p1[r]);
  { auto rr = __builtin_amdgcn_permlane32_swap(__float_as_uint(pmax), __float_as_uint(pmax), false, false);
    pmax = fmaxf(__uint_as_float(rr[0]), __uint_as_float(rr[1])); }
  if (__builtin_expect(__all(pmax - m_reg <= THR / SCALE), 1)) { mn = m_reg; alpha = 1.f; }
  else { mn = fmaxf(m_reg, pmax); alpha = __builtin_amdgcn_exp2f((m_reg - mn) * C); m_reg = mn; }
  float mnC = -mn * C;
  for (int r = 0; r < 16; ++r) p0[r] = fmaf(p0[r], C, mnC); for (int r = 0; r < 16; ++r) p1[r] = fmaf(p1[r], C, mnC);
  for (int r = 0; r < 16; ++r) p0[r] = __builtin_amdgcn_exp2f(p0[r]);
}
__device__ __forceinline__ void finishSM(f32x16& p0, f32x16& p1, float alpha, float& l_reg, bf16x8& pa0, bf16x8& pa1, bf16x8& pa2, bf16x8& pa3) {
  for (int r = 0; r < 16; ++r) p1[r] = __builtin_amdgcn_exp2f(p1[r]);
  float ps = 0; for (int r = 0; r < 16; ++r) ps += p0[r]; for (int r = 0; r < 16; ++r) ps += p1[r];
  { auto rr = __builtin_amdgcn_permlane32_swap(__float_as_uint(ps), __float_as_uint(ps), false, false);
    ps = __uint_as_float(rr[0]) + __uint_as_float(rr[1]); }
  l_reg = l_reg * alpha + ps;
#define PK4(P, BASE, OUT) do { unsigned a0 = cvtpk(P[BASE + 0], P[BASE + 1]), a1 = cvtpk(P[BASE + 2], P[BASE + 3]);   \
    unsigned b0 = cvtpk(P[BASE + 4], P[BASE + 5]), b1 = cvtpk(P[BASE + 6], P[BASE + 7]);                              \
    auto r0 = __builtin_amdgcn_permlane32_swap(a0, b0, false, false); auto r1 = __builtin_amdgcn_permlane32_swap(a1, b1, false, false); \
    u32x4 w = {r0[0], r1[0], r0[1], r1[1]}; OUT = *reinterpret_cast<bf16x8*>(&w); } while (0)
  PK4(p0, 0, pa0); PK4(p0, 8, pa1); PK4(p1, 0, pa2); PK4(p1, 8, pa3);
#undef PK4
}
__device__ __forceinline__ void qkt(f32x16& p0, f32x16& p1, const bf16* Ks, const bf16x8* qr, int r32, int hi) {
  p0 = f32x16{}; p1 = f32x16{};
  for (int d0 = 0; d0 < 8; ++d0) { int cb = (d0 * 16 + hi * 8) * 2;
    bf16x8 b0 = *reinterpret_cast<const bf16x8*>((const char*)Ks + KSWZ(r32, cb));
    bf16x8 b1 = *reinterpret_cast<const bf16x8*>((const char*)Ks + KSWZ(32 + r32, cb));
    p0 = __builtin_amdgcn_mfma_f32_32x32x16_bf16(b0, qr[d0], p0, 0, 0, 0);
    p1 = __builtin_amdgcn_mfma_f32_32x32x16_bf16(b1, qr[d0], p1, 0, 0, 0); }
}
__device__ __forceinline__ int v_st(int k, int c) { const int kk = (k & ~0xC) | ((k & 4) << 1) | ((k & 8) >> 1); return ((kk >> 3) * 4 + (c >> 5)) * 512 + ((kk & 7) * 32 + (c & 31)) * 2; }
__device__ __forceinline__ int v_rd_base(int lane) { return ((lane & 3) << 3) | (((lane >> 2) & 3) << 6) | (((lane >> 4) & 1) << 5) | (((lane >> 5) & 1) << 8); }
constexpr int v_rd_off(int d0, int ks, int half) { return d0 * 512 + ks * 4096 + half * 2048; }
template <int OFF> __device__ __forceinline__ s16x4 tr_read(int vb) {
  s16x4 r; asm volatile("ds_read_b64_tr_b16 %0, %1 offset:%2" : "=&v"(r) : "v"(vb), "i"(OFF) : "memory"); return r;
}
template <int D0> __device__ __forceinline__ void pv_one(f32x16& od, int vb, bf16x8 pa0, bf16x8 pa1, bf16x8 pa2, bf16x8 pa3) {
  const s16x4 l0 = tr_read<v_rd_off(D0, 0, 0)>(vb), h0 = tr_read<v_rd_off(D0, 0, 1)>(vb), l1 = tr_read<v_rd_off(D0, 1, 0)>(vb), h1 = tr_read<v_rd_off(D0, 1, 1)>(vb);
  const s16x4 l2 = tr_read<v_rd_off(D0, 2, 0)>(vb), h2 = tr_read<v_rd_off(D0, 2, 1)>(vb), l3 = tr_read<v_rd_off(D0, 3, 0)>(vb), h3 = tr_read<v_rd_off(D0, 3, 1)>(vb);
  asm volatile("s_waitcnt lgkmcnt(0)" ::: "memory"); SBAR();
#define PK(L, H) (bf16x8){L[0], L[1], L[2], L[3], H[0], H[1], H[2], H[3]}
  od = __builtin_amdgcn_mfma_f32_32x32x16_bf16(pa0, PK(l0, h0), od, 0, 0, 0);
  od = __builtin_amdgcn_mfma_f32_32x32x16_bf16(pa1, PK(l1, h1), od, 0, 0, 0);
  od = __builtin_amdgcn_mfma_f32_32x32x16_bf16(pa2, PK(l2, h2), od, 0, 0, 0);
  od = __builtin_amdgcn_mfma_f32_32x32x16_bf16(pa3, PK(l3, h3), od, 0, 0, 0);
#undef PK
}
__device__ __forceinline__ void pv_d0(f32x16* o, int vb, bf16x8 pa0, bf16x8 pa1, bf16x8 pa2, bf16x8 pa3) {
  pv_one<0>(o[0], vb, pa0, pa1, pa2, pa3); pv_one<1>(o[1], vb, pa0, pa1, pa2, pa3); pv_one<2>(o[2], vb, pa0, pa1, pa2, pa3); pv_one<3>(o[3], vb, pa0, pa1, pa2, pa3);
}

template <typename TQ>
__device__ __forceinline__ void attn_dense_body(const TQ* __restrict__ Qb, const bf16* __restrict__ Kh, const bf16* __restrict__ Vh,
                                                unsigned short* __restrict__ Ob, int seq, char* lds) {
  using St = Stage<bf16>; using SQ = Stage<TQ>;
  const int tid = mk_tid(), wid = tid >> 6, lane = tid & 63, r32 = lane & 31, hi = lane >> 5;
  bf16* V_lds = (bf16*)lds; bf16* K_lds = (bf16*)(lds + 2 * SHM_V);
  float* ws = (float*)(lds + 2 * SHM_V + 2 * SHM_K) + wid * 64; float* li_l = ws; float* al_l = ws + 32;
  float m_reg = -1e30f, l_reg = 0; f32x16 o[4] = {}; bf16x8 qr[8];
  const TQ* Qw = Qb + (long)(wid * QBLK + r32) * LDQ + hi * 8;
#pragma unroll
  for (int d0 = 0; d0 < 8; ++d0) qr[d0] = SQ::tobf(SQ::ld8(Qw + d0 * 16));
  const int sr = tid >> 4, sc = (tid & 15) * 8, vst0 = v_st(sr, sc), vst1 = v_st(32 + sr, sc);
  const int vb0 = (int)(uintptr_t)V_lds + v_rd_base(lane);
  struct { typename St::T vs0, vs1, ks0, ks1; } sr_[SDEPTH];
#define SLOAD(i, k0) do { sr_[i].vs0 = St::ld8(&Vh[(long)((k0) + sr) * LDK + sc]); sr_[i].vs1 = St::ld8(&Vh[(long)((k0) + 32 + sr) * LDK + sc]); \
    sr_[i].ks0 = St::ld8(&Kh[(long)((k0) + sr) * LDK + sc]); sr_[i].ks1 = St::ld8(&Kh[(long)((k0) + 32 + sr) * LDK + sc]); } while (0)
#define SWRITE(b, i) do { *(bf16x8*)((char*)V_lds + (b) * SHM_V + vst0) = St::tobf(sr_[i].vs0);          \
    *(bf16x8*)((char*)V_lds + (b) * SHM_V + vst1) = St::tobf(sr_[i].vs1); int kc = sc * 2;               \
    *(bf16x8*)((char*)K_lds + (b) * SHM_K + KSWZ(sr, kc)) = St::tobf(sr_[i].ks0);                       \
    *(bf16x8*)((char*)K_lds + (b) * SHM_K + KSWZ(32 + sr, kc)) = St::tobf(sr_[i].ks1); } while (0)
#define SWAIT() do { if constexpr (SDEPTH == 2) asm volatile("s_waitcnt vmcnt(4)" ::: "memory"); else asm volatile("s_waitcnt vmcnt(0)" ::: "memory"); } while (0)
#define RESC(a) do { if (__any((a) < 1.f)) { if (hi == 0) al_l[r32] = (a); asm volatile("s_waitcnt lgkmcnt(0)" ::: "memory"); \
    for (int d = 0; d < 4; ++d) for (int r = 0; r < 16; ++r) o[d][r] *= al_l[crow(r, hi)]; } } while (0)
  f32x16 pA0, pA1, pB0, pB1; float mnA, mnB, alA, alB; bf16x8 pa0, pa1, pa2, pa3; const int NT = seq / KVBLK;
  constexpr int SE = 0, SO = SDEPTH - 1;
  SLOAD(SE, 0); asm volatile("s_waitcnt vmcnt(0)" ::: "memory"); SWRITE(0, SE); __syncthreads();
  qkt(pA0, pA1, K_lds, qr, r32, hi); partialSM(pA0, pA1, m_reg, mnA, alA);
  SLOAD(SO, KVBLK); if constexpr (SDEPTH == 2) { if (2 < NT) SLOAD(SE, 2 * KVBLK); }
  SWAIT(); SWRITE(1, SO); __syncthreads();
  for (int j = 1; j + 1 < NT; j += 2) {
    SBAR(); qkt(pB0, pB1, (bf16*)((char*)K_lds + SHM_K), qr, r32, hi);
    finishSM(pA0, pA1, alA, l_reg, pa0, pa1, pa2, pa3); SBAR();
    SLOAD(SO, (j + SDEPTH) * KVBLK); SBAR();
    pv_d0(o, vb0, pa0, pa1, pa2, pa3); partialSM(pB0, pB1, m_reg, mnB, alB);
    __syncthreads(); SWAIT(); SWRITE(0, SE);
    RESC(alB); __syncthreads();
    SBAR(); qkt(pA0, pA1, K_lds, qr, r32, hi);
    finishSM(pB0, pB1, alB, l_reg, pa0, pa1, pa2, pa3); SBAR();
    if (SDEPTH == 1 || j + 3 < NT) SLOAD(SE, (j + 1 + SDEPTH) * KVBLK); SBAR();
    pv_d0(o, vb0 + (int)SHM_V, pa0, pa1, pa2, pa3); partialSM(pA0, pA1, m_reg, mnA, alA);
    __syncthreads(); SWAIT(); SWRITE(1, SO);
    RESC(alA); __syncthreads();
  }
  SBAR(); qkt(pB0, pB1, (bf16*)((char*)K_lds + SHM_K), qr, r32, hi);
  finishSM(pA0, pA1, alA, l_reg, pa0, pa1, pa2, pa3); SBAR();
  pv_d0(o, vb0, pa0, pa1, pa2, pa3); partialSM(pB0, pB1, m_reg, mnB, alB);
  __syncthreads(); RESC(alB);
  finishSM(pB0, pB1, alB, l_reg, pa0, pa1, pa2, pa3); SBAR();
  pv_d0(o, vb0 + (int)SHM_V, pa0, pa1, pa2, pa3);
  if (hi == 0) li_l[r32] = l_reg; asm volatile("s_waitcnt lgkmcnt(0)" ::: "memory");
  float rli[16];
#pragma unroll
  for (int r = 0; r < 16; ++r) rli[r] = __builtin_amdgcn_rcpf(li_l[crow(r, hi)]);
  unsigned short* Ow = Ob + (long)(wid * QBLK) * LDO;
#pragma unroll
  for (int r = 0; r < 16; ++r) { int orow = crow(r, hi);
    for (int d0 = 0; d0 < 4; ++d0) Ow[(long)orow * LDO + d0 * 32 + r32] = (unsigned short)(cvtpk(o[d0][r] * rli[r], 0.f) & 0xffffu); }
#undef SLOAD
#undef SWRITE
#undef SWAIT
#undef RESC
}

}
__device__ __forceinline__ int mk_tid() { int t = threadIdx.x; asm volatile("" : "+v"(t)); return t; }
namespace mk {
#define LAS __attribute__((address_space(3)))
typedef unsigned short bf16;
typedef short bf16x8 __attribute__((ext_vector_type(8)));
typedef float f32x4 __attribute__((ext_vector_type(4)));
typedef unsigned u32x4 __attribute__((ext_vector_type(4)));
typedef unsigned u32x2 __attribute__((ext_vector_type(2)));
#define XB_TMO      128
#define XB_XCNT(j)  (256  + 64 * (j))
#define XB_XSUB(j)  (1280 + 64 * (j))
#define XB_XGEN(j)  (2304 + 64 * (j))
#define XB_TOP      3328
#define XB_TOPGEN   3392
#define XCD_BAR_WORDS 3456
#define XB_SPIN_CAP (1u << 18)

__device__ __forceinline__ unsigned xb_ld(unsigned* p)              { return __hip_atomic_load(p, __ATOMIC_RELAXED, __HIP_MEMORY_SCOPE_AGENT); }
__device__ __forceinline__ unsigned xb_add(unsigned* p, unsigned v) { return __hip_atomic_fetch_add(p, v, __ATOMIC_RELAXED, __HIP_MEMORY_SCOPE_AGENT); }
__device__ __forceinline__ unsigned xb_xcc_id() { return (unsigned)__builtin_amdgcn_s_getreg((3 << 11) | 20) & 0xFu; }
#define XB_SPIN(cond, bar) do { unsigned _sp = 0; while (cond) { __builtin_amdgcn_s_sleep(1); \
    if ((++_sp & 255u) == 0u) { if (xb_ld(&(bar)[XB_TMO])) break; if (_sp > XB_SPIN_CAP) { atomicAdd(&(bar)[XB_TMO], 1u); break; } } } } while (0)

struct XcdBarrier {
    unsigned* bar; unsigned x;
    volatile LAS unsigned* st;
};

__device__ __forceinline__ XcdBarrier xcd_barrier_post(unsigned* bar, volatile LAS unsigned* st) {
    XcdBarrier b; b.bar = bar; b.x = xb_xcc_id(); b.st = st;
    if (mk_tid() == 0) (void)xb_add(&bar[XB_XCNT(b.x)], 1u);
    return b;
}
__device__ __forceinline__ void xcd_barrier_complete(unsigned* bar, unsigned x, unsigned& nloc, unsigned& nx) {
    const unsigned G = gridDim.x * gridDim.y * gridDim.z;
    unsigned sum, cnt, mine, sp = 0u;
    for (;;) {
        sum = 0u; cnt = 0u; mine = 0u;
#pragma unroll
        for (unsigned j = 0; j < 16; ++j) { const unsigned c = xb_ld(&bar[XB_XCNT(j)]); sum += c; cnt += (c > 0u) ? 1u : 0u; mine = (j == x) ? c : mine; }
        if (sum == G) break;
        __builtin_amdgcn_s_sleep(1);
        if ((++sp & 255u) == 0u) { if (xb_ld(&bar[XB_TMO])) break; if (sp > XB_SPIN_CAP) { atomicAdd(&bar[XB_TMO], 1u); break; } }
    }
    nloc = mine > 0u ? mine : 1u; nx = cnt > 0u ? cnt : 1u;
}

__device__ __forceinline__ void xcd_barrier(const XcdBarrier& b) {
    asm volatile("s_waitcnt vmcnt(0)" ::: "memory");
    __syncthreads();
    if (mk_tid() == 0) {
        unsigned* bar = b.bar;
        __builtin_amdgcn_s_waitcnt(0);
        unsigned nloc = b.st[0], nx = b.st[1];
        if (nloc == 0u) { xcd_barrier_complete(bar, b.x, nloc, nx); b.st[0] = nloc; b.st[1] = nx; }
        const unsigned old = xb_add(&bar[XB_XSUB(b.x)], 1u);
        const unsigned gen = old / nloc;
        if (old + 1u == (gen + 1u) * nloc) {
            __builtin_amdgcn_fence(__ATOMIC_RELEASE, "agent");
            asm volatile("s_waitcnt vmcnt(0)" ::: "memory");
            const unsigned og = xb_add(&bar[XB_TOP], 1u);
            const unsigned tg = og / nx;
            if (og + 1u == (tg + 1u) * nx) xb_add(&bar[XB_TOPGEN], 1u);
            else XB_SPIN(xb_ld(&bar[XB_TOPGEN]) == tg, bar);
            __builtin_amdgcn_fence(__ATOMIC_ACQUIRE, "agent");
            xb_add(&bar[XB_XGEN(b.x)], 1u);
            asm volatile("s_waitcnt vmcnt(0)" ::: "memory");
        } else {
            XB_SPIN(xb_ld(&bar[XB_XGEN(b.x)]) == gen, bar);
            __builtin_amdgcn_fence(__ATOMIC_ACQUIRE, "agent");
            asm volatile("s_waitcnt vmcnt(0)" ::: "memory");
        }
    }
    __syncthreads();
}


constexpr int D = 2048, M = 8192, SEQ = 4096, NW = 8;
constexpr int ABW = 3072, CW = 8224, FF2 = 11264, FF = 5632;
constexpr float EPS = 1e-6f;
constexpr size_t MiB = 1u << 20;
constexpr size_t WS_AB = 0, WS_BD = 12 * MiB, WS_OAB = 13 * MiB, WS_C = 21 * MiB  , WS_OC = 54 * MiB;
constexpr size_t WS_UP0 = 62 * MiB, WS_UP1 = 106 * MiB, WS_DN0 = 150 * MiB, WS_DN1 = 172 * MiB;
constexpr size_t WS_XN = 194 * MiB, WS_GATES = 226 * MiB, WS_S = 228 * MiB;
constexpr size_t WS_PROJ = WS_S, WS_POOLED = WS_S + 48 * MiB, WS_CAT = WS_S + 56 * MiB;
constexpr size_t WS_QK = WS_S, WS_OG = WS_S + 64 * MiB, WS_KVT = WS_S + 96 * MiB, WS_HF = WS_S + 160 * MiB, WS_Y = WS_S + 288 * MiB;
constexpr size_t WS_U = WS_S, WS_ACT = WS_S + 176 * MiB;
constexpr size_t WS_PB = WS_S + 320 * MiB, WS_SC = WS_S + 336 * MiB;
constexpr size_t WS_END = WS_S + 338 * MiB;
constexpr int LDS_ML = 154112 + 1024, LDS_MISC = LDS_ML, LDS_BYTES = LDS_ML + 64;
constexpr size_t WS_BAR = WS_BD + 768 * 1024, BAR_BYTES = 16384;

#define LDSWAIT() asm volatile("s_waitcnt lgkmcnt(0)" ::: "memory")
__device__ __forceinline__ unsigned f2bf(float f) { unsigned u = __float_as_uint(f); return (u + 0x7fffu + ((u >> 16) & 1u)) >> 16; }
__device__ __forceinline__ unsigned pk2(float lo, float hi) { unsigned r; asm volatile("v_cvt_pk_bf16_f32 %0, %1, %2" : "=v"(r) : "v"(lo), "v"(hi)); return r; }
__device__ __forceinline__ float bflo(unsigned w) { return __uint_as_float(w << 16); }
__device__ __forceinline__ float bfhi(unsigned w) { return __uint_as_float(w & 0xffff0000u); }
__device__ __forceinline__ float wave_sum(float v) {
#pragma unroll
    for (int o = 1; o < 64; o <<= 1) v += __shfl_xor(v, o);
    return v;
}

__device__ __forceinline__ void transpose_item64(const float* __restrict__ W, int ldw, int K, int nblk, bf16* __restrict__ WT, LAS float* scr, int item, int lane, bool upperm) {
    const int kb = item / nblk, nb = item - kb * nblk, k0 = 64 * kb, n0 = 64 * nb;
    const int d0 = !upperm ? n0 : (n0 < FF ? 256 * (n0 >> 7) + (n0 & 127) : 256 * ((n0 - FF) >> 7) + 128 + ((n0 - FF) & 127));
    f32x4 v[16];
#pragma unroll
    for (int i = 0; i < 16; ++i) { const int kk = 4 * i + (lane >> 4); v[i] = *(const f32x4*)(W + (size_t)(k0 + kk) * ldw + n0 + 4 * (lane & 15)); }
#pragma unroll
    for (int i = 0; i < 16; ++i) { const int kk = 4 * i + (lane >> 4); LAS float* s = scr + kk * 65 + 4 * (lane & 15); s[0] = v[i].x; s[1] = v[i].y; s[2] = v[i].z; s[3] = v[i].w; }
    LDSWAIT();
    const int c = lane & 7, q = lane >> 3;
#pragma unroll
    for (int j = 0; j < 8; ++j) { const int n = q + 8 * j; const LAS float* s = scr + (8 * c) * 65 + n;
        u32x4 o; o.x = pk2(s[0], s[65]); o.y = pk2(s[130], s[195]); o.z = pk2(s[260], s[325]); o.w = pk2(s[390], s[455]);
        *(u32x4*)(WT + (size_t)(d0 + n) * K + k0 + 8 * c) = o; }
    LDSWAIT();
}

__device__ __forceinline__ void rmsnorm_rows(const float* __restrict__ src, const float* __restrict__ gain, bf16* __restrict__ dst, int gw, int ngw, int lane) {
    f32x4 g[8];
#pragma unroll
    for (int j = 0; j < 8; ++j) g[j] = *(const f32x4*)(gain + 4 * lane + 256 * j);
    for (int m = gw; m < M; m += ngw) {
        const f32x4* xr = (const f32x4*)(src + (size_t)m * D) + lane; f32x4 v[8]; float s = 0.f;
#pragma unroll
        for (int j = 0; j < 8; ++j) { v[j] = xr[64 * j]; s += (v[j].x * v[j].x + v[j].y * v[j].y) + (v[j].z * v[j].z + v[j].w * v[j].w); }
        const float rstd = 1.0f / sqrtf(wave_sum(s) * (1.0f / D) + EPS);
        u32x2* o = (u32x2*)(dst + (size_t)m * D) + lane;
#pragma unroll
        for (int j = 0; j < 8; ++j) { u32x2 w; w.x = pk2(v[j].x * rstd * g[j].x, v[j].y * rstd * g[j].y); w.y = pk2(v[j].z * rstd * g[j].z, v[j].w * rstd * g[j].w); o[64 * j] = w; }
    }
}

struct In { const float *x, *norm_mix, *norm_ffn, *w_in_ab, *pool_w, *pool_scale, *q_norm, *k_norm, *w_out_ab, *w_in_c, *b_gate, *h_norm, *w_out_c, *w_up, *conv_w, *conv_b, *w_down; };

__device__ __forceinline__ void transposes(const In& I, unsigned char* ws, LAS unsigned char* lds, int first, int last, int w, int nw, int wave, int lane) {
    LAS float* scr = (LAS float*)(lds + wave * 16640);
    for (int it = first + w; it < last; it += nw) {
        const float* W; int ldw, K, nblk; bf16* WT; int r = it;
        if (r < 1536) { W = I.w_in_ab; ldw = ABW; K = D; nblk = 48; WT = (bf16*)(ws + WS_AB); }
        else if (r < 2560) { r -= 1536; W = I.w_out_ab; ldw = D; K = D; nblk = 32; WT = (bf16*)(ws + WS_OAB); }
        else if (r < 6656) { r -= 2560; W = I.w_in_c; ldw = CW; K = D; nblk = 128; WT = (bf16*)(ws + WS_C); }
        else if (r < 7680) { r -= 6656; W = I.w_out_c; ldw = D; K = D; nblk = 32; WT = (bf16*)(ws + WS_OC); }
        else if (r < 13312) { r -= 7680; W = I.w_up; ldw = FF2; K = D; nblk = 176; WT = (bf16*)(ws + WS_UP0); }
        else if (r < 18944) { r -= 13312; W = I.w_up + (size_t)D * FF2; ldw = FF2; K = D; nblk = 176; WT = (bf16*)(ws + WS_UP1); }
        else if (r < 21760) { r -= 18944; W = I.w_down; ldw = D; K = FF; nblk = 32; WT = (bf16*)(ws + WS_DN0); }
        else { r -= 21760; W = I.w_down + (size_t)FF * D; ldw = D; K = FF; nblk = 32; WT = (bf16*)(ws + WS_DN1); }
        transpose_item64(W, ldw, K, nblk, WT, scr, r, lane, (it >= 7680 && it < 18944));
    }
}
__device__ __forceinline__ void prologue(const In& I, unsigned char* ws, LAS unsigned char* lds, int gw, int ngw, int wave, int lane) {
    transposes(I, ws, lds, 0, 1536, gw, ngw, wave, lane);
    const int gt = gw * 64 + lane, ngt = ngw * 64;
    { bf16* WG = (bf16*)(ws + WS_C) + (size_t)8192 * D;
      for (int idx = gt; idx < 32 * D; idx += ngt) { const int j = idx >> 11, k = idx & 2047; WG[idx] = (bf16)f2bf(I.w_in_c[(size_t)k * CW + 8192 + j]); } }
    { bf16* BD = (bf16*)(ws + WS_BD);
      for (int idx = gt; idx < 512 * 512; idx += ngt) { const int n = idx >> 9, k = idx & 511, gn = n >> 7, gk = k >> 7;
          const float v = (gn == gk) ? I.pool_w[(size_t)(gn * 128 + (k & 127)) * 128 + (n & 127)] * I.pool_scale[n] : 0.f; BD[idx] = (bf16)f2bf(v); } }
    rmsnorm_rows(I.x, I.norm_mix, (bf16*)(ws + WS_XN), gw, ngw, lane);
}

__device__ __forceinline__ void qk_rope_pool(bf16* __restrict__ PROJ, const float* __restrict__ qn, const float* __restrict__ kn, bf16* __restrict__ POOLED, int gw, int ngw, int lane) {
    const int l = lane & 31, hsel = lane >> 5, part = (l >> 4) & 1; const bool first = (l & 8) == 0;
    float inv[4];
#pragma unroll
    for (int e = 0; e < 4; ++e) inv[e] = exp2f(-(float)(4 * (l & 7) + e) * (13.287712379549449f / 32.0f));
    const f32x4 gq = *(const f32x4*)(qn + 4 * l), gk = *(const f32x4*)(kn + 4 * l);
    for (int it0 = gw; it0 < M * 8; it0 += 4 * ngw) {
        u32x2 wv[4]; bf16* pp4[4]; int tt4[4], hh4[4]; bool ok[4];
#pragma unroll
        for (int k = 0; k < 4; ++k) { const int it = it0 + k * ngw; ok[k] = it < M * 8; const int itc = ok[k] ? it : gw; tt4[k] = itc >> 3; hh4[k] = (itc & 7) * 2 + hsel;
            pp4[k] = PROJ + (size_t)tt4[k] * ABW + 512 + hh4[k] * 128 + 4 * l; wv[k] = *(const u32x2*)pp4[k]; }
#pragma unroll
        for (int k = 0; k < 4; ++k) {
            const u32x2 w = wv[k]; const int t = tt4[k], hh = hh4[k];
            float x[4] = {bflo(w.x), bfhi(w.x), bflo(w.y), bfhi(w.y)};
            float ss = (x[0] * x[0] + x[1] * x[1]) + (x[2] * x[2] + x[3] * x[3]);
#pragma unroll
            for (int o = 1; o < 32; o <<= 1) ss += __shfl_xor(ss, o);
            const float rstd = 1.0f / sqrtf(ss * (1.0f / 128.0f) + EPS);
            const f32x4 g = (hh < 12) ? gq : gk;
            const int pos = t & (SEQ - 1); const float pp = part ? (float)(pos & 63) : (float)(pos >> 6);
            float y[4] = {x[0] * rstd * g.x, x[1] * rstd * g.y, x[2] * rstd * g.z, x[3] * rstd * g.w}, o4[4];
#pragma unroll
            for (int e = 0; e < 4; ++e) { const float yp = __shfl_xor(y[e], 8); const float ang = pp * inv[e]; const float sn = __sinf(ang), cs = __cosf(ang);
                o4[e] = y[e] * cs + (first ? -yp : yp) * sn; }
            u32x2 ow; ow.x = pk2(o4[0], o4[1]); ow.y = pk2(o4[2], o4[3]); if (ok[k]) *(u32x2*)pp4[k] = ow;
        }
    }
    const int gt = gw * 64 + lane, ngt = ngw * 64;
    for (int it = gt; it < M * 64; it += ngt) {
        const int t = it >> 6, c8 = (it & 63) * 8, g = c8 >> 7, w2 = 1 << g, pos = t & (SEQ - 1), base = t - pos;
        const int lo = max(pos - w2, 0), hi = min(pos + w2, SEQ);
        float acc[8] = {0.f, 0.f, 0.f, 0.f, 0.f, 0.f, 0.f, 0.f};
        u32x4 wv[16];
#pragma unroll
        for (int k = 0; k < 16; ++k) { const int pz = pos - w2 + k; const bool okk = (k < 2 * w2) && pz >= 0 && pz < SEQ; const u32x4 z = {0u, 0u, 0u, 0u};
            wv[k] = okk ? *(const u32x4*)(PROJ + (size_t)(base + pz) * ABW + c8) : z; }
#pragma unroll
        for (int k = 0; k < 16; ++k) { const u32x4 v = wv[k];
            acc[0] += bflo(v.x); acc[1] += bfhi(v.x); acc[2] += bflo(v.y); acc[3] += bfhi(v.y); acc[4] += bflo(v.z); acc[5] += bfhi(v.z); acc[6] += bflo(v.w); acc[7] += bfhi(v.w); }
        const u32x4 sv = *(const u32x4*)(PROJ + (size_t)t * ABW + c8); const float iv = 1.0f / (float)(hi - lo);
        u32x4 o; o.x = pk2(acc[0] * iv - bflo(sv.x), acc[1] * iv - bfhi(sv.x)); o.y = pk2(acc[2] * iv - bflo(sv.y), acc[3] * iv - bfhi(sv.y));
        o.z = pk2(acc[4] * iv - bflo(sv.z), acc[5] * iv - bfhi(sv.z)); o.w = pk2(acc[6] * iv - bflo(sv.w), acc[7] * iv - bfhi(sv.w));
        *(u32x4*)(POOLED + (size_t)t * 512 + c8) = o;
    }
}

__device__ __forceinline__ void conv_fix(const bf16* __restrict__ HALO, const float* __restrict__ cw, const float* __restrict__ cb, bf16* __restrict__ ACT, int gt, int ngt) {
    for (int it = gt; it < 256 * 704; it += ngt) {
        const int jc = it % 704, re = it / 704, blk = re >> 1, last = re & 1, j = jc * 8;
        const int t = blk * 64 + (last ? 63 : 0), pos = t & (SEQ - 1);
        const bf16* rc = HALO + ((size_t)blk * 4 + (last ? 3 : 0)) * FF2 + j;
        const bf16* ru = last ? rc - FF2 : HALO + ((size_t)(blk - 1) * 4 + 3) * FF2 + j;
        const bf16* rd = last ? HALO + ((size_t)(blk + 1) * 4) * FF2 + j : rc + FF2;
        const u32x4 z = {0u, 0u, 0u, 0u};
        const u32x4 g1 = *(const u32x4*)rc, v1 = *(const u32x4*)(rc + FF);
        const u32x4 g0 = pos > 0 ? *(const u32x4*)ru : z, v0 = pos > 0 ? *(const u32x4*)(ru + FF) : z;
        const u32x4 g2 = pos < SEQ - 1 ? *(const u32x4*)rd : z, v2 = pos < SEQ - 1 ? *(const u32x4*)(rd + FF) : z;
        float o[8];
#pragma unroll
        for (int q = 0; q < 4; ++q) {
            const int ja = j + 2 * q, jb = ja + 1;
            const float ga = cw[ja] * bflo(g0[q]) + cw[FF2 + ja] * bflo(g1[q]) + cw[2 * FF2 + ja] * bflo(g2[q]) + cb[ja];
            const float gb = cw[jb] * bfhi(g0[q]) + cw[FF2 + jb] * bfhi(g1[q]) + cw[2 * FF2 + jb] * bfhi(g2[q]) + cb[jb];
            const float va = cw[FF + ja] * bflo(v0[q]) + cw[FF2 + FF + ja] * bflo(v1[q]) + cw[2 * FF2 + FF + ja] * bflo(v2[q]) + cb[FF + ja];
            const float vb = cw[FF + jb] * bfhi(v0[q]) + cw[FF2 + FF + jb] * bfhi(v1[q]) + cw[2 * FF2 + FF + jb] * bfhi(v2[q]) + cb[FF + jb];
            o[2 * q] = ga / (1.0f + __expf(-ga)) * va; o[2 * q + 1] = gb / (1.0f + __expf(-gb)) * vb;
        }
        u32x4 ow; ow.x = pk2(o[0], o[1]); ow.y = pk2(o[2], o[3]); ow.z = pk2(o[4], o[5]); ow.w = pk2(o[6], o[7]);
        *(u32x4*)(ACT + (size_t)t * FF + j) = ow;
    }
}

__device__ __forceinline__ void gates_phase(const bf16* __restrict__ XN, const bf16* __restrict__ WG, const float* __restrict__ bg, float* __restrict__ GATES, LAS float* red, int bid, int nblk) {
    const int tid = mk_tid(), wid = tid >> 6, lane = tid & 63, fr = lane & 15, fq = lane >> 4;
    const int tile = wid & 3, tt = tile & 1, jt = tile >> 1, kh = wid >> 2;
    for (int grp = bid; grp < 256; grp += nblk) {
        f32x4 acc = {0.f, 0.f, 0.f, 0.f};
        const bf16* ap = WG + (size_t)(jt * 16 + fr) * D + kh * 1024 + fq * 8;
        const bf16* bp = XN + (size_t)(grp * 32 + tt * 16 + fr) * D + kh * 1024 + fq * 8;
#pragma unroll 8
        for (int ks = 0; ks < 32; ++ks) { const bf16x8 a = *(const bf16x8*)(ap + ks * 32), b = *(const bf16x8*)(bp + ks * 32); acc = __builtin_amdgcn_mfma_f32_16x16x32_bf16(a, b, acc, 0, 0, 0); }
        if (kh == 1) { LAS float* r = red + (tile * 64 + lane) * 4; r[0] = acc[0]; r[1] = acc[1]; r[2] = acc[2]; r[3] = acc[3]; }
        __syncthreads();
        if (kh == 0) { const LAS float* r = red + (tile * 64 + lane) * 4; const int t = grp * 32 + tt * 16 + fr, j = jt * 16 + 4 * fq;
            const f32x4 b4 = *(const f32x4*)(bg + j); f32x4 o; o.x = acc[0] + r[0] + b4.x; o.y = acc[1] + r[1] + b4.y; o.z = acc[2] + r[2] + b4.z; o.w = acc[3] + r[3] + b4.w;
            *(f32x4*)(GATES + (size_t)t * 32 + j) = o; }
        __syncthreads();
    }
}

__device__ __forceinline__ void headnorm_phase(const bf16* __restrict__ HF, const bf16* __restrict__ OG, const float* __restrict__ hn, bf16* __restrict__ Y, int gw, int ngw, int lane) {
    for (int it0 = gw; it0 < M * 8; it0 += 4 * ngw) {
        u32x2 a[4], b[4], ow[4]; f32x4 g[4]; size_t off[4]; bool ok[4];
#pragma unroll
        for (int k = 0; k < 4; ++k) { const int it = it0 + k * ngw; ok[k] = it < M * 8; const int itc = ok[k] ? it : gw; const int t = itc >> 3, h = itc & 7; off[k] = (size_t)t * D + h * 256 + 4 * lane;
            a[k] = *(const u32x2*)(HF + off[k]); b[k] = *(const u32x2*)(HF + (size_t)M * D + off[k]); ow[k] = *(const u32x2*)(OG + off[k]); g[k] = *(const f32x4*)(hn + h * 256 + 4 * lane); }
#pragma unroll
        for (int k = 0; k < 4; ++k) {
            f32x4 s; s.x = bflo(a[k].x) + bflo(b[k].x); s.y = bfhi(a[k].x) + bfhi(b[k].x); s.z = bflo(a[k].y) + bflo(b[k].y); s.w = bfhi(a[k].y) + bfhi(b[k].y);
            const float ss = wave_sum((s.x * s.x + s.y * s.y) + (s.z * s.z + s.w * s.w));
            const float rstd = 1.0f / sqrtf(ss * (1.0f / 256.0f) + EPS);
            const float o0 = bflo(ow[k].x), o1 = bfhi(ow[k].x), o2 = bflo(ow[k].y), o3 = bfhi(ow[k].y);
            u32x2 w; w.x = pk2(s.x * rstd * g[k].x * __builtin_amdgcn_rcpf(1.0f + __expf(-o0)), s.y * rstd * g[k].y * __builtin_amdgcn_rcpf(1.0f + __expf(-o1)));
            w.y = pk2(s.z * rstd * g[k].z * __builtin_amdgcn_rcpf(1.0f + __expf(-o2)), s.w * rstd * g[k].w * __builtin_amdgcn_rcpf(1.0f + __expf(-o3)));
            if (ok[k]) *(u32x2*)(Y + off[k]) = w;
        }
    }
}

namespace ml {
constexpr int LQ = 264, LS = 72;
constexpr int OFF_Q = 0, OFF_KT = 33792, OFF_VT = 70656, OFF_VTW = 77568, OFF_P = 84480, OFF_CT0 = 93696, CT_BYTES = 25344, OFF_SC = OFF_CT0 + 2 * CT_BYTES  , OFF_WS = OFF_SC + 512, ML_LDS_END = OFF_WS + 1024;
static_assert(ML_LDS_END <= LDS_ML, "mlstm lds map");
#define ML_BAR() do { asm volatile("s_waitcnt lgkmcnt(0)" ::: "memory"); __builtin_amdgcn_s_barrier(); asm volatile("" ::: "memory"); } while (0)
#define ML_DPP(old, src, ctrl, rmask) __int_as_float(__builtin_amdgcn_update_dpp(__float_as_int(old), __float_as_int(src), ctrl, rmask, 0xF, false))
#define ML_MFMA(a, b, c) __builtin_amdgcn_mfma_f32_16x16x32_bf16(a, b, c, 0, 0, 0)

__device__ __forceinline__ void mlstm_pre(LAS unsigned char* lds, const bf16* __restrict__ QK, const float* __restrict__ GATES, bf16* __restrict__ PB, float* __restrict__ SC, int bid, int nblk) {
    const int tid = mk_tid(), wid = tid >> 6, lane = tid & 63, fr = lane & 15, fq = lane >> 4;
    LAS float* sa = (LAS float*)(lds + wid * 512); LAS float* sm = sa + 64;
    for (int wg = bid; wg < 256; wg += nblk) {
        const int seq = wg >> 3, c = (wg & 7) * 8 + wid, dir = seq & 1, h = (seq >> 1) & 7, b = seq >> 4, item = seq * 64 + c;
        const int rr = dir ? 63 - lane : lane;
        const float* gbase = GATES + (size_t)b * SEQ * 32 + dir * 16 + h;
        float m_st = 0.f, a_c = 0.f, Mv_c = 0.f, ai_c = 0.f, em_c = 0.f, ws_c = 0.f, dec_c = 1.f;
        for (int k0 = 0; k0 <= c; k0 += 8) {
            float gi[8], gf[8];
#pragma unroll
            for (int j = 0; j < 8; ++j) { const int k = k0 + j, ncn = dir ? 63 - k : k; const float* gp = gbase + (size_t)(ncn * 64 + rr) * 32; gi[j] = gp[0]; gf[j] = gp[8]; }
#pragma unroll
            for (int j = 0; j < 8; ++j) { const int k = k0 + j;
                if (k <= c) {
                    const float lf = fminf(gf[j], 0.f) - log1pf(__expf(-fabsf(gf[j]))); float bc = lf;
                    bc += ML_DPP(0.f, bc, 0x111, 0xF); bc += ML_DPP(0.f, bc, 0x112, 0xF); bc += ML_DPP(0.f, bc, 0x114, 0xF); bc += ML_DPP(0.f, bc, 0x118, 0xF);
                    bc += ML_DPP(0.f, bc, 0x142, 0xA); bc += ML_DPP(0.f, bc, 0x143, 0xC);
                    const float a = gi[j] - bc; float cm = a;
                    cm = fmaxf(cm, ML_DPP(-3.0e38f, cm, 0x111, 0xF)); cm = fmaxf(cm, ML_DPP(-3.0e38f, cm, 0x112, 0xF)); cm = fmaxf(cm, ML_DPP(-3.0e38f, cm, 0x114, 0xF)); cm = fmaxf(cm, ML_DPP(-3.0e38f, cm, 0x118, 0xF));
                    cm = fmaxf(cm, ML_DPP(-3.0e38f, cm, 0x142, 0xA)); cm = fmaxf(cm, ML_DPP(-3.0e38f, cm, 0x143, 0xC));
                    const float Mv = fmaxf(m_st, cm), blast = __shfl(bc, 63), cml = __shfl(cm, 63), Mn = fmaxf(m_st, cml);
                    if (k == c) { a_c = a; Mv_c = Mv; ai_c = __expf(m_st - Mv); em_c = __expf(-(bc + Mv)); ws_c = __expf(a - Mn); dec_c = __expf(m_st - Mn); }
                    m_st = blast + Mn;
                }
            }
        }
        { float* sc = SC + (size_t)item * 256; sc[rr] = ai_c; sc[64 + rr] = em_c; sc[128 + rr] = ws_c; sc[192 + rr] = dec_c; }
        sa[rr] = a_c; sm[rr] = Mv_c;
        asm volatile("s_waitcnt lgkmcnt(0)" ::: "memory");
        const int ncn = dir ? 63 - c : c; const size_t trow = (size_t)b * SEQ + (size_t)ncn * 64;
        const bf16* Qb = QK + trow * 4096 + h * 256 + (size_t)fr * 4096 + fq * 8; const bf16* Kb = Qb + 2048;
        f32x4 acc[4][4];
#pragma unroll
        for (int tq = 0; tq < 4; ++tq)
#pragma unroll
            for (int sq = 0; sq < 4; ++sq) acc[tq][sq] = (f32x4){0.f, 0.f, 0.f, 0.f};
#pragma unroll 2
        for (int ks = 0; ks < 8; ++ks) {
            bf16x8 qf[4], kf[4];
#pragma unroll
            for (int q = 0; q < 4; ++q) { qf[q] = *(const bf16x8*)(Qb + (size_t)q * 16 * 4096 + ks * 32); kf[q] = *(const bf16x8*)(Kb + (size_t)q * 16 * 4096 + ks * 32); }
#pragma unroll
            for (int tq = 0; tq < 4; ++tq)
#pragma unroll
                for (int sq = 0; sq < 4; ++sq) acc[tq][sq] = ML_MFMA(kf[sq], qf[tq], acc[tq][sq]);
        }
        bf16* pb = PB + (size_t)item * 4096;
#pragma unroll
        for (int tq = 0; tq < 4; ++tq) { const int t = tq * 16 + fr; const float Mt = sm[t];
#pragma unroll
            for (int sq = 0; sq < 4; ++sq) { const int s0 = sq * 16 + 4 * fq; const f32x4 a4 = *(const LAS f32x4*)(sa + s0); float p[4];
#pragma unroll
                for (int r = 0; r < 4; ++r) { const int s = s0 + r; const bool ok = dir ? (s >= t) : (s <= t); p[r] = ok ? acc[tq][sq][r] * __expf(a4[r] - Mt) : 0.f; }
                u32x2 w; w.x = pk2(p[0], p[1]); w.y = pk2(p[2], p[3]); *(u32x2*)(pb + t * 64 + s0) = w; } }
        asm volatile("s_waitcnt lgkmcnt(0)" ::: "memory");
    }
}

__device__ __forceinline__ void mlstm_seq(LAS unsigned char* lds, const bf16* __restrict__ QK, const bf16* __restrict__ KVT, const bf16* __restrict__ PB, const float* __restrict__ SC, bf16* __restrict__ HF, int bid, int nblk) {
    const int tid = mk_tid(), wid = tid >> 6, lane = tid & 63, fr = lane & 15, fq = lane >> 4;
    LAS bf16* Qs = (LAS bf16*)(lds + OFF_Q); LAS bf16* KTs = (LAS bf16*)(lds + OFF_KT);
    LAS bf16* VTs = (LAS bf16*)(lds + OFF_VT); LAS bf16* VTw = (LAS bf16*)(lds + OFF_VTW); LAS bf16* Ps = (LAS bf16*)(lds + OFF_P);
    LAS float* sAI = (LAS float*)(lds + OFF_SC); LAS float* sEM = sAI + 64; LAS float* sWS = (LAS float*)(lds + OFF_WS);
    const int tt = wid & 3, sh = wid >> 2;
    for (int it0 = bid; it0 < 256; it0 += nblk) {
        const int itm = (nblk == 256) ? (((it0 & 7) * 4 + (it0 >> 6)) * 8 + ((it0 >> 3) & 7)) : it0;
        const int es = itm & 7, seq = itm >> 3, dir = seq & 1, h = (seq >> 1) & 7, b = seq >> 4;
        for (int i = tid; i < 48 * LQ / 2; i += 512) ((LAS unsigned*)(lds + OFF_CT0))[i] = 0u;
        for (int i = tid; i < 16 * LS; i += 512) { VTs[32 * LS + i] = (i < LS) ? (bf16)0x3F80 : (bf16)0; VTw[32 * LS + i] = (bf16)0; }
        f32x4 ct[2][3];
#pragma unroll
        for (int a = 0; a < 2; ++a)
#pragma unroll
            for (int e = 0; e < 3; ++e) ct[a][e] = (f32x4){0.f, 0.f, 0.f, 0.f};
        float decay = 1.f;
        bf16x8 rqA[4], rktA[4], rvtA = {0, 0, 0, 0, 0, 0, 0, 0}, rpA, rqB[4], rktB[4], rvtB = {0, 0, 0, 0, 0, 0, 0, 0}, rpB;
        float r_aiA = 0.f, r_emA = 0.f, r_wsA = 0.f, r_decA = 1.f, r_aiB = 0.f, r_emB = 0.f, r_wsB = 0.f, r_decB = 1.f;
        const unsigned voffQ = (unsigned)(((tid >> 5) * 4096 + (tid & 31) * 8) * 2), voffT = (unsigned)(((tid >> 3) * M + (tid & 7) * 8) * 2), voffP = (unsigned)(tid * 16), voffS = (unsigned)(lane * 4);
#define ML_LOAD(c, S) do { const int ncn_ = dir ? 63 - (c) : (c); const size_t trow_ = (size_t)b * SEQ + (size_t)ncn_ * 64; \
        const char* qb_ = (const char*)(QK + trow_ * 4096 + h * 256); \
        _Pragma("unroll") for (int i_ = 0; i_ < 4; ++i_) rq##S[i_] = *(const bf16x8*)(qb_ + (size_t)i_ * 131072 + voffQ); \
        const char* tb_ = (const char*)(KVT + (size_t)(h * 256) * M + trow_); \
        _Pragma("unroll") for (int i_ = 0; i_ < 4; ++i_) rkt##S[i_] = *(const bf16x8*)(tb_ + (size_t)i_ * (64 * M * 2) + voffT); \
        if (tid < 256) rvt##S = *(const bf16x8*)((const char*)(KVT + (size_t)(2048 + h * 256 + es * 32) * M + trow_) + voffT); \
        rp##S = *(const bf16x8*)((const char*)(PB + (size_t)(seq * 64 + (c)) * 4096) + voffP); \
        { const char* sp_ = (const char*)(SC + (size_t)(seq * 64 + (c)) * 256); r_ai##S = *(const float*)(sp_ + voffS); r_em##S = *(const float*)(sp_ + 256 + voffS); r_ws##S = *(const float*)(sp_ + 512 + voffS); r_dec##S = *(const float*)(sp_ + 768 + voffS); } } while (0)
#define ML_STORE(S) do { \
        decay = __uint_as_float(__builtin_amdgcn_readfirstlane(__float_as_uint(r_dec##S))); \
        if (wid == 0) { sAI[lane] = r_ai##S; sEM[lane] = r_em##S; VTw[32 * LS + lane] = (bf16)f2bf(r_ws##S); } \
        _Pragma("unroll") for (int i_ = 0; i_ < 4; ++i_) { const int q_ = tid + 512 * i_, r_ = q_ >> 5, cc_ = (q_ & 31) * 8; *(LAS bf16x8*)(Qs + r_ * LQ + cc_) = rq##S[i_]; } \
        _Pragma("unroll") for (int i_ = 0; i_ < 4; ++i_) { const int q_ = tid + 512 * i_, d_ = q_ >> 3, cc_ = (q_ & 7) * 8; *(LAS bf16x8*)(KTs + d_ * LS + cc_) = rkt##S[i_]; } \
        { const int r_ = tid >> 3, cc_ = (tid & 7) * 8; *(LAS bf16x8*)(Ps + r_ * LS + cc_) = rp##S; } \
        if (tid < 256) { const int e_ = tid >> 3, cc_ = (tid & 7) * 8; *(LAS bf16x8*)(VTs + e_ * LS + cc_) = rvt##S; \
            LAS float* wsp_ = sWS + wid * 64; wsp_[lane] = r_ws##S; asm volatile("s_waitcnt lgkmcnt(0)" ::: "memory"); \
            const f32x4 wa_ = *(const LAS f32x4*)(wsp_ + cc_), wb_ = *(const LAS f32x4*)(wsp_ + cc_ + 4); const float wv_[8] = {wa_.x, wa_.y, wa_.z, wa_.w, wb_.x, wb_.y, wb_.z, wb_.w}; \
            const u32x4 rv_ = __builtin_bit_cast(u32x4, rvt##S); u32x4 o_; \
            o_.x = pk2(bflo(rv_.x) * wv_[0], bfhi(rv_.x) * wv_[1]); o_.y = pk2(bflo(rv_.y) * wv_[2], bfhi(rv_.y) * wv_[3]); \
            o_.z = pk2(bflo(rv_.z) * wv_[4], bfhi(rv_.z) * wv_[5]); o_.w = pk2(bflo(rv_.w) * wv_[6], bfhi(rv_.w) * wv_[7]); \
            *(LAS u32x4*)(VTw + e_ * LS + cc_) = o_; } } while (0)
        ML_LOAD(0, A);
        ML_BAR();
        ML_STORE(A);
        ML_BAR();
        ML_LOAD(1, B); ML_LOAD(2, A);
#pragma unroll 2
        for (int c = 0; c < 64; ++c) {
            const int ncn = dir ? 63 - c : c; const size_t trow = (size_t)b * SEQ + (size_t)ncn * 64;
            const float dec_c = decay;
            LAS bf16* CTr = (LAS bf16*)(lds + OFF_CT0 + (c & 1) * CT_BYTES); LAS bf16* CTw = (LAS bf16*)(lds + OFF_CT0 + ((c & 1) ^ 1) * CT_BYTES);
            f32x4 n3 = {0.f, 0.f, 0.f, 0.f}, d3 = n3, n2 = n3, d2 = n3;
            {
                const LAS bf16* qp = Qs + (tt * 16 + fr) * LQ + fq * 8;
                const LAS bf16* cp0 = CTr + (sh * 16 + fr) * LQ + fq * 8; const LAS bf16* cp2 = CTr + (32 + fr) * LQ + fq * 8;
                bf16x8 pf[2], v0[2], v2[2];
#pragma unroll
                for (int ks = 0; ks < 2; ++ks) { const int ko = ks * 32 + fq * 8;
                    pf[ks] = *(const LAS bf16x8*)(Ps + (tt * 16 + fr) * LS + ko); v0[ks] = *(const LAS bf16x8*)(VTs + (sh * 16 + fr) * LS + ko); v2[ks] = *(const LAS bf16x8*)(VTs + (32 + fr) * LS + ko); }
#pragma unroll
                for (int hf = 0; hf < 4; ++hf) {
                    bf16x8 qf[2], c0[2], c2[2];
#pragma unroll
                    for (int k4 = 0; k4 < 2; ++k4) { const int ko = (hf * 2 + k4) * 32; qf[k4] = *(const LAS bf16x8*)(qp + ko); c0[k4] = *(const LAS bf16x8*)(cp0 + ko); c2[k4] = *(const LAS bf16x8*)(cp2 + ko); }
                    __builtin_amdgcn_sched_barrier(0);
                    if (hf == 0) {
#pragma unroll
                        for (int ks = 0; ks < 2; ++ks) { n2 = ML_MFMA(v0[ks], pf[ks], n2); d2 = ML_MFMA(v2[ks], pf[ks], d2); }
                    }
#pragma unroll
                    for (int k4 = 0; k4 < 2; ++k4) { n3 = ML_MFMA(c0[k4], qf[k4], n3); d3 = ML_MFMA(c2[k4], qf[k4], d3); }
                }
            }
            const int t = tt * 16 + fr;
            {
                const float ai = sAI[t], em = sEM[t];
                const float den0 = d2[0] + ai * d3[0];
                const float den = __shfl(den0, fr);
                const float rinv = 1.0f / fmaxf(fabsf(den), em);
                f32x4 hout; hout.x = (n2[0] + ai * n3[0]) * rinv; hout.y = (n2[1] + ai * n3[1]) * rinv; hout.z = (n2[2] + ai * n3[2]) * rinv; hout.w = (n2[3] + ai * n3[3]) * rinv;
                u32x2 hw; hw.x = pk2(hout.x, hout.y); hw.y = pk2(hout.z, hout.w); *(u32x2*)(HF + ((size_t)dir * M + trow + t) * D + h * 256 + es * 32 + sh * 16 + 4 * fq) = hw;
            }
#pragma unroll
            for (int a = 0; a < 2; ++a)
#pragma unroll
                for (int e = 0; e < 3; ++e) ct[a][e] = ct[a][e] * dec_c;
#pragma unroll
            for (int ks = 0; ks < 2; ++ks) { const int ko = ks * 32 + fq * 8; bf16x8 kt[2], vw[3];
#pragma unroll
                for (int a = 0; a < 2; ++a) kt[a] = *(const LAS bf16x8*)(KTs + ((2 * wid + a) * 16 + fr) * LS + ko);
#pragma unroll
                for (int e = 0; e < 3; ++e) vw[e] = *(const LAS bf16x8*)(VTw + (e * 16 + fr) * LS + ko);
                __builtin_amdgcn_sched_barrier(0);
#pragma unroll
                for (int a = 0; a < 2; ++a)
#pragma unroll
                    for (int e = 0; e < 3; ++e) ct[a][e] = ML_MFMA(kt[a], vw[e], ct[a][e]);
            }
#pragma unroll
            for (int a = 0; a < 2; ++a)
#pragma unroll
                for (int e = 0; e < 3; ++e) { u32x2 w; w.x = f2bf(ct[a][e][0]) | (f2bf(ct[a][e][1]) << 16); w.y = f2bf(ct[a][e][2]) | (f2bf(ct[a][e][3]) << 16);
                    *(LAS u32x2*)(CTw + (e * 16 + fr) * LQ + (2 * wid + a) * 16 + 4 * fq) = w; }
            ML_BAR();
            if (c + 1 < 64) { if (c & 1) { ML_STORE(A); } else { ML_STORE(B); } }
            ML_BAR();
            if (c + 3 < 64) { if (c & 1) { ML_LOAD(c + 3, A); } else { ML_LOAD(c + 3, B); } }
        }
#undef ML_LOAD
#undef ML_STORE
    }
}
}
}

struct EpiRes {
    static constexpr bool PERM = false, AFTER_DRAIN = false;
    const float* base; float* out; int ldc;
    __device__ __forceinline__ void operator()(const pg8::f32x4 (&acc)[2][2][4][2], const pg8::Unit& u, int wr, int wc, int fr, int fq) const {
#pragma unroll
        for (int ai = 0; ai < 2; ++ai)
#pragma unroll
            for (int m = 0; m < 4; ++m) { const size_t ro = (size_t)(u.pm * 256 + ai * 128 + wr * 64 + m * 16 + fr) * ldc + u.pn * 256 + wc * 32 + 4 * fq;
#pragma unroll
                for (int bj = 0; bj < 2; ++bj)
#pragma unroll
                    for (int n = 0; n < 2; ++n) { const size_t off = ro + bj * 128 + n * 16; const pg8::f32x4 bs = *(const pg8::f32x4*)(base + off); *(pg8::f32x4*)(out + off) = bs + acc[ai][bj][m][n]; } }
    }
};

#define ROR1(x) __int_as_float(__builtin_amdgcn_update_dpp(0, __float_as_int(x), 0x121, 0xF, 0xF, false))
#define ROL1(x) __int_as_float(__builtin_amdgcn_update_dpp(0, __float_as_int(x), 0x12F, 0xF, 0xF, false))
struct EpiConv {
    static constexpr bool PERM = true, AFTER_DRAIN = false;
    unsigned short* ACT; unsigned short* HALO; const float* cw; const float* cb;
    __device__ __forceinline__ void operator()(const pg8::f32x4 (&acc)[2][2][4][2], const pg8::Unit& u, int wr, int wc, int fr, int fq) const {
        using mk::FF; using mk::FF2;
        const int jb = u.pn * 128 + wc * 32 + 8 * fq;
        mk::u32x2 keep[2][4];
        pg8::f32x4 cf[2][8];
#pragma unroll
        for (int n = 0; n < 2; ++n) { const int j = jb + 4 * n;
            cf[n][0] = *(const pg8::f32x4*)(cw + j); cf[n][1] = *(const pg8::f32x4*)(cw + FF2 + j); cf[n][2] = *(const pg8::f32x4*)(cw + 2 * FF2 + j); cf[n][3] = *(const pg8::f32x4*)(cb + j);
            cf[n][4] = *(const pg8::f32x4*)(cw + FF + j); cf[n][5] = *(const pg8::f32x4*)(cw + FF2 + FF + j); cf[n][6] = *(const pg8::f32x4*)(cw + 2 * FF2 + FF + j); cf[n][7] = *(const pg8::f32x4*)(cb + FF + j); }
#pragma unroll
        for (int n = 0; n < 2; ++n) {
            const int j = jb + 4 * n;
            const pg8::f32x4 c0g = cf[n][0], c1g = cf[n][1], c2g = cf[n][2], cbg = cf[n][3], c0v = cf[n][4], c1v = cf[n][5], c2v = cf[n][6], cbv = cf[n][7];
#pragma unroll
            for (int ai = 0; ai < 2; ++ai) {
                float gRp[4], vRp[4], gLc[4], vLc[4];
#pragma unroll
                for (int i = 0; i < 4; ++i) { gLc[i] = ROL1(acc[ai][0][0][n][i]); vLc[i] = ROL1(acc[ai][1][0][n][i]); gRp[i] = 0.f; vRp[i] = 0.f; }
#pragma unroll
                for (int m = 0; m < 4; ++m) {
                    const int row = u.pm * 256 + ai * 128 + wr * 64 + m * 16 + fr;
                    float o[4];
#pragma unroll
                    for (int i = 0; i < 4; ++i) {
                        const float g = acc[ai][0][m][n][i], v = acc[ai][1][m][n][i];
                        const float gRc = ROR1(g), vRc = ROR1(v);
                        float gLn = 0.f, vLn = 0.f; if (m < 3) { gLn = ROL1(acc[ai][0][m + 1][n][i]); vLn = ROL1(acc[ai][1][m + 1][n][i]); }
                        float gu = gRc, vu = vRc, gd = gLc[i], vd = vLc[i];
                        if (m > 0) { if (fr == 0) { gu = gRp[i]; vu = vRp[i]; } }
                        if (m < 3) { if (fr == 15) { gd = gLn; vd = vLn; } }
                        gRp[i] = gRc; vRp[i] = vRc; gLc[i] = gLn; vLc[i] = vLn;
                        const float G = c0g[i] * gu + c1g[i] * g + c2g[i] * gd + cbg[i];
                        const float V = c0v[i] * vu + c1v[i] * v + c2v[i] * vd + cbv[i];
                        o[i] = G * __builtin_amdgcn_rcpf(1.0f + __expf(-G)) * V;
                    }
                    const bool edge = (m == 0 && fr == 0) || (m == 3 && fr == 15);
                    { mk::u32x2 w; w.x = mk::pk2(o[0], o[1]); w.y = mk::pk2(o[2], o[3]);
                      if (n == 0) keep[ai][m] = w;
                      else if (!edge) { mk::u32x4 w4; w4.x = keep[ai][m].x; w4.y = keep[ai][m].y; w4.z = w.x; w4.w = w.y; *(mk::u32x4*)(ACT + (size_t)row * FF + jb) = w4; } }
                    if ((m == 0 && fr < 2) || (m == 3 && fr > 13)) {
                        const int hr = (m == 0) ? fr : fr - 12;
                        unsigned short* hp = HALO + ((size_t)(row >> 6) * 4 + hr) * FF2 + j;
                        mk::u32x2 wg, wv; wg.x = mk::f2bf(acc[ai][0][m][n][0]) | (mk::f2bf(acc[ai][0][m][n][1]) << 16); wg.y = mk::f2bf(acc[ai][0][m][n][2]) | (mk::f2bf(acc[ai][0][m][n][3]) << 16);
                        wv.x = mk::f2bf(acc[ai][1][m][n][0]) | (mk::f2bf(acc[ai][1][m][n][1]) << 16); wv.y = mk::f2bf(acc[ai][1][m][n][2]) | (mk::f2bf(acc[ai][1][m][n][3]) << 16);
                        *(mk::u32x2*)hp = wg; *(mk::u32x2*)(hp + FF) = wv;
                    }
                }
            }
        }
    }
};

struct EpiBf16T {
    static constexpr bool PERM = true, AFTER_DRAIN = false;
    unsigned short* O; int ldc; int split_cols; float scale0; unsigned short* T; int tcol0; int ldt;
    __device__ __forceinline__ void operator()(const pg8::f32x4 (&acc)[2][2][4][2], const pg8::Unit& u, int wr, int wc, int fr, int fq) const {
        const int row0 = u.pm * 256 + wr * 64 + fr, colt = u.pn * 256, col0 = colt + wc * 32 + 8 * fq;
        const float sc = (colt < split_cols) ? scale0 : 1.f;
#pragma unroll
        for (int ai = 0; ai < 2; ++ai)
#pragma unroll
            for (int m = 0; m < 4; ++m) { unsigned short* rowp = O + (size_t)(row0 + ai * 128 + m * 16) * ldc + col0;
#pragma unroll
                for (int bj = 0; bj < 2; ++bj) { const pg8::f32x4 v0 = acc[ai][bj][m][0] * sc, v1 = acc[ai][bj][m][1] * sc;
                    mk::u32x4 w; w.x = mk::pk2(v0[0], v0[1]); w.y = mk::pk2(v0[2], v0[3]); w.z = mk::pk2(v1[0], v1[1]); w.w = mk::pk2(v1[2], v1[3]);
                    *(mk::u32x4*)(rowp + bj * 128) = w; } }
        if (colt >= tcol0) {
#pragma unroll
            for (int bj = 0; bj < 2; ++bj)
#pragma unroll
                for (int n = 0; n < 2; ++n)
#pragma unroll
                    for (int i = 0; i < 4; ++i) { unsigned short* tp = T + (size_t)(col0 - tcol0 + bj * 128 + 4 * n + i) * ldt + row0;
#pragma unroll
                        for (int ai = 0; ai < 2; ++ai)
#pragma unroll
                            for (int m = 0; m < 4; ++m) tp[ai * 128 + m * 16] = (unsigned short)mk::f2bf(acc[ai][bj][m][n][i]); }
        }
    }
};

struct GemmDesc { const unsigned short* A; const unsigned short* Bt; int Mg, Ng, Kg; int kind; unsigned short* O; int ldc; int split_cols; float scale0; const float* base; float* out; int G, c; };

#ifndef REPEAT_PH
#define REPEAT_PH 1000
#define N_REPEAT 0
#else
#define N_REPEAT 1
#endif
struct Params { const float* in[17]; float* out; unsigned char* ws; int ph_lo, ph_hi; };
constexpr int N_PHASES = 18;

__global__ void __launch_bounds__(512, 2) fwd_mega(Params p) {
    extern __shared__ __attribute__((aligned(16))) unsigned char lds_raw[];
    using namespace mk;
    cg::grid_group grid = cg::this_grid();
    LAS unsigned char* lds = (LAS unsigned char*)lds_raw;
    const int bid = blockIdx.x, nblk = gridDim.x;
    const int ph_lo = p.ph_lo, ph_hi = p.ph_hi;
    { volatile LAS unsigned* misc = (volatile LAS unsigned*)(lds + LDS_MISC); if (mk_tid() < 16) misc[mk_tid()] = 0u; }
    __syncthreads();
    (void)xcd_barrier_post((unsigned*)(p.ws + WS_BAR), (volatile LAS unsigned*)(lds + LDS_MISC) + 8);
    if (ph_lo < 0) grid.sync();
#ifdef PROBE_PH
    const unsigned long long t_start = __builtin_amdgcn_s_memrealtime();
#endif
#pragma unroll 1
    for (int ph_it = ph_lo; ph_it < ph_hi + N_REPEAT; ++ph_it) {
        const int ph = ph_it <= REPEAT_PH ? ph_it : ph_it - N_REPEAT;
        typedef const __attribute__((address_space(4))) Params* KP;
        KP kp = (KP)__builtin_amdgcn_kernarg_segment_ptr(); asm volatile("" : "+s"(kp));
        unsigned char* ws = kp->ws; float* OUT = kp->out; bf16* XN = (bf16*)(ws + WS_XN);
        In I; I.x = kp->in[0]; I.norm_mix = kp->in[1]; I.norm_ffn = kp->in[2]; I.w_in_ab = kp->in[3]; I.pool_w = kp->in[4]; I.pool_scale = kp->in[5]; I.q_norm = kp->in[6]; I.k_norm = kp->in[7];
        I.w_out_ab = kp->in[8]; I.w_in_c = kp->in[9]; I.b_gate = kp->in[10]; I.h_norm = kp->in[11]; I.w_out_c = kp->in[12]; I.w_up = kp->in[13]; I.conv_w = kp->in[14]; I.conv_b = kp->in[15]; I.w_down = kp->in[16];
        int nb_ = nblk; asm volatile("" : "+s"(nb_)); const int ngw = nb_ * NW, ngt = nb_ * 512;
        const int tid = mk_tid(), lane = tid & 63, wave = __builtin_amdgcn_readfirstlane(tid >> 6), gw = bid * NW + wave, gt = bid * 512 + tid;
#ifndef NO_THIN
        if (ph == 0) prologue(I, ws, lds, gw, ngw, wave, lane);
        if (ph == 5 || ph == 9 || ph == 14) rmsnorm_rows(OUT, ph == 5 ? I.norm_ffn : (ph == 9 ? I.norm_mix + D : I.norm_ffn + D), XN, gw, ngw, lane);
        if (ph == 2) qk_rope_pool((bf16*)(ws + WS_PROJ), I.q_norm, I.k_norm, (bf16*)(ws + WS_POOLED), gw, ngw, lane);
#endif
#ifndef NO_ATT
        if (ph == 3) {
            const bf16* PROJ = (const bf16*)(ws + WS_PROJ); bf16* CAT = (bf16*)(ws + WS_CAT);
            for (int u0 = bid; u0 < 384; u0 += nblk) {
                int u = u0;
                if (nblk == 256) { const int xcd = u0 & 7, j = (u0 >> 3) & 31, rnd = u0 >> 8; const int jj = j + 32 * rnd;
                    if (jj >= 48) continue; u = (xcd >> 2) * 192 + ((xcd & 3) * 3 + (jj >> 4)) * 16 + (jj & 15); }
                const int qb = u & 15, hq = (u >> 4) % 12, b = u / 192;
                const size_t r0 = (size_t)b * SEQ + (size_t)qb * 256;
                att::attn_dense_body<att::bf16>((const att::bf16*)(PROJ + r0 * ABW + 512 + hq * 128), (const att::bf16*)(PROJ + (size_t)b * SEQ * ABW + 2048 + (hq / 3) * 128),
                                                (const att::bf16*)(PROJ + (size_t)b * SEQ * ABW + 2560 + (hq / 3) * 128), CAT + r0 * D + 512 + hq * 128, SEQ, (char*)lds_raw);
                __syncthreads();
            }
        }
#endif
#ifndef NO_THIN
        if (ph == 7 || ph == 16) { const int l = ph == 7 ? 0 : 1; conv_fix((const bf16*)(ws + WS_U), I.conv_w + (size_t)l * 3 * FF2, I.conv_b + (size_t)l * FF2, (bf16*)(ws + WS_ACT), gt, ngt); }
        if (ph == 10) gates_phase(XN, (const bf16*)(ws + WS_C) + (size_t)8192 * D, I.b_gate, (float*)(ws + WS_GATES), (LAS float*)lds, bid, nblk);
#endif
#ifndef NO_ML
        if (ph == 11) {
            ml::mlstm_pre(lds, (const bf16*)(ws + WS_QK), (const float*)(ws + WS_GATES), (bf16*)(ws + WS_PB), (float*)(ws + WS_SC), bid, nblk);
            { XcdBarrier xb2; xb2.bar = (unsigned*)(ws + WS_BAR); xb2.x = xb_xcc_id(); xb2.st = (volatile LAS unsigned*)(lds + LDS_MISC) + 8; xcd_barrier(xb2); }
            ml::mlstm_seq(lds, (const bf16*)(ws + WS_QK), (const bf16*)(ws + WS_KVT), (const bf16*)(ws + WS_PB), (const float*)(ws + WS_SC), (bf16*)(ws + WS_HF), bid, nblk);
        }
#endif
#ifndef NO_THIN
        if (ph == 12) headnorm_phase((const bf16*)(ws + WS_HF), (const bf16*)(ws + WS_OG), I.h_norm, (bf16*)(ws + WS_Y), gw, ngw, lane);
#endif
#pragma unroll 1
        for (int gi = 0; gi < 3; ++gi) {
            GemmDesc d; d.kind = -1; d.G = nblk; d.c = bid; d.split_cols = 0; d.scale0 = 1.f; d.base = nullptr; d.out = nullptr; d.O = nullptr; d.ldc = 0; d.A = nullptr; d.Bt = nullptr; d.Mg = M; d.Ng = 0; d.Kg = D;
            if (gi == 0) {
                if (ph == 1) { d.kind = 0; d.A = XN; d.Bt = (bf16*)(ws + WS_AB); d.Ng = ABW; d.O = (bf16*)(ws + WS_PROJ); d.ldc = ABW; }
                else if (ph == 3) { d.kind = 0; d.A = (bf16*)(ws + WS_POOLED); d.Bt = (bf16*)(ws + WS_BD); d.Ng = 512; d.Kg = 512; d.O = (bf16*)(ws + WS_CAT); d.ldc = D;
                    if (nblk == 256) { const int slot = bid >> 3; d.G = 64; d.c = (slot - 16) * 8 + (bid & 7); if (slot < 16 || slot >= 24) d.kind = -1; } }
                else if (ph == 4) { d.kind = 1; d.A = (bf16*)(ws + WS_CAT); d.Bt = (bf16*)(ws + WS_OAB); d.Ng = D; d.base = I.x; d.out = OUT; }
                else if (ph == 6 || ph == 15) { d.kind = 2; d.A = XN; d.Bt = (bf16*)(ws + (ph == 6 ? WS_UP0 : WS_UP1)); d.Ng = FF2; d.O = (bf16*)(ws + WS_U); d.ldc = FF2; d.base = I.conv_w + (size_t)(ph == 6 ? 0 : 1) * 3 * FF2; d.out = (float*)(I.conv_b + (size_t)(ph == 6 ? 0 : 1) * FF2); }
                else if (ph == 8 || ph == 17) { d.kind = 1; d.A = (bf16*)(ws + WS_ACT); d.Bt = (bf16*)(ws + (ph == 8 ? WS_DN0 : WS_DN1)); d.Ng = D; d.Kg = FF; d.base = OUT; d.out = OUT; }
                else if (ph == 10) { d.kind = 3; d.A = XN; d.Bt = (bf16*)(ws + WS_C); d.Ng = 4096; d.O = (bf16*)(ws + WS_QK); d.ldc = 4096; d.split_cols = 2048; d.scale0 = 0.0625f; }
                else if (ph == 13) { d.kind = 1; d.A = (bf16*)(ws + WS_Y); d.Bt = (bf16*)(ws + WS_OC); d.Ng = D; d.base = OUT; d.out = OUT; }
            } else if (ph == 10) {
                if (gi == 1) { d.kind = 0; d.A = XN; d.Bt = (bf16*)(ws + WS_C) + (size_t)6144 * D; d.Ng = D; d.O = (bf16*)(ws + WS_OG); d.ldc = D; }
                else { d.kind = 0; d.A = (bf16*)(ws + WS_C) + (size_t)4096 * D; d.Bt = XN; d.Mg = 2048; d.Ng = M; d.O = (bf16*)(ws + WS_KVT) + (size_t)2048 * M; d.ldc = M; }
            }
#ifndef NO_GEMM
            if (d.kind == 0) {
                pg8::Gemm g{d.A, d.Bt, d.Mg, d.Ng, d.Kg}; pg8::StaticOrder S; S.init(d.Mg, d.Ng, d.G, d.c);
                pg8::EpiBf16<0> E{d.O, d.ldc, nullptr, d.split_cols, (size_t)d.split_cols, d.scale0};
                pg8::gemm_phase<pg8::EpiBf16<0>, pg8::StaticOrder, true, true>(lds, g, S, E);
            } else if (d.kind == 3) {
                pg8::Gemm g{d.A, d.Bt, d.Mg, d.Ng, d.Kg}; pg8::StaticOrder S; S.init(d.Mg, d.Ng, d.G, d.c);
                EpiBf16T E{d.O, d.ldc, d.split_cols, d.scale0, (bf16*)(ws + WS_KVT), 2048, M};
                pg8::gemm_phase<EpiBf16T, pg8::StaticOrder, true, true>(lds, g, S, E);
            } else if (d.kind == 2) {
                pg8::Gemm g{d.A, d.Bt, d.Mg, d.Ng, d.Kg}; pg8::StaticOrder S; S.init(d.Mg, d.Ng, d.G, d.c);
                EpiConv E{(bf16*)(ws + WS_ACT), d.O, d.base, (const float*)d.out};
                pg8::gemm_phase<EpiConv, pg8::StaticOrder, true, true>(lds, g, S, E);
            } else if (d.kind == 1) {
                pg8::Gemm g{d.A, d.Bt, d.Mg, d.Ng, d.Kg}; pg8::StaticOrder S; S.init(d.Mg, d.Ng, d.G, d.c);
                EpiRes E{d.base, d.out, D};
                pg8::gemm_phase<EpiRes, pg8::StaticOrder, true, true>(lds, g, S, E);
            }
#endif
            __syncthreads();
        }
#ifndef NO_THIN
        if (nb_ == 256) {
            if (ph == 1 && bid >= 128) { const int w = (bid - 128) * NW + wave; transposes(I, ws, lds, 1536, 2560, w, 128 * NW, wave, lane); transposes(I, ws, lds, 18944, 24576, w, 128 * NW, wave, lane); }
            if (ph == 3 && (bid >> 3) >= 16) { const int w = (((bid >> 3) - 16) * 8 + (bid & 7)) * NW + wave; transposes(I, ws, lds, 2560, 13312, w, 128 * NW, wave, lane); }
            if (ph == 6 && bid >= 128) { const int w = (bid - 128) * NW + wave; transposes(I, ws, lds, 13312, 18944, w, 128 * NW, wave, lane); }
        } else if (ph == 1) transposes(I, ws, lds, 1536, 24576, gw, ngw, wave, lane);
#endif
        if (ph_it + 1 < ph_hi + N_REPEAT) { XcdBarrier xbar; xbar.bar = (unsigned*)(ws + WS_BAR); xbar.x = xb_xcc_id(); xbar.st = (volatile LAS unsigned*)(lds + LDS_MISC) + 8; xcd_barrier(xbar);
#ifdef SYNC2
            xcd_barrier(xbar);
#endif
        }
#ifdef PROBE_PH
        if (bid == 0 && tid == 0) { unsigned long long* ts = (unsigned long long*)(ws + WS_BD + 768 * 1024); ts[ph + 1] = __builtin_amdgcn_s_memrealtime(); if (ph == 0) ts[0] = t_start;
            if (ph + 1 == ph_hi) { OUT[0] = (float)(ts[PROBE_PH + 1] - ts[PROBE_PH]) * 0.01f; } }
#endif
    }
}

#ifndef MK_MULTI
#define MK_MULTI 0
#endif
extern "C" void kernel_launch(void* const* d_in, const int* in_sizes, int n_in, void* d_out, int out_size, void* d_ws, size_t ws_size, hipStream_t stream) {
    static int grid = 0;
    if (grid == 0) {
        if (n_in != 17 || out_size != mk::M * mk::D || ws_size < mk::WS_END) { fprintf(stderr, "kernel_launch: unexpected shapes n_in %d out %d ws %zu (need %zu)\n", n_in, out_size, ws_size, (size_t)mk::WS_END); grid = -1; return; }
        int dev = 0, cus = 0, per_cu = 0;
        (void)hipGetDevice(&dev); (void)hipDeviceGetAttribute(&cus, hipDeviceAttributeMultiprocessorCount, dev);
        if (hipFuncSetAttribute((const void*)fwd_mega, hipFuncAttributeMaxDynamicSharedMemorySize, mk::LDS_BYTES) != hipSuccess) { fprintf(stderr, "kernel_launch: hipFuncSetAttribute failed\n"); grid = -1; return; }
        if (hipOccupancyMaxActiveBlocksPerMultiprocessor(&per_cu, (const void*)fwd_mega, 512, mk::LDS_BYTES) != hipSuccess || per_cu < 1) { fprintf(stderr, "kernel_launch: occupancy query gave %d\n", per_cu); per_cu = 1; }
        (void)hipGetLastError();
        if (cus <= 0) cus = 256;
        grid = cus * per_cu; if (grid > 256) grid = 256;
        fprintf(stderr, "kernel_launch: cus %d per_cu %d grid %d\n", cus, per_cu, grid);
    }
    if (grid < 0) return;
    if (hipMemsetAsync((char*)d_ws + mk::WS_BAR, 0, mk::BAR_BYTES, stream) != hipSuccess) { fprintf(stderr, "kernel_launch: memset failed\n"); return; }
    Params p{};
    for (int i = 0; i < 17; ++i) p.in[i] = (const float*)d_in[i];
    p.out = (float*)d_out; p.ws = (unsigned char*)d_ws;
#if MK_MULTI
    for (int ph = 0; ph < N_PHASES; ++ph) { p.ph_lo = ph; p.ph_hi = ph + 1; hipLaunchKernelGGL(fwd_mega, dim3(grid), dim3(512), mk::LDS_BYTES, stream, p); }
#else
    p.ph_lo = 0; p.ph_hi = N_PHASES;
    void* args[] = {&p};
    const hipError_t e = hipLaunchCooperativeKernel((const void*)fwd_mega, dim3(grid), dim3(512), args, mk::LDS_BYTES, stream);
    if (e != hipSuccess) fprintf(stderr, "kernel_launch: cooperative launch failed: %s (grid %d)\n", hipGetErrorString(e), grid);
#endif
}
```
